# Optimizing an MI355X kernel written in HIP

```python
import jax, jax.numpy as jnp
from jax import lax
import numpy as np

D_MODEL = 1024
BATCH = 16
SEQ = 2048
DEPTH = 1

N_HEADS = 8
N_KV_HEADS = 2
HEAD_DIM = 64
Q_WIDTH = N_HEADS * HEAD_DIM
KV_WIDTH = N_KV_HEADS * HEAD_DIM
ROPE_THETA = 500000.0
ROT_FRACTION = 4
IDX_HEADS = 8
IDX_DIM = 64
IDXQ_WIDTH = IDX_HEADS * IDX_DIM
TOPK_MAX = 256
Q_BLOCK = 128
CONV_DIM = 512
CONV_WIDTH = 3
N_BRANCHES = 2
IN_SPLIT_SIZES = (Q_WIDTH, KV_WIDTH, KV_WIDTH, IDXQ_WIDTH, IDX_DIM, IDX_HEADS,
                  CONV_DIM, CONV_DIM, CONV_DIM, N_BRANCHES * D_MODEL)
IN_WIDTH = Q_WIDTH + 2 * KV_WIDTH + IDXQ_WIDTH + IDX_DIM + IDX_HEADS + 3 * CONV_DIM + N_BRANCHES * D_MODEL
N_GROUPS = 4
EXPERTS_PER_GROUP = 8
N_EXPERTS = N_GROUPS * EXPERTS_PER_GROUP
EXPERT_TOPK = 2
D_EXPERT = 512
EXPERT_BLOCK = 128
LN_EPS = 1e-5
DEEPNORM_ALPHA = (2 * DEPTH) ** 0.25
DEEPNORM_BETA = (8 * DEPTH) ** -0.25

kernel_name = "hybrid_dsa_shortconv_hmoe_block"


def _split_points():
    return [int(s) for s in np.cumsum(IN_SPLIT_SIZES)[:-1]]


def layer_norm(x, g, b):
    xf = x.astype(jnp.float32)
    mu = jnp.mean(xf, axis=-1, keepdims=True)
    var = jnp.mean(jnp.square(xf - mu), axis=-1, keepdims=True)
    y = (xf - mu) * lax.rsqrt(var + LN_EPS)
    return (y * g.astype(jnp.float32) + b.astype(jnp.float32)).astype(x.dtype)


def partial_rope(t, pos):
    rot = t.shape[-1] // ROT_FRACTION
    half = rot // 2
    inv_freq = ROPE_THETA ** (-jnp.arange(half, dtype=jnp.float32) / half)
    ang = pos.astype(jnp.float32)[:, None] * inv_freq[None, :]
    cos = jnp.cos(ang)[None, :, None, :].astype(t.dtype)
    sin = jnp.sin(ang)[None, :, None, :].astype(t.dtype)
    x1 = t[..., :half]
    x2 = t[..., half:rot]
    return jnp.concatenate([x1 * cos - x2 * sin, x2 * cos + x1 * sin, t[..., rot:]], axis=-1)


def dsa_attention(q, k, v, qi, ki, wi, top_k):
    B, S = q.shape[0], q.shape[1]
    n_blocks = S // Q_BLOCK
    group = N_HEADS // N_KV_HEADS
    kpos = jnp.arange(S)

    def to_blocks(t):
        return jnp.moveaxis(t.reshape((B, n_blocks, Q_BLOCK) + t.shape[2:]), 1, 0)

    def one_block(args):
        qb, qib, wib, t0 = args
        qpos = t0 + jnp.arange(Q_BLOCK)
        admissible = kpos[None, :] <= qpos[:, None]
        rel = jax.nn.relu(jnp.einsum('bqhd,bsd->bqhs', qib, ki) * (IDX_DIM ** -0.5))
        score = jnp.einsum('bqhs,bqh->bqs', rel, wib) * (IDX_HEADS ** -0.5)
        score = jnp.where(admissible[None], score.astype(jnp.float32), -jnp.inf)
        _, idx = lax.top_k(score, top_k)
        valid = idx <= qpos[None, :, None]
        kg = jax.vmap(lambda kb, ib: kb[ib])(k, idx)
        vg = jax.vmap(lambda vb, ib: vb[ib])(v, idx)
        qg = qb.reshape(B, Q_BLOCK, N_KV_HEADS, group, HEAD_DIM)
        logits = jnp.einsum('bqhgd,bqkhd->bqhgk', qg, kg).astype(jnp.float32) * (HEAD_DIM ** -0.5)
        logits = jnp.where(valid[:, :, None, None, :], logits, -jnp.inf)
        p = jax.nn.softmax(logits, axis=-1).astype(vg.dtype)
        o = jnp.einsum('bqhgk,bqkhd->bqhgd', p, vg)
        return o.reshape(B, Q_BLOCK, N_HEADS * HEAD_DIM)

    t0s = jnp.arange(n_blocks) * Q_BLOCK
    out = lax.map(one_block, (to_blocks(q), to_blocks(qi), to_blocks(wi), t0s))
    return jnp.moveaxis(out, 0, 1).reshape(B, S, Q_WIDTH)


def short_conv(conv_in, conv_b, conv_c, conv_w):
    u = conv_c * conv_in
    rhs = conv_w[:, None, :].astype(u.dtype)
    y = lax.conv_general_dilated(u, rhs, window_strides=(1,), padding=[(CONV_WIDTH - 1, 0)],
                                 dimension_numbers=('NWC', 'WIO', 'NWC'),
                                 feature_group_count=CONV_DIM)
    return conv_b * y


def token_mixer(h, pos, top_k, w_in, gate_bias, w_attn_up, w_conv_up, conv_w, w_out):
    B, S, _ = h.shape
    proj = h @ w_in
    q, k, v, qi, ki, wi, conv_in, conv_b, conv_c, gates = jnp.split(proj, _split_points(), axis=-1)
    q = partial_rope(q.reshape(B, S, N_HEADS, HEAD_DIM), pos)
    k = partial_rope(k.reshape(B, S, N_KV_HEADS, HEAD_DIM), pos)
    v = v.reshape(B, S, N_KV_HEADS, HEAD_DIM)
    qi = partial_rope(qi.reshape(B, S, IDX_HEADS, IDX_DIM), pos)
    ki = partial_rope(ki.reshape(B, S, 1, IDX_DIM), pos)[:, :, 0]
    attn = dsa_attention(q, k, v, qi, ki, wi, top_k)
    conv = short_conv(conv_in, conv_b, conv_c, conv_w)
    g_attn, g_conv = jnp.split(jax.nn.sigmoid(gates + gate_bias), N_BRANCHES, axis=-1)
    merged = g_attn * (attn @ w_attn_up) + g_conv * (conv @ w_conv_up)
    return merged @ w_out


def hierarchical_moe(h, rg_w, rg_b, re_w, re_b, w_gate, w_up, w_down):
    B, S, D = h.shape
    n_tok = B * S
    xf = h.reshape(n_tok, D)
    g_logits = (xf @ rg_w + rg_b).astype(jnp.float32)
    grp = jnp.argmax(g_logits, axis=-1).astype(jnp.int32)
    p_grp = jnp.take_along_axis(jax.nn.softmax(g_logits, axis=-1), grp[:, None], axis=1)[:, 0]
    e_all = jnp.einsum('nd,gde->nge', xf, re_w) + re_b
    e_logits = jnp.take_along_axis(e_all, grp[:, None, None], axis=1)[:, 0].astype(jnp.float32)
    top_val, top_loc = lax.top_k(e_logits, EXPERT_TOPK)
    gate = p_grp[:, None] * jax.nn.softmax(top_val, axis=-1)
    expert = grp[:, None] * EXPERTS_PER_GROUP + top_loc.astype(jnp.int32)
    n_assign = n_tok * EXPERT_TOPK
    a_expert = expert.reshape(-1)
    a_token = jnp.repeat(jnp.arange(n_tok, dtype=jnp.int32), EXPERT_TOPK)
    a_w = gate.reshape(-1).astype(h.dtype)
    order = jnp.argsort(a_expert, stable=True)
    se, st, sw = a_expert[order], a_token[order], a_w[order]
    counts = jax.ops.segment_sum(jnp.ones_like(a_expert), a_expert, num_segments=N_EXPERTS)
    padded = ((counts + EXPERT_BLOCK - 1) // EXPERT_BLOCK) * EXPERT_BLOCK
    pad_end = jnp.cumsum(padded)
    pad_start = pad_end - padded
    raw_start = jnp.cumsum(counts) - counts
    dest = pad_start[se] + jnp.arange(n_assign, dtype=jnp.int32) - raw_start[se]
    cap = (-(-n_assign // EXPERT_BLOCK)) * EXPERT_BLOCK + N_EXPERTS * EXPERT_BLOCK
    n_blocks = cap // EXPERT_BLOCK
    row_token = jnp.zeros((cap,), jnp.int32).at[dest].set(st)
    row_w = jnp.zeros((cap,), h.dtype).at[dest].set(sw)
    block_start = jnp.arange(n_blocks, dtype=jnp.int32) * EXPERT_BLOCK
    block_expert = jnp.minimum(jnp.searchsorted(pad_end, block_start, side='right'), N_EXPERTS - 1)
    xs = xf[row_token].reshape(n_blocks, EXPERT_BLOCK, D)

    def expert_block(args):
        xb, e = args
        hid = jax.nn.silu(xb @ w_gate[e]) * (xb @ w_up[e])
        return hid @ w_down[e]

    ys = lax.map(expert_block, (xs, block_expert)).reshape(cap, D)
    out = jax.ops.segment_sum(ys * row_w[:, None], row_token, num_segments=n_tok)
    return out.reshape(B, S, D)


def setup_inputs(seed: int = 0) -> dict:
    key = jax.random.key(seed)
    ks = jax.random.split(key, 20)
    nrm = jax.random.normal
    L = DEPTH
    v_lo = Q_WIDTH + KV_WIDTH
    v_hi = v_lo + KV_WIDTH
    w_in = nrm(ks[1], (L, D_MODEL, IN_WIDTH), jnp.float32) * D_MODEL ** -0.5
    w_in = w_in.at[:, :, v_lo:v_hi].multiply(DEEPNORM_BETA)
    return {
        "x": nrm(ks[0], (BATCH, SEQ, D_MODEL), jnp.float32),
        "w_in": w_in,
        "gate_bias": 0.01 * nrm(ks[2], (L, N_BRANCHES * D_MODEL), jnp.float32),
        "w_attn_up": nrm(ks[3], (L, Q_WIDTH, D_MODEL), jnp.float32) * Q_WIDTH ** -0.5 * DEEPNORM_BETA,
        "w_conv_up": nrm(ks[4], (L, CONV_DIM, D_MODEL), jnp.float32) * CONV_DIM ** -0.5 * DEEPNORM_BETA,
        "conv_w": nrm(ks[5], (L, CONV_WIDTH, CONV_DIM), jnp.float32) * CONV_WIDTH ** -0.5,
        "w_out": nrm(ks[6], (L, D_MODEL, D_MODEL), jnp.float32) * D_MODEL ** -0.5 * DEEPNORM_BETA,
        "ln1_g": 1.0 + 0.02 * nrm(ks[7], (L, D_MODEL), jnp.float32),
        "ln1_b": 0.02 * nrm(ks[8], (L, D_MODEL), jnp.float32),
        "router_group_w": nrm(ks[9], (L, D_MODEL, N_GROUPS), jnp.float32) * D_MODEL ** -0.5,
        "router_group_b": 0.01 * nrm(ks[10], (L, N_GROUPS), jnp.float32),
        "router_expert_w": nrm(ks[11], (L, N_GROUPS, D_MODEL, EXPERTS_PER_GROUP), jnp.float32) * D_MODEL ** -0.5,
        "router_expert_b": 0.01 * nrm(ks[12], (L, N_GROUPS, EXPERTS_PER_GROUP), jnp.float32),
        "w_gate_e": nrm(ks[13], (L, N_EXPERTS, D_MODEL, D_EXPERT), jnp.float32) * D_MODEL ** -0.5,
        "w_up_e": nrm(ks[14], (L, N_EXPERTS, D_MODEL, D_EXPERT), jnp.float32) * D_MODEL ** -0.5,
        "w_down_e": nrm(ks[15], (L, N_EXPERTS, D_EXPERT, D_MODEL), jnp.float32) * D_EXPERT ** -0.5 * DEEPNORM_BETA,
        "ln2_g": 1.0 + 0.02 * nrm(ks[16], (L, D_MODEL), jnp.float32),
        "ln2_b": 0.02 * nrm(ks[17], (L, D_MODEL), jnp.float32),
    }


def reference(x, w_in, gate_bias, w_attn_up, w_conv_up, conv_w, w_out, ln1_g, ln1_b,
              router_group_w, router_group_b, router_expert_w, router_expert_b,
              w_gate_e, w_up_e, w_down_e, ln2_g, ln2_b):
    S = x.shape[1]
    top_k = min(TOPK_MAX, S // 4)
    pos = jnp.arange(S, dtype=jnp.int32)
    h = x
    for l in range(DEPTH):
        mix = token_mixer(h, pos, top_k, w_in[l], gate_bias[l], w_attn_up[l], w_conv_up[l],
                          conv_w[l], w_out[l])
        h = layer_norm(DEEPNORM_ALPHA * h + mix, ln1_g[l], ln1_b[l])
        ffn = hierarchical_moe(h, router_group_w[l], router_group_b[l], router_expert_w[l],
                               router_expert_b[l], w_gate_e[l], w_up_e[l], w_down_e[l])
        h = layer_norm(DEEPNORM_ALPHA * h + ffn, ln2_g[l], ln2_b[l])
    return h
```

```cpp
#include <hip/hip_runtime.h>
#include <hip/hip_bf16.h>
#include <cstdio>
#include <cstdint>

#ifndef MK_SPLIT
#define MK_SPLIT 0
#endif
#ifndef DBG_NAIVE
#define DBG_NAIVE 0
#endif
#ifndef DBG_G
#define DBG_G 1.0f
#endif

#define LAS __attribute__((address_space(3)))
#define GAS __attribute__((address_space(1)))
typedef unsigned short bf16_t;
typedef short bf16x8 __attribute__((ext_vector_type(8)));
typedef short s16x4 __attribute__((ext_vector_type(4)));
typedef float f32x2 __attribute__((ext_vector_type(2)));
typedef float f32x4 __attribute__((ext_vector_type(4)));
typedef float f32x16 __attribute__((ext_vector_type(16)));
typedef unsigned u32x2 __attribute__((ext_vector_type(2)));
typedef unsigned u32x4 __attribute__((ext_vector_type(4)));
typedef unsigned u32x16 __attribute__((ext_vector_type(16)));
typedef __bf16 bf16x2_t __attribute__((ext_vector_type(2)));

constexpr int NTOK = 32768, SEQ = 2048, NBATCH = 16, DM = 1024;
constexpr int NPROJ = 5120, INW = 4936;
constexpr int NEXP = 32, DEXP = 512, LISTCAP = 32768;
constexpr int CAPROWS = 65536 + NEXP * 256;
constexpr float LN_EPS = 1e-5f;
constexpr float ALPHA = 1.189207115002721f;
constexpr float C2 = 0.125f * 1.4426950408889634f;
constexpr float WSCALE = 0.125f * 0.35355339059327373f;

constexpr size_t MiB = 1u << 20;
constexpr size_t WS_CTL = 0, CTL_ZERO_BYTES = 1 * MiB;
constexpr size_t WS_ROPE = 1 * MiB;
constexpr size_t WS_WC = 1 * MiB + 256 * 1024;
constexpr size_t WS_WIN = 2 * MiB, WS_WAU = 12 * MiB, WS_WCU = 13 * MiB, WS_WOUT = 14 * MiB, WS_WD = 16 * MiB, WS_WGU = 48 * MiB;
constexpr size_t WS_XB = 112 * MiB;
constexpr size_t WS_H1Q = 112 * MiB;
constexpr size_t WS_AC = 112 * MiB;
constexpr size_t WS_Q = 176 * MiB, WS_K = 208 * MiB, WS_V = 216 * MiB, WS_QI = 224 * MiB, WS_KI = 256 * MiB, WS_WI = 260 * MiB;
constexpr size_t WS_MERGED = 176 * MiB;
constexpr size_t WS_U = 264 * MiB, WS_ATTN = 264 * MiB;
constexpr size_t WS_CB = 296 * MiB, WS_MASK = 360 * MiB, WS_GATES = 368 * MiB;
constexpr size_t WS_GA = 368 * MiB, WS_RT = 432 * MiB;
constexpr size_t WS_PRE = 240 * MiB;
constexpr size_t WS_HID = 368 * MiB;
constexpr size_t WS_LIST = 496 * MiB, WS_TOKINFO = 500 * MiB;
constexpr size_t WS_YS = 48 * MiB;
constexpr size_t WS_END = 512 * MiB;
static_assert(WS_YS + (size_t)CAPROWS * 1024 * 2 <= WS_PRE && WS_HID + (size_t)CAPROWS * 512 * 2 <= WS_LIST, "ws map");
constexpr int CW_BAR = 4096;
constexpr int CW_CNT = 8192;
constexpr int RING_BYTES = 131072;
constexpr int LDSCTL_OFF = RING_BYTES;
constexpr int TAB_OFF = RING_BYTES + 512;
constexpr int T_CNT = 0, T_BLK0 = 32, T_NB = 68, T_BLKE = 72, T_ROWS = 400, T_ROWS_UNITS = 8;
constexpr int LDS_BYTES = 147456;
static_assert(TAB_OFF + (T_ROWS + T_ROWS_UNITS * 256) * 4 <= LDS_BYTES && TAB_OFF + 8192 <= LDS_BYTES, "lds map");
constexpr int NWAVES = 8;

__device__ __forceinline__ unsigned pkbf(float lo, float hi) { f32x2 v = {lo, hi}; bf16x2_t b = __builtin_convertvector(v, bf16x2_t); return __builtin_bit_cast(unsigned, b); }
__device__ __forceinline__ float bflo(unsigned u) { return __uint_as_float(u << 16); }
__device__ __forceinline__ float bfhi(unsigned u) { return __uint_as_float(u & 0xffff0000u); }
__device__ __forceinline__ float wave_sum(float v) {
#pragma unroll
    for (int o = 1; o < 64; o <<= 1) v += __shfl_xor(v, o);
    return v;
}
__device__ __forceinline__ float wave_max(float v) {
#pragma unroll
    for (int o = 1; o < 64; o <<= 1) v = fmaxf(v, __shfl_xor(v, o));
    return v;
}
__device__ __forceinline__ float wave_min(float v) {
#pragma unroll
    for (int o = 1; o < 64; o <<= 1) v = fminf(v, __shfl_xor(v, o));
    return v;
}
#define LDS_WAIT() asm volatile("s_waitcnt lgkmcnt(0)" ::: "memory")
#define VM_WAIT() asm volatile("s_waitcnt vmcnt(0)" ::: "memory")

namespace pg8 {
constexpr int BM = 256, BK = 64, HALF = 128, HTB = HALF * BK * 2, STAGE_BYTES = 8 * HTB, NXCD = 8, WGM = 8;
__host__ __device__ __forceinline__ int lds_byte(int r, int c) { const int st = (r >> 4) * 2 + (c >> 5), rr = r & 15, cc = c & 31, ob = rr * 64 + cc * 2; return st * 1024 + (ob ^ (((ob >> 9) & 1) << 5)); }
__host__ __device__ __forceinline__ void stage_rc(int b, int& R, int& C) { const int st = b / 1024, sb = b % 1024, swz = sb ^ (((sb >> 9) & 1) << 5); R = (st >> 1) * 16 + swz / 64; C = (st & 1) * 32 + (swz % 64) / 2; }
__host__ __device__ __forceinline__ int perm32(int rho) { const int n = rho >> 4, i = rho & 15; return 8 * (i >> 2) + 4 * n + (i & 3); }

struct Unit { int pm, pn; };
struct Gemm { const bf16_t* A; const bf16_t* Bt; int M, N, K; int apitch; };

struct StaticOrder {
    int nM, nN, nwg, G, c;
    __host__ __device__ void init(int M, int N, int G_, int c_) { nM = M / BM; nN = N / BM; nwg = nM * nN; G = G_; c = c_; }
    __host__ __device__ bool next(int i, Unit& u) const {
        const long L = (long)i * G + c; if (L >= nwg) return false;
        int wgid = (int)L; { const int q = nwg / NXCD, r = nwg % NXCD, xcd = wgid % NXCD, off = wgid / NXCD; wgid = (xcd < r ? xcd * (q + 1) : r * (q + 1) + (xcd - r) * q) + off; }
        const int nig = WGM * nN, gid = wgid / nig, fm = gid * WGM, gsz = (nM - fm) < WGM ? (nM - fm) : WGM;
        u.pm = fm + ((wgid % nig) % gsz); u.pn = (wgid % nig) / gsz; return true;
    }
};
struct MoeOrder {
    const LAS int* blk_e; int nunits, G, c;
    __device__ __forceinline__ bool next(int i, Unit& u) const {
        const int L = i * G + c; if (L >= nunits) return false;
        const int rbg = L >> 2; u.pm = rbg; u.pn = blk_e[rbg] * 4 + (L & 3); return true;
    }
};

typedef int i32x8 __attribute__((ext_vector_type(8)));
typedef int i32x4_t __attribute__((ext_vector_type(4)));
constexpr int F8_WSCALE_E = 122;
template <class Epi, class Sched, bool ALIGN_EPI, bool GATHER, bool MIDHOOK = false, bool F8 = false>
__device__ __forceinline__ void gemm_phase(LAS unsigned char* lds, const Gemm g, const Sched& S, const Epi& E, const LAS int* rowtab) {
    const int tid = threadIdx.x, wid = __builtin_amdgcn_readfirstlane(tid >> 6), lane = tid & 63, wr = wid >> 2, wc = wid & 3, fr = lane & 15, fq = lane >> 4;
    const int K = g.K; int nt = K / BK;
    if constexpr (F8) asm volatile("" : "+s"(nt));
    int Rr[2]; unsigned cofs[2], voffB[2];
#pragma unroll
    for (int i = 0; i < 2; ++i) { int R, C; stage_rc(tid * 16 + i * 8192, R, C); const int Rb = Epi::PERM ? ((R & ~31) + perm32(R & 31)) : R;
        Rr[i] = R; cofs[i] = (unsigned)C * 2u; voffB[i] = (unsigned)(Rb * K + C) * 2u; }
    const unsigned rowb = g.apitch ? (unsigned)g.apitch : (unsigned)K * 2u;
    const size_t kstep = (size_t)(BK * 2);
    const size_t hstep = (size_t)HALF * K * 2;
    const size_t tstep = 2 * hstep;
    const unsigned ldsw = (unsigned)wid * 1024u;
    const int aoff = lds_byte(wr * 64 + fr, fq * 8), boff = lds_byte(wc * 32 + fr, fq * 8);
    const char* gA = (const char*)g.A;
#define PG8_SA(b, h) (((b) * 2 + (h)) * HTB)
#define PG8_SB(b, h) ((4 + (b) * 2 + (h)) * HTB)
#define PG8_STAGE(bufoff, gbase, voff) do { _Pragma("unroll") for (int _i = 0; _i < 2; ++_i) \
        __builtin_amdgcn_global_load_lds((const unsigned*)((const char*)(gbase) + (voff)[_i]), (LAS unsigned*)(lds + (bufoff) + ldsw + _i * 8192), 16, 0, 0); } while (0)
#define PG8_LD8(p_) __builtin_shufflevector(*(const LAS i32x4_t*)(p_), *(const LAS i32x4_t*)((p_) + 1024), 0, 1, 2, 3, 4, 5, 6, 7)
#define PG8_LDA(dst, b, h) do { if constexpr (F8) { _Pragma("unroll") for (int m = 0; m < 4; ++m) dst##8[m] = PG8_LD8(lds + PG8_SA(b, h) + aoff + m * 2048); } \
        else { _Pragma("unroll") for (int m = 0; m < 4; ++m) _Pragma("unroll") for (int k = 0; k < 2; ++k) dst[m][k] = *(const LAS bf16x8*)(lds + PG8_SA(b, h) + aoff + m * 2048 + k * 1024); } } while (0)
#define PG8_LDB(dst, b, h) do { if constexpr (F8) { _Pragma("unroll") for (int n = 0; n < 2; ++n) dst##8[n] = PG8_LD8(lds + PG8_SB(b, h) + boff + n * 2048); } \
        else { _Pragma("unroll") for (int n = 0; n < 2; ++n) _Pragma("unroll") for (int k = 0; k < 2; ++k) dst[n][k] = *(const LAS bf16x8*)(lds + PG8_SB(b, h) + boff + n * 2048 + k * 1024); } } while (0)
#define PG8_MMA(ai, bj, At, Bt) do { if constexpr (F8) __builtin_amdgcn_sched_barrier(0);     \
        __builtin_amdgcn_s_setprio(1); \
        if constexpr (F8) { _Pragma("unroll") for (int m = 0; m < 4; ++m) _Pragma("unroll") for (int n = 0; n < 2; ++n) \
            asm volatile("v_mfma_scale_f32_16x16x128_f8f6f4 %0, %1, %2, %0, %3, %4 op_sel_hi:[0,0,0]" : "+v"(acc[ai][bj][m][n]) : "v"(Bt##8[n]), "v"(At##8[m]), "v"(f8_sw), "v"(f8_sa));     \
            __builtin_amdgcn_sched_barrier(0); } \
        else { _Pragma("unroll") for (int m = 0; m < 4; ++m) _Pragma("unroll") for (int n = 0; n < 2; ++n) _Pragma("unroll") for (int k = 0; k < 2; ++k) \
            acc[ai][bj][m][n] = __builtin_amdgcn_mfma_f32_16x16x32_bf16(Bt[n][k], At[m][k], acc[ai][bj][m][n], 0, 0, 0); } \
        __builtin_amdgcn_s_setprio(0); } while (0)
#define PG8_WAIT_V(n) asm volatile("s_waitcnt vmcnt(" #n ")" ::: "memory")
#define PG8_WAIT_L(n) asm volatile("s_waitcnt lgkmcnt(" #n ")" ::: "memory")
#define PG8_BAR __builtin_amdgcn_s_barrier()
#define PG8_SCHED __builtin_amdgcn_sched_barrier(0)
#define PG8_AOFF(d0, d1, un, uidx) do { _Pragma("unroll") for (int _i = 0; _i < 2; ++_i) { unsigned r0_, r1_; \
        if (GATHER) { r0_ = (unsigned)rowtab[(uidx) * 256 + Rr[_i]]; r1_ = (unsigned)rowtab[(uidx) * 256 + 128 + Rr[_i]]; } \
        else { r0_ = (unsigned)((un).pm * 256 + Rr[_i]); r1_ = r0_ + 128u; } \
        d0[_i] = r0_ * rowb + cofs[_i]; d1[_i] = r1_ * rowb + cofs[_i]; } } while (0)
    Unit cur, nxt; int ui = 0;
    if (!S.next(0, cur)) return;
    f32x4 acc[2][2][4][2];
#pragma unroll
    for (int a = 0; a < 2; ++a)
#pragma unroll
        for (int b = 0; b < 2; ++b)
#pragma unroll
            for (int m = 0; m < 4; ++m)
#pragma unroll
                for (int n = 0; n < 2; ++n) acc[a][b][m][n] = (f32x4){0.f, 0.f, 0.f, 0.f};
    bf16x8 At[4][2], B0[2][2], B1[2][2]; i32x8 At8[4], B08[2], B18[2];
    int f8_sw = F8_WSCALE_E, f8_sa = 127; asm volatile("" : "+v"(f8_sw), "+v"(f8_sa));
    unsigned oc0[2], oc1[2], on0[2], on1[2];
    PG8_AOFF(oc0, oc1, cur, 0);
    const char* cB = (const char*)g.Bt + (size_t)cur.pn * tstep;
    PG8_STAGE(PG8_SB(0, 0), cB, voffB); PG8_STAGE(PG8_SB(0, 1), cB + hstep, voffB); PG8_STAGE(PG8_SA(0, 0), gA, oc0); PG8_STAGE(PG8_SA(0, 1), gA, oc1);
    if (wr == 1) PG8_BAR;
    PG8_WAIT_V(2); PG8_BAR;
    PG8_STAGE(PG8_SB(1, 0), cB + kstep, voffB); PG8_STAGE(PG8_SA(1, 0), gA + kstep, oc0); PG8_STAGE(PG8_SB(1, 1), cB + hstep + kstep, voffB);
    PG8_WAIT_V(6); PG8_BAR;
    for (;;) {
        const bool has_next = S.next(ui + 1, nxt);
        if (has_next) { PG8_AOFF(on0, on1, nxt, ui + 1); } else { on0[0] = oc0[0]; on0[1] = oc0[1]; on1[0] = oc1[0]; on1[1] = oc1[1]; }
        const char* nB = has_next ? (const char*)g.Bt + (size_t)nxt.pn * tstep : cB;
        for (int t = 0; t < nt; t += 2) {
            if constexpr (MIDHOOK) { if (t == nt / 2) E.mid(acc, cur, wr, wc, fr, fq); }
            const bool last = (t == nt - 2);
            const char* a1 = gA + (size_t)(t + 1) * kstep;
            const char* a2 = last ? gA : gA + (size_t)(t + 2) * kstep; const char* b2 = last ? nB : cB + (size_t)(t + 2) * kstep;
            const char* a3 = a2 + kstep; const char* b3 = b2 + kstep;
            unsigned o20[2], o21[2];
            o20[0] = last ? on0[0] : oc0[0]; o20[1] = last ? on0[1] : oc0[1]; o21[0] = last ? on1[0] : oc1[0]; o21[1] = last ? on1[1] : oc1[1];
            PG8_LDB(B0, 0, 0); PG8_LDB(B1, 0, 1); PG8_SCHED; PG8_LDA(At, 0, 0); PG8_STAGE(PG8_SA(1, 1), a1, oc1);
            PG8_WAIT_V(8); PG8_WAIT_L(0); PG8_BAR; PG8_MMA(0, 0, At, B0); PG8_MMA(0, 1, At, B1); PG8_BAR; PG8_SCHED;
            PG8_LDA(At, 0, 1); PG8_STAGE(PG8_SB(0, 0), b2, voffB); PG8_STAGE(PG8_SB(0, 1), b2 + hstep, voffB); PG8_STAGE(PG8_SA(0, 0), a2, o20);
            PG8_WAIT_V(8); PG8_WAIT_L(0); PG8_BAR; PG8_MMA(1, 0, At, B0); PG8_MMA(1, 1, At, B1); PG8_BAR; PG8_SCHED;
            PG8_LDB(B0, 1, 0); PG8_LDB(B1, 1, 1); PG8_SCHED; PG8_LDA(At, 1, 0); PG8_STAGE(PG8_SA(0, 1), a2, o21);
            PG8_WAIT_V(8); PG8_WAIT_L(0); PG8_BAR; PG8_MMA(0, 0, At, B0); PG8_MMA(0, 1, At, B1); PG8_BAR; PG8_SCHED;
            PG8_LDA(At, 1, 1); PG8_STAGE(PG8_SB(1, 0), b3, voffB); PG8_STAGE(PG8_SB(1, 1), b3 + hstep, voffB); PG8_STAGE(PG8_SA(1, 0), a3, o20);
            PG8_WAIT_V(8); PG8_WAIT_L(0); PG8_BAR; PG8_MMA(1, 0, At, B0); PG8_MMA(1, 1, At, B1); PG8_BAR; PG8_SCHED;
        }
        if constexpr (ALIGN_EPI) { if (wr == 0) PG8_BAR; }
        if constexpr (F8) asm volatile("s_nop 15\n\ts_nop 15" ::: "memory");
        E(acc, cur, wr, wc, fr, fq);
        if (!has_next) break;
#pragma unroll
        for (int a = 0; a < 2; ++a)
#pragma unroll
            for (int b = 0; b < 2; ++b)
#pragma unroll
                for (int m = 0; m < 4; ++m)
#pragma unroll
                    for (int n = 0; n < 2; ++n) acc[a][b][m][n] = (f32x4){0.f, 0.f, 0.f, 0.f};
        cur = nxt; cB = nB; ++ui;
        oc0[0] = on0[0]; oc0[1] = on0[1]; oc1[0] = on1[0]; oc1[1] = on1[1];
        if constexpr (ALIGN_EPI) { if (wr == 1) PG8_BAR; }
    }
    PG8_WAIT_V(0);
    if constexpr (!ALIGN_EPI) { if (wr == 0) PG8_BAR; }
    PG8_BAR;
#undef PG8_SA
#undef PG8_SB
#undef PG8_STAGE
#undef PG8_LDA
#undef PG8_LDB
#undef PG8_MMA
#undef PG8_LD8
#undef PG8_WAIT_V
#undef PG8_WAIT_L
#undef PG8_BAR
#undef PG8_SCHED
#undef PG8_AOFF
}
}

typedef f32x4 AccT[2][2][4][2];
__device__ __forceinline__ void store8bf(bf16_t* p, const f32x4& v0, const f32x4& v1) {
    u32x4 w; w.x = pkbf(v0[0], v0[1]); w.y = pkbf(v0[2], v0[3]); w.z = pkbf(v1[0], v1[1]); w.w = pkbf(v1[2], v1[3]); *(u32x4*)p = w;
}
__device__ __forceinline__ void rope8(f32x4& v0, f32x4& v1, const float* rope, int pos, int i0) {
    const f32x4 c = *(const f32x4*)(rope + pos * 8 + i0), s = *(const f32x4*)(rope + SEQ * 8 + pos * 8 + i0);
    float a, b;
    a = v0[0]; b = v0[1]; v0[0] = a * c[0] - b * s[0]; v0[1] = b * c[0] + a * s[0];
    a = v0[2]; b = v0[3]; v0[2] = a * c[1] - b * s[1]; v0[3] = b * c[1] + a * s[1];
    a = v1[0]; b = v1[1]; v1[0] = a * c[2] - b * s[2]; v1[1] = b * c[2] + a * s[2];
    a = v1[2]; b = v1[3]; v1[2] = a * c[3] - b * s[3]; v1[3] = b * c[3] + a * s[3];
}
__device__ __forceinline__ float sigmoidf_(float z) { return __builtin_amdgcn_rcpf(1.0f + __expf(-z)); }

struct EpiProj {
    static constexpr bool PERM = true;
    bf16_t *q, *k, *v, *qi, *ki, *u, *cb, *ga, *rt; float* wi; const float* rope; const float* gate_bias;
    __device__ __forceinline__ void operator()(const AccT& acc, const pg8::Unit& un, int wr, int wc, int fr, int fq) const {
        const int pn = un.pn, row0 = un.pm * 256 + wr * 64 + fr, cg = 32 * wc + 8 * fq;
        const bool rot = ((wc & 1) == 0) && (fq < 2); const int i0 = 4 * fq;
        if (pn < 2 || pn == 3 || pn == 4) {
            bf16_t* dst = (pn < 2) ? q + pn * 256 : qi + (pn - 3) * 256; const float sc = (pn < 2) ? C2 : 1.0f;
#pragma unroll
            for (int ai = 0; ai < 2; ++ai)
#pragma unroll
                for (int m = 0; m < 4; ++m) { const int row = row0 + ai * 128 + m * 16, pos = row & (SEQ - 1);
#pragma unroll
                    for (int bj = 0; bj < 2; ++bj) { f32x4 v0 = acc[ai][bj][m][0], v1 = acc[ai][bj][m][1];
                        if (rot) rope8(v0, v1, rope, pos, i0);
                        v0 = v0 * sc; v1 = v1 * sc; store8bf(dst + (size_t)row * 512 + bj * 128 + cg, v0, v1); } }
        } else if (pn == 2) {
#pragma unroll
            for (int ai = 0; ai < 2; ++ai)
#pragma unroll
                for (int m = 0; m < 4; ++m) { const int row = row0 + ai * 128 + m * 16, pos = row & (SEQ - 1);
                    f32x4 v0 = acc[ai][0][m][0], v1 = acc[ai][0][m][1];
                    if (rot) rope8(v0, v1, rope, pos, i0);
                    store8bf(k + (size_t)row * 128 + cg, v0, v1);
                    store8bf(v + (size_t)row * 128 + cg, acc[ai][1][m][0], acc[ai][1][m][1]); }
        } else if (pn == 5) {
            if (wc < 2) {
#pragma unroll
                for (int ai = 0; ai < 2; ++ai)
#pragma unroll
                    for (int m = 0; m < 4; ++m) { const int row = row0 + ai * 128 + m * 16, pos = row & (SEQ - 1);
                        f32x4 v0 = acc[ai][0][m][0], v1 = acc[ai][0][m][1];
                        if (rot) rope8(v0, v1, rope, pos, i0);
                        { const int jch = cg >> 3; store8bf(ki + ((size_t)(row >> 5) * 4 + (jch >> 1)) * 512 + (row & 31) * 16 + (jch & 1) * 8, v0, v1); } }
            } else if (wc == 2 && fq == 0) {
#pragma unroll
                for (int ai = 0; ai < 2; ++ai)
#pragma unroll
                    for (int m = 0; m < 4; ++m) { const int row = row0 + ai * 128 + m * 16;
                        *(f32x4*)(wi + (size_t)row * 8) = acc[ai][0][m][0]; *(f32x4*)(wi + (size_t)row * 8 + 4) = acc[ai][0][m][1]; }
            }
        } else if (pn < 10) {
#pragma unroll
            for (int ai = 0; ai < 2; ++ai)
#pragma unroll
                for (int m = 0; m < 4; ++m) { const int row = row0 + ai * 128 + m * 16;
                    store8bf(u + (size_t)row * 512 + (pn - 6) * 128 + cg, acc[ai][0][m][0] * acc[ai][1][m][0], acc[ai][0][m][1] * acc[ai][1][m][1]); }
        } else if (pn < 12) {
#pragma unroll
            for (int ai = 0; ai < 2; ++ai)
#pragma unroll
                for (int m = 0; m < 4; ++m) { const int row = row0 + ai * 128 + m * 16;
#pragma unroll
                    for (int bj = 0; bj < 2; ++bj) store8bf(cb + (size_t)row * 512 + (pn - 10) * 256 + bj * 128 + cg, acc[ai][bj][m][0], acc[ai][bj][m][1]); }
        } else {
            const int gc0 = (pn - 12) * 128 + cg;
            const f32x4 ba0 = *(const f32x4*)(gate_bias + gc0), ba1 = *(const f32x4*)(gate_bias + gc0 + 4), bc0 = *(const f32x4*)(gate_bias + 1024 + gc0), bc1 = *(const f32x4*)(gate_bias + 1024 + gc0 + 4);
#pragma unroll
            for (int ai = 0; ai < 2; ++ai)
#pragma unroll
                for (int m = 0; m < 4; ++m) { const int row = row0 + ai * 128 + m * 16;
                    const f32x4 a0 = acc[ai][0][m][0] + ba0, a1 = acc[ai][0][m][1] + ba1, c0 = acc[ai][1][m][0] + bc0, c1 = acc[ai][1][m][1] + bc1;
                    f32x4 g0, g1, r0, r1;
#pragma unroll
                    for (int e = 0; e < 4; ++e) { const float ea0 = 1.0f + __expf(-a0[e]), ea1 = 1.0f + __expf(-a1[e]);
                        g0[e] = __builtin_amdgcn_rcpf(ea0); g1[e] = __builtin_amdgcn_rcpf(ea1);
                        r0[e] = ea0 * __builtin_amdgcn_rcpf(1.0f + __expf(-c0[e])); r1[e] = ea1 * __builtin_amdgcn_rcpf(1.0f + __expf(-c1[e])); }
                    store8bf(ga + (size_t)row * 1024 + gc0, g0, g1); store8bf(rt + (size_t)row * 1024 + gc0, r0, r1); }
        }
    }
};
struct EpiMerged {
    static constexpr bool PERM = true;
    const bf16_t* ga; const bf16_t* rt; bf16_t* out;
    __device__ __forceinline__ void scale(AccT& acc, const bf16_t* gsrc, const pg8::Unit& un, int wr, int wc, int fr, int fq) const {
        unsigned off0 = (unsigned)(un.pm * 256 + wr * 64 + fr) * 1024u + (unsigned)(un.pn * 256 + 32 * wc + 8 * fq);
        asm volatile("" : "+v"(off0));
#pragma unroll
        for (int ai = 0; ai < 2; ++ai)
#pragma unroll
            for (int m = 0; m < 4; ++m) {
#pragma unroll
                for (int bj = 0; bj < 2; ++bj) { const u32x4 gw = *(const u32x4*)(gsrc + (off0 + (unsigned)((ai * 128 + m * 16) * 1024 + bj * 128)));
                    f32x4& v0 = acc[ai][bj][m][0]; f32x4& v1 = acc[ai][bj][m][1];
                    v0[0] *= bflo(gw.x); v0[1] *= bfhi(gw.x); v0[2] *= bflo(gw.y); v0[3] *= bfhi(gw.y);
                    v1[0] *= bflo(gw.z); v1[1] *= bfhi(gw.z); v1[2] *= bflo(gw.w); v1[3] *= bfhi(gw.w); } }
    }
    __device__ __forceinline__ void mid(AccT& acc, const pg8::Unit& un, int wr, int wc, int fr, int fq) const { scale(acc, rt, un, wr, wc, fr, fq); }
    __device__ __forceinline__ void operator()(AccT& acc, const pg8::Unit& un, int wr, int wc, int fr, int fq) const {
        scale(acc, ga, un, wr, wc, fr, fq);
        const int row0 = un.pm * 256 + wr * 64 + fr, col0 = un.pn * 256 + 32 * wc + 8 * fq;
#pragma unroll
        for (int ai = 0; ai < 2; ++ai)
#pragma unroll
            for (int m = 0; m < 4; ++m) { const int row = row0 + ai * 128 + m * 16;
#pragma unroll
                for (int bj = 0; bj < 2; ++bj) store8bf(out + (size_t)row * 1024 + col0 + bj * 128, acc[ai][bj][m][0], acc[ai][bj][m][1]); }
    }
};
struct EpiOut {
    static constexpr bool PERM = false;
    const float* x; float* pre;
    __device__ __forceinline__ void operator()(const AccT& acc, const pg8::Unit& un, int wr, int wc, int fr, int fq) const {
        const int row0 = un.pm * 256 + wr * 64 + fr, col0 = un.pn * 256 + 32 * wc + 4 * fq;
#pragma unroll
        for (int ai = 0; ai < 2; ++ai)
#pragma unroll
            for (int m = 0; m < 4; ++m) { const size_t off = (size_t)(row0 + ai * 128 + m * 16) * 1024 + col0;
#pragma unroll
                for (int bj = 0; bj < 2; ++bj)
#pragma unroll
                    for (int n = 0; n < 2; ++n) { const f32x4 xv = *(const f32x4*)(x + off + bj * 128 + n * 16);
                        *(f32x4*)(pre + off + bj * 128 + n * 16) = xv * ALPHA + acc[ai][bj][m][n]; } }
    }
};
struct EpiSwiGLU {
    static constexpr bool PERM = true;
    unsigned char* hid;
    __device__ __forceinline__ void operator()(const AccT& acc, const pg8::Unit& un, int wr, int wc, int fr, int fq) const {
        const int row0 = un.pm * 256 + wr * 64 + fr, col0 = (un.pn & 3) * 128 + 32 * wc + 8 * fq;
#pragma unroll
        for (int ai = 0; ai < 2; ++ai)
#pragma unroll
            for (int m = 0; m < 4; ++m) { const int row = row0 + ai * 128 + m * 16; f32x4 h0, h1;
#pragma unroll
                for (int e = 0; e < 4; ++e) { const float g0 = acc[ai][0][m][0][e], g1 = acc[ai][0][m][1][e];
                    h0[e] = g0 * sigmoidf_(g0) * acc[ai][1][m][0][e]; h1[e] = g1 * sigmoidf_(g1) * acc[ai][1][m][1][e]; }
                int w0 = 0, w1 = 0;
                w0 = __builtin_amdgcn_cvt_pk_fp8_f32(h0[0], h0[1], w0, false); w0 = __builtin_amdgcn_cvt_pk_fp8_f32(h0[2], h0[3], w0, true);
                w1 = __builtin_amdgcn_cvt_pk_fp8_f32(h1[0], h1[1], w1, false); w1 = __builtin_amdgcn_cvt_pk_fp8_f32(h1[2], h1[3], w1, true);
                *(u32x2*)(hid + (size_t)row * 512 + col0) = (u32x2){(unsigned)w0, (unsigned)w1}; }
    }
};
struct EpiYs {
    static constexpr bool PERM = true;
    unsigned char* ys;
    __device__ __forceinline__ void operator()(const AccT& acc, const pg8::Unit& un, int wr, int wc, int fr, int fq) const {
        const int row0 = un.pm * 256 + wr * 64 + fr, col0 = (un.pn & 3) * 256 + 32 * wc + 8 * fq;
#pragma unroll
        for (int ai = 0; ai < 2; ++ai)
#pragma unroll
            for (int m = 0; m < 4; ++m) { const int row = row0 + ai * 128 + m * 16;
#pragma unroll
                for (int bj = 0; bj < 2; ++bj) { const f32x4 v0 = acc[ai][bj][m][0], v1 = acc[ai][bj][m][1]; int w0 = 0, w1 = 0;
                    w0 = __builtin_amdgcn_cvt_pk_fp8_f32(v0[0], v0[1], w0, false); w0 = __builtin_amdgcn_cvt_pk_fp8_f32(v0[2], v0[3], w0, true);
                    w1 = __builtin_amdgcn_cvt_pk_fp8_f32(v1[0], v1[1], w1, false); w1 = __builtin_amdgcn_cvt_pk_fp8_f32(v1[2], v1[3], w1, true);
                    *(u32x2*)(ys + (size_t)row * 1024 + col0 + bj * 128) = (u32x2){(unsigned)w0, (unsigned)w1}; } }
    }
};

namespace attn_body {
using bf16 = __hip_bfloat16;
constexpr int D = 64, QP = 512, KP = 128, OP = 1024, OCOL = 512;
constexpr int NW = 8, QBLK = 32, QB = QBLK * NW, KVBLK = 64;
__device__ __forceinline__ int crow(int r, int hi) { return (r & 3) + 8 * (r >> 2) + 4 * hi; }
#define SBAR() __builtin_amdgcn_sched_barrier(0)
__device__ __forceinline__ void cmask(f32x16& p0, f32x16& p1, int jb, int qrel, int hi) {
    const float NEG = -INFINITY; int kb = 64 * jb + 4 * hi;
#pragma unroll
    for (int r = 0; r < 16; ++r) { int kv = kb + (r & 3) + 8 * (r >> 2); if (kv > qrel) p0[r] = NEG; if (kv + 32 > qrel) p1[r] = NEG; }
}
constexpr int NSLOT = 3, SLOTB = 8192;
constexpr int LDS_K = 0, LDS_V = NSLOT * SLOTB, LDS_WS = 2 * NSLOT * SLOTB, LDS_OST = LDS_WS + NW * 64 * 4, LDS_QF = LDS_OST + NW * 4096, LDS_BYTES_A = LDS_QF + NW * 4096;
static_assert(LDS_BYTES_A <= 131072, "attention LDS");
__device__ __forceinline__ void glds16(const void* gsrc, unsigned lds_dst) { unsigned keep;
    asm volatile("s_mov_b32 %0, m0\n\ts_mov_b32 m0, %2\n\ts_nop 0\n\tglobal_load_lds_dwordx4 %1, off\n\ts_mov_b32 m0, %0" : "=&s"(keep) : "v"(gsrc), "s"(lds_dst) : "memory"); }
__device__ __forceinline__ float max3f(float a, float b, float c) { float r; asm("v_max3_f32 %0, %1, %2, %3" : "=v"(r) : "v"(a), "v"(b), "v"(c)); return r; }
__device__ __forceinline__ float max2f(float a, float b) { float r; asm("v_max_f32_e32 %0, %1, %2" : "=v"(r) : "v"(a), "v"(b)); return r; }
__device__ __forceinline__ float fadd_s(float a, float b) { float r; asm("v_add_f32_e32 %0, %1, %2" : "=v"(r) : "v"(a), "v"(b)); return r; }
__device__ __forceinline__ float fsub_s(float a, float b) { float r; asm("v_sub_f32_e32 %0, %1, %2" : "=v"(r) : "v"(a), "v"(b)); return r; }
__device__ __forceinline__ unsigned cvtpk_s(float lo, float hi) { return pkbf(lo, hi); }
__device__ __forceinline__ float msel(float x, float neg, unsigned long long m) { float r; asm("v_cndmask_b32_e64 %0, %1, %2, %3" : "=v"(r) : "v"(neg), "v"(x), "s"(m)); return r; }
#define WAIT_BAR(N) asm volatile("s_waitcnt vmcnt(" #N ") lgkmcnt(0)\n\ts_barrier" ::: "memory")

typedef __attribute__((address_space(3))) const char* lds_cptr;
__device__ __forceinline__ void qkt(f32x16& p0, f32x16& p1, const char* Kslot, lds_cptr qfp, const f32x16& negm, int r32, int hi) {
    const char* kb = Kslot + hi * 1024 + r32 * 16;
#pragma unroll
    for (int d0 = 0; d0 < 4; ++d0) {
        const bf16x8 b0 = *reinterpret_cast<const bf16x8*>(kb + d0 * 2048);
        const bf16x8 b1 = *reinterpret_cast<const bf16x8*>(kb + d0 * 2048 + 512);
        const bf16x8 qd = *(const LAS bf16x8*)(qfp + d0 * 1024);
        if (d0 == 0) { p0 = __builtin_amdgcn_mfma_f32_32x32x16_bf16(b0, qd, negm, 0, 0, 0); p1 = __builtin_amdgcn_mfma_f32_32x32x16_bf16(b1, qd, negm, 0, 0, 0); }
        else { p0 = __builtin_amdgcn_mfma_f32_32x32x16_bf16(b0, qd, p0, 0, 0, 0); p1 = __builtin_amdgcn_mfma_f32_32x32x16_bf16(b1, qd, p1, 0, 0, 0); } }
}
typedef short v4i16_t __attribute__((ext_vector_type(4)));
__device__ __forceinline__ void kload8(bf16x8* kf, lds_cptr kp) {
    kf[0] = *(const LAS bf16x8*)(kp);        kf[1] = *(const LAS bf16x8*)(kp + 512);
    kf[2] = *(const LAS bf16x8*)(kp + 2048); kf[3] = *(const LAS bf16x8*)(kp + 2560);
    kf[4] = *(const LAS bf16x8*)(kp + 4096); kf[5] = *(const LAS bf16x8*)(kp + 4608);
    kf[6] = *(const LAS bf16x8*)(kp + 6144); kf[7] = *(const LAS bf16x8*)(kp + 6656);
}
__device__ __forceinline__ void kload2(bf16x8* kf, lds_cptr kp, int j) { kf[2 * j] = *(const LAS bf16x8*)(kp + j * 2048); kf[2 * j + 1] = *(const LAS bf16x8*)(kp + j * 2048 + 512); }
__device__ __forceinline__ s16x4 vtr(lds_cptr p) { return __builtin_bit_cast(s16x4, __builtin_amdgcn_ds_read_tr16_b64_v4i16((LAS v4i16_t*)p)); }
__device__ __forceinline__ float rowmax(const f32x16& p0, const f32x16& p1) {
    float a = max3f(p0[0], p0[1], p1[0]), b = max3f(p0[2], p0[3], p1[1]); a = max3f(a, p1[2], p1[3]);
#pragma unroll
    for (int r = 4; r < 16; r += 4) { a = max3f(a, p0[r], p0[r + 1]); b = max3f(b, p0[r + 2], p0[r + 3]); a = max3f(a, p1[r], p1[r + 1]); b = max3f(b, p1[r + 2], p1[r + 3]); }
    const float m = max2f(a, b);
    auto rr = __builtin_amdgcn_permlane32_swap(__float_as_uint(m), __float_as_uint(m), false, false);
    return max2f(__uint_as_float(rr[0]), __uint_as_float(rr[1]));
}
__device__ __forceinline__ void pv(f32x16* o, int vb, bf16x8 pa0, bf16x8 pa1, bf16x8 pa2, bf16x8 pa3) {
#pragma unroll
    for (int d0 = 0; d0 < 2; ++d0) { s16x4 lo[4], hi[4];
#pragma unroll
        for (int ks = 0; ks < 4; ++ks) {
            asm volatile("ds_read_b64_tr_b16 %0,%1 offset:%c2" : "=&v"(lo[ks]) : "v"(vb), "i"(d0 * 4096 + ks * 1024) : "memory");
            asm volatile("ds_read_b64_tr_b16 %0,%1 offset:%c2" : "=&v"(hi[ks]) : "v"(vb), "i"(d0 * 4096 + ks * 1024 + 512) : "memory"); }
        asm volatile("s_waitcnt lgkmcnt(0)" ::: "memory"); SBAR();
#define PK(k) (bf16x8){lo[k][0], lo[k][1], lo[k][2], lo[k][3], hi[k][0], hi[k][1], hi[k][2], hi[k][3]}
        o[d0] = __builtin_amdgcn_mfma_f32_32x32x16_bf16(pa0, PK(0), o[d0], 0, 0, 0);
        o[d0] = __builtin_amdgcn_mfma_f32_32x32x16_bf16(pa1, PK(1), o[d0], 0, 0, 0);
        o[d0] = __builtin_amdgcn_mfma_f32_32x32x16_bf16(pa2, PK(2), o[d0], 0, 0, 0);
        o[d0] = __builtin_amdgcn_mfma_f32_32x32x16_bf16(pa3, PK(3), o[d0], 0, 0, 0);
#undef PK
    }
}
#define ATTN_STORE16(p, v) (*(u32x4*)(p) = (v))
template <int THRL> __device__ __forceinline__ void attn_unit(int b, int h, int qb, const bf16* Q, const bf16* __restrict__ K, const bf16* __restrict__ V, bf16* O, const unsigned* masks, char* shm) {
    const int tid = threadIdx.x, lane = tid & 63, r32 = lane & 31, hi = lane >> 5; const int wid = __builtin_amdgcn_readfirstlane(tid >> 6);
    const long rowbase = (long)b * SEQ; const int q0 = qb * QB;
    const bf16* Qw = Q + (rowbase + q0 + wid * QBLK) * QP + h * D;
    const bf16 *Kh = K + rowbase * KP + (h >> 2) * D, *Vh = V + rowbase * KP + (h >> 2) * D;
    const unsigned* mrow = masks + ((size_t)(b * (SEQ / 32) + (q0 >> 5) + wid) * (SEQ / 64)) * 64;
    const unsigned lds0 = (unsigned)(uintptr_t)shm;
    float* wsf = (float*)(shm + LDS_WS) + wid * 64;
    const bf16* ksrc = Kh + (long)lane * KP + wid * 8;
    const bf16* vsrc = Vh + (long)(16 * (wid & 3) + (lane >> 2)) * KP + (wid >> 2) * 32 + (lane & 3) * 8;
    const unsigned kdst = lds0 + LDS_K + wid * 1024, vdst = lds0 + LDS_V + wid * 1024;
#define DMA_K(t, slot) glds16(ksrc + (long)(t) * KVBLK * KP, (unsigned)__builtin_amdgcn_readfirstlane(kdst + (slot)))
#define DMA_V(t, slot) glds16(vsrc + (long)(t) * KVBLK * KP, (unsigned)__builtin_amdgcn_readfirstlane(vdst + (slot)))
    const int vb0 = (int)(lds0 + LDS_V) + ((lane >> 4) & 1) * 32 + (lane & 3) * 8 + (4 * hi + ((lane & 15) >> 2)) * 64;
    const char* Kbase = shm + LDS_K; bf16x8 kf[8];
    const lds_cptr shm3 = (lds_cptr)shm; const lds_cptr kp0 = shm3 + LDS_K + hi * 1024 + r32 * 16; const lds_cptr vp0 = shm3 + LDS_V + ((lane >> 4) & 1) * 32 + (lane & 3) * 8 + (4 * hi + ((lane & 15) >> 2)) * 64;
    const int NT = (q0 + QB) / KVBLK;
    u32x16 mA, mB;
#define MLOAD0(t) do { const unsigned* mp_ = mrow + (size_t)(t) * 64; \
        asm volatile("s_load_dwordx16 %0, %1, 0x0" : "=s"(mA) : "s"(mp_)); asm volatile("s_load_dwordx16 %0, %1, 0x40" : "=s"(mB) : "s"(mp_)); } while (0)
#define MLOAD1(t) do { const unsigned* mp_ = mrow + (size_t)(t) * 64; \
        asm volatile("s_load_dwordx16 %0, %1, 0x80" : "=s"(mA) : "s"(mp_)); asm volatile("s_load_dwordx16 %0, %1, 0xc0" : "=s"(mB) : "s"(mp_)); } while (0)
#define MPAIR(M, j) (((unsigned long long)(M)[2 * (j) + 1] << 32) | (unsigned long long)(M)[2 * (j)])
#define MAPPLY(P) do { asm volatile("s_waitcnt lgkmcnt(0)" : "+s"(mA), "+s"(mB)); const float NEG_ = -INFINITY; \
        _Pragma("unroll") for (int r = 0; r < 8; ++r) { P[r] = msel(P[r], NEG_, MPAIR(mA, r)); P[r + 8] = msel(P[r + 8], NEG_, MPAIR(mB, r)); } } while (0)
    DMA_K(0, 0); DMA_V(0, 0); DMA_K(1, SLOTB);
    MLOAD0(0);
    const lds_cptr qfp = shm3 + LDS_QF + wid * 4096 + lane * 16;
    { bf16x8 qr[4];
#pragma unroll
      for (int d0 = 0; d0 < 4; ++d0) qr[d0] = *reinterpret_cast<const bf16x8*>(&Qw[(long)r32 * QP + d0 * 16 + hi * 8]);
#pragma unroll
      for (int d0 = 0; d0 < 4; ++d0) *(LAS bf16x8*)(LAS char*)(qfp + d0 * 1024) = qr[d0]; }
#define QF(i) (*(const LAS bf16x8*)(qfp + (i) * 1024))
    float mhat = 0.f, l_reg = 0.f; f32x16 o[2]; o[0] = f32x16{}; o[1] = f32x16{}; f32x16 negm = f32x16{}; asm volatile("" : "+v"(negm));
    const int qrel = wid * QBLK + r32;
#define CMASK(P0, P1, t) do { int jb_ = (t) - (NT - 4); if (jb_ >= 0) cmask(P0, P1, jb_, qrel, hi); } while (0)
    bool resc = false;
#define START(P0, P1) do { const float rm = rowmax(P0, P1); resc = false; \
    { const float dl = rm; mhat = fadd_s(mhat, dl); \
      _Pragma("unroll") for (int r = 0; r < 16; ++r) { P0[r] = fsub_s(P0[r], dl); P1[r] = fsub_s(P1[r], dl); } \
      _Pragma("unroll") for (int r = 0; r < 16; ++r) negm[r] = -mhat; asm volatile("" : "+v"(negm)); } } while (0)
#define RESC() do { if (resc) { asm volatile("s_waitcnt lgkmcnt(0)" ::: "memory"); \
      _Pragma("unroll") for (int d_ = 0; d_ < 2; ++d_) _Pragma("unroll") for (int r = 0; r < 16; ++r) o[d_][r] *= wsf[crow(r, hi)]; } } while (0)
    f32x16 pA0, pA1, pB0, pB1;
    int sl_prev = 0, sl_cur = 0, sl_next = SLOTB;
#define ROT() do { sl_prev = sl_cur; sl_cur = sl_next; sl_next = (sl_next == (NSLOT - 1) * SLOTB) ? 0 : sl_next + SLOTB; } while (0)
    DMA_K(2, 2 * SLOTB);
    WAIT_BAR(3);
    qkt(pA0, pA1, Kbase, qfp, negm, r32, hi); asm volatile("s_nop 15\n\ts_nop 7" : "+v"(pA0), "+v"(pA1)); CMASK(pA0, pA1, 0);
    START(pA0, pA1);
    MAPPLY(pA0); MLOAD1(0); MAPPLY(pA1); MLOAD0(1);
    _Pragma("unroll") for (int r = 0; r < 16; ++r) { pA0[r] = __builtin_amdgcn_exp2f(pA0[r]); pA1[r] = __builtin_amdgcn_exp2f(pA1[r]); }
    WAIT_BAR(0);
    DMA_K(3, 0); DMA_V(1, SLOTB);
    ROT();
    kload8(kf, kp0 + sl_cur);
    WAIT_BAR(2);
    s16x4 vlo[8], vhi[8]; u32x4 pw0, pw1, pw2, pw3;
#define PKW(P, B) cvtpk_s(P[B], P[B + 1])
#define PAF(k) __builtin_bit_cast(bf16x8, pw##k)
#define VFR(i) (bf16x8){vlo[i][0], vlo[i][1], vlo[i][2], vlo[i][3], vhi[i][0], vhi[i][1], vhi[i][2], vhi[i][3]}
#define PIN(x) asm volatile("" : "+v"(x))
#define MX3(a, b, c) __builtin_fmaxf(__builtin_fmaxf((a), (b)), (c))
#define GAPA(MF, A0, A1, A2, A3, W0, W1, PW) do { MF; sacc += A0; sacc += A1; sacc += A2; sacc += A3; PIN(sacc); W0; W1; PIN(PW); SBAR(); } while (0)
#define EX(v) __builtin_amdgcn_exp2f(v)
#define GAPB(MF, X, B) do { MF; X[B] = EX(X[B]); X[B + 1] = EX(X[B + 1]); X[B + 2] = EX(X[B + 2]); X[B + 3] = EX(X[B + 3]); PIN(X); SBAR(); } while (0)
#define VRD(i) do { vlo[i] = vtr(vp_ + (((i) >> 2) * 4096 + ((i) & 3) * 1024)); vhi[i] = vtr(vp_ + (((i) >> 2) * 4096 + ((i) & 3) * 1024 + 512)); } while (0)
#define KRD(G, j) do { if (G) { kload2(kf, kp0 + sl_next, j); SBAR(); } } while (0)
#define STEP(C0, C1, P0, P1, t, GK, GV, GL, GM) do { SBAR(); \
    const lds_cptr vp_ = vp0 + sl_prev; \
    VRD(0); bf16x8 qa_ = QF(0), qb_ = QF(1); SBAR(); float sacc = (P0[0] + P0[1]); \
    GAPA(C0 = __builtin_amdgcn_mfma_f32_32x32x16_bf16(kf[0], qa_, negm, 0, 0, 0), P0[2], P0[3], P0[4], P0[5],     pw0[0] = PKW(P0, 0), pw0[1] = PKW(P0, 2), pw0); \
    VRD(4); SBAR(); GAPA(C1 = __builtin_amdgcn_mfma_f32_32x32x16_bf16(kf[1], qa_, negm, 0, 0, 0), P0[6], P0[7], P0[8], P0[9],     pw0[2] = PKW(P0, 4), pw0[3] = PKW(P0, 6), pw0); \
    VRD(1); qa_ = QF(2); SBAR(); GAPA(C0 = __builtin_amdgcn_mfma_f32_32x32x16_bf16(kf[2], qb_, C0, 0, 0, 0),   P0[10], P0[11], P0[12], P0[13], pw1[0] = PKW(P0, 8), pw1[1] = PKW(P0, 10), pw1); \
    VRD(5); SBAR(); GAPA(C1 = __builtin_amdgcn_mfma_f32_32x32x16_bf16(kf[3], qb_, C1, 0, 0, 0),   P0[14], P0[15], P1[0], P1[1],   pw1[2] = PKW(P0, 12), pw1[3] = PKW(P0, 14), pw1); \
    VRD(2); qb_ = QF(3); SBAR(); GAPA(C0 = __builtin_amdgcn_mfma_f32_32x32x16_bf16(kf[4], qa_, C0, 0, 0, 0),   P1[2], P1[3], P1[4], P1[5],     pw2[0] = PKW(P1, 0), pw2[1] = PKW(P1, 2), pw2); \
    VRD(6); SBAR(); GAPA(C1 = __builtin_amdgcn_mfma_f32_32x32x16_bf16(kf[5], qa_, C1, 0, 0, 0),   P1[6], P1[7], P1[8], P1[9],     pw2[2] = PKW(P1, 4), pw2[3] = PKW(P1, 6), pw2); \
    VRD(3); SBAR(); GAPA(C0 = __builtin_amdgcn_mfma_f32_32x32x16_bf16(kf[6], qb_, C0, 0, 0, 0),   P1[10], P1[11], P1[12], P1[13], pw3[0] = PKW(P1, 8), pw3[1] = PKW(P1, 10), pw3); \
    VRD(7); SBAR(); GAPA(C1 = __builtin_amdgcn_mfma_f32_32x32x16_bf16(kf[7], qb_, C1, 0, 0, 0),   P1[14], P1[15], 0.f, 0.f,       pw3[2] = PKW(P1, 12), pw3[3] = PKW(P1, 14), pw3); \
    l_reg += sacc; \
    if (GK) { DMA_K((t) + 3, sl_cur); } if (GV) { DMA_V((t) + 1, sl_next); } \
    CMASK(C0, C1, t); \
    { float a = MX3(C0[0], C0[1], C1[0]), b = MX3(C0[2], C0[3], C1[1]); a = MX3(a, C1[2], C1[3]); \
      _Pragma("unroll") for (int r = 4; r < 16; r += 4) { a = MX3(a, C0[r], C0[r + 1]); b = MX3(b, C0[r + 2], C0[r + 3]); a = MX3(a, C1[r], C1[r + 1]); b = MX3(b, C1[r + 2], C1[r + 3]); } \
      float rm = __builtin_fmaxf(a, b); { auto rr = __builtin_amdgcn_permlane32_swap(__float_as_uint(rm), __float_as_uint(rm), false, false); rm = __builtin_fmaxf(__uint_as_float(rr[0]), __uint_as_float(rr[1])); } \
      resc = false; \
      if (__builtin_expect(__any(rm > (float)THRL), 0)) { const float dl = __builtin_fmaxf(rm, 0.f); mhat += dl; \
        _Pragma("unroll") for (int r = 0; r < 16; ++r) { C0[r] -= dl; C1[r] -= dl; } \
        _Pragma("unroll") for (int r = 0; r < 16; ++r) negm[r] = -mhat; asm volatile("" : "+v"(negm)); \
        const float f = __builtin_amdgcn_exp2f(-dl); l_reg *= f; if (hi == 0) wsf[r32] = f; resc = true; } } \
    MAPPLY(C0); MLOAD1(t); \
    SBAR(); \
    GAPB(o[0] = __builtin_amdgcn_mfma_f32_32x32x16_bf16(PAF(0), VFR(0), o[0], 0, 0, 0), C0, 0); \
    GAPB(o[1] = __builtin_amdgcn_mfma_f32_32x32x16_bf16(PAF(0), VFR(4), o[1], 0, 0, 0), C0, 4); \
    KRD(GL, 0); GAPB(o[0] = __builtin_amdgcn_mfma_f32_32x32x16_bf16(PAF(1), VFR(1), o[0], 0, 0, 0), C0, 8); \
    KRD(GL, 1); GAPB(o[1] = __builtin_amdgcn_mfma_f32_32x32x16_bf16(PAF(1), VFR(5), o[1], 0, 0, 0), C0, 12); \
    MAPPLY(C1); if (GM) { MLOAD0((t) + 1); } SBAR(); \
    KRD(GL, 2); GAPB(o[0] = __builtin_amdgcn_mfma_f32_32x32x16_bf16(PAF(2), VFR(2), o[0], 0, 0, 0), C1, 0); \
    KRD(GL, 3); GAPB(o[1] = __builtin_amdgcn_mfma_f32_32x32x16_bf16(PAF(2), VFR(6), o[1], 0, 0, 0), C1, 4); \
    GAPB(o[0] = __builtin_amdgcn_mfma_f32_32x32x16_bf16(PAF(3), VFR(3), o[0], 0, 0, 0), C1, 8); \
    GAPB(o[1] = __builtin_amdgcn_mfma_f32_32x32x16_bf16(PAF(3), VFR(7), o[1], 0, 0, 0), C1, 12); \
    } while (0)
    int t = 1;
#undef CMASK
#define CMASK(P0, P1, t) do { } while (0)
    for (; t + 5 < NT; t += 2) {
        STEP(pB0, pB1, pA0, pA1, t, true, true, true, true);     WAIT_BAR(2); RESC(); ROT();
        STEP(pA0, pA1, pB0, pB1, t + 1, true, true, true, true); WAIT_BAR(2); RESC(); ROT();
    }
#undef CMASK
#define CMASK(P0, P1, t) do { int jb_ = (t) - (NT - 4); if (jb_ >= 0) cmask(P0, P1, jb_, qrel, hi); } while (0)
#define ENDW(tt) do { if ((tt) + 3 < NT) { WAIT_BAR(2); } else if ((tt) + 2 < NT) { WAIT_BAR(1); } else { WAIT_BAR(0); } } while (0)
    for (; t + 1 < NT; t += 2) {
        STEP(pB0, pB1, pA0, pA1, t, (t + 3 < NT), (t + 1 < NT), (t + 1 < NT), (t + 1 < NT));         ENDW(t);     RESC(); ROT();
        STEP(pA0, pA1, pB0, pB1, t + 1, (t + 4 < NT), (t + 2 < NT), (t + 2 < NT), (t + 2 < NT));     ENDW(t + 1); RESC(); ROT();
    }
    STEP(pB0, pB1, pA0, pA1, NT - 1, false, false, false, false); RESC();
    { float sacc = pB0[0] + pB0[1]; _Pragma("unroll") for (int r = 2; r < 16; ++r) sacc += pB0[r]; _Pragma("unroll") for (int r = 0; r < 16; ++r) sacc += pB1[r]; l_reg += sacc;
      pw0 = (u32x4){PKW(pB0, 0), PKW(pB0, 2), PKW(pB0, 4), PKW(pB0, 6)}; pw1 = (u32x4){PKW(pB0, 8), PKW(pB0, 10), PKW(pB0, 12), PKW(pB0, 14)}; pw2 = (u32x4){PKW(pB1, 0), PKW(pB1, 2), PKW(pB1, 4), PKW(pB1, 6)}; pw3 = (u32x4){PKW(pB1, 8), PKW(pB1, 10), PKW(pB1, 12), PKW(pB1, 14)};
      SBAR(); pv(o, vb0 + sl_cur, PAF(0), PAF(1), PAF(2), PAF(3)); }
#undef PKW
#undef PAF
#undef VFR
#undef PIN
#undef MX3
#undef GAPA
#undef GAPB
#undef EX
#undef VRD
#undef KRD
#undef STEP
#undef ENDW
    { auto rr = __builtin_amdgcn_permlane32_swap(__float_as_uint(l_reg), __float_as_uint(l_reg), false, false); l_reg = __uint_as_float(rr[0]) + __uint_as_float(rr[1]); }
    if (hi == 0) wsf[32 + r32] = l_reg; asm volatile("s_waitcnt lgkmcnt(0)" ::: "memory");
    float rli[16];
#pragma unroll
    for (int r = 0; r < 16; ++r) rli[r] = __builtin_amdgcn_rcpf(wsf[32 + crow(r, hi)]);
    bf16* Ow = O + (rowbase + q0 + wid * QBLK) * OP + OCOL + h * D;
    { bf16* stg = (bf16*)(shm + LDS_OST) + wid * 2048;
#pragma unroll
      for (int r = 0; r < 16; ++r) { const int orow = crow(r, hi);
#pragma unroll
        for (int d0 = 0; d0 < 2; ++d0) stg[orow * 64 + d0 * 32 + r32] = __float2bfloat16(o[d0][r] * rli[r]); }
      asm volatile("s_waitcnt lgkmcnt(0)" ::: "memory");
#pragma unroll
      for (int i = 0; i < 4; ++i) { const int row = i * 8 + (lane >> 3), ch = lane & 7; const u32x4 v = *(const u32x4*)(stg + row * 64 + ch * 8); ATTN_STORE16(Ow + (long)row * OP + ch * 8, v); } }
    asm volatile("s_waitcnt lgkmcnt(0)\n\ts_barrier" ::: "memory");
#undef DMA_K
#undef DMA_V
#undef CMASK
#undef START
#undef RESC
#undef ROT
#undef MLOAD0
#undef MLOAD1
#undef MPAIR
#undef QF
#undef MAPPLY
}
#undef SBAR
#undef WAIT_BAR
}

#define XB_TMO      128
#define XB_XCNT(j)  (256  + 64 * (j))
#define XB_XSUB(j)  (1280 + 64 * (j))
#define XB_XGEN(j)  (2304 + 64 * (j))
#define XB_TOP      3328
#define XB_TOPGEN   3392
#define XCD_BAR_WORDS 3456
#define XB_SPIN_CAP (1u << 18)
__device__ __forceinline__ unsigned xb_ld(unsigned* p)              { return __hip_atomic_load(p, __ATOMIC_RELAXED, __HIP_MEMORY_SCOPE_AGENT); }
__device__ __forceinline__ unsigned xb_add(unsigned* p, unsigned v) { return __hip_atomic_fetch_add(p, v, __ATOMIC_RELAXED, __HIP_MEMORY_SCOPE_AGENT); }
__device__ __forceinline__ unsigned xb_xcc_id() { return (unsigned)__builtin_amdgcn_s_getreg((3 << 11) | 20) & 0xFu; }
#define XB_SPIN(cond, bar) do { unsigned _sp = 0; while (cond) { __builtin_amdgcn_s_sleep(1); \
    if ((++_sp & 255u) == 0u) { if (xb_ld(&(bar)[XB_TMO])) break; if (_sp > XB_SPIN_CAP) { atomicAdd(&(bar)[XB_TMO], 1u); break; } } } } while (0)
struct XcdBarrier { unsigned* bar; unsigned x; volatile LAS unsigned* st; };
__device__ __forceinline__ XcdBarrier xcd_barrier_post(unsigned* bar, volatile LAS unsigned* st) {
    XcdBarrier b; b.bar = bar; b.x = xb_xcc_id(); b.st = st;
    if (threadIdx.x == 0) (void)xb_add(&bar[XB_XCNT(b.x)], 1u);
    return b;
}
__device__ __forceinline__ void xcd_barrier_complete(unsigned* bar, unsigned x, unsigned& nloc, unsigned& nx) {
    const unsigned G = gridDim.x * gridDim.y * gridDim.z;
    unsigned sum, cnt, mine, sp = 0u;
    for (;;) {
        sum = 0u; cnt = 0u; mine = 0u;
#pragma unroll
        for (unsigned j = 0; j < 16; ++j) { const unsigned c = xb_ld(&bar[XB_XCNT(j)]); sum += c; cnt += (c > 0u) ? 1u : 0u; mine = (j == x) ? c : mine; }
        if (sum == G) break;
        __builtin_amdgcn_s_sleep(1);
        if ((++sp & 255u) == 0u) { if (xb_ld(&bar[XB_TMO])) break; if (sp > XB_SPIN_CAP) { atomicAdd(&bar[XB_TMO], 1u); break; } }
    }
    nloc = mine > 0u ? mine : 1u; nx = cnt > 0u ? cnt : 1u;
}
__device__ __forceinline__ void xcd_barrier(const XcdBarrier& b) {
    asm volatile("s_waitcnt vmcnt(0)" ::: "memory");
    __syncthreads();
    if (threadIdx.x == 0) {
        unsigned* bar = b.bar;
        __builtin_amdgcn_s_waitcnt(0);
        unsigned nloc = b.st[0], nx = b.st[1];
        if (nloc == 0u) { xcd_barrier_complete(bar, b.x, nloc, nx); b.st[0] = nloc; b.st[1] = nx; }
        const unsigned old = xb_add(&bar[XB_XSUB(b.x)], 1u);
        const unsigned gen = old / nloc;
        if (old + 1u == (gen + 1u) * nloc) {
            __builtin_amdgcn_fence(__ATOMIC_RELEASE, "agent");
            asm volatile("s_waitcnt vmcnt(0)" ::: "memory");
            const unsigned og = xb_add(&bar[XB_TOP], 1u);
            const unsigned tg = og / nx;
            if (og + 1u == (tg + 1u) * nx) xb_add(&bar[XB_TOPGEN], 1u);
            else XB_SPIN(xb_ld(&bar[XB_TOPGEN]) == tg, bar);
            __builtin_amdgcn_fence(__ATOMIC_ACQUIRE, "agent");
            xb_add(&bar[XB_XGEN(b.x)], 1u);
            asm volatile("s_waitcnt vmcnt(0)" ::: "memory");
        } else {
            XB_SPIN(xb_ld(&bar[XB_XGEN(b.x)]) == gen, bar);
            __builtin_amdgcn_fence(__ATOMIC_ACQUIRE, "agent");
            asm volatile("s_waitcnt vmcnt(0)" ::: "memory");
        }
    }
    __syncthreads();
}

struct Frame {
    LAS unsigned char* lds; volatile LAS unsigned* MISC; unsigned* ctl;
    int tid, lane, wave, vcu, G;
    unsigned char* ws;
};
struct Args { const float* in[18]; float* out; unsigned char* ws; int ph_lo, ph_hi, flags, pad; };
typedef const __attribute__((address_space(4))) Args* KArgs;
__device__ __forceinline__ KArgs kargs() { KArgs p = (KArgs)__builtin_amdgcn_kernarg_segment_ptr(); asm volatile("" : "+s"(p)); return p; }

__device__ __forceinline__ int ropeperm(int d) { return d < 8 ? 2 * d : (d < 16 ? 2 * (d - 8) + 1 : d); }
__device__ __forceinline__ int win_row(int c) {
    if (c < 512)  return (c & ~63) + ropeperm(c & 63);
    if (c < 640)  { const int cc = c - 512; return 512 + (cc & ~63) + ropeperm(cc & 63); }
    if (c < 768)  return c;
    if (c < 1280) { const int cc = c - 768; return 768 + (cc & ~63) + ropeperm(cc & 63); }
    if (c < 1344) return 1280 + ropeperm(c - 1280);
    if (c < 1352) return c;
    if (c < 1864) { const int ch = c - 1352; return 1536 + (ch >> 7) * 256 + (ch & 127); }
    if (c < 2376) return 2560 + (c - 1864);
    if (c < 2888) { const int ch = c - 2376; return 1536 + (ch >> 7) * 256 + 128 + (ch & 127); }
    { const int g = c - 2888, gi = g & 1023; return 3072 + (gi >> 7) * 256 + (g >> 10) * 128 + (gi & 127); }
}
struct TItem { const float* src; bf16_t* WT; int N, KT, rbase, mode, n0, k0, kd; };
__device__ __forceinline__ void t_load(const TItem& t, float (&rg)[32], int lane) {
    int nn = t.n0 + (lane & 31); if (nn >= t.N) nn = t.N - 1;
    const float* p = t.src + (size_t)(t.k0 + (lane >> 5)) * t.N + nn;
#pragma unroll
    for (int i = 0; i < 32; ++i) rg[i] = p[(size_t)(2 * i) * t.N];
}
__device__ __forceinline__ void t_write(const TItem& t, const float (&rg)[32], LAS float* scr, int lane) {
#pragma unroll
    for (int i = 0; i < 32; ++i) scr[(2 * i + (lane >> 5)) * 33 + (lane & 31)] = rg[i];
    LDS_WAIT(); asm volatile("" ::: "memory");
    if (t.mode >= 3) {
        const int c4 = lane & 3;
#pragma unroll
        for (int j = 0; j < 2; ++j) { const int n = (lane >> 2) + 16 * j; const LAS float* sp = scr + (16 * c4) * 33 + n;
            if (t.n0 + n < t.N) { const int nn = t.n0 + n; const int row = t.mode == 3 ? t.rbase + (nn >> 7) * 256 + (nn & 127) : t.rbase + nn;
                u32x4 o;
#pragma unroll
                for (int q = 0; q < 4; ++q) { int wv = 0;
                    wv = __builtin_amdgcn_cvt_pk_fp8_f32(32.f * sp[(4 * q + 0) * 33], 32.f * sp[(4 * q + 1) * 33], wv, false);
                    wv = __builtin_amdgcn_cvt_pk_fp8_f32(32.f * sp[(4 * q + 2) * 33], 32.f * sp[(4 * q + 3) * 33], wv, true); o[q] = (unsigned)wv; }
                *(u32x4*)((unsigned char*)t.WT + (size_t)row * t.KT + t.k0 + 16 * c4) = o; } }
        LDS_WAIT(); asm volatile("" ::: "memory");
        return;
    }
    const int c = lane & 7;
#pragma unroll
    for (int j = 0; j < 4; ++j) { const int n = (lane >> 3) + 8 * j; const LAS float* sp = scr + (8 * c) * 33 + n;
        if (t.n0 + n < t.N) { const int nn = t.n0 + n; const int row = t.mode == 0 ? t.rbase + nn : (t.mode == 1 ? win_row(nn) : t.rbase + (nn >> 7) * 256 + (nn & 127));
            u32x4 o; o.x = pkbf(sp[0 * 33], sp[1 * 33]); o.y = pkbf(sp[2 * 33], sp[3 * 33]); o.z = pkbf(sp[4 * 33], sp[5 * 33]); o.w = pkbf(sp[6 * 33], sp[7 * 33]);
            *(u32x4*)(t.WT + (size_t)row * t.KT + t.kd + t.k0 + 8 * c) = o; } }
    LDS_WAIT(); asm volatile("" ::: "memory");
}
__device__ __forceinline__ void p0_prologue(Frame& F) {
    const KArgs ka = kargs();
    unsigned char* ws = F.ws;
    LAS float* scr = (LAS float*)(F.lds + F.wave * 16384);
    const int gw = F.vcu * NWAVES + F.wave, NGW = F.G * NWAVES;
    const int gt = F.vcu * 512 + F.tid, NGT = F.G * 512;
    bf16_t* Win = (bf16_t*)(ws + WS_WIN); bf16_t* Wau = (bf16_t*)(ws + WS_WAU); bf16_t* Wout = (bf16_t*)(ws + WS_WOUT);
    bf16_t* Wd = (bf16_t*)(ws + WS_WD); bf16_t* Wgu = (bf16_t*)(ws + WS_WGU);
    constexpr int I_IN = 16 * 155, I_AU = 8 * 32, I_OUT = 16 * 32, I_G = 32 * 16 * 16, I_D = 32 * 8 * 32;
    constexpr int NITEMS = I_IN + 2 * I_AU + I_OUT + 2 * I_G + I_D;
    const float *p_win = ka->in[1], *p_wau = ka->in[3], *p_wcu = ka->in[4], *p_wout = ka->in[6], *p_wg = ka->in[13], *p_wu = ka->in[14], *p_wd = ka->in[15];
#define T_DECODE(IT, T) do { int r_ = (IT); \
        if (r_ < I_IN) { T = TItem{p_win, Win, INW, 1024, 0, 1, 32 * (r_ % 155), 64 * (r_ / 155), 0}; } else { r_ -= I_IN; \
        if (r_ < I_AU) { T = TItem{p_wau, Wau, 1024, 1024, 0, 0, 32 * (r_ % 32), 64 * (r_ / 32), 512};     } else { r_ -= I_AU; \
        if (r_ < I_AU) { T = TItem{p_wcu, Wau, 1024, 1024, 0, 0, 32 * (r_ % 32), 64 * (r_ / 32), 0}; } else { r_ -= I_AU; \
        if (r_ < I_OUT) { T = TItem{p_wout, Wout, 1024, 1024, 0, 0, 32 * (r_ % 32), 64 * (r_ / 32), 0}; } else { r_ -= I_OUT; \
        if (r_ < I_G) { const int e_ = r_ >> 8, q_ = r_ & 255; T = TItem{p_wg + (size_t)e_ * 1024 * 512, Wgu, 512, 1024, e_ * 1024, 3, 32 * (q_ & 15), 64 * (q_ >> 4), 0}; } else { r_ -= I_G; \
        if (r_ < I_G) { const int e_ = r_ >> 8, q_ = r_ & 255; T = TItem{p_wu + (size_t)e_ * 1024 * 512, Wgu, 512, 1024, e_ * 1024 + 128, 3, 32 * (q_ & 15), 64 * (q_ >> 4), 0}; } else { r_ -= I_G; \
        { const int e_ = r_ >> 8, q_ = r_ & 255; T = TItem{p_wd + (size_t)e_ * 512 * 1024, Wd, 1024, 512, e_ * 1024, 4, 32 * (q_ & 31), 64 * (q_ >> 5), 0}; } } } } } } } } while (0)
    const int nitems = (F.G == 256) ? I_IN + 2 * I_AU + I_OUT : NITEMS;
    if (gw < nitems) {
        TItem cur, nxt; float rc[32], rn[32];
        T_DECODE(gw, cur); t_load(cur, rc, F.lane);
        for (int it = gw; it < nitems; it += NGW) {
            const int itn = (it + NGW < nitems) ? it + NGW : it;
            T_DECODE(itn, nxt); t_load(nxt, rn, F.lane);
            t_write(cur, rc, scr, F.lane);
            cur = nxt;
#pragma unroll
            for (int i = 0; i < 32; ++i) rc[i] = rn[i];
        }
    }
#undef T_DECODE
    for (int i = gt; i < 184 * 128; i += NGT) *(u32x4*)(Win + (size_t)1352 * 1024 + (size_t)i * 8) = (u32x4){0u, 0u, 0u, 0u};
    float* rope = (float*)(ws + WS_ROPE);
    for (int i = gt; i < SEQ * 8; i += NGT) { const int pos = i >> 3, j = i & 7;
        const float inv = (float)pow(500000.0, -(double)j / 8.0); const float ang = (float)pos * inv;
        rope[i] = cosf(ang); rope[SEQ * 8 + i] = sinf(ang); }
    { float* wc = (float*)(ws + WS_WC); const float* rgw = ka->in[9]; const float* rew = ka->in[11];
      for (int i = gt; i < 1024 * 48; i += NGT) { const int k = i / 48, c = i % 48;
          wc[i] = c < 4 ? rgw[k * 4 + c] : (c < 36 ? rew[(size_t)((c - 4) >> 3) * 1024 * 8 + k * 8 + ((c - 4) & 7)] : 0.f); } }
    const float* x = ka->in[0]; bf16_t* xb = (bf16_t*)(ws + WS_XB);
    for (size_t i = gt; i < (size_t)NTOK * DM / 8; i += (size_t)NGT * 4) {
        f32x4 va[4], vb[4];
#pragma unroll
        for (int q = 0; q < 4; ++q) { size_t ii = i + (size_t)q * NGT; if (ii >= (size_t)NTOK * DM / 8) ii = i; va[q] = *(const f32x4*)(x + ii * 8); vb[q] = *(const f32x4*)(x + ii * 8 + 4); }
#pragma unroll
        for (int q = 0; q < 4; ++q) { const size_t ii = i + (size_t)q * NGT; if (ii < (size_t)NTOK * DM / 8) store8bf(xb + ii * 8, va[q], vb[q]); } }
}

__device__ __forceinline__ int dpp_sum_i(int v) {
    v += __builtin_amdgcn_update_dpp(0, v, 0x111, 0xf, 0xf, true); v += __builtin_amdgcn_update_dpp(0, v, 0x112, 0xf, 0xf, true);
    v += __builtin_amdgcn_update_dpp(0, v, 0x114, 0xf, 0xf, true); v += __builtin_amdgcn_update_dpp(0, v, 0x118, 0xf, 0xf, true);
    return __builtin_amdgcn_readlane(v, 15) + __builtin_amdgcn_readlane(v, 31) + __builtin_amdgcn_readlane(v, 47) + __builtin_amdgcn_readlane(v, 63);
}
__device__ __forceinline__ float dpp_shr_f(float v, int ctrl_sel) {
    const int vi = __float_as_int(v);
    return __int_as_float(ctrl_sel == 1 ? __builtin_amdgcn_update_dpp(vi, vi, 0x111, 0xf, 0xf, false) : ctrl_sel == 2 ? __builtin_amdgcn_update_dpp(vi, vi, 0x112, 0xf, 0xf, false)
                        : ctrl_sel == 4 ? __builtin_amdgcn_update_dpp(vi, vi, 0x114, 0xf, 0xf, false) : __builtin_amdgcn_update_dpp(vi, vi, 0x118, 0xf, 0xf, false));
}
__device__ __forceinline__ float dpp_max_f(float v) {
    v = fmaxf(v, dpp_shr_f(v, 1)); v = fmaxf(v, dpp_shr_f(v, 2)); v = fmaxf(v, dpp_shr_f(v, 4)); v = fmaxf(v, dpp_shr_f(v, 8));
    const float a = __int_as_float(__builtin_amdgcn_readlane(__float_as_int(v), 15)), b = __int_as_float(__builtin_amdgcn_readlane(__float_as_int(v), 31));
    const float c = __int_as_float(__builtin_amdgcn_readlane(__float_as_int(v), 47)), d = __int_as_float(__builtin_amdgcn_readlane(__float_as_int(v), 63));
    return fmaxf(fmaxf(a, b), fmaxf(c, d));
}
__device__ __forceinline__ float dpp_min_f(float v) { return -dpp_max_f(-v); }
__device__ __forceinline__ float dpp_sum_f(float v) {
    v += __int_as_float(__builtin_amdgcn_update_dpp(0, __float_as_int(v), 0x111, 0xf, 0xf, true)); v += __int_as_float(__builtin_amdgcn_update_dpp(0, __float_as_int(v), 0x112, 0xf, 0xf, true));
    v += __int_as_float(__builtin_amdgcn_update_dpp(0, __float_as_int(v), 0x114, 0xf, 0xf, true)); v += __int_as_float(__builtin_amdgcn_update_dpp(0, __float_as_int(v), 0x118, 0xf, 0xf, true));
    const float a = __int_as_float(__builtin_amdgcn_readlane(__float_as_int(v), 15)), b = __int_as_float(__builtin_amdgcn_readlane(__float_as_int(v), 31));
    const float c = __int_as_float(__builtin_amdgcn_readlane(__float_as_int(v), 47)), d = __int_as_float(__builtin_amdgcn_readlane(__float_as_int(v), 63));
    return (a + b) + (c + d);
}
template <int NC>
__device__ __forceinline__ void select_token(const LAS float* srow, int t, int lane, unsigned tbit, LAS unsigned* maskw) {
    if (t < 256) {
#pragma unroll
        for (int c = 0; c < (NC < 4 ? NC : 4); ++c) if (64 * c + lane <= t) (void)__hip_atomic_fetch_or(maskw + 64 * c + lane, tbit, __ATOMIC_RELAXED, __HIP_MEMORY_SCOPE_WORKGROUP);
        return;
    }
    float x[NC];
#pragma unroll
    for (int c = 0; c < NC; ++c) x[c] = srow[64 * c + lane];
#pragma unroll
    for (int c = 4; c < NC; ++c) if (64 * c + 63 > t) x[c] = (64 * c + lane <= t) ? x[c] : -INFINITY;
    float mn = fminf(fminf(x[0], x[1]), fminf(x[2], x[3])), mx = -INFINITY;
#pragma unroll
    for (int c = 0; c < NC; ++c) mx = fmaxf(mx, x[c]);
    mn = dpp_min_f(mn);
    float lo = mn - (fabsf(mn) * 1e-6f + 1e-30f), hi = dpp_max_f(mx);
    const float BIGF = 0x1p100f;
#define COUNT_GT(P, OUT) do { const float nb1_ = -(P) * BIGF; const f32x2 nb_ = {nb1_, nb1_}, bg_ = {BIGF, BIGF}; f32x2 a0_ = {0.f, 0.f}, a1_ = {0.f, 0.f}, a2_ = {0.f, 0.f}, a3_ = {0.f, 0.f}; \
        _Pragma("unroll") for (int c = 0; c < NC; c += 8) { f32x2 y_[4]; \
            _Pragma("unroll") for (int e = 0; e < 4; ++e) { const f32x2 xx_ = {x[c + 2 * e], x[c + 2 * e + 1]}; asm("v_pk_fma_f32 %0, %1, %2, %3 clamp" : "=v"(y_[e]) : "v"(xx_), "v"(bg_), "v"(nb_)); } \
            a0_ += y_[0]; a1_ += y_[1]; a2_ += y_[2]; a3_ += y_[3]; } \
        const f32x2 s2_ = (a0_ + a1_) + (a2_ + a3_); OUT = (int)(dpp_sum_f(s2_[0] + s2_[1]) + 0.5f); } while (0)
    float tau = hi; int need = 256; bool exact = false;
#ifndef PROBE_SEL
#define PROBE_SEL 0
#endif
    {
        float glo = (float)(t + 1) - 255.5f, ghi = -255.5f; int side = 0;
        for (int it = 0; it < 200; ++it) {
            float p = lo + (hi - lo) * (glo * __builtin_amdgcn_rcpf(glo - ghi));
            if (it >= 48 || !(p > lo) || !(p < hi)) p = lo + (hi - lo) * 0.5f;
            if (!(p > lo) || !(p < hi)) break;
            int cm; COUNT_GT(p, cm);
            if (cm == 256) { tau = p; exact = true; break; }
            if (cm > 256) { lo = p; glo = (float)cm - 255.5f; if (side < 0) ghi *= 0.5f; side = -1; }
            else { hi = p; ghi = (float)cm - 255.5f; if (side > 0) glo *= 0.5f; side = 1; }
        }
        if (!exact) { tau = hi; int g; COUNT_GT(hi, g); need = 256 - g; }
    }
#undef COUNT_GT
    if (exact) {
#pragma unroll
        for (int c = 0; c < NC; ++c) (void)__hip_atomic_fetch_or(maskw + 64 * c + lane, (x[c] > tau) ? tbit : 0u, __ATOMIC_RELAXED, __HIP_MEMORY_SCOPE_WORKGROUP);
    } else {
        int base = 0;
#pragma unroll
        for (int c = 0; c < NC; ++c) {
            const bool gt = x[c] > tau, eq = x[c] == tau;
            const unsigned long long tb = __ballot(eq);
            const int rank = base + (int)__builtin_amdgcn_mbcnt_hi((unsigned)(tb >> 32), __builtin_amdgcn_mbcnt_lo((unsigned)tb, 0u));
            base += __popcll(tb);
            if (gt || (eq && rank < need)) (void)__hip_atomic_fetch_or(maskw + 64 * c + lane, tbit, __ATOMIC_RELAXED, __HIP_MEMORY_SCOPE_WORKGROUP);
        }
    }
}
struct XItem { const float* src; unsigned char* dst; int N; };
__device__ __forceinline__ XItem x_decode(int id, int lane, const float* wg, const float* wu, const float* wd, unsigned char* Wgu8, unsigned char* Wd8) {
    const int m = id >> 13, r = id & 8191, e = r >> 8, q = r & 255; XItem t;
    if (m < 2) { const int kb = q >> 3, nb = q & 7, n = nb * 64 + lane;
        t.src = (m == 0 ? wg : wu) + (size_t)e * 1024 * 512 + (size_t)(kb * 32) * 512 + n; t.N = 512;
        t.dst = Wgu8 + (size_t)(e * 1024 + (n >> 7) * 256 + m * 128 + (n & 127)) * 1024 + kb * 32; }
    else { const int kb = q >> 4, nb = q & 15, n = nb * 64 + lane;
        t.src = wd + (size_t)e * 512 * 1024 + (size_t)(kb * 32) * 1024 + n; t.N = 1024;
        t.dst = Wd8 + (size_t)(e * 1024 + n) * 512 + kb * 32; }
    return t;
}
__device__ __forceinline__ void x_load(const XItem& t, float (&rg)[32]) {
#pragma unroll
    for (int i = 0; i < 32; ++i) rg[i] = t.src[(size_t)i * t.N];
}
__device__ __forceinline__ void x_store(const XItem& t, float (&rg)[32]) {
#pragma unroll
    for (int i = 0; i < 32; ++i) asm volatile("" : "+v"(rg[i]));
    u32x4 o0, o1;
#pragma unroll
    for (int q = 0; q < 4; ++q) { int w0 = 0, w1 = 0;
        w0 = __builtin_amdgcn_cvt_pk_fp8_f32(32.f * rg[4 * q], 32.f * rg[4 * q + 1], w0, false); w0 = __builtin_amdgcn_cvt_pk_fp8_f32(32.f * rg[4 * q + 2], 32.f * rg[4 * q + 3], w0, true);
        w1 = __builtin_amdgcn_cvt_pk_fp8_f32(32.f * rg[16 + 4 * q], 32.f * rg[16 + 4 * q + 1], w1, false); w1 = __builtin_amdgcn_cvt_pk_fp8_f32(32.f * rg[16 + 4 * q + 2], 32.f * rg[16 + 4 * q + 3], w1, true);
        o0[q] = (unsigned)w0; o1[q] = (unsigned)w1; }
    *(u32x4*)t.dst = o0; *(u32x4*)(t.dst + 16) = o1;
}
__device__ __forceinline__ void score_select_unit(Frame& F, int b, int qt16, const bf16_t* qi, const bf16_t* ki, const float* wi, LAS float* scl, LAS unsigned* maskw, unsigned* masks, int xid0, int xid1) {
    const int lane = F.lane, wid = F.wave, r = lane & 31, h = lane >> 5;
    const int T0 = qt16 * 16; const size_t rowb = (size_t)b * SEQ;
    XItem xa, xb; float xr0[32], xr1[32];
    { const KArgs ka = kargs(); unsigned char* w8a = F.ws + WS_WGU; unsigned char* w8b = F.ws + WS_WD;
      xa = x_decode(xid0 >= 0 ? xid0 : 0, lane, ka->in[13], ka->in[14], ka->in[15], w8a, w8b); xb = x_decode(xid1 >= 0 ? xid1 : 0, lane, ka->in[13], ka->in[14], ka->in[15], w8a, w8b); }
    {
        LAS float* wtab = (LAS float*)(F.lds + TAB_OFF + 8192);
        if (F.tid < 128) wtab[F.tid] = wi[(rowb + T0) * 8 + F.tid] * WSCALE;
        bf16x8 a[4][4];
        const int tk = (r >> 4) + 2 * ((r >> 2) & 1), hd = (r & 3) + 4 * ((r >> 3) & 1);
        const int nsteps = ((T0 + 15) >> 8) + 1, kb0 = 32 * wid;
        const bf16_t* kp0 = ki + (rowb >> 5) * 2048 + (kb0 >> 5) * 2048 + r * 16 + h * 8;
        bf16x8 bfA[4], bfB[4];
#pragma unroll
        for (int kk = 0; kk < 4; ++kk) bfA[kk] = *(const bf16x8*)(kp0 + 512 * kk);
#pragma unroll
        for (int rb = 0; rb < 4; ++rb) {
            const bf16_t* qp = qi + (rowb + T0 + 4 * rb + tk) * 512 + hd * 64 + 8 * h;
#pragma unroll
            for (int kk = 0; kk < 4; ++kk) a[rb][kk] = *(const bf16x8*)(qp + 16 * kk);
        }
        LDS_WAIT(); __syncthreads();
        const LAS float* wl = wtab + 16 * h;
#define SCORE_STEP(KS, BF) do { const int kb_ = 256 * (KS) + kb0; if (kb_ <= T0 + 15) { \
            _Pragma("unroll") for (int rb = 0; rb < 4; ++rb) { \
                f32x16 acc = f32x16{}; \
                _Pragma("unroll") for (int kk = 0; kk < 4; ++kk) acc = __builtin_amdgcn_mfma_f32_32x32x16_bf16(a[rb][kk], BF[kk], acc, 0, 0, 0); \
                const f32x4 w0_ = *(const LAS f32x4*)(wl + 32 * rb), w1_ = *(const LAS f32x4*)(wl + 32 * rb + 4), w2_ = *(const LAS f32x4*)(wl + 32 * rb + 8), w3_ = *(const LAS f32x4*)(wl + 32 * rb + 12); \
                float s0 = 0.f, s1 = 0.f; \
                _Pragma("unroll") for (int reg = 0; reg < 4; ++reg) {     \
                    const float y0_ = __int_as_float(max(__float_as_int(acc[reg]), 0)), y1_ = __int_as_float(max(__float_as_int(acc[reg + 4]), 0)); \
                    const float y2_ = __int_as_float(max(__float_as_int(acc[reg + 8]), 0)), y3_ = __int_as_float(max(__float_as_int(acc[reg + 12]), 0)); \
                    s0 += w0_[reg] * y0_; s0 += w1_[reg] * y1_; s1 += w2_[reg] * y2_; s1 += w3_[reg] * y3_; } \
                LAS float* sp = scl + (4 * rb + 2 * h) * 2048 + kb_ + r; \
                sp[0] = s0; sp[2048] = s1; } } } while (0)
        for (int ks = 0; ks < nsteps; ks += 2) {
            { const int kn = (ks + 1 < 8) ? ks + 1 : 7;
#pragma unroll
              for (int kk = 0; kk < 4; ++kk) bfB[kk] = *(const bf16x8*)(kp0 + (size_t)kn * 16384 + 512 * kk); }
            SCORE_STEP(ks, bfA);
            { const int kn = (ks + 2 < 8) ? ks + 2 : 7;
#pragma unroll
              for (int kk = 0; kk < 4; ++kk) bfA[kk] = *(const bf16x8*)(kp0 + (size_t)kn * 16384 + 512 * kk); }
            if (ks + 1 < nsteps) SCORE_STEP(ks + 1, bfB);
        }
#undef SCORE_STEP
    }
    LDS_WAIT(); __syncthreads();
    if (xid0 >= 0) x_load(xa, xr0);
    if (xid1 >= 0) x_load(xb, xr1);
#ifndef PROBE_P2
#define PROBE_P2 0
#endif
#pragma unroll 1
    for (int jx = 0; jx < (PROBE_P2 == 2 ? 4 : 2); ++jx) { const int j = jx & 1;
        const int tl = wid * 2 + j, t = T0 + tl, nch = (t >> 6) + 1;
        const unsigned tbit = 1u << tl; const LAS float* srow = scl + tl * 2048;
        if (nch <= 8) select_token<8>(srow, t, lane, tbit, maskw);
        else if (nch <= 16) select_token<16>(srow, t, lane, tbit, maskw);
        else if (nch <= 24) select_token<24>(srow, t, lane, tbit, maskw);
        else select_token<32>(srow, t, lane, tbit, maskw);
    }
    if (xid0 >= 0) x_store(xa, xr0);
    if (xid1 >= 0) x_store(xb, xr1);
    LDS_WAIT(); __syncthreads();
    {
        const int ktmax = (T0 + 15) >> 6; unsigned short* mbase = (unsigned short*)(masks + ((size_t)(b * (SEQ / 32) + (qt16 >> 1)) * (SEQ / 64)) * 64) + (qt16 & 1);
#pragma unroll
        for (int jj = 0; jj < 4; ++jj) { const int key = F.tid + 512 * jj, kt = key >> 6, kap = key & 63;
            const unsigned wv = maskw[key]; maskw[key] = 0u;
            if (kt <= ktmax) { const int half = kap >> 5, k5 = kap & 31, hi_ = (k5 >> 2) & 1, rr = (k5 & 3) + 4 * (k5 >> 3); mbase[2 * (kt * 64 + 32 * half + 2 * rr + hi_)] = (unsigned short)wv; } }
    }
    LDS_WAIT(); __syncthreads();
}
__device__ __forceinline__ void conv_pass(Frame& F, const bf16_t* u, const bf16_t* cb, const float* cw, bf16_t* conv) {
    const int gt = F.vcu * 512 + F.tid, NGT = F.G * 512;
    for (int idx = gt; idx < NTOK * 64; idx += NGT) {
        const int tok = idx >> 6, cg = (idx & 63) * 8, pos = tok & (SEQ - 1);
        const u32x4 z = (u32x4){0u, 0u, 0u, 0u};
        const u32x4 u0 = *(const u32x4*)(u + (size_t)tok * 512 + cg);
        const u32x4 u1 = pos >= 1 ? *(const u32x4*)(u + (size_t)(tok - 1) * 512 + cg) : z;
        const u32x4 u2 = pos >= 2 ? *(const u32x4*)(u + (size_t)(tok - 2) * 512 + cg) : z;
        const u32x4 bv = *(const u32x4*)(cb + (size_t)tok * 512 + cg);
        const f32x4 w0a = *(const f32x4*)(cw + cg), w0b = *(const f32x4*)(cw + cg + 4);
        const f32x4 w1a = *(const f32x4*)(cw + 512 + cg), w1b = *(const f32x4*)(cw + 512 + cg + 4);
        const f32x4 w2a = *(const f32x4*)(cw + 1024 + cg), w2b = *(const f32x4*)(cw + 1024 + cg + 4);
        f32x4 ya, yb;
#define CV(E, WA, I, WORD, HALF) (WA[I] * (HALF ? bfhi(E.WORD) : bflo(E.WORD)))
        ya[0] = bflo(bv.x) * (CV(u2, w0a, 0, x, 0) + CV(u1, w1a, 0, x, 0) + CV(u0, w2a, 0, x, 0));
        ya[1] = bfhi(bv.x) * (CV(u2, w0a, 1, x, 1) + CV(u1, w1a, 1, x, 1) + CV(u0, w2a, 1, x, 1));
        ya[2] = bflo(bv.y) * (CV(u2, w0a, 2, y, 0) + CV(u1, w1a, 2, y, 0) + CV(u0, w2a, 2, y, 0));
        ya[3] = bfhi(bv.y) * (CV(u2, w0a, 3, y, 1) + CV(u1, w1a, 3, y, 1) + CV(u0, w2a, 3, y, 1));
        yb[0] = bflo(bv.z) * (CV(u2, w0b, 0, z, 0) + CV(u1, w1b, 0, z, 0) + CV(u0, w2b, 0, z, 0));
        yb[1] = bfhi(bv.z) * (CV(u2, w0b, 1, z, 1) + CV(u1, w1b, 1, z, 1) + CV(u0, w2b, 1, z, 1));
        yb[2] = bflo(bv.w) * (CV(u2, w0b, 2, w, 0) + CV(u1, w1b, 2, w, 0) + CV(u0, w2b, 2, w, 0));
        yb[3] = bfhi(bv.w) * (CV(u2, w0b, 3, w, 1) + CV(u1, w1b, 3, w, 1) + CV(u0, w2b, 3, w, 1));
#undef CV
        store8bf(conv + (size_t)tok * 1024 + cg, ya, yb);
    }
}

constexpr int P7_HS = 1028;
constexpr int P7_H = 0, P7_P = 16 * P7_HS * 4, P7_L = P7_P + 8 * 16 * 48 * 4, P7_R = P7_L + 16 * 48 * 4, P7_END = P7_R + 6 * 128 * 4 + 2 * 32 * 4;
static_assert(P7_END <= RING_BYTES && (P7_P % 16) == 0, "P7 LDS map");
__device__ __forceinline__ void ln1_router(Frame& F, bool dry) {
    const KArgs a = kargs();
    unsigned char* ws = F.ws;
    float* pre = (float*)(ws + WS_PRE); bf16_t* h1b = dry ? (bf16_t*)(ws + WS_GATES) : (bf16_t*)(ws + WS_PRE);
    int* lists = (int*)(ws + (dry ? WS_MERGED : WS_LIST)); unsigned* tokinfo = (unsigned*)(ws + (dry ? WS_MERGED + 8 * MiB : WS_TOKINFO)); const int cbank = dry ? 64 * NEXP : 0;
    unsigned char* h1q = ws + (dry ? WS_MERGED + 16 * MiB : WS_H1Q);
    const float *g1 = a->in[7], *b1 = a->in[8], *rgb = a->in[10], *reb = a->in[12]; const float* wc = (const float*)(ws + WS_WC);
    const int lane = F.lane, wid = F.wave, tid = F.tid;
    LAS float* H = (LAS float*)(F.lds + P7_H); LAS float* P = (LAS float*)(F.lds + P7_P); LAS float* L = (LAS float*)(F.lds + P7_L);
    LAS int* RE = (LAS int*)(F.lds + P7_R);
    LAS int* hist = RE + 768; LAS int* basev = RE + 800;
    if (tid < 64) hist[tid] = 0;
    f32x4 gv[4], bv[4];
#pragma unroll
    for (int j = 0; j < 4; ++j) { gv[j] = *(const f32x4*)(g1 + 4 * lane + 256 * j); bv[j] = *(const f32x4*)(b1 + 4 * lane + 256 * j); }
    float breg[3][32];
    { const int kq = lane >> 4, jn = lane & 15; const float* wp = wc + (size_t)(128 * wid + 32 * kq) * 48 + jn;
#pragma unroll
      for (int cb = 0; cb < 3; ++cb)
#pragma unroll
          for (int sidx = 0; sidx < 32; ++sidx) breg[cb][sidx] = wp[sidx * 48 + 16 * cb]; }
    const int ngrp_total = NTOK / 16;
#pragma unroll 1
    for (int gi = F.vcu * 8; gi < ngrp_total; gi += F.G * 8) {
      f32x4 vn[2][4];
#pragma unroll
      for (int rr = 0; rr < 2; ++rr)
#pragma unroll
          for (int j = 0; j < 4; ++j) vn[rr][j] = *(const f32x4*)(pre + (size_t)(gi * 16 + 2 * wid + rr) * DM + 4 * lane + 256 * j);
#pragma unroll 1
      for (int gg = 0; gg < 8; ++gg) {
        const int row0 = (gi + gg) * 16;
#pragma unroll
        for (int rr = 0; rr < 2; ++rr) { const int rl = 2 * wid + rr, row = row0 + rl;
            f32x4 v[4]; float sm = 0.f;
#pragma unroll
            for (int j = 0; j < 4; ++j) { v[j] = vn[rr][j]; sm += (v[j][0] + v[j][1]) + (v[j][2] + v[j][3]); }
            const float mean = wave_sum(sm) * (1.f / DM); float s2 = 0.f;
#pragma unroll
            for (int j = 0; j < 4; ++j) { v[j] = v[j] - mean; s2 += (v[j][0] * v[j][0] + v[j][1] * v[j][1]) + (v[j][2] * v[j][2] + v[j][3] * v[j][3]); }
            const float rstd = 1.f / sqrtf(wave_sum(s2) * (1.f / DM) + LN_EPS);
#pragma unroll
            for (int j = 0; j < 4; ++j) { v[j] = v[j] * rstd * gv[j] + bv[j];
                u32x2 o; o.x = pkbf(v[j][0], v[j][1]); o.y = pkbf(v[j][2], v[j][3]); *(u32x2*)(h1b + (size_t)row * 2048 + 4 * lane + 256 * j) = o;
                { int wv = 0; wv = __builtin_amdgcn_cvt_pk_fp8_f32(v[j][0], v[j][1], wv, false); wv = __builtin_amdgcn_cvt_pk_fp8_f32(v[j][2], v[j][3], wv, true);
                  *(int*)(h1q + (size_t)row * 1024 + 4 * lane + 256 * j) = wv; }
                *(LAS f32x4*)(H + rl * P7_HS + 4 * lane + 256 * j) = v[j]; } }
        { const int gnx = gg < 7 ? gg + 1 : gg;
#pragma unroll
          for (int rr = 0; rr < 2; ++rr)
#pragma unroll
              for (int j = 0; j < 4; ++j) vn[rr][j] = *(const f32x4*)(pre + (size_t)((gi + gnx) * 16 + 2 * wid + rr) * DM + 4 * lane + 256 * j); }
        LDS_WAIT(); __syncthreads();
        { f32x4 acc[3]; acc[0] = (f32x4){0.f, 0.f, 0.f, 0.f}; acc[1] = acc[0]; acc[2] = acc[0];
          const LAS float* hp = H + (lane & 15) * P7_HS + 128 * wid + 32 * (lane >> 4);
#pragma unroll
          for (int s4 = 0; s4 < 8; ++s4) { const f32x4 av = *(const LAS f32x4*)(hp + 4 * s4);
#pragma unroll
              for (int e = 0; e < 4; ++e)
#pragma unroll
                  for (int cb = 0; cb < 3; ++cb) acc[cb] = __builtin_amdgcn_mfma_f32_16x16x4f32(av[e], breg[cb][4 * s4 + e], acc[cb], 0, 0, 0); }
          LAS float* pp = P + (wid * 16 + 4 * (lane >> 4)) * 48 + (lane & 15);
#pragma unroll
          for (int cb = 0; cb < 3; ++cb)
#pragma unroll
              for (int rg = 0; rg < 4; ++rg) pp[rg * 48 + 16 * cb] = acc[cb][rg]; }
        LDS_WAIT(); __syncthreads();
        for (int idx = tid; idx < 16 * 48; idx += 512) { float sum = 0.f;
#pragma unroll
            for (int w = 0; w < 8; ++w) sum += P[w * 768 + idx];
            L[idx] = sum; }
        LDS_WAIT(); __syncthreads();
        if (tid < 16) { const LAS float* lr = L + tid * 48;
            float gl[4]; int grp = 0;
#pragma unroll
            for (int i = 0; i < 4; ++i) gl[i] = lr[i] + rgb[i];
            float gm = gl[0];
#pragma unroll
            for (int i = 1; i < 4; ++i) if (gl[i] > gm) { gm = gl[i]; grp = i; }
            float den = 0.f;
#pragma unroll
            for (int i = 0; i < 4; ++i) den += __expf(gl[i] - gm);
            const float pgrp = 1.f / den;
            float el[8];
#pragma unroll
            for (int i = 0; i < 8; ++i) el[i] = lr[4 + 8 * grp + i] + reb[grp * 8 + i];
            int i1 = 0; float v1 = el[0];
#pragma unroll
            for (int i = 1; i < 8; ++i) if (el[i] > v1) { v1 = el[i]; i1 = i; }
            int i2 = -1; float v2 = -INFINITY;
#pragma unroll
            for (int i = 0; i < 8; ++i) if (i != i1 && el[i] > v2) { v2 = el[i]; i2 = i; }
            const float ex = __expf(v2 - v1), w1 = pgrp / (1.f + ex), w2 = pgrp * ex / (1.f + ex);
            const int e1 = grp * 8 + i1, e2 = grp * 8 + i2, ti = gg * 16 + tid;
            RE[ti] = e1; RE[128 + ti] = e2; RE[256 + ti] = (int)__float_as_uint(w1); RE[384 + ti] = (int)__float_as_uint(w2);
            RE[512 + ti] = __hip_atomic_fetch_add(hist + e1, 1, __ATOMIC_RELAXED, __HIP_MEMORY_SCOPE_WORKGROUP);
            RE[640 + ti] = __hip_atomic_fetch_add(hist + e2, 1, __ATOMIC_RELAXED, __HIP_MEMORY_SCOPE_WORKGROUP);
        }
      }
      LDS_WAIT(); __syncthreads();
      if (tid < NEXP) { const int hc = hist[tid]; basev[tid] = hc ? (int)__hip_atomic_fetch_add(F.ctl + CW_CNT + cbank + 64 * tid, (unsigned)hc, __ATOMIC_RELAXED, __HIP_MEMORY_SCOPE_AGENT) : 0; }
      LDS_WAIT(); __syncthreads();
      if (tid < 128) { const int row = gi * 16 + tid; const int e1 = RE[tid], e2 = RE[128 + tid];
          const unsigned r1 = (unsigned)(basev[e1] + RE[512 + tid]), r2 = (unsigned)(basev[e2] + RE[640 + tid]);
          if (r1 < (unsigned)LISTCAP) lists[(size_t)e1 * LISTCAP + r1] = row;
          if (r2 < (unsigned)LISTCAP) lists[(size_t)e2 * LISTCAP + r2] = row;
          unsigned* ti = tokinfo + (size_t)row * 8;
          *(u32x4*)ti = (u32x4){(unsigned)e1, r1, (unsigned)RE[256 + tid], (unsigned)e2}; *(u32x2*)(ti + 4) = (u32x2){r2, (unsigned)RE[384 + tid]}; }
      LDS_WAIT(); __syncthreads();
      if (tid < 64) hist[tid] = 0;
      LDS_WAIT(); __syncthreads();
    }
}
__device__ __forceinline__ void moe_tables(Frame& F) {
    LAS int* tab = (LAS int*)(F.lds + TAB_OFF);
    __syncthreads();
    if (F.tid < NEXP) { int c = (int)__hip_atomic_load(F.ctl + CW_CNT + 64 * F.tid, __ATOMIC_RELAXED, __HIP_MEMORY_SCOPE_AGENT); if (c > LISTCAP) c = LISTCAP; tab[T_CNT + F.tid] = c; }
    __syncthreads();
    if (F.tid == 0) { int acc = 0; for (int e = 0; e < NEXP; ++e) { tab[T_BLK0 + e] = acc; acc += (tab[T_CNT + e] + 255) >> 8; } tab[T_BLK0 + NEXP] = acc; tab[T_NB] = acc; }
    __syncthreads();
    if (F.tid < NEXP) { const int b0 = tab[T_BLK0 + F.tid], b1 = tab[T_BLK0 + F.tid + 1]; for (int bb = b0; bb < b1; ++bb) tab[T_BLKE + bb] = F.tid; }
    __syncthreads();
}

__device__ __forceinline__ void combine_ln2(Frame& F) {
    const KArgs a = kargs();
    unsigned char* ws = F.ws;
    const bf16_t* h1 = (const bf16_t*)(ws + WS_PRE); const unsigned char* ys = ws + WS_YS;     const unsigned* tokinfo = (const unsigned*)(ws + WS_TOKINFO);
    const LAS int* tab = (const LAS int*)(F.lds + TAB_OFF);
    const float *g2 = a->in[16], *b2 = a->in[17]; float* outp = a->out;
    const int lane = F.lane, gw = F.vcu * NWAVES + F.wave, NGW = F.G * NWAVES;
    f32x4 gv[4], bv[4];
#pragma unroll
    for (int j = 0; j < 4; ++j) { gv[j] = *(const f32x4*)(g2 + 4 * lane + 256 * j); bv[j] = *(const f32x4*)(b2 + 4 * lane + 256 * j); }
    const int nrw = (NTOK - gw + NGW - 1) / NGW;
    if (nrw > 0) {
#define ROWK(k) (gw + ((k) < nrw ? (k) : nrw - 1) * NGW)
#define TI_LOAD(k, A, B) do { const unsigned* ti_ = tokinfo + (size_t)ROWK(k) * 8; A = *(const u32x4*)ti_; B = *(const u32x2*)(ti_ + 4); } while (0)
#define DATA_LOAD(k, A, B, HW, YA, YB) do { const int e1_ = (int)A.x, e2_ = (int)A.w; \
        const size_t s1_ = (size_t)tab[T_BLK0 + e1_] * 256 + A.y, s2_ = (size_t)tab[T_BLK0 + e2_] * 256 + B.x; \
        const bf16_t* hr_ = h1 + (size_t)ROWK(k) * 2048 + 4 * lane; const unsigned char* y1_ = ys + s1_ * DM + 4 * lane; const unsigned char* y2_ = ys + s2_ * DM + 4 * lane; \
        _Pragma("unroll") for (int j = 0; j < 4; ++j) { HW[j] = *(const u32x2*)(hr_ + 256 * j); YA[j] = *(const unsigned*)(y1_ + 256 * j); YB[j] = *(const unsigned*)(y2_ + 256 * j); } } while (0)
        u32x4 tc0, tn0, tq0; u32x2 tc1, tn1, tq1;
        u32x2 hw[4], hwn[4]; unsigned ya[4], yb[4], yan[4], ybn[4];
        TI_LOAD(0, tc0, tc1); TI_LOAD(1, tn0, tn1);
        DATA_LOAD(0, tc0, tc1, hw, ya, yb);
        for (int k = 0; k < nrw; ++k) {
            TI_LOAD(k + 2, tq0, tq1);
            DATA_LOAD(k + 1, tn0, tn1, hwn, yan, ybn);
            const float w1 = __uint_as_float(tc0.z), w2 = __uint_as_float(tc1.y);
            f32x4 v[4]; float sm = 0.f;
#pragma unroll
            for (int j = 0; j < 4; ++j) {
                v[j][0] = ALPHA * bflo(hw[j].x) + w1 * __builtin_amdgcn_cvt_f32_fp8((int)ya[j], 0) + w2 * __builtin_amdgcn_cvt_f32_fp8((int)yb[j], 0);
                v[j][1] = ALPHA * bfhi(hw[j].x) + w1 * __builtin_amdgcn_cvt_f32_fp8((int)ya[j], 1) + w2 * __builtin_amdgcn_cvt_f32_fp8((int)yb[j], 1);
                v[j][2] = ALPHA * bflo(hw[j].y) + w1 * __builtin_amdgcn_cvt_f32_fp8((int)ya[j], 2) + w2 * __builtin_amdgcn_cvt_f32_fp8((int)yb[j], 2);
                v[j][3] = ALPHA * bfhi(hw[j].y) + w1 * __builtin_amdgcn_cvt_f32_fp8((int)ya[j], 3) + w2 * __builtin_amdgcn_cvt_f32_fp8((int)yb[j], 3);
                sm += (v[j][0] + v[j][1]) + (v[j][2] + v[j][3]); }
            const float mean = wave_sum(sm) * (1.f / DM); float s2v = 0.f;
#pragma unroll
            for (int j = 0; j < 4; ++j) { v[j] = v[j] - mean; s2v += (v[j][0] * v[j][0] + v[j][1] * v[j][1]) + (v[j][2] * v[j][2] + v[j][3] * v[j][3]); }
            const float rstd = 1.f / sqrtf(wave_sum(s2v) * (1.f / DM) + LN_EPS);
            float* orow = outp + (size_t)(gw + k * NGW) * DM + 4 * lane;
#pragma unroll
            for (int j = 0; j < 4; ++j) *(f32x4*)(orow + 256 * j) = v[j] * rstd * gv[j] + bv[j];
            tc0 = tn0; tc1 = tn1; tn0 = tq0; tn1 = tq1;
#pragma unroll
            for (int j = 0; j < 4; ++j) { hw[j] = hwn[j]; ya[j] = yan[j]; yb[j] = ybn[j]; }
        }
#undef ROWK
#undef TI_LOAD
#undef DATA_LOAD
    }
}

#if DBG_NAIVE
constexpr size_t WS_NK = 296 * MiB, WS_NV = 312 * MiB, WS_NKI = 328 * MiB;
__device__ __forceinline__ float naive_proj(const float* xs  , const float* w_in, int col) {
    float s = 0.f; for (int d = 0; d < DM; ++d) s += xs[d] * w_in[(size_t)d * INW + col]; return s;
}
__device__ __forceinline__ void naive_kv(Frame& F) {
    const KArgs ka = kargs(); const float* xin = ka->in[0]; const float* win = ka->in[1];
    float* nk = (float*)(F.ws + WS_NK); float* nv = (float*)(F.ws + WS_NV); float* nki = (float*)(F.ws + WS_NKI);
    LAS float* xs = (LAS float*)F.lds; LAS float* pr = xs + 1024;
    for (int tok = F.vcu; tok < NTOK; tok += F.G) {
        __syncthreads();
        for (int i = F.tid; i < DM; i += 512) xs[i] = xin[(size_t)tok * DM + i];
        __syncthreads();
        if (F.tid < 320) { const int col = F.tid < 256 ? 512 + F.tid : 1280 + (F.tid - 256); float s = 0.f; for (int d = 0; d < DM; ++d) s += xs[d] * win[(size_t)d * INW + col]; pr[F.tid] = s; }
        __syncthreads();
        const int pos = tok & (SEQ - 1);
        if (F.tid < 24) {
            const int grp = F.tid >> 3, i = F.tid & 7, base = grp == 0 ? 0 : (grp == 1 ? 64 : 256);
            const float inv = (float)pow(500000.0, -(double)i / 8.0); const float ang = (float)pos * inv, c = cosf(ang), s = sinf(ang);
            const float x1 = pr[base + i], x2 = pr[base + 8 + i]; pr[base + i] = x1 * c - x2 * s; pr[base + 8 + i] = x2 * c + x1 * s;
        }
        __syncthreads();
        if (F.tid < 128) { nk[(size_t)tok * 128 + F.tid] = pr[F.tid]; nv[(size_t)tok * 128 + F.tid] = pr[128 + F.tid]; }
        if (F.tid < 64) nki[(size_t)tok * 64 + F.tid] = pr[256 + F.tid];
    }
}
__device__ __forceinline__ void naive_attn(Frame& F) {
    const KArgs ka = kargs(); const float* xin = ka->in[0]; const float* win = ka->in[1];
    const float* nk = (const float*)(F.ws + WS_NK); const float* nv = (const float*)(F.ws + WS_NV); const float* nki = (const float*)(F.ws + WS_NKI);
    bf16_t* attn = (bf16_t*)(F.ws + WS_AC) + 512;
    LAS float* xs = (LAS float*)F.lds;
    LAS float* qs = xs + 1024;
    LAS float* qis = qs + 512;
    LAS float* wis = qis + 512;
    LAS float* sc = wis + 16;
    LAS int* sel = (LAS int*)(sc + 2048);
    LAS int* nsel = sel + 256;
    LAS float* pl = (LAS float*)(nsel + 16);
    for (int tok = F.vcu; tok < NTOK; tok += F.G) {
        const int pos = tok & (SEQ - 1), b0 = tok - pos;
        __syncthreads();
        for (int i = F.tid; i < DM; i += 512) xs[i] = xin[(size_t)tok * DM + i];
        if (F.tid == 0) nsel[0] = 0;
        __syncthreads();
        for (int c = F.tid; c < 1032; c += 512) { const int col = c < 512 ? c : (c < 1024 ? 768 + (c - 512) : 1344 + (c - 1024));
            float s = 0.f; for (int d = 0; d < DM; ++d) s += xs[d] * win[(size_t)d * INW + col];
            if (c < 512) qs[c] = s; else if (c < 1024) qis[c - 512] = s; else wis[c - 1024] = s; }
        __syncthreads();
        if (F.tid < 128) { const int which = F.tid >> 6, hd = (F.tid >> 3) & 7, i = F.tid & 7; LAS float* p = (which ? qis : qs) + hd * 64;
            const float inv = (float)pow(500000.0, -(double)i / 8.0); const float ang = (float)pos * inv, c = cosf(ang), s = sinf(ang);
            const float x1 = p[i], x2 = p[8 + i]; p[i] = x1 * c - x2 * s; p[8 + i] = x2 * c + x1 * s; }
        __syncthreads();
#if DBG_NAIVE == 2
        { const bf16_t* qif = (const bf16_t*)(F.ws + WS_QI) + (size_t)tok * 512; for (int i = F.tid; i < 512; i += 512) qis[i] = __uint_as_float((unsigned)qif[i] << 16);
          if (F.tid < 8) wis[F.tid] = ((const float*)(F.ws + WS_WI))[(size_t)tok * 8 + F.tid]; }
        __syncthreads();
        for (int s = F.tid; s <= pos; s += 512) { const int tk_ = b0 + s; const bf16_t* kr = (const bf16_t*)(F.ws + WS_KI) + (size_t)(tk_ >> 5) * 2048 + (tk_ & 31) * 16; float tot = 0.f;
            for (int hd = 0; hd < 8; ++hd) { float d = 0.f; for (int e = 0; e < 64; ++e) d += qis[hd * 64 + e] * __uint_as_float((unsigned)kr[(e >> 4) * 512 + ((e >> 3) & 1) * 8 + (e & 7)] << 16); tot += fmaxf(d, 0.f) * (wis[hd] * WSCALE); }
            sc[s] = tot; }
#else
        for (int s = F.tid; s <= pos; s += 512) { const float* kr = nki + (size_t)(b0 + s) * 64; float tot = 0.f;
            for (int hd = 0; hd < 8; ++hd) { float d = 0.f; for (int e = 0; e < 64; ++e) d += qis[hd * 64 + e] * kr[e]; d *= 0.125f; tot += fmaxf(d, 0.f) * wis[hd]; }
            sc[s] = tot * 0.35355339059327373f; }
#endif
        __syncthreads();
        for (int s = F.tid; s <= pos; s += 512) { bool take = true;
            if (pos >= 256) { const float xv = sc[s]; int rank = 0; for (int s2 = 0; s2 <= pos; ++s2) { const float y = sc[s2]; rank += (y > xv || (y == xv && s2 < s)) ? 1 : 0; } take = rank < 256; }
            if (take) { const int p = atomicAdd((int*)nsel, 1); sel[p] = s; } }
        __syncthreads();
        const int ns = nsel[0]; const int hd = F.wave, lane = F.lane;
        float lg[4]; float mx = -INFINITY;
        for (int jj = 0; jj < 4; ++jj) { const int j = lane + 64 * jj; lg[jj] = -INFINITY;
            if (j < ns) { const float* kr = nk + (size_t)(b0 + sel[j]) * 128 + (hd >> 2) * 64; float d = 0.f; for (int e = 0; e < 64; ++e) d += qs[hd * 64 + e] * kr[e]; lg[jj] = d * 0.125f; mx = fmaxf(mx, lg[jj]); } }
        mx = wave_max(mx); float sum = 0.f;
        for (int jj = 0; jj < 4; ++jj) { const int j = lane + 64 * jj; const float p = (j < ns) ? expf(lg[jj] - mx) : 0.f; sum += p; pl[hd * 256 + j] = p; }
        sum = wave_sum(sum);
        LDS_WAIT(); asm volatile("" ::: "memory");
        float o = 0.f;
        for (int j = 0; j < ns; ++j) o += pl[hd * 256 + j] * nv[(size_t)(b0 + sel[j]) * 128 + (hd >> 2) * 64 + lane];
        o /= sum;
        bf16_t* ap = attn + (size_t)tok * 1024 + hd * 64 + lane;
        const float fast = __uint_as_float((unsigned)(*ap) << 16);
        const float blended = o + DBG_G * (fast - o);
        *ap = (bf16_t)(pkbf(blended, 0.f) & 0xffffu);
    }
}
#endif

__global__ void __launch_bounds__(NWAVES * 64, 2) mk_fwd(Args args_unused) {
    extern __shared__ __attribute__((aligned(16))) unsigned char lds[];
    Frame F;
    F.lds = (LAS unsigned char*)lds;
    F.MISC = (volatile LAS unsigned*)(F.lds + LDSCTL_OFF);
    F.tid = threadIdx.x; F.lane = F.tid & 63; F.wave = __builtin_amdgcn_readfirstlane(F.tid >> 6);
    F.G = gridDim.x; { const int bx = blockIdx.x; F.vcu = (F.G % 8 == 0) ? (bx % 8) * (F.G / 8) + bx / 8 : bx; }
    unsigned char* ws; int lo, hi;
    { const KArgs ka = kargs(); ws = ka->ws; lo = ka->ph_lo; hi = ka->ph_hi; }
    F.ws = ws; F.ctl = (unsigned*)(ws + WS_CTL);
    for (int u = F.tid; u < (LDS_BYTES - LDSCTL_OFF) / 4; u += NWAVES * 64) ((LAS unsigned*)(F.lds + LDSCTL_OFF))[u] = 0u;
    __syncthreads();
#if MK_SPLIT
#define GRID_BAR() do { } while (0)
#else
    XcdBarrier bar = xcd_barrier_post(F.ctl + CW_BAR, F.MISC + 8);
#define GRID_BAR() xcd_barrier(bar)
#endif
#ifndef PHASE_MASK
#define PHASE_MASK 0xFFFF
#endif
#define IN(k) ((((PHASE_MASK) >> (k)) & 1) && lo <= (k) && (k) < hi)
#define BOTH(k, k2) (IN(k) && IN(k2))

    bf16_t* xb = (bf16_t*)(ws + WS_XB);
    bf16_t *qb = (bf16_t*)(ws + WS_Q), *kbuf = (bf16_t*)(ws + WS_K), *vbuf = (bf16_t*)(ws + WS_V), *qib = (bf16_t*)(ws + WS_QI), *kib = (bf16_t*)(ws + WS_KI);
    float* wib = (float*)(ws + WS_WI);
    bf16_t *ub = (bf16_t*)(ws + WS_U), *cbb = (bf16_t*)(ws + WS_CB), *acb = (bf16_t*)(ws + WS_AC), *gab = (bf16_t*)(ws + WS_GA), *rtb = (bf16_t*)(ws + WS_RT);
    unsigned* masks = (unsigned*)(ws + WS_MASK);
    bf16_t *merged = (bf16_t*)(ws + WS_MERGED), *h1b = (bf16_t*)(ws + WS_PRE), *ysb_unused = nullptr; (void)ysb_unused;
    float* pre = (float*)(ws + WS_PRE);

    if (IN(0)) { p0_prologue(F); if (BOTH(0, 1)) GRID_BAR(); }
    if (IN(1)) {
        pg8::Gemm g{xb, (const bf16_t*)(ws + WS_WIN), NTOK, NPROJ, DM, 0}; pg8::StaticOrder S; S.init(NTOK, NPROJ, F.G, (int)blockIdx.x);
        EpiProj E{qb, kbuf, vbuf, qib, kib, ub, cbb, gab, rtb, wib, (const float*)(ws + WS_ROPE), kargs()->in[2]};
        pg8::gemm_phase<EpiProj, pg8::StaticOrder, true, false>(F.lds, g, S, E, nullptr);
        if (BOTH(1, 2)) GRID_BAR();
    }
    if (IN(2)) {
        LAS float* scl = (LAS float*)F.lds;
        LAS unsigned* maskw = (LAS unsigned*)(F.lds + TAB_OFF);
        for (int i = F.tid; i < 2048; i += 512) maskw[i] = 0u;
        __syncthreads();
        if (F.G == 256) {
            const int b = F.vcu >> 4, j = F.vcu & 15;
#pragma unroll 1
            for (int i = 0; i < 8; ++i) { const int qt = 32 * (i >> 1) + ((i & 1) ? 31 - j : j);
                const int gwv = F.vcu * NWAVES + F.wave, jx0 = i < 4 ? 2 * i : 4 + i;
                score_select_unit(F, b, qt, qib, kib, wib, scl, maskw, masks, gwv + 2048 * jx0, i < 4 ? gwv + 2048 * (jx0 + 1) : -1); }
        } else {
#pragma unroll 1
            for (int un = F.vcu; un < NBATCH * 128; un += F.G) score_select_unit(F, un >> 7, un & 127, qib, kib, wib, scl, maskw, masks, -1, -1);
        }
        conv_pass(F, ub, cbb, kargs()->in[5], acb);
        if (PROBE_P2 == 3) conv_pass(F, ub, cbb, kargs()->in[5], acb);
        if (BOTH(2, 3)) GRID_BAR();
    }
    if (IN(3)) {
        const int nun = NBATCH * 8 * 8;
        if (F.G == 256) {
            const int bh = F.vcu >> 1, s0 = 2 * (F.vcu & 1);
#pragma unroll 1
            for (int i = 0; i < 4; ++i) { const int qbk = (i == 0) ? s0 : (i == 1) ? 7 - s0 : (i == 2) ? s0 + 1 : 6 - s0;
                attn_body::attn_unit<8>(bh >> 3, bh & 7, qbk, (const attn_body::bf16*)qb, (const attn_body::bf16*)kbuf, (const attn_body::bf16*)vbuf, (attn_body::bf16*)acb, masks, (char*)lds); }
        } else {
#pragma unroll 1
            for (int un = F.vcu; un < nun; un += F.G) attn_body::attn_unit<8>(un >> 6, (un >> 3) & 7, un & 7, (const attn_body::bf16*)qb, (const attn_body::bf16*)kbuf, (const attn_body::bf16*)vbuf, (attn_body::bf16*)acb, masks, (char*)lds);
        }
        if (BOTH(3, 4)) GRID_BAR();
    }
#if DBG_NAIVE
    if (IN(4)) { naive_kv(F); }
    if (IN(11)) { naive_attn(F); }
#else
    if (IN(4)) { if (BOTH(4, 5)) { } }
#endif
    if (IN(5)) {
        pg8::Gemm g{acb, (const bf16_t*)(ws + WS_WAU), NTOK, DM, DM, 0}; pg8::StaticOrder S; S.init(NTOK, DM, F.G, (int)blockIdx.x);
        EpiMerged E{gab, rtb, merged};
        pg8::gemm_phase<EpiMerged, pg8::StaticOrder, true, false, true>(F.lds, g, S, E, nullptr);
        if (BOTH(5, 6)) GRID_BAR();
    }
    if (IN(6)) {
        pg8::Gemm g{merged, (const bf16_t*)(ws + WS_WOUT), NTOK, DM, DM, 0}; pg8::StaticOrder S; S.init(NTOK, DM, F.G, (int)blockIdx.x);
        EpiOut E{kargs()->in[0], pre};
        pg8::gemm_phase<EpiOut, pg8::StaticOrder, true, false>(F.lds, g, S, E, nullptr);
        if (BOTH(6, 7)) GRID_BAR();
    }
    if (IN(7)) { ln1_router(F, (kargs()->flags & 1) != 0); if (BOTH(7, 8)) GRID_BAR(); }
    if (IN(8)) {
        moe_tables(F);
        LAS int* tab = (LAS int*)(F.lds + TAB_OFF);
        const int nunits = tab[T_NB] * 4; const int* lists = (const int*)(ws + WS_LIST);
        for (int i = 0; i < T_ROWS_UNITS; ++i) { const int L = i * F.G + F.vcu; if (L >= nunits) break;
            const int rbg = L >> 2, e = tab[T_BLKE + rbg], slot0 = (rbg - tab[T_BLK0 + e]) * 256, cnt = tab[T_CNT + e];
            if (F.tid < 256) { const int sl = slot0 + F.tid; tab[T_ROWS + i * 256 + F.tid] = sl < cnt ? lists[(size_t)e * LISTCAP + sl] : 0; } }
        __syncthreads();
        pg8::Gemm g{(const bf16_t*)(ws + WS_H1Q), (const bf16_t*)(ws + WS_WGU), CAPROWS, NEXP * 1024, 512, 0}; pg8::MoeOrder S{tab + T_BLKE, nunits, F.G, F.vcu};
        EpiSwiGLU E{ws + WS_HID};
        pg8::gemm_phase<EpiSwiGLU, pg8::MoeOrder, true, true, false, true>(F.lds, g, S, E, tab + T_ROWS);
        if (BOTH(8, 9)) GRID_BAR();
    }
    if (IN(9)) {
        moe_tables(F);
        LAS int* tab = (LAS int*)(F.lds + TAB_OFF);
        const int nunits = tab[T_NB] * 4;
        pg8::Gemm g{(const bf16_t*)(ws + WS_HID), (const bf16_t*)(ws + WS_WD), CAPROWS, NEXP * 1024, 256, 0}; pg8::MoeOrder S{tab + T_BLKE, nunits, F.G, F.vcu};
        EpiYs E{ws + WS_YS};
        pg8::gemm_phase<EpiYs, pg8::MoeOrder, true, false, false, true>(F.lds, g, S, E, nullptr);
        if (BOTH(9, 10)) GRID_BAR();
    }
    if (IN(10)) { moe_tables(F); combine_ln2(F); }
#undef IN
#undef BOTH
}

extern "C" void kernel_launch(void* const* d_in, const int* in_sizes, int n_in, void* d_out, int out_size, void* d_ws, size_t ws_size, hipStream_t stream) {
    static int grid = 0;
    if (grid == 0) {
        if (n_in != 18 || in_sizes[0] != NTOK * DM || out_size != NTOK * DM || ws_size < WS_END) { fprintf(stderr, "kernel_launch: unexpected shapes (n_in %d, ws %zu)\n", n_in, ws_size); grid = -1; return; }
        int dev = 0, cus = 0, per_cu = 0;
        if (hipGetDevice(&dev) != hipSuccess || hipDeviceGetAttribute(&cus, hipDeviceAttributeMultiprocessorCount, dev) != hipSuccess) { grid = -1; return; }
        if (hipFuncSetAttribute((const void*)mk_fwd, hipFuncAttributeMaxDynamicSharedMemorySize, LDS_BYTES) != hipSuccess) { fprintf(stderr, "kernel_launch: hipFuncSetAttribute failed\n"); grid = -1; return; }
        if (hipOccupancyMaxActiveBlocksPerMultiprocessor(&per_cu, (const void*)mk_fwd, NWAVES * 64, LDS_BYTES) != hipSuccess || per_cu < 1) fprintf(stderr, "kernel_launch: occupancy query reports %d\n", per_cu);
        (void)hipGetLastError();
        grid = cus;
    }
    if (grid < 0) return;
    (void)hipMemsetAsync((char*)d_ws + WS_CTL, 0, CTL_ZERO_BYTES, stream);
    Args a{};
    for (int i = 0; i < 18; ++i) a.in[i] = (const float*)d_in[i];
    a.out = (float*)d_out; a.ws = (unsigned char*)d_ws;
#if MK_SPLIT
#if DBG_NAIVE
    const int seq[] = {0, 1, 2, 3, 4, 11, 5, 6, 7, 8, 9, 10};
#else
    const int seq[] = {0, 1, 2, 3, 5, 6, 7, 8, 9, 10};
#endif
    for (int ph : seq) { a.ph_lo = ph; a.ph_hi = ph + 1;
#ifdef PROBE_P7
        if (ph == 7) { a.flags = 1; hipLaunchKernelGGL(mk_fwd, dim3(grid), dim3(NWAVES * 64), LDS_BYTES, stream, a); a.flags = 0; }
#endif
        hipLaunchKernelGGL(mk_fwd, dim3(grid), dim3(NWAVES * 64), LDS_BYTES, stream, a);
#ifdef PROBE_DUP
        if (ph == PROBE_DUP) hipLaunchKernelGGL(mk_fwd, dim3(grid), dim3(NWAVES * 64), LDS_BYTES, stream, a);
#endif
    }
#else
    a.ph_lo = 0; a.ph_hi = 11;
    hipLaunchKernelGGL(mk_fwd, dim3(grid), dim3(NWAVES * 64), LDS_BYTES, stream, a);
#endif
}
```

```cpp
#include <hip/hip_runtime.h>
#include <hip/hip_bf16.h>
#include <cstdio>
#include <cstdint>

#ifndef MK_SPLIT
#define MK_SPLIT 0
#endif
#ifndef DBG_NAIVE
#define DBG_NAIVE 0
#endif
#ifndef DBG_G
#define DBG_G 1.0f
#endif

#define LAS __attribute__((address_space(3)))
#define GAS __attribute__((address_space(1)))
typedef unsigned short bf16_t;
typedef short bf16x8 __attribute__((ext_vector_type(8)));
typedef short s16x4 __attribute__((ext_vector_type(4)));
typedef float f32x2 __attribute__((ext_vector_type(2)));
typedef float f32x4 __attribute__((ext_vector_type(4)));
typedef float f32x16 __attribute__((ext_vector_type(16)));
typedef unsigned u32x2 __attribute__((ext_vector_type(2)));
typedef unsigned u32x4 __attribute__((ext_vector_type(4)));
typedef unsigned u32x16 __attribute__((ext_vector_type(16)));
typedef __bf16 bf16x2_t __attribute__((ext_vector_type(2)));

constexpr int NTOK = 32768, SEQ = 2048, NBATCH = 16, DM = 1024;
constexpr int NPROJ = 5120, INW = 4936;
constexpr int NEXP = 32, DEXP = 512, LISTCAP = 32768;
constexpr int CAPROWS = 65536 + NEXP * 256;
constexpr float LN_EPS = 1e-5f;
constexpr float ALPHA = 1.189207115002721f;
constexpr float C2 = 0.125f * 1.4426950408889634f;
constexpr float WSCALE = 0.125f * 0.35355339059327373f;

constexpr size_t MiB = 1u << 20;
constexpr size_t WS_CTL = 0, CTL_ZERO_BYTES = 1 * MiB;
constexpr size_t WS_ROPE = 1 * MiB;
constexpr size_t WS_WC = 1 * MiB + 256 * 1024;
constexpr size_t WS_WIN = 2 * MiB, WS_WAU = 12 * MiB, WS_WCU = 13 * MiB, WS_WOUT = 14 * MiB, WS_WD = 16 * MiB, WS_WGU = 48 * MiB;
constexpr size_t WS_XB = 112 * MiB;
constexpr size_t WS_MIX = 112 * MiB;
constexpr size_t WS_H1Q = 304 * MiB;
constexpr size_t WS_AC = 112 * MiB;
constexpr size_t WS_Q = 176 * MiB, WS_K = 208 * MiB, WS_V = 216 * MiB, WS_QI = 224 * MiB, WS_KI = 256 * MiB, WS_WI = 260 * MiB;
constexpr size_t WS_MERGED = 176 * MiB;
constexpr size_t WS_U = 264 * MiB, WS_ATTN = 264 * MiB;
constexpr size_t WS_CB = 296 * MiB, WS_MASK = 360 * MiB, WS_GATES = 368 * MiB;
constexpr size_t WS_GA = 368 * MiB, WS_RT = 432 * MiB;
constexpr size_t WS_PRE = 240 * MiB;
constexpr size_t WS_HID = 368 * MiB;
constexpr size_t WS_LIST = 496 * MiB, WS_TOKINFO = 500 * MiB;
constexpr size_t WS_YS = 48 * MiB;
constexpr size_t WS_END = 512 * MiB;
static_assert(WS_YS + (size_t)CAPROWS * 1024 * 2 <= WS_PRE && WS_HID + (size_t)CAPROWS * 512 * 2 <= WS_LIST, "ws map");
constexpr int CW_BAR = 4096;
constexpr int CW_CNT = 8192;
constexpr int RING_BYTES = 131072;
constexpr int LDSCTL_OFF = RING_BYTES;
constexpr int TAB_OFF = RING_BYTES + 512;
constexpr int T_CNT = 0, T_BLK0 = 32, T_NB = 68, T_BLKE = 72, T_ROWS = 400, T_ROWS_UNITS = 8;
constexpr int LDS_BYTES = 147456;
static_assert(TAB_OFF + (T_ROWS + T_ROWS_UNITS * 256) * 4 <= LDS_BYTES && TAB_OFF + 8192 <= LDS_BYTES, "lds map");
constexpr int NWAVES = 8;

__device__ __forceinline__ unsigned pkbf(float lo, float hi) { f32x2 v = {lo, hi}; bf16x2_t b = __builtin_convertvector(v, bf16x2_t); return __builtin_bit_cast(unsigned, b); }
__device__ __forceinline__ float bflo(unsigned u) { return __uint_as_float(u << 16); }
__device__ __forceinline__ float bfhi(unsigned u) { return __uint_as_float(u & 0xffff0000u); }
__device__ __forceinline__ float wave_sum(float v) {
#pragma unroll
    for (int o = 1; o < 64; o <<= 1) v += __shfl_xor(v, o);
    return v;
}
__device__ __forceinline__ float wave_max(float v) {
#pragma unroll
    for (int o = 1; o < 64; o <<= 1) v = fmaxf(v, __shfl_xor(v, o));
    return v;
}
__device__ __forceinline__ float wave_min(float v) {
#pragma unroll
    for (int o = 1; o < 64; o <<= 1) v = fminf(v, __shfl_xor(v, o));
    return v;
}
#define LDS_WAIT() asm volatile("s_waitcnt lgkmcnt(0)" ::: "memory")
#define VM_WAIT() asm volatile("s_waitcnt vmcnt(0)" ::: "memory")

namespace pg8 {
constexpr int BM = 256, BK = 64, HALF = 128, HTB = HALF * BK * 2, STAGE_BYTES = 8 * HTB, NXCD = 8, WGM = 8;
__host__ __device__ __forceinline__ int lds_byte(int r, int c) { const int st = (r >> 4) * 2 + (c >> 5), rr = r & 15, cc = c & 31, ob = rr * 64 + cc * 2; return st * 1024 + (ob ^ (((ob >> 9) & 1) << 5)); }
__host__ __device__ __forceinline__ void stage_rc(int b, int& R, int& C) { const int st = b / 1024, sb = b % 1024, swz = sb ^ (((sb >> 9) & 1) << 5); R = (st >> 1) * 16 + swz / 64; C = (st & 1) * 32 + (swz % 64) / 2; }
__host__ __device__ __forceinline__ int perm32(int rho) { const int n = rho >> 4, i = rho & 15; return 8 * (i >> 2) + 4 * n + (i & 3); }

struct Unit { int pm, pn; };
struct Gemm { const bf16_t* A; const bf16_t* Bt; int M, N, K; int apitch; };

struct StaticOrder {
    int nM, nN, nwg, G, c;
    __host__ __device__ void init(int M, int N, int G_, int c_) { nM = M / BM; nN = N / BM; nwg = nM * nN; G = G_; c = c_; }
    __host__ __device__ bool next(int i, Unit& u) const {
        const long L = (long)i * G + c; if (L >= nwg) return false;
        int wgid = (int)L; { const int q = nwg / NXCD, r = nwg % NXCD, xcd = wgid % NXCD, off = wgid / NXCD; wgid = (xcd < r ? xcd * (q + 1) : r * (q + 1) + (xcd - r) * q) + off; }
        const int nig = WGM * nN, gid = wgid / nig, fm = gid * WGM, gsz = (nM - fm) < WGM ? (nM - fm) : WGM;
        u.pm = fm + ((wgid % nig) % gsz); u.pn = (wgid % nig) / gsz; return true;
    }
};
struct MoeOrder {
    const LAS int* blk_e; int nunits, G, c;
    __device__ __forceinline__ bool next(int i, Unit& u) const {
        const int L = i * G + c; if (L >= nunits) return false;
        const int rbg = L >> 2; u.pm = rbg; u.pn = blk_e[rbg] * 4 + (L & 3); return true;
    }
};

typedef int i32x8 __attribute__((ext_vector_type(8)));
typedef int i32x4_t __attribute__((ext_vector_type(4)));
constexpr int F8_WSCALE_E = 122;
template <class Epi, class Sched, bool ALIGN_EPI, bool GATHER, bool MIDHOOK = false, bool F8 = false>
__device__ __forceinline__ void gemm_phase(LAS unsigned char* lds, const Gemm g, const Sched& S, const Epi& E, const LAS int* rowtab) {
    const int tid = threadIdx.x, wid = __builtin_amdgcn_readfirstlane(tid >> 6), lane = tid & 63, wr = wid >> 2, wc = wid & 3, fr = lane & 15, fq = lane >> 4;
    const int K = g.K; int nt = K / BK;
    if constexpr (F8) asm volatile("" : "+s"(nt));
    int Rr[2]; unsigned cofs[2], voffB[2];
#pragma unroll
    for (int i = 0; i < 2; ++i) { int R, C; stage_rc(tid * 16 + i * 8192, R, C); const int Rb = Epi::PERM ? ((R & ~31) + perm32(R & 31)) : R;
        Rr[i] = R; cofs[i] = (unsigned)C * 2u; voffB[i] = (unsigned)(Rb * K + C) * 2u; }
    const unsigned rowb = g.apitch ? (unsigned)g.apitch : (unsigned)K * 2u;
    const size_t kstep = (size_t)(BK * 2);
    const size_t hstep = (size_t)HALF * K * 2;
    const size_t tstep = 2 * hstep;
    const unsigned ldsw = (unsigned)wid * 1024u;
    const int aoff = lds_byte(wr * 64 + fr, fq * 8), boff = lds_byte(wc * 32 + fr, fq * 8);
    const char* gA = (const char*)g.A;
#define PG8_SA(b, h) (((b) * 2 + (h)) * HTB)
#define PG8_SB(b, h) ((4 + (b) * 2 + (h)) * HTB)
#define PG8_STAGE(bufoff, gbase, voff) do { _Pragma("unroll") for (int _i = 0; _i < 2; ++_i) \
        __builtin_amdgcn_global_load_lds((const unsigned*)((const char*)(gbase) + (voff)[_i]), (LAS unsigned*)(lds + (bufoff) + ldsw + _i * 8192), 16, 0, 0); } while (0)
#define PG8_LD8(p_) __builtin_shufflevector(*(const LAS i32x4_t*)(p_), *(const LAS i32x4_t*)((p_) + 1024), 0, 1, 2, 3, 4, 5, 6, 7)
#define PG8_LDA(dst, b, h) do { if constexpr (F8) { _Pragma("unroll") for (int m = 0; m < 4; ++m) dst##8[m] = PG8_LD8(lds + PG8_SA(b, h) + aoff + m * 2048); } \
        else { _Pragma("unroll") for (int m = 0; m < 4; ++m) _Pragma("unroll") for (int k = 0; k < 2; ++k) dst[m][k] = *(const LAS bf16x8*)(lds + PG8_SA(b, h) + aoff + m * 2048 + k * 1024); } } while (0)
#define PG8_LDB(dst, b, h) do { if constexpr (F8) { _Pragma("unroll") for (int n = 0; n < 2; ++n) dst##8[n] = PG8_LD8(lds + PG8_SB(b, h) + boff + n * 2048); } \
        else { _Pragma("unroll") for (int n = 0; n < 2; ++n) _Pragma("unroll") for (int k = 0; k < 2; ++k) dst[n][k] = *(const LAS bf16x8*)(lds + PG8_SB(b, h) + boff + n * 2048 + k * 1024); } } while (0)
#define PG8_MMA(ai, bj, At, Bt) do { if constexpr (F8) __builtin_amdgcn_sched_barrier(0);     \
        __builtin_amdgcn_s_setprio(1); \
        if constexpr (F8) { _Pragma("unroll") for (int m = 0; m < 4; ++m) _Pragma("unroll") for (int n = 0; n < 2; ++n) \
            asm volatile("v_mfma_scale_f32_16x16x128_f8f6f4 %0, %1, %2, %0, %3, %4 op_sel_hi:[0,0,0]" : "+v"(acc[ai][bj][m][n]) : "v"(Bt##8[n]), "v"(At##8[m]), "v"(f8_sw), "v"(f8_sa));     \
            __builtin_amdgcn_sched_barrier(0); } \
        else { _Pragma("unroll") for (int m = 0; m < 4; ++m) _Pragma("unroll") for (int n = 0; n < 2; ++n) _Pragma("unroll") for (int k = 0; k < 2; ++k) \
            acc[ai][bj][m][n] = __builtin_amdgcn_mfma_f32_16x16x32_bf16(Bt[n][k], At[m][k], acc[ai][bj][m][n], 0, 0, 0); } \
        __builtin_amdgcn_s_setprio(0); } while (0)
#define PG8_WAIT_V(n) asm volatile("s_waitcnt vmcnt(" #n ")" ::: "memory")
#define PG8_WAIT_L(n) asm volatile("s_waitcnt lgkmcnt(" #n ")" ::: "memory")
#define PG8_BAR __builtin_amdgcn_s_barrier()
#define PG8_SCHED __builtin_amdgcn_sched_barrier(0)
#define PG8_AOFF(d0, d1, un, uidx) do { _Pragma("unroll") for (int _i = 0; _i < 2; ++_i) { unsigned r0_, r1_; \
        if (GATHER) { r0_ = (unsigned)rowtab[(uidx) * 256 + Rr[_i]]; r1_ = (unsigned)rowtab[(uidx) * 256 + 128 + Rr[_i]]; } \
        else { r0_ = (unsigned)((un).pm * 256 + Rr[_i]); r1_ = r0_ + 128u; } \
        d0[_i] = r0_ * rowb + cofs[_i]; d1[_i] = r1_ * rowb + cofs[_i]; } } while (0)
    Unit cur, nxt; int ui = 0;
    if (!S.next(0, cur)) return;
    f32x4 acc[2][2][4][2];
#pragma unroll
    for (int a = 0; a < 2; ++a)
#pragma unroll
        for (int b = 0; b < 2; ++b)
#pragma unroll
            for (int m = 0; m < 4; ++m)
#pragma unroll
                for (int n = 0; n < 2; ++n) acc[a][b][m][n] = (f32x4){0.f, 0.f, 0.f, 0.f};
    bf16x8 At[4][2], B0[2][2], B1[2][2]; i32x8 At8[4], B08[2], B18[2];
    int f8_sw = F8_WSCALE_E, f8_sa = 127; asm volatile("" : "+v"(f8_sw), "+v"(f8_sa));
    unsigned oc0[2], oc1[2], on0[2], on1[2];
    PG8_AOFF(oc0, oc1, cur, 0);
    const char* cB = (const char*)g.Bt + (size_t)cur.pn * tstep;
    PG8_STAGE(PG8_SB(0, 0), cB, voffB); PG8_STAGE(PG8_SB(0, 1), cB + hstep, voffB); PG8_STAGE(PG8_SA(0, 0), gA, oc0); PG8_STAGE(PG8_SA(0, 1), gA, oc1);
    if (wr == 1) PG8_BAR;
    PG8_WAIT_V(2); PG8_BAR;
    PG8_STAGE(PG8_SB(1, 0), cB + kstep, voffB); PG8_STAGE(PG8_SA(1, 0), gA + kstep, oc0); PG8_STAGE(PG8_SB(1, 1), cB + hstep + kstep, voffB);
    PG8_WAIT_V(6); PG8_BAR;
    for (;;) {
        const bool has_next = S.next(ui + 1, nxt);
        if (has_next) { PG8_AOFF(on0, on1, nxt, ui + 1); } else { on0[0] = oc0[0]; on0[1] = oc0[1]; on1[0] = oc1[0]; on1[1] = oc1[1]; }
        const char* nB = has_next ? (const char*)g.Bt + (size_t)nxt.pn * tstep : cB;
        for (int t = 0; t < nt; t += 2) {
            if constexpr (MIDHOOK) { if (t == nt / 2) E.mid(acc, cur, wr, wc, fr, fq); }
            const bool last = (t == nt - 2);
            const char* a1 = gA + (size_t)(t + 1) * kstep;
            const char* a2 = last ? gA : gA + (size_t)(t + 2) * kstep; const char* b2 = last ? nB : cB + (size_t)(t + 2) * kstep;
            const char* a3 = a2 + kstep; const char* b3 = b2 + kstep;
            unsigned o20[2], o21[2];
            o20[0] = last ? on0[0] : oc0[0]; o20[1] = last ? on0[1] : oc0[1]; o21[0] = last ? on1[0] : oc1[0]; o21[1] = last ? on1[1] : oc1[1];
            PG8_LDB(B0, 0, 0); PG8_LDB(B1, 0, 1); PG8_SCHED; PG8_LDA(At, 0, 0); PG8_STAGE(PG8_SA(1, 1), a1, oc1);
            PG8_WAIT_V(8); PG8_WAIT_L(0); PG8_BAR; PG8_MMA(0, 0, At, B0); PG8_MMA(0, 1, At, B1); PG8_BAR; PG8_SCHED;
            PG8_LDA(At, 0, 1); PG8_STAGE(PG8_SB(0, 0), b2, voffB); PG8_STAGE(PG8_SB(0, 1), b2 + hstep, voffB); PG8_STAGE(PG8_SA(0, 0), a2, o20);
            PG8_WAIT_V(8); PG8_WAIT_L(0); PG8_BAR; PG8_MMA(1, 0, At, B0); PG8_MMA(1, 1, At, B1); PG8_BAR; PG8_SCHED;
            PG8_LDB(B0, 1, 0); PG8_LDB(B1, 1, 1); PG8_SCHED; PG8_LDA(At, 1, 0); PG8_STAGE(PG8_SA(0, 1), a2, o21);
            PG8_WAIT_V(8); PG8_WAIT_L(0); PG8_BAR; PG8_MMA(0, 0, At, B0); PG8_MMA(0, 1, At, B1); PG8_BAR; PG8_SCHED;
            PG8_LDA(At, 1, 1); PG8_STAGE(PG8_SB(1, 0), b3, voffB); PG8_STAGE(PG8_SB(1, 1), b3 + hstep, voffB); PG8_STAGE(PG8_SA(1, 0), a3, o20);
            PG8_WAIT_V(8); PG8_WAIT_L(0); PG8_BAR; PG8_MMA(1, 0, At, B0); PG8_MMA(1, 1, At, B1); PG8_BAR; PG8_SCHED;
        }
        if constexpr (ALIGN_EPI) { if (wr == 0) PG8_BAR; }
        if constexpr (F8) asm volatile("s_nop 15\n\ts_nop 15" ::: "memory");
        E(acc, cur, wr, wc, fr, fq);
        if (!has_next) break;
#pragma unroll
        for (int a = 0; a < 2; ++a)
#pragma unroll
            for (int b = 0; b < 2; ++b)
#pragma unroll
                for (int m = 0; m < 4; ++m)
#pragma unroll
                    for (int n = 0; n < 2; ++n) acc[a][b][m][n] = (f32x4){0.f, 0.f, 0.f, 0.f};
        cur = nxt; cB = nB; ++ui;
        oc0[0] = on0[0]; oc0[1] = on0[1]; oc1[0] = on1[0]; oc1[1] = on1[1];
        if constexpr (ALIGN_EPI) { if (wr == 1) PG8_BAR; }
    }
    PG8_WAIT_V(0);
    if constexpr (!ALIGN_EPI) { if (wr == 0) PG8_BAR; }
    PG8_BAR;
#undef PG8_SA
#undef PG8_SB
#undef PG8_STAGE
#undef PG8_LDA
#undef PG8_LDB
#undef PG8_MMA
#undef PG8_LD8
#undef PG8_WAIT_V
#undef PG8_WAIT_L
#undef PG8_BAR
#undef PG8_SCHED
#undef PG8_AOFF
}
}

typedef f32x4 AccT[2][2][4][2];
__device__ __forceinline__ void store8bf(bf16_t* p, const f32x4& v0, const f32x4& v1) {
    u32x4 w; w.x = pkbf(v0[0], v0[1]); w.y = pkbf(v0[2], v0[3]); w.z = pkbf(v1[0], v1[1]); w.w = pkbf(v1[2], v1[3]); *(u32x4*)p = w;
}
__device__ __forceinline__ void rope8(f32x4& v0, f32x4& v1, const float* rope, int pos, int i0) {
    const f32x4 c = *(const f32x4*)(rope + pos * 8 + i0), s = *(const f32x4*)(rope + SEQ * 8 + pos * 8 + i0);
    float a, b;
    a = v0[0]; b = v0[1]; v0[0] = a * c[0] - b * s[0]; v0[1] = b * c[0] + a * s[0];
    a = v0[2]; b = v0[3]; v0[2] = a * c[1] - b * s[1]; v0[3] = b * c[1] + a * s[1];
    a = v1[0]; b = v1[1]; v1[0] = a * c[2] - b * s[2]; v1[1] = b * c[2] + a * s[2];
    a = v1[2]; b = v1[3]; v1[2] = a * c[3] - b * s[3]; v1[3] = b * c[3] + a * s[3];
}
__device__ __forceinline__ float sigmoidf_(float z) { return __builtin_amdgcn_rcpf(1.0f + __expf(-z)); }

struct EpiProj {
    static constexpr bool PERM = true;
    bf16_t *q, *k, *v, *qi, *ki, *u, *cb, *ga, *rt; float* wi; const float* rope; const float* gate_bias;
    __device__ __forceinline__ void operator()(const AccT& acc, const pg8::Unit& un, int wr, int wc, int fr, int fq) const {
        const int pn = un.pn, row0 = un.pm * 256 + wr * 64 + fr, cg = 32 * wc + 8 * fq;
        const bool rot = ((wc & 1) == 0) && (fq < 2); const int i0 = 4 * fq;
        if (pn < 2 || pn == 3 || pn == 4) {
            bf16_t* dst = (pn < 2) ? q + pn * 256 : qi + (pn - 3) * 256; const float sc = (pn < 2) ? C2 : 1.0f;
#pragma unroll
            for (int ai = 0; ai < 2; ++ai)
#pragma unroll
                for (int m = 0; m < 4; ++m) { const int row = row0 + ai * 128 + m * 16, pos = row & (SEQ - 1);
#pragma unroll
                    for (int bj = 0; bj < 2; ++bj) { f32x4 v0 = acc[ai][bj][m][0], v1 = acc[ai][bj][m][1];
                        if (rot) rope8(v0, v1, rope, pos, i0);
                        v0 = v0 * sc; v1 = v1 * sc; store8bf(dst + (size_t)row * 512 + bj * 128 + cg, v0, v1); } }
        } else if (pn == 2) {
#pragma unroll
            for (int ai = 0; ai < 2; ++ai)
#pragma unroll
                for (int m = 0; m < 4; ++m) { const int row = row0 + ai * 128 + m * 16, pos = row & (SEQ - 1);
                    f32x4 v0 = acc[ai][0][m][0], v1 = acc[ai][0][m][1];
                    if (rot) rope8(v0, v1, rope, pos, i0);
                    store8bf(k + (size_t)row * 128 + cg, v0, v1);
                    store8bf(v + (size_t)row * 128 + cg, acc[ai][1][m][0], acc[ai][1][m][1]); }
        } else if (pn == 5) {
            if (wc < 2) {
#pragma unroll
                for (int ai = 0; ai < 2; ++ai)
#pragma unroll
                    for (int m = 0; m < 4; ++m) { const int row = row0 + ai * 128 + m * 16, pos = row & (SEQ - 1);
                        f32x4 v0 = acc[ai][0][m][0], v1 = acc[ai][0][m][1];
                        if (rot) rope8(v0, v1, rope, pos, i0);
                        { const int jch = cg >> 3; store8bf(ki + ((size_t)(row >> 5) * 4 + (jch >> 1)) * 512 + (row & 31) * 16 + (jch & 1) * 8, v0, v1); } }
            } else if (wc == 2 && fq == 0) {
#pragma unroll
                for (int ai = 0; ai < 2; ++ai)
#pragma unroll
                    for (int m = 0; m < 4; ++m) { const int row = row0 + ai * 128 + m * 16;
                        *(f32x4*)(wi + (size_t)row * 8) = acc[ai][0][m][0]; *(f32x4*)(wi + (size_t)row * 8 + 4) = acc[ai][0][m][1]; }
            }
        } else if (pn < 10) {
#pragma unroll
            for (int ai = 0; ai < 2; ++ai)
#pragma unroll
                for (int m = 0; m < 4; ++m) { const int row = row0 + ai * 128 + m * 16;
                    store8bf(u + (size_t)row * 512 + (pn - 6) * 128 + cg, acc[ai][0][m][0] * acc[ai][1][m][0], acc[ai][0][m][1] * acc[ai][1][m][1]); }
        } else if (pn < 12) {
#pragma unroll
            for (int ai = 0; ai < 2; ++ai)
#pragma unroll
                for (int m = 0; m < 4; ++m) { const int row = row0 + ai * 128 + m * 16;
#pragma unroll
                    for (int bj = 0; bj < 2; ++bj) store8bf(cb + (size_t)row * 512 + (pn - 10) * 256 + bj * 128 + cg, acc[ai][bj][m][0], acc[ai][bj][m][1]); }
        } else {
            const int gc0 = (pn - 12) * 128 + cg;
            const f32x4 ba0 = *(const f32x4*)(gate_bias + gc0), ba1 = *(const f32x4*)(gate_bias + gc0 + 4), bc0 = *(const f32x4*)(gate_bias + 1024 + gc0), bc1 = *(const f32x4*)(gate_bias + 1024 + gc0 + 4);
#pragma unroll
            for (int ai = 0; ai < 2; ++ai)
#pragma unroll
                for (int m = 0; m < 4; ++m) { const int row = row0 + ai * 128 + m * 16;
                    const f32x4 a0 = acc[ai][0][m][0] + ba0, a1 = acc[ai][0][m][1] + ba1, c0 = acc[ai][1][m][0] + bc0, c1 = acc[ai][1][m][1] + bc1;
                    f32x4 g0, g1, r0, r1;
#pragma unroll
                    for (int e = 0; e < 4; ++e) { const float ea0 = 1.0f + __expf(-a0[e]), ea1 = 1.0f + __expf(-a1[e]);
                        g0[e] = __builtin_amdgcn_rcpf(ea0); g1[e] = __builtin_amdgcn_rcpf(ea1);
                        r0[e] = ea0 * __builtin_amdgcn_rcpf(1.0f + __expf(-c0[e])); r1[e] = ea1 * __builtin_amdgcn_rcpf(1.0f + __expf(-c1[e])); }
                    store8bf(ga + (size_t)row * 1024 + gc0, g0, g1); store8bf(rt + (size_t)row * 1024 + gc0, r0, r1); }
        }
    }
};
struct EpiMerged {
    static constexpr bool PERM = true;
    const bf16_t* ga; const bf16_t* rt; bf16_t* out;
    __device__ __forceinline__ void scale(AccT& acc, const bf16_t* gsrc, const pg8::Unit& un, int wr, int wc, int fr, int fq) const {
        unsigned off0 = (unsigned)(un.pm * 256 + wr * 64 + fr) * 1024u + (unsigned)(un.pn * 256 + 32 * wc + 8 * fq);
        asm volatile("" : "+v"(off0));
#pragma unroll
        for (int ai = 0; ai < 2; ++ai)
#pragma unroll
            for (int m = 0; m < 4; ++m) {
#pragma unroll
                for (int bj = 0; bj < 2; ++bj) { const u32x4 gw = *(const u32x4*)(gsrc + (off0 + (unsigned)((ai * 128 + m * 16) * 1024 + bj * 128)));
                    f32x4& v0 = acc[ai][bj][m][0]; f32x4& v1 = acc[ai][bj][m][1];
                    v0[0] *= bflo(gw.x); v0[1] *= bfhi(gw.x); v0[2] *= bflo(gw.y); v0[3] *= bfhi(gw.y);
                    v1[0] *= bflo(gw.z); v1[1] *= bfhi(gw.z); v1[2] *= bflo(gw.w); v1[3] *= bfhi(gw.w); } }
    }
    __device__ __forceinline__ void mid(AccT& acc, const pg8::Unit& un, int wr, int wc, int fr, int fq) const { scale(acc, rt, un, wr, wc, fr, fq); }
    __device__ __forceinline__ void operator()(AccT& acc, const pg8::Unit& un, int wr, int wc, int fr, int fq) const {
        scale(acc, ga, un, wr, wc, fr, fq);
        const int row0 = un.pm * 256 + wr * 64 + fr, col0 = un.pn * 256 + 32 * wc + 8 * fq;
#pragma unroll
        for (int ai = 0; ai < 2; ++ai)
#pragma unroll
            for (int m = 0; m < 4; ++m) { const int row = row0 + ai * 128 + m * 16;
#pragma unroll
                for (int bj = 0; bj < 2; ++bj) store8bf(out + (size_t)row * 1024 + col0 + bj * 128, acc[ai][bj][m][0], acc[ai][bj][m][1]); }
    }
};
struct EpiOut {
    static constexpr bool PERM = true;
    bf16_t* mix;
    __device__ __forceinline__ void operator()(const AccT& acc, const pg8::Unit& un, int wr, int wc, int fr, int fq) const {
        const int row0 = un.pm * 256 + wr * 64 + fr, col0 = un.pn * 256 + 32 * wc + 8 * fq;
#pragma unroll
        for (int ai = 0; ai < 2; ++ai)
#pragma unroll
            for (int m = 0; m < 4; ++m) { const int row = row0 + ai * 128 + m * 16;
#pragma unroll
                for (int bj = 0; bj < 2; ++bj) store8bf(mix + (size_t)row * 1024 + col0 + bj * 128, acc[ai][bj][m][0], acc[ai][bj][m][1]); }
    }
};
struct EpiSwiGLU {
    static constexpr bool PERM = true;
    unsigned char* hid;
    __device__ __forceinline__ void operator()(const AccT& acc, const pg8::Unit& un, int wr, int wc, int fr, int fq) const {
        const int row0 = un.pm * 256 + wr * 64 + fr, col0 = (un.pn & 3) * 128 + 32 * wc + 8 * fq;
#pragma unroll
        for (int ai = 0; ai < 2; ++ai)
#pragma unroll
            for (int m = 0; m < 4; ++m) { const int row = row0 + ai * 128 + m * 16; f32x4 h0, h1;
#pragma unroll
                for (int e = 0; e < 4; ++e) { const float g0 = acc[ai][0][m][0][e], g1 = acc[ai][0][m][1][e];
                    h0[e] = g0 * sigmoidf_(g0) * acc[ai][1][m][0][e]; h1[e] = g1 * sigmoidf_(g1) * acc[ai][1][m][1][e]; }
                int w0 = 0, w1 = 0;
                w0 = __builtin_amdgcn_cvt_pk_fp8_f32(h0[0], h0[1], w0, false); w0 = __builtin_amdgcn_cvt_pk_fp8_f32(h0[2], h0[3], w0, true);
                w1 = __builtin_amdgcn_cvt_pk_fp8_f32(h1[0], h1[1], w1, false); w1 = __builtin_amdgcn_cvt_pk_fp8_f32(h1[2], h1[3], w1, true);
                *(u32x2*)(hid + (size_t)row * 512 + col0) = (u32x2){(unsigned)w0, (unsigned)w1}; }
    }
};
struct EpiYs {
    static constexpr bool PERM = true;
    unsigned char* ys;
    __device__ __forceinline__ void operator()(const AccT& acc, const pg8::Unit& un, int wr, int wc, int fr, int fq) const {
        const int row0 = un.pm * 256 + wr * 64 + fr, col0 = (un.pn & 3) * 256 + 32 * wc + 8 * fq;
#pragma unroll
        for (int ai = 0; ai < 2; ++ai)
#pragma unroll
            for (int m = 0; m < 4; ++m) { const int row = row0 + ai * 128 + m * 16;
#pragma unroll
                for (int bj = 0; bj < 2; ++bj) { const f32x4 v0 = acc[ai][bj][m][0], v1 = acc[ai][bj][m][1]; int w0 = 0, w1 = 0;
                    w0 = __builtin_amdgcn_cvt_pk_fp8_f32(v0[0], v0[1], w0, false); w0 = __builtin_amdgcn_cvt_pk_fp8_f32(v0[2], v0[3], w0, true);
                    w1 = __builtin_amdgcn_cvt_pk_fp8_f32(v1[0], v1[1], w1, false); w1 = __builtin_amdgcn_cvt_pk_fp8_f32(v1[2], v1[3], w1, true);
                    *(u32x2*)(ys + (size_t)row * 1024 + col0 + bj * 128) = (u32x2){(unsigned)w0, (unsigned)w1}; } }
    }
};

namespace attn_body {
using bf16 = __hip_bfloat16;
constexpr int D = 64, QP = 512, KP = 128, OP = 1024, OCOL = 512;
constexpr int NW = 8, QBLK = 32, QB = QBLK * NW, KVBLK = 64;
__device__ __forceinline__ int crow(int r, int hi) { return (r & 3) + 8 * (r >> 2) + 4 * hi; }
#define SBAR() __builtin_amdgcn_sched_barrier(0)
__device__ __forceinline__ void cmask(f32x16& p0, f32x16& p1, int jb, int qrel, int hi) {
    const float NEG = -INFINITY; int kb = 64 * jb + 4 * hi;
#pragma unroll
    for (int r = 0; r < 16; ++r) { int kv = kb + (r & 3) + 8 * (r >> 2); if (kv > qrel) p0[r] = NEG; if (kv + 32 > qrel) p1[r] = NEG; }
}
constexpr int NSLOT = 3, SLOTB = 8192;
constexpr int LDS_K = 0, LDS_V = NSLOT * SLOTB, LDS_WS = 2 * NSLOT * SLOTB, LDS_OST = LDS_WS + NW * 64 * 4, LDS_QF = LDS_OST + NW * 4096, LDS_BYTES_A = LDS_QF + NW * 4096;
static_assert(LDS_BYTES_A <= 131072, "attention LDS");
__device__ __forceinline__ void glds16(const void* gsrc, unsigned lds_dst) { unsigned keep;
    asm volatile("s_mov_b32 %0, m0\n\ts_mov_b32 m0, %2\n\ts_nop 0\n\tglobal_load_lds_dwordx4 %1, off\n\ts_mov_b32 m0, %0" : "=&s"(keep) : "v"(gsrc), "s"(lds_dst) : "memory"); }
__device__ __forceinline__ float max3f(float a, float b, float c) { float r; asm("v_max3_f32 %0, %1, %2, %3" : "=v"(r) : "v"(a), "v"(b), "v"(c)); return r; }
__device__ __forceinline__ float max2f(float a, float b) { float r; asm("v_max_f32_e32 %0, %1, %2" : "=v"(r) : "v"(a), "v"(b)); return r; }
__device__ __forceinline__ float fadd_s(float a, float b) { float r; asm("v_add_f32_e32 %0, %1, %2" : "=v"(r) : "v"(a), "v"(b)); return r; }
__device__ __forceinline__ float fsub_s(float a, float b) { float r; asm("v_sub_f32_e32 %0, %1, %2" : "=v"(r) : "v"(a), "v"(b)); return r; }
__device__ __forceinline__ unsigned cvtpk_s(float lo, float hi) { return pkbf(lo, hi); }
__device__ __forceinline__ float msel(float x, float neg, unsigned long long m) { float r; asm("v_cndmask_b32_e64 %0, %1, %2, %3" : "=v"(r) : "v"(neg), "v"(x), "s"(m)); return r; }
#define WAIT_BAR(N) asm volatile("s_waitcnt vmcnt(" #N ") lgkmcnt(0)\n\ts_barrier" ::: "memory")

typedef __attribute__((address_space(3))) const char* lds_cptr;
__device__ __forceinline__ void qkt(f32x16& p0, f32x16& p1, const char* Kslot, lds_cptr qfp, const f32x16& negm, int r32, int hi) {
    const char* kb = Kslot + hi * 1024 + r32 * 16;
#pragma unroll
    for (int d0 = 0; d0 < 4; ++d0) {
        const bf16x8 b0 = *reinterpret_cast<const bf16x8*>(kb + d0 * 2048);
        const bf16x8 b1 = *reinterpret_cast<const bf16x8*>(kb + d0 * 2048 + 512);
        const bf16x8 qd = *(const LAS bf16x8*)(qfp + d0 * 1024);
        if (d0 == 0) { p0 = __builtin_amdgcn_mfma_f32_32x32x16_bf16(b0, qd, negm, 0, 0, 0); p1 = __builtin_amdgcn_mfma_f32_32x32x16_bf16(b1, qd, negm, 0, 0, 0); }
        else { p0 = __builtin_amdgcn_mfma_f32_32x32x16_bf16(b0, qd, p0, 0, 0, 0); p1 = __builtin_amdgcn_mfma_f32_32x32x16_bf16(b1, qd, p1, 0, 0, 0); } }
}
typedef short v4i16_t __attribute__((ext_vector_type(4)));
__device__ __forceinline__ void kload8(bf16x8* kf, lds_cptr kp) {
    kf[0] = *(const LAS bf16x8*)(kp);        kf[1] = *(const LAS bf16x8*)(kp + 512);
    kf[2] = *(const LAS bf16x8*)(kp + 2048); kf[3] = *(const LAS bf16x8*)(kp + 2560);
    kf[4] = *(const LAS bf16x8*)(kp + 4096); kf[5] = *(const LAS bf16x8*)(kp + 4608);
    kf[6] = *(const LAS bf16x8*)(kp + 6144); kf[7] = *(const LAS bf16x8*)(kp + 6656);
}
__device__ __forceinline__ void kload2(bf16x8* kf, lds_cptr kp, int j) { kf[2 * j] = *(const LAS bf16x8*)(kp + j * 2048); kf[2 * j + 1] = *(const LAS bf16x8*)(kp + j * 2048 + 512); }
__device__ __forceinline__ s16x4 vtr(lds_cptr p) { return __builtin_bit_cast(s16x4, __builtin_amdgcn_ds_read_tr16_b64_v4i16((LAS v4i16_t*)p)); }
__device__ __forceinline__ float rowmax(const f32x16& p0, const f32x16& p1) {
    float a = max3f(p0[0], p0[1], p1[0]), b = max3f(p0[2], p0[3], p1[1]); a = max3f(a, p1[2], p1[3]);
#pragma unroll
    for (int r = 4; r < 16; r += 4) { a = max3f(a, p0[r], p0[r + 1]); b = max3f(b, p0[r + 2], p0[r + 3]); a = max3f(a, p1[r], p1[r + 1]); b = max3f(b, p1[r + 2], p1[r + 3]); }
    const float m = max2f(a, b);
    auto rr = __builtin_amdgcn_permlane32_swap(__float_as_uint(m), __float_as_uint(m), false, false);
    return max2f(__uint_as_float(rr[0]), __uint_as_float(rr[1]));
}
__device__ __forceinline__ void pv(f32x16* o, int vb, bf16x8 pa0, bf16x8 pa1, bf16x8 pa2, bf16x8 pa3) {
#pragma unroll
    for (int d0 = 0; d0 < 2; ++d0) { s16x4 lo[4], hi[4];
#pragma unroll
        for (int ks = 0; ks < 4; ++ks) {
            asm volatile("ds_read_b64_tr_b16 %0,%1 offset:%c2" : "=&v"(lo[ks]) : "v"(vb), "i"(d0 * 4096 + ks * 1024) : "memory");
            asm volatile("ds_read_b64_tr_b16 %0,%1 offset:%c2" : "=&v"(hi[ks]) : "v"(vb), "i"(d0 * 4096 + ks * 1024 + 512) : "memory"); }
        asm volatile("s_waitcnt lgkmcnt(0)" ::: "memory"); SBAR();
#define PK(k) (bf16x8){lo[k][0], lo[k][1], lo[k][2], lo[k][3], hi[k][0], hi[k][1], hi[k][2], hi[k][3]}
        o[d0] = __builtin_amdgcn_mfma_f32_32x32x16_bf16(pa0, PK(0), o[d0], 0, 0, 0);
        o[d0] = __builtin_amdgcn_mfma_f32_32x32x16_bf16(pa1, PK(1), o[d0], 0, 0, 0);
        o[d0] = __builtin_amdgcn_mfma_f32_32x32x16_bf16(pa2, PK(2), o[d0], 0, 0, 0);
        o[d0] = __builtin_amdgcn_mfma_f32_32x32x16_bf16(pa3, PK(3), o[d0], 0, 0, 0);
#undef PK
    }
}
#define ATTN_STORE16(p, v) (*(u32x4*)(p) = (v))
template <int THRL> __device__ __forceinline__ void attn_unit(int b, int h, int qb, const bf16* Q, const bf16* __restrict__ K, const bf16* __restrict__ V, bf16* O, const unsigned* masks, char* shm) {
    const int tid = threadIdx.x, lane = tid & 63, r32 = lane & 31, hi = lane >> 5; const int wid = __builtin_amdgcn_readfirstlane(tid >> 6);
    const long rowbase = (long)b * SEQ; const int q0 = qb * QB;
    const bf16* Qw = Q + (rowbase + q0 + wid * QBLK) * QP + h * D;
    const bf16 *Kh = K + rowbase * KP + (h >> 2) * D, *Vh = V + rowbase * KP + (h >> 2) * D;
    const unsigned* mrow = masks + ((size_t)(b * (SEQ / 32) + (q0 >> 5) + wid) * (SEQ / 64)) * 64;
    const unsigned lds0 = (unsigned)(uintptr_t)shm;
    float* wsf = (float*)(shm + LDS_WS) + wid * 64;
    const bf16* ksrc = Kh + (long)lane * KP + wid * 8;
    const bf16* vsrc = Vh + (long)(16 * (wid & 3) + (lane >> 2)) * KP + (wid >> 2) * 32 + (lane & 3) * 8;
    const unsigned kdst = lds0 + LDS_K + wid * 1024, vdst = lds0 + LDS_V + wid * 1024;
#define DMA_K(t, slot) glds16(ksrc + (long)(t) * KVBLK * KP, (unsigned)__builtin_amdgcn_readfirstlane(kdst + (slot)))
#define DMA_V(t, slot) glds16(vsrc + (long)(t) * KVBLK * KP, (unsigned)__builtin_amdgcn_readfirstlane(vdst + (slot)))
    const int vb0 = (int)(lds0 + LDS_V) + ((lane >> 4) & 1) * 32 + (lane & 3) * 8 + (4 * hi + ((lane & 15) >> 2)) * 64;
    const char* Kbase = shm + LDS_K; bf16x8 kf[8];
    const lds_cptr shm3 = (lds_cptr)shm; const lds_cptr kp0 = shm3 + LDS_K + hi * 1024 + r32 * 16; const lds_cptr vp0 = shm3 + LDS_V + ((lane >> 4) & 1) * 32 + (lane & 3) * 8 + (4 * hi + ((lane & 15) >> 2)) * 64;
    const int NT = (q0 + QB) / KVBLK;
    u32x16 mA, mB;
#define MLOAD0(t) do { const unsigned* mp_ = mrow + (size_t)(t) * 64; \
        asm volatile("s_load_dwordx16 %0, %1, 0x0" : "=s"(mA) : "s"(mp_)); asm volatile("s_load_dwordx16 %0, %1, 0x40" : "=s"(mB) : "s"(mp_)); } while (0)
#define MLOAD1(t) do { const unsigned* mp_ = mrow + (size_t)(t) * 64; \
        asm volatile("s_load_dwordx16 %0, %1, 0x80" : "=s"(mA) : "s"(mp_)); asm volatile("s_load_dwordx16 %0, %1, 0xc0" : "=s"(mB) : "s"(mp_)); } while (0)
#define MPAIR(M, j) (((unsigned long long)(M)[2 * (j) + 1] << 32) | (unsigned long long)(M)[2 * (j)])
#define MAPPLY(P) do { asm volatile("s_waitcnt lgkmcnt(0)" : "+s"(mA), "+s"(mB)); const float NEG_ = -INFINITY; \
        _Pragma("unroll") for (int r = 0; r < 8; ++r) { P[r] = msel(P[r], NEG_, MPAIR(mA, r)); P[r + 8] = msel(P[r + 8], NEG_, MPAIR(mB, r)); } } while (0)
    DMA_K(0, 0); DMA_V(0, 0); DMA_K(1, SLOTB);
    MLOAD0(0);
    const lds_cptr qfp = shm3 + LDS_QF + wid * 4096 + lane * 16;
    { bf16x8 qr[4];
#pragma unroll
      for (int d0 = 0; d0 < 4; ++d0) qr[d0] = *reinterpret_cast<const bf16x8*>(&Qw[(long)r32 * QP + d0 * 16 + hi * 8]);
#pragma unroll
      for (int d0 = 0; d0 < 4; ++d0) *(LAS bf16x8*)(LAS char*)(qfp + d0 * 1024) = qr[d0]; }
#define QF(i) (*(const LAS bf16x8*)(qfp + (i) * 1024))
    float mhat = 0.f, l_reg = 0.f; f32x16 o[2]; o[0] = f32x16{}; o[1] = f32x16{}; f32x16 negm = f32x16{}; asm volatile("" : "+v"(negm));
    const int qrel = wid * QBLK + r32;
#define CMASK(P0, P1, t) do { int jb_ = (t) - (NT - 4); if (jb_ >= 0) cmask(P0, P1, jb_, qrel, hi); } while (0)
    bool resc = false;
#define START(P0, P1) do { const float rm = rowmax(P0, P1); resc = false; \
    { const float dl = rm; mhat = fadd_s(mhat, dl); \
      _Pragma("unroll") for (int r = 0; r < 16; ++r) { P0[r] = fsub_s(P0[r], dl); P1[r] = fsub_s(P1[r], dl); } \
      _Pragma("unroll") for (int r = 0; r < 16; ++r) negm[r] = -mhat; asm volatile("" : "+v"(negm)); } } while (0)
#define RESC() do { if (resc) { asm volatile("s_waitcnt lgkmcnt(0)" ::: "memory"); \
      _Pragma("unroll") for (int d_ = 0; d_ < 2; ++d_) _Pragma("unroll") for (int r = 0; r < 16; ++r) o[d_][r] *= wsf[crow(r, hi)]; } } while (0)
    f32x16 pA0, pA1, pB0, pB1;
    int sl_prev = 0, sl_cur = 0, sl_next = SLOTB;
#define ROT() do { sl_prev = sl_cur; sl_cur = sl_next; sl_next = (sl_next == (NSLOT - 1) * SLOTB) ? 0 : sl_next + SLOTB; } while (0)
    DMA_K(2, 2 * SLOTB);
    WAIT_BAR(3);
    qkt(pA0, pA1, Kbase, qfp, negm, r32, hi); asm volatile("s_nop 15\n\ts_nop 7" : "+v"(pA0), "+v"(pA1)); CMASK(pA0, pA1, 0);
    START(pA0, pA1);
    MAPPLY(pA0); MLOAD1(0); MAPPLY(pA1); MLOAD0(1);
    _Pragma("unroll") for (int r = 0; r < 16; ++r) { pA0[r] = __builtin_amdgcn_exp2f(pA0[r]); pA1[r] = __builtin_amdgcn_exp2f(pA1[r]); }
    WAIT_BAR(0);
    DMA_K(3, 0); DMA_V(1, SLOTB);
    ROT();
    kload8(kf, kp0 + sl_cur);
    WAIT_BAR(2);
    s16x4 vlo[8], vhi[8]; u32x4 pw0, pw1, pw2, pw3;
#define PKW(P, B) cvtpk_s(P[B], P[B + 1])
#define PAF(k) __builtin_bit_cast(bf16x8, pw##k)
#define VFR(i) (bf16x8){vlo[i][0], vlo[i][1], vlo[i][2], vlo[i][3], vhi[i][0], vhi[i][1], vhi[i][2], vhi[i][3]}
#define PIN(x) asm volatile("" : "+v"(x))
#define MX3(a, b, c) __builtin_fmaxf(__builtin_fmaxf((a), (b)), (c))
#define GAPA(MF, A0, A1, A2, A3, W0, W1, PW) do { MF; sacc += A0; sacc += A1; sacc += A2; sacc += A3; PIN(sacc); W0; W1; PIN(PW); SBAR(); } while (0)
#define EX(v) __builtin_amdgcn_exp2f(v)
#define GAPB(MF, X, B) do { MF; X[B] = EX(X[B]); X[B + 1] = EX(X[B + 1]); X[B + 2] = EX(X[B + 2]); X[B + 3] = EX(X[B + 3]); PIN(X); SBAR(); } while (0)
#define VRD(i) do { vlo[i] = vtr(vp_ + (((i) >> 2) * 4096 + ((i) & 3) * 1024)); vhi[i] = vtr(vp_ + (((i) >> 2) * 4096 + ((i) & 3) * 1024 + 512)); } while (0)
#define KRD(G, j) do { if (G) { kload2(kf, kp0 + sl_next, j); SBAR(); } } while (0)
#define STEP(C0, C1, P0, P1, t, GK, GV, GL, GM) do { SBAR(); \
    const lds_cptr vp_ = vp0 + sl_prev; \
    VRD(0); bf16x8 qa_ = QF(0), qb_ = QF(1); SBAR(); float sacc = (P0[0] + P0[1]); \
    GAPA(C0 = __builtin_amdgcn_mfma_f32_32x32x16_bf16(kf[0], qa_, negm, 0, 0, 0), P0[2], P0[3], P0[4], P0[5],     pw0[0] = PKW(P0, 0), pw0[1] = PKW(P0, 2), pw0); \
    VRD(4); SBAR(); GAPA(C1 = __builtin_amdgcn_mfma_f32_32x32x16_bf16(kf[1], qa_, negm, 0, 0, 0), P0[6], P0[7], P0[8], P0[9],     pw0[2] = PKW(P0, 4), pw0[3] = PKW(P0, 6), pw0); \
    VRD(1); qa_ = QF(2); SBAR(); GAPA(C0 = __builtin_amdgcn_mfma_f32_32x32x16_bf16(kf[2], qb_, C0, 0, 0, 0),   P0[10], P0[11], P0[12], P0[13], pw1[0] = PKW(P0, 8), pw1[1] = PKW(P0, 10), pw1); \
    VRD(5); SBAR(); GAPA(C1 = __builtin_amdgcn_mfma_f32_32x32x16_bf16(kf[3], qb_, C1, 0, 0, 0),   P0[14], P0[15], P1[0], P1[1],   pw1[2] = PKW(P0, 12), pw1[3] = PKW(P0, 14), pw1); \
    VRD(2); qb_ = QF(3); SBAR(); GAPA(C0 = __builtin_amdgcn_mfma_f32_32x32x16_bf16(kf[4], qa_, C0, 0, 0, 0),   P1[2], P1[3], P1[4], P1[5],     pw2[0] = PKW(P1, 0), pw2[1] = PKW(P1, 2), pw2); \
    VRD(6); SBAR(); GAPA(C1 = __builtin_amdgcn_mfma_f32_32x32x16_bf16(kf[5], qa_, C1, 0, 0, 0),   P1[6], P1[7], P1[8], P1[9],     pw2[2] = PKW(P1, 4), pw2[3] = PKW(P1, 6), pw2); \
    VRD(3); SBAR(); GAPA(C0 = __builtin_amdgcn_mfma_f32_32x32x16_bf16(kf[6], qb_, C0, 0, 0, 0),   P1[10], P1[11], P1[12], P1[13], pw3[0] = PKW(P1, 8), pw3[1] = PKW(P1, 10), pw3); \
    VRD(7); SBAR(); GAPA(C1 = __builtin_amdgcn_mfma_f32_32x32x16_bf16(kf[7], qb_, C1, 0, 0, 0),   P1[14], P1[15], 0.f, 0.f,       pw3[2] = PKW(P1, 12), pw3[3] = PKW(P1, 14), pw3); \
    l_reg += sacc; \
    if (GK) { DMA_K((t) + 3, sl_cur); } if (GV) { DMA_V((t) + 1, sl_next); } \
    CMASK(C0, C1, t); \
    { float a = MX3(C0[0], C0[1], C1[0]), b = MX3(C0[2], C0[3], C1[1]); a = MX3(a, C1[2], C1[3]); \
      _Pragma("unroll") for (int r = 4; r < 16; r += 4) { a = MX3(a, C0[r], C0[r + 1]); b = MX3(b, C0[r + 2], C0[r + 3]); a = MX3(a, C1[r], C1[r + 1]); b = MX3(b, C1[r + 2], C1[r + 3]); } \
      float rm = __builtin_fmaxf(a, b); { auto rr = __builtin_amdgcn_permlane32_swap(__float_as_uint(rm), __float_as_uint(rm), false, false); rm = __builtin_fmaxf(__uint_as_float(rr[0]), __uint_as_float(rr[1])); } \
      resc = false; \
      if (__builtin_expect(__any(rm > (float)THRL), 0)) { const float dl = __builtin_fmaxf(rm, 0.f); mhat += dl; \
        _Pragma("unroll") for (int r = 0; r < 16; ++r) { C0[r] -= dl; C1[r] -= dl; } \
        _Pragma("unroll") for (int r = 0; r < 16; ++r) negm[r] = -mhat; asm volatile("" : "+v"(negm)); \
        const float f = __builtin_amdgcn_exp2f(-dl); l_reg *= f; if (hi == 0) wsf[r32] = f; resc = true; } } \
    MAPPLY(C0); MLOAD1(t); \
    SBAR(); \
    GAPB(o[0] = __builtin_amdgcn_mfma_f32_32x32x16_bf16(PAF(0), VFR(0), o[0], 0, 0, 0), C0, 0); \
    GAPB(o[1] = __builtin_amdgcn_mfma_f32_32x32x16_bf16(PAF(0), VFR(4), o[1], 0, 0, 0), C0, 4); \
    KRD(GL, 0); GAPB(o[0] = __builtin_amdgcn_mfma_f32_32x32x16_bf16(PAF(1), VFR(1), o[0], 0, 0, 0), C0, 8); \
    KRD(GL, 1); GAPB(o[1] = __builtin_amdgcn_mfma_f32_32x32x16_bf16(PAF(1), VFR(5), o[1], 0, 0, 0), C0, 12); \
    MAPPLY(C1); if (GM) { MLOAD0((t) + 1); } SBAR(); \
    KRD(GL, 2); GAPB(o[0] = __builtin_amdgcn_mfma_f32_32x32x16_bf16(PAF(2), VFR(2), o[0], 0, 0, 0), C1, 0); \
    KRD(GL, 3); GAPB(o[1] = __builtin_amdgcn_mfma_f32_32x32x16_bf16(PAF(2), VFR(6), o[1], 0, 0, 0), C1, 4); \
    GAPB(o[0] = __builtin_amdgcn_mfma_f32_32x32x16_bf16(PAF(3), VFR(3), o[0], 0, 0, 0), C1, 8); \
    GAPB(o[1] = __builtin_amdgcn_mfma_f32_32x32x16_bf16(PAF(3), VFR(7), o[1], 0, 0, 0), C1, 12); \
    } while (0)
    int t = 1;
#undef CMASK
#define CMASK(P0, P1, t) do { } while (0)
    for (; t + 5 < NT; t += 2) {
        STEP(pB0, pB1, pA0, pA1, t, true, true, true, true);     WAIT_BAR(2); RESC(); ROT();
        STEP(pA0, pA1, pB0, pB1, t + 1, true, true, true, true); WAIT_BAR(2); RESC(); ROT();
    }
#undef CMASK
#define CMASK(P0, P1, t) do { int jb_ = (t) - (NT - 4); if (jb_ >= 0) cmask(P0, P1, jb_, qrel, hi); } while (0)
#define ENDW(tt) do { if ((tt) + 3 < NT) { WAIT_BAR(2); } else if ((tt) + 2 < NT) { WAIT_BAR(1); } else { WAIT_BAR(0); } } while (0)
    for (; t + 1 < NT; t += 2) {
        STEP(pB0, pB1, pA0, pA1, t, (t + 3 < NT), (t + 1 < NT), (t + 1 < NT), (t + 1 < NT));         ENDW(t);     RESC(); ROT();
        STEP(pA0, pA1, pB0, pB1, t + 1, (t + 4 < NT), (t + 2 < NT), (t + 2 < NT), (t + 2 < NT));     ENDW(t + 1); RESC(); ROT();
    }
    STEP(pB0, pB1, pA0, pA1, NT - 1, false, false, false, false); RESC();
    { float sacc = pB0[0] + pB0[1]; _Pragma("unroll") for (int r = 2; r < 16; ++r) sacc += pB0[r]; _Pragma("unroll") for (int r = 0; r < 16; ++r) sacc += pB1[r]; l_reg += sacc;
      pw0 = (u32x4){PKW(pB0, 0), PKW(pB0, 2), PKW(pB0, 4), PKW(pB0, 6)}; pw1 = (u32x4){PKW(pB0, 8), PKW(pB0, 10), PKW(pB0, 12), PKW(pB0, 14)}; pw2 = (u32x4){PKW(pB1, 0), PKW(pB1, 2), PKW(pB1, 4), PKW(pB1, 6)}; pw3 = (u32x4){PKW(pB1, 8), PKW(pB1, 10), PKW(pB1, 12), PKW(pB1, 14)};
      SBAR(); pv(o, vb0 + sl_cur, PAF(0), PAF(1), PAF(2), PAF(3)); }
#undef PKW
#undef PAF
#undef VFR
#undef PIN
#undef MX3
#undef GAPA
#undef GAPB
#undef EX
#undef VRD
#undef KRD
#undef STEP
#undef ENDW
    { auto rr = __builtin_amdgcn_permlane32_swap(__float_as_uint(l_reg), __float_as_uint(l_reg), false, false); l_reg = __uint_as_float(rr[0]) + __uint_as_float(rr[1]); }
    if (hi == 0) wsf[32 + r32] = l_reg; asm volatile("s_waitcnt lgkmcnt(0)" ::: "memory");
    float rli[16];
#pragma unroll
    for (int r = 0; r < 16; ++r) rli[r] = __builtin_amdgcn_rcpf(wsf[32 + crow(r, hi)]);
    bf16* Ow = O + (rowbase + q0 + wid * QBLK) * OP + OCOL + h * D;
    { bf16* stg = (bf16*)(shm + LDS_OST) + wid * 2048;
#pragma unroll
      for (int r = 0; r < 16; ++r) { const int orow = crow(r, hi);
#pragma unroll
        for (int d0 = 0; d0 < 2; ++d0) stg[orow * 64 + d0 * 32 + r32] = __float2bfloat16(o[d0][r] * rli[r]); }
      asm volatile("s_waitcnt lgkmcnt(0)" ::: "memory");
#pragma unroll
      for (int i = 0; i < 4; ++i) { const int row = i * 8 + (lane >> 3), ch = lane & 7; const u32x4 v = *(const u32x4*)(stg + row * 64 + ch * 8); ATTN_STORE16(Ow + (long)row * OP + ch * 8, v); } }
    asm volatile("s_waitcnt lgkmcnt(0)\n\ts_barrier" ::: "memory");
#undef DMA_K
#undef DMA_V
#undef CMASK
#undef START
#undef RESC
#undef ROT
#undef MLOAD0
#undef MLOAD1
#undef MPAIR
#undef QF
#undef MAPPLY
}
#undef SBAR
#undef WAIT_BAR
}

#define XB_TMO      128
#define XB_XCNT(j)  (256  + 64 * (j))
#define XB_XSUB(j)  (1280 + 64 * (j))
#define XB_XGEN(j)  (2304 + 64 * (j))
#define XB_TOP      3328
#define XB_TOPGEN   3392
#define XCD_BAR_WORDS 3456
#define XB_SPIN_CAP (1u << 18)
__device__ __forceinline__ unsigned xb_ld(unsigned* p)              { return __hip_atomic_load(p, __ATOMIC_RELAXED, __HIP_MEMORY_SCOPE_AGENT); }
__device__ __forceinline__ unsigned xb_add(unsigned* p, unsigned v) { return __hip_atomic_fetch_add(p, v, __ATOMIC_RELAXED, __HIP_MEMORY_SCOPE_AGENT); }
__device__ __forceinline__ unsigned xb_xcc_id() { return (unsigned)__builtin_amdgcn_s_getreg((3 << 11) | 20) & 0xFu; }
#define XB_SPIN(cond, bar) do { unsigned _sp = 0; while (cond) { __builtin_amdgcn_s_sleep(1); \
    if ((++_sp & 255u) == 0u) { if (xb_ld(&(bar)[XB_TMO])) break; if (_sp > XB_SPIN_CAP) { atomicAdd(&(bar)[XB_TMO], 1u); break; } } } } while (0)
struct XcdBarrier { unsigned* bar; unsigned x; volatile LAS unsigned* st; };
__device__ __forceinline__ XcdBarrier xcd_barrier_post(unsigned* bar, volatile LAS unsigned* st) {
    XcdBarrier b; b.bar = bar; b.x = xb_xcc_id(); b.st = st;
    if (threadIdx.x == 0) (void)xb_add(&bar[XB_XCNT(b.x)], 1u);
    return b;
}
__device__ __forceinline__ void xcd_barrier_complete(unsigned* bar, unsigned x, unsigned& nloc, unsigned& nx) {
    const unsigned G = gridDim.x * gridDim.y * gridDim.z;
    unsigned sum, cnt, mine, sp = 0u;
    for (;;) {
        sum = 0u; cnt = 0u; mine = 0u;
#pragma unroll
        for (unsigned j = 0; j < 16; ++j) { const unsigned c = xb_ld(&bar[XB_XCNT(j)]); sum += c; cnt += (c > 0u) ? 1u : 0u; mine = (j == x) ? c : mine; }
        if (sum == G) break;
        __builtin_amdgcn_s_sleep(1);
        if ((++sp & 255u) == 0u) { if (xb_ld(&bar[XB_TMO])) break; if (sp > XB_SPIN_CAP) { atomicAdd(&bar[XB_TMO], 1u); break; } }
    }
    nloc = mine > 0u ? mine : 1u; nx = cnt > 0u ? cnt : 1u;
}
__device__ __forceinline__ void xcd_barrier(const XcdBarrier& b) {
    asm volatile("s_waitcnt vmcnt(0)" ::: "memory");
    __syncthreads();
    if (threadIdx.x == 0) {
        unsigned* bar = b.bar;
        __builtin_amdgcn_s_waitcnt(0);
        unsigned nloc = b.st[0], nx = b.st[1];
        if (nloc == 0u) { xcd_barrier_complete(bar, b.x, nloc, nx); b.st[0] = nloc; b.st[1] = nx; }
        const unsigned old = xb_add(&bar[XB_XSUB(b.x)], 1u);
        const unsigned gen = old / nloc;
        if (old + 1u == (gen + 1u) * nloc) {
            __builtin_amdgcn_fence(__ATOMIC_RELEASE, "agent");
            asm volatile("s_waitcnt vmcnt(0)" ::: "memory");
            const unsigned og = xb_add(&bar[XB_TOP], 1u);
            const unsigned tg = og / nx;
            if (og + 1u == (tg + 1u) * nx) xb_add(&bar[XB_TOPGEN], 1u);
            else XB_SPIN(xb_ld(&bar[XB_TOPGEN]) == tg, bar);
            __builtin_amdgcn_fence(__ATOMIC_ACQUIRE, "agent");
            xb_add(&bar[XB_XGEN(b.x)], 1u);
            asm volatile("s_waitcnt vmcnt(0)" ::: "memory");
        } else {
            XB_SPIN(xb_ld(&bar[XB_XGEN(b.x)]) == gen, bar);
            __builtin_amdgcn_fence(__ATOMIC_ACQUIRE, "agent");
            asm volatile("s_waitcnt vmcnt(0)" ::: "memory");
        }
    }
    __syncthreads();
}

struct Frame {
    LAS unsigned char* lds; volatile LAS unsigned* MISC; unsigned* ctl;
    int tid, lane, wave, vcu, G;
    unsigned char* ws;
};
struct Args { const float* in[18]; float* out; unsigned char* ws; int ph_lo, ph_hi, flags, pad; };
typedef const __attribute__((address_space(4))) Args* KArgs;
__device__ __forceinline__ KArgs kargs() { KArgs p = (KArgs)__builtin_amdgcn_kernarg_segment_ptr(); asm volatile("" : "+s"(p)); return p; }

__device__ __forceinline__ int ropeperm(int d) { return d < 8 ? 2 * d : (d < 16 ? 2 * (d - 8) + 1 : d); }
__device__ __forceinline__ int win_row(int c) {
    if (c < 512)  return (c & ~63) + ropeperm(c & 63);
    if (c < 640)  { const int cc = c - 512; return 512 + (cc & ~63) + ropeperm(cc & 63); }
    if (c < 768)  return c;
    if (c < 1280) { const int cc = c - 768; return 768 + (cc & ~63) + ropeperm(cc & 63); }
    if (c < 1344) return 1280 + ropeperm(c - 1280);
    if (c < 1352) return c;
    if (c < 1864) { const int ch = c - 1352; return 1536 + (ch >> 7) * 256 + (ch & 127); }
    if (c < 2376) return 2560 + (c - 1864);
    if (c < 2888) { const int ch = c - 2376; return 1536 + (ch >> 7) * 256 + 128 + (ch & 127); }
    { const int g = c - 2888, gi = g & 1023; return 3072 + (gi >> 7) * 256 + (g >> 10) * 128 + (gi & 127); }
}
struct TItem { const float* src; bf16_t* WT; int N, KT, rbase, mode, n0, k0, kd; };
__device__ __forceinline__ void t_load(const TItem& t, float (&rg)[32], int lane) {
    int nn = t.n0 + (lane & 31); if (nn >= t.N) nn = t.N - 1;
    const float* p = t.src + (size_t)(t.k0 + (lane >> 5)) * t.N + nn;
#pragma unroll
    for (int i = 0; i < 32; ++i) rg[i] = p[(size_t)(2 * i) * t.N];
}
__device__ __forceinline__ void t_write(const TItem& t, const float (&rg)[32], LAS float* scr, int lane) {
#pragma unroll
    for (int i = 0; i < 32; ++i) scr[(2 * i + (lane >> 5)) * 33 + (lane & 31)] = rg[i];
    LDS_WAIT(); asm volatile("" ::: "memory");
    if (t.mode >= 3) {
        const int c4 = lane & 3;
#pragma unroll
        for (int j = 0; j < 2; ++j) { const int n = (lane >> 2) + 16 * j; const LAS float* sp = scr + (16 * c4) * 33 + n;
            if (t.n0 + n < t.N) { const int nn = t.n0 + n; const int row = t.mode == 3 ? t.rbase + (nn >> 7) * 256 + (nn & 127) : t.rbase + nn;
                u32x4 o;
#pragma unroll
                for (int q = 0; q < 4; ++q) { int wv = 0;
                    wv = __builtin_amdgcn_cvt_pk_fp8_f32(32.f * sp[(4 * q + 0) * 33], 32.f * sp[(4 * q + 1) * 33], wv, false);
                    wv = __builtin_amdgcn_cvt_pk_fp8_f32(32.f * sp[(4 * q + 2) * 33], 32.f * sp[(4 * q + 3) * 33], wv, true); o[q] = (unsigned)wv; }
                *(u32x4*)((unsigned char*)t.WT + (size_t)row * t.KT + t.k0 + 16 * c4) = o; } }
        LDS_WAIT(); asm volatile("" ::: "memory");
        return;
    }
    const int c = lane & 7;
#pragma unroll
    for (int j = 0; j < 4; ++j) { const int n = (lane >> 3) + 8 * j; const LAS float* sp = scr + (8 * c) * 33 + n;
        if (t.n0 + n < t.N) { const int nn = t.n0 + n; const int row = t.mode == 0 ? t.rbase + nn : (t.mode == 1 ? win_row(nn) : t.rbase + (nn >> 7) * 256 + (nn & 127));
            u32x4 o; o.x = pkbf(sp[0 * 33], sp[1 * 33]); o.y = pkbf(sp[2 * 33], sp[3 * 33]); o.z = pkbf(sp[4 * 33], sp[5 * 33]); o.w = pkbf(sp[6 * 33], sp[7 * 33]);
            *(u32x4*)(t.WT + (size_t)row * t.KT + t.kd + t.k0 + 8 * c) = o; } }
    LDS_WAIT(); asm volatile("" ::: "memory");
}
__device__ __forceinline__ void p0_prologue(Frame& F) {
    const KArgs ka = kargs();
    unsigned char* ws = F.ws;
    LAS float* scr = (LAS float*)(F.lds + F.wave * 16384);
    const int gw = F.vcu * NWAVES + F.wave, NGW = F.G * NWAVES;
    const int gt = F.vcu * 512 + F.tid, NGT = F.G * 512;
    bf16_t* Win = (bf16_t*)(ws + WS_WIN); bf16_t* Wau = (bf16_t*)(ws + WS_WAU); bf16_t* Wout = (bf16_t*)(ws + WS_WOUT);
    bf16_t* Wd = (bf16_t*)(ws + WS_WD); bf16_t* Wgu = (bf16_t*)(ws + WS_WGU);
    constexpr int I_IN = 16 * 155, I_AU = 8 * 32, I_OUT = 16 * 32, I_G = 32 * 16 * 16, I_D = 32 * 8 * 32;
    constexpr int NITEMS = I_IN + 2 * I_AU + I_OUT + 2 * I_G + I_D;
    const float *p_win = ka->in[1], *p_wau = ka->in[3], *p_wcu = ka->in[4], *p_wout = ka->in[6], *p_wg = ka->in[13], *p_wu = ka->in[14], *p_wd = ka->in[15];
#define T_DECODE(IT, T) do { int r_ = (IT); \
        if (r_ < I_IN) { T = TItem{p_win, Win, INW, 1024, 0, 1, 32 * (r_ % 155), 64 * (r_ / 155), 0}; } else { r_ -= I_IN; \
        if (r_ < I_AU) { T = TItem{p_wau, Wau, 1024, 1024, 0, 0, 32 * (r_ % 32), 64 * (r_ / 32), 512};     } else { r_ -= I_AU; \
        if (r_ < I_AU) { T = TItem{p_wcu, Wau, 1024, 1024, 0, 0, 32 * (r_ % 32), 64 * (r_ / 32), 0}; } else { r_ -= I_AU; \
        if (r_ < I_OUT) { T = TItem{p_wout, Wout, 1024, 1024, 0, 0, 32 * (r_ % 32), 64 * (r_ / 32), 0}; } else { r_ -= I_OUT; \
        if (r_ < I_G) { const int e_ = r_ >> 8, q_ = r_ & 255; T = TItem{p_wg + (size_t)e_ * 1024 * 512, Wgu, 512, 1024, e_ * 1024, 3, 32 * (q_ & 15), 64 * (q_ >> 4), 0}; } else { r_ -= I_G; \
        if (r_ < I_G) { const int e_ = r_ >> 8, q_ = r_ & 255; T = TItem{p_wu + (size_t)e_ * 1024 * 512, Wgu, 512, 1024, e_ * 1024 + 128, 3, 32 * (q_ & 15), 64 * (q_ >> 4), 0}; } else { r_ -= I_G; \
        { const int e_ = r_ >> 8, q_ = r_ & 255; T = TItem{p_wd + (size_t)e_ * 512 * 1024, Wd, 1024, 512, e_ * 1024, 4, 32 * (q_ & 31), 64 * (q_ >> 5), 0}; } } } } } } } } while (0)
    const int nitems = (F.G == 256) ? I_IN + 2 * I_AU + I_OUT : NITEMS;
    if (gw < nitems) {
        TItem cur, nxt; float rc[32], rn[32];
        T_DECODE(gw, cur); t_load(cur, rc, F.lane);
        for (int it = gw; it < nitems; it += NGW) {
            const int itn = (it + NGW < nitems) ? it + NGW : it;
            T_DECODE(itn, nxt); t_load(nxt, rn, F.lane);
            t_write(cur, rc, scr, F.lane);
            cur = nxt;
#pragma unroll
            for (int i = 0; i < 32; ++i) rc[i] = rn[i];
        }
    }
#undef T_DECODE
    for (int i = gt; i < 184 * 128; i += NGT) *(u32x4*)(Win + (size_t)1352 * 1024 + (size_t)i * 8) = (u32x4){0u, 0u, 0u, 0u};
    float* rope = (float*)(ws + WS_ROPE);
    for (int i = gt; i < SEQ * 8; i += NGT) { const int pos = i >> 3, j = i & 7;
        const float inv = (float)pow(500000.0, -(double)j / 8.0); const float ang = (float)pos * inv;
        rope[i] = cosf(ang); rope[SEQ * 8 + i] = sinf(ang); }
    { float* wc = (float*)(ws + WS_WC); const float* rgw = ka->in[9]; const float* rew = ka->in[11];
      for (int i = gt; i < 1024 * 48; i += NGT) { const int k = i / 48, c = i % 48;
          wc[i] = c < 4 ? rgw[k * 4 + c] : (c < 36 ? rew[(size_t)((c - 4) >> 3) * 1024 * 8 + k * 8 + ((c - 4) & 7)] : 0.f); } }
    const float* x = ka->in[0]; bf16_t* xb = (bf16_t*)(ws + WS_XB);
    for (size_t i = gt; i < (size_t)NTOK * DM / 8; i += (size_t)NGT * 4) {
        f32x4 va[4], vb[4];
#pragma unroll
        for (int q = 0; q < 4; ++q) { size_t ii = i + (size_t)q * NGT; if (ii >= (size_t)NTOK * DM / 8) ii = i; va[q] = *(const f32x4*)(x + ii * 8); vb[q] = *(const f32x4*)(x + ii * 8 + 4); }
#pragma unroll
        for (int q = 0; q < 4; ++q) { const size_t ii = i + (size_t)q * NGT; if (ii < (size_t)NTOK * DM / 8) store8bf(xb + ii * 8, va[q], vb[q]); } }
}

__device__ __forceinline__ int dpp_sum_i(int v) {
    v += __builtin_amdgcn_update_dpp(0, v, 0x111, 0xf, 0xf, true); v += __builtin_amdgcn_update_dpp(0, v, 0x112, 0xf, 0xf, true);
    v += __builtin_amdgcn_update_dpp(0, v, 0x114, 0xf, 0xf, true); v += __builtin_amdgcn_update_dpp(0, v, 0x118, 0xf, 0xf, true);
    return __builtin_amdgcn_readlane(v, 15) + __builtin_amdgcn_readlane(v, 31) + __builtin_amdgcn_readlane(v, 47) + __builtin_amdgcn_readlane(v, 63);
}
__device__ __forceinline__ float dpp_shr_f(float v, int ctrl_sel) {
    const int vi = __float_as_int(v);
    return __int_as_float(ctrl_sel == 1 ? __builtin_amdgcn_update_dpp(vi, vi, 0x111, 0xf, 0xf, false) : ctrl_sel == 2 ? __builtin_amdgcn_update_dpp(vi, vi, 0x112, 0xf, 0xf, false)
                        : ctrl_sel == 4 ? __builtin_amdgcn_update_dpp(vi, vi, 0x114, 0xf, 0xf, false) : __builtin_amdgcn_update_dpp(vi, vi, 0x118, 0xf, 0xf, false));
}
__device__ __forceinline__ float dpp_max_f(float v) {
    v = fmaxf(v, dpp_shr_f(v, 1)); v = fmaxf(v, dpp_shr_f(v, 2)); v = fmaxf(v, dpp_shr_f(v, 4)); v = fmaxf(v, dpp_shr_f(v, 8));
    const float a = __int_as_float(__builtin_amdgcn_readlane(__float_as_int(v), 15)), b = __int_as_float(__builtin_amdgcn_readlane(__float_as_int(v), 31));
    const float c = __int_as_float(__builtin_amdgcn_readlane(__float_as_int(v), 47)), d = __int_as_float(__builtin_amdgcn_readlane(__float_as_int(v), 63));
    return fmaxf(fmaxf(a, b), fmaxf(c, d));
}
__device__ __forceinline__ float dpp_min_f(float v) { return -dpp_max_f(-v); }
__device__ __forceinline__ float dpp_sum_f(float v) {
    v += __int_as_float(__builtin_amdgcn_update_dpp(0, __float_as_int(v), 0x111, 0xf, 0xf, true)); v += __int_as_float(__builtin_amdgcn_update_dpp(0, __float_as_int(v), 0x112, 0xf, 0xf, true));
    v += __int_as_float(__builtin_amdgcn_update_dpp(0, __float_as_int(v), 0x114, 0xf, 0xf, true)); v += __int_as_float(__builtin_amdgcn_update_dpp(0, __float_as_int(v), 0x118, 0xf, 0xf, true));
    const float a = __int_as_float(__builtin_amdgcn_readlane(__float_as_int(v), 15)), b = __int_as_float(__builtin_amdgcn_readlane(__float_as_int(v), 31));
    const float c = __int_as_float(__builtin_amdgcn_readlane(__float_as_int(v), 47)), d = __int_as_float(__builtin_amdgcn_readlane(__float_as_int(v), 63));
    return (a + b) + (c + d);
}
template <int NC>
__device__ __forceinline__ void select_token(const LAS float* srow, int t, int lane, unsigned tbit, LAS unsigned* maskw) {
    if (t < 256) {
#pragma unroll
        for (int c = 0; c < (NC < 4 ? NC : 4); ++c) if (64 * c + lane <= t) (void)__hip_atomic_fetch_or(maskw + 64 * c + lane, tbit, __ATOMIC_RELAXED, __HIP_MEMORY_SCOPE_WORKGROUP);
        return;
    }
    float x[NC];
#pragma unroll
    for (int c = 0; c < NC; ++c) x[c] = srow[64 * c + lane];
#pragma unroll
    for (int c = 4; c < NC; ++c) if (64 * c + 63 > t) x[c] = (64 * c + lane <= t) ? x[c] : -INFINITY;
    float mn = fminf(fminf(x[0], x[1]), fminf(x[2], x[3])), mx = -INFINITY;
#pragma unroll
    for (int c = 0; c < NC; ++c) mx = fmaxf(mx, x[c]);
    mn = dpp_min_f(mn);
    float lo = mn - (fabsf(mn) * 1e-6f + 1e-30f), hi = dpp_max_f(mx);
    const float BIGF = 0x1p100f;
#define COUNT_GT(P, OUT) do { const float nb1_ = -(P) * BIGF; const f32x2 nb_ = {nb1_, nb1_}, bg_ = {BIGF, BIGF}; f32x2 a0_ = {0.f, 0.f}, a1_ = {0.f, 0.f}, a2_ = {0.f, 0.f}, a3_ = {0.f, 0.f}; \
        _Pragma("unroll") for (int c = 0; c < NC; c += 8) { f32x2 y_[4]; \
            _Pragma("unroll") for (int e = 0; e < 4; ++e) { const f32x2 xx_ = {x[c + 2 * e], x[c + 2 * e + 1]}; asm("v_pk_fma_f32 %0, %1, %2, %3 clamp" : "=v"(y_[e]) : "v"(xx_), "v"(bg_), "v"(nb_)); } \
            a0_ += y_[0]; a1_ += y_[1]; a2_ += y_[2]; a3_ += y_[3]; } \
        const f32x2 s2_ = (a0_ + a1_) + (a2_ + a3_); OUT = (int)(dpp_sum_f(s2_[0] + s2_[1]) + 0.5f); } while (0)
    float tau = hi; int need = 256; bool exact = false;
#ifndef PROBE_SEL
#define PROBE_SEL 0
#endif
    {
        float glo = (float)(t + 1) - 255.5f, ghi = -255.5f; int side = 0;
        for (int it = 0; it < 200; ++it) {
            float p = lo + (hi - lo) * (glo * __builtin_amdgcn_rcpf(glo - ghi));
            if (it >= 48 || !(p > lo) || !(p < hi)) p = lo + (hi - lo) * 0.5f;
            if (!(p > lo) || !(p < hi)) break;
            int cm; COUNT_GT(p, cm);
            if (cm == 256) { tau = p; exact = true; break; }
            if (cm > 256) { lo = p; glo = (float)cm - 255.5f; if (side < 0) ghi *= 0.5f; side = -1; }
            else { hi = p; ghi = (float)cm - 255.5f; if (side > 0) glo *= 0.5f; side = 1; }
        }
        if (!exact) { tau = hi; int g; COUNT_GT(hi, g); need = 256 - g; }
    }
#undef COUNT_GT
    if (exact) {
#pragma unroll
        for (int c = 0; c < NC; ++c) (void)__hip_atomic_fetch_or(maskw + 64 * c + lane, (x[c] > tau) ? tbit : 0u, __ATOMIC_RELAXED, __HIP_MEMORY_SCOPE_WORKGROUP);
    } else {
        int base = 0;
#pragma unroll
        for (int c = 0; c < NC; ++c) {
            const bool gt = x[c] > tau, eq = x[c] == tau;
            const unsigned long long tb = __ballot(eq);
            const int rank = base + (int)__builtin_amdgcn_mbcnt_hi((unsigned)(tb >> 32), __builtin_amdgcn_mbcnt_lo((unsigned)tb, 0u));
            base += __popcll(tb);
            if (gt || (eq && rank < need)) (void)__hip_atomic_fetch_or(maskw + 64 * c + lane, tbit, __ATOMIC_RELAXED, __HIP_MEMORY_SCOPE_WORKGROUP);
        }
    }
}
struct XItem { const float* src; unsigned char* dst; int N; };
__device__ __forceinline__ XItem x_decode(int id, int lane, const float* wg, const float* wu, const float* wd, unsigned char* Wgu8, unsigned char* Wd8) {
    const int m = id >> 13, r = id & 8191, e = r >> 8, q = r & 255; XItem t;
    if (m < 2) { const int kb = q >> 3, nb = q & 7, n = nb * 64 + lane;
        t.src = (m == 0 ? wg : wu) + (size_t)e * 1024 * 512 + (size_t)(kb * 32) * 512 + n; t.N = 512;
        t.dst = Wgu8 + (size_t)(e * 1024 + (n >> 7) * 256 + m * 128 + (n & 127)) * 1024 + kb * 32; }
    else { const int kb = q >> 4, nb = q & 15, n = nb * 64 + lane;
        t.src = wd + (size_t)e * 512 * 1024 + (size_t)(kb * 32) * 1024 + n; t.N = 1024;
        t.dst = Wd8 + (size_t)(e * 1024 + n) * 512 + kb * 32; }
    return t;
}
__device__ __forceinline__ void x_load(const XItem& t, float (&rg)[32]) {
#pragma unroll
    for (int i = 0; i < 32; ++i) rg[i] = t.src[(size_t)i * t.N];
}
__device__ __forceinline__ void x_store(const XItem& t, float (&rg)[32]) {
#pragma unroll
    for (int i = 0; i < 32; ++i) asm volatile("" : "+v"(rg[i]));
    u32x4 o0, o1;
#pragma unroll
    for (int q = 0; q < 4; ++q) { int w0 = 0, w1 = 0;
        w0 = __builtin_amdgcn_cvt_pk_fp8_f32(32.f * rg[4 * q], 32.f * rg[4 * q + 1], w0, false); w0 = __builtin_amdgcn_cvt_pk_fp8_f32(32.f * rg[4 * q + 2], 32.f * rg[4 * q + 3], w0, true);
        w1 = __builtin_amdgcn_cvt_pk_fp8_f32(32.f * rg[16 + 4 * q], 32.f * rg[16 + 4 * q + 1], w1, false); w1 = __builtin_amdgcn_cvt_pk_fp8_f32(32.f * rg[16 + 4 * q + 2], 32.f * rg[16 + 4 * q + 3], w1, true);
        o0[q] = (unsigned)w0; o1[q] = (unsigned)w1; }
    *(u32x4*)t.dst = o0; *(u32x4*)(t.dst + 16) = o1;
}
__device__ __forceinline__ void score_select_unit(Frame& F, int b, int qt16, const bf16_t* qi, const bf16_t* ki, const float* wi, LAS float* scl, LAS unsigned* maskw, unsigned* masks, int xid0, int xid1) {
    const int lane = F.lane, wid = F.wave, r = lane & 31, h = lane >> 5;
    const int T0 = qt16 * 16; const size_t rowb = (size_t)b * SEQ;
    XItem xa, xb; float xr0[32], xr1[32];
    { const KArgs ka = kargs(); unsigned char* w8a = F.ws + WS_WGU; unsigned char* w8b = F.ws + WS_WD;
      xa = x_decode(xid0 >= 0 ? xid0 : 0, lane, ka->in[13], ka->in[14], ka->in[15], w8a, w8b); xb = x_decode(xid1 >= 0 ? xid1 : 0, lane, ka->in[13], ka->in[14], ka->in[15], w8a, w8b); }
    {
        LAS float* wtab = (LAS float*)(F.lds + TAB_OFF + 8192);
        if (F.tid < 128) wtab[F.tid] = wi[(rowb + T0) * 8 + F.tid] * WSCALE;
        bf16x8 a[4][4];
        const int tk = (r >> 4) + 2 * ((r >> 2) & 1), hd = (r & 3) + 4 * ((r >> 3) & 1);
        const int nsteps = ((T0 + 15) >> 8) + 1, kb0 = 32 * wid;
        const bf16_t* kp0 = ki + (rowb >> 5) * 2048 + (kb0 >> 5) * 2048 + r * 16 + h * 8;
        bf16x8 bfA[4], bfB[4];
#pragma unroll
        for (int kk = 0; kk < 4; ++kk) bfA[kk] = *(const bf16x8*)(kp0 + 512 * kk);
#pragma unroll
        for (int rb = 0; rb < 4; ++rb) {
            const bf16_t* qp = qi + (rowb + T0 + 4 * rb + tk) * 512 + hd * 64 + 8 * h;
#pragma unroll
            for (int kk = 0; kk < 4; ++kk) a[rb][kk] = *(const bf16x8*)(qp + 16 * kk);
        }
        LDS_WAIT(); __syncthreads();
        const LAS float* wl = wtab + 16 * h;
#define SCORE_STEP(KS, BF) do { const int kb_ = 256 * (KS) + kb0; if (kb_ <= T0 + 15) { \
            _Pragma("unroll") for (int rb = 0; rb < 4; ++rb) { \
                f32x16 acc = f32x16{}; \
                _Pragma("unroll") for (int kk = 0; kk < 4; ++kk) acc = __builtin_amdgcn_mfma_f32_32x32x16_bf16(a[rb][kk], BF[kk], acc, 0, 0, 0); \
                const f32x4 w0_ = *(const LAS f32x4*)(wl + 32 * rb), w1_ = *(const LAS f32x4*)(wl + 32 * rb + 4), w2_ = *(const LAS f32x4*)(wl + 32 * rb + 8), w3_ = *(const LAS f32x4*)(wl + 32 * rb + 12); \
                float s0 = 0.f, s1 = 0.f; \
                _Pragma("unroll") for (int reg = 0; reg < 4; ++reg) {     \
                    const float y0_ = __int_as_float(max(__float_as_int(acc[reg]), 0)), y1_ = __int_as_float(max(__float_as_int(acc[reg + 4]), 0)); \
                    const float y2_ = __int_as_float(max(__float_as_int(acc[reg + 8]), 0)), y3_ = __int_as_float(max(__float_as_int(acc[reg + 12]), 0)); \
                    s0 += w0_[reg] * y0_; s0 += w1_[reg] * y1_; s1 += w2_[reg] * y2_; s1 += w3_[reg] * y3_; } \
                LAS float* sp = scl + (4 * rb + 2 * h) * 2048 + kb_ + r; \
                sp[0] = s0; sp[2048] = s1; } } } while (0)
        for (int ks = 0; ks < nsteps; ks += 2) {
            { const int kn = (ks + 1 < 8) ? ks + 1 : 7;
#pragma unroll
              for (int kk = 0; kk < 4; ++kk) bfB[kk] = *(const bf16x8*)(kp0 + (size_t)kn * 16384 + 512 * kk); }
            SCORE_STEP(ks, bfA);
            { const int kn = (ks + 2 < 8) ? ks + 2 : 7;
#pragma unroll
              for (int kk = 0; kk < 4; ++kk) bfA[kk] = *(const bf16x8*)(kp0 + (size_t)kn * 16384 + 512 * kk); }
            if (ks + 1 < nsteps) SCORE_STEP(ks + 1, bfB);
        }
#undef SCORE_STEP
    }
    LDS_WAIT(); __syncthreads();
    if (xid0 >= 0) x_load(xa, xr0);
    if (xid1 >= 0) x_load(xb, xr1);
#ifndef PROBE_P2
#define PROBE_P2 0
#endif
#pragma unroll 1
    for (int jx = 0; jx < (PROBE_P2 == 2 ? 4 : 2); ++jx) { const int j = jx & 1;
        const int tl = wid * 2 + j, t = T0 + tl, nch = (t >> 6) + 1;
        const unsigned tbit = 1u << tl; const LAS float* srow = scl + tl * 2048;
        if (nch <= 8) select_token<8>(srow, t, lane, tbit, maskw);
        else if (nch <= 16) select_token<16>(srow, t, lane, tbit, maskw);
        else if (nch <= 24) select_token<24>(srow, t, lane, tbit, maskw);
        else select_token<32>(srow, t, lane, tbit, maskw);
    }
    if (xid0 >= 0) x_store(xa, xr0);
    if (xid1 >= 0) x_store(xb, xr1);
    LDS_WAIT(); __syncthreads();
    {
        const int ktmax = (T0 + 15) >> 6; unsigned short* mbase = (unsigned short*)(masks + ((size_t)(b * (SEQ / 32) + (qt16 >> 1)) * (SEQ / 64)) * 64) + (qt16 & 1);
#pragma unroll
        for (int jj = 0; jj < 4; ++jj) { const int key = F.tid + 512 * jj, kt = key >> 6, kap = key & 63;
            const unsigned wv = maskw[key]; maskw[key] = 0u;
            if (kt <= ktmax) { const int half = kap >> 5, k5 = kap & 31, hi_ = (k5 >> 2) & 1, rr = (k5 & 3) + 4 * (k5 >> 3); mbase[2 * (kt * 64 + 32 * half + 2 * rr + hi_)] = (unsigned short)wv; } }
    }
    LDS_WAIT(); __syncthreads();
}
__device__ __forceinline__ void conv_pass(Frame& F, const bf16_t* u, const bf16_t* cb, const float* cw, bf16_t* conv) {
    const int gt = F.vcu * 512 + F.tid, NGT = F.G * 512;
    for (int idx = gt; idx < NTOK * 64; idx += NGT) {
        const int tok = idx >> 6, cg = (idx & 63) * 8, pos = tok & (SEQ - 1);
        const u32x4 z = (u32x4){0u, 0u, 0u, 0u};
        const u32x4 u0 = *(const u32x4*)(u + (size_t)tok * 512 + cg);
        const u32x4 u1 = pos >= 1 ? *(const u32x4*)(u + (size_t)(tok - 1) * 512 + cg) : z;
        const u32x4 u2 = pos >= 2 ? *(const u32x4*)(u + (size_t)(tok - 2) * 512 + cg) : z;
        const u32x4 bv = *(const u32x4*)(cb + (size_t)tok * 512 + cg);
        const f32x4 w0a = *(const f32x4*)(cw + cg), w0b = *(const f32x4*)(cw + cg + 4);
        const f32x4 w1a = *(const f32x4*)(cw + 512 + cg), w1b = *(const f32x4*)(cw + 512 + cg + 4);
        const f32x4 w2a = *(const f32x4*)(cw + 1024 + cg), w2b = *(const f32x4*)(cw + 1024 + cg + 4);
        f32x4 ya, yb;
#define CV(E, WA, I, WORD, HALF) (WA[I] * (HALF ? bfhi(E.WORD) : bflo(E.WORD)))
        ya[0] = bflo(bv.x) * (CV(u2, w0a, 0, x, 0) + CV(u1, w1a, 0, x, 0) + CV(u0, w2a, 0, x, 0));
        ya[1] = bfhi(bv.x) * (CV(u2, w0a, 1, x, 1) + CV(u1, w1a, 1, x, 1) + CV(u0, w2a, 1, x, 1));
        ya[2] = bflo(bv.y) * (CV(u2, w0a, 2, y, 0) + CV(u1, w1a, 2, y, 0) + CV(u0, w2a, 2, y, 0));
        ya[3] = bfhi(bv.y) * (CV(u2, w0a, 3, y, 1) + CV(u1, w1a, 3, y, 1) + CV(u0, w2a, 3, y, 1));
        yb[0] = bflo(bv.z) * (CV(u2, w0b, 0, z, 0) + CV(u1, w1b, 0, z, 0) + CV(u0, w2b, 0, z, 0));
        yb[1] = bfhi(bv.z) * (CV(u2, w0b, 1, z, 1) + CV(u1, w1b, 1, z, 1) + CV(u0, w2b, 1, z, 1));
        yb[2] = bflo(bv.w) * (CV(u2, w0b, 2, w, 0) + CV(u1, w1b, 2, w, 0) + CV(u0, w2b, 2, w, 0));
        yb[3] = bfhi(bv.w) * (CV(u2, w0b, 3, w, 1) + CV(u1, w1b, 3, w, 1) + CV(u0, w2b, 3, w, 1));
#undef CV
        store8bf(conv + (size_t)tok * 1024 + cg, ya, yb);
    }
}

constexpr int P7_HS = 1028;
constexpr int P7_H = 0, P7_P = 16 * P7_HS * 4, P7_L = P7_P + 8 * 16 * 48 * 4, P7_R = P7_L + 16 * 48 * 4, P7_END = P7_R + 6 * 128 * 4 + 2 * 32 * 4;
static_assert(P7_END <= RING_BYTES && (P7_P % 16) == 0, "P7 LDS map");
__device__ __forceinline__ void ln1_router(Frame& F, bool dry) {
    const KArgs a = kargs();
    unsigned char* ws = F.ws;
    const float* xin = a->in[0]; const bf16_t* mixb = (const bf16_t*)(ws + WS_MIX); bf16_t* h1b = dry ? (bf16_t*)(ws + WS_GATES) : (bf16_t*)(ws + WS_PRE);
    int* lists = (int*)(ws + (dry ? WS_MERGED : WS_LIST)); unsigned* tokinfo = (unsigned*)(ws + (dry ? WS_MERGED + 8 * MiB : WS_TOKINFO)); const int cbank = dry ? 64 * NEXP : 0;
    unsigned char* h1q = ws + (dry ? WS_MERGED + 16 * MiB : WS_H1Q);
    const float *g1 = a->in[7], *b1 = a->in[8], *rgb = a->in[10], *reb = a->in[12]; const float* wc = (const float*)(ws + WS_WC);
    const int lane = F.lane, wid = F.wave, tid = F.tid;
    LAS float* H = (LAS float*)(F.lds + P7_H); LAS float* P = (LAS float*)(F.lds + P7_P); LAS float* L = (LAS float*)(F.lds + P7_L);
    LAS int* RE = (LAS int*)(F.lds + P7_R);
    LAS int* hist = RE + 768; LAS int* basev = RE + 800;
    if (tid < 64) hist[tid] = 0;
    f32x4 gv[4], bv[4];
#pragma unroll
    for (int j = 0; j < 4; ++j) { gv[j] = *(const f32x4*)(g1 + 4 * lane + 256 * j); bv[j] = *(const f32x4*)(b1 + 4 * lane + 256 * j); }
    float breg[3][32];
    { const int kq = lane >> 4, jn = lane & 15; const float* wp = wc + (size_t)(128 * wid + 32 * kq) * 48 + jn;
#pragma unroll
      for (int cb = 0; cb < 3; ++cb)
#pragma unroll
          for (int sidx = 0; sidx < 32; ++sidx) breg[cb][sidx] = wp[sidx * 48 + 16 * cb]; }
    const int ngrp_total = NTOK / 16;
#pragma unroll 1
    for (int gi = F.vcu * 8; gi < ngrp_total; gi += F.G * 8) {
      f32x4 vn[2][4]; u32x2 mn[2][4];
#pragma unroll
      for (int rr = 0; rr < 2; ++rr)
#pragma unroll
          for (int j = 0; j < 4; ++j) { const size_t o_ = (size_t)(gi * 16 + 2 * wid + rr) * DM + 4 * lane + 256 * j; vn[rr][j] = *(const f32x4*)(xin + o_); mn[rr][j] = *(const u32x2*)(mixb + o_); }
#pragma unroll 1
      for (int gg = 0; gg < 8; ++gg) {
        const int row0 = (gi + gg) * 16;
#pragma unroll
        for (int rr = 0; rr < 2; ++rr) { const int rl = 2 * wid + rr, row = row0 + rl;
            f32x4 v[4]; float sm = 0.f;
#pragma unroll
            for (int j = 0; j < 4; ++j) { const u32x2 mw = mn[rr][j]; v[j] = vn[rr][j] * ALPHA + (f32x4){bflo(mw.x), bfhi(mw.x), bflo(mw.y), bfhi(mw.y)}; sm += (v[j][0] + v[j][1]) + (v[j][2] + v[j][3]); }
            const float mean = wave_sum(sm) * (1.f / DM); float s2 = 0.f;
#pragma unroll
            for (int j = 0; j < 4; ++j) { v[j] = v[j] - mean; s2 += (v[j][0] * v[j][0] + v[j][1] * v[j][1]) + (v[j][2] * v[j][2] + v[j][3] * v[j][3]); }
            const float rstd = 1.f / sqrtf(wave_sum(s2) * (1.f / DM) + LN_EPS);
#pragma unroll
            for (int j = 0; j < 4; ++j) { v[j] = v[j] * rstd * gv[j] + bv[j];
                u32x2 o; o.x = pkbf(v[j][0], v[j][1]); o.y = pkbf(v[j][2], v[j][3]); *(u32x2*)(h1b + (size_t)row * DM + 4 * lane + 256 * j) = o;
                { int wv = 0; wv = __builtin_amdgcn_cvt_pk_fp8_f32(v[j][0], v[j][1], wv, false); wv = __builtin_amdgcn_cvt_pk_fp8_f32(v[j][2], v[j][3], wv, true);
                  *(int*)(h1q + (size_t)row * 1024 + 4 * lane + 256 * j) = wv; }
                *(LAS f32x4*)(H + rl * P7_HS + 4 * lane + 256 * j) = v[j]; } }
        { const int gnx = gg < 7 ? gg + 1 : gg;
#pragma unroll
          for (int rr = 0; rr < 2; ++rr)
#pragma unroll
              for (int j = 0; j < 4; ++j) { const size_t o_ = (size_t)((gi + gnx) * 16 + 2 * wid + rr) * DM + 4 * lane + 256 * j; vn[rr][j] = *(const f32x4*)(xin + o_); mn[rr][j] = *(const u32x2*)(mixb + o_); } }
        LDS_WAIT(); __syncthreads();
        { f32x4 acc[3]; acc[0] = (f32x4){0.f, 0.f, 0.f, 0.f}; acc[1] = acc[0]; acc[2] = acc[0];
          const LAS float* hp = H + (lane & 15) * P7_HS + 128 * wid + 32 * (lane >> 4);
#pragma unroll
          for (int s4 = 0; s4 < 8; ++s4) { const f32x4 av = *(const LAS f32x4*)(hp + 4 * s4);
#pragma unroll
              for (int e = 0; e < 4; ++e)
#pragma unroll
                  for (int cb = 0; cb < 3; ++cb) acc[cb] = __builtin_amdgcn_mfma_f32_16x16x4f32(av[e], breg[cb][4 * s4 + e], acc[cb], 0, 0, 0); }
          LAS float* pp = P + (wid * 16 + 4 * (lane >> 4)) * 48 + (lane & 15);
#pragma unroll
          for (int cb = 0; cb < 3; ++cb)
#pragma unroll
              for (int rg = 0; rg < 4; ++rg) pp[rg * 48 + 16 * cb] = acc[cb][rg]; }
        LDS_WAIT(); __syncthreads();
        for (int idx = tid; idx < 16 * 48; idx += 512) { float sum = 0.f;
#pragma unroll
            for (int w = 0; w < 8; ++w) sum += P[w * 768 + idx];
            L[idx] = sum; }
        LDS_WAIT(); __syncthreads();
        if (tid < 16) { const LAS float* lr = L + tid * 48;
            float gl[4]; int grp = 0;
#pragma unroll
            for (int i = 0; i < 4; ++i) gl[i] = lr[i] + rgb[i];
            float gm = gl[0];
#pragma unroll
            for (int i = 1; i < 4; ++i) if (gl[i] > gm) { gm = gl[i]; grp = i; }
            float den = 0.f;
#pragma unroll
            for (int i = 0; i < 4; ++i) den += __expf(gl[i] - gm);
            const float pgrp = 1.f / den;
            float el[8];
#pragma unroll
            for (int i = 0; i < 8; ++i) el[i] = lr[4 + 8 * grp + i] + reb[grp * 8 + i];
            int i1 = 0; float v1 = el[0];
#pragma unroll
            for (int i = 1; i < 8; ++i) if (el[i] > v1) { v1 = el[i]; i1 = i; }
            int i2 = -1; float v2 = -INFINITY;
#pragma unroll
            for (int i = 0; i < 8; ++i) if (i != i1 && el[i] > v2) { v2 = el[i]; i2 = i; }
            const float ex = __expf(v2 - v1), w1 = pgrp / (1.f + ex), w2 = pgrp * ex / (1.f + ex);
            const int e1 = grp * 8 + i1, e2 = grp * 8 + i2, ti = gg * 16 + tid;
            RE[ti] = e1; RE[128 + ti] = e2; RE[256 + ti] = (int)__float_as_uint(w1); RE[384 + ti] = (int)__float_as_uint(w2);
            RE[512 + ti] = __hip_atomic_fetch_add(hist + e1, 1, __ATOMIC_RELAXED, __HIP_MEMORY_SCOPE_WORKGROUP);
            RE[640 + ti] = __hip_atomic_fetch_add(hist + e2, 1, __ATOMIC_RELAXED, __HIP_MEMORY_SCOPE_WORKGROUP);
        }
      }
      LDS_WAIT(); __syncthreads();
      if (tid < NEXP) { const int hc = hist[tid]; basev[tid] = hc ? (int)__hip_atomic_fetch_add(F.ctl + CW_CNT + cbank + 64 * tid, (unsigned)hc, __ATOMIC_RELAXED, __HIP_MEMORY_SCOPE_AGENT) : 0; }
      LDS_WAIT(); __syncthreads();
      if (tid < 128) { const int row = gi * 16 + tid; const int e1 = RE[tid], e2 = RE[128 + tid];
          const unsigned r1 = (unsigned)(basev[e1] + RE[512 + tid]), r2 = (unsigned)(basev[e2] + RE[640 + tid]);
          if (r1 < (unsigned)LISTCAP) lists[(size_t)e1 * LISTCAP + r1] = row;
          if (r2 < (unsigned)LISTCAP) lists[(size_t)e2 * LISTCAP + r2] = row;
          unsigned* ti = tokinfo + (size_t)row * 8;
          *(u32x4*)ti = (u32x4){(unsigned)e1, r1, (unsigned)RE[256 + tid], (unsigned)e2}; *(u32x2*)(ti + 4) = (u32x2){r2, (unsigned)RE[384 + tid]}; }
      LDS_WAIT(); __syncthreads();
      if (tid < 64) hist[tid] = 0;
      LDS_WAIT(); __syncthreads();
    }
}
__device__ __forceinline__ void moe_tables(Frame& F) {
    LAS int* tab = (LAS int*)(F.lds + TAB_OFF);
    __syncthreads();
    if (F.tid < NEXP) { int c = (int)__hip_atomic_load(F.ctl + CW_CNT + 64 * F.tid, __ATOMIC_RELAXED, __HIP_MEMORY_SCOPE_AGENT); if (c > LISTCAP) c = LISTCAP; tab[T_CNT + F.tid] = c; }
    __syncthreads();
    if (F.tid == 0) { int acc = 0; for (int e = 0; e < NEXP; ++e) { tab[T_BLK0 + e] = acc; acc += (tab[T_CNT + e] + 255) >> 8; } tab[T_BLK0 + NEXP] = acc; tab[T_NB] = acc; }
    __syncthreads();
    if (F.tid < NEXP) { const int b0 = tab[T_BLK0 + F.tid], b1 = tab[T_BLK0 + F.tid + 1]; for (int bb = b0; bb < b1; ++bb) tab[T_BLKE + bb] = F.tid; }
    __syncthreads();
}

__device__ __forceinline__ void combine_ln2(Frame& F) {
    const KArgs a = kargs();
    unsigned char* ws = F.ws;
    const bf16_t* h1 = (const bf16_t*)(ws + WS_PRE); const unsigned char* ys = ws + WS_YS;     const unsigned* tokinfo = (const unsigned*)(ws + WS_TOKINFO);
    const LAS int* tab = (const LAS int*)(F.lds + TAB_OFF);
    const float *g2 = a->in[16], *b2 = a->in[17]; float* outp = a->out;
    const int lane = F.lane, gw = F.vcu * NWAVES + F.wave, NGW = F.G * NWAVES;
    f32x4 gv[4], bv[4];
#pragma unroll
    for (int j = 0; j < 4; ++j) { gv[j] = *(const f32x4*)(g2 + 4 * lane + 256 * j); bv[j] = *(const f32x4*)(b2 + 4 * lane + 256 * j); }
    const int nrw = (NTOK - gw + NGW - 1) / NGW;
    if (nrw > 0) {
#define ROWK(k) (gw + ((k) < nrw ? (k) : nrw - 1) * NGW)
#define TI_LOAD(k, A, B) do { const unsigned* ti_ = tokinfo + (size_t)ROWK(k) * 8; A = *(const u32x4*)ti_; B = *(const u32x2*)(ti_ + 4); } while (0)
#define DATA_LOAD(k, A, B, HW, YA, YB) do { const int e1_ = (int)A.x, e2_ = (int)A.w; \
        const size_t s1_ = (size_t)tab[T_BLK0 + e1_] * 256 + A.y, s2_ = (size_t)tab[T_BLK0 + e2_] * 256 + B.x; \
        const bf16_t* hr_ = h1 + (size_t)ROWK(k) * DM + 4 * lane; const unsigned char* y1_ = ys + s1_ * DM + 4 * lane; const unsigned char* y2_ = ys + s2_ * DM + 4 * lane; \
        _Pragma("unroll") for (int j = 0; j < 4; ++j) { HW[j] = *(const u32x2*)(hr_ + 256 * j); YA[j] = *(const unsigned*)(y1_ + 256 * j); YB[j] = *(const unsigned*)(y2_ + 256 * j); } } while (0)
        u32x4 tc0, tn0, tq0; u32x2 tc1, tn1, tq1;
        u32x2 hw[4], hwn[4]; unsigned ya[4], yb[4], yan[4], ybn[4];
        TI_LOAD(0, tc0, tc1); TI_LOAD(1, tn0, tn1);
        DATA_LOAD(0, tc0, tc1, hw, ya, yb);
        for (int k = 0; k < nrw; ++k) {
            TI_LOAD(k + 2, tq0, tq1);
            DATA_LOAD(k + 1, tn0, tn1, hwn, yan, ybn);
            const float w1 = __uint_as_float(tc0.z), w2 = __uint_as_float(tc1.y);
            f32x4 v[4]; float sm = 0.f;
#pragma unroll
            for (int j = 0; j < 4; ++j) {
                v[j][0] = ALPHA * bflo(hw[j].x) + w1 * __builtin_amdgcn_cvt_f32_fp8((int)ya[j], 0) + w2 * __builtin_amdgcn_cvt_f32_fp8((int)yb[j], 0);
                v[j][1] = ALPHA * bfhi(hw[j].x) + w1 * __builtin_amdgcn_cvt_f32_fp8((int)ya[j], 1) + w2 * __builtin_amdgcn_cvt_f32_fp8((int)yb[j], 1);
                v[j][2] = ALPHA * bflo(hw[j].y) + w1 * __builtin_amdgcn_cvt_f32_fp8((int)ya[j], 2) + w2 * __builtin_amdgcn_cvt_f32_fp8((int)yb[j], 2);
                v[j][3] = ALPHA * bfhi(hw[j].y) + w1 * __builtin_amdgcn_cvt_f32_fp8((int)ya[j], 3) + w2 * __builtin_amdgcn_cvt_f32_fp8((int)yb[j], 3);
                sm += (v[j][0] + v[j][1]) + (v[j][2] + v[j][3]); }
            const float mean = wave_sum(sm) * (1.f / DM); float s2v = 0.f;
#pragma unroll
            for (int j = 0; j < 4; ++j) { v[j] = v[j] - mean; s2v += (v[j][0] * v[j][0] + v[j][1] * v[j][1]) + (v[j][2] * v[j][2] + v[j][3] * v[j][3]); }
            const float rstd = 1.f / sqrtf(wave_sum(s2v) * (1.f / DM) + LN_EPS);
            float* orow = outp + (size_t)(gw + k * NGW) * DM + 4 * lane;
#pragma unroll
            for (int j = 0; j < 4; ++j) *(f32x4*)(orow + 256 * j) = v[j] * rstd * gv[j] + bv[j];
            tc0 = tn0; tc1 = tn1; tn0 = tq0; tn1 = tq1;
#pragma unroll
            for (int j = 0; j < 4; ++j) { hw[j] = hwn[j]; ya[j] = yan[j]; yb[j] = ybn[j]; }
        }
#undef ROWK
#undef TI_LOAD
#undef DATA_LOAD
    }
}

#if DBG_NAIVE
constexpr size_t WS_NK = 296 * MiB, WS_NV = 312 * MiB, WS_NKI = 328 * MiB;
__device__ __forceinline__ float naive_proj(const float* xs  , const float* w_in, int col) {
    float s = 0.f; for (int d = 0; d < DM; ++d) s += xs[d] * w_in[(size_t)d * INW + col]; return s;
}
__device__ __forceinline__ void naive_kv(Frame& F) {
    const KArgs ka = kargs(); const float* xin = ka->in[0]; const float* win = ka->in[1];
    float* nk = (float*)(F.ws + WS_NK); float* nv = (float*)(F.ws + WS_NV); float* nki = (float*)(F.ws + WS_NKI);
    LAS float* xs = (LAS float*)F.lds; LAS float* pr = xs + 1024;
    for (int tok = F.vcu; tok < NTOK; tok += F.G) {
        __syncthreads();
        for (int i = F.tid; i < DM; i += 512) xs[i] = xin[(size_t)tok * DM + i];
        __syncthreads();
        if (F.tid < 320) { const int col = F.tid < 256 ? 512 + F.tid : 1280 + (F.tid - 256); float s = 0.f; for (int d = 0; d < DM; ++d) s += xs[d] * win[(size_t)d * INW + col]; pr[F.tid] = s; }
        __syncthreads();
        const int pos = tok & (SEQ - 1);
        if (F.tid < 24) {
            const int grp = F.tid >> 3, i = F.tid & 7, base = grp == 0 ? 0 : (grp == 1 ? 64 : 256);
            const float inv = (float)pow(500000.0, -(double)i / 8.0); const float ang = (float)pos * inv, c = cosf(ang), s = sinf(ang);
            const float x1 = pr[base + i], x2 = pr[base + 8 + i]; pr[base + i] = x1 * c - x2 * s; pr[base + 8 + i] = x2 * c + x1 * s;
        }
        __syncthreads();
        if (F.tid < 128) { nk[(size_t)tok * 128 + F.tid] = pr[F.tid]; nv[(size_t)tok * 128 + F.tid] = pr[128 + F.tid]; }
        if (F.tid < 64) nki[(size_t)tok * 64 + F.tid] = pr[256 + F.tid];
    }
}
__device__ __forceinline__ void naive_attn(Frame& F) {
    const KArgs ka = kargs(); const float* xin = ka->in[0]; const float* win = ka->in[1];
    const float* nk = (const float*)(F.ws + WS_NK); const float* nv = (const float*)(F.ws + WS_NV); const float* nki = (const float*)(F.ws + WS_NKI);
    bf16_t* attn = (bf16_t*)(F.ws + WS_AC) + 512;
    LAS float* xs = (LAS float*)F.lds;
    LAS float* qs = xs + 1024;
    LAS float* qis = qs + 512;
    LAS float* wis = qis + 512;
    LAS float* sc = wis + 16;
    LAS int* sel = (LAS int*)(sc + 2048);
    LAS int* nsel = sel + 256;
    LAS float* pl = (LAS float*)(nsel + 16);
    for (int tok = F.vcu; tok < NTOK; tok += F.G) {
        const int pos = tok & (SEQ - 1), b0 = tok - pos;
        __syncthreads();
        for (int i = F.tid; i < DM; i += 512) xs[i] = xin[(size_t)tok * DM + i];
        if (F.tid == 0) nsel[0] = 0;
        __syncthreads();
        for (int c = F.tid; c < 1032; c += 512) { const int col = c < 512 ? c : (c < 1024 ? 768 + (c - 512) : 1344 + (c - 1024));
            float s = 0.f; for (int d = 0; d < DM; ++d) s += xs[d] * win[(size_t)d * INW + col];
            if (c < 512) qs[c] = s; else if (c < 1024) qis[c - 512] = s; else wis[c - 1024] = s; }
        __syncthreads();
        if (F.tid < 128) { const int which = F.tid >> 6, hd = (F.tid >> 3) & 7, i = F.tid & 7; LAS float* p = (which ? qis : qs) + hd * 64;
            const float inv = (float)pow(500000.0, -(double)i / 8.0); const float ang = (float)pos * inv, c = cosf(ang), s = sinf(ang);
            const float x1 = p[i], x2 = p[8 + i]; p[i] = x1 * c - x2 * s; p[8 + i] = x2 * c + x1 * s; }
        __syncthreads();
#if DBG_NAIVE == 2
        { const bf16_t* qif = (const bf16_t*)(F.ws + WS_QI) + (size_t)tok * 512; for (int i = F.tid; i < 512; i += 512) qis[i] = __uint_as_float((unsigned)qif[i] << 16);
          if (F.tid < 8) wis[F.tid] = ((const float*)(F.ws + WS_WI))[(size_t)tok * 8 + F.tid]; }
        __syncthreads();
        for (int s = F.tid; s <= pos; s += 512) { const int tk_ = b0 + s; const bf16_t* kr = (const bf16_t*)(F.ws + WS_KI) + (size_t)(tk_ >> 5) * 2048 + (tk_ & 31) * 16; float tot = 0.f;
            for (int hd = 0; hd < 8; ++hd) { float d = 0.f; for (int e = 0; e < 64; ++e) d += qis[hd * 64 + e] * __uint_as_float((unsigned)kr[(e >> 4) * 512 + ((e >> 3) & 1) * 8 + (e & 7)] << 16); tot += fmaxf(d, 0.f) * (wis[hd] * WSCALE); }
            sc[s] = tot; }
#else
        for (int s = F.tid; s <= pos; s += 512) { const float* kr = nki + (size_t)(b0 + s) * 64; float tot = 0.f;
            for (int hd = 0; hd < 8; ++hd) { float d = 0.f; for (int e = 0; e < 64; ++e) d += qis[hd * 64 + e] * kr[e]; d *= 0.125f; tot += fmaxf(d, 0.f) * wis[hd]; }
            sc[s] = tot * 0.35355339059327373f; }
#endif
        __syncthreads();
        for (int s = F.tid; s <= pos; s += 512) { bool take = true;
            if (pos >= 256) { const float xv = sc[s]; int rank = 0; for (int s2 = 0; s2 <= pos; ++s2) { const float y = sc[s2]; rank += (y > xv || (y == xv && s2 < s)) ? 1 : 0; } take = rank < 256; }
            if (take) { const int p = atomicAdd((int*)nsel, 1); sel[p] = s; } }
        __syncthreads();
        const int ns = nsel[0]; const int hd = F.wave, lane = F.lane;
        float lg[4]; float mx = -INFINITY;
        for (int jj = 0; jj < 4; ++jj) { const int j = lane + 64 * jj; lg[jj] = -INFINITY;
            if (j < ns) { const float* kr = nk + (size_t)(b0 + sel[j]) * 128 + (hd >> 2) * 64; float d = 0.f; for (int e = 0; e < 64; ++e) d += qs[hd * 64 + e] * kr[e]; lg[jj] = d * 0.125f; mx = fmaxf(mx, lg[jj]); } }
        mx = wave_max(mx); float sum = 0.f;
        for (int jj = 0; jj < 4; ++jj) { const int j = lane + 64 * jj; const float p = (j < ns) ? expf(lg[jj] - mx) : 0.f; sum += p; pl[hd * 256 + j] = p; }
        sum = wave_sum(sum);
        LDS_WAIT(); asm volatile("" ::: "memory");
        float o = 0.f;
        for (int j = 0; j < ns; ++j) o += pl[hd * 256 + j] * nv[(size_t)(b0 + sel[j]) * 128 + (hd >> 2) * 64 + lane];
        o /= sum;
        bf16_t* ap = attn + (size_t)tok * 1024 + hd * 64 + lane;
        const float fast = __uint_as_float((unsigned)(*ap) << 16);
        const float blended = o + DBG_G * (fast - o);
        *ap = (bf16_t)(pkbf(blended, 0.f) & 0xffffu);
    }
}
#endif

__global__ void __launch_bounds__(NWAVES * 64, 2) mk_fwd(Args args_unused) {
    extern __shared__ __attribute__((aligned(16))) unsigned char lds[];
    Frame F;
    F.lds = (LAS unsigned char*)lds;
    F.MISC = (volatile LAS unsigned*)(F.lds + LDSCTL_OFF);
    F.tid = threadIdx.x; F.lane = F.tid & 63; F.wave = __builtin_amdgcn_readfirstlane(F.tid >> 6);
    F.G = gridDim.x; { const int bx = blockIdx.x; F.vcu = (F.G % 8 == 0) ? (bx % 8) * (F.G / 8) + bx / 8 : bx; }
    unsigned char* ws; int lo, hi;
    { const KArgs ka = kargs(); ws = ka->ws; lo = ka->ph_lo; hi = ka->ph_hi; }
    F.ws = ws; F.ctl = (unsigned*)(ws + WS_CTL);
    for (int u = F.tid; u < (LDS_BYTES - LDSCTL_OFF) / 4; u += NWAVES * 64) ((LAS unsigned*)(F.lds + LDSCTL_OFF))[u] = 0u;
    __syncthreads();
#if MK_SPLIT
#define GRID_BAR() do { } while (0)
#else
    XcdBarrier bar = xcd_barrier_post(F.ctl + CW_BAR, F.MISC + 8);
#define GRID_BAR() xcd_barrier(bar)
#endif
#ifndef PHASE_MASK
#define PHASE_MASK 0xFFFF
#endif
#define IN(k) ((((PHASE_MASK) >> (k)) & 1) && lo <= (k) && (k) < hi)
#define BOTH(k, k2) (IN(k) && IN(k2))

    bf16_t* xb = (bf16_t*)(ws + WS_XB);
    bf16_t *qb = (bf16_t*)(ws + WS_Q), *kbuf = (bf16_t*)(ws + WS_K), *vbuf = (bf16_t*)(ws + WS_V), *qib = (bf16_t*)(ws + WS_QI), *kib = (bf16_t*)(ws + WS_KI);
    float* wib = (float*)(ws + WS_WI);
    bf16_t *ub = (bf16_t*)(ws + WS_U), *cbb = (bf16_t*)(ws + WS_CB), *acb = (bf16_t*)(ws + WS_AC), *gab = (bf16_t*)(ws + WS_GA), *rtb = (bf16_t*)(ws + WS_RT);
    unsigned* masks = (unsigned*)(ws + WS_MASK);
    bf16_t *merged = (bf16_t*)(ws + WS_MERGED), *h1b = (bf16_t*)(ws + WS_PRE), *ysb_unused = nullptr; (void)ysb_unused;
    float* pre = (float*)(ws + WS_PRE);

    if (IN(0)) { p0_prologue(F); if (BOTH(0, 1)) GRID_BAR(); }
    if (IN(1)) {
        pg8::Gemm g{xb, (const bf16_t*)(ws + WS_WIN), NTOK, NPROJ, DM, 0}; pg8::StaticOrder S; S.init(NTOK, NPROJ, F.G, (int)blockIdx.x);
        EpiProj E{qb, kbuf, vbuf, qib, kib, ub, cbb, gab, rtb, wib, (const float*)(ws + WS_ROPE), kargs()->in[2]};
        pg8::gemm_phase<EpiProj, pg8::StaticOrder, true, false>(F.lds, g, S, E, nullptr);
        if (BOTH(1, 2)) GRID_BAR();
    }
    if (IN(2)) {
        LAS float* scl = (LAS float*)F.lds;
        LAS unsigned* maskw = (LAS unsigned*)(F.lds + TAB_OFF);
        for (int i = F.tid; i < 2048; i += 512) maskw[i] = 0u;
        __syncthreads();
        if (F.G == 256) {
            const int b = F.vcu >> 4, j = F.vcu & 15;
#pragma unroll 1
            for (int i = 0; i < 8; ++i) { const int qt = 32 * (i >> 1) + ((i & 1) ? 31 - j : j);
                const int gwv = F.vcu * NWAVES + F.wave, jx0 = i < 4 ? 2 * i : 4 + i;
                score_select_unit(F, b, qt, qib, kib, wib, scl, maskw, masks, gwv + 2048 * jx0, i < 4 ? gwv + 2048 * (jx0 + 1) : -1); }
        } else {
#pragma unroll 1
            for (int un = F.vcu; un < NBATCH * 128; un += F.G) score_select_unit(F, un >> 7, un & 127, qib, kib, wib, scl, maskw, masks, -1, -1);
        }
        conv_pass(F, ub, cbb, kargs()->in[5], acb);
        if (PROBE_P2 == 3) conv_pass(F, ub, cbb, kargs()->in[5], acb);
        if (BOTH(2, 3)) GRID_BAR();
    }
    if (IN(3)) {
        const int nun = NBATCH * 8 * 8;
        if (F.G == 256) {
            const int bh = F.vcu >> 1, s0 = 2 * (F.vcu & 1);
#pragma unroll 1
            for (int i = 0; i < 4; ++i) { const int qbk = (i == 0) ? s0 : (i == 1) ? 7 - s0 : (i == 2) ? s0 + 1 : 6 - s0;
                attn_body::attn_unit<8>(bh >> 3, bh & 7, qbk, (const attn_body::bf16*)qb, (const attn_body::bf16*)kbuf, (const attn_body::bf16*)vbuf, (attn_body::bf16*)acb, masks, (char*)lds); }
        } else {
#pragma unroll 1
            for (int un = F.vcu; un < nun; un += F.G) attn_body::attn_unit<8>(un >> 6, (un >> 3) & 7, un & 7, (const attn_body::bf16*)qb, (const attn_body::bf16*)kbuf, (const attn_body::bf16*)vbuf, (attn_body::bf16*)acb, masks, (char*)lds);
        }
        if (BOTH(3, 4)) GRID_BAR();
    }
#if DBG_NAIVE
    if (IN(4)) { naive_kv(F); }
    if (IN(11)) { naive_attn(F); }
#else
    if (IN(4)) { if (BOTH(4, 5)) { } }
#endif
    if (IN(5)) {
        pg8::Gemm g{acb, (const bf16_t*)(ws + WS_WAU), NTOK, DM, DM, 0}; pg8::StaticOrder S; S.init(NTOK, DM, F.G, (int)blockIdx.x);
        EpiMerged E{gab, rtb, merged};
        pg8::gemm_phase<EpiMerged, pg8::StaticOrder, true, false, true>(F.lds, g, S, E, nullptr);
        if (BOTH(5, 6)) GRID_BAR();
    }
    if (IN(6)) {
        pg8::Gemm g{merged, (const bf16_t*)(ws + WS_WOUT), NTOK, DM, DM, 0}; pg8::StaticOrder S; S.init(NTOK, DM, F.G, (int)blockIdx.x);
        EpiOut E{(bf16_t*)(ws + WS_MIX)};
        pg8::gemm_phase<EpiOut, pg8::StaticOrder, true, false>(F.lds, g, S, E, nullptr);
        if (BOTH(6, 7)) GRID_BAR();
    }
    if (IN(7)) { ln1_router(F, (kargs()->flags & 1) != 0); if (BOTH(7, 8)) GRID_BAR(); }
    if (IN(8)) {
        moe_tables(F);
        LAS int* tab = (LAS int*)(F.lds + TAB_OFF);
        const int nunits = tab[T_NB] * 4; const int* lists = (const int*)(ws + WS_LIST);
        for (int i = 0; i < T_ROWS_UNITS; ++i) { const int L = i * F.G + F.vcu; if (L >= nunits) break;
            const int rbg = L >> 2, e = tab[T_BLKE + rbg], slot0 = (rbg - tab[T_BLK0 + e]) * 256, cnt = tab[T_CNT + e];
            if (F.tid < 256) { const int sl = slot0 + F.tid; tab[T_ROWS + i * 256 + F.tid] = sl < cnt ? lists[(size_t)e * LISTCAP + sl] : 0; } }
        __syncthreads();
        pg8::Gemm g{(const bf16_t*)(ws + WS_H1Q), (const bf16_t*)(ws + WS_WGU), CAPROWS, NEXP * 1024, 512, 0}; pg8::MoeOrder S{tab + T_BLKE, nunits, F.G, F.vcu};
        EpiSwiGLU E{ws + WS_HID};
        pg8::gemm_phase<EpiSwiGLU, pg8::MoeOrder, true, true, false, true>(F.lds, g, S, E, tab + T_ROWS);
        if (BOTH(8, 9)) GRID_BAR();
    }
    if (IN(9)) {
        moe_tables(F);
        LAS int* tab = (LAS int*)(F.lds + TAB_OFF);
        const int nunits = tab[T_NB] * 4;
        pg8::Gemm g{(const bf16_t*)(ws + WS_HID), (const bf16_t*)(ws + WS_WD), CAPROWS, NEXP * 1024, 256, 0}; pg8::MoeOrder S{tab + T_BLKE, nunits, F.G, F.vcu};
        EpiYs E{ws + WS_YS};
        pg8::gemm_phase<EpiYs, pg8::MoeOrder, true, false, false, true>(F.lds, g, S, E, nullptr);
        if (BOTH(9, 10)) GRID_BAR();
    }
    if (IN(10)) { moe_tables(F); combine_ln2(F); }
#undef IN
#undef BOTH
}

extern "C" void kernel_launch(void* const* d_in, const int* in_sizes, int n_in, void* d_out, int out_size, void* d_ws, size_t ws_size, hipStream_t stream) {
    static int grid = 0;
    if (grid == 0) {
        if (n_in != 18 || in_sizes[0] != NTOK * DM || out_size != NTOK * DM || ws_size < WS_END) { fprintf(stderr, "kernel_launch: unexpected shapes (n_in %d, ws %zu)\n", n_in, ws_size); grid = -1; return; }
        int dev = 0, cus = 0, per_cu = 0;
        if (hipGetDevice(&dev) != hipSuccess || hipDeviceGetAttribute(&cus, hipDeviceAttributeMultiprocessorCount, dev) != hipSuccess) { grid = -1; return; }
        if (hipFuncSetAttribute((const void*)mk_fwd, hipFuncAttributeMaxDynamicSharedMemorySize, LDS_BYTES) != hipSuccess) { fprintf(stderr, "kernel_launch: hipFuncSetAttribute failed\n"); grid = -1; return; }
        if (hipOccupancyMaxActiveBlocksPerMultiprocessor(&per_cu, (const void*)mk_fwd, NWAVES * 64, LDS_BYTES) != hipSuccess || per_cu < 1) fprintf(stderr, "kernel_launch: occupancy query reports %d\n", per_cu);
        (void)hipGetLastError();
        grid = cus;
    }
    if (grid < 0) return;
    (void)hipMemsetAsync((char*)d_ws + WS_CTL, 0, CTL_ZERO_BYTES, stream);
    Args a{};
    for (int i = 0; i < 18; ++i) a.in[i] = (const float*)d_in[i];
    a.out = (float*)d_out; a.ws = (unsigned char*)d_ws;
#if MK_SPLIT
#if DBG_NAIVE
    const int seq[] = {0, 1, 2, 3, 4, 11, 5, 6, 7, 8, 9, 10};
#else
    const int seq[] = {0, 1, 2, 3, 5, 6, 7, 8, 9, 10};
#endif
    for (int ph : seq) { a.ph_lo = ph; a.ph_hi = ph + 1;
#ifdef PROBE_P7
        if (ph == 7) { a.flags = 1; hipLaunchKernelGGL(mk_fwd, dim3(grid), dim3(NWAVES * 64), LDS_BYTES, stream, a); a.flags = 0; }
#endif
        hipLaunchKernelGGL(mk_fwd, dim3(grid), dim3(NWAVES * 64), LDS_BYTES, stream, a);
#ifdef PROBE_DUP
        if (ph == PROBE_DUP) hipLaunchKernelGGL(mk_fwd, dim3(grid), dim3(NWAVES * 64), LDS_BYTES, stream, a);
#endif
    }
#else
    a.ph_lo = 0; a.ph_hi = 11;
    hipLaunchKernelGGL(mk_fwd, dim3(grid), dim3(NWAVES * 64), LDS_BYTES, stream, a);
#endif
}
```

```cpp
#include <hip/hip_runtime.h>
#include <hip/hip_bf16.h>
#include <cstdio>
#include <cstdint>

#ifndef MK_SPLIT
#define MK_SPLIT 0
#endif
#ifndef DBG_NAIVE
#define DBG_NAIVE 0
#endif
#ifndef DBG_G
#define DBG_G 1.0f
#endif

#define LAS __attribute__((address_space(3)))
#define GAS __attribute__((address_space(1)))
typedef unsigned short bf16_t;
typedef short bf16x8 __attribute__((ext_vector_type(8)));
typedef short s16x4 __attribute__((ext_vector_type(4)));
typedef float f32x2 __attribute__((ext_vector_type(2)));
typedef float f32x4 __attribute__((ext_vector_type(4)));
typedef float f32x16 __attribute__((ext_vector_type(16)));
typedef unsigned u32x2 __attribute__((ext_vector_type(2)));
typedef unsigned u32x4 __attribute__((ext_vector_type(4)));
typedef unsigned u32x16 __attribute__((ext_vector_type(16)));
typedef __bf16 bf16x2_t __attribute__((ext_vector_type(2)));

constexpr int NTOK = 32768, SEQ = 2048, NBATCH = 16, DM = 1024;
constexpr int NPROJ = 5120, INW = 4936;
constexpr int NEXP = 32, DEXP = 512, LISTCAP = 32768;
constexpr int CAPROWS = 65536 + NEXP * 256;
constexpr float LN_EPS = 1e-5f;
constexpr float ALPHA = 1.189207115002721f;
constexpr float C2 = 0.125f * 1.4426950408889634f;
constexpr float WSCALE = 0.125f * 0.35355339059327373f;

constexpr size_t MiB = 1u << 20;
constexpr size_t WS_CTL = 0, CTL_ZERO_BYTES = 1 * MiB;
constexpr size_t WS_ROPE = 1 * MiB;
constexpr size_t WS_WC = 1 * MiB + 256 * 1024;
constexpr size_t WS_WIN = 2 * MiB, WS_WAU = 12 * MiB, WS_WCU = 13 * MiB, WS_WOUT = 14 * MiB, WS_WD = 16 * MiB, WS_WGU = 48 * MiB;
constexpr size_t WS_XB = 112 * MiB;
constexpr size_t WS_MIX = 112 * MiB;
constexpr size_t WS_H1Q = 304 * MiB;
constexpr size_t WS_AC = 112 * MiB;
constexpr size_t WS_Q = 176 * MiB, WS_K = 208 * MiB, WS_V = 216 * MiB, WS_QI = 224 * MiB, WS_KI = 256 * MiB, WS_WI = 260 * MiB;
constexpr size_t WS_MERGED = 176 * MiB;
constexpr size_t WS_U = 264 * MiB, WS_ATTN = 264 * MiB;
constexpr size_t WS_CB = 296 * MiB, WS_MASK = 360 * MiB, WS_GATES = 368 * MiB;
constexpr size_t WS_GA = 368 * MiB, WS_RT = 432 * MiB;
constexpr size_t WS_PRE = 240 * MiB;
constexpr size_t WS_HID = 368 * MiB;
constexpr size_t WS_LIST = 496 * MiB, WS_TOKINFO = 500 * MiB;
constexpr size_t WS_YS = 48 * MiB;
constexpr size_t WS_END = 512 * MiB;
static_assert(WS_YS + (size_t)CAPROWS * 1024 * 2 <= WS_PRE && WS_HID + (size_t)CAPROWS * 512 * 2 <= WS_LIST, "ws map");
constexpr int CW_BAR = 4096;
constexpr int CW_CNT = 8192;
constexpr int RING_BYTES = 131072;
constexpr int LDSCTL_OFF = RING_BYTES;
constexpr int TAB_OFF = RING_BYTES + 512;
constexpr int T_CNT = 0, T_BLK0 = 32, T_NB = 68, T_BLKE = 72, T_ROWS = 400, T_ROWS_UNITS = 12;
constexpr int LDS_BYTES = 147456;
static_assert(TAB_OFF + (T_ROWS + T_ROWS_UNITS * 256) * 4 <= LDS_BYTES && TAB_OFF + 8192 <= LDS_BYTES, "lds map");
constexpr int NWAVES = 8;

__device__ __forceinline__ unsigned pkbf(float lo, float hi) { f32x2 v = {lo, hi}; bf16x2_t b = __builtin_convertvector(v, bf16x2_t); return __builtin_bit_cast(unsigned, b); }
__device__ __forceinline__ float bflo(unsigned u) { return __uint_as_float(u << 16); }
__device__ __forceinline__ float bfhi(unsigned u) { return __uint_as_float(u & 0xffff0000u); }
__device__ __forceinline__ float wave_sum(float v) {
#pragma unroll
    for (int o = 1; o < 64; o <<= 1) v += __shfl_xor(v, o);
    return v;
}
__device__ __forceinline__ float wave_max(float v) {
#pragma unroll
    for (int o = 1; o < 64; o <<= 1) v = fmaxf(v, __shfl_xor(v, o));
    return v;
}
__device__ __forceinline__ float wave_min(float v) {
#pragma unroll
    for (int o = 1; o < 64; o <<= 1) v = fminf(v, __shfl_xor(v, o));
    return v;
}
#define LDS_WAIT() asm volatile("s_waitcnt lgkmcnt(0)" ::: "memory")
#define VM_WAIT() asm volatile("s_waitcnt vmcnt(0)" ::: "memory")

namespace pg8 {
constexpr int BM = 256, BK = 64, HALF = 128, HTB = HALF * BK * 2, STAGE_BYTES = 8 * HTB, NXCD = 8, WGM = 8;
__host__ __device__ __forceinline__ int lds_byte(int r, int c) { const int st = (r >> 4) * 2 + (c >> 5), rr = r & 15, cc = c & 31, ob = rr * 64 + cc * 2; return st * 1024 + (ob ^ (((ob >> 9) & 1) << 5)); }
__host__ __device__ __forceinline__ void stage_rc(int b, int& R, int& C) { const int st = b / 1024, sb = b % 1024, swz = sb ^ (((sb >> 9) & 1) << 5); R = (st >> 1) * 16 + swz / 64; C = (st & 1) * 32 + (swz % 64) / 2; }
__host__ __device__ __forceinline__ int perm32(int rho) { const int n = rho >> 4, i = rho & 15; return 8 * (i >> 2) + 4 * n + (i & 3); }

struct Unit { int pm, pn; };
struct Gemm { const bf16_t* A; const bf16_t* Bt; int M, N, K; int apitch; };

struct StaticOrder {
    int nM, nN, nwg, G, c;
    __host__ __device__ void init(int M, int N, int G_, int c_) { nM = M / BM; nN = N / BM; nwg = nM * nN; G = G_; c = c_; }
    __host__ __device__ bool next(int i, Unit& u) const {
        const long L = (long)i * G + c; if (L >= nwg) return false;
        int wgid = (int)L; { const int q = nwg / NXCD, r = nwg % NXCD, xcd = wgid % NXCD, off = wgid / NXCD; wgid = (xcd < r ? xcd * (q + 1) : r * (q + 1) + (xcd - r) * q) + off; }
        const int nig = WGM * nN, gid = wgid / nig, fm = gid * WGM, gsz = (nM - fm) < WGM ? (nM - fm) : WGM;
        u.pm = fm + ((wgid % nig) % gsz); u.pn = (wgid % nig) / gsz; return true;
    }
};
struct MoeOrder {
    const LAS int* blk_e; int nunits, G, c;
    __device__ __forceinline__ bool next(int i, Unit& u) const {
        const int L = i * G + c; if (L >= nunits) return false;
        const int rbg = L >> 2; u.pm = rbg; u.pn = blk_e[rbg] * 4 + (L & 3); return true;
    }
};

typedef int i32x8 __attribute__((ext_vector_type(8)));
typedef int i32x4_t __attribute__((ext_vector_type(4)));
constexpr int F8_WSCALE_E = 122;
template <class Epi, class Sched, bool ALIGN_EPI, bool GATHER, bool MIDHOOK = false, bool F8 = false>
__device__ __forceinline__ void gemm_phase(LAS unsigned char* lds, const Gemm g, const Sched& S, const Epi& E, const LAS int* rowtab) {
    const int tid = threadIdx.x, wid = __builtin_amdgcn_readfirstlane(tid >> 6), lane = tid & 63, wr = wid >> 2, wc = wid & 3, fr = lane & 15, fq = lane >> 4;
    const int K = g.K; int nt = K / BK;
    if constexpr (F8) asm volatile("" : "+s"(nt));
    int Rr[2]; unsigned cofs[2], voffB[2];
#pragma unroll
    for (int i = 0; i < 2; ++i) { int R, C; stage_rc(tid * 16 + i * 8192, R, C); const int Rb = Epi::PERM ? ((R & ~31) + perm32(R & 31)) : R;
        Rr[i] = R; cofs[i] = (unsigned)C * 2u; voffB[i] = (unsigned)(Rb * K + C) * 2u; }
    const unsigned rowb = g.apitch ? (unsigned)g.apitch : (unsigned)K * 2u;
    const size_t kstep = (size_t)(BK * 2);
    const size_t hstep = (size_t)HALF * K * 2;
    const size_t tstep = 2 * hstep;
    const unsigned ldsw = (unsigned)wid * 1024u;
    const int aoff = lds_byte(wr * 64 + fr, fq * 8), boff = lds_byte(wc * 32 + fr, fq * 8);
    const char* gA = (const char*)g.A;
#define PG8_SA(b, h) (((b) * 2 + (h)) * HTB)
#define PG8_SB(b, h) ((4 + (b) * 2 + (h)) * HTB)
#define PG8_STAGE(bufoff, gbase, voff) do { _Pragma("unroll") for (int _i = 0; _i < 2; ++_i) \
        __builtin_amdgcn_global_load_lds((const unsigned*)((const char*)(gbase) + (voff)[_i]), (LAS unsigned*)(lds + (bufoff) + ldsw + _i * 8192), 16, 0, 0); } while (0)
#define PG8_LD8(p_) __builtin_shufflevector(*(const LAS i32x4_t*)(p_), *(const LAS i32x4_t*)((p_) + 1024), 0, 1, 2, 3, 4, 5, 6, 7)
#define PG8_LDA(dst, b, h) do { if constexpr (F8) { _Pragma("unroll") for (int m = 0; m < 4; ++m) dst##8[m] = PG8_LD8(lds + PG8_SA(b, h) + aoff + m * 2048); } \
        else { _Pragma("unroll") for (int m = 0; m < 4; ++m) _Pragma("unroll") for (int k = 0; k < 2; ++k) dst[m][k] = *(const LAS bf16x8*)(lds + PG8_SA(b, h) + aoff + m * 2048 + k * 1024); } } while (0)
#define PG8_LDB(dst, b, h) do { if constexpr (F8) { _Pragma("unroll") for (int n = 0; n < 2; ++n) dst##8[n] = PG8_LD8(lds + PG8_SB(b, h) + boff + n * 2048); } \
        else { _Pragma("unroll") for (int n = 0; n < 2; ++n) _Pragma("unroll") for (int k = 0; k < 2; ++k) dst[n][k] = *(const LAS bf16x8*)(lds + PG8_SB(b, h) + boff + n * 2048 + k * 1024); } } while (0)
#define PG8_MMA(ai, bj, At, Bt) do { if constexpr (F8) __builtin_amdgcn_sched_barrier(0);     \
        __builtin_amdgcn_s_setprio(1); \
        if constexpr (F8) { _Pragma("unroll") for (int m = 0; m < 4; ++m) _Pragma("unroll") for (int n = 0; n < 2; ++n) \
            asm volatile("v_mfma_scale_f32_16x16x128_f8f6f4 %0, %1, %2, %0, %3, %4 op_sel_hi:[0,0,0]" : "+v"(acc[ai][bj][m][n]) : "v"(Bt##8[n]), "v"(At##8[m]), "v"(f8_sw), "v"(f8_sa));     \
            __builtin_amdgcn_sched_barrier(0); } \
        else { _Pragma("unroll") for (int m = 0; m < 4; ++m) _Pragma("unroll") for (int n = 0; n < 2; ++n) _Pragma("unroll") for (int k = 0; k < 2; ++k) \
            acc[ai][bj][m][n] = __builtin_amdgcn_mfma_f32_16x16x32_bf16(Bt[n][k], At[m][k], acc[ai][bj][m][n], 0, 0, 0); } \
        __builtin_amdgcn_s_setprio(0); } while (0)
#define PG8_WAIT_V(n) asm volatile("s_waitcnt vmcnt(" #n ")" ::: "memory")
#define PG8_WAIT_L(n) asm volatile("s_waitcnt lgkmcnt(" #n ")" ::: "memory")
#define PG8_BAR __builtin_amdgcn_s_barrier()
#define PG8_SCHED __builtin_amdgcn_sched_barrier(0)
#define PG8_AOFF(d0, d1, un, uidx) do { _Pragma("unroll") for (int _i = 0; _i < 2; ++_i) { unsigned r0_, r1_; \
        if (GATHER) { r0_ = (unsigned)rowtab[(uidx) * 256 + Rr[_i]]; r1_ = (unsigned)rowtab[(uidx) * 256 + 128 + Rr[_i]]; } \
        else { r0_ = (unsigned)((un).pm * 256 + Rr[_i]); r1_ = r0_ + 128u; } \
        d0[_i] = r0_ * rowb + cofs[_i]; d1[_i] = r1_ * rowb + cofs[_i]; } } while (0)
    Unit cur, nxt; int ui = 0;
    if (!S.next(0, cur)) return;
    f32x4 acc[2][2][4][2];
#pragma unroll
    for (int a = 0; a < 2; ++a)
#pragma unroll
        for (int b = 0; b < 2; ++b)
#pragma unroll
            for (int m = 0; m < 4; ++m)
#pragma unroll
                for (int n = 0; n < 2; ++n) acc[a][b][m][n] = (f32x4){0.f, 0.f, 0.f, 0.f};
    bf16x8 At[4][2], B0[2][2], B1[2][2]; i32x8 At8[4], B08[2], B18[2];
    int f8_sw = F8_WSCALE_E, f8_sa = 127; asm volatile("" : "+v"(f8_sw), "+v"(f8_sa));
    unsigned oc0[2], oc1[2], on0[2], on1[2];
    PG8_AOFF(oc0, oc1, cur, 0);
    const char* cB = (const char*)g.Bt + (size_t)cur.pn * tstep;
    PG8_STAGE(PG8_SB(0, 0), cB, voffB); PG8_STAGE(PG8_SB(0, 1), cB + hstep, voffB); PG8_STAGE(PG8_SA(0, 0), gA, oc0); PG8_STAGE(PG8_SA(0, 1), gA, oc1);
    if (wr == 1) PG8_BAR;
    PG8_WAIT_V(2); PG8_BAR;
    PG8_STAGE(PG8_SB(1, 0), cB + kstep, voffB); PG8_STAGE(PG8_SA(1, 0), gA + kstep, oc0); PG8_STAGE(PG8_SB(1, 1), cB + hstep + kstep, voffB);
    PG8_WAIT_V(6); PG8_BAR;
    for (;;) {
        const bool has_next = S.next(ui + 1, nxt);
        if (has_next) { PG8_AOFF(on0, on1, nxt, ui + 1); } else { on0[0] = oc0[0]; on0[1] = oc0[1]; on1[0] = oc1[0]; on1[1] = oc1[1]; }
        const char* nB = has_next ? (const char*)g.Bt + (size_t)nxt.pn * tstep : cB;
        for (int t = 0; t < nt; t += 2) {
            if constexpr (MIDHOOK) { if (t == nt / 2) E.mid(acc, cur, wr, wc, fr, fq); }
            const bool last = (t == nt - 2);
            const char* a1 = gA + (size_t)(t + 1) * kstep;
            const char* a2 = last ? gA : gA + (size_t)(t + 2) * kstep; const char* b2 = last ? nB : cB + (size_t)(t + 2) * kstep;
            const char* a3 = a2 + kstep; const char* b3 = b2 + kstep;
            unsigned o20[2], o21[2];
            o20[0] = last ? on0[0] : oc0[0]; o20[1] = last ? on0[1] : oc0[1]; o21[0] = last ? on1[0] : oc1[0]; o21[1] = last ? on1[1] : oc1[1];
            PG8_LDB(B0, 0, 0); PG8_LDB(B1, 0, 1); PG8_SCHED; PG8_LDA(At, 0, 0); PG8_STAGE(PG8_SA(1, 1), a1, oc1);
            PG8_WAIT_V(8); PG8_WAIT_L(0); PG8_BAR; PG8_MMA(0, 0, At, B0); PG8_MMA(0, 1, At, B1); PG8_BAR; PG8_SCHED;
            PG8_LDA(At, 0, 1); PG8_STAGE(PG8_SB(0, 0), b2, voffB); PG8_STAGE(PG8_SB(0, 1), b2 + hstep, voffB); PG8_STAGE(PG8_SA(0, 0), a2, o20);
            PG8_WAIT_V(8); PG8_WAIT_L(0); PG8_BAR; PG8_MMA(1, 0, At, B0); PG8_MMA(1, 1, At, B1); PG8_BAR; PG8_SCHED;
            PG8_LDB(B0, 1, 0); PG8_LDB(B1, 1, 1); PG8_SCHED; PG8_LDA(At, 1, 0); PG8_STAGE(PG8_SA(0, 1), a2, o21);
            PG8_WAIT_V(8); PG8_WAIT_L(0); PG8_BAR; PG8_MMA(0, 0, At, B0); PG8_MMA(0, 1, At, B1); PG8_BAR; PG8_SCHED;
            PG8_LDA(At, 1, 1); PG8_STAGE(PG8_SB(1, 0), b3, voffB); PG8_STAGE(PG8_SB(1, 1), b3 + hstep, voffB); PG8_STAGE(PG8_SA(1, 0), a3, o20);
            PG8_WAIT_V(8); PG8_WAIT_L(0); PG8_BAR; PG8_MMA(1, 0, At, B0); PG8_MMA(1, 1, At, B1); PG8_BAR; PG8_SCHED;
        }
        if constexpr (ALIGN_EPI) { if (wr == 0) PG8_BAR; }
        if constexpr (F8) asm volatile("s_nop 15\n\ts_nop 15" ::: "memory");
        E(acc, cur, wr, wc, fr, fq);
#ifdef PROBE_EPI2
        if constexpr (!MIDHOOK && !F8 && !GATHER) E(acc, cur, wr, wc, fr, fq);
#endif
        if (!has_next) break;
#pragma unroll
        for (int a = 0; a < 2; ++a)
#pragma unroll
            for (int b = 0; b < 2; ++b)
#pragma unroll
                for (int m = 0; m < 4; ++m)
#pragma unroll
                    for (int n = 0; n < 2; ++n) acc[a][b][m][n] = (f32x4){0.f, 0.f, 0.f, 0.f};
        cur = nxt; cB = nB; ++ui;
        oc0[0] = on0[0]; oc0[1] = on0[1]; oc1[0] = on1[0]; oc1[1] = on1[1];
        if constexpr (ALIGN_EPI) { if (wr == 1) PG8_BAR; }
    }
    PG8_WAIT_V(0);
    if constexpr (!ALIGN_EPI) { if (wr == 0) PG8_BAR; }
    PG8_BAR;
#undef PG8_SA
#undef PG8_SB
#undef PG8_STAGE
#undef PG8_LDA
#undef PG8_LDB
#undef PG8_MMA
#undef PG8_LD8
#undef PG8_WAIT_V
#undef PG8_WAIT_L
#undef PG8_BAR
#undef PG8_SCHED
#undef PG8_AOFF
}
}

typedef f32x4 AccT[2][2][4][2];
__device__ __forceinline__ void store8bf(bf16_t* p, const f32x4& v0, const f32x4& v1) {
    u32x4 w; w.x = pkbf(v0[0], v0[1]); w.y = pkbf(v0[2], v0[3]); w.z = pkbf(v1[0], v1[1]); w.w = pkbf(v1[2], v1[3]); *(u32x4*)p = w;
}
__device__ __forceinline__ void rope8(f32x4& v0, f32x4& v1, const float* rope, int pos, int i0) {
    const f32x4 c = *(const f32x4*)(rope + pos * 8 + i0), s = *(const f32x4*)(rope + SEQ * 8 + pos * 8 + i0);
    float a, b;
    a = v0[0]; b = v0[1]; v0[0] = a * c[0] - b * s[0]; v0[1] = b * c[0] + a * s[0];
    a = v0[2]; b = v0[3]; v0[2] = a * c[1] - b * s[1]; v0[3] = b * c[1] + a * s[1];
    a = v1[0]; b = v1[1]; v1[0] = a * c[2] - b * s[2]; v1[1] = b * c[2] + a * s[2];
    a = v1[2]; b = v1[3]; v1[2] = a * c[3] - b * s[3]; v1[3] = b * c[3] + a * s[3];
}
__device__ __forceinline__ float sigmoidf_(float z) { return __builtin_amdgcn_rcpf(1.0f + __expf(-z)); }

struct EpiProj {
    static constexpr bool PERM = true;
    bf16_t *q, *k, *v, *qi, *ki, *u, *cb, *ga, *rt; float* wi; const float* rope; const float* gate_bias;
    __device__ __forceinline__ void operator()(const AccT& acc, const pg8::Unit& un, int wr, int wc, int fr, int fq) const {
        const int pn = un.pn, row0 = un.pm * 256 + wr * 64 + fr, cg = 32 * wc + 8 * fq;
        const bool rot = ((wc & 1) == 0) && (fq < 2); const int i0 = 4 * fq;
        if (pn < 2 || pn == 3 || pn == 4) {
            bf16_t* dst = (pn < 2) ? q + pn * 256 : qi + (pn - 3) * 256; const float sc = (pn < 2) ? C2 : 1.0f;
#pragma unroll
            for (int ai = 0; ai < 2; ++ai)
#pragma unroll
                for (int m = 0; m < 4; ++m) { const int row = row0 + ai * 128 + m * 16, pos = row & (SEQ - 1);
#pragma unroll
                    for (int bj = 0; bj < 2; ++bj) { f32x4 v0 = acc[ai][bj][m][0], v1 = acc[ai][bj][m][1];
                        if (rot) rope8(v0, v1, rope, pos, i0);
                        v0 = v0 * sc; v1 = v1 * sc; store8bf(dst + (size_t)row * 512 + bj * 128 + cg, v0, v1); } }
        } else if (pn == 2) {
#pragma unroll
            for (int ai = 0; ai < 2; ++ai)
#pragma unroll
                for (int m = 0; m < 4; ++m) { const int row = row0 + ai * 128 + m * 16, pos = row & (SEQ - 1);
                    f32x4 v0 = acc[ai][0][m][0], v1 = acc[ai][0][m][1];
                    if (rot) rope8(v0, v1, rope, pos, i0);
                    store8bf(k + (size_t)row * 128 + cg, v0, v1);
                    store8bf(v + (size_t)row * 128 + cg, acc[ai][1][m][0], acc[ai][1][m][1]); }
        } else if (pn == 5) {
            if (wc < 2) {
#pragma unroll
                for (int ai = 0; ai < 2; ++ai)
#pragma unroll
                    for (int m = 0; m < 4; ++m) { const int row = row0 + ai * 128 + m * 16, pos = row & (SEQ - 1);
                        f32x4 v0 = acc[ai][0][m][0], v1 = acc[ai][0][m][1];
                        if (rot) rope8(v0, v1, rope, pos, i0);
                        { const int jch = cg >> 3; store8bf(ki + ((size_t)(row >> 5) * 4 + (jch >> 1)) * 512 + (row & 31) * 16 + (jch & 1) * 8, v0, v1); } }
            } else if (wc == 2 && fq == 0) {
#pragma unroll
                for (int ai = 0; ai < 2; ++ai)
#pragma unroll
                    for (int m = 0; m < 4; ++m) { const int row = row0 + ai * 128 + m * 16;
                        *(f32x4*)(wi + (size_t)row * 8) = acc[ai][0][m][0]; *(f32x4*)(wi + (size_t)row * 8 + 4) = acc[ai][0][m][1]; }
            }
        } else if (pn < 10) {
#pragma unroll
            for (int ai = 0; ai < 2; ++ai)
#pragma unroll
                for (int m = 0; m < 4; ++m) { const int row = row0 + ai * 128 + m * 16;
                    store8bf(u + (size_t)row * 512 + (pn - 6) * 128 + cg, acc[ai][0][m][0] * acc[ai][1][m][0], acc[ai][0][m][1] * acc[ai][1][m][1]); }
        } else if (pn < 12) {
#pragma unroll
            for (int ai = 0; ai < 2; ++ai)
#pragma unroll
                for (int m = 0; m < 4; ++m) { const int row = row0 + ai * 128 + m * 16;
#pragma unroll
                    for (int bj = 0; bj < 2; ++bj) store8bf(cb + (size_t)row * 512 + (pn - 10) * 256 + bj * 128 + cg, acc[ai][bj][m][0], acc[ai][bj][m][1]); }
        } else {
            const int gc0 = (pn - 12) * 128 + cg;
            const f32x4 ba0 = *(const f32x4*)(gate_bias + gc0), ba1 = *(const f32x4*)(gate_bias + gc0 + 4), bc0 = *(const f32x4*)(gate_bias + 1024 + gc0), bc1 = *(const f32x4*)(gate_bias + 1024 + gc0 + 4);
#pragma unroll
            for (int ai = 0; ai < 2; ++ai)
#pragma unroll
                for (int m = 0; m < 4; ++m) { const int row = row0 + ai * 128 + m * 16;
                    const f32x4 a0 = acc[ai][0][m][0] + ba0, a1 = acc[ai][0][m][1] + ba1, c0 = acc[ai][1][m][0] + bc0, c1 = acc[ai][1][m][1] + bc1;
                    f32x4 g0, g1, r0, r1;
#pragma unroll
                    for (int e = 0; e < 4; ++e) { const float ea0 = 1.0f + __expf(-a0[e]), ea1 = 1.0f + __expf(-a1[e]);
                        g0[e] = __builtin_amdgcn_rcpf(ea0); g1[e] = __builtin_amdgcn_rcpf(ea1);
                        r0[e] = ea0 * __builtin_amdgcn_rcpf(1.0f + __expf(-c0[e])); r1[e] = ea1 * __builtin_amdgcn_rcpf(1.0f + __expf(-c1[e])); }
                    store8bf(ga + (size_t)row * 1024 + gc0, g0, g1); store8bf(rt + (size_t)row * 1024 + gc0, r0, r1); }
        }
    }
};
struct EpiMerged {
    static constexpr bool PERM = true;
    const bf16_t* ga; const bf16_t* rt; bf16_t* out;
    __device__ __forceinline__ void scale(AccT& acc, const bf16_t* gsrc, const pg8::Unit& un, int wr, int wc, int fr, int fq) const {
        unsigned off0 = (unsigned)(un.pm * 256 + wr * 64 + fr) * 1024u + (unsigned)(un.pn * 256 + 32 * wc + 8 * fq);
        asm volatile("" : "+v"(off0));
#pragma unroll
        for (int ai = 0; ai < 2; ++ai)
#pragma unroll
            for (int m = 0; m < 4; ++m) {
#pragma unroll
                for (int bj = 0; bj < 2; ++bj) { const u32x4 gw = __builtin_nontemporal_load((const u32x4*)(gsrc + (off0 + (unsigned)((ai * 128 + m * 16) * 1024 + bj * 128))));
                    f32x4& v0 = acc[ai][bj][m][0]; f32x4& v1 = acc[ai][bj][m][1];
                    v0[0] *= bflo(gw.x); v0[1] *= bfhi(gw.x); v0[2] *= bflo(gw.y); v0[3] *= bfhi(gw.y);
                    v1[0] *= bflo(gw.z); v1[1] *= bfhi(gw.z); v1[2] *= bflo(gw.w); v1[3] *= bfhi(gw.w); } }
    }
    __device__ __forceinline__ void mid(AccT& acc, const pg8::Unit& un, int wr, int wc, int fr, int fq) const { scale(acc, rt, un, wr, wc, fr, fq); }
    __device__ __forceinline__ void operator()(AccT& acc, const pg8::Unit& un, int wr, int wc, int fr, int fq) const {
        scale(acc, ga, un, wr, wc, fr, fq);
        const int row0 = un.pm * 256 + wr * 64 + fr, col0 = un.pn * 256 + 32 * wc + 8 * fq;
#pragma unroll
        for (int ai = 0; ai < 2; ++ai)
#pragma unroll
            for (int m = 0; m < 4; ++m) { const int row = row0 + ai * 128 + m * 16;
#pragma unroll
                for (int bj = 0; bj < 2; ++bj) store8bf(out + (size_t)row * 1024 + col0 + bj * 128, acc[ai][bj][m][0], acc[ai][bj][m][1]); }
    }
};
struct EpiOut {
    static constexpr bool PERM = true;
    bf16_t* mix;
    __device__ __forceinline__ void operator()(const AccT& acc, const pg8::Unit& un, int wr, int wc, int fr, int fq) const {
        const int row0 = un.pm * 256 + wr * 64 + fr, col0 = un.pn * 256 + 32 * wc + 8 * fq;
#pragma unroll
        for (int ai = 0; ai < 2; ++ai)
#pragma unroll
            for (int m = 0; m < 4; ++m) { const int row = row0 + ai * 128 + m * 16;
#pragma unroll
                for (int bj = 0; bj < 2; ++bj) store8bf(mix + (size_t)row * 1024 + col0 + bj * 128, acc[ai][bj][m][0], acc[ai][bj][m][1]); }
    }
};
struct EpiSwiGLU {
    static constexpr bool PERM = true;
    unsigned char* hid;
    __device__ __forceinline__ void operator()(const AccT& acc, const pg8::Unit& un, int wr, int wc, int fr, int fq) const {
        const int row0 = un.pm * 256 + wr * 64 + fr, col0 = (un.pn & 3) * 128 + 32 * wc + 8 * fq;
#pragma unroll
        for (int ai = 0; ai < 2; ++ai)
#pragma unroll
            for (int m = 0; m < 4; ++m) { const int row = row0 + ai * 128 + m * 16; f32x4 h0, h1;
#pragma unroll
                for (int e = 0; e < 4; ++e) { const float g0 = acc[ai][0][m][0][e], g1 = acc[ai][0][m][1][e];
                    h0[e] = g0 * sigmoidf_(g0) * acc[ai][1][m][0][e]; h1[e] = g1 * sigmoidf_(g1) * acc[ai][1][m][1][e]; }
                int w0 = 0, w1 = 0;
                w0 = __builtin_amdgcn_cvt_pk_fp8_f32(h0[0], h0[1], w0, false); w0 = __builtin_amdgcn_cvt_pk_fp8_f32(h0[2], h0[3], w0, true);
                w1 = __builtin_amdgcn_cvt_pk_fp8_f32(h1[0], h1[1], w1, false); w1 = __builtin_amdgcn_cvt_pk_fp8_f32(h1[2], h1[3], w1, true);
                *(u32x2*)(hid + (size_t)row * 512 + col0) = (u32x2){(unsigned)w0, (unsigned)w1}; }
    }
};
struct EpiYs {
    static constexpr bool PERM = true;
    unsigned char* ys;
    __device__ __forceinline__ void operator()(const AccT& acc, const pg8::Unit& un, int wr, int wc, int fr, int fq) const {
        const int row0 = un.pm * 256 + wr * 64 + fr, col0 = (un.pn & 3) * 256 + 32 * wc + 8 * fq;
#pragma unroll
        for (int ai = 0; ai < 2; ++ai)
#pragma unroll
            for (int m = 0; m < 4; ++m) { const int row = row0 + ai * 128 + m * 16;
#pragma unroll
                for (int bj = 0; bj < 2; ++bj) { const f32x4 v0 = acc[ai][bj][m][0], v1 = acc[ai][bj][m][1]; int w0 = 0, w1 = 0;
                    w0 = __builtin_amdgcn_cvt_pk_fp8_f32(v0[0], v0[1], w0, false); w0 = __builtin_amdgcn_cvt_pk_fp8_f32(v0[2], v0[3], w0, true);
                    w1 = __builtin_amdgcn_cvt_pk_fp8_f32(v1[0], v1[1], w1, false); w1 = __builtin_amdgcn_cvt_pk_fp8_f32(v1[2], v1[3], w1, true);
                    *(u32x2*)(ys + (size_t)row * 1024 + col0 + bj * 128) = (u32x2){(unsigned)w0, (unsigned)w1}; } }
    }
};

namespace attn_body {
using bf16 = __hip_bfloat16;
constexpr int D = 64, QP = 512, KP = 128, OP = 1024, OCOL = 512;
constexpr int NW = 8, QBLK = 32, QB = QBLK * NW, KVBLK = 64;
__device__ __forceinline__ int crow(int r, int hi) { return (r & 3) + 8 * (r >> 2) + 4 * hi; }
#define SBAR() __builtin_amdgcn_sched_barrier(0)
__device__ __forceinline__ void cmask(f32x16& p0, f32x16& p1, int jb, int qrel, int hi) {
    const float NEG = -INFINITY; int kb = 64 * jb + 4 * hi;
#pragma unroll
    for (int r = 0; r < 16; ++r) { int kv = kb + (r & 3) + 8 * (r >> 2); if (kv > qrel) p0[r] = NEG; if (kv + 32 > qrel) p1[r] = NEG; }
}
constexpr int NSLOT = 3, SLOTB = 8192;
constexpr int LDS_K = 0, LDS_V = NSLOT * SLOTB, LDS_WS = 2 * NSLOT * SLOTB, LDS_OST = LDS_WS + NW * 64 * 4, LDS_QF = LDS_OST + NW * 4096, LDS_BYTES_A = LDS_QF + NW * 4096;
static_assert(LDS_BYTES_A <= 131072, "attention LDS");
__device__ __forceinline__ void glds16(const void* gsrc, unsigned lds_dst) { unsigned keep;
    asm volatile("s_mov_b32 %0, m0\n\ts_mov_b32 m0, %2\n\ts_nop 0\n\tglobal_load_lds_dwordx4 %1, off\n\ts_mov_b32 m0, %0" : "=&s"(keep) : "v"(gsrc), "s"(lds_dst) : "memory"); }
__device__ __forceinline__ float max3f(float a, float b, float c) { float r; asm("v_max3_f32 %0, %1, %2, %3" : "=v"(r) : "v"(a), "v"(b), "v"(c)); return r; }
__device__ __forceinline__ float max2f(float a, float b) { float r; asm("v_max_f32_e32 %0, %1, %2" : "=v"(r) : "v"(a), "v"(b)); return r; }
__device__ __forceinline__ float fadd_s(float a, float b) { float r; asm("v_add_f32_e32 %0, %1, %2" : "=v"(r) : "v"(a), "v"(b)); return r; }
__device__ __forceinline__ float fsub_s(float a, float b) { float r; asm("v_sub_f32_e32 %0, %1, %2" : "=v"(r) : "v"(a), "v"(b)); return r; }
__device__ __forceinline__ unsigned cvtpk_s(float lo, float hi) { return pkbf(lo, hi); }
__device__ __forceinline__ float msel(float x, float neg, unsigned long long m) { float r; asm("v_cndmask_b32_e64 %0, %1, %2, %3" : "=v"(r) : "v"(neg), "v"(x), "s"(m)); return r; }
#define WAIT_BAR(N) asm volatile("s_waitcnt vmcnt(" #N ") lgkmcnt(0)\n\ts_barrier" ::: "memory")

typedef __attribute__((address_space(3))) const char* lds_cptr;
__device__ __forceinline__ void qkt(f32x16& p0, f32x16& p1, const char* Kslot, lds_cptr qfp, const f32x16& negm, int r32, int hi) {
    const char* kb = Kslot + hi * 1024 + r32 * 16;
#pragma unroll
    for (int d0 = 0; d0 < 4; ++d0) {
        const bf16x8 b0 = *reinterpret_cast<const bf16x8*>(kb + d0 * 2048);
        const bf16x8 b1 = *reinterpret_cast<const bf16x8*>(kb + d0 * 2048 + 512);
        const bf16x8 qd = *(const LAS bf16x8*)(qfp + d0 * 1024);
        if (d0 == 0) { p0 = __builtin_amdgcn_mfma_f32_32x32x16_bf16(b0, qd, negm, 0, 0, 0); p1 = __builtin_amdgcn_mfma_f32_32x32x16_bf16(b1, qd, negm, 0, 0, 0); }
        else { p0 = __builtin_amdgcn_mfma_f32_32x32x16_bf16(b0, qd, p0, 0, 0, 0); p1 = __builtin_amdgcn_mfma_f32_32x32x16_bf16(b1, qd, p1, 0, 0, 0); } }
}
typedef short v4i16_t __attribute__((ext_vector_type(4)));
__device__ __forceinline__ void kload8(bf16x8* kf, lds_cptr kp) {
    kf[0] = *(const LAS bf16x8*)(kp);        kf[1] = *(const LAS bf16x8*)(kp + 512);
    kf[2] = *(const LAS bf16x8*)(kp + 2048); kf[3] = *(const LAS bf16x8*)(kp + 2560);
    kf[4] = *(const LAS bf16x8*)(kp + 4096); kf[5] = *(const LAS bf16x8*)(kp + 4608);
    kf[6] = *(const LAS bf16x8*)(kp + 6144); kf[7] = *(const LAS bf16x8*)(kp + 6656);
}
__device__ __forceinline__ void kload2(bf16x8* kf, lds_cptr kp, int j) { kf[2 * j] = *(const LAS bf16x8*)(kp + j * 2048); kf[2 * j + 1] = *(const LAS bf16x8*)(kp + j * 2048 + 512); }
__device__ __forceinline__ s16x4 vtr(lds_cptr p) { return __builtin_bit_cast(s16x4, __builtin_amdgcn_ds_read_tr16_b64_v4i16((LAS v4i16_t*)p)); }
__device__ __forceinline__ float rowmax(const f32x16& p0, const f32x16& p1) {
    float a = max3f(p0[0], p0[1], p1[0]), b = max3f(p0[2], p0[3], p1[1]); a = max3f(a, p1[2], p1[3]);
#pragma unroll
    for (int r = 4; r < 16; r += 4) { a = max3f(a, p0[r], p0[r + 1]); b = max3f(b, p0[r + 2], p0[r + 3]); a = max3f(a, p1[r], p1[r + 1]); b = max3f(b, p1[r + 2], p1[r + 3]); }
    const float m = max2f(a, b);
    auto rr = __builtin_amdgcn_permlane32_swap(__float_as_uint(m), __float_as_uint(m), false, false);
    return max2f(__uint_as_float(rr[0]), __uint_as_float(rr[1]));
}
__device__ __forceinline__ void pv(f32x16* o, int vb, bf16x8 pa0, bf16x8 pa1, bf16x8 pa2, bf16x8 pa3) {
#pragma unroll
    for (int d0 = 0; d0 < 2; ++d0) { s16x4 lo[4], hi[4];
#pragma unroll
        for (int ks = 0; ks < 4; ++ks) {
            asm volatile("ds_read_b64_tr_b16 %0,%1 offset:%c2" : "=&v"(lo[ks]) : "v"(vb), "i"(d0 * 4096 + ks * 1024) : "memory");
            asm volatile("ds_read_b64_tr_b16 %0,%1 offset:%c2" : "=&v"(hi[ks]) : "v"(vb), "i"(d0 * 4096 + ks * 1024 + 512) : "memory"); }
        asm volatile("s_waitcnt lgkmcnt(0)" ::: "memory"); SBAR();
#define PK(k) (bf16x8){lo[k][0], lo[k][1], lo[k][2], lo[k][3], hi[k][0], hi[k][1], hi[k][2], hi[k][3]}
        o[d0] = __builtin_amdgcn_mfma_f32_32x32x16_bf16(pa0, PK(0), o[d0], 0, 0, 0);
        o[d0] = __builtin_amdgcn_mfma_f32_32x32x16_bf16(pa1, PK(1), o[d0], 0, 0, 0);
        o[d0] = __builtin_amdgcn_mfma_f32_32x32x16_bf16(pa2, PK(2), o[d0], 0, 0, 0);
        o[d0] = __builtin_amdgcn_mfma_f32_32x32x16_bf16(pa3, PK(3), o[d0], 0, 0, 0);
#undef PK
    }
}
#define ATTN_STORE16(p, v) (*(u32x4*)(p) = (v))
template <int THRL> __device__ __forceinline__ void attn_unit(int b, int h, int qb, const bf16* Q, const bf16* __restrict__ K, const bf16* __restrict__ V, bf16* O, const unsigned* masks, char* shm) {
    const int tid = threadIdx.x, lane = tid & 63, r32 = lane & 31, hi = lane >> 5; const int wid = __builtin_amdgcn_readfirstlane(tid >> 6);
    const long rowbase = (long)b * SEQ; const int q0 = qb * QB;
    const bf16* Qw = Q + (rowbase + q0 + wid * QBLK) * QP + h * D;
    const bf16 *Kh = K + rowbase * KP + (h >> 2) * D, *Vh = V + rowbase * KP + (h >> 2) * D;
    const unsigned* mrow = masks + ((size_t)(b * (SEQ / 32) + (q0 >> 5) + wid) * (SEQ / 64)) * 64;
    const unsigned lds0 = (unsigned)(uintptr_t)shm;
    float* wsf = (float*)(shm + LDS_WS) + wid * 64;
    const bf16* ksrc = Kh + (long)lane * KP + wid * 8;
    const bf16* vsrc = Vh + (long)(16 * (wid & 3) + (lane >> 2)) * KP + (wid >> 2) * 32 + (lane & 3) * 8;
    const unsigned kdst = lds0 + LDS_K + wid * 1024, vdst = lds0 + LDS_V + wid * 1024;
#define DMA_K(t, slot) glds16(ksrc + (long)(t) * KVBLK * KP, (unsigned)__builtin_amdgcn_readfirstlane(kdst + (slot)))
#define DMA_V(t, slot) glds16(vsrc + (long)(t) * KVBLK * KP, (unsigned)__builtin_amdgcn_readfirstlane(vdst + (slot)))
    const int vb0 = (int)(lds0 + LDS_V) + ((lane >> 4) & 1) * 32 + (lane & 3) * 8 + (4 * hi + ((lane & 15) >> 2)) * 64;
    const char* Kbase = shm + LDS_K; bf16x8 kf[8];
    const lds_cptr shm3 = (lds_cptr)shm; const lds_cptr kp0 = shm3 + LDS_K + hi * 1024 + r32 * 16; const lds_cptr vp0 = shm3 + LDS_V + ((lane >> 4) & 1) * 32 + (lane & 3) * 8 + (4 * hi + ((lane & 15) >> 2)) * 64;
    const int NT = (q0 + QB) / KVBLK;
    u32x16 mA, mB;
#define MLOAD0(t) do { const unsigned* mp_ = mrow + (size_t)(t) * 64; \
        asm volatile("s_load_dwordx16 %0, %1, 0x0" : "=s"(mA) : "s"(mp_)); asm volatile("s_load_dwordx16 %0, %1, 0x40" : "=s"(mB) : "s"(mp_)); } while (0)
#define MLOAD1(t) do { const unsigned* mp_ = mrow + (size_t)(t) * 64; \
        asm volatile("s_load_dwordx16 %0, %1, 0x80" : "=s"(mA) : "s"(mp_)); asm volatile("s_load_dwordx16 %0, %1, 0xc0" : "=s"(mB) : "s"(mp_)); } while (0)
#define MPAIR(M, j) (((unsigned long long)(M)[2 * (j) + 1] << 32) | (unsigned long long)(M)[2 * (j)])
#define MAPPLY(P) do { asm volatile("s_waitcnt lgkmcnt(0)" : "+s"(mA), "+s"(mB)); const float NEG_ = -INFINITY; \
        _Pragma("unroll") for (int r = 0; r < 8; ++r) { P[r] = msel(P[r], NEG_, MPAIR(mA, r)); P[r + 8] = msel(P[r + 8], NEG_, MPAIR(mB, r)); } } while (0)
    DMA_K(0, 0); DMA_V(0, 0); DMA_K(1, SLOTB);
    MLOAD0(0);
    const lds_cptr qfp = shm3 + LDS_QF + wid * 4096 + lane * 16;
    { bf16x8 qr[4];
#pragma unroll
      for (int d0 = 0; d0 < 4; ++d0) qr[d0] = *reinterpret_cast<const bf16x8*>(&Qw[(long)r32 * QP + d0 * 16 + hi * 8]);
#pragma unroll
      for (int d0 = 0; d0 < 4; ++d0) *(LAS bf16x8*)(LAS char*)(qfp + d0 * 1024) = qr[d0]; }
#define QF(i) (*(const LAS bf16x8*)(qfp + (i) * 1024))
    float mhat = 0.f, l_reg = 0.f; f32x16 o[2]; o[0] = f32x16{}; o[1] = f32x16{}; f32x16 negm = f32x16{}; asm volatile("" : "+v"(negm));
    const int qrel = wid * QBLK + r32;
#define CMASK(P0, P1, t) do { int jb_ = (t) - (NT - 4); if (jb_ >= 0) cmask(P0, P1, jb_, qrel, hi); } while (0)
    bool resc = false;
#define START(P0, P1) do { const float rm = rowmax(P0, P1); resc = false; \
    { const float dl = rm; mhat = fadd_s(mhat, dl); \
      _Pragma("unroll") for (int r = 0; r < 16; ++r) { P0[r] = fsub_s(P0[r], dl); P1[r] = fsub_s(P1[r], dl); } \
      _Pragma("unroll") for (int r = 0; r < 16; ++r) negm[r] = -mhat; asm volatile("" : "+v"(negm)); } } while (0)
#define RESC() do { if (resc) { asm volatile("s_waitcnt lgkmcnt(0)" ::: "memory"); \
      _Pragma("unroll") for (int d_ = 0; d_ < 2; ++d_) _Pragma("unroll") for (int r = 0; r < 16; ++r) o[d_][r] *= wsf[crow(r, hi)]; } } while (0)
    f32x16 pA0, pA1, pB0, pB1;
    int sl_prev = 0, sl_cur = 0, sl_next = SLOTB;
#define ROT() do { sl_prev = sl_cur; sl_cur = sl_next; sl_next = (sl_next == (NSLOT - 1) * SLOTB) ? 0 : sl_next + SLOTB; } while (0)
    DMA_K(2, 2 * SLOTB);
    WAIT_BAR(3);
    qkt(pA0, pA1, Kbase, qfp, negm, r32, hi); asm volatile("s_nop 15\n\ts_nop 7" : "+v"(pA0), "+v"(pA1)); CMASK(pA0, pA1, 0);
    START(pA0, pA1);
    MAPPLY(pA0); MLOAD1(0); MAPPLY(pA1); MLOAD0(1);
    _Pragma("unroll") for (int r = 0; r < 16; ++r) { pA0[r] = __builtin_amdgcn_exp2f(pA0[r]); pA1[r] = __builtin_amdgcn_exp2f(pA1[r]); }
    WAIT_BAR(0);
    DMA_K(3, 0); DMA_V(1, SLOTB);
    ROT();
    kload8(kf, kp0 + sl_cur);
    WAIT_BAR(2);
    s16x4 vlo[8], vhi[8]; u32x4 pw0, pw1, pw2, pw3;
#define PKW(P, B) cvtpk_s(P[B], P[B + 1])
#define PAF(k) __builtin_bit_cast(bf16x8, pw##k)
#define VFR(i) (bf16x8){vlo[i][0], vlo[i][1], vlo[i][2], vlo[i][3], vhi[i][0], vhi[i][1], vhi[i][2], vhi[i][3]}
#define PIN(x) asm volatile("" : "+v"(x))
#define MX3(a, b, c) __builtin_fmaxf(__builtin_fmaxf((a), (b)), (c))
#define GAPA(MF, A0, A1, A2, A3, W0, W1, PW) do { MF; sacc += A0; sacc += A1; sacc += A2; sacc += A3; PIN(sacc); W0; W1; PIN(PW); SBAR(); } while (0)
#define EX(v) __builtin_amdgcn_exp2f(v)
#define GAPB(MF, X, B) do { MF; X[B] = EX(X[B]); X[B + 1] = EX(X[B + 1]); X[B + 2] = EX(X[B + 2]); X[B + 3] = EX(X[B + 3]); PIN(X); SBAR(); } while (0)
#define VRD(i) do { vlo[i] = vtr(vp_ + (((i) >> 2) * 4096 + ((i) & 3) * 1024)); vhi[i] = vtr(vp_ + (((i) >> 2) * 4096 + ((i) & 3) * 1024 + 512)); } while (0)
#define KRD(G, j) do { if (G) { kload2(kf, kp0 + sl_next, j); SBAR(); } } while (0)
#define STEP(C0, C1, P0, P1, t, GK, GV, GL, GM) do { SBAR(); \
    const lds_cptr vp_ = vp0 + sl_prev; \
    VRD(0); bf16x8 qa_ = QF(0), qb_ = QF(1); SBAR(); float sacc = (P0[0] + P0[1]); \
    GAPA(C0 = __builtin_amdgcn_mfma_f32_32x32x16_bf16(kf[0], qa_, negm, 0, 0, 0), P0[2], P0[3], P0[4], P0[5],     pw0[0] = PKW(P0, 0), pw0[1] = PKW(P0, 2), pw0); \
    VRD(4); SBAR(); GAPA(C1 = __builtin_amdgcn_mfma_f32_32x32x16_bf16(kf[1], qa_, negm, 0, 0, 0), P0[6], P0[7], P0[8], P0[9],     pw0[2] = PKW(P0, 4), pw0[3] = PKW(P0, 6), pw0); \
    VRD(1); qa_ = QF(2); SBAR(); GAPA(C0 = __builtin_amdgcn_mfma_f32_32x32x16_bf16(kf[2], qb_, C0, 0, 0, 0),   P0[10], P0[11], P0[12], P0[13], pw1[0] = PKW(P0, 8), pw1[1] = PKW(P0, 10), pw1); \
    VRD(5); SBAR(); GAPA(C1 = __builtin_amdgcn_mfma_f32_32x32x16_bf16(kf[3], qb_, C1, 0, 0, 0),   P0[14], P0[15], P1[0], P1[1],   pw1[2] = PKW(P0, 12), pw1[3] = PKW(P0, 14), pw1); \
    VRD(2); qb_ = QF(3); SBAR(); GAPA(C0 = __builtin_amdgcn_mfma_f32_32x32x16_bf16(kf[4], qa_, C0, 0, 0, 0),   P1[2], P1[3], P1[4], P1[5],     pw2[0] = PKW(P1, 0), pw2[1] = PKW(P1, 2), pw2); \
    VRD(6); SBAR(); GAPA(C1 = __builtin_amdgcn_mfma_f32_32x32x16_bf16(kf[5], qa_, C1, 0, 0, 0),   P1[6], P1[7], P1[8], P1[9],     pw2[2] = PKW(P1, 4), pw2[3] = PKW(P1, 6), pw2); \
    VRD(3); SBAR(); GAPA(C0 = __builtin_amdgcn_mfma_f32_32x32x16_bf16(kf[6], qb_, C0, 0, 0, 0),   P1[10], P1[11], P1[12], P1[13], pw3[0] = PKW(P1, 8), pw3[1] = PKW(P1, 10), pw3); \
    VRD(7); SBAR(); GAPA(C1 = __builtin_amdgcn_mfma_f32_32x32x16_bf16(kf[7], qb_, C1, 0, 0, 0),   P1[14], P1[15], 0.f, 0.f,       pw3[2] = PKW(P1, 12), pw3[3] = PKW(P1, 14), pw3); \
    l_reg += sacc; \
    if (GK) { DMA_K((t) + 3, sl_cur); } if (GV) { DMA_V((t) + 1, sl_next); } \
    CMASK(C0, C1, t); \
    { float a = MX3(C0[0], C0[1], C1[0]), b = MX3(C0[2], C0[3], C1[1]); a = MX3(a, C1[2], C1[3]); \
      _Pragma("unroll") for (int r = 4; r < 16; r += 4) { a = MX3(a, C0[r], C0[r + 1]); b = MX3(b, C0[r + 2], C0[r + 3]); a = MX3(a, C1[r], C1[r + 1]); b = MX3(b, C1[r + 2], C1[r + 3]); } \
      float rm = __builtin_fmaxf(a, b); { auto rr = __builtin_amdgcn_permlane32_swap(__float_as_uint(rm), __float_as_uint(rm), false, false); rm = __builtin_fmaxf(__uint_as_float(rr[0]), __uint_as_float(rr[1])); } \
      resc = false; \
      if (__builtin_expect(__any(rm > (float)THRL), 0)) { const float dl = __builtin_fmaxf(rm, 0.f); mhat += dl; \
        _Pragma("unroll") for (int r = 0; r < 16; ++r) { C0[r] -= dl; C1[r] -= dl; } \
        _Pragma("unroll") for (int r = 0; r < 16; ++r) negm[r] = -mhat; asm volatile("" : "+v"(negm)); \
        const float f = __builtin_amdgcn_exp2f(-dl); l_reg *= f; if (hi == 0) wsf[r32] = f; resc = true; } } \
    MAPPLY(C0); MLOAD1(t); \
    SBAR(); \
    GAPB(o[0] = __builtin_amdgcn_mfma_f32_32x32x16_bf16(PAF(0), VFR(0), o[0], 0, 0, 0), C0, 0); \
    GAPB(o[1] = __builtin_amdgcn_mfma_f32_32x32x16_bf16(PAF(0), VFR(4), o[1], 0, 0, 0), C0, 4); \
    KRD(GL, 0); GAPB(o[0] = __builtin_amdgcn_mfma_f32_32x32x16_bf16(PAF(1), VFR(1), o[0], 0, 0, 0), C0, 8); \
    KRD(GL, 1); GAPB(o[1] = __builtin_amdgcn_mfma_f32_32x32x16_bf16(PAF(1), VFR(5), o[1], 0, 0, 0), C0, 12); \
    MAPPLY(C1); if (GM) { MLOAD0((t) + 1); } SBAR(); \
    KRD(GL, 2); GAPB(o[0] = __builtin_amdgcn_mfma_f32_32x32x16_bf16(PAF(2), VFR(2), o[0], 0, 0, 0), C1, 0); \
    KRD(GL, 3); GAPB(o[1] = __builtin_amdgcn_mfma_f32_32x32x16_bf16(PAF(2), VFR(6), o[1], 0, 0, 0), C1, 4); \
    GAPB(o[0] = __builtin_amdgcn_mfma_f32_32x32x16_bf16(PAF(3), VFR(3), o[0], 0, 0, 0), C1, 8); \
    GAPB(o[1] = __builtin_amdgcn_mfma_f32_32x32x16_bf16(PAF(3), VFR(7), o[1], 0, 0, 0), C1, 12); \
    } while (0)
    int t = 1;
#undef CMASK
#define CMASK(P0, P1, t) do { } while (0)
    for (; t + 5 < NT; t += 2) {
        STEP(pB0, pB1, pA0, pA1, t, true, true, true, true);     WAIT_BAR(2); RESC(); ROT();
        STEP(pA0, pA1, pB0, pB1, t + 1, true, true, true, true); WAIT_BAR(2); RESC(); ROT();
    }
#undef CMASK
#define CMASK(P0, P1, t) do { int jb_ = (t) - (NT - 4); if (jb_ >= 0) cmask(P0, P1, jb_, qrel, hi); } while (0)
#define ENDW(tt) do { if ((tt) + 3 < NT) { WAIT_BAR(2); } else if ((tt) + 2 < NT) { WAIT_BAR(1); } else { WAIT_BAR(0); } } while (0)
    for (; t + 1 < NT; t += 2) {
        STEP(pB0, pB1, pA0, pA1, t, (t + 3 < NT), (t + 1 < NT), (t + 1 < NT), (t + 1 < NT));         ENDW(t);     RESC(); ROT();
        STEP(pA0, pA1, pB0, pB1, t + 1, (t + 4 < NT), (t + 2 < NT), (t + 2 < NT), (t + 2 < NT));     ENDW(t + 1); RESC(); ROT();
    }
    STEP(pB0, pB1, pA0, pA1, NT - 1, false, false, false, false); RESC();
    { float sacc = pB0[0] + pB0[1]; _Pragma("unroll") for (int r = 2; r < 16; ++r) sacc += pB0[r]; _Pragma("unroll") for (int r = 0; r < 16; ++r) sacc += pB1[r]; l_reg += sacc;
      pw0 = (u32x4){PKW(pB0, 0), PKW(pB0, 2), PKW(pB0, 4), PKW(pB0, 6)}; pw1 = (u32x4){PKW(pB0, 8), PKW(pB0, 10), PKW(pB0, 12), PKW(pB0, 14)}; pw2 = (u32x4){PKW(pB1, 0), PKW(pB1, 2), PKW(pB1, 4), PKW(pB1, 6)}; pw3 = (u32x4){PKW(pB1, 8), PKW(pB1, 10), PKW(pB1, 12), PKW(pB1, 14)};
      SBAR(); pv(o, vb0 + sl_cur, PAF(0), PAF(1), PAF(2), PAF(3)); }
#undef PKW
#undef PAF
#undef VFR
#undef PIN
#undef MX3
#undef GAPA
#undef GAPB
#undef EX
#undef VRD
#undef KRD
#undef STEP
#undef ENDW
    { auto rr = __builtin_amdgcn_permlane32_swap(__float_as_uint(l_reg), __float_as_uint(l_reg), false, false); l_reg = __uint_as_float(rr[0]) + __uint_as_float(rr[1]); }
    if (hi == 0) wsf[32 + r32] = l_reg; asm volatile("s_waitcnt lgkmcnt(0)" ::: "memory");
    float rli[16];
#pragma unroll
    for (int r = 0; r < 16; ++r) rli[r] = __builtin_amdgcn_rcpf(wsf[32 + crow(r, hi)]);
    bf16* Ow = O + (rowbase + q0 + wid * QBLK) * OP + OCOL + h * D;
    { bf16* stg = (bf16*)(shm + LDS_OST) + wid * 2048;
#pragma unroll
      for (int r = 0; r < 16; ++r) { const int orow = crow(r, hi);
#pragma unroll
        for (int d0 = 0; d0 < 2; ++d0) stg[orow * 64 + d0 * 32 + r32] = __float2bfloat16(o[d0][r] * rli[r]); }
      asm volatile("s_waitcnt lgkmcnt(0)" ::: "memory");
#pragma unroll
      for (int i = 0; i < 4; ++i) { const int row = i * 8 + (lane >> 3), ch = lane & 7; const u32x4 v = *(const u32x4*)(stg + row * 64 + ch * 8); ATTN_STORE16(Ow + (long)row * OP + ch * 8, v); } }
    asm volatile("s_waitcnt lgkmcnt(0)\n\ts_barrier" ::: "memory");
#undef DMA_K
#undef DMA_V
#undef CMASK
#undef START
#undef RESC
#undef ROT
#undef MLOAD0
#undef MLOAD1
#undef MPAIR
#undef QF
#undef MAPPLY
}
#undef SBAR
#undef WAIT_BAR
}

#define XB_TMO      128
#define XB_XCNT(j)  (256  + 64 * (j))
#define XB_XSUB(j)  (1280 + 64 * (j))
#define XB_XGEN(j)  (2304 + 64 * (j))
#define XB_TOP      3328
#define XB_TOPGEN   3392
#define XCD_BAR_WORDS 3456
#define XB_SPIN_CAP (1u << 18)
__device__ __forceinline__ unsigned xb_ld(unsigned* p)              { return __hip_atomic_load(p, __ATOMIC_RELAXED, __HIP_MEMORY_SCOPE_AGENT); }
__device__ __forceinline__ unsigned xb_add(unsigned* p, unsigned v) { return __hip_atomic_fetch_add(p, v, __ATOMIC_RELAXED, __HIP_MEMORY_SCOPE_AGENT); }
__device__ __forceinline__ unsigned xb_xcc_id() { return (unsigned)__builtin_amdgcn_s_getreg((3 << 11) | 20) & 0xFu; }
#define XB_SPIN(cond, bar) do { unsigned _sp = 0; while (cond) { __builtin_amdgcn_s_sleep(1); \
    if ((++_sp & 255u) == 0u) { if (xb_ld(&(bar)[XB_TMO])) break; if (_sp > XB_SPIN_CAP) { atomicAdd(&(bar)[XB_TMO], 1u); break; } } } } while (0)
struct XcdBarrier { unsigned* bar; unsigned x; volatile LAS unsigned* st; };
__device__ __forceinline__ XcdBarrier xcd_barrier_post(unsigned* bar, volatile LAS unsigned* st) {
    XcdBarrier b; b.bar = bar; b.x = xb_xcc_id(); b.st = st;
    if (threadIdx.x == 0) (void)xb_add(&bar[XB_XCNT(b.x)], 1u);
    return b;
}
__device__ __forceinline__ void xcd_barrier_complete(unsigned* bar, unsigned x, unsigned& nloc, unsigned& nx) {
    const unsigned G = gridDim.x * gridDim.y * gridDim.z;
    unsigned sum, cnt, mine, sp = 0u;
    for (;;) {
        sum = 0u; cnt = 0u; mine = 0u;
#pragma unroll
        for (unsigned j = 0; j < 16; ++j) { const unsigned c = xb_ld(&bar[XB_XCNT(j)]); sum += c; cnt += (c > 0u) ? 1u : 0u; mine = (j == x) ? c : mine; }
        if (sum == G) break;
        __builtin_amdgcn_s_sleep(1);
        if ((++sp & 255u) == 0u) { if (xb_ld(&bar[XB_TMO])) break; if (sp > XB_SPIN_CAP) { atomicAdd(&bar[XB_TMO], 1u); break; } }
    }
    nloc = mine > 0u ? mine : 1u; nx = cnt > 0u ? cnt : 1u;
}
__device__ __forceinline__ void xcd_barrier(const XcdBarrier& b) {
    asm volatile("s_waitcnt vmcnt(0)" ::: "memory");
    __syncthreads();
    if (threadIdx.x == 0) {
        unsigned* bar = b.bar;
        __builtin_amdgcn_s_waitcnt(0);
        unsigned nloc = b.st[0], nx = b.st[1];
        if (nloc == 0u) { xcd_barrier_complete(bar, b.x, nloc, nx); b.st[0] = nloc; b.st[1] = nx; }
        const unsigned old = xb_add(&bar[XB_XSUB(b.x)], 1u);
        const unsigned gen = old / nloc;
        if (old + 1u == (gen + 1u) * nloc) {
            __builtin_amdgcn_fence(__ATOMIC_RELEASE, "agent");
            asm volatile("s_waitcnt vmcnt(0)" ::: "memory");
            const unsigned og = xb_add(&bar[XB_TOP], 1u);
            const unsigned tg = og / nx;
            if (og + 1u == (tg + 1u) * nx) xb_add(&bar[XB_TOPGEN], 1u);
            else XB_SPIN(xb_ld(&bar[XB_TOPGEN]) == tg, bar);
            __builtin_amdgcn_fence(__ATOMIC_ACQUIRE, "agent");
            xb_add(&bar[XB_XGEN(b.x)], 1u);
            asm volatile("s_waitcnt vmcnt(0)" ::: "memory");
        } else {
            XB_SPIN(xb_ld(&bar[XB_XGEN(b.x)]) == gen, bar);
            __builtin_amdgcn_fence(__ATOMIC_ACQUIRE, "agent");
            asm volatile("s_waitcnt vmcnt(0)" ::: "memory");
        }
    }
    __syncthreads();
}

struct Frame {
    LAS unsigned char* lds; volatile LAS unsigned* MISC; unsigned* ctl;
    int tid, lane, wave, vcu, G;
    unsigned char* ws;
};
struct Args { const float* in[18]; float* out; unsigned char* ws; int ph_lo, ph_hi, flags, pad; };
typedef const __attribute__((address_space(4))) Args* KArgs;
__device__ __forceinline__ KArgs kargs() { KArgs p = (KArgs)__builtin_amdgcn_kernarg_segment_ptr(); asm volatile("" : "+s"(p)); return p; }

__device__ __forceinline__ int ropeperm(int d) { return d < 8 ? 2 * d : (d < 16 ? 2 * (d - 8) + 1 : d); }
__device__ __forceinline__ int win_row(int c) {
    if (c < 512)  return (c & ~63) + ropeperm(c & 63);
    if (c < 640)  { const int cc = c - 512; return 512 + (cc & ~63) + ropeperm(cc & 63); }
    if (c < 768)  return c;
    if (c < 1280) { const int cc = c - 768; return 768 + (cc & ~63) + ropeperm(cc & 63); }
    if (c < 1344) return 1280 + ropeperm(c - 1280);
    if (c < 1352) return c;
    if (c < 1864) { const int ch = c - 1352; return 1536 + (ch >> 7) * 256 + (ch & 127); }
    if (c < 2376) return 2560 + (c - 1864);
    if (c < 2888) { const int ch = c - 2376; return 1536 + (ch >> 7) * 256 + 128 + (ch & 127); }
    { const int g = c - 2888, gi = g & 1023; return 3072 + (gi >> 7) * 256 + (g >> 10) * 128 + (gi & 127); }
}
struct TItem { const float* src; bf16_t* WT; int N, KT, rbase, mode, n0, k0, kd; };
__device__ __forceinline__ void t_load(const TItem& t, float (&rg)[32], int lane) {
    int nn = t.n0 + (lane & 31); if (nn >= t.N) nn = t.N - 1;
    const float* p = t.src + (size_t)(t.k0 + (lane >> 5)) * t.N + nn;
#pragma unroll
    for (int i = 0; i < 32; ++i) rg[i] = __builtin_nontemporal_load(p + (size_t)(2 * i) * t.N);
}
__device__ __forceinline__ void t_write(const TItem& t, const float (&rg)[32], LAS float* scr, int lane) {
#pragma unroll
    for (int i = 0; i < 32; ++i) scr[(2 * i + (lane >> 5)) * 33 + (lane & 31)] = rg[i];
    LDS_WAIT(); asm volatile("" ::: "memory");
    if (t.mode >= 3) {
        const int c4 = lane & 3;
#pragma unroll
        for (int j = 0; j < 2; ++j) { const int n = (lane >> 2) + 16 * j; const LAS float* sp = scr + (16 * c4) * 33 + n;
            if (t.n0 + n < t.N) { const int nn = t.n0 + n; const int row = t.mode == 3 ? t.rbase + (nn >> 7) * 256 + (nn & 127) : t.rbase + nn;
                u32x4 o;
#pragma unroll
                for (int q = 0; q < 4; ++q) { int wv = 0;
                    wv = __builtin_amdgcn_cvt_pk_fp8_f32(32.f * sp[(4 * q + 0) * 33], 32.f * sp[(4 * q + 1) * 33], wv, false);
                    wv = __builtin_amdgcn_cvt_pk_fp8_f32(32.f * sp[(4 * q + 2) * 33], 32.f * sp[(4 * q + 3) * 33], wv, true); o[q] = (unsigned)wv; }
                *(u32x4*)((unsigned char*)t.WT + (size_t)row * t.KT + t.k0 + 16 * c4) = o; } }
        LDS_WAIT(); asm volatile("" ::: "memory");
        return;
    }
    const int c = lane & 7;
#pragma unroll
    for (int j = 0; j < 4; ++j) { const int n = (lane >> 3) + 8 * j; const LAS float* sp = scr + (8 * c) * 33 + n;
        if (t.n0 + n < t.N) { const int nn = t.n0 + n; const int row = t.mode == 0 ? t.rbase + nn : (t.mode == 1 ? win_row(nn) : t.rbase + (nn >> 7) * 256 + (nn & 127));
            u32x4 o; o.x = pkbf(sp[0 * 33], sp[1 * 33]); o.y = pkbf(sp[2 * 33], sp[3 * 33]); o.z = pkbf(sp[4 * 33], sp[5 * 33]); o.w = pkbf(sp[6 * 33], sp[7 * 33]);
            *(u32x4*)(t.WT + (size_t)row * t.KT + t.kd + t.k0 + 8 * c) = o; } }
    LDS_WAIT(); asm volatile("" ::: "memory");
}
__device__ __forceinline__ void p0_prologue(Frame& F) {
    const KArgs ka = kargs();
    unsigned char* ws = F.ws;
    LAS float* scr = (LAS float*)(F.lds + F.wave * 16384);
    const int gw = F.vcu * NWAVES + F.wave, NGW = F.G * NWAVES;
    const int gt = F.vcu * 512 + F.tid, NGT = F.G * 512;
    bf16_t* Win = (bf16_t*)(ws + WS_WIN); bf16_t* Wau = (bf16_t*)(ws + WS_WAU); bf16_t* Wout = (bf16_t*)(ws + WS_WOUT);
    bf16_t* Wd = (bf16_t*)(ws + WS_WD); bf16_t* Wgu = (bf16_t*)(ws + WS_WGU);
    constexpr int I_IN = 16 * 155, I_AU = 8 * 32, I_OUT = 16 * 32, I_G = 32 * 16 * 16, I_D = 32 * 8 * 32;
    constexpr int NITEMS = I_IN + 2 * I_AU + I_OUT + 2 * I_G + I_D;
    const float *p_win = ka->in[1], *p_wau = ka->in[3], *p_wcu = ka->in[4], *p_wout = ka->in[6], *p_wg = ka->in[13], *p_wu = ka->in[14], *p_wd = ka->in[15];
#define T_DECODE(IT, T) do { int r_ = (IT); \
        if (r_ < I_IN) { T = TItem{p_win, Win, INW, 1024, 0, 1, 32 * (r_ % 155), 64 * (r_ / 155), 0}; } else { r_ -= I_IN; \
        if (r_ < I_AU) { T = TItem{p_wau, Wau, 1024, 1024, 0, 0, 32 * (r_ % 32), 64 * (r_ / 32), 512};     } else { r_ -= I_AU; \
        if (r_ < I_AU) { T = TItem{p_wcu, Wau, 1024, 1024, 0, 0, 32 * (r_ % 32), 64 * (r_ / 32), 0}; } else { r_ -= I_AU; \
        if (r_ < I_OUT) { T = TItem{p_wout, Wout, 1024, 1024, 0, 0, 32 * (r_ % 32), 64 * (r_ / 32), 0}; } else { r_ -= I_OUT; \
        if (r_ < I_G) { const int e_ = r_ >> 8, q_ = r_ & 255; T = TItem{p_wg + (size_t)e_ * 1024 * 512, Wgu, 512, 1024, e_ * 1024, 3, 32 * (q_ & 15), 64 * (q_ >> 4), 0}; } else { r_ -= I_G; \
        if (r_ < I_G) { const int e_ = r_ >> 8, q_ = r_ & 255; T = TItem{p_wu + (size_t)e_ * 1024 * 512, Wgu, 512, 1024, e_ * 1024 + 128, 3, 32 * (q_ & 15), 64 * (q_ >> 4), 0}; } else { r_ -= I_G; \
        { const int e_ = r_ >> 8, q_ = r_ & 255; T = TItem{p_wd + (size_t)e_ * 512 * 1024, Wd, 1024, 512, e_ * 1024, 4, 32 * (q_ & 31), 64 * (q_ >> 5), 0}; } } } } } } } } while (0)
    const int nitems = (F.G == 256) ? I_IN + 2 * I_AU + I_OUT : NITEMS;
    if (gw < nitems) {
        TItem cur, nxt; float rc[32], rn[32];
        T_DECODE(gw, cur); t_load(cur, rc, F.lane);
        for (int it = gw; it < nitems; it += NGW) {
            const int itn = (it + NGW < nitems) ? it + NGW : it;
            T_DECODE(itn, nxt); t_load(nxt, rn, F.lane);
            t_write(cur, rc, scr, F.lane);
            cur = nxt;
#pragma unroll
            for (int i = 0; i < 32; ++i) rc[i] = rn[i];
        }
    }
#undef T_DECODE
    for (int i = gt; i < 184 * 128; i += NGT) *(u32x4*)(Win + (size_t)1352 * 1024 + (size_t)i * 8) = (u32x4){0u, 0u, 0u, 0u};
    float* rope = (float*)(ws + WS_ROPE);
    for (int i = gt; i < SEQ * 8; i += NGT) { const int pos = i >> 3, j = i & 7;
        const float inv = (float)pow(500000.0, -(double)j / 8.0); const float ang = (float)pos * inv;
        rope[i] = cosf(ang); rope[SEQ * 8 + i] = sinf(ang); }
    { float* wc = (float*)(ws + WS_WC); const float* rgw = ka->in[9]; const float* rew = ka->in[11];
      for (int i = gt; i < 1024 * 48; i += NGT) { const int k = i / 48, c = i % 48;
          wc[i] = c < 4 ? rgw[k * 4 + c] : (c < 36 ? rew[(size_t)((c - 4) >> 3) * 1024 * 8 + k * 8 + ((c - 4) & 7)] : 0.f); } }
    const float* x = ka->in[0]; bf16_t* xb = (bf16_t*)(ws + WS_XB);
    for (size_t i = gt; i < (size_t)NTOK * DM / 8; i += (size_t)NGT * 4) {
        f32x4 va[4], vb[4];
#pragma unroll
        for (int q = 0; q < 4; ++q) { size_t ii = i + (size_t)q * NGT; if (ii >= (size_t)NTOK * DM / 8) ii = i; va[q] = __builtin_nontemporal_load((const f32x4*)(x + ii * 8)); vb[q] = __builtin_nontemporal_load((const f32x4*)(x + ii * 8 + 4)); }
#pragma unroll
        for (int q = 0; q < 4; ++q) { const size_t ii = i + (size_t)q * NGT; if (ii < (size_t)NTOK * DM / 8) store8bf(xb + ii * 8, va[q], vb[q]); } }
}

__device__ __forceinline__ int dpp_sum_i(int v) {
    v += __builtin_amdgcn_update_dpp(0, v, 0x111, 0xf, 0xf, true); v += __builtin_amdgcn_update_dpp(0, v, 0x112, 0xf, 0xf, true);
    v += __builtin_amdgcn_update_dpp(0, v, 0x114, 0xf, 0xf, true); v += __builtin_amdgcn_update_dpp(0, v, 0x118, 0xf, 0xf, true);
    return __builtin_amdgcn_readlane(v, 15) + __builtin_amdgcn_readlane(v, 31) + __builtin_amdgcn_readlane(v, 47) + __builtin_amdgcn_readlane(v, 63);
}
__device__ __forceinline__ float dpp_shr_f(float v, int ctrl_sel) {
    const int vi = __float_as_int(v);
    return __int_as_float(ctrl_sel == 1 ? __builtin_amdgcn_update_dpp(vi, vi, 0x111, 0xf, 0xf, false) : ctrl_sel == 2 ? __builtin_amdgcn_update_dpp(vi, vi, 0x112, 0xf, 0xf, false)
                        : ctrl_sel == 4 ? __builtin_amdgcn_update_dpp(vi, vi, 0x114, 0xf, 0xf, false) : __builtin_amdgcn_update_dpp(vi, vi, 0x118, 0xf, 0xf, false));
}
__device__ __forceinline__ float dpp_max_f(float v) {
    v = fmaxf(v, dpp_shr_f(v, 1)); v = fmaxf(v, dpp_shr_f(v, 2)); v = fmaxf(v, dpp_shr_f(v, 4)); v = fmaxf(v, dpp_shr_f(v, 8));
    const float a = __int_as_float(__builtin_amdgcn_readlane(__float_as_int(v), 15)), b = __int_as_float(__builtin_amdgcn_readlane(__float_as_int(v), 31));
    const float c = __int_as_float(__builtin_amdgcn_readlane(__float_as_int(v), 47)), d = __int_as_float(__builtin_amdgcn_readlane(__float_as_int(v), 63));
    return fmaxf(fmaxf(a, b), fmaxf(c, d));
}
__device__ __forceinline__ float dpp_min_f(float v) { return -dpp_max_f(-v); }
__device__ __forceinline__ float dpp_sum_f(float v) {
    v += __int_as_float(__builtin_amdgcn_update_dpp(0, __float_as_int(v), 0x111, 0xf, 0xf, true)); v += __int_as_float(__builtin_amdgcn_update_dpp(0, __float_as_int(v), 0x112, 0xf, 0xf, true));
    v += __int_as_float(__builtin_amdgcn_update_dpp(0, __float_as_int(v), 0x114, 0xf, 0xf, true)); v += __int_as_float(__builtin_amdgcn_update_dpp(0, __float_as_int(v), 0x118, 0xf, 0xf, true));
    const float a = __int_as_float(__builtin_amdgcn_readlane(__float_as_int(v), 15)), b = __int_as_float(__builtin_amdgcn_readlane(__float_as_int(v), 31));
    const float c = __int_as_float(__builtin_amdgcn_readlane(__float_as_int(v), 47)), d = __int_as_float(__builtin_amdgcn_readlane(__float_as_int(v), 63));
    return (a + b) + (c + d);
}
template <int NC>
__device__ __forceinline__ void select_token(const LAS float* srow, int t, int lane, unsigned tbit, LAS unsigned* maskw) {
    if (t < 256) {
#pragma unroll
        for (int c = 0; c < (NC < 4 ? NC : 4); ++c) if (64 * c + lane <= t) (void)__hip_atomic_fetch_or(maskw + 64 * c + lane, tbit, __ATOMIC_RELAXED, __HIP_MEMORY_SCOPE_WORKGROUP);
        return;
    }
    float x[NC];
#pragma unroll
    for (int c = 0; c < NC; ++c) x[c] = srow[64 * c + lane];
#pragma unroll
    for (int c = 4; c < NC; ++c) if (64 * c + 63 > t) x[c] = (64 * c + lane <= t) ? x[c] : -INFINITY;
    float mn = fminf(fminf(x[0], x[1]), fminf(x[2], x[3])), mx = -INFINITY;
#pragma unroll
    for (int c = 0; c < NC; ++c) mx = fmaxf(mx, x[c]);
    mn = dpp_min_f(mn);
    float lo = mn - (fabsf(mn) * 1e-6f + 1e-30f), hi = dpp_max_f(mx);
    const float BIGF = 0x1p100f;
#define COUNT_GT(P, OUT) do { const float nb1_ = -(P) * BIGF; const f32x2 nb_ = {nb1_, nb1_}, bg_ = {BIGF, BIGF}; f32x2 a0_ = {0.f, 0.f}, a1_ = {0.f, 0.f}, a2_ = {0.f, 0.f}, a3_ = {0.f, 0.f}; \
        _Pragma("unroll") for (int c = 0; c < NC; c += 8) { f32x2 y_[4]; \
            _Pragma("unroll") for (int e = 0; e < 4; ++e) { const f32x2 xx_ = {x[c + 2 * e], x[c + 2 * e + 1]}; asm("v_pk_fma_f32 %0, %1, %2, %3 clamp" : "=v"(y_[e]) : "v"(xx_), "v"(bg_), "v"(nb_)); } \
            a0_ += y_[0]; a1_ += y_[1]; a2_ += y_[2]; a3_ += y_[3]; } \
        const f32x2 s2_ = (a0_ + a1_) + (a2_ + a3_); OUT = (int)(dpp_sum_f(s2_[0] + s2_[1]) + 0.5f); } while (0)
    float tau = hi; int need = 256; bool exact = false;
#ifndef PROBE_SEL
#define PROBE_SEL 0
#endif
    {
        float glo = (float)(t + 1) - 255.5f, ghi = -255.5f; int side = 0;
        for (int it = 0; it < 200; ++it) {
            float p = lo + (hi - lo) * (glo * __builtin_amdgcn_rcpf(glo - ghi));
            if (it >= 48 || !(p > lo) || !(p < hi)) p = lo + (hi - lo) * 0.5f;
            if (!(p > lo) || !(p < hi)) break;
            int cm; COUNT_GT(p, cm);
            if (cm == 256) { tau = p; exact = true; break; }
            if (cm > 256) { lo = p; glo = (float)cm - 255.5f; if (side < 0) ghi *= 0.5f; side = -1; }
            else { hi = p; ghi = (float)cm - 255.5f; if (side > 0) glo *= 0.5f; side = 1; }
        }
        if (!exact) { tau = hi; int g; COUNT_GT(hi, g); need = 256 - g; }
    }
#undef COUNT_GT
    if (exact) {
#pragma unroll
        for (int c = 0; c < NC; ++c) (void)__hip_atomic_fetch_or(maskw + 64 * c + lane, (x[c] > tau) ? tbit : 0u, __ATOMIC_RELAXED, __HIP_MEMORY_SCOPE_WORKGROUP);
    } else {
        int base = 0;
#pragma unroll
        for (int c = 0; c < NC; ++c) {
            const bool gt = x[c] > tau, eq = x[c] == tau;
            const unsigned long long tb = __ballot(eq);
            const int rank = base + (int)__builtin_amdgcn_mbcnt_hi((unsigned)(tb >> 32), __builtin_amdgcn_mbcnt_lo((unsigned)tb, 0u));
            base += __popcll(tb);
            if (gt || (eq && rank < need)) (void)__hip_atomic_fetch_or(maskw + 64 * c + lane, tbit, __ATOMIC_RELAXED, __HIP_MEMORY_SCOPE_WORKGROUP);
        }
    }
}
struct XItem { const float* src; unsigned char* dst; int N; };
__device__ __forceinline__ XItem x_decode(int id, int lane, const float* wg, const float* wu, const float* wd, unsigned char* Wgu8, unsigned char* Wd8) {
    const int m = id >> 13, r = id & 8191, e = r >> 8, q = r & 255; XItem t;
    if (m < 2) { const int kb = q >> 3, nb = q & 7, n = nb * 64 + lane;
        t.src = (m == 0 ? wg : wu) + (size_t)e * 1024 * 512 + (size_t)(kb * 32) * 512 + n; t.N = 512;
        t.dst = Wgu8 + (size_t)(e * 1024 + (n >> 7) * 256 + m * 128 + (n & 127)) * 1024 + kb * 32; }
    else { const int kb = q >> 4, nb = q & 15, n = nb * 64 + lane;
        t.src = wd + (size_t)e * 512 * 1024 + (size_t)(kb * 32) * 1024 + n; t.N = 1024;
        t.dst = Wd8 + (size_t)(e * 1024 + n) * 512 + kb * 32; }
    return t;
}
__device__ __forceinline__ void x_load(const XItem& t, float (&rg)[32]) {
#pragma unroll
    for (int i = 0; i < 32; ++i) rg[i] = __builtin_nontemporal_load(t.src + (size_t)i * t.N);
}
__device__ __forceinline__ void x_store(const XItem& t, float (&rg)[32]) {
#pragma unroll
    for (int i = 0; i < 32; ++i) asm volatile("" : "+v"(rg[i]));
    u32x4 o0, o1;
#pragma unroll
    for (int q = 0; q < 4; ++q) { int w0 = 0, w1 = 0;
        w0 = __builtin_amdgcn_cvt_pk_fp8_f32(32.f * rg[4 * q], 32.f * rg[4 * q + 1], w0, false); w0 = __builtin_amdgcn_cvt_pk_fp8_f32(32.f * rg[4 * q + 2], 32.f * rg[4 * q + 3], w0, true);
        w1 = __builtin_amdgcn_cvt_pk_fp8_f32(32.f * rg[16 + 4 * q], 32.f * rg[16 + 4 * q + 1], w1, false); w1 = __builtin_amdgcn_cvt_pk_fp8_f32(32.f * rg[16 + 4 * q + 2], 32.f * rg[16 + 4 * q + 3], w1, true);
        o0[q] = (unsigned)w0; o1[q] = (unsigned)w1; }
    *(u32x4*)t.dst = o0; *(u32x4*)(t.dst + 16) = o1;
}
__device__ __forceinline__ void score_select_unit(Frame& F, int b, int qt16, const bf16_t* qi, const bf16_t* ki, const float* wi, LAS float* scl, LAS unsigned* maskw, unsigned* masks, int xid0, int xid1) {
    const int lane = F.lane, wid = F.wave, r = lane & 31, h = lane >> 5;
    const int T0 = qt16 * 16; const size_t rowb = (size_t)b * SEQ;
    XItem xa, xb; float xr0[32], xr1[32];
    { const KArgs ka = kargs(); unsigned char* w8a = F.ws + WS_WGU; unsigned char* w8b = F.ws + WS_WD;
      xa = x_decode(xid0 >= 0 ? xid0 : 0, lane, ka->in[13], ka->in[14], ka->in[15], w8a, w8b); xb = x_decode(xid1 >= 0 ? xid1 : 0, lane, ka->in[13], ka->in[14], ka->in[15], w8a, w8b); }
    {
        LAS float* wtab = (LAS float*)(F.lds + TAB_OFF + 8192);
        if (F.tid < 128) wtab[F.tid] = wi[(rowb + T0) * 8 + F.tid] * WSCALE;
        bf16x8 a[4][4];
        const int tk = (r >> 4) + 2 * ((r >> 2) & 1), hd = (r & 3) + 4 * ((r >> 3) & 1);
        const int nsteps = ((T0 + 15) >> 8) + 1, kb0 = 32 * wid;
        const bf16_t* kp0 = ki + (rowb >> 5) * 2048 + (kb0 >> 5) * 2048 + r * 16 + h * 8;
        bf16x8 bfA[4], bfB[4];
#pragma unroll
        for (int kk = 0; kk < 4; ++kk) bfA[kk] = *(const bf16x8*)(kp0 + 512 * kk);
#pragma unroll
        for (int rb = 0; rb < 4; ++rb) {
            const bf16_t* qp = qi + (rowb + T0 + 4 * rb + tk) * 512 + hd * 64 + 8 * h;
#pragma unroll
            for (int kk = 0; kk < 4; ++kk) a[rb][kk] = *(const bf16x8*)(qp + 16 * kk);
        }
        LDS_WAIT(); __syncthreads();
        const LAS float* wl = wtab + 16 * h;
#define SCORE_STEP(KS, BF) do { const int kb_ = 256 * (KS) + kb0; if (kb_ <= T0 + 15) { \
            _Pragma("unroll") for (int rb = 0; rb < 4; ++rb) { \
                f32x16 acc = f32x16{}; \
                _Pragma("unroll") for (int kk = 0; kk < 4; ++kk) acc = __builtin_amdgcn_mfma_f32_32x32x16_bf16(a[rb][kk], BF[kk], acc, 0, 0, 0); \
                const f32x4 w0_ = *(const LAS f32x4*)(wl + 32 * rb), w1_ = *(const LAS f32x4*)(wl + 32 * rb + 4), w2_ = *(const LAS f32x4*)(wl + 32 * rb + 8), w3_ = *(const LAS f32x4*)(wl + 32 * rb + 12); \
                float s0 = 0.f, s1 = 0.f; \
                _Pragma("unroll") for (int reg = 0; reg < 4; ++reg) {     \
                    const float y0_ = __int_as_float(max(__float_as_int(acc[reg]), 0)), y1_ = __int_as_float(max(__float_as_int(acc[reg + 4]), 0)); \
                    const float y2_ = __int_as_float(max(__float_as_int(acc[reg + 8]), 0)), y3_ = __int_as_float(max(__float_as_int(acc[reg + 12]), 0)); \
                    s0 += w0_[reg] * y0_; s0 += w1_[reg] * y1_; s1 += w2_[reg] * y2_; s1 += w3_[reg] * y3_; } \
                LAS float* sp = scl + (4 * rb + 2 * h) * 2048 + kb_ + r; \
                sp[0] = s0; sp[2048] = s1; } } } while (0)
        for (int ks = 0; ks < nsteps; ks += 2) {
            { const int kn = (ks + 1 < 8) ? ks + 1 : 7;
#pragma unroll
              for (int kk = 0; kk < 4; ++kk) bfB[kk] = *(const bf16x8*)(kp0 + (size_t)kn * 16384 + 512 * kk); }
            SCORE_STEP(ks, bfA);
            { const int kn = (ks + 2 < 8) ? ks + 2 : 7;
#pragma unroll
              for (int kk = 0; kk < 4; ++kk) bfA[kk] = *(const bf16x8*)(kp0 + (size_t)kn * 16384 + 512 * kk); }
            if (ks + 1 < nsteps) SCORE_STEP(ks + 1, bfB);
        }
#undef SCORE_STEP
    }
    LDS_WAIT(); __syncthreads();
    if (xid0 >= 0) x_load(xa, xr0);
    if (xid1 >= 0) x_load(xb, xr1);
#ifndef PROBE_P2
#define PROBE_P2 0
#endif
#pragma unroll 1
    for (int jx = 0; jx < (PROBE_P2 == 2 ? 4 : 2); ++jx) { const int j = jx & 1;
        const int tl = wid * 2 + j, t = T0 + tl, nch = (t >> 6) + 1;
        const unsigned tbit = 1u << tl; const LAS float* srow = scl + tl * 2048;
        if (nch <= 8) select_token<8>(srow, t, lane, tbit, maskw);
        else if (nch <= 16) select_token<16>(srow, t, lane, tbit, maskw);
        else if (nch <= 24) select_token<24>(srow, t, lane, tbit, maskw);
        else select_token<32>(srow, t, lane, tbit, maskw);
    }
    if (xid0 >= 0) x_store(xa, xr0);
    if (xid1 >= 0) x_store(xb, xr1);
    LDS_WAIT(); __syncthreads();
    {
        const int ktmax = (T0 + 15) >> 6; unsigned short* mbase = (unsigned short*)(masks + ((size_t)(b * (SEQ / 32) + (qt16 >> 1)) * (SEQ / 64)) * 64) + (qt16 & 1);
#pragma unroll
        for (int jj = 0; jj < 4; ++jj) { const int key = F.tid + 512 * jj, kt = key >> 6, kap = key & 63;
            const unsigned wv = maskw[key]; maskw[key] = 0u;
            if (kt <= ktmax) { const int half = kap >> 5, k5 = kap & 31, hi_ = (k5 >> 2) & 1, rr = (k5 & 3) + 4 * (k5 >> 3); mbase[2 * (kt * 64 + 32 * half + 2 * rr + hi_)] = (unsigned short)wv; } }
    }
    LDS_WAIT(); __syncthreads();
}
__device__ __forceinline__ void conv_pass(Frame& F, const bf16_t* u, const bf16_t* cb, const float* cw, bf16_t* conv) {
    const int gt = F.vcu * 512 + F.tid, NGT = F.G * 512;
    for (int idx = gt; idx < NTOK * 64; idx += NGT) {
        const int tok = idx >> 6, cg = (idx & 63) * 8, pos = tok & (SEQ - 1);
        const u32x4 z = (u32x4){0u, 0u, 0u, 0u};
        const u32x4 u0 = *(const u32x4*)(u + (size_t)tok * 512 + cg);
        const u32x4 u1 = pos >= 1 ? *(const u32x4*)(u + (size_t)(tok - 1) * 512 + cg) : z;
        const u32x4 u2 = pos >= 2 ? *(const u32x4*)(u + (size_t)(tok - 2) * 512 + cg) : z;
        const u32x4 bv = __builtin_nontemporal_load((const u32x4*)(cb + (size_t)tok * 512 + cg));
        const f32x4 w0a = *(const f32x4*)(cw + cg), w0b = *(const f32x4*)(cw + cg + 4);
        const f32x4 w1a = *(const f32x4*)(cw + 512 + cg), w1b = *(const f32x4*)(cw + 512 + cg + 4);
        const f32x4 w2a = *(const f32x4*)(cw + 1024 + cg), w2b = *(const f32x4*)(cw + 1024 + cg + 4);
        f32x4 ya, yb;
#define CV(E, WA, I, WORD, HALF) (WA[I] * (HALF ? bfhi(E.WORD) : bflo(E.WORD)))
        ya[0] = bflo(bv.x) * (CV(u2, w0a, 0, x, 0) + CV(u1, w1a, 0, x, 0) + CV(u0, w2a, 0, x, 0));
        ya[1] = bfhi(bv.x) * (CV(u2, w0a, 1, x, 1) + CV(u1, w1a, 1, x, 1) + CV(u0, w2a, 1, x, 1));
        ya[2] = bflo(bv.y) * (CV(u2, w0a, 2, y, 0) + CV(u1, w1a, 2, y, 0) + CV(u0, w2a, 2, y, 0));
        ya[3] = bfhi(bv.y) * (CV(u2, w0a, 3, y, 1) + CV(u1, w1a, 3, y, 1) + CV(u0, w2a, 3, y, 1));
        yb[0] = bflo(bv.z) * (CV(u2, w0b, 0, z, 0) + CV(u1, w1b, 0, z, 0) + CV(u0, w2b, 0, z, 0));
        yb[1] = bfhi(bv.z) * (CV(u2, w0b, 1, z, 1) + CV(u1, w1b, 1, z, 1) + CV(u0, w2b, 1, z, 1));
        yb[2] = bflo(bv.w) * (CV(u2, w0b, 2, w, 0) + CV(u1, w1b, 2, w, 0) + CV(u0, w2b, 2, w, 0));
        yb[3] = bfhi(bv.w) * (CV(u2, w0b, 3, w, 1) + CV(u1, w1b, 3, w, 1) + CV(u0, w2b, 3, w, 1));
#undef CV
        store8bf(conv + (size_t)tok * 1024 + cg, ya, yb);
    }
}

constexpr int P7_HS = 1028;
constexpr int P7_H = 0, P7_P = 16 * P7_HS * 4, P7_L = P7_P + 8 * 16 * 48 * 4, P7_R = P7_L + 16 * 48 * 4, P7_END = P7_R + 6 * 128 * 4 + 2 * 32 * 4;
static_assert(P7_END <= RING_BYTES && (P7_P % 16) == 0, "P7 LDS map");
__device__ __forceinline__ void ln1_router(Frame& F, bool dry) {
    const KArgs a = kargs();
    unsigned char* ws = F.ws;
    const float* xin = a->in[0]; const bf16_t* mixb = (const bf16_t*)(ws + WS_MIX); bf16_t* h1b = dry ? (bf16_t*)(ws + WS_GATES) : (bf16_t*)(ws + WS_PRE);
    int* lists = (int*)(ws + (dry ? WS_MERGED : WS_LIST)); unsigned* tokinfo = (unsigned*)(ws + (dry ? WS_MERGED + 8 * MiB : WS_TOKINFO)); const int cbank = dry ? 64 * NEXP : 0;
    unsigned char* h1q = ws + (dry ? WS_MERGED + 16 * MiB : WS_H1Q);
    const float *g1 = a->in[7], *b1 = a->in[8], *rgb = a->in[10], *reb = a->in[12]; const float* wc = (const float*)(ws + WS_WC);
    const int lane = F.lane, wid = F.wave, tid = F.tid;
    LAS float* H = (LAS float*)(F.lds + P7_H); LAS float* P = (LAS float*)(F.lds + P7_P); LAS float* L = (LAS float*)(F.lds + P7_L);
    LAS int* RE = (LAS int*)(F.lds + P7_R);
    LAS int* hist = RE + 768; LAS int* basev = RE + 800;
    if (tid < 64) hist[tid] = 0;
    f32x4 gv[4], bv[4];
#pragma unroll
    for (int j = 0; j < 4; ++j) { gv[j] = *(const f32x4*)(g1 + 4 * lane + 256 * j); bv[j] = *(const f32x4*)(b1 + 4 * lane + 256 * j); }
    float breg[3][32];
    { const int kq = lane >> 4, jn = lane & 15; const float* wp = wc + (size_t)(128 * wid + 32 * kq) * 48 + jn;
#pragma unroll
      for (int cb = 0; cb < 3; ++cb)
#pragma unroll
          for (int sidx = 0; sidx < 32; ++sidx) breg[cb][sidx] = wp[sidx * 48 + 16 * cb]; }
    const int ngrp_total = NTOK / 16;
#pragma unroll 1
    for (int gi = F.vcu * 8; gi < ngrp_total; gi += F.G * 8) {
      f32x4 vn[2][4]; u32x2 mn[2][4];
#pragma unroll
      for (int rr = 0; rr < 2; ++rr)
#pragma unroll
          for (int j = 0; j < 4; ++j) { const size_t o_ = (size_t)(gi * 16 + 2 * wid + rr) * DM + 4 * lane + 256 * j; vn[rr][j] = __builtin_nontemporal_load((const f32x4*)(xin + o_)); mn[rr][j] = __builtin_nontemporal_load((const u32x2*)(mixb + o_)); }
#pragma unroll 1
      for (int gg = 0; gg < 8; ++gg) {
        const int row0 = (gi + gg) * 16;
#pragma unroll
        for (int rr = 0; rr < 2; ++rr) { const int rl = 2 * wid + rr, row = row0 + rl;
            f32x4 v[4]; float sm = 0.f;
#pragma unroll
            for (int j = 0; j < 4; ++j) { const u32x2 mw = mn[rr][j]; v[j] = vn[rr][j] * ALPHA + (f32x4){bflo(mw.x), bfhi(mw.x), bflo(mw.y), bfhi(mw.y)}; sm += (v[j][0] + v[j][1]) + (v[j][2] + v[j][3]); }
            const float mean = wave_sum(sm) * (1.f / DM); float s2 = 0.f;
#pragma unroll
            for (int j = 0; j < 4; ++j) { v[j] = v[j] - mean; s2 += (v[j][0] * v[j][0] + v[j][1] * v[j][1]) + (v[j][2] * v[j][2] + v[j][3] * v[j][3]); }
            const float rstd = 1.f / sqrtf(wave_sum(s2) * (1.f / DM) + LN_EPS);
#pragma unroll
            for (int j = 0; j < 4; ++j) { v[j] = v[j] * rstd * gv[j] + bv[j];
                u32x2 o; o.x = pkbf(v[j][0], v[j][1]); o.y = pkbf(v[j][2], v[j][3]); *(u32x2*)(h1b + (size_t)row * DM + 4 * lane + 256 * j) = o;
                { int wv = 0; wv = __builtin_amdgcn_cvt_pk_fp8_f32(v[j][0], v[j][1], wv, false); wv = __builtin_amdgcn_cvt_pk_fp8_f32(v[j][2], v[j][3], wv, true);
                  *(int*)(h1q + (size_t)row * 1024 + 4 * lane + 256 * j) = wv; }
                *(LAS f32x4*)(H + rl * P7_HS + 4 * lane + 256 * j) = v[j]; } }
        { const int gnx = gg < 7 ? gg + 1 : gg;
#pragma unroll
          for (int rr = 0; rr < 2; ++rr)
#pragma unroll
              for (int j = 0; j < 4; ++j) { const size_t o_ = (size_t)((gi + gnx) * 16 + 2 * wid + rr) * DM + 4 * lane + 256 * j; vn[rr][j] = __builtin_nontemporal_load((const f32x4*)(xin + o_)); mn[rr][j] = __builtin_nontemporal_load((const u32x2*)(mixb + o_)); } }
        LDS_WAIT(); __syncthreads();
        { f32x4 acc[3]; acc[0] = (f32x4){0.f, 0.f, 0.f, 0.f}; acc[1] = acc[0]; acc[2] = acc[0];
          const LAS float* hp = H + (lane & 15) * P7_HS + 128 * wid + 32 * (lane >> 4);
#pragma unroll
          for (int s4 = 0; s4 < 8; ++s4) { const f32x4 av = *(const LAS f32x4*)(hp + 4 * s4);
#pragma unroll
              for (int e = 0; e < 4; ++e)
#pragma unroll
                  for (int cb = 0; cb < 3; ++cb) acc[cb] = __builtin_amdgcn_mfma_f32_16x16x4f32(av[e], breg[cb][4 * s4 + e], acc[cb], 0, 0, 0); }
          LAS float* pp = P + (wid * 16 + 4 * (lane >> 4)) * 48 + (lane & 15);
#pragma unroll
          for (int cb = 0; cb < 3; ++cb)
#pragma unroll
              for (int rg = 0; rg < 4; ++rg) pp[rg * 48 + 16 * cb] = acc[cb][rg]; }
        LDS_WAIT(); __syncthreads();
        for (int idx = tid; idx < 16 * 48; idx += 512) { float sum = 0.f;
#pragma unroll
            for (int w = 0; w < 8; ++w) sum += P[w * 768 + idx];
            L[idx] = sum; }
        LDS_WAIT(); __syncthreads();
        if (tid < 16) { const LAS float* lr = L + tid * 48;
            float gl[4]; int grp = 0;
#pragma unroll
            for (int i = 0; i < 4; ++i) gl[i] = lr[i] + rgb[i];
            float gm = gl[0];
#pragma unroll
            for (int i = 1; i < 4; ++i) if (gl[i] > gm) { gm = gl[i]; grp = i; }
            float den = 0.f;
#pragma unroll
            for (int i = 0; i < 4; ++i) den += __expf(gl[i] - gm);
            const float pgrp = 1.f / den;
            float el[8];
#pragma unroll
            for (int i = 0; i < 8; ++i) el[i] = lr[4 + 8 * grp + i] + reb[grp * 8 + i];
            int i1 = 0; float v1 = el[0];
#pragma unroll
            for (int i = 1; i < 8; ++i) if (el[i] > v1) { v1 = el[i]; i1 = i; }
            int i2 = -1; float v2 = -INFINITY;
#pragma unroll
            for (int i = 0; i < 8; ++i) if (i != i1 && el[i] > v2) { v2 = el[i]; i2 = i; }
            const float ex = __expf(v2 - v1), w1 = pgrp / (1.f + ex), w2 = pgrp * ex / (1.f + ex);
            const int e1 = grp * 8 + i1, e2 = grp * 8 + i2, ti = gg * 16 + tid;
            RE[ti] = e1; RE[128 + ti] = e2; RE[256 + ti] = (int)__float_as_uint(w1); RE[384 + ti] = (int)__float_as_uint(w2);
            RE[512 + ti] = __hip_atomic_fetch_add(hist + e1, 1, __ATOMIC_RELAXED, __HIP_MEMORY_SCOPE_WORKGROUP);
            RE[640 + ti] = __hip_atomic_fetch_add(hist + e2, 1, __ATOMIC_RELAXED, __HIP_MEMORY_SCOPE_WORKGROUP);
        }
      }
      LDS_WAIT(); __syncthreads();
      if (tid < NEXP) { const int hc = hist[tid]; basev[tid] = hc ? (int)__hip_atomic_fetch_add(F.ctl + CW_CNT + cbank + 64 * tid, (unsigned)hc, __ATOMIC_RELAXED, __HIP_MEMORY_SCOPE_AGENT) : 0; }
      LDS_WAIT(); __syncthreads();
      if (tid < 128) { const int row = gi * 16 + tid; const int e1 = RE[tid], e2 = RE[128 + tid];
          const unsigned r1 = (unsigned)(basev[e1] + RE[512 + tid]), r2 = (unsigned)(basev[e2] + RE[640 + tid]);
          if (r1 < (unsigned)LISTCAP) lists[(size_t)e1 * LISTCAP + r1] = row;
          if (r2 < (unsigned)LISTCAP) lists[(size_t)e2 * LISTCAP + r2] = row;
          unsigned* ti = tokinfo + (size_t)row * 8;
          *(u32x4*)ti = (u32x4){(unsigned)e1, r1, (unsigned)RE[256 + tid], (unsigned)e2}; *(u32x2*)(ti + 4) = (u32x2){r2, (unsigned)RE[384 + tid]}; }
      LDS_WAIT(); __syncthreads();
      if (tid < 64) hist[tid] = 0;
      LDS_WAIT(); __syncthreads();
    }
}
__device__ __forceinline__ void moe_tables(Frame& F) {
    LAS int* tab = (LAS int*)(F.lds + TAB_OFF);
    __syncthreads();
    if (F.tid < NEXP) { int c = (int)__hip_atomic_load(F.ctl + CW_CNT + 64 * F.tid, __ATOMIC_RELAXED, __HIP_MEMORY_SCOPE_AGENT); if (c > LISTCAP) c = LISTCAP; tab[T_CNT + F.tid] = c; }
    __syncthreads();
    if (F.tid == 0) { int acc = 0; for (int e = 0; e < NEXP; ++e) { tab[T_BLK0 + e] = acc; acc += (tab[T_CNT + e] + 255) >> 8; } tab[T_BLK0 + NEXP] = acc; tab[T_NB] = acc; }
    __syncthreads();
    if (F.tid < NEXP) { const int b0 = tab[T_BLK0 + F.tid], b1 = tab[T_BLK0 + F.tid + 1]; for (int bb = b0; bb < b1; ++bb) tab[T_BLKE + bb] = F.tid; }
    __syncthreads();
}

__device__ __forceinline__ void combine_ln2(Frame& F) {
    const KArgs a = kargs();
    unsigned char* ws = F.ws;
    const bf16_t* h1 = (const bf16_t*)(ws + WS_PRE); const unsigned char* ys = ws + WS_YS;     const unsigned* tokinfo = (const unsigned*)(ws + WS_TOKINFO);
    const LAS int* tab = (const LAS int*)(F.lds + TAB_OFF);
    const float *g2 = a->in[16], *b2 = a->in[17]; float* outp = a->out;
    const int lane = F.lane, gw = F.vcu * NWAVES + F.wave, NGW = F.G * NWAVES;
    f32x4 gv[4], bv[4];
#pragma unroll
    for (int j = 0; j < 4; ++j) { gv[j] = *(const f32x4*)(g2 + 4 * lane + 256 * j); bv[j] = *(const f32x4*)(b2 + 4 * lane + 256 * j); }
    const int nrw = (NTOK - gw + NGW - 1) / NGW;
    if (nrw > 0) {
#define ROWK(k) (gw + ((k) < nrw ? (k) : nrw - 1) * NGW)
#define TI_LOAD(k, A, B) do { const unsigned* ti_ = tokinfo + (size_t)ROWK(k) * 8; A = *(const u32x4*)ti_; B = *(const u32x2*)(ti_ + 4); } while (0)
#define DATA_LOAD(k, A, B, HW, YA, YB) do { const int e1_ = (int)A.x, e2_ = (int)A.w; \
        const size_t s1_ = (size_t)tab[T_BLK0 + e1_] * 256 + A.y, s2_ = (size_t)tab[T_BLK0 + e2_] * 256 + B.x; \
        const bf16_t* hr_ = h1 + (size_t)ROWK(k) * DM + 4 * lane; const unsigned char* y1_ = ys + s1_ * DM + 4 * lane; const unsigned char* y2_ = ys + s2_ * DM + 4 * lane; \
        _Pragma("unroll") for (int j = 0; j < 4; ++j) { HW[j] = __builtin_nontemporal_load((const u32x2*)(hr_ + 256 * j)); YA[j] = __builtin_nontemporal_load((const unsigned*)(y1_ + 256 * j)); YB[j] = __builtin_nontemporal_load((const unsigned*)(y2_ + 256 * j)); } } while (0)
        u32x4 tc0, tn0, tq0; u32x2 tc1, tn1, tq1;
        u32x2 hw[4], hwn[4]; unsigned ya[4], yb[4], yan[4], ybn[4];
        TI_LOAD(0, tc0, tc1); TI_LOAD(1, tn0, tn1);
        DATA_LOAD(0, tc0, tc1, hw, ya, yb);
        for (int k = 0; k < nrw; ++k) {
            TI_LOAD(k + 2, tq0, tq1);
            DATA_LOAD(k + 1, tn0, tn1, hwn, yan, ybn);
            const float w1 = __uint_as_float(tc0.z), w2 = __uint_as_float(tc1.y);
            f32x4 v[4]; float sm = 0.f;
#pragma unroll
            for (int j = 0; j < 4; ++j) {
                v[j][0] = ALPHA * bflo(hw[j].x) + w1 * __builtin_amdgcn_cvt_f32_fp8((int)ya[j], 0) + w2 * __builtin_amdgcn_cvt_f32_fp8((int)yb[j], 0);
                v[j][1] = ALPHA * bfhi(hw[j].x) + w1 * __builtin_amdgcn_cvt_f32_fp8((int)ya[j], 1) + w2 * __builtin_amdgcn_cvt_f32_fp8((int)yb[j], 1);
                v[j][2] = ALPHA * bflo(hw[j].y) + w1 * __builtin_amdgcn_cvt_f32_fp8((int)ya[j], 2) + w2 * __builtin_amdgcn_cvt_f32_fp8((int)yb[j], 2);
                v[j][3] = ALPHA * bfhi(hw[j].y) + w1 * __builtin_amdgcn_cvt_f32_fp8((int)ya[j], 3) + w2 * __builtin_amdgcn_cvt_f32_fp8((int)yb[j], 3);
                sm += (v[j][0] + v[j][1]) + (v[j][2] + v[j][3]); }
            const float mean = wave_sum(sm) * (1.f / DM); float s2v = 0.f;
#pragma unroll
            for (int j = 0; j < 4; ++j) { v[j] = v[j] - mean; s2v += (v[j][0] * v[j][0] + v[j][1] * v[j][1]) + (v[j][2] * v[j][2] + v[j][3] * v[j][3]); }
            const float rstd = 1.f / sqrtf(wave_sum(s2v) * (1.f / DM) + LN_EPS);
            float* orow = outp + (size_t)(gw + k * NGW) * DM + 4 * lane;
#pragma unroll
            for (int j = 0; j < 4; ++j) __builtin_nontemporal_store(v[j] * rstd * gv[j] + bv[j], (f32x4*)(orow + 256 * j));
            tc0 = tn0; tc1 = tn1; tn0 = tq0; tn1 = tq1;
#pragma unroll
            for (int j = 0; j < 4; ++j) { hw[j] = hwn[j]; ya[j] = yan[j]; yb[j] = ybn[j]; }
        }
#undef ROWK
#undef TI_LOAD
#undef DATA_LOAD
    }
}

#if DBG_NAIVE
constexpr size_t WS_NK = 296 * MiB, WS_NV = 312 * MiB, WS_NKI = 328 * MiB;
__device__ __forceinline__ float naive_proj(const float* xs  , const float* w_in, int col) {
    float s = 0.f; for (int d = 0; d < DM; ++d) s += xs[d] * w_in[(size_t)d * INW + col]; return s;
}
__device__ __forceinline__ void naive_kv(Frame& F) {
    const KArgs ka = kargs(); const float* xin = ka->in[0]; const float* win = ka->in[1];
    float* nk = (float*)(F.ws + WS_NK); float* nv = (float*)(F.ws + WS_NV); float* nki = (float*)(F.ws + WS_NKI);
    LAS float* xs = (LAS float*)F.lds; LAS float* pr = xs + 1024;
    for (int tok = F.vcu; tok < NTOK; tok += F.G) {
        __syncthreads();
        for (int i = F.tid; i < DM; i += 512) xs[i] = xin[(size_t)tok * DM + i];
        __syncthreads();
        if (F.tid < 320) { const int col = F.tid < 256 ? 512 + F.tid : 1280 + (F.tid - 256); float s = 0.f; for (int d = 0; d < DM; ++d) s += xs[d] * win[(size_t)d * INW + col]; pr[F.tid] = s; }
        __syncthreads();
        const int pos = tok & (SEQ - 1);
        if (F.tid < 24) {
            const int grp = F.tid >> 3, i = F.tid & 7, base = grp == 0 ? 0 : (grp == 1 ? 64 : 256);
            const float inv = (float)pow(500000.0, -(double)i / 8.0); const float ang = (float)pos * inv, c = cosf(ang), s = sinf(ang);
            const float x1 = pr[base + i], x2 = pr[base + 8 + i]; pr[base + i] = x1 * c - x2 * s; pr[base + 8 + i] = x2 * c + x1 * s;
        }
        __syncthreads();
        if (F.tid < 128) { nk[(size_t)tok * 128 + F.tid] = pr[F.tid]; nv[(size_t)tok * 128 + F.tid] = pr[128 + F.tid]; }
        if (F.tid < 64) nki[(size_t)tok * 64 + F.tid] = pr[256 + F.tid];
    }
}
__device__ __forceinline__ void naive_attn(Frame& F) {
    const KArgs ka = kargs(); const float* xin = ka->in[0]; const float* win = ka->in[1];
    const float* nk = (const float*)(F.ws + WS_NK); const float* nv = (const float*)(F.ws + WS_NV); const float* nki = (const float*)(F.ws + WS_NKI);
    bf16_t* attn = (bf16_t*)(F.ws + WS_AC) + 512;
    LAS float* xs = (LAS float*)F.lds;
    LAS float* qs = xs + 1024;
    LAS float* qis = qs + 512;
    LAS float* wis = qis + 512;
    LAS float* sc = wis + 16;
    LAS int* sel = (LAS int*)(sc + 2048);
    LAS int* nsel = sel + 256;
    LAS float* pl = (LAS float*)(nsel + 16);
    for (int tok = F.vcu; tok < NTOK; tok += F.G) {
        const int pos = tok & (SEQ - 1), b0 = tok - pos;
        __syncthreads();
        for (int i = F.tid; i < DM; i += 512) xs[i] = xin[(size_t)tok * DM + i];
        if (F.tid == 0) nsel[0] = 0;
        __syncthreads();
        for (int c = F.tid; c < 1032; c += 512) { const int col = c < 512 ? c : (c < 1024 ? 768 + (c - 512) : 1344 + (c - 1024));
            float s = 0.f; for (int d = 0; d < DM; ++d) s += xs[d] * win[(size_t)d * INW + col];
            if (c < 512) qs[c] = s; else if (c < 1024) qis[c - 512] = s; else wis[c - 1024] = s; }
        __syncthreads();
        if (F.tid < 128) { const int which = F.tid >> 6, hd = (F.tid >> 3) & 7, i = F.tid & 7; LAS float* p = (which ? qis : qs) + hd * 64;
            const float inv = (float)pow(500000.0, -(double)i / 8.0); const float ang = (float)pos * inv, c = cosf(ang), s = sinf(ang);
            const float x1 = p[i], x2 = p[8 + i]; p[i] = x1 * c - x2 * s; p[8 + i] = x2 * c + x1 * s; }
        __syncthreads();
#if DBG_NAIVE == 2
        { const bf16_t* qif = (const bf16_t*)(F.ws + WS_QI) + (size_t)tok * 512; for (int i = F.tid; i < 512; i += 512) qis[i] = __uint_as_float((unsigned)qif[i] << 16);
          if (F.tid < 8) wis[F.tid] = ((const float*)(F.ws + WS_WI))[(size_t)tok * 8 + F.tid]; }
        __syncthreads();
        for (int s = F.tid; s <= pos; s += 512) { const int tk_ = b0 + s; const bf16_t* kr = (const bf16_t*)(F.ws + WS_KI) + (size_t)(tk_ >> 5) * 2048 + (tk_ & 31) * 16; float tot = 0.f;
            for (int hd = 0; hd < 8; ++hd) { float d = 0.f; for (int e = 0; e < 64; ++e) d += qis[hd * 64 + e] * __uint_as_float((unsigned)kr[(e >> 4) * 512 + ((e >> 3) & 1) * 8 + (e & 7)] << 16); tot += fmaxf(d, 0.f) * (wis[hd] * WSCALE); }
            sc[s] = tot; }
#else
        for (int s = F.tid; s <= pos; s += 512) { const float* kr = nki + (size_t)(b0 + s) * 64; float tot = 0.f;
            for (int hd = 0; hd < 8; ++hd) { float d = 0.f; for (int e = 0; e < 64; ++e) d += qis[hd * 64 + e] * kr[e]; d *= 0.125f; tot += fmaxf(d, 0.f) * wis[hd]; }
            sc[s] = tot * 0.35355339059327373f; }
#endif
        __syncthreads();
        for (int s = F.tid; s <= pos; s += 512) { bool take = true;
            if (pos >= 256) { const float xv = sc[s]; int rank = 0; for (int s2 = 0; s2 <= pos; ++s2) { const float y = sc[s2]; rank += (y > xv || (y == xv && s2 < s)) ? 1 : 0; } take = rank < 256; }
            if (take) { const int p = atomicAdd((int*)nsel, 1); sel[p] = s; } }
        __syncthreads();
        const int ns = nsel[0]; const int hd = F.wave, lane = F.lane;
        float lg[4]; float mx = -INFINITY;
        for (int jj = 0; jj < 4; ++jj) { const int j = lane + 64 * jj; lg[jj] = -INFINITY;
            if (j < ns) { const float* kr = nk + (size_t)(b0 + sel[j]) * 128 + (hd >> 2) * 64; float d = 0.f; for (int e = 0; e < 64; ++e) d += qs[hd * 64 + e] * kr[e]; lg[jj] = d * 0.125f; mx = fmaxf(mx, lg[jj]); } }
        mx = wave_max(mx); float sum = 0.f;
        for (int jj = 0; jj < 4; ++jj) { const int j = lane + 64 * jj; const float p = (j < ns) ? expf(lg[jj] - mx) : 0.f; sum += p; pl[hd * 256 + j] = p; }
        sum = wave_sum(sum);
        LDS_WAIT(); asm volatile("" ::: "memory");
        float o = 0.f;
        for (int j = 0; j < ns; ++j) o += pl[hd * 256 + j] * nv[(size_t)(b0 + sel[j]) * 128 + (hd >> 2) * 64 + lane];
        o /= sum;
        bf16_t* ap = attn + (size_t)tok * 1024 + hd * 64 + lane;
        const float fast = __uint_as_float((unsigned)(*ap) << 16);
        const float blended = o + DBG_G * (fast - o);
        *ap = (bf16_t)(pkbf(blended, 0.f) & 0xffffu);
    }
}
#endif

__global__ void __launch_bounds__(NWAVES * 64, 2) mk_fwd(Args args_unused) {
    extern __shared__ __attribute__((aligned(16))) unsigned char lds[];
    Frame F;
    F.lds = (LAS unsigned char*)lds;
    F.MISC = (volatile LAS unsigned*)(F.lds + LDSCTL_OFF);
    F.tid = threadIdx.x; F.lane = F.tid & 63; F.wave = __builtin_amdgcn_readfirstlane(F.tid >> 6);
    F.G = gridDim.x; { const int bx = blockIdx.x; F.vcu = (F.G % 8 == 0) ? (bx % 8) * (F.G / 8) + bx / 8 : bx; }
    unsigned char* ws; int lo, hi;
    { const KArgs ka = kargs(); ws = ka->ws; lo = ka->ph_lo; hi = ka->ph_hi; }
    F.ws = ws; F.ctl = (unsigned*)(ws + WS_CTL);
    for (int u = F.tid; u < (LDS_BYTES - LDSCTL_OFF) / 4; u += NWAVES * 64) ((LAS unsigned*)(F.lds + LDSCTL_OFF))[u] = 0u;
    __syncthreads();
#if MK_SPLIT
#define GRID_BAR() do { } while (0)
#else
    XcdBarrier bar = xcd_barrier_post(F.ctl + CW_BAR, F.MISC + 8);
#define GRID_BAR() xcd_barrier(bar)
#endif
#ifndef PHASE_MASK
#define PHASE_MASK 0xFFFF
#endif
#define IN(k) ((((PHASE_MASK) >> (k)) & 1) && lo <= (k) && (k) < hi)
#define BOTH(k, k2) (IN(k) && IN(k2))

    bf16_t* xb = (bf16_t*)(ws + WS_XB);
    bf16_t *qb = (bf16_t*)(ws + WS_Q), *kbuf = (bf16_t*)(ws + WS_K), *vbuf = (bf16_t*)(ws + WS_V), *qib = (bf16_t*)(ws + WS_QI), *kib = (bf16_t*)(ws + WS_KI);
    float* wib = (float*)(ws + WS_WI);
    bf16_t *ub = (bf16_t*)(ws + WS_U), *cbb = (bf16_t*)(ws + WS_CB), *acb = (bf16_t*)(ws + WS_AC), *gab = (bf16_t*)(ws + WS_GA), *rtb = (bf16_t*)(ws + WS_RT);
    unsigned* masks = (unsigned*)(ws + WS_MASK);
    bf16_t *merged = (bf16_t*)(ws + WS_MERGED), *h1b = (bf16_t*)(ws + WS_PRE), *ysb_unused = nullptr; (void)ysb_unused;
    float* pre = (float*)(ws + WS_PRE);

    if (IN(0)) { p0_prologue(F); if (BOTH(0, 1)) GRID_BAR(); }
    if (IN(1)) {
        pg8::Gemm g{xb, (const bf16_t*)(ws + WS_WIN), NTOK, NPROJ, DM, 0}; pg8::StaticOrder S; S.init(NTOK, NPROJ, F.G, (int)blockIdx.x);
        EpiProj E{qb, kbuf, vbuf, qib, kib, ub, cbb, gab, rtb, wib, (const float*)(ws + WS_ROPE), kargs()->in[2]};
        pg8::gemm_phase<EpiProj, pg8::StaticOrder, true, false>(F.lds, g, S, E, nullptr);
        if (BOTH(1, 2)) GRID_BAR();
    }
    if (IN(2)) {
        LAS float* scl = (LAS float*)F.lds;
        LAS unsigned* maskw = (LAS unsigned*)(F.lds + TAB_OFF);
        for (int i = F.tid; i < 2048; i += 512) maskw[i] = 0u;
        __syncthreads();
        if (F.G == 256) {
            const int b = F.vcu >> 4, j = F.vcu & 15;
#pragma unroll 1
            for (int i = 0; i < 8; ++i) { const int qt = 32 * (i >> 1) + ((i & 1) ? 31 - j : j);
                const int gwv = F.vcu * NWAVES + F.wave, jx0 = i < 4 ? 2 * i : 4 + i;
                score_select_unit(F, b, qt, qib, kib, wib, scl, maskw, masks, gwv + 2048 * jx0, i < 4 ? gwv + 2048 * (jx0 + 1) : -1); }
        } else {
#pragma unroll 1
            for (int un = F.vcu; un < NBATCH * 128; un += F.G) score_select_unit(F, un >> 7, un & 127, qib, kib, wib, scl, maskw, masks, -1, -1);
        }
        conv_pass(F, ub, cbb, kargs()->in[5], acb);
        if (PROBE_P2 == 3) conv_pass(F, ub, cbb, kargs()->in[5], acb);
        if (BOTH(2, 3)) GRID_BAR();
    }
    if (IN(3)) {
        const int nun = NBATCH * 8 * 8;
        if (F.G == 256) {
            const int bh = F.vcu >> 1, s0 = 2 * (F.vcu & 1);
#pragma unroll 1
            for (int i = 0; i < 4; ++i) { const int qbk = (i == 0) ? s0 : (i == 1) ? 7 - s0 : (i == 2) ? s0 + 1 : 6 - s0;
                attn_body::attn_unit<8>(bh >> 3, bh & 7, qbk, (const attn_body::bf16*)qb, (const attn_body::bf16*)kbuf, (const attn_body::bf16*)vbuf, (attn_body::bf16*)acb, masks, (char*)lds); }
        } else {
#pragma unroll 1
            for (int un = F.vcu; un < nun; un += F.G) attn_body::attn_unit<8>(un >> 6, (un >> 3) & 7, un & 7, (const attn_body::bf16*)qb, (const attn_body::bf16*)kbuf, (const attn_body::bf16*)vbuf, (attn_body::bf16*)acb, masks, (char*)lds);
        }
        if (BOTH(3, 4)) GRID_BAR();
    }
#if DBG_NAIVE
    if (IN(4)) { naive_kv(F); }
    if (IN(11)) { naive_attn(F); }
#else
    if (IN(4)) { if (BOTH(4, 5)) { } }
#endif
    if (IN(5)) {
        pg8::Gemm g{acb, (const bf16_t*)(ws + WS_WAU), NTOK, DM, DM, 0}; pg8::StaticOrder S; S.init(NTOK, DM, F.G, (int)blockIdx.x);
        EpiMerged E{gab, rtb, merged};
        pg8::gemm_phase<EpiMerged, pg8::StaticOrder, true, false, true>(F.lds, g, S, E, nullptr);
        if (BOTH(5, 6)) GRID_BAR();
    }
    if (IN(6)) {
        pg8::Gemm g{merged, (const bf16_t*)(ws + WS_WOUT), NTOK, DM, DM, 0}; pg8::StaticOrder S; S.init(NTOK, DM, F.G, (int)blockIdx.x);
        EpiOut E{(bf16_t*)(ws + WS_MIX)};
        pg8::gemm_phase<EpiOut, pg8::StaticOrder, true, false>(F.lds, g, S, E, nullptr);
        if (BOTH(6, 7)) GRID_BAR();
    }
    if (IN(7)) { ln1_router(F, (kargs()->flags & 1) != 0); if (BOTH(7, 8)) GRID_BAR(); }
    if (IN(8)) {
        moe_tables(F);
        LAS int* tab = (LAS int*)(F.lds + TAB_OFF);
        const int nunits = tab[T_NB] * 4; const int* lists = (const int*)(ws + WS_LIST);
        for (int i = 0; i < T_ROWS_UNITS; ++i) { const int L = i * F.G + F.vcu; if (L >= nunits) break;
            const int rbg = L >> 2, e = tab[T_BLKE + rbg], slot0 = (rbg - tab[T_BLK0 + e]) * 256, cnt = tab[T_CNT + e];
            if (F.tid < 256) { const int sl = slot0 + F.tid; tab[T_ROWS + i * 256 + F.tid] = sl < cnt ? lists[(size_t)e * LISTCAP + sl] : 0; } }
        __syncthreads();
        pg8::Gemm g{(const bf16_t*)(ws + WS_H1Q), (const bf16_t*)(ws + WS_WGU), CAPROWS, NEXP * 1024, 512, 0}; pg8::MoeOrder S{tab + T_BLKE, nunits, F.G, F.vcu};
        EpiSwiGLU E{ws + WS_HID};
        pg8::gemm_phase<EpiSwiGLU, pg8::MoeOrder, true, true, false, true>(F.lds, g, S, E, tab + T_ROWS);
        if (BOTH(8, 9)) GRID_BAR();
    }
    if (IN(9)) {
        moe_tables(F);
        LAS int* tab = (LAS int*)(F.lds + TAB_OFF);
        const int nunits = tab[T_NB] * 4;
        pg8::Gemm g{(const bf16_t*)(ws + WS_HID), (const bf16_t*)(ws + WS_WD), CAPROWS, NEXP * 1024, 256, 0}; pg8::MoeOrder S{tab + T_BLKE, nunits, F.G, F.vcu};
        EpiYs E{ws + WS_YS};
        pg8::gemm_phase<EpiYs, pg8::MoeOrder, true, false, false, true>(F.lds, g, S, E, nullptr);
        if (BOTH(9, 10)) GRID_BAR();
    }
    if (IN(10)) { moe_tables(F); combine_ln2(F); }
#undef IN
#undef BOTH
}

extern "C" void kernel_launch(void* const* d_in, const int* in_sizes, int n_in, void* d_out, int out_size, void* d_ws, size_t ws_size, hipStream_t stream) {
    static int grid = 0;
    if (grid == 0) {
        if (n_in != 18 || in_sizes[0] != NTOK * DM || out_size != NTOK * DM || ws_size < WS_END) { fprintf(stderr, "kernel_launch: unexpected shapes (n_in %d, ws %zu)\n", n_in, ws_size); grid = -1; return; }
        int dev = 0, cus = 0, per_cu = 0;
        if (hipGetDevice(&dev) != hipSuccess || hipDeviceGetAttribute(&cus, hipDeviceAttributeMultiprocessorCount, dev) != hipSuccess) { grid = -1; return; }
        if (hipFuncSetAttribute((const void*)mk_fwd, hipFuncAttributeMaxDynamicSharedMemorySize, LDS_BYTES) != hipSuccess) { fprintf(stderr, "kernel_launch: hipFuncSetAttribute failed\n"); grid = -1; return; }
        if (hipOccupancyMaxActiveBlocksPerMultiprocessor(&per_cu, (const void*)mk_fwd, NWAVES * 64, LDS_BYTES) != hipSuccess || per_cu < 1) fprintf(stderr, "kernel_launch: occupancy query reports %d\n", per_cu);
        (void)hipGetLastError();
        grid = cus;
    }
    if (grid < 0) return;
    (void)hipMemsetAsync((char*)d_ws + WS_CTL, 0, CTL_ZERO_BYTES, stream);
    Args a{};
    for (int i = 0; i < 18; ++i) a.in[i] = (const float*)d_in[i];
    a.out = (float*)d_out; a.ws = (unsigned char*)d_ws;
#if MK_SPLIT
#if DBG_NAIVE
    const int seq[] = {0, 1, 2, 3, 4, 11, 5, 6, 7, 8, 9, 10};
#else
    const int seq[] = {0, 1, 2, 3, 5, 6, 7, 8, 9, 10};
#endif
    for (int ph : seq) { a.ph_lo = ph; a.ph_hi = ph + 1;
#ifdef PROBE_P7
        if (ph == 7) { a.flags = 1; hipLaunchKernelGGL(mk_fwd, dim3(grid), dim3(NWAVES * 64), LDS_BYTES, stream, a); a.flags = 0; }
#endif
        hipLaunchKernelGGL(mk_fwd, dim3(grid), dim3(NWAVES * 64), LDS_BYTES, stream, a);
#ifdef PROBE_DUP
        if (ph == PROBE_DUP) hipLaunchKernelGGL(mk_fwd, dim3(grid), dim3(NWAVES * 64), LDS_BYTES, stream, a);
#endif
    }
#else
    a.ph_lo = 0; a.ph_hi = 11;
    hipLaunchKernelGGL(mk_fwd, dim3(grid), dim3(NWAVES * 64), LDS_BYTES, stream, a);
#endif
}
```

```cpp
#include <hip/hip_runtime.h>
#include <hip/hip_bf16.h>
#include <cstdio>
#include <cstdint>

#ifndef MK_SPLIT
#define MK_SPLIT 0
#endif
#ifndef DBG_NAIVE
#define DBG_NAIVE 0
#endif
#ifndef DBG_G
#define DBG_G 1.0f
#endif

#define LAS __attribute__((address_space(3)))
#define GAS __attribute__((address_space(1)))
typedef unsigned short bf16_t;
typedef short bf16x8 __attribute__((ext_vector_type(8)));
typedef short s16x4 __attribute__((ext_vector_type(4)));
typedef float f32x2 __attribute__((ext_vector_type(2)));
typedef float f32x4 __attribute__((ext_vector_type(4)));
typedef float f32x16 __attribute__((ext_vector_type(16)));
typedef unsigned u32x2 __attribute__((ext_vector_type(2)));
typedef unsigned u32x4 __attribute__((ext_vector_type(4)));
typedef unsigned u32x16 __attribute__((ext_vector_type(16)));
typedef __bf16 bf16x2_t __attribute__((ext_vector_type(2)));

constexpr int NTOK = 32768, SEQ = 2048, NBATCH = 16, DM = 1024;
constexpr int NPROJ = 5120, INW = 4936;
constexpr int NEXP = 32, DEXP = 512, LISTCAP = 32768;
constexpr int CAPROWS = 65536 + NEXP * 256;
constexpr float LN_EPS = 1e-5f;
constexpr float ALPHA = 1.189207115002721f;
constexpr float C2 = 0.125f * 1.4426950408889634f;
constexpr float WSCALE = 0.125f * 0.35355339059327373f;

constexpr size_t MiB = 1u << 20;
constexpr size_t WS_CTL = 0, CTL_ZERO_BYTES = 1 * MiB;
constexpr size_t WS_ROPE = 1 * MiB;
constexpr size_t WS_WC = 1 * MiB + 256 * 1024;
constexpr size_t WS_WIN = 2 * MiB, WS_WAU = 12 * MiB, WS_WCU = 13 * MiB, WS_WOUT = 14 * MiB, WS_WD = 16 * MiB, WS_WGU = 48 * MiB;
constexpr size_t WS_XB = 112 * MiB;
constexpr size_t WS_MIX = 112 * MiB;
constexpr size_t WS_H1Q = 304 * MiB;
constexpr size_t WS_AC = 112 * MiB;
constexpr size_t WS_Q = 176 * MiB, WS_K = 208 * MiB, WS_V = 216 * MiB, WS_QI = 224 * MiB, WS_KI = 256 * MiB, WS_WI = 260 * MiB;
constexpr size_t WS_MERGED = 176 * MiB;
constexpr size_t WS_U = 264 * MiB, WS_ATTN = 264 * MiB;
constexpr size_t WS_CB = 296 * MiB, WS_MASK = 360 * MiB, WS_GATES = 368 * MiB;
constexpr size_t WS_GA = 368 * MiB, WS_RT = 432 * MiB;
constexpr size_t WS_PRE = 240 * MiB;
constexpr size_t WS_HID = 368 * MiB;
constexpr size_t WS_LIST = 496 * MiB, WS_TOKINFO = 500 * MiB;
constexpr size_t WS_YS = 48 * MiB;
constexpr size_t WS_END = 512 * MiB;
static_assert(WS_YS + (size_t)CAPROWS * 1024 * 2 <= WS_PRE && WS_HID + (size_t)CAPROWS * 512 * 2 <= WS_LIST, "ws map");
constexpr int CW_BAR = 4096;
constexpr int CW_CNT = 8192;
constexpr int RING_BYTES = 131072;
constexpr int LDSCTL_OFF = RING_BYTES;
constexpr int TAB_OFF = RING_BYTES + 512;
constexpr int T_CNT = 0, T_BLK0 = 32, T_NB = 68, T_BLKE = 72, T_ROWS = 400, T_ROWS_UNITS = 12;
constexpr int LDS_BYTES = 147456;
static_assert(TAB_OFF + (T_ROWS + T_ROWS_UNITS * 256) * 4 <= LDS_BYTES && TAB_OFF + 8192 <= LDS_BYTES, "lds map");
constexpr int NWAVES = 8;

__device__ __forceinline__ unsigned pkbf(float lo, float hi) { f32x2 v = {lo, hi}; bf16x2_t b = __builtin_convertvector(v, bf16x2_t); return __builtin_bit_cast(unsigned, b); }
__device__ __forceinline__ float bflo(unsigned u) { return __uint_as_float(u << 16); }
__device__ __forceinline__ float bfhi(unsigned u) { return __uint_as_float(u & 0xffff0000u); }
__device__ __forceinline__ float wave_sum(float v) {
#pragma unroll
    for (int o = 1; o < 64; o <<= 1) v += __shfl_xor(v, o);
    return v;
}
__device__ __forceinline__ float wave_max(float v) {
#pragma unroll
    for (int o = 1; o < 64; o <<= 1) v = fmaxf(v, __shfl_xor(v, o));
    return v;
}
__device__ __forceinline__ float wave_min(float v) {
#pragma unroll
    for (int o = 1; o < 64; o <<= 1) v = fminf(v, __shfl_xor(v, o));
    return v;
}
#define LDS_WAIT() asm volatile("s_waitcnt lgkmcnt(0)" ::: "memory")
#define VM_WAIT() asm volatile("s_waitcnt vmcnt(0)" ::: "memory")

namespace pg8 {
constexpr int BM = 256, BK = 64, HALF = 128, HTB = HALF * BK * 2, STAGE_BYTES = 8 * HTB, NXCD = 8, WGM = 8;
__host__ __device__ __forceinline__ int lds_byte(int r, int c) { const int st = (r >> 4) * 2 + (c >> 5), rr = r & 15, cc = c & 31, ob = rr * 64 + cc * 2; return st * 1024 + (ob ^ (((ob >> 9) & 1) << 5)); }
__host__ __device__ __forceinline__ void stage_rc(int b, int& R, int& C) { const int st = b / 1024, sb = b % 1024, swz = sb ^ (((sb >> 9) & 1) << 5); R = (st >> 1) * 16 + swz / 64; C = (st & 1) * 32 + (swz % 64) / 2; }
__host__ __device__ __forceinline__ int perm32(int rho) { const int n = rho >> 4, i = rho & 15; return 8 * (i >> 2) + 4 * n + (i & 3); }

struct Unit { int pm, pn; };
struct Gemm { const bf16_t* A; const bf16_t* Bt; int M, N, K; int apitch; };

struct StaticOrder {
    int nM, nN, nwg, G, c;
    __host__ __device__ void init(int M, int N, int G_, int c_) { nM = M / BM; nN = N / BM; nwg = nM * nN; G = G_; c = c_; }
    __host__ __device__ bool next(int i, Unit& u) const {
        const long L = (long)i * G + c; if (L >= nwg) return false;
        int wgid = (int)L; { const int q = nwg / NXCD, r = nwg % NXCD, xcd = wgid % NXCD, off = wgid / NXCD; wgid = (xcd < r ? xcd * (q + 1) : r * (q + 1) + (xcd - r) * q) + off; }
        const int nig = WGM * nN, gid = wgid / nig, fm = gid * WGM, gsz = (nM - fm) < WGM ? (nM - fm) : WGM;
        u.pm = fm + ((wgid % nig) % gsz); u.pn = (wgid % nig) / gsz; return true;
    }
};
struct MoeOrder {
    const LAS int* blk_e; int nunits, G, c;
    __device__ __forceinline__ bool next(int i, Unit& u) const {
        const int L = i * G + c; if (L >= nunits) return false;
        const int rbg = L >> 2; u.pm = rbg; u.pn = blk_e[rbg] * 4 + (L & 3); return true;
    }
};

typedef int i32x8 __attribute__((ext_vector_type(8)));
typedef int i32x4_t __attribute__((ext_vector_type(4)));
constexpr int F8_WSCALE_E = 122;
template <class Epi, class Sched, bool ALIGN_EPI, bool GATHER, bool MIDHOOK = false, bool F8 = false>
__device__ __forceinline__ void gemm_phase(LAS unsigned char* lds, const Gemm g, const Sched& S, const Epi& E, const LAS int* rowtab) {
    const int tid = threadIdx.x, wid = __builtin_amdgcn_readfirstlane(tid >> 6), lane = tid & 63, wr = wid >> 2, wc = wid & 3, fr = lane & 15, fq = lane >> 4;
    const int K = g.K; int nt = K / BK;
    if constexpr (F8) asm volatile("" : "+s"(nt));
    int Rr[2]; unsigned cofs[2], voffB[2];
#pragma unroll
    for (int i = 0; i < 2; ++i) { int R, C; stage_rc(tid * 16 + i * 8192, R, C); const int Rb = Epi::PERM ? ((R & ~31) + perm32(R & 31)) : R;
        Rr[i] = R; cofs[i] = (unsigned)C * 2u; voffB[i] = (unsigned)(Rb * K + C) * 2u; }
    const unsigned rowb = g.apitch ? (unsigned)g.apitch : (unsigned)K * 2u;
    const size_t kstep = (size_t)(BK * 2);
    const size_t hstep = (size_t)HALF * K * 2;
    const size_t tstep = 2 * hstep;
    const unsigned ldsw = (unsigned)wid * 1024u;
    const int aoff = lds_byte(wr * 64 + fr, fq * 8), boff = lds_byte(wc * 32 + fr, fq * 8);
    const char* gA = (const char*)g.A;
#define PG8_SA(b, h) (((b) * 2 + (h)) * HTB)
#define PG8_SB(b, h) ((4 + (b) * 2 + (h)) * HTB)
#define PG8_STAGE(bufoff, gbase, voff) do { _Pragma("unroll") for (int _i = 0; _i < 2; ++_i) \
        __builtin_amdgcn_global_load_lds((const unsigned*)((const char*)(gbase) + (voff)[_i]), (LAS unsigned*)(lds + (bufoff) + ldsw + _i * 8192), 16, 0, 0); } while (0)
#define PG8_LD8(p_) __builtin_shufflevector(*(const LAS i32x4_t*)(p_), *(const LAS i32x4_t*)((p_) + 1024), 0, 1, 2, 3, 4, 5, 6, 7)
#define PG8_LDA(dst, b, h) do { if constexpr (F8) { _Pragma("unroll") for (int m = 0; m < 4; ++m) dst##8[m] = PG8_LD8(lds + PG8_SA(b, h) + aoff + m * 2048); } \
        else { _Pragma("unroll") for (int m = 0; m < 4; ++m) _Pragma("unroll") for (int k = 0; k < 2; ++k) dst[m][k] = *(const LAS bf16x8*)(lds + PG8_SA(b, h) + aoff + m * 2048 + k * 1024); } } while (0)
#define PG8_LDB(dst, b, h) do { if constexpr (F8) { _Pragma("unroll") for (int n = 0; n < 2; ++n) dst##8[n] = PG8_LD8(lds + PG8_SB(b, h) + boff + n * 2048); } \
        else { _Pragma("unroll") for (int n = 0; n < 2; ++n) _Pragma("unroll") for (int k = 0; k < 2; ++k) dst[n][k] = *(const LAS bf16x8*)(lds + PG8_SB(b, h) + boff + n * 2048 + k * 1024); } } while (0)
#define PG8_MMA(ai, bj, At, Bt) do { if constexpr (F8) __builtin_amdgcn_sched_barrier(0);     \
        __builtin_amdgcn_s_setprio(1); \
        if constexpr (F8) { _Pragma("unroll") for (int m = 0; m < 4; ++m) _Pragma("unroll") for (int n = 0; n < 2; ++n) \
            asm volatile("v_mfma_scale_f32_16x16x128_f8f6f4 %0, %1, %2, %0, %3, %4 op_sel_hi:[0,0,0]" : "+v"(acc[ai][bj][m][n]) : "v"(Bt##8[n]), "v"(At##8[m]), "v"(f8_sw), "v"(f8_sa));     \
            __builtin_amdgcn_sched_barrier(0); } \
        else { _Pragma("unroll") for (int m = 0; m < 4; ++m) _Pragma("unroll") for (int n = 0; n < 2; ++n) _Pragma("unroll") for (int k = 0; k < 2; ++k) \
            acc[ai][bj][m][n] = __builtin_amdgcn_mfma_f32_16x16x32_bf16(Bt[n][k], At[m][k], acc[ai][bj][m][n], 0, 0, 0); } \
        __builtin_amdgcn_s_setprio(0); } while (0)
#define PG8_WAIT_V(n) asm volatile("s_waitcnt vmcnt(" #n ")" ::: "memory")
#define PG8_WAIT_L(n) asm volatile("s_waitcnt lgkmcnt(" #n ")" ::: "memory")
#define PG8_BAR __builtin_amdgcn_s_barrier()
#define PG8_SCHED __builtin_amdgcn_sched_barrier(0)
#define PG8_AOFF(d0, d1, un, uidx) do { _Pragma("unroll") for (int _i = 0; _i < 2; ++_i) { unsigned r0_, r1_; \
        if (GATHER) { r0_ = (unsigned)rowtab[(uidx) * 256 + Rr[_i]]; r1_ = (unsigned)rowtab[(uidx) * 256 + 128 + Rr[_i]]; } \
        else { r0_ = (unsigned)((un).pm * 256 + Rr[_i]); r1_ = r0_ + 128u; } \
        d0[_i] = r0_ * rowb + cofs[_i]; d1[_i] = r1_ * rowb + cofs[_i]; } } while (0)
    Unit cur, nxt; int ui = 0;
    if (!S.next(0, cur)) return;
    f32x4 acc[2][2][4][2];
#pragma unroll
    for (int a = 0; a < 2; ++a)
#pragma unroll
        for (int b = 0; b < 2; ++b)
#pragma unroll
            for (int m = 0; m < 4; ++m)
#pragma unroll
                for (int n = 0; n < 2; ++n) acc[a][b][m][n] = (f32x4){0.f, 0.f, 0.f, 0.f};
    bf16x8 At[4][2], B0[2][2], B1[2][2]; i32x8 At8[4], B08[2], B18[2];
    int f8_sw = F8_WSCALE_E, f8_sa = 127; asm volatile("" : "+v"(f8_sw), "+v"(f8_sa));
    unsigned oc0[2], oc1[2], on0[2], on1[2];
    PG8_AOFF(oc0, oc1, cur, 0);
    const char* cB = (const char*)g.Bt + (size_t)cur.pn * tstep;
    PG8_STAGE(PG8_SB(0, 0), cB, voffB); PG8_STAGE(PG8_SB(0, 1), cB + hstep, voffB); PG8_STAGE(PG8_SA(0, 0), gA, oc0); PG8_STAGE(PG8_SA(0, 1), gA, oc1);
    if (wr == 1) PG8_BAR;
    PG8_WAIT_V(2); PG8_BAR;
    PG8_STAGE(PG8_SB(1, 0), cB + kstep, voffB); PG8_STAGE(PG8_SA(1, 0), gA + kstep, oc0); PG8_STAGE(PG8_SB(1, 1), cB + hstep + kstep, voffB);
    PG8_WAIT_V(6); PG8_BAR;
    for (;;) {
        const bool has_next = S.next(ui + 1, nxt);
        if (has_next) { PG8_AOFF(on0, on1, nxt, ui + 1); } else { on0[0] = oc0[0]; on0[1] = oc0[1]; on1[0] = oc1[0]; on1[1] = oc1[1]; }
        const char* nB = has_next ? (const char*)g.Bt + (size_t)nxt.pn * tstep : cB;
        for (int t = 0; t < nt; t += 2) {
            if constexpr (MIDHOOK) { if (t == nt / 2) E.mid(acc, cur, wr, wc, fr, fq); }
            const bool last = (t == nt - 2);
            const char* a1 = gA + (size_t)(t + 1) * kstep;
            const char* a2 = last ? gA : gA + (size_t)(t + 2) * kstep; const char* b2 = last ? nB : cB + (size_t)(t + 2) * kstep;
            const char* a3 = a2 + kstep; const char* b3 = b2 + kstep;
            unsigned o20[2], o21[2];
            o20[0] = last ? on0[0] : oc0[0]; o20[1] = last ? on0[1] : oc0[1]; o21[0] = last ? on1[0] : oc1[0]; o21[1] = last ? on1[1] : oc1[1];
            PG8_LDB(B0, 0, 0); PG8_LDB(B1, 0, 1); PG8_SCHED; PG8_LDA(At, 0, 0); PG8_STAGE(PG8_SA(1, 1), a1, oc1);
            PG8_WAIT_V(8); PG8_WAIT_L(0); PG8_BAR; PG8_MMA(0, 0, At, B0); PG8_MMA(0, 1, At, B1); PG8_BAR; PG8_SCHED;
            PG8_LDA(At, 0, 1); PG8_STAGE(PG8_SB(0, 0), b2, voffB); PG8_STAGE(PG8_SB(0, 1), b2 + hstep, voffB); PG8_STAGE(PG8_SA(0, 0), a2, o20);
            PG8_WAIT_V(8); PG8_WAIT_L(0); PG8_BAR; PG8_MMA(1, 0, At, B0); PG8_MMA(1, 1, At, B1); PG8_BAR; PG8_SCHED;
            PG8_LDB(B0, 1, 0); PG8_LDB(B1, 1, 1); PG8_SCHED; PG8_LDA(At, 1, 0); PG8_STAGE(PG8_SA(0, 1), a2, o21);
            PG8_WAIT_V(8); PG8_WAIT_L(0); PG8_BAR; PG8_MMA(0, 0, At, B0); PG8_MMA(0, 1, At, B1); PG8_BAR; PG8_SCHED;
            PG8_LDA(At, 1, 1); PG8_STAGE(PG8_SB(1, 0), b3, voffB); PG8_STAGE(PG8_SB(1, 1), b3 + hstep, voffB); PG8_STAGE(PG8_SA(1, 0), a3, o20);
            PG8_WAIT_V(8); PG8_WAIT_L(0); PG8_BAR; PG8_MMA(1, 0, At, B0); PG8_MMA(1, 1, At, B1); PG8_BAR; PG8_SCHED;
        }
        if constexpr (ALIGN_EPI) { if (wr == 0) PG8_BAR; }
        if constexpr (F8) asm volatile("s_nop 15\n\ts_nop 15" ::: "memory");
        E(acc, cur, wr, wc, fr, fq);
#ifdef PROBE_EPI2
        if constexpr (!MIDHOOK && !F8 && !GATHER) E(acc, cur, wr, wc, fr, fq);
#endif
        if (!has_next) break;
#pragma unroll
        for (int a = 0; a < 2; ++a)
#pragma unroll
            for (int b = 0; b < 2; ++b)
#pragma unroll
                for (int m = 0; m < 4; ++m)
#pragma unroll
                    for (int n = 0; n < 2; ++n) acc[a][b][m][n] = (f32x4){0.f, 0.f, 0.f, 0.f};
        cur = nxt; cB = nB; ++ui;
        oc0[0] = on0[0]; oc0[1] = on0[1]; oc1[0] = on1[0]; oc1[1] = on1[1];
        if constexpr (ALIGN_EPI) { if (wr == 1) PG8_BAR; }
    }
    PG8_WAIT_V(0);
    if constexpr (!ALIGN_EPI) { if (wr == 0) PG8_BAR; }
    PG8_BAR;
#undef PG8_SA
#undef PG8_SB
#undef PG8_STAGE
#undef PG8_LDA
#undef PG8_LDB
#undef PG8_MMA
#undef PG8_LD8
#undef PG8_WAIT_V
#undef PG8_WAIT_L
#undef PG8_BAR
#undef PG8_SCHED
#undef PG8_AOFF
}
}

typedef f32x4 AccT[2][2][4][2];
__device__ __forceinline__ void store8bf(bf16_t* p, const f32x4& v0, const f32x4& v1) {
    u32x4 w; w.x = pkbf(v0[0], v0[1]); w.y = pkbf(v0[2], v0[3]); w.z = pkbf(v1[0], v1[1]); w.w = pkbf(v1[2], v1[3]); *(u32x4*)p = w;
}
__device__ __forceinline__ void rope8(f32x4& v0, f32x4& v1, const float* rope, int pos, int i0) {
    const f32x4 c = *(const f32x4*)(rope + pos * 8 + i0), s = *(const f32x4*)(rope + SEQ * 8 + pos * 8 + i0);
    float a, b;
    a = v0[0]; b = v0[1]; v0[0] = a * c[0] - b * s[0]; v0[1] = b * c[0] + a * s[0];
    a = v0[2]; b = v0[3]; v0[2] = a * c[1] - b * s[1]; v0[3] = b * c[1] + a * s[1];
    a = v1[0]; b = v1[1]; v1[0] = a * c[2] - b * s[2]; v1[1] = b * c[2] + a * s[2];
    a = v1[2]; b = v1[3]; v1[2] = a * c[3] - b * s[3]; v1[3] = b * c[3] + a * s[3];
}
__device__ __forceinline__ float sigmoidf_(float z) { return __builtin_amdgcn_rcpf(1.0f + __expf(-z)); }

struct EpiProj {
    static constexpr bool PERM = true;
    bf16_t *q, *k, *v, *qi, *ki, *u, *cb, *ga, *rt; float* wi; const float* rope; const float* gate_bias;
    __device__ __forceinline__ void operator()(const AccT& acc, const pg8::Unit& un, int wr, int wc, int fr, int fq) const {
        const int pn = un.pn, row0 = un.pm * 256 + wr * 64 + fr, cg = 32 * wc + 8 * fq;
        const bool rot = ((wc & 1) == 0) && (fq < 2); const int i0 = 4 * fq;
        if (pn < 2 || pn == 3 || pn == 4) {
            bf16_t* dst = (pn < 2) ? q + pn * 256 : qi + (pn - 3) * 256; const float sc = (pn < 2) ? C2 : 1.0f;
#pragma unroll
            for (int ai = 0; ai < 2; ++ai)
#pragma unroll
                for (int m = 0; m < 4; ++m) { const int row = row0 + ai * 128 + m * 16, pos = row & (SEQ - 1);
#pragma unroll
                    for (int bj = 0; bj < 2; ++bj) { f32x4 v0 = acc[ai][bj][m][0], v1 = acc[ai][bj][m][1];
                        if (rot) rope8(v0, v1, rope, pos, i0);
                        v0 = v0 * sc; v1 = v1 * sc; store8bf(dst + (size_t)row * 512 + bj * 128 + cg, v0, v1); } }
        } else if (pn == 2) {
#pragma unroll
            for (int ai = 0; ai < 2; ++ai)
#pragma unroll
                for (int m = 0; m < 4; ++m) { const int row = row0 + ai * 128 + m * 16, pos = row & (SEQ - 1);
                    f32x4 v0 = acc[ai][0][m][0], v1 = acc[ai][0][m][1];
                    if (rot) rope8(v0, v1, rope, pos, i0);
                    store8bf(k + (size_t)row * 128 + cg, v0, v1);
                    store8bf(v + (size_t)row * 128 + cg, acc[ai][1][m][0], acc[ai][1][m][1]); }
        } else if (pn == 5) {
            if (wc < 2) {
#pragma unroll
                for (int ai = 0; ai < 2; ++ai)
#pragma unroll
                    for (int m = 0; m < 4; ++m) { const int row = row0 + ai * 128 + m * 16, pos = row & (SEQ - 1);
                        f32x4 v0 = acc[ai][0][m][0], v1 = acc[ai][0][m][1];
                        if (rot) rope8(v0, v1, rope, pos, i0);
                        { const int jch = cg >> 3; store8bf(ki + ((size_t)(row >> 5) * 4 + (jch >> 1)) * 512 + (row & 31) * 16 + (jch & 1) * 8, v0, v1); } }
            } else if (wc == 2 && fq == 0) {
#pragma unroll
                for (int ai = 0; ai < 2; ++ai)
#pragma unroll
                    for (int m = 0; m < 4; ++m) { const int row = row0 + ai * 128 + m * 16;
                        *(f32x4*)(wi + (size_t)row * 8) = acc[ai][0][m][0]; *(f32x4*)(wi + (size_t)row * 8 + 4) = acc[ai][0][m][1]; }
            }
        } else if (pn < 10) {
#pragma unroll
            for (int ai = 0; ai < 2; ++ai)
#pragma unroll
                for (int m = 0; m < 4; ++m) { const int row = row0 + ai * 128 + m * 16;
                    store8bf(u + (size_t)row * 512 + (pn - 6) * 128 + cg, acc[ai][0][m][0] * acc[ai][1][m][0], acc[ai][0][m][1] * acc[ai][1][m][1]); }
        } else if (pn < 12) {
#pragma unroll
            for (int ai = 0; ai < 2; ++ai)
#pragma unroll
                for (int m = 0; m < 4; ++m) { const int row = row0 + ai * 128 + m * 16;
#pragma unroll
                    for (int bj = 0; bj < 2; ++bj) store8bf(cb + (size_t)row * 512 + (pn - 10) * 256 + bj * 128 + cg, acc[ai][bj][m][0], acc[ai][bj][m][1]); }
        } else {
            const int gc0 = (pn - 12) * 128 + cg;
            const f32x4 ba0 = *(const f32x4*)(gate_bias + gc0), ba1 = *(const f32x4*)(gate_bias + gc0 + 4), bc0 = *(const f32x4*)(gate_bias + 1024 + gc0), bc1 = *(const f32x4*)(gate_bias + 1024 + gc0 + 4);
#pragma unroll
            for (int ai = 0; ai < 2; ++ai)
#pragma unroll
                for (int m = 0; m < 4; ++m) { const int row = row0 + ai * 128 + m * 16;
                    const f32x4 a0 = acc[ai][0][m][0] + ba0, a1 = acc[ai][0][m][1] + ba1, c0 = acc[ai][1][m][0] + bc0, c1 = acc[ai][1][m][1] + bc1;
                    f32x4 g0, g1, r0, r1;
#pragma unroll
                    for (int e = 0; e < 4; ++e) { const float ea0 = 1.0f + __expf(-a0[e]), ea1 = 1.0f + __expf(-a1[e]);
                        g0[e] = __builtin_amdgcn_rcpf(ea0); g1[e] = __builtin_amdgcn_rcpf(ea1);
                        r0[e] = ea0 * __builtin_amdgcn_rcpf(1.0f + __expf(-c0[e])); r1[e] = ea1 * __builtin_amdgcn_rcpf(1.0f + __expf(-c1[e])); }
                    store8bf(ga + (size_t)row * 1024 + gc0, g0, g1); store8bf(rt + (size_t)row * 1024 + gc0, r0, r1); }
        }
    }
};
struct EpiMerged {
    static constexpr bool PERM = true;
    const bf16_t* ga; const bf16_t* rt; bf16_t* out;
    __device__ __forceinline__ void scale(AccT& acc, const bf16_t* gsrc, const pg8::Unit& un, int wr, int wc, int fr, int fq) const {
        unsigned off0 = (unsigned)(un.pm * 256 + wr * 64 + fr) * 1024u + (unsigned)(un.pn * 256 + 32 * wc + 8 * fq);
        asm volatile("" : "+v"(off0));
#pragma unroll
        for (int ai = 0; ai < 2; ++ai)
#pragma unroll
            for (int m = 0; m < 4; ++m) {
#pragma unroll
                for (int bj = 0; bj < 2; ++bj) { const u32x4 gw = __builtin_nontemporal_load((const u32x4*)(gsrc + (off0 + (unsigned)((ai * 128 + m * 16) * 1024 + bj * 128))));
                    f32x4& v0 = acc[ai][bj][m][0]; f32x4& v1 = acc[ai][bj][m][1];
                    v0[0] *= bflo(gw.x); v0[1] *= bfhi(gw.x); v0[2] *= bflo(gw.y); v0[3] *= bfhi(gw.y);
                    v1[0] *= bflo(gw.z); v1[1] *= bfhi(gw.z); v1[2] *= bflo(gw.w); v1[3] *= bfhi(gw.w); } }
    }
    __device__ __forceinline__ void mid(AccT& acc, const pg8::Unit& un, int wr, int wc, int fr, int fq) const { scale(acc, rt, un, wr, wc, fr, fq); }
    __device__ __forceinline__ void operator()(AccT& acc, const pg8::Unit& un, int wr, int wc, int fr, int fq) const {
        scale(acc, ga, un, wr, wc, fr, fq);
        const int row0 = un.pm * 256 + wr * 64 + fr, col0 = un.pn * 256 + 32 * wc + 8 * fq;
#pragma unroll
        for (int ai = 0; ai < 2; ++ai)
#pragma unroll
            for (int m = 0; m < 4; ++m) { const int row = row0 + ai * 128 + m * 16;
#pragma unroll
                for (int bj = 0; bj < 2; ++bj) store8bf(out + (size_t)row * 1024 + col0 + bj * 128, acc[ai][bj][m][0], acc[ai][bj][m][1]); }
    }
};
struct EpiOut {
    static constexpr bool PERM = true;
    bf16_t* mix;
    __device__ __forceinline__ void operator()(const AccT& acc, const pg8::Unit& un, int wr, int wc, int fr, int fq) const {
        const int row0 = un.pm * 256 + wr * 64 + fr, col0 = un.pn * 256 + 32 * wc + 8 * fq;
#pragma unroll
        for (int ai = 0; ai < 2; ++ai)
#pragma unroll
            for (int m = 0; m < 4; ++m) { const int row = row0 + ai * 128 + m * 16;
#pragma unroll
                for (int bj = 0; bj < 2; ++bj) store8bf(mix + (size_t)row * 1024 + col0 + bj * 128, acc[ai][bj][m][0], acc[ai][bj][m][1]); }
    }
};
struct EpiSwiGLU {
    static constexpr bool PERM = true;
    unsigned char* hid;
    __device__ __forceinline__ void operator()(const AccT& acc, const pg8::Unit& un, int wr, int wc, int fr, int fq) const {
        const int row0 = un.pm * 256 + wr * 64 + fr, col0 = (un.pn & 3) * 128 + 32 * wc + 8 * fq;
#pragma unroll
        for (int ai = 0; ai < 2; ++ai)
#pragma unroll
            for (int m = 0; m < 4; ++m) { const int row = row0 + ai * 128 + m * 16; f32x4 h0, h1;
#pragma unroll
                for (int e = 0; e < 4; ++e) { const float g0 = acc[ai][0][m][0][e], g1 = acc[ai][0][m][1][e];
                    h0[e] = g0 * sigmoidf_(g0) * acc[ai][1][m][0][e]; h1[e] = g1 * sigmoidf_(g1) * acc[ai][1][m][1][e]; }
                int w0 = 0, w1 = 0;
                w0 = __builtin_amdgcn_cvt_pk_fp8_f32(h0[0], h0[1], w0, false); w0 = __builtin_amdgcn_cvt_pk_fp8_f32(h0[2], h0[3], w0, true);
                w1 = __builtin_amdgcn_cvt_pk_fp8_f32(h1[0], h1[1], w1, false); w1 = __builtin_amdgcn_cvt_pk_fp8_f32(h1[2], h1[3], w1, true);
                *(u32x2*)(hid + (size_t)row * 512 + col0) = (u32x2){(unsigned)w0, (unsigned)w1}; }
    }
};
struct EpiYs {
    static constexpr bool PERM = true;
    unsigned char* ys;
    __device__ __forceinline__ void operator()(const AccT& acc, const pg8::Unit& un, int wr, int wc, int fr, int fq) const {
        const int row0 = un.pm * 256 + wr * 64 + fr, col0 = (un.pn & 3) * 256 + 32 * wc + 8 * fq;
#pragma unroll
        for (int ai = 0; ai < 2; ++ai)
#pragma unroll
            for (int m = 0; m < 4; ++m) { const int row = row0 + ai * 128 + m * 16;
#pragma unroll
                for (int bj = 0; bj < 2; ++bj) { const f32x4 v0 = acc[ai][bj][m][0], v1 = acc[ai][bj][m][1]; int w0 = 0, w1 = 0;
                    w0 = __builtin_amdgcn_cvt_pk_fp8_f32(v0[0], v0[1], w0, false); w0 = __builtin_amdgcn_cvt_pk_fp8_f32(v0[2], v0[3], w0, true);
                    w1 = __builtin_amdgcn_cvt_pk_fp8_f32(v1[0], v1[1], w1, false); w1 = __builtin_amdgcn_cvt_pk_fp8_f32(v1[2], v1[3], w1, true);
                    *(u32x2*)(ys + (size_t)row * 1024 + col0 + bj * 128) = (u32x2){(unsigned)w0, (unsigned)w1}; } }
    }
};

namespace attn_body {
using bf16 = __hip_bfloat16;
constexpr int D = 64, QP = 512, KP = 128, OP = 1024, OCOL = 512;
constexpr int NW = 8, QBLK = 32, QB = QBLK * NW, KVBLK = 64;
__device__ __forceinline__ int crow(int r, int hi) { return (r & 3) + 8 * (r >> 2) + 4 * hi; }
#define SBAR() __builtin_amdgcn_sched_barrier(0)
__device__ __forceinline__ void cmask(f32x16& p0, f32x16& p1, int jb, int qrel, int hi) {
    const float NEG = -INFINITY; int kb = 64 * jb + 4 * hi;
#pragma unroll
    for (int r = 0; r < 16; ++r) { int kv = kb + (r & 3) + 8 * (r >> 2); if (kv > qrel) p0[r] = NEG; if (kv + 32 > qrel) p1[r] = NEG; }
}
constexpr int NSLOT = 3, SLOTB = 8192;
constexpr int LDS_K = 0, LDS_V = NSLOT * SLOTB, LDS_WS = 2 * NSLOT * SLOTB, LDS_OST = LDS_WS + NW * 64 * 4, LDS_QF = LDS_OST + NW * 4096, LDS_BYTES_A = LDS_QF + NW * 4096;
static_assert(LDS_BYTES_A <= 131072, "attention LDS");
__device__ __forceinline__ void glds16(const void* gsrc, unsigned lds_dst) { unsigned keep;
    asm volatile("s_mov_b32 %0, m0\n\ts_mov_b32 m0, %2\n\ts_nop 0\n\tglobal_load_lds_dwordx4 %1, off\n\ts_mov_b32 m0, %0" : "=&s"(keep) : "v"(gsrc), "s"(lds_dst) : "memory"); }
__device__ __forceinline__ float max3f(float a, float b, float c) { float r; asm("v_max3_f32 %0, %1, %2, %3" : "=v"(r) : "v"(a), "v"(b), "v"(c)); return r; }
__device__ __forceinline__ float max2f(float a, float b) { float r; asm("v_max_f32_e32 %0, %1, %2" : "=v"(r) : "v"(a), "v"(b)); return r; }
__device__ __forceinline__ float fadd_s(float a, float b) { float r; asm("v_add_f32_e32 %0, %1, %2" : "=v"(r) : "v"(a), "v"(b)); return r; }
__device__ __forceinline__ float fsub_s(float a, float b) { float r; asm("v_sub_f32_e32 %0, %1, %2" : "=v"(r) : "v"(a), "v"(b)); return r; }
__device__ __forceinline__ unsigned cvtpk_s(float lo, float hi) { return pkbf(lo, hi); }
__device__ __forceinline__ float msel(float x, float neg, unsigned long long m) { float r; asm("v_cndmask_b32_e64 %0, %1, %2, %3" : "=v"(r) : "v"(neg), "v"(x), "s"(m)); return r; }
#define WAIT_BAR(N) asm volatile("s_waitcnt vmcnt(" #N ") lgkmcnt(0)\n\ts_barrier" ::: "memory")

typedef __attribute__((address_space(3))) const char* lds_cptr;
__device__ __forceinline__ void qkt(f32x16& p0, f32x16& p1, const char* Kslot, lds_cptr qfp, const f32x16& negm, int r32, int hi) {
    const char* kb = Kslot + hi * 1024 + r32 * 16;
#pragma unroll
    for (int d0 = 0; d0 < 4; ++d0) {
        const bf16x8 b0 = *reinterpret_cast<const bf16x8*>(kb + d0 * 2048);
        const bf16x8 b1 = *reinterpret_cast<const bf16x8*>(kb + d0 * 2048 + 512);
        const bf16x8 qd = *(const LAS bf16x8*)(qfp + d0 * 1024);
        if (d0 == 0) { p0 = __builtin_amdgcn_mfma_f32_32x32x16_bf16(b0, qd, negm, 0, 0, 0); p1 = __builtin_amdgcn_mfma_f32_32x32x16_bf16(b1, qd, negm, 0, 0, 0); }
        else { p0 = __builtin_amdgcn_mfma_f32_32x32x16_bf16(b0, qd, p0, 0, 0, 0); p1 = __builtin_amdgcn_mfma_f32_32x32x16_bf16(b1, qd, p1, 0, 0, 0); } }
}
typedef short v4i16_t __attribute__((ext_vector_type(4)));
__device__ __forceinline__ void kload8(bf16x8* kf, lds_cptr kp) {
    kf[0] = *(const LAS bf16x8*)(kp);        kf[1] = *(const LAS bf16x8*)(kp + 512);
    kf[2] = *(const LAS bf16x8*)(kp + 2048); kf[3] = *(const LAS bf16x8*)(kp + 2560);
    kf[4] = *(const LAS bf16x8*)(kp + 4096); kf[5] = *(const LAS bf16x8*)(kp + 4608);
    kf[6] = *(const LAS bf16x8*)(kp + 6144); kf[7] = *(const LAS bf16x8*)(kp + 6656);
}
__device__ __forceinline__ void kload2(bf16x8* kf, lds_cptr kp, int j) { kf[2 * j] = *(const LAS bf16x8*)(kp + j * 2048); kf[2 * j + 1] = *(const LAS bf16x8*)(kp + j * 2048 + 512); }
__device__ __forceinline__ s16x4 vtr(lds_cptr p) { return __builtin_bit_cast(s16x4, __builtin_amdgcn_ds_read_tr16_b64_v4i16((LAS v4i16_t*)p)); }
__device__ __forceinline__ float rowmax(const f32x16& p0, const f32x16& p1) {
    float a = max3f(p0[0], p0[1], p1[0]), b = max3f(p0[2], p0[3], p1[1]); a = max3f(a, p1[2], p1[3]);
#pragma unroll
    for (int r = 4; r < 16; r += 4) { a = max3f(a, p0[r], p0[r + 1]); b = max3f(b, p0[r + 2], p0[r + 3]); a = max3f(a, p1[r], p1[r + 1]); b = max3f(b, p1[r + 2], p1[r + 3]); }
    const float m = max2f(a, b);
    auto rr = __builtin_amdgcn_permlane32_swap(__float_as_uint(m), __float_as_uint(m), false, false);
    return max2f(__uint_as_float(rr[0]), __uint_as_float(rr[1]));
}
__device__ __forceinline__ void pv(f32x16* o, int vb, bf16x8 pa0, bf16x8 pa1, bf16x8 pa2, bf16x8 pa3) {
#pragma unroll
    for (int d0 = 0; d0 < 2; ++d0) { s16x4 lo[4], hi[4];
#pragma unroll
        for (int ks = 0; ks < 4; ++ks) {
            asm volatile("ds_read_b64_tr_b16 %0,%1 offset:%c2" : "=&v"(lo[ks]) : "v"(vb), "i"(d0 * 4096 + ks * 1024) : "memory");
            asm volatile("ds_read_b64_tr_b16 %0,%1 offset:%c2" : "=&v"(hi[ks]) : "v"(vb), "i"(d0 * 4096 + ks * 1024 + 512) : "memory"); }
        asm volatile("s_waitcnt lgkmcnt(0)" ::: "memory"); SBAR();
#define PK(k) (bf16x8){lo[k][0], lo[k][1], lo[k][2], lo[k][3], hi[k][0], hi[k][1], hi[k][2], hi[k][3]}
        o[d0] = __builtin_amdgcn_mfma_f32_32x32x16_bf16(pa0, PK(0), o[d0], 0, 0, 0);
        o[d0] = __builtin_amdgcn_mfma_f32_32x32x16_bf16(pa1, PK(1), o[d0], 0, 0, 0);
        o[d0] = __builtin_amdgcn_mfma_f32_32x32x16_bf16(pa2, PK(2), o[d0], 0, 0, 0);
        o[d0] = __builtin_amdgcn_mfma_f32_32x32x16_bf16(pa3, PK(3), o[d0], 0, 0, 0);
#undef PK
    }
}
#define ATTN_STORE16(p, v) (*(u32x4*)(p) = (v))
template <int THRL> __device__ __forceinline__ void attn_unit(int b, int h, int qb, const bf16* Q, const bf16* __restrict__ K, const bf16* __restrict__ V, bf16* O, const unsigned* masks, char* shm) {
    const int tid = threadIdx.x, lane = tid & 63, r32 = lane & 31, hi = lane >> 5; const int wid = __builtin_amdgcn_readfirstlane(tid >> 6);
    const long rowbase = (long)b * SEQ; const int q0 = qb * QB;
    const bf16* Qw = Q + (rowbase + q0 + wid * QBLK) * QP + h * D;
    const bf16 *Kh = K + rowbase * KP + (h >> 2) * D, *Vh = V + rowbase * KP + (h >> 2) * D;
    const unsigned* mrow = masks + ((size_t)(b * (SEQ / 32) + (q0 >> 5) + wid) * (SEQ / 64)) * 64;
    const unsigned lds0 = (unsigned)(uintptr_t)shm;
    float* wsf = (float*)(shm + LDS_WS) + wid * 64;
    const bf16* ksrc = Kh + (long)lane * KP + wid * 8;
    const bf16* vsrc = Vh + (long)(16 * (wid & 3) + (lane >> 2)) * KP + (wid >> 2) * 32 + (lane & 3) * 8;
    const unsigned kdst = lds0 + LDS_K + wid * 1024, vdst = lds0 + LDS_V + wid * 1024;
#define DMA_K(t, slot) glds16(ksrc + (long)(t) * KVBLK * KP, (unsigned)__builtin_amdgcn_readfirstlane(kdst + (slot)))
#define DMA_V(t, slot) glds16(vsrc + (long)(t) * KVBLK * KP, (unsigned)__builtin_amdgcn_readfirstlane(vdst + (slot)))
    const int vb0 = (int)(lds0 + LDS_V) + ((lane >> 4) & 1) * 32 + (lane & 3) * 8 + (4 * hi + ((lane & 15) >> 2)) * 64;
    const char* Kbase = shm + LDS_K; bf16x8 kf[8];
    const lds_cptr shm3 = (lds_cptr)shm; const lds_cptr kp0 = shm3 + LDS_K + hi * 1024 + r32 * 16; const lds_cptr vp0 = shm3 + LDS_V + ((lane >> 4) & 1) * 32 + (lane & 3) * 8 + (4 * hi + ((lane & 15) >> 2)) * 64;
    const int NT = (q0 + QB) / KVBLK;
    u32x16 mA, mB;
#define MLOAD0(t) do { const unsigned* mp_ = mrow + (size_t)(t) * 64; \
        asm volatile("s_load_dwordx16 %0, %1, 0x0" : "=s"(mA) : "s"(mp_)); asm volatile("s_load_dwordx16 %0, %1, 0x40" : "=s"(mB) : "s"(mp_)); } while (0)
#define MLOAD1(t) do { const unsigned* mp_ = mrow + (size_t)(t) * 64; \
        asm volatile("s_load_dwordx16 %0, %1, 0x80" : "=s"(mA) : "s"(mp_)); asm volatile("s_load_dwordx16 %0, %1, 0xc0" : "=s"(mB) : "s"(mp_)); } while (0)
#define MPAIR(M, j) (((unsigned long long)(M)[2 * (j) + 1] << 32) | (unsigned long long)(M)[2 * (j)])
#define MAPPLY(P) do { asm volatile("s_waitcnt lgkmcnt(0)" : "+s"(mA), "+s"(mB)); const float NEG_ = -INFINITY; \
        _Pragma("unroll") for (int r = 0; r < 8; ++r) { P[r] = msel(P[r], NEG_, MPAIR(mA, r)); P[r + 8] = msel(P[r + 8], NEG_, MPAIR(mB, r)); } } while (0)
    DMA_K(0, 0); DMA_V(0, 0); DMA_K(1, SLOTB);
    MLOAD0(0);
    const lds_cptr qfp = shm3 + LDS_QF + wid * 4096 + lane * 16;
    { bf16x8 qr[4];
#pragma unroll
      for (int d0 = 0; d0 < 4; ++d0) qr[d0] = *reinterpret_cast<const bf16x8*>(&Qw[(long)r32 * QP + d0 * 16 + hi * 8]);
#pragma unroll
      for (int d0 = 0; d0 < 4; ++d0) *(LAS bf16x8*)(LAS char*)(qfp + d0 * 1024) = qr[d0]; }
#define QF(i) (*(const LAS bf16x8*)(qfp + (i) * 1024))
    float mhat = 0.f, l_reg = 0.f; f32x16 o[2]; o[0] = f32x16{}; o[1] = f32x16{}; f32x16 negm = f32x16{}; asm volatile("" : "+v"(negm));
    const int qrel = wid * QBLK + r32;
#define CMASK(P0, P1, t) do { int jb_ = (t) - (NT - 4); if (jb_ >= 0) cmask(P0, P1, jb_, qrel, hi); } while (0)
    bool resc = false;
#define START(P0, P1) do { const float rm = rowmax(P0, P1); resc = false; \
    { const float dl = rm; mhat = fadd_s(mhat, dl); \
      _Pragma("unroll") for (int r = 0; r < 16; ++r) { P0[r] = fsub_s(P0[r], dl); P1[r] = fsub_s(P1[r], dl); } \
      _Pragma("unroll") for (int r = 0; r < 16; ++r) negm[r] = -mhat; asm volatile("" : "+v"(negm)); } } while (0)
#define RESC() do { if (resc) { asm volatile("s_waitcnt lgkmcnt(0)" ::: "memory"); \
      _Pragma("unroll") for (int d_ = 0; d_ < 2; ++d_) _Pragma("unroll") for (int r = 0; r < 16; ++r) o[d_][r] *= wsf[crow(r, hi)]; } } while (0)
    f32x16 pA0, pA1, pB0, pB1;
    int sl_prev = 0, sl_cur = 0, sl_next = SLOTB;
#define ROT() do { sl_prev = sl_cur; sl_cur = sl_next; sl_next = (sl_next == (NSLOT - 1) * SLOTB) ? 0 : sl_next + SLOTB; } while (0)
    DMA_K(2, 2 * SLOTB);
    WAIT_BAR(3);
    qkt(pA0, pA1, Kbase, qfp, negm, r32, hi); asm volatile("s_nop 15\n\ts_nop 7" : "+v"(pA0), "+v"(pA1)); CMASK(pA0, pA1, 0);
    START(pA0, pA1);
    MAPPLY(pA0); MLOAD1(0); MAPPLY(pA1); MLOAD0(1);
    _Pragma("unroll") for (int r = 0; r < 16; ++r) { pA0[r] = __builtin_amdgcn_exp2f(pA0[r]); pA1[r] = __builtin_amdgcn_exp2f(pA1[r]); }
    WAIT_BAR(0);
    DMA_K(3, 0); DMA_V(1, SLOTB);
    ROT();
    kload8(kf, kp0 + sl_cur);
    WAIT_BAR(2);
    s16x4 vlo[8], vhi[8]; u32x4 pw0, pw1, pw2, pw3;
#define PKW(P, B) cvtpk_s(P[B], P[B + 1])
#define PAF(k) __builtin_bit_cast(bf16x8, pw##k)
#define VFR(i) (bf16x8){vlo[i][0], vlo[i][1], vlo[i][2], vlo[i][3], vhi[i][0], vhi[i][1], vhi[i][2], vhi[i][3]}
#define PIN(x) asm volatile("" : "+v"(x))
#define MX3(a, b, c) __builtin_fmaxf(__builtin_fmaxf((a), (b)), (c))
#define GAPA(MF, A0, A1, A2, A3, W0, W1, PW) do { MF; sacc += A0; sacc += A1; sacc += A2; sacc += A3; PIN(sacc); W0; W1; PIN(PW); SBAR(); } while (0)
#define EX(v) __builtin_amdgcn_exp2f(v)
#define GAPB(MF, X, B) do { MF; X[B] = EX(X[B]); X[B + 1] = EX(X[B + 1]); X[B + 2] = EX(X[B + 2]); X[B + 3] = EX(X[B + 3]); PIN(X); SBAR(); } while (0)
#define VRD(i) do { vlo[i] = vtr(vp_ + (((i) >> 2) * 4096 + ((i) & 3) * 1024)); vhi[i] = vtr(vp_ + (((i) >> 2) * 4096 + ((i) & 3) * 1024 + 512)); } while (0)
#define KRD(G, j) do { if (G) { kload2(kf, kp0 + sl_next, j); SBAR(); } } while (0)
#define STEP(C0, C1, P0, P1, t, GK, GV, GL, GM) do { SBAR(); \
    const lds_cptr vp_ = vp0 + sl_prev; \
    VRD(0); bf16x8 qa_ = QF(0), qb_ = QF(1); SBAR(); float sacc = (P0[0] + P0[1]); \
    GAPA(C0 = __builtin_amdgcn_mfma_f32_32x32x16_bf16(kf[0], qa_, negm, 0, 0, 0), P0[2], P0[3], P0[4], P0[5],     pw0[0] = PKW(P0, 0), pw0[1] = PKW(P0, 2), pw0); \
    VRD(4); SBAR(); GAPA(C1 = __builtin_amdgcn_mfma_f32_32x32x16_bf16(kf[1], qa_, negm, 0, 0, 0), P0[6], P0[7], P0[8], P0[9],     pw0[2] = PKW(P0, 4), pw0[3] = PKW(P0, 6), pw0); \
    VRD(1); qa_ = QF(2); SBAR(); GAPA(C0 = __builtin_amdgcn_mfma_f32_32x32x16_bf16(kf[2], qb_, C0, 0, 0, 0),   P0[10], P0[11], P0[12], P0[13], pw1[0] = PKW(P0, 8), pw1[1] = PKW(P0, 10), pw1); \
    VRD(5); SBAR(); GAPA(C1 = __builtin_amdgcn_mfma_f32_32x32x16_bf16(kf[3], qb_, C1, 0, 0, 0),   P0[14], P0[15], P1[0], P1[1],   pw1[2] = PKW(P0, 12), pw1[3] = PKW(P0, 14), pw1); \
    VRD(2); qb_ = QF(3); SBAR(); GAPA(C0 = __builtin_amdgcn_mfma_f32_32x32x16_bf16(kf[4], qa_, C0, 0, 0, 0),   P1[2], P1[3], P1[4], P1[5],     pw2[0] = PKW(P1, 0), pw2[1] = PKW(P1, 2), pw2); \
    VRD(6); SBAR(); GAPA(C1 = __builtin_amdgcn_mfma_f32_32x32x16_bf16(kf[5], qa_, C1, 0, 0, 0),   P1[6], P1[7], P1[8], P1[9],     pw2[2] = PKW(P1, 4), pw2[3] = PKW(P1, 6), pw2); \
    VRD(3); SBAR(); GAPA(C0 = __builtin_amdgcn_mfma_f32_32x32x16_bf16(kf[6], qb_, C0, 0, 0, 0),   P1[10], P1[11], P1[12], P1[13], pw3[0] = PKW(P1, 8), pw3[1] = PKW(P1, 10), pw3); \
    VRD(7); SBAR(); GAPA(C1 = __builtin_amdgcn_mfma_f32_32x32x16_bf16(kf[7], qb_, C1, 0, 0, 0),   P1[14], P1[15], 0.f, 0.f,       pw3[2] = PKW(P1, 12), pw3[3] = PKW(P1, 14), pw3); \
    l_reg += sacc; \
    if (GK) { DMA_K((t) + 3, sl_cur); } if (GV) { DMA_V((t) + 1, sl_next); } \
    CMASK(C0, C1, t); \
    { float a = MX3(C0[0], C0[1], C1[0]), b = MX3(C0[2], C0[3], C1[1]); a = MX3(a, C1[2], C1[3]); \
      _Pragma("unroll") for (int r = 4; r < 16; r += 4) { a = MX3(a, C0[r], C0[r + 1]); b = MX3(b, C0[r + 2], C0[r + 3]); a = MX3(a, C1[r], C1[r + 1]); b = MX3(b, C1[r + 2], C1[r + 3]); } \
      float rm = __builtin_fmaxf(a, b); { auto rr = __builtin_amdgcn_permlane32_swap(__float_as_uint(rm), __float_as_uint(rm), false, false); rm = __builtin_fmaxf(__uint_as_float(rr[0]), __uint_as_float(rr[1])); } \
      resc = false; \
      if (__builtin_expect(__any(rm > (float)THRL), 0)) { const float dl = __builtin_fmaxf(rm, 0.f); mhat += dl; \
        _Pragma("unroll") for (int r = 0; r < 16; ++r) { C0[r] -= dl; C1[r] -= dl; } \
        _Pragma("unroll") for (int r = 0; r < 16; ++r) negm[r] = -mhat; asm volatile("" : "+v"(negm)); \
        const float f = __builtin_amdgcn_exp2f(-dl); l_reg *= f; if (hi == 0) wsf[r32] = f; resc = true; } } \
    MAPPLY(C0); MLOAD1(t); \
    SBAR(); \
    GAPB(o[0] = __builtin_amdgcn_mfma_f32_32x32x16_bf16(PAF(0), VFR(0), o[0], 0, 0, 0), C0, 0); \
    GAPB(o[1] = __builtin_amdgcn_mfma_f32_32x32x16_bf16(PAF(0), VFR(4), o[1], 0, 0, 0), C0, 4); \
    KRD(GL, 0); GAPB(o[0] = __builtin_amdgcn_mfma_f32_32x32x16_bf16(PAF(1), VFR(1), o[0], 0, 0, 0), C0, 8); \
    KRD(GL, 1); GAPB(o[1] = __builtin_amdgcn_mfma_f32_32x32x16_bf16(PAF(1), VFR(5), o[1], 0, 0, 0), C0, 12); \
    MAPPLY(C1); if (GM) { MLOAD0((t) + 1); } SBAR(); \
    KRD(GL, 2); GAPB(o[0] = __builtin_amdgcn_mfma_f32_32x32x16_bf16(PAF(2), VFR(2), o[0], 0, 0, 0), C1, 0); \
    KRD(GL, 3); GAPB(o[1] = __builtin_amdgcn_mfma_f32_32x32x16_bf16(PAF(2), VFR(6), o[1], 0, 0, 0), C1, 4); \
    GAPB(o[0] = __builtin_amdgcn_mfma_f32_32x32x16_bf16(PAF(3), VFR(3), o[0], 0, 0, 0), C1, 8); \
    GAPB(o[1] = __builtin_amdgcn_mfma_f32_32x32x16_bf16(PAF(3), VFR(7), o[1], 0, 0, 0), C1, 12); \
    } while (0)
    int t = 1;
#undef CMASK
#define CMASK(P0, P1, t) do { } while (0)
    for (; t + 5 < NT; t += 2) {
        STEP(pB0, pB1, pA0, pA1, t, true, true, true, true);     WAIT_BAR(2); RESC(); ROT();
        STEP(pA0, pA1, pB0, pB1, t + 1, true, true, true, true); WAIT_BAR(2); RESC(); ROT();
    }
#undef CMASK
#define CMASK(P0, P1, t) do { int jb_ = (t) - (NT - 4); if (jb_ >= 0) cmask(P0, P1, jb_, qrel, hi); } while (0)
#define ENDW(tt) do { if ((tt) + 3 < NT) { WAIT_BAR(2); } else if ((tt) + 2 < NT) { WAIT_BAR(1); } else { WAIT_BAR(0); } } while (0)
    for (; t + 1 < NT; t += 2) {
        STEP(pB0, pB1, pA0, pA1, t, (t + 3 < NT), (t + 1 < NT), (t + 1 < NT), (t + 1 < NT));         ENDW(t);     RESC(); ROT();
        STEP(pA0, pA1, pB0, pB1, t + 1, (t + 4 < NT), (t + 2 < NT), (t + 2 < NT), (t + 2 < NT));     ENDW(t + 1); RESC(); ROT();
    }
    STEP(pB0, pB1, pA0, pA1, NT - 1, false, false, false, false); RESC();
    { float sacc = pB0[0] + pB0[1]; _Pragma("unroll") for (int r = 2; r < 16; ++r) sacc += pB0[r]; _Pragma("unroll") for (int r = 0; r < 16; ++r) sacc += pB1[r]; l_reg += sacc;
      pw0 = (u32x4){PKW(pB0, 0), PKW(pB0, 2), PKW(pB0, 4), PKW(pB0, 6)}; pw1 = (u32x4){PKW(pB0, 8), PKW(pB0, 10), PKW(pB0, 12), PKW(pB0, 14)}; pw2 = (u32x4){PKW(pB1, 0), PKW(pB1, 2), PKW(pB1, 4), PKW(pB1, 6)}; pw3 = (u32x4){PKW(pB1, 8), PKW(pB1, 10), PKW(pB1, 12), PKW(pB1, 14)};
      SBAR(); pv(o, vb0 + sl_cur, PAF(0), PAF(1), PAF(2), PAF(3)); }
#undef PKW
#undef PAF
#undef VFR
#undef PIN
#undef MX3
#undef GAPA
#undef GAPB
#undef EX
#undef VRD
#undef KRD
#undef STEP
#undef ENDW
    { auto rr = __builtin_amdgcn_permlane32_swap(__float_as_uint(l_reg), __float_as_uint(l_reg), false, false); l_reg = __uint_as_float(rr[0]) + __uint_as_float(rr[1]); }
    if (hi == 0) wsf[32 + r32] = l_reg; asm volatile("s_waitcnt lgkmcnt(0)" ::: "memory");
    float rli[16];
#pragma unroll
    for (int r = 0; r < 16; ++r) rli[r] = __builtin_amdgcn_rcpf(wsf[32 + crow(r, hi)]);
    bf16* Ow = O + (rowbase + q0 + wid * QBLK) * OP + OCOL + h * D;
    { bf16* stg = (bf16*)(shm + LDS_OST) + wid * 2048;
#pragma unroll
      for (int r = 0; r < 16; ++r) { const int orow = crow(r, hi);
#pragma unroll
        for (int d0 = 0; d0 < 2; ++d0) stg[orow * 64 + d0 * 32 + r32] = __float2bfloat16(o[d0][r] * rli[r]); }
      asm volatile("s_waitcnt lgkmcnt(0)" ::: "memory");
#pragma unroll
      for (int i = 0; i < 4; ++i) { const int row = i * 8 + (lane >> 3), ch = lane & 7; const u32x4 v = *(const u32x4*)(stg + row * 64 + ch * 8); ATTN_STORE16(Ow + (long)row * OP + ch * 8, v); } }
    asm volatile("s_waitcnt lgkmcnt(0)\n\ts_barrier" ::: "memory");
#undef DMA_K
#undef DMA_V
#undef CMASK
#undef START
#undef RESC
#undef ROT
#undef MLOAD0
#undef MLOAD1
#undef MPAIR
#undef QF
#undef MAPPLY
}
#undef SBAR
#undef WAIT_BAR
}

#define XB_TMO      128
#define XB_XCNT(j)  (256  + 64 * (j))
#define XB_XSUB(j)  (1280 + 64 * (j))
#define XB_XGEN(j)  (2304 + 64 * (j))
#define XB_TOP      3328
#define XB_TOPGEN   3392
#define XCD_BAR_WORDS 3456
#define XB_SPIN_CAP (1u << 18)
__device__ __forceinline__ unsigned xb_ld(unsigned* p)              { return __hip_atomic_load(p, __ATOMIC_RELAXED, __HIP_MEMORY_SCOPE_AGENT); }
__device__ __forceinline__ unsigned xb_add(unsigned* p, unsigned v) { return __hip_atomic_fetch_add(p, v, __ATOMIC_RELAXED, __HIP_MEMORY_SCOPE_AGENT); }
__device__ __forceinline__ unsigned xb_xcc_id() { return (unsigned)__builtin_amdgcn_s_getreg((3 << 11) | 20) & 0xFu; }
#define XB_SPIN(cond, bar) do { unsigned _sp = 0; while (cond) { __builtin_amdgcn_s_sleep(1); \
    if ((++_sp & 255u) == 0u) { if (xb_ld(&(bar)[XB_TMO])) break; if (_sp > XB_SPIN_CAP) { atomicAdd(&(bar)[XB_TMO], 1u); break; } } } } while (0)
struct XcdBarrier { unsigned* bar; unsigned x; volatile LAS unsigned* st; };
__device__ __forceinline__ XcdBarrier xcd_barrier_post(unsigned* bar, volatile LAS unsigned* st) {
    XcdBarrier b; b.bar = bar; b.x = xb_xcc_id(); b.st = st;
    if (threadIdx.x == 0) (void)xb_add(&bar[XB_XCNT(b.x)], 1u);
    return b;
}
__device__ __forceinline__ void xcd_barrier_complete(unsigned* bar, unsigned x, unsigned& nloc, unsigned& nx) {
    const unsigned G = gridDim.x * gridDim.y * gridDim.z;
    unsigned sum, cnt, mine, sp = 0u;
    for (;;) {
        sum = 0u; cnt = 0u; mine = 0u;
#pragma unroll
        for (unsigned j = 0; j < 16; ++j) { const unsigned c = xb_ld(&bar[XB_XCNT(j)]); sum += c; cnt += (c > 0u) ? 1u : 0u; mine = (j == x) ? c : mine; }
        if (sum == G) break;
        __builtin_amdgcn_s_sleep(1);
        if ((++sp & 255u) == 0u) { if (xb_ld(&bar[XB_TMO])) break; if (sp > XB_SPIN_CAP) { atomicAdd(&bar[XB_TMO], 1u); break; } }
    }
    nloc = mine > 0u ? mine : 1u; nx = cnt > 0u ? cnt : 1u;
}
__device__ __forceinline__ void xcd_barrier(const XcdBarrier& b) {
    asm volatile("s_waitcnt vmcnt(0)" ::: "memory");
    __syncthreads();
    if (threadIdx.x == 0) {
        unsigned* bar = b.bar;
        __builtin_amdgcn_s_waitcnt(0);
        unsigned nloc = b.st[0], nx = b.st[1];
        if (nloc == 0u) { xcd_barrier_complete(bar, b.x, nloc, nx); b.st[0] = nloc; b.st[1] = nx; }
        const unsigned old = xb_add(&bar[XB_XSUB(b.x)], 1u);
        const unsigned gen = old / nloc;
        if (old + 1u == (gen + 1u) * nloc) {
            __builtin_amdgcn_fence(__ATOMIC_RELEASE, "agent");
            asm volatile("s_waitcnt vmcnt(0)" ::: "memory");
            const unsigned og = xb_add(&bar[XB_TOP], 1u);
            const unsigned tg = og / nx;
            if (og + 1u == (tg + 1u) * nx) xb_add(&bar[XB_TOPGEN], 1u);
            else XB_SPIN(xb_ld(&bar[XB_TOPGEN]) == tg, bar);
            __builtin_amdgcn_fence(__ATOMIC_ACQUIRE, "agent");
            xb_add(&bar[XB_XGEN(b.x)], 1u);
            asm volatile("s_waitcnt vmcnt(0)" ::: "memory");
        } else {
            XB_SPIN(xb_ld(&bar[XB_XGEN(b.x)]) == gen, bar);
            __builtin_amdgcn_fence(__ATOMIC_ACQUIRE, "agent");
            asm volatile("s_waitcnt vmcnt(0)" ::: "memory");
        }
    }
    __syncthreads();
}

struct Frame {
    LAS unsigned char* lds; volatile LAS unsigned* MISC; unsigned* ctl;
    int tid, lane, wave, vcu, G;
    unsigned char* ws;
};
struct Args { const float* in[18]; float* out; unsigned char* ws; int ph_lo, ph_hi, flags, pad; };
typedef const __attribute__((address_space(4))) Args* KArgs;
__device__ __forceinline__ KArgs kargs() { KArgs p = (KArgs)__builtin_amdgcn_kernarg_segment_ptr(); asm volatile("" : "+s"(p)); return p; }

__device__ __forceinline__ int ropeperm(int d) { return d < 8 ? 2 * d : (d < 16 ? 2 * (d - 8) + 1 : d); }
__device__ __forceinline__ int win_row(int c) {
    if (c < 512)  return (c & ~63) + ropeperm(c & 63);
    if (c < 640)  { const int cc = c - 512; return 512 + (cc & ~63) + ropeperm(cc & 63); }
    if (c < 768)  return c;
    if (c < 1280) { const int cc = c - 768; return 768 + (cc & ~63) + ropeperm(cc & 63); }
    if (c < 1344) return 1280 + ropeperm(c - 1280);
    if (c < 1352) return c;
    if (c < 1864) { const int ch = c - 1352; return 1536 + (ch >> 7) * 256 + (ch & 127); }
    if (c < 2376) return 2560 + (c - 1864);
    if (c < 2888) { const int ch = c - 2376; return 1536 + (ch >> 7) * 256 + 128 + (ch & 127); }
    { const int g = c - 2888, gi = g & 1023; return 3072 + (gi >> 7) * 256 + (g >> 10) * 128 + (gi & 127); }
}
struct TItem { const float* src; bf16_t* WT; int N, KT, rbase, mode, n0, k0, kd; };
__device__ __forceinline__ void t_load(const TItem& t, float (&rg)[32], int lane) {
    int nn = t.n0 + (lane & 31); if (nn >= t.N) nn = t.N - 1;
    const float* p = t.src + (size_t)(t.k0 + (lane >> 5)) * t.N + nn;
#pragma unroll
    for (int i = 0; i < 32; ++i) rg[i] = __builtin_nontemporal_load(p + (size_t)(2 * i) * t.N);
}
__device__ __forceinline__ void t_write(const TItem& t, const float (&rg)[32], LAS float* scr, int lane) {
#pragma unroll
    for (int i = 0; i < 32; ++i) scr[(2 * i + (lane >> 5)) * 33 + (lane & 31)] = rg[i];
    LDS_WAIT(); asm volatile("" ::: "memory");
    if (t.mode >= 3) {
        const int c4 = lane & 3;
#pragma unroll
        for (int j = 0; j < 2; ++j) { const int n = (lane >> 2) + 16 * j; const LAS float* sp = scr + (16 * c4) * 33 + n;
            if (t.n0 + n < t.N) { const int nn = t.n0 + n; const int row = t.mode == 3 ? t.rbase + (nn >> 7) * 256 + (nn & 127) : t.rbase + nn;
                u32x4 o;
#pragma unroll
                for (int q = 0; q < 4; ++q) { int wv = 0;
                    wv = __builtin_amdgcn_cvt_pk_fp8_f32(32.f * sp[(4 * q + 0) * 33], 32.f * sp[(4 * q + 1) * 33], wv, false);
                    wv = __builtin_amdgcn_cvt_pk_fp8_f32(32.f * sp[(4 * q + 2) * 33], 32.f * sp[(4 * q + 3) * 33], wv, true); o[q] = (unsigned)wv; }
                *(u32x4*)((unsigned char*)t.WT + (size_t)row * t.KT + t.k0 + 16 * c4) = o; } }
        LDS_WAIT(); asm volatile("" ::: "memory");
        return;
    }
    const int c = lane & 7;
#pragma unroll
    for (int j = 0; j < 4; ++j) { const int n = (lane >> 3) + 8 * j; const LAS float* sp = scr + (8 * c) * 33 + n;
        if (t.n0 + n < t.N) { const int nn = t.n0 + n; const int row = t.mode == 0 ? t.rbase + nn : (t.mode == 1 ? win_row(nn) : t.rbase + (nn >> 7) * 256 + (nn & 127));
            u32x4 o; o.x = pkbf(sp[0 * 33], sp[1 * 33]); o.y = pkbf(sp[2 * 33], sp[3 * 33]); o.z = pkbf(sp[4 * 33], sp[5 * 33]); o.w = pkbf(sp[6 * 33], sp[7 * 33]);
            *(u32x4*)(t.WT + (size_t)row * t.KT + t.kd + t.k0 + 8 * c) = o; } }
    LDS_WAIT(); asm volatile("" ::: "memory");
}
__device__ __forceinline__ void p0_prologue(Frame& F) {
    const KArgs ka = kargs();
    unsigned char* ws = F.ws;
    LAS float* scr = (LAS float*)(F.lds + F.wave * 16384);
    const int gw = F.vcu * NWAVES + F.wave, NGW = F.G * NWAVES;
    const int gt = F.vcu * 512 + F.tid, NGT = F.G * 512;
    bf16_t* Win = (bf16_t*)(ws + WS_WIN); bf16_t* Wau = (bf16_t*)(ws + WS_WAU); bf16_t* Wout = (bf16_t*)(ws + WS_WOUT);
    bf16_t* Wd = (bf16_t*)(ws + WS_WD); bf16_t* Wgu = (bf16_t*)(ws + WS_WGU);
    constexpr int I_IN = 16 * 155, I_AU = 8 * 32, I_OUT = 16 * 32, I_G = 32 * 16 * 16, I_D = 32 * 8 * 32;
    constexpr int NITEMS = I_IN + 2 * I_AU + I_OUT + 2 * I_G + I_D;
    const float *p_win = ka->in[1], *p_wau = ka->in[3], *p_wcu = ka->in[4], *p_wout = ka->in[6], *p_wg = ka->in[13], *p_wu = ka->in[14], *p_wd = ka->in[15];
#define T_DECODE(IT, T) do { int r_ = (IT); \
        if (r_ < I_IN) { T = TItem{p_win, Win, INW, 1024, 0, 1, 32 * (r_ % 155), 64 * (r_ / 155), 0}; } else { r_ -= I_IN; \
        if (r_ < I_AU) { T = TItem{p_wau, Wau, 1024, 1024, 0, 0, 32 * (r_ % 32), 64 * (r_ / 32), 512};     } else { r_ -= I_AU; \
        if (r_ < I_AU) { T = TItem{p_wcu, Wau, 1024, 1024, 0, 0, 32 * (r_ % 32), 64 * (r_ / 32), 0}; } else { r_ -= I_AU; \
        if (r_ < I_OUT) { T = TItem{p_wout, Wout, 1024, 1024, 0, 0, 32 * (r_ % 32), 64 * (r_ / 32), 0}; } else { r_ -= I_OUT; \
        if (r_ < I_G) { const int e_ = r_ >> 8, q_ = r_ & 255; T = TItem{p_wg + (size_t)e_ * 1024 * 512, Wgu, 512, 1024, e_ * 1024, 3, 32 * (q_ & 15), 64 * (q_ >> 4), 0}; } else { r_ -= I_G; \
        if (r_ < I_G) { const int e_ = r_ >> 8, q_ = r_ & 255; T = TItem{p_wu + (size_t)e_ * 1024 * 512, Wgu, 512, 1024, e_ * 1024 + 128, 3, 32 * (q_ & 15), 64 * (q_ >> 4), 0}; } else { r_ -= I_G; \
        { const int e_ = r_ >> 8, q_ = r_ & 255; T = TItem{p_wd + (size_t)e_ * 512 * 1024, Wd, 1024, 512, e_ * 1024, 4, 32 * (q_ & 31), 64 * (q_ >> 5), 0}; } } } } } } } } while (0)
    const int nitems = (F.G == 256) ? I_IN + 2 * I_AU + I_OUT : NITEMS;
    if (gw < nitems) {
        TItem cur, nxt; float rc[32], rn[32];
        T_DECODE(gw, cur); t_load(cur, rc, F.lane);
        for (int it = gw; it < nitems; it += NGW) {
            const int itn = (it + NGW < nitems) ? it + NGW : it;
            T_DECODE(itn, nxt); t_load(nxt, rn, F.lane);
            t_write(cur, rc, scr, F.lane);
            cur = nxt;
#pragma unroll
            for (int i = 0; i < 32; ++i) rc[i] = rn[i];
        }
    }
#undef T_DECODE
    for (int i = gt; i < 184 * 128; i += NGT) *(u32x4*)(Win + (size_t)1352 * 1024 + (size_t)i * 8) = (u32x4){0u, 0u, 0u, 0u};
    float* rope = (float*)(ws + WS_ROPE);
    for (int i = gt; i < SEQ * 8; i += NGT) { const int pos = i >> 3, j = i & 7;
        const float inv = (float)pow(500000.0, -(double)j / 8.0); const float ang = (float)pos * inv;
        rope[i] = cosf(ang); rope[SEQ * 8 + i] = sinf(ang); }
    { float* wc = (float*)(ws + WS_WC); const float* rgw = ka->in[9]; const float* rew = ka->in[11];
      for (int i = gt; i < 1024 * 48; i += NGT) { const int k = i / 48, c = i % 48;
          wc[i] = c < 4 ? rgw[k * 4 + c] : (c < 36 ? rew[(size_t)((c - 4) >> 3) * 1024 * 8 + k * 8 + ((c - 4) & 7)] : 0.f); } }
    const float* x = ka->in[0]; bf16_t* xb = (bf16_t*)(ws + WS_XB);
    for (size_t i = gt; i < (size_t)NTOK * DM / 8; i += (size_t)NGT * 4) {
        f32x4 va[4], vb[4];
#pragma unroll
        for (int q = 0; q < 4; ++q) { size_t ii = i + (size_t)q * NGT; if (ii >= (size_t)NTOK * DM / 8) ii = i; va[q] = __builtin_nontemporal_load((const f32x4*)(x + ii * 8)); vb[q] = __builtin_nontemporal_load((const f32x4*)(x + ii * 8 + 4)); }
#pragma unroll
        for (int q = 0; q < 4; ++q) { const size_t ii = i + (size_t)q * NGT; if (ii < (size_t)NTOK * DM / 8) store8bf(xb + ii * 8, va[q], vb[q]); } }
}

__device__ __forceinline__ int dpp_sum_i(int v) {
    v += __builtin_amdgcn_update_dpp(0, v, 0x111, 0xf, 0xf, true); v += __builtin_amdgcn_update_dpp(0, v, 0x112, 0xf, 0xf, true);
    v += __builtin_amdgcn_update_dpp(0, v, 0x114, 0xf, 0xf, true); v += __builtin_amdgcn_update_dpp(0, v, 0x118, 0xf, 0xf, true);
    return __builtin_amdgcn_readlane(v, 15) + __builtin_amdgcn_readlane(v, 31) + __builtin_amdgcn_readlane(v, 47) + __builtin_amdgcn_readlane(v, 63);
}
__device__ __forceinline__ float dpp_shr_f(float v, int ctrl_sel) {
    const int vi = __float_as_int(v);
    return __int_as_float(ctrl_sel == 1 ? __builtin_amdgcn_update_dpp(vi, vi, 0x111, 0xf, 0xf, false) : ctrl_sel == 2 ? __builtin_amdgcn_update_dpp(vi, vi, 0x112, 0xf, 0xf, false)
                        : ctrl_sel == 4 ? __builtin_amdgcn_update_dpp(vi, vi, 0x114, 0xf, 0xf, false) : __builtin_amdgcn_update_dpp(vi, vi, 0x118, 0xf, 0xf, false));
}
__device__ __forceinline__ float dpp_max_f(float v) {
    v = fmaxf(v, dpp_shr_f(v, 1)); v = fmaxf(v, dpp_shr_f(v, 2)); v = fmaxf(v, dpp_shr_f(v, 4)); v = fmaxf(v, dpp_shr_f(v, 8));
    const float a = __int_as_float(__builtin_amdgcn_readlane(__float_as_int(v), 15)), b = __int_as_float(__builtin_amdgcn_readlane(__float_as_int(v), 31));
    const float c = __int_as_float(__builtin_amdgcn_readlane(__float_as_int(v), 47)), d = __int_as_float(__builtin_amdgcn_readlane(__float_as_int(v), 63));
    return fmaxf(fmaxf(a, b), fmaxf(c, d));
}
__device__ __forceinline__ float dpp_min_f(float v) { return -dpp_max_f(-v); }
__device__ __forceinline__ float dpp_sum_f(float v) {
    v += __int_as_float(__builtin_amdgcn_update_dpp(0, __float_as_int(v), 0x111, 0xf, 0xf, true)); v += __int_as_float(__builtin_amdgcn_update_dpp(0, __float_as_int(v), 0x112, 0xf, 0xf, true));
    v += __int_as_float(__builtin_amdgcn_update_dpp(0, __float_as_int(v), 0x114, 0xf, 0xf, true)); v += __int_as_float(__builtin_amdgcn_update_dpp(0, __float_as_int(v), 0x118, 0xf, 0xf, true));
    const float a = __int_as_float(__builtin_amdgcn_readlane(__float_as_int(v), 15)), b = __int_as_float(__builtin_amdgcn_readlane(__float_as_int(v), 31));
    const float c = __int_as_float(__builtin_amdgcn_readlane(__float_as_int(v), 47)), d = __int_as_float(__builtin_amdgcn_readlane(__float_as_int(v), 63));
    return (a + b) + (c + d);
}
template <int NC>
__device__ __forceinline__ void select_token(const LAS float* srow, int t, int lane, unsigned tbit, LAS unsigned* maskw) {
    if (t < 256) {
#pragma unroll
        for (int c = 0; c < (NC < 4 ? NC : 4); ++c) if (64 * c + lane <= t) (void)__hip_atomic_fetch_or(maskw + 64 * c + lane, tbit, __ATOMIC_RELAXED, __HIP_MEMORY_SCOPE_WORKGROUP);
        return;
    }
    float x[NC];
#pragma unroll
    for (int c = 0; c < NC; ++c) x[c] = srow[64 * c + lane];
#pragma unroll
    for (int c = 4; c < NC; ++c) if (64 * c + 63 > t) x[c] = (64 * c + lane <= t) ? x[c] : -INFINITY;
    float mn = fminf(fminf(x[0], x[1]), fminf(x[2], x[3])), mx = -INFINITY;
#pragma unroll
    for (int c = 0; c < NC; ++c) mx = fmaxf(mx, x[c]);
    mn = dpp_min_f(mn);
    float lo = mn - (fabsf(mn) * 1e-6f + 1e-30f), hi = dpp_max_f(mx);
    const float BIGF = 0x1p100f;
#define COUNT_GT(P, OUT) do { const float nb1_ = -(P) * BIGF; const f32x2 nb_ = {nb1_, nb1_}, bg_ = {BIGF, BIGF}; f32x2 a0_ = {0.f, 0.f}, a1_ = {0.f, 0.f}, a2_ = {0.f, 0.f}, a3_ = {0.f, 0.f}; \
        _Pragma("unroll") for (int c = 0; c < NC; c += 8) { f32x2 y_[4]; \
            _Pragma("unroll") for (int e = 0; e < 4; ++e) { const f32x2 xx_ = {x[c + 2 * e], x[c + 2 * e + 1]}; asm("v_pk_fma_f32 %0, %1, %2, %3 clamp" : "=v"(y_[e]) : "v"(xx_), "v"(bg_), "v"(nb_)); } \
            a0_ += y_[0]; a1_ += y_[1]; a2_ += y_[2]; a3_ += y_[3]; } \
        const f32x2 s2_ = (a0_ + a1_) + (a2_ + a3_); OUT = (int)(dpp_sum_f(s2_[0] + s2_[1]) + 0.5f); } while (0)
    float tau = hi; int need = 256; bool exact = false;
#ifndef PROBE_SEL
#define PROBE_SEL 0
#endif
    {
        float glo = (float)(t + 1) - 255.5f, ghi = -255.5f; int side = 0;
        for (int it = 0; it < 200; ++it) {
            float p = lo + (hi - lo) * (glo * __builtin_amdgcn_rcpf(glo - ghi));
            if (it >= 48 || !(p > lo) || !(p < hi)) p = lo + (hi - lo) * 0.5f;
            if (!(p > lo) || !(p < hi)) break;
            int cm; COUNT_GT(p, cm);
            if (cm == 256) { tau = p; exact = true; break; }
            if (cm > 256) { lo = p; glo = (float)cm - 255.5f; if (side < 0) ghi *= 0.5f; side = -1; }
            else { hi = p; ghi = (float)cm - 255.5f; if (side > 0) glo *= 0.5f; side = 1; }
        }
        if (!exact) { tau = hi; int g; COUNT_GT(hi, g); need = 256 - g; }
    }
#undef COUNT_GT
    if (exact) {
#pragma unroll
        for (int c = 0; c < NC; ++c) (void)__hip_atomic_fetch_or(maskw + 64 * c + lane, (x[c] > tau) ? tbit : 0u, __ATOMIC_RELAXED, __HIP_MEMORY_SCOPE_WORKGROUP);
    } else {
        int base = 0;
#pragma unroll
        for (int c = 0; c < NC; ++c) {
            const bool gt = x[c] > tau, eq = x[c] == tau;
            const unsigned long long tb = __ballot(eq);
            const int rank = base + (int)__builtin_amdgcn_mbcnt_hi((unsigned)(tb >> 32), __builtin_amdgcn_mbcnt_lo((unsigned)tb, 0u));
            base += __popcll(tb);
            if (gt || (eq && rank < need)) (void)__hip_atomic_fetch_or(maskw + 64 * c + lane, tbit, __ATOMIC_RELAXED, __HIP_MEMORY_SCOPE_WORKGROUP);
        }
    }
}
struct XItem { const float* src; unsigned char* dst; int N; };
__device__ __forceinline__ XItem x_decode(int id, int lane, const float* wg, const float* wu, const float* wd, unsigned char* Wgu8, unsigned char* Wd8) {
    const int m = id >> 13, r = id & 8191, e = r >> 8, q = r & 255; XItem t;
    if (m < 2) { const int kb = q >> 3, nb = q & 7, n = nb * 64 + lane;
        t.src = (m == 0 ? wg : wu) + (size_t)e * 1024 * 512 + (size_t)(kb * 32) * 512 + n; t.N = 512;
        t.dst = Wgu8 + (size_t)(e * 1024 + (n >> 7) * 256 + m * 128 + (n & 127)) * 1024 + kb * 32; }
    else { const int kb = q >> 4, nb = q & 15, n = nb * 64 + lane;
        t.src = wd + (size_t)e * 512 * 1024 + (size_t)(kb * 32) * 1024 + n; t.N = 1024;
        t.dst = Wd8 + (size_t)(e * 1024 + n) * 512 + kb * 32; }
    return t;
}
__device__ __forceinline__ void x_load(const XItem& t, float (&rg)[32]) {
#pragma unroll
    for (int i = 0; i < 32; ++i) rg[i] = __builtin_nontemporal_load(t.src + (size_t)i * t.N);
}
__device__ __forceinline__ void x_store(const XItem& t, float (&rg)[32]) {
#pragma unroll
    for (int i = 0; i < 32; ++i) asm volatile("" : "+v"(rg[i]));
    u32x4 o0, o1;
#pragma unroll
    for (int q = 0; q < 4; ++q) { int w0 = 0, w1 = 0;
        w0 = __builtin_amdgcn_cvt_pk_fp8_f32(32.f * rg[4 * q], 32.f * rg[4 * q + 1], w0, false); w0 = __builtin_amdgcn_cvt_pk_fp8_f32(32.f * rg[4 * q + 2], 32.f * rg[4 * q + 3], w0, true);
        w1 = __builtin_amdgcn_cvt_pk_fp8_f32(32.f * rg[16 + 4 * q], 32.f * rg[16 + 4 * q + 1], w1, false); w1 = __builtin_amdgcn_cvt_pk_fp8_f32(32.f * rg[16 + 4 * q + 2], 32.f * rg[16 + 4 * q + 3], w1, true);
        o0[q] = (unsigned)w0; o1[q] = (unsigned)w1; }
    *(u32x4*)t.dst = o0; *(u32x4*)(t.dst + 16) = o1;
}
__device__ __forceinline__ void score_select_unit(Frame& F, int b, int qt16, const bf16_t* qi, const bf16_t* ki, const float* wi, LAS float* scl, LAS unsigned* maskw, unsigned* masks, int xid0, int xid1) {
    const int lane = F.lane, wid = F.wave, r = lane & 31, h = lane >> 5;
    const int T0 = qt16 * 16; const size_t rowb = (size_t)b * SEQ;
    XItem xa, xb; float xr0[32], xr1[32];
    { const KArgs ka = kargs(); unsigned char* w8a = F.ws + WS_WGU; unsigned char* w8b = F.ws + WS_WD;
      xa = x_decode(xid0 >= 0 ? xid0 : 0, lane, ka->in[13], ka->in[14], ka->in[15], w8a, w8b); xb = x_decode(xid1 >= 0 ? xid1 : 0, lane, ka->in[13], ka->in[14], ka->in[15], w8a, w8b); }
    {
        LAS float* wtab = (LAS float*)(F.lds + TAB_OFF + 8192);
        if (F.tid < 128) wtab[F.tid] = wi[(rowb + T0) * 8 + F.tid] * WSCALE;
        bf16x8 a[4][4];
        const int tk = (r >> 4) + 2 * ((r >> 2) & 1), hd = (r & 3) + 4 * ((r >> 3) & 1);
        const int nsteps = ((T0 + 15) >> 8) + 1, kb0 = 32 * wid;
        const bf16_t* kp0 = ki + (rowb >> 5) * 2048 + (kb0 >> 5) * 2048 + r * 16 + h * 8;
        bf16x8 bfA[4], bfB[4];
#pragma unroll
        for (int kk = 0; kk < 4; ++kk) bfA[kk] = *(const bf16x8*)(kp0 + 512 * kk);
#pragma unroll
        for (int rb = 0; rb < 4; ++rb) {
            const bf16_t* qp = qi + (rowb + T0 + 4 * rb + tk) * 512 + hd * 64 + 8 * h;
#pragma unroll
            for (int kk = 0; kk < 4; ++kk) a[rb][kk] = *(const bf16x8*)(qp + 16 * kk);
        }
        LDS_WAIT(); __syncthreads();
        const LAS float* wl = wtab + 16 * h;
#define SCORE_STEP(KS, BF) do { const int kb_ = 256 * (KS) + kb0; if (kb_ <= T0 + 15) { \
            _Pragma("unroll") for (int rb = 0; rb < 4; ++rb) { \
                f32x16 acc = f32x16{}; \
                _Pragma("unroll") for (int kk = 0; kk < 4; ++kk) acc = __builtin_amdgcn_mfma_f32_32x32x16_bf16(a[rb][kk], BF[kk], acc, 0, 0, 0); \
                const f32x4 w0_ = *(const LAS f32x4*)(wl + 32 * rb), w1_ = *(const LAS f32x4*)(wl + 32 * rb + 4), w2_ = *(const LAS f32x4*)(wl + 32 * rb + 8), w3_ = *(const LAS f32x4*)(wl + 32 * rb + 12); \
                float s0 = 0.f, s1 = 0.f; \
                _Pragma("unroll") for (int reg = 0; reg < 4; ++reg) {     \
                    const float y0_ = __int_as_float(max(__float_as_int(acc[reg]), 0)), y1_ = __int_as_float(max(__float_as_int(acc[reg + 4]), 0)); \
                    const float y2_ = __int_as_float(max(__float_as_int(acc[reg + 8]), 0)), y3_ = __int_as_float(max(__float_as_int(acc[reg + 12]), 0)); \
                    s0 += w0_[reg] * y0_; s0 += w1_[reg] * y1_; s1 += w2_[reg] * y2_; s1 += w3_[reg] * y3_; } \
                LAS float* sp = scl + (4 * rb + 2 * h) * 2048 + kb_ + r; \
                sp[0] = s0; sp[2048] = s1; } } } while (0)
        for (int ks = 0; ks < nsteps; ks += 2) {
            { const int kn = (ks + 1 < 8) ? ks + 1 : 7;
#pragma unroll
              for (int kk = 0; kk < 4; ++kk) bfB[kk] = *(const bf16x8*)(kp0 + (size_t)kn * 16384 + 512 * kk); }
            SCORE_STEP(ks, bfA);
            { const int kn = (ks + 2 < 8) ? ks + 2 : 7;
#pragma unroll
              for (int kk = 0; kk < 4; ++kk) bfA[kk] = *(const bf16x8*)(kp0 + (size_t)kn * 16384 + 512 * kk); }
            if (ks + 1 < nsteps) SCORE_STEP(ks + 1, bfB);
        }
#undef SCORE_STEP
    }
    LDS_WAIT(); __syncthreads();
    if (xid0 >= 0) x_load(xa, xr0);
    if (xid1 >= 0) x_load(xb, xr1);
#ifndef PROBE_P2
#define PROBE_P2 0
#endif
#pragma unroll 1
    for (int jx = 0; jx < (PROBE_P2 == 2 ? 4 : 2); ++jx) { const int j = jx & 1;
        const int tl = wid * 2 + j, t = T0 + tl, nch = (t >> 6) + 1;
        const unsigned tbit = 1u << tl; const LAS float* srow = scl + tl * 2048;
        if (nch <= 8) select_token<8>(srow, t, lane, tbit, maskw);
        else if (nch <= 16) select_token<16>(srow, t, lane, tbit, maskw);
        else if (nch <= 24) select_token<24>(srow, t, lane, tbit, maskw);
        else select_token<32>(srow, t, lane, tbit, maskw);
    }
    if (xid0 >= 0) x_store(xa, xr0);
    if (xid1 >= 0) x_store(xb, xr1);
    LDS_WAIT(); __syncthreads();
    {
        const int ktmax = (T0 + 15) >> 6; unsigned short* mbase = (unsigned short*)(masks + ((size_t)(b * (SEQ / 32) + (qt16 >> 1)) * (SEQ / 64)) * 64) + (qt16 & 1);
#pragma unroll
        for (int jj = 0; jj < 4; ++jj) { const int key = F.tid + 512 * jj, kt = key >> 6, kap = key & 63;
            const unsigned wv = maskw[key]; maskw[key] = 0u;
            if (kt <= ktmax) { const int half = kap >> 5, k5 = kap & 31, hi_ = (k5 >> 2) & 1, rr = (k5 & 3) + 4 * (k5 >> 3); mbase[2 * (kt * 64 + 32 * half + 2 * rr + hi_)] = (unsigned short)wv; } }
    }
    LDS_WAIT(); __syncthreads();
}
__device__ __forceinline__ void conv_pass(Frame& F, const bf16_t* u, const bf16_t* cb, const float* cw, bf16_t* conv) {
    const int gt = F.vcu * 512 + F.tid, NGT = F.G * 512;
    for (int idx = gt; idx < NTOK * 64; idx += NGT) {
        const int tok = idx >> 6, cg = (idx & 63) * 8, pos = tok & (SEQ - 1);
        const u32x4 z = (u32x4){0u, 0u, 0u, 0u};
        const u32x4 u0 = *(const u32x4*)(u + (size_t)tok * 512 + cg);
        const u32x4 u1 = pos >= 1 ? *(const u32x4*)(u + (size_t)(tok - 1) * 512 + cg) : z;
        const u32x4 u2 = pos >= 2 ? *(const u32x4*)(u + (size_t)(tok - 2) * 512 + cg) : z;
        const u32x4 bv = __builtin_nontemporal_load((const u32x4*)(cb + (size_t)tok * 512 + cg));
        const f32x4 w0a = *(const f32x4*)(cw + cg), w0b = *(const f32x4*)(cw + cg + 4);
        const f32x4 w1a = *(const f32x4*)(cw + 512 + cg), w1b = *(const f32x4*)(cw + 512 + cg + 4);
        const f32x4 w2a = *(const f32x4*)(cw + 1024 + cg), w2b = *(const f32x4*)(cw + 1024 + cg + 4);
        f32x4 ya, yb;
#define CV(E, WA, I, WORD, HALF) (WA[I] * (HALF ? bfhi(E.WORD) : bflo(E.WORD)))
        ya[0] = bflo(bv.x) * (CV(u2, w0a, 0, x, 0) + CV(u1, w1a, 0, x, 0) + CV(u0, w2a, 0, x, 0));
        ya[1] = bfhi(bv.x) * (CV(u2, w0a, 1, x, 1) + CV(u1, w1a, 1, x, 1) + CV(u0, w2a, 1, x, 1));
        ya[2] = bflo(bv.y) * (CV(u2, w0a, 2, y, 0) + CV(u1, w1a, 2, y, 0) + CV(u0, w2a, 2, y, 0));
        ya[3] = bfhi(bv.y) * (CV(u2, w0a, 3, y, 1) + CV(u1, w1a, 3, y, 1) + CV(u0, w2a, 3, y, 1));
        yb[0] = bflo(bv.z) * (CV(u2, w0b, 0, z, 0) + CV(u1, w1b, 0, z, 0) + CV(u0, w2b, 0, z, 0));
        yb[1] = bfhi(bv.z) * (CV(u2, w0b, 1, z, 1) + CV(u1, w1b, 1, z, 1) + CV(u0, w2b, 1, z, 1));
        yb[2] = bflo(bv.w) * (CV(u2, w0b, 2, w, 0) + CV(u1, w1b, 2, w, 0) + CV(u0, w2b, 2, w, 0));
        yb[3] = bfhi(bv.w) * (CV(u2, w0b, 3, w, 1) + CV(u1, w1b, 3, w, 1) + CV(u0, w2b, 3, w, 1));
#undef CV
        store8bf(conv + (size_t)tok * 1024 + cg, ya, yb);
    }
}

constexpr int P7_HS = 1032;
constexpr int P7_H = 0, P7_HL = 16 * P7_HS * 2, P7_P = 2 * 16 * P7_HS * 2, P7_L = P7_P + 8 * 16 * 48 * 4, P7_R = P7_L + 16 * 48 * 4, P7_END = P7_R + 6 * 128 * 4 + 2 * 32 * 4;
static_assert(P7_END <= RING_BYTES && (P7_P % 16) == 0, "P7 LDS map");
__device__ __forceinline__ void ln1_router(Frame& F, bool dry) {
    const KArgs a = kargs();
    unsigned char* ws = F.ws;
    const float* xin = a->in[0]; const bf16_t* mixb = (const bf16_t*)(ws + WS_MIX); bf16_t* h1b = dry ? (bf16_t*)(ws + WS_GATES) : (bf16_t*)(ws + WS_PRE);
    int* lists = (int*)(ws + (dry ? WS_MERGED : WS_LIST)); unsigned* tokinfo = (unsigned*)(ws + (dry ? WS_MERGED + 8 * MiB : WS_TOKINFO)); const int cbank = dry ? 64 * NEXP : 0;
    unsigned char* h1q = ws + (dry ? WS_MERGED + 16 * MiB : WS_H1Q);
    const float *g1 = a->in[7], *b1 = a->in[8], *rgb = a->in[10], *reb = a->in[12]; const float* wc = (const float*)(ws + WS_WC);
    const int lane = F.lane, wid = F.wave, tid = F.tid;
    LAS bf16_t* Hh = (LAS bf16_t*)(F.lds + P7_H); LAS bf16_t* Hl = (LAS bf16_t*)(F.lds + P7_HL); LAS float* P = (LAS float*)(F.lds + P7_P); LAS float* L = (LAS float*)(F.lds + P7_L);
    LAS int* RE = (LAS int*)(F.lds + P7_R);
    LAS int* hist = RE + 768; LAS int* basev = RE + 800;
    if (tid < 64) hist[tid] = 0;
    f32x4 gv[4], bv[4];
#pragma unroll
    for (int j = 0; j < 4; ++j) { gv[j] = *(const f32x4*)(g1 + 4 * lane + 256 * j); bv[j] = *(const f32x4*)(b1 + 4 * lane + 256 * j); }
    bf16x8 bhi[4][3], blo[4][3];
    { const int kq = lane >> 4, jn = lane & 15; const float* wp = wc + (size_t)(128 * wid + 8 * kq) * 48 + jn;
#pragma unroll
      for (int sidx = 0; sidx < 4; ++sidx)
#pragma unroll
          for (int cb = 0; cb < 3; ++cb) { u32x4 ph, pl;
#pragma unroll
              for (int jp = 0; jp < 4; ++jp) { const float w0 = wp[(size_t)(32 * sidx + 2 * jp) * 48 + 16 * cb], w1 = wp[(size_t)(32 * sidx + 2 * jp + 1) * 48 + 16 * cb];
                  const unsigned hh = pkbf(w0, w1); ph[jp] = hh; pl[jp] = pkbf(w0 - bflo(hh), w1 - bfhi(hh)); }
              bhi[sidx][cb] = __builtin_bit_cast(bf16x8, ph); blo[sidx][cb] = __builtin_bit_cast(bf16x8, pl); } }
    const int ngrp_total = NTOK / 16;
#pragma unroll 1
    for (int gi = F.vcu * 8; gi < ngrp_total; gi += F.G * 8) {
      f32x4 vn[2][4]; u32x2 mn[2][4];
#pragma unroll
      for (int rr = 0; rr < 2; ++rr)
#pragma unroll
          for (int j = 0; j < 4; ++j) { const size_t o_ = (size_t)(gi * 16 + 2 * wid + rr) * DM + 4 * lane + 256 * j; vn[rr][j] = __builtin_nontemporal_load((const f32x4*)(xin + o_)); mn[rr][j] = __builtin_nontemporal_load((const u32x2*)(mixb + o_)); }
#pragma unroll 1
      for (int gg = 0; gg < 8; ++gg) {
        const int row0 = (gi + gg) * 16;
#pragma unroll
        for (int rr = 0; rr < 2; ++rr) { const int rl = 2 * wid + rr, row = row0 + rl;
            f32x4 v[4]; float sm = 0.f;
#pragma unroll
            for (int j = 0; j < 4; ++j) { const u32x2 mw = mn[rr][j]; v[j] = vn[rr][j] * ALPHA + (f32x4){bflo(mw.x), bfhi(mw.x), bflo(mw.y), bfhi(mw.y)}; sm += (v[j][0] + v[j][1]) + (v[j][2] + v[j][3]); }
            const float mean = wave_sum(sm) * (1.f / DM); float s2 = 0.f;
#pragma unroll
            for (int j = 0; j < 4; ++j) { v[j] = v[j] - mean; s2 += (v[j][0] * v[j][0] + v[j][1] * v[j][1]) + (v[j][2] * v[j][2] + v[j][3] * v[j][3]); }
            const float rstd = 1.f / sqrtf(wave_sum(s2) * (1.f / DM) + LN_EPS);
#pragma unroll
            for (int j = 0; j < 4; ++j) { v[j] = v[j] * rstd * gv[j] + bv[j];
                u32x2 o; o.x = pkbf(v[j][0], v[j][1]); o.y = pkbf(v[j][2], v[j][3]); *(u32x2*)(h1b + (size_t)row * DM + 4 * lane + 256 * j) = o;
                { int wv = 0; wv = __builtin_amdgcn_cvt_pk_fp8_f32(v[j][0], v[j][1], wv, false); wv = __builtin_amdgcn_cvt_pk_fp8_f32(v[j][2], v[j][3], wv, true);
                  *(int*)(h1q + (size_t)row * 1024 + 4 * lane + 256 * j) = wv; }
                { const unsigned h01 = o.x, h23 = o.y;
                  *(LAS u32x2*)(Hh + rl * P7_HS + 4 * lane + 256 * j) = (u32x2){h01, h23};
                  *(LAS u32x2*)(Hl + rl * P7_HS + 4 * lane + 256 * j) = (u32x2){pkbf(v[j][0] - bflo(h01), v[j][1] - bfhi(h01)), pkbf(v[j][2] - bflo(h23), v[j][3] - bfhi(h23))}; } } }
        { const int gnx = gg < 7 ? gg + 1 : gg;
#pragma unroll
          for (int rr = 0; rr < 2; ++rr)
#pragma unroll
              for (int j = 0; j < 4; ++j) { const size_t o_ = (size_t)((gi + gnx) * 16 + 2 * wid + rr) * DM + 4 * lane + 256 * j; vn[rr][j] = __builtin_nontemporal_load((const f32x4*)(xin + o_)); mn[rr][j] = __builtin_nontemporal_load((const u32x2*)(mixb + o_)); } }
        LDS_WAIT(); __syncthreads();
        { f32x4 acc[3]; acc[0] = (f32x4){0.f, 0.f, 0.f, 0.f}; acc[1] = acc[0]; acc[2] = acc[0];
          const int hoff = (lane & 15) * P7_HS + 128 * wid + 8 * (lane >> 4);
#pragma unroll
          for (int sidx = 0; sidx < 4; ++sidx) { const bf16x8 ah = *(const LAS bf16x8*)(Hh + hoff + 32 * sidx), al = *(const LAS bf16x8*)(Hl + hoff + 32 * sidx);
#pragma unroll
              for (int cb = 0; cb < 3; ++cb) { acc[cb] = __builtin_amdgcn_mfma_f32_16x16x32_bf16(ah, bhi[sidx][cb], acc[cb], 0, 0, 0);
                  acc[cb] = __builtin_amdgcn_mfma_f32_16x16x32_bf16(ah, blo[sidx][cb], acc[cb], 0, 0, 0); acc[cb] = __builtin_amdgcn_mfma_f32_16x16x32_bf16(al, bhi[sidx][cb], acc[cb], 0, 0, 0); } }
          LAS float* pp = P + (wid * 16 + 4 * (lane >> 4)) * 48 + (lane & 15);
#pragma unroll
          for (int cb = 0; cb < 3; ++cb)
#pragma unroll
              for (int rg = 0; rg < 4; ++rg) pp[rg * 48 + 16 * cb] = acc[cb][rg]; }
        LDS_WAIT(); __syncthreads();
        for (int idx = tid; idx < 16 * 48; idx += 512) { float sum = 0.f;
#pragma unroll
            for (int w = 0; w < 8; ++w) sum += P[w * 768 + idx];
            L[idx] = sum; }
        LDS_WAIT(); __syncthreads();
        if (tid < 16) { const LAS float* lr = L + tid * 48;
            float gl[4]; int grp = 0;
#pragma unroll
            for (int i = 0; i < 4; ++i) gl[i] = lr[i] + rgb[i];
            float gm = gl[0];
#pragma unroll
            for (int i = 1; i < 4; ++i) if (gl[i] > gm) { gm = gl[i]; grp = i; }
            float den = 0.f;
#pragma unroll
            for (int i = 0; i < 4; ++i) den += __expf(gl[i] - gm);
            const float pgrp = 1.f / den;
            float el[8];
#pragma unroll
            for (int i = 0; i < 8; ++i) el[i] = lr[4 + 8 * grp + i] + reb[grp * 8 + i];
            int i1 = 0; float v1 = el[0];
#pragma unroll
            for (int i = 1; i < 8; ++i) if (el[i] > v1) { v1 = el[i]; i1 = i; }
            int i2 = -1; float v2 = -INFINITY;
#pragma unroll
            for (int i = 0; i < 8; ++i) if (i != i1 && el[i] > v2) { v2 = el[i]; i2 = i; }
            const float ex = __expf(v2 - v1), w1 = pgrp / (1.f + ex), w2 = pgrp * ex / (1.f + ex);
            const int e1 = grp * 8 + i1, e2 = grp * 8 + i2, ti = gg * 16 + tid;
            RE[ti] = e1; RE[128 + ti] = e2; RE[256 + ti] = (int)__float_as_uint(w1); RE[384 + ti] = (int)__float_as_uint(w2);
            RE[512 + ti] = __hip_atomic_fetch_add(hist + e1, 1, __ATOMIC_RELAXED, __HIP_MEMORY_SCOPE_WORKGROUP);
            RE[640 + ti] = __hip_atomic_fetch_add(hist + e2, 1, __ATOMIC_RELAXED, __HIP_MEMORY_SCOPE_WORKGROUP);
        }
      }
      LDS_WAIT(); __syncthreads();
      if (tid < NEXP) { const int hc = hist[tid]; basev[tid] = hc ? (int)__hip_atomic_fetch_add(F.ctl + CW_CNT + cbank + 64 * tid, (unsigned)hc, __ATOMIC_RELAXED, __HIP_MEMORY_SCOPE_AGENT) : 0; }
      LDS_WAIT(); __syncthreads();
      if (tid < 128) { const int row = gi * 16 + tid; const int e1 = RE[tid], e2 = RE[128 + tid];
          const unsigned r1 = (unsigned)(basev[e1] + RE[512 + tid]), r2 = (unsigned)(basev[e2] + RE[640 + tid]);
          if (r1 < (unsigned)LISTCAP) lists[(size_t)e1 * LISTCAP + r1] = row;
          if (r2 < (unsigned)LISTCAP) lists[(size_t)e2 * LISTCAP + r2] = row;
          unsigned* ti = tokinfo + (size_t)row * 8;
          *(u32x4*)ti = (u32x4){(unsigned)e1, r1, (unsigned)RE[256 + tid], (unsigned)e2}; *(u32x2*)(ti + 4) = (u32x2){r2, (unsigned)RE[384 + tid]}; }
      LDS_WAIT(); __syncthreads();
      if (tid < 64) hist[tid] = 0;
      LDS_WAIT(); __syncthreads();
    }
}
__device__ __forceinline__ void moe_tables(Frame& F) {
    LAS int* tab = (LAS int*)(F.lds + TAB_OFF);
    __syncthreads();
    if (F.tid < NEXP) { int c = (int)__hip_atomic_load(F.ctl + CW_CNT + 64 * F.tid, __ATOMIC_RELAXED, __HIP_MEMORY_SCOPE_AGENT); if (c > LISTCAP) c = LISTCAP; tab[T_CNT + F.tid] = c; }
    __syncthreads();
    if (F.tid == 0) { int acc = 0; for (int e = 0; e < NEXP; ++e) { tab[T_BLK0 + e] = acc; acc += (tab[T_CNT + e] + 255) >> 8; } tab[T_BLK0 + NEXP] = acc; tab[T_NB] = acc; }
    __syncthreads();
    if (F.tid < NEXP) { const int b0 = tab[T_BLK0 + F.tid], b1 = tab[T_BLK0 + F.tid + 1]; for (int bb = b0; bb < b1; ++bb) tab[T_BLKE + bb] = F.tid; }
    __syncthreads();
}

__device__ __forceinline__ void combine_ln2(Frame& F) {
    const KArgs a = kargs();
    unsigned char* ws = F.ws;
    const bf16_t* h1 = (const bf16_t*)(ws + WS_PRE); const unsigned char* ys = ws + WS_YS;     const unsigned* tokinfo = (const unsigned*)(ws + WS_TOKINFO);
    const LAS int* tab = (const LAS int*)(F.lds + TAB_OFF);
    const float *g2 = a->in[16], *b2 = a->in[17]; float* outp = a->out;
    const int lane = F.lane, gw = F.vcu * NWAVES + F.wave, NGW = F.G * NWAVES;
    f32x4 gv[4], bv[4];
#pragma unroll
    for (int j = 0; j < 4; ++j) { gv[j] = *(const f32x4*)(g2 + 4 * lane + 256 * j); bv[j] = *(const f32x4*)(b2 + 4 * lane + 256 * j); }
    const int nrw = (NTOK - gw + NGW - 1) / NGW;
    if (nrw > 0) {
#define ROWK(k) (gw + ((k) < nrw ? (k) : nrw - 1) * NGW)
#define TI_LOAD(k, A, B) do { const unsigned* ti_ = tokinfo + (size_t)ROWK(k) * 8; A = *(const u32x4*)ti_; B = *(const u32x2*)(ti_ + 4); } while (0)
#define DATA_LOAD(k, A, B, HW, YA, YB) do { const int e1_ = (int)A.x, e2_ = (int)A.w; \
        const size_t s1_ = (size_t)tab[T_BLK0 + e1_] * 256 + A.y, s2_ = (size_t)tab[T_BLK0 + e2_] * 256 + B.x; \
        const bf16_t* hr_ = h1 + (size_t)ROWK(k) * DM + 4 * lane; const unsigned char* y1_ = ys + s1_ * DM + 4 * lane; const unsigned char* y2_ = ys + s2_ * DM + 4 * lane; \
        _Pragma("unroll") for (int j = 0; j < 4; ++j) { HW[j] = __builtin_nontemporal_load((const u32x2*)(hr_ + 256 * j)); YA[j] = __builtin_nontemporal_load((const unsigned*)(y1_ + 256 * j)); YB[j] = __builtin_nontemporal_load((const unsigned*)(y2_ + 256 * j)); } } while (0)
        u32x4 tc0, tn0, tq0; u32x2 tc1, tn1, tq1;
        u32x2 hw[4], hwn[4]; unsigned ya[4], yb[4], yan[4], ybn[4];
        TI_LOAD(0, tc0, tc1); TI_LOAD(1, tn0, tn1);
        DATA_LOAD(0, tc0, tc1, hw, ya, yb);
        for (int k = 0; k < nrw; ++k) {
            TI_LOAD(k + 2, tq0, tq1);
            DATA_LOAD(k + 1, tn0, tn1, hwn, yan, ybn);
            const float w1 = __uint_as_float(tc0.z), w2 = __uint_as_float(tc1.y);
            f32x4 v[4]; float sm = 0.f;
#pragma unroll
            for (int j = 0; j < 4; ++j) {
                v[j][0] = ALPHA * bflo(hw[j].x) + w1 * __builtin_amdgcn_cvt_f32_fp8((int)ya[j], 0) + w2 * __builtin_amdgcn_cvt_f32_fp8((int)yb[j], 0);
                v[j][1] = ALPHA * bfhi(hw[j].x) + w1 * __builtin_amdgcn_cvt_f32_fp8((int)ya[j], 1) + w2 * __builtin_amdgcn_cvt_f32_fp8((int)yb[j], 1);
                v[j][2] = ALPHA * bflo(hw[j].y) + w1 * __builtin_amdgcn_cvt_f32_fp8((int)ya[j], 2) + w2 * __builtin_amdgcn_cvt_f32_fp8((int)yb[j], 2);
                v[j][3] = ALPHA * bfhi(hw[j].y) + w1 * __builtin_amdgcn_cvt_f32_fp8((int)ya[j], 3) + w2 * __builtin_amdgcn_cvt_f32_fp8((int)yb[j], 3);
                sm += (v[j][0] + v[j][1]) + (v[j][2] + v[j][3]); }
            const float mean = wave_sum(sm) * (1.f / DM); float s2v = 0.f;
#pragma unroll
            for (int j = 0; j < 4; ++j) { v[j] = v[j] - mean; s2v += (v[j][0] * v[j][0] + v[j][1] * v[j][1]) + (v[j][2] * v[j][2] + v[j][3] * v[j][3]); }
            const float rstd = 1.f / sqrtf(wave_sum(s2v) * (1.f / DM) + LN_EPS);
            float* orow = outp + (size_t)(gw + k * NGW) * DM + 4 * lane;
#pragma unroll
            for (int j = 0; j < 4; ++j) __builtin_nontemporal_store(v[j] * rstd * gv[j] + bv[j], (f32x4*)(orow + 256 * j));
            tc0 = tn0; tc1 = tn1; tn0 = tq0; tn1 = tq1;
#pragma unroll
            for (int j = 0; j < 4; ++j) { hw[j] = hwn[j]; ya[j] = yan[j]; yb[j] = ybn[j]; }
        }
#undef ROWK
#undef TI_LOAD
#undef DATA_LOAD
    }
}

#if DBG_NAIVE
constexpr size_t WS_NK = 296 * MiB, WS_NV = 312 * MiB, WS_NKI = 328 * MiB;
__device__ __forceinline__ float naive_proj(const float* xs  , const float* w_in, int col) {
    float s = 0.f; for (int d = 0; d < DM; ++d) s += xs[d] * w_in[(size_t)d * INW + col]; return s;
}
__device__ __forceinline__ void naive_kv(Frame& F) {
    const KArgs ka = kargs(); const float* xin = ka->in[0]; const float* win = ka->in[1];
    float* nk = (float*)(F.ws + WS_NK); float* nv = (float*)(F.ws + WS_NV); float* nki = (float*)(F.ws + WS_NKI);
    LAS float* xs = (LAS float*)F.lds; LAS float* pr = xs + 1024;
    for (int tok = F.vcu; tok < NTOK; tok += F.G) {
        __syncthreads();
        for (int i = F.tid; i < DM; i += 512) xs[i] = xin[(size_t)tok * DM + i];
        __syncthreads();
        if (F.tid < 320) { const int col = F.tid < 256 ? 512 + F.tid : 1280 + (F.tid - 256); float s = 0.f; for (int d = 0; d < DM; ++d) s += xs[d] * win[(size_t)d * INW + col]; pr[F.tid] = s; }
        __syncthreads();
        const int pos = tok & (SEQ - 1);
        if (F.tid < 24) {
            const int grp = F.tid >> 3, i = F.tid & 7, base = grp == 0 ? 0 : (grp == 1 ? 64 : 256);
            const float inv = (float)pow(500000.0, -(double)i / 8.0); const float ang = (float)pos * inv, c = cosf(ang), s = sinf(ang);
            const float x1 = pr[base + i], x2 = pr[base + 8 + i]; pr[base + i] = x1 * c - x2 * s; pr[base + 8 + i] = x2 * c + x1 * s;
        }
        __syncthreads();
        if (F.tid < 128) { nk[(size_t)tok * 128 + F.tid] = pr[F.tid]; nv[(size_t)tok * 128 + F.tid] = pr[128 + F.tid]; }
        if (F.tid < 64) nki[(size_t)tok * 64 + F.tid] = pr[256 + F.tid];
    }
}
__device__ __forceinline__ void naive_attn(Frame& F) {
    const KArgs ka = kargs(); const float* xin = ka->in[0]; const float* win = ka->in[1];
    const float* nk = (const float*)(F.ws + WS_NK); const float* nv = (const float*)(F.ws + WS_NV); const float* nki = (const float*)(F.ws + WS_NKI);
    bf16_t* attn = (bf16_t*)(F.ws + WS_AC) + 512;
    LAS float* xs = (LAS float*)F.lds;
    LAS float* qs = xs + 1024;
    LAS float* qis = qs + 512;
    LAS float* wis = qis + 512;
    LAS float* sc = wis + 16;
    LAS int* sel = (LAS int*)(sc + 2048);
    LAS int* nsel = sel + 256;
    LAS float* pl = (LAS float*)(nsel + 16);
    for (int tok = F.vcu; tok < NTOK; tok += F.G) {
        const int pos = tok & (SEQ - 1), b0 = tok - pos;
        __syncthreads();
        for (int i = F.tid; i < DM; i += 512) xs[i] = xin[(size_t)tok * DM + i];
        if (F.tid == 0) nsel[0] = 0;
        __syncthreads();
        for (int c = F.tid; c < 1032; c += 512) { const int col = c < 512 ? c : (c < 1024 ? 768 + (c - 512) : 1344 + (c - 1024));
            float s = 0.f; for (int d = 0; d < DM; ++d) s += xs[d] * win[(size_t)d * INW + col];
            if (c < 512) qs[c] = s; else if (c < 1024) qis[c - 512] = s; else wis[c - 1024] = s; }
        __syncthreads();
        if (F.tid < 128) { const int which = F.tid >> 6, hd = (F.tid >> 3) & 7, i = F.tid & 7; LAS float* p = (which ? qis : qs) + hd * 64;
            const float inv = (float)pow(500000.0, -(double)i / 8.0); const float ang = (float)pos * inv, c = cosf(ang), s = sinf(ang);
            const float x1 = p[i], x2 = p[8 + i]; p[i] = x1 * c - x2 * s; p[8 + i] = x2 * c + x1 * s; }
        __syncthreads();
#if DBG_NAIVE == 2
        { const bf16_t* qif = (const bf16_t*)(F.ws + WS_QI) + (size_t)tok * 512; for (int i = F.tid; i < 512; i += 512) qis[i] = __uint_as_float((unsigned)qif[i] << 16);
          if (F.tid < 8) wis[F.tid] = ((const float*)(F.ws + WS_WI))[(size_t)tok * 8 + F.tid]; }
        __syncthreads();
        for (int s = F.tid; s <= pos; s += 512) { const int tk_ = b0 + s; const bf16_t* kr = (const bf16_t*)(F.ws + WS_KI) + (size_t)(tk_ >> 5) * 2048 + (tk_ & 31) * 16; float tot = 0.f;
            for (int hd = 0; hd < 8; ++hd) { float d = 0.f; for (int e = 0; e < 64; ++e) d += qis[hd * 64 + e] * __uint_as_float((unsigned)kr[(e >> 4) * 512 + ((e >> 3) & 1) * 8 + (e & 7)] << 16); tot += fmaxf(d, 0.f) * (wis[hd] * WSCALE); }
            sc[s] = tot; }
#else
        for (int s = F.tid; s <= pos; s += 512) { const float* kr = nki + (size_t)(b0 + s) * 64; float tot = 0.f;
            for (int hd = 0; hd < 8; ++hd) { float d = 0.f; for (int e = 0; e < 64; ++e) d += qis[hd * 64 + e] * kr[e]; d *= 0.125f; tot += fmaxf(d, 0.f) * wis[hd]; }
            sc[s] = tot * 0.35355339059327373f; }
#endif
        __syncthreads();
        for (int s = F.tid; s <= pos; s += 512) { bool take = true;
            if (pos >= 256) { const float xv = sc[s]; int rank = 0; for (int s2 = 0; s2 <= pos; ++s2) { const float y = sc[s2]; rank += (y > xv || (y == xv && s2 < s)) ? 1 : 0; } take = rank < 256; }
            if (take) { const int p = atomicAdd((int*)nsel, 1); sel[p] = s; } }
        __syncthreads();
        const int ns = nsel[0]; const int hd = F.wave, lane = F.lane;
        float lg[4]; float mx = -INFINITY;
        for (int jj = 0; jj < 4; ++jj) { const int j = lane + 64 * jj; lg[jj] = -INFINITY;
            if (j < ns) { const float* kr = nk + (size_t)(b0 + sel[j]) * 128 + (hd >> 2) * 64; float d = 0.f; for (int e = 0; e < 64; ++e) d += qs[hd * 64 + e] * kr[e]; lg[jj] = d * 0.125f; mx = fmaxf(mx, lg[jj]); } }
        mx = wave_max(mx); float sum = 0.f;
        for (int jj = 0; jj < 4; ++jj) { const int j = lane + 64 * jj; const float p = (j < ns) ? expf(lg[jj] - mx) : 0.f; sum += p; pl[hd * 256 + j] = p; }
        sum = wave_sum(sum);
        LDS_WAIT(); asm volatile("" ::: "memory");
        float o = 0.f;
        for (int j = 0; j < ns; ++j) o += pl[hd * 256 + j] * nv[(size_t)(b0 + sel[j]) * 128 + (hd >> 2) * 64 + lane];
        o /= sum;
        bf16_t* ap = attn + (size_t)tok * 1024 + hd * 64 + lane;
        const float fast = __uint_as_float((unsigned)(*ap) << 16);
        const float blended = o + DBG_G * (fast - o);
        *ap = (bf16_t)(pkbf(blended, 0.f) & 0xffffu);
    }
}
#endif

__global__ void __launch_bounds__(NWAVES * 64, 2) mk_fwd(Args args_unused) {
    extern __shared__ __attribute__((aligned(16))) unsigned char lds[];
    Frame F;
    F.lds = (LAS unsigned char*)lds;
    F.MISC = (volatile LAS unsigned*)(F.lds + LDSCTL_OFF);
    F.tid = threadIdx.x; F.lane = F.tid & 63; F.wave = __builtin_amdgcn_readfirstlane(F.tid >> 6);
    F.G = gridDim.x; { const int bx = blockIdx.x; F.vcu = (F.G % 8 == 0) ? (bx % 8) * (F.G / 8) + bx / 8 : bx; }
    unsigned char* ws; int lo, hi;
    { const KArgs ka = kargs(); ws = ka->ws; lo = ka->ph_lo; hi = ka->ph_hi; }
    F.ws = ws; F.ctl = (unsigned*)(ws + WS_CTL);
    for (int u = F.tid; u < (LDS_BYTES - LDSCTL_OFF) / 4; u += NWAVES * 64) ((LAS unsigned*)(F.lds + LDSCTL_OFF))[u] = 0u;
    __syncthreads();
#if MK_SPLIT
#define GRID_BAR() do { } while (0)
#else
    XcdBarrier bar = xcd_barrier_post(F.ctl + CW_BAR, F.MISC + 8);
#define GRID_BAR() xcd_barrier(bar)
#endif
#ifndef PHASE_MASK
#define PHASE_MASK 0xFFFF
#endif
#define IN(k) ((((PHASE_MASK) >> (k)) & 1) && lo <= (k) && (k) < hi)
#define BOTH(k, k2) (IN(k) && IN(k2))

    bf16_t* xb = (bf16_t*)(ws + WS_XB);
    bf16_t *qb = (bf16_t*)(ws + WS_Q), *kbuf = (bf16_t*)(ws + WS_K), *vbuf = (bf16_t*)(ws + WS_V), *qib = (bf16_t*)(ws + WS_QI), *kib = (bf16_t*)(ws + WS_KI);
    float* wib = (float*)(ws + WS_WI);
    bf16_t *ub = (bf16_t*)(ws + WS_U), *cbb = (bf16_t*)(ws + WS_CB), *acb = (bf16_t*)(ws + WS_AC), *gab = (bf16_t*)(ws + WS_GA), *rtb = (bf16_t*)(ws + WS_RT);
    unsigned* masks = (unsigned*)(ws + WS_MASK);
    bf16_t *merged = (bf16_t*)(ws + WS_MERGED), *h1b = (bf16_t*)(ws + WS_PRE), *ysb_unused = nullptr; (void)ysb_unused;
    float* pre = (float*)(ws + WS_PRE);

    if (IN(0)) { p0_prologue(F); if (BOTH(0, 1)) GRID_BAR(); }
    if (IN(1)) {
        pg8::Gemm g{xb, (const bf16_t*)(ws + WS_WIN), NTOK, NPROJ, DM, 0}; pg8::StaticOrder S; S.init(NTOK, NPROJ, F.G, (int)blockIdx.x);
        EpiProj E{qb, kbuf, vbuf, qib, kib, ub, cbb, gab, rtb, wib, (const float*)(ws + WS_ROPE), kargs()->in[2]};
        pg8::gemm_phase<EpiProj, pg8::StaticOrder, true, false>(F.lds, g, S, E, nullptr);
        if (BOTH(1, 2)) GRID_BAR();
    }
    if (IN(2)) {
        LAS float* scl = (LAS float*)F.lds;
        LAS unsigned* maskw = (LAS unsigned*)(F.lds + TAB_OFF);
        for (int i = F.tid; i < 2048; i += 512) maskw[i] = 0u;
        __syncthreads();
        if (F.G == 256) {
            const int b = F.vcu >> 4, j = F.vcu & 15;
#pragma unroll 1
            for (int i = 0; i < 8; ++i) { const int qt = 32 * (i >> 1) + ((i & 1) ? 31 - j : j);
                const int gwv = F.vcu * NWAVES + F.wave, jx0 = i < 4 ? 2 * i : 4 + i;
                score_select_unit(F, b, qt, qib, kib, wib, scl, maskw, masks, gwv + 2048 * jx0, i < 4 ? gwv + 2048 * (jx0 + 1) : -1); }
        } else {
#pragma unroll 1
            for (int un = F.vcu; un < NBATCH * 128; un += F.G) score_select_unit(F, un >> 7, un & 127, qib, kib, wib, scl, maskw, masks, -1, -1);
        }
        conv_pass(F, ub, cbb, kargs()->in[5], acb);
        if (PROBE_P2 == 3) conv_pass(F, ub, cbb, kargs()->in[5], acb);
        if (BOTH(2, 3)) GRID_BAR();
    }
    if (IN(3)) {
        const int nun = NBATCH * 8 * 8;
        if (F.G == 256) {
            const int bh = F.vcu >> 1, s0 = 2 * (F.vcu & 1);
#pragma unroll 1
            for (int i = 0; i < 4; ++i) { const int qbk = (i == 0) ? s0 : (i == 1) ? 7 - s0 : (i == 2) ? s0 + 1 : 6 - s0;
                attn_body::attn_unit<8>(bh >> 3, bh & 7, qbk, (const attn_body::bf16*)qb, (const attn_body::bf16*)kbuf, (const attn_body::bf16*)vbuf, (attn_body::bf16*)acb, masks, (char*)lds); }
        } else {
#pragma unroll 1
            for (int un = F.vcu; un < nun; un += F.G) attn_body::attn_unit<8>(un >> 6, (un >> 3) & 7, un & 7, (const attn_body::bf16*)qb, (const attn_body::bf16*)kbuf, (const attn_body::bf16*)vbuf, (attn_body::bf16*)acb, masks, (char*)lds);
        }
        if (BOTH(3, 4)) GRID_BAR();
    }
#if DBG_NAIVE
    if (IN(4)) { naive_kv(F); }
    if (IN(11)) { naive_attn(F); }
#else
    if (IN(4)) { if (BOTH(4, 5)) { } }
#endif
    if (IN(5)) {
        pg8::Gemm g{acb, (const bf16_t*)(ws + WS_WAU), NTOK, DM, DM, 0}; pg8::StaticOrder S; S.init(NTOK, DM, F.G, (int)blockIdx.x);
        EpiMerged E{gab, rtb, merged};
        pg8::gemm_phase<EpiMerged, pg8::StaticOrder, true, false, true>(F.lds, g, S, E, nullptr);
        if (BOTH(5, 6)) GRID_BAR();
    }
    if (IN(6)) {
        pg8::Gemm g{merged, (const bf16_t*)(ws + WS_WOUT), NTOK, DM, DM, 0}; pg8::StaticOrder S; S.init(NTOK, DM, F.G, (int)blockIdx.x);
        EpiOut E{(bf16_t*)(ws + WS_MIX)};
        pg8::gemm_phase<EpiOut, pg8::StaticOrder, true, false>(F.lds, g, S, E, nullptr);
        if (BOTH(6, 7)) GRID_BAR();
    }
    if (IN(7)) { ln1_router(F, (kargs()->flags & 1) != 0); if (BOTH(7, 8)) GRID_BAR(); }
    if (IN(8)) {
        moe_tables(F);
        LAS int* tab = (LAS int*)(F.lds + TAB_OFF);
        const int nunits = tab[T_NB] * 4; const int* lists = (const int*)(ws + WS_LIST);
        for (int i = 0; i < T_ROWS_UNITS; ++i) { const int L = i * F.G + F.vcu; if (L >= nunits) break;
            const int rbg = L >> 2, e = tab[T_BLKE + rbg], slot0 = (rbg - tab[T_BLK0 + e]) * 256, cnt = tab[T_CNT + e];
            if (F.tid < 256) { const int sl = slot0 + F.tid; tab[T_ROWS + i * 256 + F.tid] = sl < cnt ? lists[(size_t)e * LISTCAP + sl] : 0; } }
        __syncthreads();
        pg8::Gemm g{(const bf16_t*)(ws + WS_H1Q), (const bf16_t*)(ws + WS_WGU), CAPROWS, NEXP * 1024, 512, 0}; pg8::MoeOrder S{tab + T_BLKE, nunits, F.G, F.vcu};
        EpiSwiGLU E{ws + WS_HID};
        pg8::gemm_phase<EpiSwiGLU, pg8::MoeOrder, true, true, false, true>(F.lds, g, S, E, tab + T_ROWS);
        if (BOTH(8, 9)) GRID_BAR();
    }
    if (IN(9)) {
        moe_tables(F);
        LAS int* tab = (LAS int*)(F.lds + TAB_OFF);
        const int nunits = tab[T_NB] * 4;
        pg8::Gemm g{(const bf16_t*)(ws + WS_HID), (const bf16_t*)(ws + WS_WD), CAPROWS, NEXP * 1024, 256, 0}; pg8::MoeOrder S{tab + T_BLKE, nunits, F.G, F.vcu};
        EpiYs E{ws + WS_YS};
        pg8::gemm_phase<EpiYs, pg8::MoeOrder, true, false, false, true>(F.lds, g, S, E, nullptr);
        if (BOTH(9, 10)) GRID_BAR();
    }
    if (IN(10)) { moe_tables(F); combine_ln2(F); }
#undef IN
#undef BOTH
}

extern "C" void kernel_launch(void* const* d_in, const int* in_sizes, int n_in, void* d_out, int out_size, void* d_ws, size_t ws_size, hipStream_t stream) {
    static int grid = 0;
    if (grid == 0) {
        if (n_in != 18 || in_sizes[0] != NTOK * DM || out_size != NTOK * DM || ws_size < WS_END) { fprintf(stderr, "kernel_launch: unexpected shapes (n_in %d, ws %zu)\n", n_in, ws_size); grid = -1; return; }
        int dev = 0, cus = 0, per_cu = 0;
        if (hipGetDevice(&dev) != hipSuccess || hipDeviceGetAttribute(&cus, hipDeviceAttributeMultiprocessorCount, dev) != hipSuccess) { grid = -1; return; }
        if (hipFuncSetAttribute((const void*)mk_fwd, hipFuncAttributeMaxDynamicSharedMemorySize, LDS_BYTES) != hipSuccess) { fprintf(stderr, "kernel_launch: hipFuncSetAttribute failed\n"); grid = -1; return; }
        if (hipOccupancyMaxActiveBlocksPerMultiprocessor(&per_cu, (const void*)mk_fwd, NWAVES * 64, LDS_BYTES) != hipSuccess || per_cu < 1) fprintf(stderr, "kernel_launch: occupancy query reports %d\n", per_cu);
        (void)hipGetLastError();
        grid = cus;
    }
    if (grid < 0) return;
    (void)hipMemsetAsync((char*)d_ws + WS_CTL, 0, CTL_ZERO_BYTES, stream);
    Args a{};
    for (int i = 0; i < 18; ++i) a.in[i] = (const float*)d_in[i];
    a.out = (float*)d_out; a.ws = (unsigned char*)d_ws;
#if MK_SPLIT
#if DBG_NAIVE
    const int seq[] = {0, 1, 2, 3, 4, 11, 5, 6, 7, 8, 9, 10};
#else
    const int seq[] = {0, 1, 2, 3, 5, 6, 7, 8, 9, 10};
#endif
    for (int ph : seq) { a.ph_lo = ph; a.ph_hi = ph + 1;
#ifdef PROBE_P7
        if (ph == 7) { a.flags = 1; hipLaunchKernelGGL(mk_fwd, dim3(grid), dim3(NWAVES * 64), LDS_BYTES, stream, a); a.flags = 0; }
#endif
        hipLaunchKernelGGL(mk_fwd, dim3(grid), dim3(NWAVES * 64), LDS_BYTES, stream, a);
#ifdef PROBE_DUP
        if (ph == PROBE_DUP) hipLaunchKernelGGL(mk_fwd, dim3(grid), dim3(NWAVES * 64), LDS_BYTES, stream, a);
#endif
    }
#else
    a.ph_lo = 0; a.ph_hi = 11;
    hipLaunchKernelGGL(mk_fwd, dim3(grid), dim3(NWAVES * 64), LDS_BYTES, stream, a);
#endif
}
```

```cpp
#include <hip/hip_runtime.h>
#include <hip/hip_bf16.h>
#include <cstdio>
#include <cstdint>

#ifndef MK_SPLIT
#define MK_SPLIT 0
#endif
#ifndef DBG_NAIVE
#define DBG_NAIVE 0
#endif
#ifndef DBG_G
#define DBG_G 1.0f
#endif

#define LAS __attribute__((address_space(3)))
#define GAS __attribute__((address_space(1)))
typedef unsigned short bf16_t;
typedef short bf16x8 __attribute__((ext_vector_type(8)));
typedef short s16x4 __attribute__((ext_vector_type(4)));
typedef float f32x2 __attribute__((ext_vector_type(2)));
typedef float f32x4 __attribute__((ext_vector_type(4)));
typedef float f32x16 __attribute__((ext_vector_type(16)));
typedef unsigned u32x2 __attribute__((ext_vector_type(2)));
typedef unsigned u32x4 __attribute__((ext_vector_type(4)));
typedef unsigned u32x16 __attribute__((ext_vector_type(16)));
typedef __bf16 bf16x2_t __attribute__((ext_vector_type(2)));

constexpr int NTOK = 32768, SEQ = 2048, NBATCH = 16, DM = 1024;
constexpr int NPROJ = 5120, INW = 4936;
constexpr int NEXP = 32, DEXP = 512, LISTCAP = 32768;
constexpr int CAPROWS = 65536 + NEXP * 256;
constexpr float LN_EPS = 1e-5f;
constexpr float ALPHA = 1.189207115002721f;
constexpr float C2 = 0.125f * 1.4426950408889634f;
constexpr float WSCALE = 0.125f * 0.35355339059327373f;

constexpr size_t MiB = 1u << 20;
constexpr size_t WS_CTL = 0, CTL_ZERO_BYTES = 1 * MiB;
constexpr size_t WS_ROPE = 1 * MiB;
constexpr size_t WS_WC = 1 * MiB + 256 * 1024;
constexpr size_t WS_WIN = 2 * MiB, WS_WAU = 12 * MiB, WS_WCU = 13 * MiB, WS_WOUT = 14 * MiB, WS_WD = 16 * MiB, WS_WGU = 48 * MiB;
constexpr size_t WS_XB = 112 * MiB;
constexpr size_t WS_MIX = 112 * MiB;
constexpr size_t WS_H1Q = 304 * MiB;
constexpr size_t WS_AC = 112 * MiB;
constexpr size_t WS_Q = 176 * MiB, WS_K = 208 * MiB, WS_V = 216 * MiB, WS_QI = 224 * MiB, WS_KI = 256 * MiB, WS_WI = 260 * MiB;
constexpr size_t WS_MERGED = 176 * MiB;
constexpr size_t WS_U = 264 * MiB, WS_ATTN = 264 * MiB;
constexpr size_t WS_CB = 296 * MiB, WS_MASK = 360 * MiB, WS_GATES = 368 * MiB;
constexpr size_t WS_GA = 368 * MiB, WS_RT = 432 * MiB;
constexpr size_t WS_PRE = 240 * MiB;
constexpr size_t WS_HID = 368 * MiB;
constexpr size_t WS_LIST = 496 * MiB, WS_TOKINFO = 500 * MiB;
constexpr size_t WS_YS = 48 * MiB;
constexpr size_t WS_END = 512 * MiB;
static_assert(WS_YS + (size_t)CAPROWS * 1024 * 2 <= WS_PRE && WS_HID + (size_t)CAPROWS * 512 * 2 <= WS_LIST, "ws map");
constexpr int CW_BAR = 4096;
constexpr int CW_CNT = 8192;
constexpr int RING_BYTES = 131072;
constexpr int LDSCTL_OFF = RING_BYTES;
constexpr int TAB_OFF = RING_BYTES + 512;
constexpr int T_CNT = 0, T_BLK0 = 32, T_NB = 68, T_BLKE = 72, T_ROWS = 400, T_ROWS_UNITS = 12;
constexpr int LDS_BYTES = 147456;
static_assert(TAB_OFF + (T_ROWS + T_ROWS_UNITS * 256) * 4 <= LDS_BYTES && TAB_OFF + 8192 <= LDS_BYTES, "lds map");
constexpr int NWAVES = 8;

__device__ __forceinline__ unsigned pkbf(float lo, float hi) { f32x2 v = {lo, hi}; bf16x2_t b = __builtin_convertvector(v, bf16x2_t); return __builtin_bit_cast(unsigned, b); }
__device__ __forceinline__ float bflo(unsigned u) { return __uint_as_float(u << 16); }
__device__ __forceinline__ float bfhi(unsigned u) { return __uint_as_float(u & 0xffff0000u); }
__device__ __forceinline__ float wave_sum(float v) {
#pragma unroll
    for (int o = 1; o < 64; o <<= 1) v += __shfl_xor(v, o);
    return v;
}
__device__ __forceinline__ float wave_max(float v) {
#pragma unroll
    for (int o = 1; o < 64; o <<= 1) v = fmaxf(v, __shfl_xor(v, o));
    return v;
}
__device__ __forceinline__ float wave_min(float v) {
#pragma unroll
    for (int o = 1; o < 64; o <<= 1) v = fminf(v, __shfl_xor(v, o));
    return v;
}
#define LDS_WAIT() asm volatile("s_waitcnt lgkmcnt(0)" ::: "memory")
#define VM_WAIT() asm volatile("s_waitcnt vmcnt(0)" ::: "memory")

namespace pg8 {
constexpr int BM = 256, BK = 64, HALF = 128, HTB = HALF * BK * 2, STAGE_BYTES = 8 * HTB, NXCD = 8, WGM = 8;
__host__ __device__ __forceinline__ int lds_byte(int r, int c) { const int st = (r >> 4) * 2 + (c >> 5), rr = r & 15, cc = c & 31, ob = rr * 64 + cc * 2; return st * 1024 + (ob ^ (((ob >> 9) & 1) << 5)); }
__host__ __device__ __forceinline__ void stage_rc(int b, int& R, int& C) { const int st = b / 1024, sb = b % 1024, swz = sb ^ (((sb >> 9) & 1) << 5); R = (st >> 1) * 16 + swz / 64; C = (st & 1) * 32 + (swz % 64) / 2; }
__host__ __device__ __forceinline__ int perm32(int rho) { const int n = rho >> 4, i = rho & 15; return 8 * (i >> 2) + 4 * n + (i & 3); }

struct Unit { int pm, pn; };
struct Gemm { const bf16_t* A; const bf16_t* Bt; int M, N, K; int apitch; };

struct StaticOrder {
    int nM, nN, nwg, G, c;
    __host__ __device__ void init(int M, int N, int G_, int c_) { nM = M / BM; nN = N / BM; nwg = nM * nN; G = G_; c = c_; }
    __host__ __device__ bool next(int i, Unit& u) const {
        const long L = (long)i * G + c; if (L >= nwg) return false;
        int wgid = (int)L; { const int q = nwg / NXCD, r = nwg % NXCD, xcd = wgid % NXCD, off = wgid / NXCD; wgid = (xcd < r ? xcd * (q + 1) : r * (q + 1) + (xcd - r) * q) + off; }
        const int nig = WGM * nN, gid = wgid / nig, fm = gid * WGM, gsz = (nM - fm) < WGM ? (nM - fm) : WGM;
        u.pm = fm + ((wgid % nig) % gsz); u.pn = (wgid % nig) / gsz; return true;
    }
};
struct MoeOrder {
    const LAS int* blk_e; int nunits, G, c;
    __device__ __forceinline__ bool next(int i, Unit& u) const {
        const int L = i * G + c; if (L >= nunits) return false;
        const int rbg = L >> 2; u.pm = rbg; u.pn = blk_e[rbg] * 4 + (L & 3); return true;
    }
};

typedef int i32x8 __attribute__((ext_vector_type(8)));
typedef int i32x4_t __attribute__((ext_vector_type(4)));
constexpr int F8_WSCALE_E = 122;
template <class Epi, class Sched, bool ALIGN_EPI, bool GATHER, bool MIDHOOK = false, bool F8 = false>
__device__ __forceinline__ void gemm_phase(LAS unsigned char* lds, const Gemm g, const Sched& S, const Epi& E, const LAS int* rowtab) {
    const int tid = threadIdx.x, wid = __builtin_amdgcn_readfirstlane(tid >> 6), lane = tid & 63, wr = wid >> 2, wc = wid & 3, fr = lane & 15, fq = lane >> 4;
    const int K = g.K; int nt = K / BK;
    if constexpr (F8) asm volatile("" : "+s"(nt));
    int Rr[2]; unsigned cofs[2], voffB[2];
#pragma unroll
    for (int i = 0; i < 2; ++i) { int R, C; stage_rc(tid * 16 + i * 8192, R, C); const int Rb = Epi::PERM ? ((R & ~31) + perm32(R & 31)) : R;
        Rr[i] = R; cofs[i] = (unsigned)C * 2u; voffB[i] = (unsigned)(Rb * K + C) * 2u; }
    const unsigned rowb = g.apitch ? (unsigned)g.apitch : (unsigned)K * 2u;
    const size_t kstep = (size_t)(BK * 2);
    const size_t hstep = (size_t)HALF * K * 2;
    const size_t tstep = 2 * hstep;
    const unsigned ldsw = (unsigned)wid * 1024u;
    const int aoff = lds_byte(wr * 64 + fr, fq * 8), boff = lds_byte(wc * 32 + fr, fq * 8);
    const char* gA = (const char*)g.A;
#define PG8_SA(b, h) (((b) * 2 + (h)) * HTB)
#define PG8_SB(b, h) ((4 + (b) * 2 + (h)) * HTB)
#define PG8_STAGE(bufoff, gbase, voff) do { _Pragma("unroll") for (int _i = 0; _i < 2; ++_i) \
        __builtin_amdgcn_global_load_lds((const unsigned*)((const char*)(gbase) + (voff)[_i]), (LAS unsigned*)(lds + (bufoff) + ldsw + _i * 8192), 16, 0, 0); } while (0)
#define PG8_LD8(p_) __builtin_shufflevector(*(const LAS i32x4_t*)(p_), *(const LAS i32x4_t*)((p_) + 1024), 0, 1, 2, 3, 4, 5, 6, 7)
#define PG8_LDA(dst, b, h) do { if constexpr (F8) { _Pragma("unroll") for (int m = 0; m < 4; ++m) dst##8[m] = PG8_LD8(lds + PG8_SA(b, h) + aoff + m * 2048); } \
        else { _Pragma("unroll") for (int m = 0; m < 4; ++m) _Pragma("unroll") for (int k = 0; k < 2; ++k) dst[m][k] = *(const LAS bf16x8*)(lds + PG8_SA(b, h) + aoff + m * 2048 + k * 1024); } } while (0)
#define PG8_LDB(dst, b, h) do { if constexpr (F8) { _Pragma("unroll") for (int n = 0; n < 2; ++n) dst##8[n] = PG8_LD8(lds + PG8_SB(b, h) + boff + n * 2048); } \
        else { _Pragma("unroll") for (int n = 0; n < 2; ++n) _Pragma("unroll") for (int k = 0; k < 2; ++k) dst[n][k] = *(const LAS bf16x8*)(lds + PG8_SB(b, h) + boff + n * 2048 + k * 1024); } } while (0)
#define PG8_MMA(ai, bj, At, Bt) do { if constexpr (F8) __builtin_amdgcn_sched_barrier(0);     \
        __builtin_amdgcn_s_setprio(1); \
        if constexpr (F8) { _Pragma("unroll") for (int m = 0; m < 4; ++m) _Pragma("unroll") for (int n = 0; n < 2; ++n) \
            asm volatile("v_mfma_scale_f32_16x16x128_f8f6f4 %0, %1, %2, %0, %3, %4 op_sel_hi:[0,0,0]" : "+v"(acc[ai][bj][m][n]) : "v"(Bt##8[n]), "v"(At##8[m]), "v"(f8_sw), "v"(f8_sa));     \
            __builtin_amdgcn_sched_barrier(0); } \
        else { _Pragma("unroll") for (int m = 0; m < 4; ++m) _Pragma("unroll") for (int n = 0; n < 2; ++n) _Pragma("unroll") for (int k = 0; k < 2; ++k) \
            acc[ai][bj][m][n] = __builtin_amdgcn_mfma_f32_16x16x32_bf16(Bt[n][k], At[m][k], acc[ai][bj][m][n], 0, 0, 0); } \
        __builtin_amdgcn_s_setprio(0); } while (0)
#define PG8_WAIT_V(n) asm volatile("s_waitcnt vmcnt(" #n ")" ::: "memory")
#define PG8_WAIT_L(n) asm volatile("s_waitcnt lgkmcnt(" #n ")" ::: "memory")
#define PG8_BAR __builtin_amdgcn_s_barrier()
#define PG8_SCHED __builtin_amdgcn_sched_barrier(0)
#define PG8_AOFF(d0, d1, un, uidx) do { _Pragma("unroll") for (int _i = 0; _i < 2; ++_i) { unsigned r0_, r1_; \
        if (GATHER) { r0_ = (unsigned)rowtab[(uidx) * 256 + Rr[_i]]; r1_ = (unsigned)rowtab[(uidx) * 256 + 128 + Rr[_i]]; } \
        else { r0_ = (unsigned)((un).pm * 256 + Rr[_i]); r1_ = r0_ + 128u; } \
        d0[_i] = r0_ * rowb + cofs[_i]; d1[_i] = r1_ * rowb + cofs[_i]; } } while (0)
    Unit cur, nxt; int ui = 0;
    if (!S.next(0, cur)) return;
    f32x4 acc[2][2][4][2];
#pragma unroll
    for (int a = 0; a < 2; ++a)
#pragma unroll
        for (int b = 0; b < 2; ++b)
#pragma unroll
            for (int m = 0; m < 4; ++m)
#pragma unroll
                for (int n = 0; n < 2; ++n) acc[a][b][m][n] = (f32x4){0.f, 0.f, 0.f, 0.f};
    bf16x8 At[4][2], B0[2][2], B1[2][2]; i32x8 At8[4], B08[2], B18[2];
    int f8_sw = F8_WSCALE_E, f8_sa = 127; asm volatile("" : "+v"(f8_sw), "+v"(f8_sa));
    unsigned oc0[2], oc1[2], on0[2], on1[2];
    PG8_AOFF(oc0, oc1, cur, 0);
    const char* cB = (const char*)g.Bt + (size_t)cur.pn * tstep;
    PG8_STAGE(PG8_SB(0, 0), cB, voffB); PG8_STAGE(PG8_SB(0, 1), cB + hstep, voffB); PG8_STAGE(PG8_SA(0, 0), gA, oc0); PG8_STAGE(PG8_SA(0, 1), gA, oc1);
    if (wr == 1) PG8_BAR;
    PG8_WAIT_V(2); PG8_BAR;
    PG8_STAGE(PG8_SB(1, 0), cB + kstep, voffB); PG8_STAGE(PG8_SA(1, 0), gA + kstep, oc0); PG8_STAGE(PG8_SB(1, 1), cB + hstep + kstep, voffB);
    PG8_WAIT_V(6); PG8_BAR;
    for (;;) {
        const bool has_next = S.next(ui + 1, nxt);
        if (has_next) { PG8_AOFF(on0, on1, nxt, ui + 1); } else { on0[0] = oc0[0]; on0[1] = oc0[1]; on1[0] = oc1[0]; on1[1] = oc1[1]; }
        const char* nB = has_next ? (const char*)g.Bt + (size_t)nxt.pn * tstep : cB;
        for (int t = 0; t < nt; t += 2) {
            if constexpr (MIDHOOK) { if (t == nt / 2) E.mid(acc, cur, wr, wc, fr, fq); }
            const bool last = (t == nt - 2);
            const char* a1 = gA + (size_t)(t + 1) * kstep;
            const char* a2 = last ? gA : gA + (size_t)(t + 2) * kstep; const char* b2 = last ? nB : cB + (size_t)(t + 2) * kstep;
            const char* a3 = a2 + kstep; const char* b3 = b2 + kstep;
            unsigned o20[2], o21[2];
            o20[0] = last ? on0[0] : oc0[0]; o20[1] = last ? on0[1] : oc0[1]; o21[0] = last ? on1[0] : oc1[0]; o21[1] = last ? on1[1] : oc1[1];
            PG8_LDB(B0, 0, 0); PG8_LDB(B1, 0, 1); PG8_SCHED; PG8_LDA(At, 0, 0); PG8_STAGE(PG8_SA(1, 1), a1, oc1);
            PG8_WAIT_V(8); PG8_WAIT_L(0); PG8_BAR; PG8_MMA(0, 0, At, B0); PG8_MMA(0, 1, At, B1); PG8_BAR; PG8_SCHED;
            PG8_LDA(At, 0, 1); PG8_STAGE(PG8_SB(0, 0), b2, voffB); PG8_STAGE(PG8_SB(0, 1), b2 + hstep, voffB); PG8_STAGE(PG8_SA(0, 0), a2, o20);
            PG8_WAIT_V(8); PG8_WAIT_L(0); PG8_BAR; PG8_MMA(1, 0, At, B0); PG8_MMA(1, 1, At, B1); PG8_BAR; PG8_SCHED;
            PG8_LDB(B0, 1, 0); PG8_LDB(B1, 1, 1); PG8_SCHED; PG8_LDA(At, 1, 0); PG8_STAGE(PG8_SA(0, 1), a2, o21);
            PG8_WAIT_V(8); PG8_WAIT_L(0); PG8_BAR; PG8_MMA(0, 0, At, B0); PG8_MMA(0, 1, At, B1); PG8_BAR; PG8_SCHED;
            PG8_LDA(At, 1, 1); PG8_STAGE(PG8_SB(1, 0), b3, voffB); PG8_STAGE(PG8_SB(1, 1), b3 + hstep, voffB); PG8_STAGE(PG8_SA(1, 0), a3, o20);
            PG8_WAIT_V(8); PG8_WAIT_L(0); PG8_BAR; PG8_MMA(1, 0, At, B0); PG8_MMA(1, 1, At, B1); PG8_BAR; PG8_SCHED;
        }
        if constexpr (ALIGN_EPI) { if (wr == 0) PG8_BAR; }
        if constexpr (F8) asm volatile("s_nop 15\n\ts_nop 15" ::: "memory");
        E(acc, cur, wr, wc, fr, fq);
#ifdef PROBE_EPI2
        if constexpr (!MIDHOOK && !F8 && !GATHER) E(acc, cur, wr, wc, fr, fq);
#endif
        if (!has_next) break;
#pragma unroll
        for (int a = 0; a < 2; ++a)
#pragma unroll
            for (int b = 0; b < 2; ++b)
#pragma unroll
                for (int m = 0; m < 4; ++m)
#pragma unroll
                    for (int n = 0; n < 2; ++n) acc[a][b][m][n] = (f32x4){0.f, 0.f, 0.f, 0.f};
        cur = nxt; cB = nB; ++ui;
        oc0[0] = on0[0]; oc0[1] = on0[1]; oc1[0] = on1[0]; oc1[1] = on1[1];
        if constexpr (ALIGN_EPI) { if (wr == 1) PG8_BAR; }
    }
    PG8_WAIT_V(0);
    if constexpr (!ALIGN_EPI) { if (wr == 0) PG8_BAR; }
    PG8_BAR;
#undef PG8_SA
#undef PG8_SB
#undef PG8_STAGE
#undef PG8_LDA
#undef PG8_LDB
#undef PG8_MMA
#undef PG8_LD8
#undef PG8_WAIT_V
#undef PG8_WAIT_L
#undef PG8_BAR
#undef PG8_SCHED
#undef PG8_AOFF
}
}

typedef f32x4 AccT[2][2][4][2];
__device__ __forceinline__ void store8bf(bf16_t* p, const f32x4& v0, const f32x4& v1) {
    u32x4 w; w.x = pkbf(v0[0], v0[1]); w.y = pkbf(v0[2], v0[3]); w.z = pkbf(v1[0], v1[1]); w.w = pkbf(v1[2], v1[3]); *(u32x4*)p = w;
}
__device__ __forceinline__ void rope8(f32x4& v0, f32x4& v1, const float* rope, int pos, int i0) {
    const f32x4 c = *(const f32x4*)(rope + pos * 8 + i0), s = *(const f32x4*)(rope + SEQ * 8 + pos * 8 + i0);
    float a, b;
    a = v0[0]; b = v0[1]; v0[0] = a * c[0] - b * s[0]; v0[1] = b * c[0] + a * s[0];
    a = v0[2]; b = v0[3]; v0[2] = a * c[1] - b * s[1]; v0[3] = b * c[1] + a * s[1];
    a = v1[0]; b = v1[1]; v1[0] = a * c[2] - b * s[2]; v1[1] = b * c[2] + a * s[2];
    a = v1[2]; b = v1[3]; v1[2] = a * c[3] - b * s[3]; v1[3] = b * c[3] + a * s[3];
}
__device__ __forceinline__ float sigmoidf_(float z) { return __builtin_amdgcn_rcpf(1.0f + __expf(-z)); }

struct EpiProj {
    static constexpr bool PERM = true;
    bf16_t *q, *k, *v, *qi, *ki, *u, *cb, *ga, *rt; float* wi; const float* rope; const float* gate_bias;
    __device__ __forceinline__ void operator()(const AccT& acc, const pg8::Unit& un, int wr, int wc, int fr, int fq) const {
        const int pn = un.pn, row0 = un.pm * 256 + wr * 64 + fr, cg = 32 * wc + 8 * fq;
        const bool rot = ((wc & 1) == 0) && (fq < 2); const int i0 = 4 * fq;
        if (pn < 2 || pn == 3 || pn == 4) {
            bf16_t* dst = (pn < 2) ? q + pn * 256 : qi + (pn - 3) * 256; const float sc = (pn < 2) ? C2 : 1.0f;
#pragma unroll
            for (int ai = 0; ai < 2; ++ai)
#pragma unroll
                for (int m = 0; m < 4; ++m) { const int row = row0 + ai * 128 + m * 16, pos = row & (SEQ - 1);
#pragma unroll
                    for (int bj = 0; bj < 2; ++bj) { f32x4 v0 = acc[ai][bj][m][0], v1 = acc[ai][bj][m][1];
                        if (rot) rope8(v0, v1, rope, pos, i0);
                        v0 = v0 * sc; v1 = v1 * sc; store8bf(dst + (size_t)row * 512 + bj * 128 + cg, v0, v1); } }
        } else if (pn == 2) {
#pragma unroll
            for (int ai = 0; ai < 2; ++ai)
#pragma unroll
                for (int m = 0; m < 4; ++m) { const int row = row0 + ai * 128 + m * 16, pos = row & (SEQ - 1);
                    f32x4 v0 = acc[ai][0][m][0], v1 = acc[ai][0][m][1];
                    if (rot) rope8(v0, v1, rope, pos, i0);
                    store8bf(k + (size_t)row * 128 + cg, v0, v1);
                    store8bf(v + (size_t)row * 128 + cg, acc[ai][1][m][0], acc[ai][1][m][1]); }
        } else if (pn == 5) {
            if (wc < 2) {
#pragma unroll
                for (int ai = 0; ai < 2; ++ai)
#pragma unroll
                    for (int m = 0; m < 4; ++m) { const int row = row0 + ai * 128 + m * 16, pos = row & (SEQ - 1);
                        f32x4 v0 = acc[ai][0][m][0], v1 = acc[ai][0][m][1];
                        if (rot) rope8(v0, v1, rope, pos, i0);
                        { const int jch = cg >> 3; store8bf(ki + ((size_t)(row >> 5) * 4 + (jch >> 1)) * 512 + (row & 31) * 16 + (jch & 1) * 8, v0, v1); } }
            } else if (wc == 2 && fq == 0) {
#pragma unroll
                for (int ai = 0; ai < 2; ++ai)
#pragma unroll
                    for (int m = 0; m < 4; ++m) { const int row = row0 + ai * 128 + m * 16;
                        *(f32x4*)(wi + (size_t)row * 8) = acc[ai][0][m][0]; *(f32x4*)(wi + (size_t)row * 8 + 4) = acc[ai][0][m][1]; }
            }
        } else if (pn < 10) {
#pragma unroll
            for (int ai = 0; ai < 2; ++ai)
#pragma unroll
                for (int m = 0; m < 4; ++m) { const int row = row0 + ai * 128 + m * 16;
                    store8bf(u + (size_t)row * 512 + (pn - 6) * 128 + cg, acc[ai][0][m][0] * acc[ai][1][m][0], acc[ai][0][m][1] * acc[ai][1][m][1]); }
        } else if (pn < 12) {
#pragma unroll
            for (int ai = 0; ai < 2; ++ai)
#pragma unroll
                for (int m = 0; m < 4; ++m) { const int row = row0 + ai * 128 + m * 16;
#pragma unroll
                    for (int bj = 0; bj < 2; ++bj) store8bf(cb + (size_t)row * 512 + (pn - 10) * 256 + bj * 128 + cg, acc[ai][bj][m][0], acc[ai][bj][m][1]); }
        } else {
            const int gc0 = (pn - 12) * 128 + cg;
            const f32x4 ba0 = *(const f32x4*)(gate_bias + gc0), ba1 = *(const f32x4*)(gate_bias + gc0 + 4), bc0 = *(const f32x4*)(gate_bias + 1024 + gc0), bc1 = *(const f32x4*)(gate_bias + 1024 + gc0 + 4);
#pragma unroll
            for (int ai = 0; ai < 2; ++ai)
#pragma unroll
                for (int m = 0; m < 4; ++m) { const int row = row0 + ai * 128 + m * 16;
                    const f32x4 a0 = acc[ai][0][m][0] + ba0, a1 = acc[ai][0][m][1] + ba1, c0 = acc[ai][1][m][0] + bc0, c1 = acc[ai][1][m][1] + bc1;
                    f32x4 g0, g1, r0, r1;
#pragma unroll
                    for (int e = 0; e < 4; ++e) { const float ea0 = 1.0f + __expf(-a0[e]), ea1 = 1.0f + __expf(-a1[e]);
                        g0[e] = __builtin_amdgcn_rcpf(ea0); g1[e] = __builtin_amdgcn_rcpf(ea1);
                        r0[e] = ea0 * __builtin_amdgcn_rcpf(1.0f + __expf(-c0[e])); r1[e] = ea1 * __builtin_amdgcn_rcpf(1.0f + __expf(-c1[e])); }
                    store8bf(ga + (size_t)row * 1024 + gc0, g0, g1); store8bf(rt + (size_t)row * 1024 + gc0, r0, r1); }
        }
    }
};
struct EpiMerged {
    static constexpr bool PERM = true;
    const bf16_t* ga; const bf16_t* rt; bf16_t* out;
    __device__ __forceinline__ void scale(AccT& acc, const bf16_t* gsrc, const pg8::Unit& un, int wr, int wc, int fr, int fq) const {
        unsigned off0 = (unsigned)(un.pm * 256 + wr * 64 + fr) * 1024u + (unsigned)(un.pn * 256 + 32 * wc + 8 * fq);
        asm volatile("" : "+v"(off0));
#pragma unroll
        for (int ai = 0; ai < 2; ++ai)
#pragma unroll
            for (int m = 0; m < 4; ++m) {
#pragma unroll
                for (int bj = 0; bj < 2; ++bj) { const u32x4 gw = __builtin_nontemporal_load((const u32x4*)(gsrc + (off0 + (unsigned)((ai * 128 + m * 16) * 1024 + bj * 128))));
                    f32x4& v0 = acc[ai][bj][m][0]; f32x4& v1 = acc[ai][bj][m][1];
                    v0[0] *= bflo(gw.x); v0[1] *= bfhi(gw.x); v0[2] *= bflo(gw.y); v0[3] *= bfhi(gw.y);
                    v1[0] *= bflo(gw.z); v1[1] *= bfhi(gw.z); v1[2] *= bflo(gw.w); v1[3] *= bfhi(gw.w); } }
    }
    __device__ __forceinline__ void mid(AccT& acc, const pg8::Unit& un, int wr, int wc, int fr, int fq) const { scale(acc, rt, un, wr, wc, fr, fq); }
    __device__ __forceinline__ void operator()(AccT& acc, const pg8::Unit& un, int wr, int wc, int fr, int fq) const {
        scale(acc, ga, un, wr, wc, fr, fq);
        const int row0 = un.pm * 256 + wr * 64 + fr, col0 = un.pn * 256 + 32 * wc + 8 * fq;
#pragma unroll
        for (int ai = 0; ai < 2; ++ai)
#pragma unroll
            for (int m = 0; m < 4; ++m) { const int row = row0 + ai * 128 + m * 16;
#pragma unroll
                for (int bj = 0; bj < 2; ++bj) store8bf(out + (size_t)row * 1024 + col0 + bj * 128, acc[ai][bj][m][0], acc[ai][bj][m][1]); }
    }
};
struct EpiOut {
    static constexpr bool PERM = true;
    bf16_t* mix;
    __device__ __forceinline__ void operator()(const AccT& acc, const pg8::Unit& un, int wr, int wc, int fr, int fq) const {
        const int row0 = un.pm * 256 + wr * 64 + fr, col0 = un.pn * 256 + 32 * wc + 8 * fq;
#pragma unroll
        for (int ai = 0; ai < 2; ++ai)
#pragma unroll
            for (int m = 0; m < 4; ++m) { const int row = row0 + ai * 128 + m * 16;
#pragma unroll
                for (int bj = 0; bj < 2; ++bj) store8bf(mix + (size_t)row * 1024 + col0 + bj * 128, acc[ai][bj][m][0], acc[ai][bj][m][1]); }
    }
};
struct EpiSwiGLU {
    static constexpr bool PERM = true;
    unsigned char* hid;
    __device__ __forceinline__ void operator()(const AccT& acc, const pg8::Unit& un, int wr, int wc, int fr, int fq) const {
        const int row0 = un.pm * 256 + wr * 64 + fr, col0 = (un.pn & 3) * 128 + 32 * wc + 8 * fq;
#pragma unroll
        for (int ai = 0; ai < 2; ++ai)
#pragma unroll
            for (int m = 0; m < 4; ++m) { const int row = row0 + ai * 128 + m * 16; f32x4 h0, h1;
#pragma unroll
                for (int e = 0; e < 4; ++e) { const float g0 = acc[ai][0][m][0][e], g1 = acc[ai][0][m][1][e];
                    h0[e] = g0 * sigmoidf_(g0) * acc[ai][1][m][0][e]; h1[e] = g1 * sigmoidf_(g1) * acc[ai][1][m][1][e]; }
                int w0 = 0, w1 = 0;
                w0 = __builtin_amdgcn_cvt_pk_fp8_f32(h0[0], h0[1], w0, false); w0 = __builtin_amdgcn_cvt_pk_fp8_f32(h0[2], h0[3], w0, true);
                w1 = __builtin_amdgcn_cvt_pk_fp8_f32(h1[0], h1[1], w1, false); w1 = __builtin_amdgcn_cvt_pk_fp8_f32(h1[2], h1[3], w1, true);
                *(u32x2*)(hid + (size_t)row * 512 + col0) = (u32x2){(unsigned)w0, (unsigned)w1}; }
    }
};
struct EpiYs {
    static constexpr bool PERM = true;
    unsigned char* ys;
    __device__ __forceinline__ void operator()(const AccT& acc, const pg8::Unit& un, int wr, int wc, int fr, int fq) const {
        const int row0 = un.pm * 256 + wr * 64 + fr, col0 = (un.pn & 3) * 256 + 32 * wc + 8 * fq;
#pragma unroll
        for (int ai = 0; ai < 2; ++ai)
#pragma unroll
            for (int m = 0; m < 4; ++m) { const int row = row0 + ai * 128 + m * 16;
#pragma unroll
                for (int bj = 0; bj < 2; ++bj) { const f32x4 v0 = acc[ai][bj][m][0], v1 = acc[ai][bj][m][1]; int w0 = 0, w1 = 0;
                    w0 = __builtin_amdgcn_cvt_pk_fp8_f32(v0[0], v0[1], w0, false); w0 = __builtin_amdgcn_cvt_pk_fp8_f32(v0[2], v0[3], w0, true);
                    w1 = __builtin_amdgcn_cvt_pk_fp8_f32(v1[0], v1[1], w1, false); w1 = __builtin_amdgcn_cvt_pk_fp8_f32(v1[2], v1[3], w1, true);
                    *(u32x2*)(ys + (size_t)row * 1024 + col0 + bj * 128) = (u32x2){(unsigned)w0, (unsigned)w1}; } }
    }
};

namespace attn_body {
using bf16 = __hip_bfloat16;
constexpr int D = 64, QP = 512, KP = 128, OP = 1024, OCOL = 512;
constexpr int NW = 8, QBLK = 32, QB = QBLK * NW, KVBLK = 64;
__device__ __forceinline__ int crow(int r, int hi) { return (r & 3) + 8 * (r >> 2) + 4 * hi; }
#define SBAR() __builtin_amdgcn_sched_barrier(0)
__device__ __forceinline__ void cmask(f32x16& p0, f32x16& p1, int jb, int qrel, int hi) {
    const float NEG = -INFINITY; int kb = 64 * jb + 4 * hi;
#pragma unroll
    for (int r = 0; r < 16; ++r) { int kv = kb + (r & 3) + 8 * (r >> 2); if (kv > qrel) p0[r] = NEG; if (kv + 32 > qrel) p1[r] = NEG; }
}
constexpr int NSLOT = 3, SLOTB = 8192;
constexpr int LDS_K = 0, LDS_V = NSLOT * SLOTB, LDS_WS = 2 * NSLOT * SLOTB, LDS_OST = LDS_WS + NW * 64 * 4, LDS_QF = LDS_OST + NW * 4096, LDS_BYTES_A = LDS_QF + NW * 4096;
static_assert(LDS_BYTES_A <= 131072, "attention LDS");
__device__ __forceinline__ void glds16(const void* gsrc, unsigned lds_dst) { unsigned keep;
    asm volatile("s_mov_b32 %0, m0\n\ts_mov_b32 m0, %2\n\ts_nop 0\n\tglobal_load_lds_dwordx4 %1, off\n\ts_mov_b32 m0, %0" : "=&s"(keep) : "v"(gsrc), "s"(lds_dst) : "memory"); }
__device__ __forceinline__ float max3f(float a, float b, float c) { float r; asm("v_max3_f32 %0, %1, %2, %3" : "=v"(r) : "v"(a), "v"(b), "v"(c)); return r; }
__device__ __forceinline__ float max2f(float a, float b) { float r; asm("v_max_f32_e32 %0, %1, %2" : "=v"(r) : "v"(a), "v"(b)); return r; }
__device__ __forceinline__ float fadd_s(float a, float b) { float r; asm("v_add_f32_e32 %0, %1, %2" : "=v"(r) : "v"(a), "v"(b)); return r; }
__device__ __forceinline__ float fsub_s(float a, float b) { float r; asm("v_sub_f32_e32 %0, %1, %2" : "=v"(r) : "v"(a), "v"(b)); return r; }
__device__ __forceinline__ unsigned cvtpk_s(float lo, float hi) { return pkbf(lo, hi); }
__device__ __forceinline__ float msel(float x, float neg, unsigned long long m) { float r; asm("v_cndmask_b32_e64 %0, %1, %2, %3" : "=v"(r) : "v"(neg), "v"(x), "s"(m)); return r; }
#define WAIT_BAR(N) asm volatile("s_waitcnt vmcnt(" #N ") lgkmcnt(0)\n\ts_barrier" ::: "memory")

typedef __attribute__((address_space(3))) const char* lds_cptr;
__device__ __forceinline__ void qkt(f32x16& p0, f32x16& p1, const char* Kslot, lds_cptr qfp, const f32x16& negm, int r32, int hi) {
    const char* kb = Kslot + hi * 1024 + r32 * 16;
#pragma unroll
    for (int d0 = 0; d0 < 4; ++d0) {
        const bf16x8 b0 = *reinterpret_cast<const bf16x8*>(kb + d0 * 2048);
        const bf16x8 b1 = *reinterpret_cast<const bf16x8*>(kb + d0 * 2048 + 512);
        const bf16x8 qd = *(const LAS bf16x8*)(qfp + d0 * 1024);
        if (d0 == 0) { p0 = __builtin_amdgcn_mfma_f32_32x32x16_bf16(b0, qd, negm, 0, 0, 0); p1 = __builtin_amdgcn_mfma_f32_32x32x16_bf16(b1, qd, negm, 0, 0, 0); }
        else { p0 = __builtin_amdgcn_mfma_f32_32x32x16_bf16(b0, qd, p0, 0, 0, 0); p1 = __builtin_amdgcn_mfma_f32_32x32x16_bf16(b1, qd, p1, 0, 0, 0); } }
}
typedef short v4i16_t __attribute__((ext_vector_type(4)));
__device__ __forceinline__ void kload8(bf16x8* kf, lds_cptr kp) {
    kf[0] = *(const LAS bf16x8*)(kp);        kf[1] = *(const LAS bf16x8*)(kp + 512);
    kf[2] = *(const LAS bf16x8*)(kp + 2048); kf[3] = *(const LAS bf16x8*)(kp + 2560);
    kf[4] = *(const LAS bf16x8*)(kp + 4096); kf[5] = *(const LAS bf16x8*)(kp + 4608);
    kf[6] = *(const LAS bf16x8*)(kp + 6144); kf[7] = *(const LAS bf16x8*)(kp + 6656);
}
__device__ __forceinline__ void kload2(bf16x8* kf, lds_cptr kp, int j) { kf[2 * j] = *(const LAS bf16x8*)(kp + j * 2048); kf[2 * j + 1] = *(const LAS bf16x8*)(kp + j * 2048 + 512); }
__device__ __forceinline__ s16x4 vtr(lds_cptr p) { return __builtin_bit_cast(s16x4, __builtin_amdgcn_ds_read_tr16_b64_v4i16((LAS v4i16_t*)p)); }
__device__ __forceinline__ float rowmax(const f32x16& p0, const f32x16& p1) {
    float a = max3f(p0[0], p0[1], p1[0]), b = max3f(p0[2], p0[3], p1[1]); a = max3f(a, p1[2], p1[3]);
#pragma unroll
    for (int r = 4; r < 16; r += 4) { a = max3f(a, p0[r], p0[r + 1]); b = max3f(b, p0[r + 2], p0[r + 3]); a = max3f(a, p1[r], p1[r + 1]); b = max3f(b, p1[r + 2], p1[r + 3]); }
    const float m = max2f(a, b);
    auto rr = __builtin_amdgcn_permlane32_swap(__float_as_uint(m), __float_as_uint(m), false, false);
    return max2f(__uint_as_float(rr[0]), __uint_as_float(rr[1]));
}
__device__ __forceinline__ void pv(f32x16* o, int vb, bf16x8 pa0, bf16x8 pa1, bf16x8 pa2, bf16x8 pa3) {
#pragma unroll
    for (int d0 = 0; d0 < 2; ++d0) { s16x4 lo[4], hi[4];
#pragma unroll
        for (int ks = 0; ks < 4; ++ks) {
            asm volatile("ds_read_b64_tr_b16 %0,%1 offset:%c2" : "=&v"(lo[ks]) : "v"(vb), "i"(d0 * 4096 + ks * 1024) : "memory");
            asm volatile("ds_read_b64_tr_b16 %0,%1 offset:%c2" : "=&v"(hi[ks]) : "v"(vb), "i"(d0 * 4096 + ks * 1024 + 512) : "memory"); }
        asm volatile("s_waitcnt lgkmcnt(0)" ::: "memory"); SBAR();
#define PK(k) (bf16x8){lo[k][0], lo[k][1], lo[k][2], lo[k][3], hi[k][0], hi[k][1], hi[k][2], hi[k][3]}
        o[d0] = __builtin_amdgcn_mfma_f32_32x32x16_bf16(pa0, PK(0), o[d0], 0, 0, 0);
        o[d0] = __builtin_amdgcn_mfma_f32_32x32x16_bf16(pa1, PK(1), o[d0], 0, 0, 0);
        o[d0] = __builtin_amdgcn_mfma_f32_32x32x16_bf16(pa2, PK(2), o[d0], 0, 0, 0);
        o[d0] = __builtin_amdgcn_mfma_f32_32x32x16_bf16(pa3, PK(3), o[d0], 0, 0, 0);
#undef PK
    }
}
#define ATTN_STORE16(p, v) (*(u32x4*)(p) = (v))
template <int THRL> __device__ __forceinline__ void attn_unit(int b, int h, int qb, const bf16* Q, const bf16* __restrict__ K, const bf16* __restrict__ V, bf16* O, const unsigned* masks, char* shm) {
    const int tid = threadIdx.x, lane = tid & 63, r32 = lane & 31, hi = lane >> 5; const int wid = __builtin_amdgcn_readfirstlane(tid >> 6);
    const long rowbase = (long)b * SEQ; const int q0 = qb * QB;
    const bf16* Qw = Q + (rowbase + q0 + wid * QBLK) * QP + h * D;
    const bf16 *Kh = K + rowbase * KP + (h >> 2) * D, *Vh = V + rowbase * KP + (h >> 2) * D;
    const unsigned* mrow = masks + ((size_t)(b * (SEQ / 32) + (q0 >> 5) + wid) * (SEQ / 64)) * 64;
    const unsigned lds0 = (unsigned)(uintptr_t)shm;
    float* wsf = (float*)(shm + LDS_WS) + wid * 64;
    const bf16* ksrc = Kh + (long)lane * KP + wid * 8;
    const bf16* vsrc = Vh + (long)(16 * (wid & 3) + (lane >> 2)) * KP + (wid >> 2) * 32 + (lane & 3) * 8;
    const unsigned kdst = lds0 + LDS_K + wid * 1024, vdst = lds0 + LDS_V + wid * 1024;
#define DMA_K(t, slot) glds16(ksrc + (long)(t) * KVBLK * KP, (unsigned)__builtin_amdgcn_readfirstlane(kdst + (slot)))
#define DMA_V(t, slot) glds16(vsrc + (long)(t) * KVBLK * KP, (unsigned)__builtin_amdgcn_readfirstlane(vdst + (slot)))
    const int vb0 = (int)(lds0 + LDS_V) + ((lane >> 4) & 1) * 32 + (lane & 3) * 8 + (4 * hi + ((lane & 15) >> 2)) * 64;
    const char* Kbase = shm + LDS_K; bf16x8 kf[8];
    const lds_cptr shm3 = (lds_cptr)shm; const lds_cptr kp0 = shm3 + LDS_K + hi * 1024 + r32 * 16; const lds_cptr vp0 = shm3 + LDS_V + ((lane >> 4) & 1) * 32 + (lane & 3) * 8 + (4 * hi + ((lane & 15) >> 2)) * 64;
    const int NT = (q0 + QB) / KVBLK;
    u32x16 mA, mB;
#define MLOAD0(t) do { const unsigned* mp_ = mrow + (size_t)(t) * 64; \
        asm volatile("s_load_dwordx16 %0, %1, 0x0" : "=s"(mA) : "s"(mp_)); asm volatile("s_load_dwordx16 %0, %1, 0x40" : "=s"(mB) : "s"(mp_)); } while (0)
#define MLOAD1(t) do { const unsigned* mp_ = mrow + (size_t)(t) * 64; \
        asm volatile("s_load_dwordx16 %0, %1, 0x80" : "=s"(mA) : "s"(mp_)); asm volatile("s_load_dwordx16 %0, %1, 0xc0" : "=s"(mB) : "s"(mp_)); } while (0)
#define MPAIR(M, j) (((unsigned long long)(M)[2 * (j) + 1] << 32) | (unsigned long long)(M)[2 * (j)])
#define MAPPLY(P) do { asm volatile("s_waitcnt lgkmcnt(0)" : "+s"(mA), "+s"(mB)); const float NEG_ = -INFINITY; \
        _Pragma("unroll") for (int r = 0; r < 8; ++r) { P[r] = msel(P[r], NEG_, MPAIR(mA, r)); P[r + 8] = msel(P[r + 8], NEG_, MPAIR(mB, r)); } } while (0)
    DMA_K(0, 0); DMA_V(0, 0); DMA_K(1, SLOTB);
    MLOAD0(0);
    const lds_cptr qfp = shm3 + LDS_QF + wid * 4096 + lane * 16;
    { bf16x8 qr[4];
#pragma unroll
      for (int d0 = 0; d0 < 4; ++d0) qr[d0] = *reinterpret_cast<const bf16x8*>(&Qw[(long)r32 * QP + d0 * 16 + hi * 8]);
#pragma unroll
      for (int d0 = 0; d0 < 4; ++d0) *(LAS bf16x8*)(LAS char*)(qfp + d0 * 1024) = qr[d0]; }
#define QF(i) (*(const LAS bf16x8*)(qfp + (i) * 1024))
    float mhat = 0.f, l_reg = 0.f; f32x16 o[2]; o[0] = f32x16{}; o[1] = f32x16{}; f32x16 negm = f32x16{}; asm volatile("" : "+v"(negm));
    const int qrel = wid * QBLK + r32;
#define CMASK(P0, P1, t) do { int jb_ = (t) - (NT - 4); if (jb_ >= 0) cmask(P0, P1, jb_, qrel, hi); } while (0)
    bool resc = false;
#define START(P0, P1) do { const float rm = rowmax(P0, P1); resc = false; \
    { const float dl = rm; mhat = fadd_s(mhat, dl); \
      _Pragma("unroll") for (int r = 0; r < 16; ++r) { P0[r] = fsub_s(P0[r], dl); P1[r] = fsub_s(P1[r], dl); } \
      _Pragma("unroll") for (int r = 0; r < 16; ++r) negm[r] = -mhat; asm volatile("" : "+v"(negm)); } } while (0)
#define RESC() do { if (resc) { asm volatile("s_waitcnt lgkmcnt(0)" ::: "memory"); \
      _Pragma("unroll") for (int d_ = 0; d_ < 2; ++d_) _Pragma("unroll") for (int r = 0; r < 16; ++r) o[d_][r] *= wsf[crow(r, hi)]; } } while (0)
    f32x16 pA0, pA1, pB0, pB1;
    int sl_prev = 0, sl_cur = 0, sl_next = SLOTB;
#define ROT() do { sl_prev = sl_cur; sl_cur = sl_next; sl_next = (sl_next == (NSLOT - 1) * SLOTB) ? 0 : sl_next + SLOTB; } while (0)
    DMA_K(2, 2 * SLOTB);
    WAIT_BAR(3);
    qkt(pA0, pA1, Kbase, qfp, negm, r32, hi); asm volatile("s_nop 15\n\ts_nop 7" : "+v"(pA0), "+v"(pA1)); CMASK(pA0, pA1, 0);
    START(pA0, pA1);
    MAPPLY(pA0); MLOAD1(0); MAPPLY(pA1); MLOAD0(1);
    _Pragma("unroll") for (int r = 0; r < 16; ++r) { pA0[r] = __builtin_amdgcn_exp2f(pA0[r]); pA1[r] = __builtin_amdgcn_exp2f(pA1[r]); }
    WAIT_BAR(0);
    DMA_K(3, 0); DMA_V(1, SLOTB);
    ROT();
    kload8(kf, kp0 + sl_cur);
    WAIT_BAR(2);
    s16x4 vlo[8], vhi[8]; u32x4 pw0, pw1, pw2, pw3;
#define PKW(P, B) cvtpk_s(P[B], P[B + 1])
#define PAF(k) __builtin_bit_cast(bf16x8, pw##k)
#define VFR(i) (bf16x8){vlo[i][0], vlo[i][1], vlo[i][2], vlo[i][3], vhi[i][0], vhi[i][1], vhi[i][2], vhi[i][3]}
#define PIN(x) asm volatile("" : "+v"(x))
#define MX3(a, b, c) __builtin_fmaxf(__builtin_fmaxf((a), (b)), (c))
#define GAPA(MF, A0, A1, A2, A3, W0, W1, PW) do { MF; sacc += A0; sacc += A1; sacc += A2; sacc += A3; PIN(sacc); W0; W1; PIN(PW); SBAR(); } while (0)
#define EX(v) __builtin_amdgcn_exp2f(v)
#define GAPB(MF, X, B) do { MF; X[B] = EX(X[B]); X[B + 1] = EX(X[B + 1]); X[B + 2] = EX(X[B + 2]); X[B + 3] = EX(X[B + 3]); PIN(X); SBAR(); } while (0)
#define VRD(i) do { vlo[i] = vtr(vp_ + (((i) >> 2) * 4096 + ((i) & 3) * 1024)); vhi[i] = vtr(vp_ + (((i) >> 2) * 4096 + ((i) & 3) * 1024 + 512)); } while (0)
#define KRD(G, j) do { if (G) { kload2(kf, kp0 + sl_next, j); SBAR(); } } while (0)
#define STEP(C0, C1, P0, P1, t, GK, GV, GL, GM) do { SBAR(); \
    const lds_cptr vp_ = vp0 + sl_prev; \
    VRD(0); bf16x8 qa_ = QF(0), qb_ = QF(1); SBAR(); float sacc = (P0[0] + P0[1]); \
    GAPA(C0 = __builtin_amdgcn_mfma_f32_32x32x16_bf16(kf[0], qa_, negm, 0, 0, 0), P0[2], P0[3], P0[4], P0[5],     pw0[0] = PKW(P0, 0), pw0[1] = PKW(P0, 2), pw0); \
    VRD(4); SBAR(); GAPA(C1 = __builtin_amdgcn_mfma_f32_32x32x16_bf16(kf[1], qa_, negm, 0, 0, 0), P0[6], P0[7], P0[8], P0[9],     pw0[2] = PKW(P0, 4), pw0[3] = PKW(P0, 6), pw0); \
    VRD(1); qa_ = QF(2); SBAR(); GAPA(C0 = __builtin_amdgcn_mfma_f32_32x32x16_bf16(kf[2], qb_, C0, 0, 0, 0),   P0[10], P0[11], P0[12], P0[13], pw1[0] = PKW(P0, 8), pw1[1] = PKW(P0, 10), pw1); \
    VRD(5); SBAR(); GAPA(C1 = __builtin_amdgcn_mfma_f32_32x32x16_bf16(kf[3], qb_, C1, 0, 0, 0),   P0[14], P0[15], P1[0], P1[1],   pw1[2] = PKW(P0, 12), pw1[3] = PKW(P0, 14), pw1); \
    VRD(2); qb_ = QF(3); SBAR(); GAPA(C0 = __builtin_amdgcn_mfma_f32_32x32x16_bf16(kf[4], qa_, C0, 0, 0, 0),   P1[2], P1[3], P1[4], P1[5],     pw2[0] = PKW(P1, 0), pw2[1] = PKW(P1, 2), pw2); \
    VRD(6); SBAR(); GAPA(C1 = __builtin_amdgcn_mfma_f32_32x32x16_bf16(kf[5], qa_, C1, 0, 0, 0),   P1[6], P1[7], P1[8], P1[9],     pw2[2] = PKW(P1, 4), pw2[3] = PKW(P1, 6), pw2); \
    VRD(3); SBAR(); GAPA(C0 = __builtin_amdgcn_mfma_f32_32x32x16_bf16(kf[6], qb_, C0, 0, 0, 0),   P1[10], P1[11], P1[12], P1[13], pw3[0] = PKW(P1, 8), pw3[1] = PKW(P1, 10), pw3); \
    VRD(7); SBAR(); GAPA(C1 = __builtin_amdgcn_mfma_f32_32x32x16_bf16(kf[7], qb_, C1, 0, 0, 0),   P1[14], P1[15], 0.f, 0.f,       pw3[2] = PKW(P1, 12), pw3[3] = PKW(P1, 14), pw3); \
    l_reg += sacc; \
    if (GK) { DMA_K((t) + 3, sl_cur); } if (GV) { DMA_V((t) + 1, sl_next); } \
    CMASK(C0, C1, t); \
    { float a = MX3(C0[0], C0[1], C1[0]), b = MX3(C0[2], C0[3], C1[1]); a = MX3(a, C1[2], C1[3]); \
      _Pragma("unroll") for (int r = 4; r < 16; r += 4) { a = MX3(a, C0[r], C0[r + 1]); b = MX3(b, C0[r + 2], C0[r + 3]); a = MX3(a, C1[r], C1[r + 1]); b = MX3(b, C1[r + 2], C1[r + 3]); } \
      float rm = __builtin_fmaxf(a, b); { auto rr = __builtin_amdgcn_permlane32_swap(__float_as_uint(rm), __float_as_uint(rm), false, false); rm = __builtin_fmaxf(__uint_as_float(rr[0]), __uint_as_float(rr[1])); } \
      resc = false; \
      if (__builtin_expect(__any(rm > (float)THRL), 0)) { const float dl = __builtin_fmaxf(rm, 0.f); mhat += dl; \
        _Pragma("unroll") for (int r = 0; r < 16; ++r) { C0[r] -= dl; C1[r] -= dl; } \
        _Pragma("unroll") for (int r = 0; r < 16; ++r) negm[r] = -mhat; asm volatile("" : "+v"(negm)); \
        const float f = __builtin_amdgcn_exp2f(-dl); l_reg *= f; if (hi == 0) wsf[r32] = f; resc = true; } } \
    MAPPLY(C0); MLOAD1(t); \
    SBAR(); \
    GAPB(o[0] = __builtin_amdgcn_mfma_f32_32x32x16_bf16(PAF(0), VFR(0), o[0], 0, 0, 0), C0, 0); \
    GAPB(o[1] = __builtin_amdgcn_mfma_f32_32x32x16_bf16(PAF(0), VFR(4), o[1], 0, 0, 0), C0, 4); \
    KRD(GL, 0); GAPB(o[0] = __builtin_amdgcn_mfma_f32_32x32x16_bf16(PAF(1), VFR(1), o[0], 0, 0, 0), C0, 8); \
    KRD(GL, 1); GAPB(o[1] = __builtin_amdgcn_mfma_f32_32x32x16_bf16(PAF(1), VFR(5), o[1], 0, 0, 0), C0, 12); \
    MAPPLY(C1); if (GM) { MLOAD0((t) + 1); } SBAR(); \
    KRD(GL, 2); GAPB(o[0] = __builtin_amdgcn_mfma_f32_32x32x16_bf16(PAF(2), VFR(2), o[0], 0, 0, 0), C1, 0); \
    KRD(GL, 3); GAPB(o[1] = __builtin_amdgcn_mfma_f32_32x32x16_bf16(PAF(2), VFR(6), o[1], 0, 0, 0), C1, 4); \
    GAPB(o[0] = __builtin_amdgcn_mfma_f32_32x32x16_bf16(PAF(3), VFR(3), o[0], 0, 0, 0), C1, 8); \
    GAPB(o[1] = __builtin_amdgcn_mfma_f32_32x32x16_bf16(PAF(3), VFR(7), o[1], 0, 0, 0), C1, 12); \
    } while (0)
    int t = 1;
#undef CMASK
#define CMASK(P0, P1, t) do { } while (0)
    for (; t + 5 < NT; t += 2) {
        STEP(pB0, pB1, pA0, pA1, t, true, true, true, true);     WAIT_BAR(2); RESC(); ROT();
        STEP(pA0, pA1, pB0, pB1, t + 1, true, true, true, true); WAIT_BAR(2); RESC(); ROT();
    }
#undef CMASK
#define CMASK(P0, P1, t) do { int jb_ = (t) - (NT - 4); if (jb_ >= 0) cmask(P0, P1, jb_, qrel, hi); } while (0)
#define ENDW(tt) do { if ((tt) + 3 < NT) { WAIT_BAR(2); } else if ((tt) + 2 < NT) { WAIT_BAR(1); } else { WAIT_BAR(0); } } while (0)
    for (; t + 1 < NT; t += 2) {
        STEP(pB0, pB1, pA0, pA1, t, (t + 3 < NT), (t + 1 < NT), (t + 1 < NT), (t + 1 < NT));         ENDW(t);     RESC(); ROT();
        STEP(pA0, pA1, pB0, pB1, t + 1, (t + 4 < NT), (t + 2 < NT), (t + 2 < NT), (t + 2 < NT));     ENDW(t + 1); RESC(); ROT();
    }
    STEP(pB0, pB1, pA0, pA1, NT - 1, false, false, false, false); RESC();
    { float sacc = pB0[0] + pB0[1]; _Pragma("unroll") for (int r = 2; r < 16; ++r) sacc += pB0[r]; _Pragma("unroll") for (int r = 0; r < 16; ++r) sacc += pB1[r]; l_reg += sacc;
      pw0 = (u32x4){PKW(pB0, 0), PKW(pB0, 2), PKW(pB0, 4), PKW(pB0, 6)}; pw1 = (u32x4){PKW(pB0, 8), PKW(pB0, 10), PKW(pB0, 12), PKW(pB0, 14)}; pw2 = (u32x4){PKW(pB1, 0), PKW(pB1, 2), PKW(pB1, 4), PKW(pB1, 6)}; pw3 = (u32x4){PKW(pB1, 8), PKW(pB1, 10), PKW(pB1, 12), PKW(pB1, 14)};
      SBAR(); pv(o, vb0 + sl_cur, PAF(0), PAF(1), PAF(2), PAF(3)); }
#undef PKW
#undef PAF
#undef VFR
#undef PIN
#undef MX3
#undef GAPA
#undef GAPB
#undef EX
#undef VRD
#undef KRD
#undef STEP
#undef ENDW
    { auto rr = __builtin_amdgcn_permlane32_swap(__float_as_uint(l_reg), __float_as_uint(l_reg), false, false); l_reg = __uint_as_float(rr[0]) + __uint_as_float(rr[1]); }
    if (hi == 0) wsf[32 + r32] = l_reg; asm volatile("s_waitcnt lgkmcnt(0)" ::: "memory");
    float rli[16];
#pragma unroll
    for (int r = 0; r < 16; ++r) rli[r] = __builtin_amdgcn_rcpf(wsf[32 + crow(r, hi)]);
    bf16* Ow = O + (rowbase + q0 + wid * QBLK) * OP + OCOL + h * D;
    { bf16* stg = (bf16*)(shm + LDS_OST) + wid * 2048;
#pragma unroll
      for (int r = 0; r < 16; ++r) { const int orow = crow(r, hi);
#pragma unroll
        for (int d0 = 0; d0 < 2; ++d0) stg[orow * 64 + d0 * 32 + r32] = __float2bfloat16(o[d0][r] * rli[r]); }
      asm volatile("s_waitcnt lgkmcnt(0)" ::: "memory");
#pragma unroll
      for (int i = 0; i < 4; ++i) { const int row = i * 8 + (lane >> 3), ch = lane & 7; const u32x4 v = *(const u32x4*)(stg + row * 64 + ch * 8); ATTN_STORE16(Ow + (long)row * OP + ch * 8, v); } }
    asm volatile("s_waitcnt lgkmcnt(0)\n\ts_barrier" ::: "memory");
#undef DMA_K
#undef DMA_V
#undef CMASK
#undef START
#undef RESC
#undef ROT
#undef MLOAD0
#undef MLOAD1
#undef MPAIR
#undef QF
#undef MAPPLY
}
#undef SBAR
#undef WAIT_BAR
}

#define XB_TMO      128
#define XB_XCNT(j)  (256  + 64 * (j))
#define XB_XSUB(j)  (1280 + 64 * (j))
#define XB_XGEN(j)  (2304 + 64 * (j))
#define XB_TOP      3328
#define XB_TOPGEN   3392
#define XCD_BAR_WORDS 3456
#define XB_SPIN_CAP (1u << 18)
__device__ __forceinline__ unsigned xb_ld(unsigned* p)              { return __hip_atomic_load(p, __ATOMIC_RELAXED, __HIP_MEMORY_SCOPE_AGENT); }
__device__ __forceinline__ unsigned xb_add(unsigned* p, unsigned v) { return __hip_atomic_fetch_add(p, v, __ATOMIC_RELAXED, __HIP_MEMORY_SCOPE_AGENT); }
__device__ __forceinline__ unsigned xb_xcc_id() { return (unsigned)__builtin_amdgcn_s_getreg((3 << 11) | 20) & 0xFu; }
#define XB_SPIN(cond, bar) do { unsigned _sp = 0; while (cond) { __builtin_amdgcn_s_sleep(1); \
    if ((++_sp & 255u) == 0u) { if (xb_ld(&(bar)[XB_TMO])) break; if (_sp > XB_SPIN_CAP) { atomicAdd(&(bar)[XB_TMO], 1u); break; } } } } while (0)
struct XcdBarrier { unsigned* bar; unsigned x; volatile LAS unsigned* st; };
__device__ __forceinline__ XcdBarrier xcd_barrier_post(unsigned* bar, volatile LAS unsigned* st) {
    XcdBarrier b; b.bar = bar; b.x = xb_xcc_id(); b.st = st;
    if (threadIdx.x == 0) (void)xb_add(&bar[XB_XCNT(b.x)], 1u);
    return b;
}
__device__ __forceinline__ void xcd_barrier_complete(unsigned* bar, unsigned x, unsigned& nloc, unsigned& nx) {
    const unsigned G = gridDim.x * gridDim.y * gridDim.z;
    unsigned sum, cnt, mine, sp = 0u;
    for (;;) {
        sum = 0u; cnt = 0u; mine = 0u;
#pragma unroll
        for (unsigned j = 0; j < 16; ++j) { const unsigned c = xb_ld(&bar[XB_XCNT(j)]); sum += c; cnt += (c > 0u) ? 1u : 0u; mine = (j == x) ? c : mine; }
        if (sum == G) break;
        __builtin_amdgcn_s_sleep(1);
        if ((++sp & 255u) == 0u) { if (xb_ld(&bar[XB_TMO])) break; if (sp > XB_SPIN_CAP) { atomicAdd(&bar[XB_TMO], 1u); break; } }
    }
    nloc = mine > 0u ? mine : 1u; nx = cnt > 0u ? cnt : 1u;
}
__device__ __forceinline__ void xcd_barrier(const XcdBarrier& b) {
    asm volatile("s_waitcnt vmcnt(0)" ::: "memory");
    __syncthreads();
    if (threadIdx.x == 0) {
        unsigned* bar = b.bar;
        __builtin_amdgcn_s_waitcnt(0);
        unsigned nloc = b.st[0], nx = b.st[1];
        if (nloc == 0u) { xcd_barrier_complete(bar, b.x, nloc, nx); b.st[0] = nloc; b.st[1] = nx; }
        const unsigned old = xb_add(&bar[XB_XSUB(b.x)], 1u);
        const unsigned gen = old / nloc;
        if (old + 1u == (gen + 1u) * nloc) {
            __builtin_amdgcn_fence(__ATOMIC_RELEASE, "agent");
            asm volatile("s_waitcnt vmcnt(0)" ::: "memory");
            const unsigned og = xb_add(&bar[XB_TOP], 1u);
            const unsigned tg = og / nx;
            if (og + 1u == (tg + 1u) * nx) xb_add(&bar[XB_TOPGEN], 1u);
            else XB_SPIN(xb_ld(&bar[XB_TOPGEN]) == tg, bar);
            __builtin_amdgcn_fence(__ATOMIC_ACQUIRE, "agent");
            xb_add(&bar[XB_XGEN(b.x)], 1u);
            asm volatile("s_waitcnt vmcnt(0)" ::: "memory");
        } else {
            XB_SPIN(xb_ld(&bar[XB_XGEN(b.x)]) == gen, bar);
            __builtin_amdgcn_fence(__ATOMIC_ACQUIRE, "agent");
            asm volatile("s_waitcnt vmcnt(0)" ::: "memory");
        }
    }
    __syncthreads();
}

struct Frame {
    LAS unsigned char* lds; volatile LAS unsigned* MISC; unsigned* ctl;
    int tid, lane, wave, vcu, G;
    unsigned char* ws;
};
struct Args { const float* in[18]; float* out; unsigned char* ws; int ph_lo, ph_hi, flags, pad; };
typedef const __attribute__((address_space(4))) Args* KArgs;
__device__ __forceinline__ KArgs kargs() { KArgs p = (KArgs)__builtin_amdgcn_kernarg_segment_ptr(); asm volatile("" : "+s"(p)); return p; }

__device__ __forceinline__ int ropeperm(int d) { return d < 8 ? 2 * d : (d < 16 ? 2 * (d - 8) + 1 : d); }
__device__ __forceinline__ int win_row(int c) {
    if (c < 512)  return (c & ~63) + ropeperm(c & 63);
    if (c < 640)  { const int cc = c - 512; return 512 + (cc & ~63) + ropeperm(cc & 63); }
    if (c < 768)  return c;
    if (c < 1280) { const int cc = c - 768; return 768 + (cc & ~63) + ropeperm(cc & 63); }
    if (c < 1344) return 1280 + ropeperm(c - 1280);
    if (c < 1352) return c;
    if (c < 1864) { const int ch = c - 1352; return 1536 + (ch >> 7) * 256 + (ch & 127); }
    if (c < 2376) return 2560 + (c - 1864);
    if (c < 2888) { const int ch = c - 2376; return 1536 + (ch >> 7) * 256 + 128 + (ch & 127); }
    { const int g = c - 2888, gi = g & 1023; return 3072 + (gi >> 7) * 256 + (g >> 10) * 128 + (gi & 127); }
}
struct TItem { const float* src; bf16_t* WT; int N, KT, rbase, mode, n0, k0, kd; };
__device__ __forceinline__ void t_load(const TItem& t, float (&rg)[32], int lane) {
    int nn = t.n0 + (lane & 31); if (nn >= t.N) nn = t.N - 1;
    const float* p = t.src + (size_t)(t.k0 + (lane >> 5)) * t.N + nn;
#pragma unroll
    for (int i = 0; i < 32; ++i) rg[i] = __builtin_nontemporal_load(p + (size_t)(2 * i) * t.N);
}
__device__ __forceinline__ void t_write(const TItem& t, const float (&rg)[32], LAS float* scr, int lane) {
#pragma unroll
    for (int i = 0; i < 32; ++i) scr[(2 * i + (lane >> 5)) * 33 + (lane & 31)] = rg[i];
    LDS_WAIT(); asm volatile("" ::: "memory");
    if (t.mode >= 3) {
        const int c4 = lane & 3;
#pragma unroll
        for (int j = 0; j < 2; ++j) { const int n = (lane >> 2) + 16 * j; const LAS float* sp = scr + (16 * c4) * 33 + n;
            if (t.n0 + n < t.N) { const int nn = t.n0 + n; const int row = t.mode == 3 ? t.rbase + (nn >> 7) * 256 + (nn & 127) : t.rbase + nn;
                u32x4 o;
#pragma unroll
                for (int q = 0; q < 4; ++q) { int wv = 0;
                    wv = __builtin_amdgcn_cvt_pk_fp8_f32(32.f * sp[(4 * q + 0) * 33], 32.f * sp[(4 * q + 1) * 33], wv, false);
                    wv = __builtin_amdgcn_cvt_pk_fp8_f32(32.f * sp[(4 * q + 2) * 33], 32.f * sp[(4 * q + 3) * 33], wv, true); o[q] = (unsigned)wv; }
                *(u32x4*)((unsigned char*)t.WT + (size_t)row * t.KT + t.k0 + 16 * c4) = o; } }
        LDS_WAIT(); asm volatile("" ::: "memory");
        return;
    }
    const int c = lane & 7;
#pragma unroll
    for (int j = 0; j < 4; ++j) { const int n = (lane >> 3) + 8 * j; const LAS float* sp = scr + (8 * c) * 33 + n;
        if (t.n0 + n < t.N) { const int nn = t.n0 + n; const int row = t.mode == 0 ? t.rbase + nn : (t.mode == 1 ? win_row(nn) : t.rbase + (nn >> 7) * 256 + (nn & 127));
            u32x4 o; o.x = pkbf(sp[0 * 33], sp[1 * 33]); o.y = pkbf(sp[2 * 33], sp[3 * 33]); o.z = pkbf(sp[4 * 33], sp[5 * 33]); o.w = pkbf(sp[6 * 33], sp[7 * 33]);
            *(u32x4*)(t.WT + (size_t)row * t.KT + t.kd + t.k0 + 8 * c) = o; } }
    LDS_WAIT(); asm volatile("" ::: "memory");
}
__device__ __forceinline__ void p0_prologue(Frame& F) {
    const KArgs ka = kargs();
    unsigned char* ws = F.ws;
    LAS float* scr = (LAS float*)(F.lds + F.wave * 16384);
    const int gw = F.vcu * NWAVES + F.wave, NGW = F.G * NWAVES;
    const int gt = F.vcu * 512 + F.tid, NGT = F.G * 512;
    bf16_t* Win = (bf16_t*)(ws + WS_WIN); bf16_t* Wau = (bf16_t*)(ws + WS_WAU); bf16_t* Wout = (bf16_t*)(ws + WS_WOUT);
    bf16_t* Wd = (bf16_t*)(ws + WS_WD); bf16_t* Wgu = (bf16_t*)(ws + WS_WGU);
    constexpr int I_IN = 16 * 155, I_AU = 8 * 32, I_OUT = 16 * 32, I_G = 32 * 16 * 16, I_D = 32 * 8 * 32;
    constexpr int NITEMS = I_IN + 2 * I_AU + I_OUT + 2 * I_G + I_D;
    const float *p_win = ka->in[1], *p_wau = ka->in[3], *p_wcu = ka->in[4], *p_wout = ka->in[6], *p_wg = ka->in[13], *p_wu = ka->in[14], *p_wd = ka->in[15];
#define T_DECODE(IT, T) do { int r_ = (IT); \
        if (r_ < I_IN) { T = TItem{p_win, Win, INW, 1024, 0, 1, 32 * (r_ % 155), 64 * (r_ / 155), 0}; } else { r_ -= I_IN; \
        if (r_ < I_AU) { T = TItem{p_wau, Wau, 1024, 1024, 0, 0, 32 * (r_ % 32), 64 * (r_ / 32), 512};     } else { r_ -= I_AU; \
        if (r_ < I_AU) { T = TItem{p_wcu, Wau, 1024, 1024, 0, 0, 32 * (r_ % 32), 64 * (r_ / 32), 0}; } else { r_ -= I_AU; \
        if (r_ < I_OUT) { T = TItem{p_wout, Wout, 1024, 1024, 0, 0, 32 * (r_ % 32), 64 * (r_ / 32), 0}; } else { r_ -= I_OUT; \
        if (r_ < I_G) { const int e_ = r_ >> 8, q_ = r_ & 255; T = TItem{p_wg + (size_t)e_ * 1024 * 512, Wgu, 512, 1024, e_ * 1024, 3, 32 * (q_ & 15), 64 * (q_ >> 4), 0}; } else { r_ -= I_G; \
        if (r_ < I_G) { const int e_ = r_ >> 8, q_ = r_ & 255; T = TItem{p_wu + (size_t)e_ * 1024 * 512, Wgu, 512, 1024, e_ * 1024 + 128, 3, 32 * (q_ & 15), 64 * (q_ >> 4), 0}; } else { r_ -= I_G; \
        { const int e_ = r_ >> 8, q_ = r_ & 255; T = TItem{p_wd + (size_t)e_ * 512 * 1024, Wd, 1024, 512, e_ * 1024, 4, 32 * (q_ & 31), 64 * (q_ >> 5), 0}; } } } } } } } } while (0)
    const int nitems = (F.G == 256) ? I_IN + 2 * I_AU + I_OUT : NITEMS;
    if (gw < nitems) {
        TItem cur, nxt; float rc[32], rn[32];
        T_DECODE(gw, cur); t_load(cur, rc, F.lane);
        for (int it = gw; it < nitems; it += NGW) {
            const int itn = (it + NGW < nitems) ? it + NGW : it;
            T_DECODE(itn, nxt); t_load(nxt, rn, F.lane);
            t_write(cur, rc, scr, F.lane);
            cur = nxt;
#pragma unroll
            for (int i = 0; i < 32; ++i) rc[i] = rn[i];
        }
    }
#undef T_DECODE
    for (int i = gt; i < 184 * 128; i += NGT) *(u32x4*)(Win + (size_t)1352 * 1024 + (size_t)i * 8) = (u32x4){0u, 0u, 0u, 0u};
    float* rope = (float*)(ws + WS_ROPE);
    for (int i = gt; i < SEQ * 8; i += NGT) { const int pos = i >> 3, j = i & 7;
        const float inv = (float)pow(500000.0, -(double)j / 8.0); const float ang = (float)pos * inv;
        rope[i] = cosf(ang); rope[SEQ * 8 + i] = sinf(ang); }
    { float* wc = (float*)(ws + WS_WC); const float* rgw = ka->in[9]; const float* rew = ka->in[11];
      for (int i = gt; i < 1024 * 48; i += NGT) { const int k = i / 48, c = i % 48;
          wc[i] = c < 4 ? rgw[k * 4 + c] : (c < 36 ? rew[(size_t)((c - 4) >> 3) * 1024 * 8 + k * 8 + ((c - 4) & 7)] : 0.f); } }
    const float* x = ka->in[0]; bf16_t* xb = (bf16_t*)(ws + WS_XB);
    for (size_t i = gt; i < (size_t)NTOK * DM / 8; i += (size_t)NGT * 4) {
        f32x4 va[4], vb[4];
#pragma unroll
        for (int q = 0; q < 4; ++q) { size_t ii = i + (size_t)q * NGT; if (ii >= (size_t)NTOK * DM / 8) ii = i; va[q] = __builtin_nontemporal_load((const f32x4*)(x + ii * 8)); vb[q] = __builtin_nontemporal_load((const f32x4*)(x + ii * 8 + 4)); }
#pragma unroll
        for (int q = 0; q < 4; ++q) { const size_t ii = i + (size_t)q * NGT; if (ii < (size_t)NTOK * DM / 8) store8bf(xb + ii * 8, va[q], vb[q]); } }
}

__device__ __forceinline__ int dpp_sum_i(int v) {
    v += __builtin_amdgcn_update_dpp(0, v, 0x111, 0xf, 0xf, true); v += __builtin_amdgcn_update_dpp(0, v, 0x112, 0xf, 0xf, true);
    v += __builtin_amdgcn_update_dpp(0, v, 0x114, 0xf, 0xf, true); v += __builtin_amdgcn_update_dpp(0, v, 0x118, 0xf, 0xf, true);
    return __builtin_amdgcn_readlane(v, 15) + __builtin_amdgcn_readlane(v, 31) + __builtin_amdgcn_readlane(v, 47) + __builtin_amdgcn_readlane(v, 63);
}
__device__ __forceinline__ float dpp_shr_f(float v, int ctrl_sel) {
    const int vi = __float_as_int(v);
    return __int_as_float(ctrl_sel == 1 ? __builtin_amdgcn_update_dpp(vi, vi, 0x111, 0xf, 0xf, false) : ctrl_sel == 2 ? __builtin_amdgcn_update_dpp(vi, vi, 0x112, 0xf, 0xf, false)
                        : ctrl_sel == 4 ? __builtin_amdgcn_update_dpp(vi, vi, 0x114, 0xf, 0xf, false) : __builtin_amdgcn_update_dpp(vi, vi, 0x118, 0xf, 0xf, false));
}
__device__ __forceinline__ float dpp_max_f(float v) {
    v = fmaxf(v, dpp_shr_f(v, 1)); v = fmaxf(v, dpp_shr_f(v, 2)); v = fmaxf(v, dpp_shr_f(v, 4)); v = fmaxf(v, dpp_shr_f(v, 8));
    const float a = __int_as_float(__builtin_amdgcn_readlane(__float_as_int(v), 15)), b = __int_as_float(__builtin_amdgcn_readlane(__float_as_int(v), 31));
    const float c = __int_as_float(__builtin_amdgcn_readlane(__float_as_int(v), 47)), d = __int_as_float(__builtin_amdgcn_readlane(__float_as_int(v), 63));
    return fmaxf(fmaxf(a, b), fmaxf(c, d));
}
__device__ __forceinline__ float dpp_min_f(float v) { return -dpp_max_f(-v); }
__device__ __forceinline__ float dpp_sum_f(float v) {
    v += __int_as_float(__builtin_amdgcn_update_dpp(0, __float_as_int(v), 0x111, 0xf, 0xf, true)); v += __int_as_float(__builtin_amdgcn_update_dpp(0, __float_as_int(v), 0x112, 0xf, 0xf, true));
    v += __int_as_float(__builtin_amdgcn_update_dpp(0, __float_as_int(v), 0x114, 0xf, 0xf, true)); v += __int_as_float(__builtin_amdgcn_update_dpp(0, __float_as_int(v), 0x118, 0xf, 0xf, true));
    const float a = __int_as_float(__builtin_amdgcn_readlane(__float_as_int(v), 15)), b = __int_as_float(__builtin_amdgcn_readlane(__float_as_int(v), 31));
    const float c = __int_as_float(__builtin_amdgcn_readlane(__float_as_int(v), 47)), d = __int_as_float(__builtin_amdgcn_readlane(__float_as_int(v), 63));
    return (a + b) + (c + d);
}
template <int NC>
__device__ __forceinline__ void select_token(const LAS float* srow, int t, int lane, unsigned tbit, LAS unsigned* maskw) {
    if (t < 256) {
#pragma unroll
        for (int c = 0; c < (NC < 4 ? NC : 4); ++c) if (64 * c + lane <= t) (void)__hip_atomic_fetch_or(maskw + 64 * c + lane, tbit, __ATOMIC_RELAXED, __HIP_MEMORY_SCOPE_WORKGROUP);
        return;
    }
    float x[NC];
#pragma unroll
    for (int c = 0; c < NC; ++c) x[c] = srow[64 * c + lane];
#pragma unroll
    for (int c = 4; c < NC; ++c) if (64 * c + 63 > t) x[c] = (64 * c + lane <= t) ? x[c] : -INFINITY;
    float mn = fminf(fminf(x[0], x[1]), fminf(x[2], x[3])), mx = -INFINITY;
#pragma unroll
    for (int c = 0; c < NC; ++c) mx = fmaxf(mx, x[c]);
    mn = dpp_min_f(mn);
    float lo = mn - (fabsf(mn) * 1e-6f + 1e-30f), hi = dpp_max_f(mx);
    const float BIGF = 0x1p100f;
#define COUNT_GT(P, OUT) do { const float nb1_ = -(P) * BIGF; const f32x2 nb_ = {nb1_, nb1_}, bg_ = {BIGF, BIGF}; f32x2 a0_ = {0.f, 0.f}, a1_ = {0.f, 0.f}, a2_ = {0.f, 0.f}, a3_ = {0.f, 0.f}; \
        _Pragma("unroll") for (int c = 0; c < NC; c += 8) { f32x2 y_[4]; \
            _Pragma("unroll") for (int e = 0; e < 4; ++e) { const f32x2 xx_ = {x[c + 2 * e], x[c + 2 * e + 1]}; asm("v_pk_fma_f32 %0, %1, %2, %3 clamp" : "=v"(y_[e]) : "v"(xx_), "v"(bg_), "v"(nb_)); } \
            a0_ += y_[0]; a1_ += y_[1]; a2_ += y_[2]; a3_ += y_[3]; } \
        const f32x2 s2_ = (a0_ + a1_) + (a2_ + a3_); OUT = (int)(dpp_sum_f(s2_[0] + s2_[1]) + 0.5f); } while (0)
    float tau = hi; int need = 256; bool exact = false;
#ifndef PROBE_SEL
#define PROBE_SEL 0
#endif
    {
        float glo = (float)(t + 1) - 255.5f, ghi = -255.5f; int side = 0;
        for (int it = 0; it < 200; ++it) {
            float p = lo + (hi - lo) * (glo * __builtin_amdgcn_rcpf(glo - ghi));
            if (it >= 48 || !(p > lo) || !(p < hi)) p = lo + (hi - lo) * 0.5f;
            if (!(p > lo) || !(p < hi)) break;
            int cm; COUNT_GT(p, cm);
            if (cm == 256) { tau = p; exact = true; break; }
            if (cm > 256) { lo = p; glo = (float)cm - 255.5f; if (side < 0) ghi *= 0.5f; side = -1; }
            else { hi = p; ghi = (float)cm - 255.5f; if (side > 0) glo *= 0.5f; side = 1; }
        }
        if (!exact) { tau = hi; int g; COUNT_GT(hi, g); need = 256 - g; }
    }
#undef COUNT_GT
    if (exact) {
#pragma unroll
        for (int c = 0; c < NC; ++c) (void)__hip_atomic_fetch_or(maskw + 64 * c + lane, (x[c] > tau) ? tbit : 0u, __ATOMIC_RELAXED, __HIP_MEMORY_SCOPE_WORKGROUP);
    } else {
        int base = 0;
#pragma unroll
        for (int c = 0; c < NC; ++c) {
            const bool gt = x[c] > tau, eq = x[c] == tau;
            const unsigned long long tb = __ballot(eq);
            const int rank = base + (int)__builtin_amdgcn_mbcnt_hi((unsigned)(tb >> 32), __builtin_amdgcn_mbcnt_lo((unsigned)tb, 0u));
            base += __popcll(tb);
            if (gt || (eq && rank < need)) (void)__hip_atomic_fetch_or(maskw + 64 * c + lane, tbit, __ATOMIC_RELAXED, __HIP_MEMORY_SCOPE_WORKGROUP);
        }
    }
}
struct XItem { const float* src; unsigned char* dst; int N; };
__device__ __forceinline__ XItem x_decode(int id, int lane, const float* wg, const float* wu, const float* wd, unsigned char* Wgu8, unsigned char* Wd8) {
    const int m = id >> 13, r = id & 8191, e = r >> 8, q = r & 255; XItem t;
    if (m < 2) { const int kb = q >> 3, nb = q & 7, n = nb * 64 + lane;
        t.src = (m == 0 ? wg : wu) + (size_t)e * 1024 * 512 + (size_t)(kb * 32) * 512 + n; t.N = 512;
        t.dst = Wgu8 + (size_t)(e * 1024 + (n >> 7) * 256 + m * 128 + (n & 127)) * 1024 + kb * 32; }
    else { const int kb = q >> 4, nb = q & 15, n = nb * 64 + lane;
        t.src = wd + (size_t)e * 512 * 1024 + (size_t)(kb * 32) * 1024 + n; t.N = 1024;
        t.dst = Wd8 + (size_t)(e * 1024 + n) * 512 + kb * 32; }
    return t;
}
__device__ __forceinline__ void x_load(const XItem& t, float (&rg)[32]) {
#pragma unroll
    for (int i = 0; i < 32; ++i) rg[i] = __builtin_nontemporal_load(t.src + (size_t)i * t.N);
}
__device__ __forceinline__ void x_store(const XItem& t, float (&rg)[32]) {
#pragma unroll
    for (int i = 0; i < 32; ++i) asm volatile("" : "+v"(rg[i]));
    u32x4 o0, o1;
#pragma unroll
    for (int q = 0; q < 4; ++q) { int w0 = 0, w1 = 0;
        w0 = __builtin_amdgcn_cvt_pk_fp8_f32(32.f * rg[4 * q], 32.f * rg[4 * q + 1], w0, false); w0 = __builtin_amdgcn_cvt_pk_fp8_f32(32.f * rg[4 * q + 2], 32.f * rg[4 * q + 3], w0, true);
        w1 = __builtin_amdgcn_cvt_pk_fp8_f32(32.f * rg[16 + 4 * q], 32.f * rg[16 + 4 * q + 1], w1, false); w1 = __builtin_amdgcn_cvt_pk_fp8_f32(32.f * rg[16 + 4 * q + 2], 32.f * rg[16 + 4 * q + 3], w1, true);
        o0[q] = (unsigned)w0; o1[q] = (unsigned)w1; }
    *(u32x4*)t.dst = o0; *(u32x4*)(t.dst + 16) = o1;
}
__device__ __forceinline__ void score_select_unit(Frame& F, int b, int qt16, const bf16_t* qi, const bf16_t* ki, const float* wi, LAS float* scl, LAS unsigned* maskw, unsigned* masks, int xid0, int xid1) {
    const int lane = F.lane, wid = F.wave, r = lane & 31, h = lane >> 5;
    const int T0 = qt16 * 16; const size_t rowb = (size_t)b * SEQ;
    XItem xa, xb; float xr0[32], xr1[32];
    { const KArgs ka = kargs(); unsigned char* w8a = F.ws + WS_WGU; unsigned char* w8b = F.ws + WS_WD;
      xa = x_decode(xid0 >= 0 ? xid0 : 0, lane, ka->in[13], ka->in[14], ka->in[15], w8a, w8b); xb = x_decode(xid1 >= 0 ? xid1 : 0, lane, ka->in[13], ka->in[14], ka->in[15], w8a, w8b); }
    {
        LAS float* wtab = (LAS float*)(F.lds + TAB_OFF + 8192);
        if (F.tid < 128) wtab[F.tid] = wi[(rowb + T0) * 8 + F.tid] * WSCALE;
        bf16x8 a[4][4];
        const int tk = (r >> 4) + 2 * ((r >> 2) & 1), hd = (r & 3) + 4 * ((r >> 3) & 1);
        const int nsteps = ((T0 + 15) >> 8) + 1, kb0 = 32 * wid;
        const bf16_t* kp0 = ki + (rowb >> 5) * 2048 + (kb0 >> 5) * 2048 + r * 16 + h * 8;
        bf16x8 bfA[4], bfB[4];
#pragma unroll
        for (int kk = 0; kk < 4; ++kk) bfA[kk] = *(const bf16x8*)(kp0 + 512 * kk);
#pragma unroll
        for (int rb = 0; rb < 4; ++rb) {
            const bf16_t* qp = qi + (rowb + T0 + 4 * rb + tk) * 512 + hd * 64 + 8 * h;
#pragma unroll
            for (int kk = 0; kk < 4; ++kk) a[rb][kk] = *(const bf16x8*)(qp + 16 * kk);
        }
        LDS_WAIT(); __syncthreads();
        const LAS float* wl = wtab + 16 * h;
#define SCORE_STEP(KS, BF) do { const int kb_ = 256 * (KS) + kb0; if (kb_ <= T0 + 15) { \
            _Pragma("unroll") for (int rb = 0; rb < 4; ++rb) { \
                f32x16 acc = f32x16{}; \
                _Pragma("unroll") for (int kk = 0; kk < 4; ++kk) acc = __builtin_amdgcn_mfma_f32_32x32x16_bf16(a[rb][kk], BF[kk], acc, 0, 0, 0); \
                const f32x4 w0_ = *(const LAS f32x4*)(wl + 32 * rb), w1_ = *(const LAS f32x4*)(wl + 32 * rb + 4), w2_ = *(const LAS f32x4*)(wl + 32 * rb + 8), w3_ = *(const LAS f32x4*)(wl + 32 * rb + 12); \
                float s0 = 0.f, s1 = 0.f; \
                _Pragma("unroll") for (int reg = 0; reg < 4; ++reg) {     \
                    const float y0_ = __int_as_float(max(__float_as_int(acc[reg]), 0)), y1_ = __int_as_float(max(__float_as_int(acc[reg + 4]), 0)); \
                    const float y2_ = __int_as_float(max(__float_as_int(acc[reg + 8]), 0)), y3_ = __int_as_float(max(__float_as_int(acc[reg + 12]), 0)); \
                    s0 += w0_[reg] * y0_; s0 += w1_[reg] * y1_; s1 += w2_[reg] * y2_; s1 += w3_[reg] * y3_; } \
                LAS float* sp = scl + (4 * rb + 2 * h) * 2048 + kb_ + r; \
                sp[0] = s0; sp[2048] = s1; } } } while (0)
        for (int ks = 0; ks < nsteps; ks += 2) {
            { const int kn = (ks + 1 < 8) ? ks + 1 : 7;
#pragma unroll
              for (int kk = 0; kk < 4; ++kk) bfB[kk] = *(const bf16x8*)(kp0 + (size_t)kn * 16384 + 512 * kk); }
            SCORE_STEP(ks, bfA);
            { const int kn = (ks + 2 < 8) ? ks + 2 : 7;
#pragma unroll
              for (int kk = 0; kk < 4; ++kk) bfA[kk] = *(const bf16x8*)(kp0 + (size_t)kn * 16384 + 512 * kk); }
            if (ks + 1 < nsteps) SCORE_STEP(ks + 1, bfB);
        }
#undef SCORE_STEP
    }
    LDS_WAIT(); __syncthreads();
    if (xid0 >= 0) x_load(xa, xr0);
    if (xid1 >= 0) x_load(xb, xr1);
#ifndef PROBE_P2
#define PROBE_P2 0
#endif
#pragma unroll 1
    for (int jx = 0; jx < (PROBE_P2 == 2 ? 4 : 2); ++jx) { const int j = jx & 1;
        const int tl = wid * 2 + j, t = T0 + tl, nch = (t >> 6) + 1;
        const unsigned tbit = 1u << tl; const LAS float* srow = scl + tl * 2048;
        if (nch <= 8) select_token<8>(srow, t, lane, tbit, maskw);
        else if (nch <= 16) select_token<16>(srow, t, lane, tbit, maskw);
        else if (nch <= 24) select_token<24>(srow, t, lane, tbit, maskw);
        else select_token<32>(srow, t, lane, tbit, maskw);
    }
    if (xid0 >= 0) x_store(xa, xr0);
    if (xid1 >= 0) x_store(xb, xr1);
    LDS_WAIT(); __syncthreads();
    {
        const int ktmax = (T0 + 15) >> 6; unsigned short* mbase = (unsigned short*)(masks + ((size_t)(b * (SEQ / 32) + (qt16 >> 1)) * (SEQ / 64)) * 64) + (qt16 & 1);
#pragma unroll
        for (int jj = 0; jj < 4; ++jj) { const int key = F.tid + 512 * jj, kt = key >> 6, kap = key & 63;
            const unsigned wv = maskw[key]; maskw[key] = 0u;
            if (kt <= ktmax) { const int half = kap >> 5, k5 = kap & 31, hi_ = (k5 >> 2) & 1, rr = (k5 & 3) + 4 * (k5 >> 3); mbase[2 * (kt * 64 + 32 * half + 2 * rr + hi_)] = (unsigned short)wv; } }
    }
    LDS_WAIT(); __syncthreads();
}
__device__ __forceinline__ void conv_pass(Frame& F, const bf16_t* u, const bf16_t* cb, const float* cw, bf16_t* conv) {
    const int gt = F.vcu * 512 + F.tid, NGT = F.G * 512;
    for (int idx = gt; idx < NTOK * 64; idx += NGT) {
        const int tok = idx >> 6, cg = (idx & 63) * 8, pos = tok & (SEQ - 1);
        const u32x4 z = (u32x4){0u, 0u, 0u, 0u};
        const u32x4 u0 = *(const u32x4*)(u + (size_t)tok * 512 + cg);
        const u32x4 u1 = pos >= 1 ? *(const u32x4*)(u + (size_t)(tok - 1) * 512 + cg) : z;
        const u32x4 u2 = pos >= 2 ? *(const u32x4*)(u + (size_t)(tok - 2) * 512 + cg) : z;
        const u32x4 bv = __builtin_nontemporal_load((const u32x4*)(cb + (size_t)tok * 512 + cg));
        const f32x4 w0a = *(const f32x4*)(cw + cg), w0b = *(const f32x4*)(cw + cg + 4);
        const f32x4 w1a = *(const f32x4*)(cw + 512 + cg), w1b = *(const f32x4*)(cw + 512 + cg + 4);
        const f32x4 w2a = *(const f32x4*)(cw + 1024 + cg), w2b = *(const f32x4*)(cw + 1024 + cg + 4);
        f32x4 ya, yb;
#define CV(E, WA, I, WORD, HALF) (WA[I] * (HALF ? bfhi(E.WORD) : bflo(E.WORD)))
        ya[0] = bflo(bv.x) * (CV(u2, w0a, 0, x, 0) + CV(u1, w1a, 0, x, 0) + CV(u0, w2a, 0, x, 0));
        ya[1] = bfhi(bv.x) * (CV(u2, w0a, 1, x, 1) + CV(u1, w1a, 1, x, 1) + CV(u0, w2a, 1, x, 1));
        ya[2] = bflo(bv.y) * (CV(u2, w0a, 2, y, 0) + CV(u1, w1a, 2, y, 0) + CV(u0, w2a, 2, y, 0));
        ya[3] = bfhi(bv.y) * (CV(u2, w0a, 3, y, 1) + CV(u1, w1a, 3, y, 1) + CV(u0, w2a, 3, y, 1));
        yb[0] = bflo(bv.z) * (CV(u2, w0b, 0, z, 0) + CV(u1, w1b, 0, z, 0) + CV(u0, w2b, 0, z, 0));
        yb[1] = bfhi(bv.z) * (CV(u2, w0b, 1, z, 1) + CV(u1, w1b, 1, z, 1) + CV(u0, w2b, 1, z, 1));
        yb[2] = bflo(bv.w) * (CV(u2, w0b, 2, w, 0) + CV(u1, w1b, 2, w, 0) + CV(u0, w2b, 2, w, 0));
        yb[3] = bfhi(bv.w) * (CV(u2, w0b, 3, w, 1) + CV(u1, w1b, 3, w, 1) + CV(u0, w2b, 3, w, 1));
#undef CV
        store8bf(conv + (size_t)tok * 1024 + cg, ya, yb);
    }
}

constexpr int P7_HS = 1032;
constexpr int P7_H = 0, P7_HL = 16 * P7_HS * 2, P7_P = 2 * 16 * P7_HS * 2, P7_L = P7_P + 8 * 16 * 48 * 4, P7_R = P7_L + 16 * 48 * 4, P7_END = P7_R + 6 * 128 * 4 + 2 * 32 * 4;
static_assert(P7_END <= RING_BYTES && (P7_P % 16) == 0, "P7 LDS map");
__device__ __forceinline__ void ln1_router(Frame& F, bool dry) {
    const KArgs a = kargs();
    unsigned char* ws = F.ws;
    const float* xin = a->in[0]; const bf16_t* mixb = (const bf16_t*)(ws + WS_MIX); bf16_t* h1b = dry ? (bf16_t*)(ws + WS_GATES) : (bf16_t*)(ws + WS_PRE);
    int* lists = (int*)(ws + (dry ? WS_MERGED : WS_LIST)); unsigned* tokinfo = (unsigned*)(ws + (dry ? WS_MERGED + 8 * MiB : WS_TOKINFO)); const int cbank = dry ? 64 * NEXP : 0;
    unsigned char* h1q = ws + (dry ? WS_MERGED + 16 * MiB : WS_H1Q);
    const float *g1 = a->in[7], *b1 = a->in[8], *rgb = a->in[10], *reb = a->in[12]; const float* wc = (const float*)(ws + WS_WC);
    const int lane = F.lane, wid = F.wave, tid = F.tid;
    LAS bf16_t* Hh = (LAS bf16_t*)(F.lds + P7_H); LAS bf16_t* Hl = (LAS bf16_t*)(F.lds + P7_HL); LAS float* P = (LAS float*)(F.lds + P7_P); LAS float* L = (LAS float*)(F.lds + P7_L);
    LAS int* RE = (LAS int*)(F.lds + P7_R);
    LAS int* hist = RE + 768; LAS int* basev = RE + 800;
    if (tid < 64) hist[tid] = 0;
    f32x4 gv[4], bv[4];
#pragma unroll
    for (int j = 0; j < 4; ++j) { gv[j] = *(const f32x4*)(g1 + 4 * lane + 256 * j); bv[j] = *(const f32x4*)(b1 + 4 * lane + 256 * j); }
    bf16x8 bhi[4][3], blo[4][3];
    { const int kq = lane >> 4, jn = lane & 15; const float* wp = wc + (size_t)(128 * wid + 8 * kq) * 48 + jn;
#pragma unroll
      for (int sidx = 0; sidx < 4; ++sidx)
#pragma unroll
          for (int cb = 0; cb < 3; ++cb) { u32x4 ph, pl;
#pragma unroll
              for (int jp = 0; jp < 4; ++jp) { const float w0 = wp[(size_t)(32 * sidx + 2 * jp) * 48 + 16 * cb], w1 = wp[(size_t)(32 * sidx + 2 * jp + 1) * 48 + 16 * cb];
                  const unsigned hh = pkbf(w0, w1); ph[jp] = hh; pl[jp] = pkbf(w0 - bflo(hh), w1 - bfhi(hh)); }
              bhi[sidx][cb] = __builtin_bit_cast(bf16x8, ph); blo[sidx][cb] = __builtin_bit_cast(bf16x8, pl); } }
    const int ngrp_total = NTOK / 16;
#pragma unroll 1
    for (int gi = F.vcu * 8; gi < ngrp_total; gi += F.G * 8) {
      f32x4 vn[2][4]; u32x2 mn[2][4];
#pragma unroll
      for (int rr = 0; rr < 2; ++rr)
#pragma unroll
          for (int j = 0; j < 4; ++j) { const size_t o_ = (size_t)(gi * 16 + 2 * wid + rr) * DM + 4 * lane + 256 * j; vn[rr][j] = __builtin_nontemporal_load((const f32x4*)(xin + o_)); mn[rr][j] = __builtin_nontemporal_load((const u32x2*)(mixb + o_)); }
#pragma unroll 1
      for (int gg = 0; gg < 8; ++gg) {
        const int row0 = (gi + gg) * 16;
#pragma unroll
        for (int rr = 0; rr < 2; ++rr) { const int rl = 2 * wid + rr, row = row0 + rl;
            f32x4 v[4]; float sm = 0.f;
#pragma unroll
            for (int j = 0; j < 4; ++j) { const u32x2 mw = mn[rr][j]; v[j] = vn[rr][j] * ALPHA + (f32x4){bflo(mw.x), bfhi(mw.x), bflo(mw.y), bfhi(mw.y)}; sm += (v[j][0] + v[j][1]) + (v[j][2] + v[j][3]); }
            const float mean = dpp_sum_f(sm) * (1.f / DM); float s2 = 0.f;
#pragma unroll
            for (int j = 0; j < 4; ++j) { v[j] = v[j] - mean; s2 += (v[j][0] * v[j][0] + v[j][1] * v[j][1]) + (v[j][2] * v[j][2] + v[j][3] * v[j][3]); }
            const float rstd = 1.f / sqrtf(dpp_sum_f(s2) * (1.f / DM) + LN_EPS);
#pragma unroll
            for (int j = 0; j < 4; ++j) { v[j] = v[j] * rstd * gv[j] + bv[j];
                u32x2 o; o.x = pkbf(v[j][0], v[j][1]); o.y = pkbf(v[j][2], v[j][3]); *(u32x2*)(h1b + (size_t)row * DM + 4 * lane + 256 * j) = o;
                { int wv = 0; wv = __builtin_amdgcn_cvt_pk_fp8_f32(v[j][0], v[j][1], wv, false); wv = __builtin_amdgcn_cvt_pk_fp8_f32(v[j][2], v[j][3], wv, true);
                  *(int*)(h1q + (size_t)row * 1024 + 4 * lane + 256 * j) = wv; }
                { const unsigned h01 = o.x, h23 = o.y;
                  *(LAS u32x2*)(Hh + rl * P7_HS + 4 * lane + 256 * j) = (u32x2){h01, h23};
                  *(LAS u32x2*)(Hl + rl * P7_HS + 4 * lane + 256 * j) = (u32x2){pkbf(v[j][0] - bflo(h01), v[j][1] - bfhi(h01)), pkbf(v[j][2] - bflo(h23), v[j][3] - bfhi(h23))}; } } }
        { const int gnx = gg < 7 ? gg + 1 : gg;
#pragma unroll
          for (int rr = 0; rr < 2; ++rr)
#pragma unroll
              for (int j = 0; j < 4; ++j) { const size_t o_ = (size_t)((gi + gnx) * 16 + 2 * wid + rr) * DM + 4 * lane + 256 * j; vn[rr][j] = __builtin_nontemporal_load((const f32x4*)(xin + o_)); mn[rr][j] = __builtin_nontemporal_load((const u32x2*)(mixb + o_)); } }
        LDS_WAIT(); __syncthreads();
        { f32x4 acc[3]; acc[0] = (f32x4){0.f, 0.f, 0.f, 0.f}; acc[1] = acc[0]; acc[2] = acc[0];
          const int hoff = (lane & 15) * P7_HS + 128 * wid + 8 * (lane >> 4);
#pragma unroll
          for (int sidx = 0; sidx < 4; ++sidx) { const bf16x8 ah = *(const LAS bf16x8*)(Hh + hoff + 32 * sidx), al = *(const LAS bf16x8*)(Hl + hoff + 32 * sidx);
#pragma unroll
              for (int cb = 0; cb < 3; ++cb) { acc[cb] = __builtin_amdgcn_mfma_f32_16x16x32_bf16(ah, bhi[sidx][cb], acc[cb], 0, 0, 0);
                  acc[cb] = __builtin_amdgcn_mfma_f32_16x16x32_bf16(ah, blo[sidx][cb], acc[cb], 0, 0, 0); acc[cb] = __builtin_amdgcn_mfma_f32_16x16x32_bf16(al, bhi[sidx][cb], acc[cb], 0, 0, 0); } }
          LAS float* pp = P + (wid * 16 + 4 * (lane >> 4)) * 48 + (lane & 15);
#pragma unroll
          for (int cb = 0; cb < 3; ++cb)
#pragma unroll
              for (int rg = 0; rg < 4; ++rg) pp[rg * 48 + 16 * cb] = acc[cb][rg]; }
        LDS_WAIT(); __syncthreads();
        for (int idx = tid; idx < 16 * 48; idx += 512) { float sum = 0.f;
#pragma unroll
            for (int w = 0; w < 8; ++w) sum += P[w * 768 + idx];
            L[idx] = sum; }
        LDS_WAIT(); __syncthreads();
        if (tid < 16) { const LAS float* lr = L + tid * 48;
            float gl[4]; int grp = 0;
#pragma unroll
            for (int i = 0; i < 4; ++i) gl[i] = lr[i] + rgb[i];
            float gm = gl[0];
#pragma unroll
            for (int i = 1; i < 4; ++i) if (gl[i] > gm) { gm = gl[i]; grp = i; }
            float den = 0.f;
#pragma unroll
            for (int i = 0; i < 4; ++i) den += __expf(gl[i] - gm);
            const float pgrp = 1.f / den;
            float el[8];
#pragma unroll
            for (int i = 0; i < 8; ++i) el[i] = lr[4 + 8 * grp + i] + reb[grp * 8 + i];
            int i1 = 0; float v1 = el[0];
#pragma unroll
            for (int i = 1; i < 8; ++i) if (el[i] > v1) { v1 = el[i]; i1 = i; }
            int i2 = -1; float v2 = -INFINITY;
#pragma unroll
            for (int i = 0; i < 8; ++i) if (i != i1 && el[i] > v2) { v2 = el[i]; i2 = i; }
            const float ex = __expf(v2 - v1), w1 = pgrp / (1.f + ex), w2 = pgrp * ex / (1.f + ex);
            const int e1 = grp * 8 + i1, e2 = grp * 8 + i2, ti = gg * 16 + tid;
            RE[ti] = e1; RE[128 + ti] = e2; RE[256 + ti] = (int)__float_as_uint(w1); RE[384 + ti] = (int)__float_as_uint(w2);
            RE[512 + ti] = __hip_atomic_fetch_add(hist + e1, 1, __ATOMIC_RELAXED, __HIP_MEMORY_SCOPE_WORKGROUP);
            RE[640 + ti] = __hip_atomic_fetch_add(hist + e2, 1, __ATOMIC_RELAXED, __HIP_MEMORY_SCOPE_WORKGROUP);
        }
      }
      LDS_WAIT(); __syncthreads();
      if (tid < NEXP) { const int hc = hist[tid]; basev[tid] = hc ? (int)__hip_atomic_fetch_add(F.ctl + CW_CNT + cbank + 64 * tid, (unsigned)hc, __ATOMIC_RELAXED, __HIP_MEMORY_SCOPE_AGENT) : 0; }
      LDS_WAIT(); __syncthreads();
      if (tid < 128) { const int row = gi * 16 + tid; const int e1 = RE[tid], e2 = RE[128 + tid];
          const unsigned r1 = (unsigned)(basev[e1] + RE[512 + tid]), r2 = (unsigned)(basev[e2] + RE[640 + tid]);
          if (r1 < (unsigned)LISTCAP) lists[(size_t)e1 * LISTCAP + r1] = row;
          if (r2 < (unsigned)LISTCAP) lists[(size_t)e2 * LISTCAP + r2] = row;
          unsigned* ti = tokinfo + (size_t)row * 8;
          *(u32x4*)ti = (u32x4){(unsigned)e1, r1, (unsigned)RE[256 + tid], (unsigned)e2}; *(u32x2*)(ti + 4) = (u32x2){r2, (unsigned)RE[384 + tid]}; }
      LDS_WAIT(); __syncthreads();
      if (tid < 64) hist[tid] = 0;
      LDS_WAIT(); __syncthreads();
    }
}
__device__ __forceinline__ void moe_tables(Frame& F) {
    LAS int* tab = (LAS int*)(F.lds + TAB_OFF);
    __syncthreads();
    if (F.tid < NEXP) { int c = (int)__hip_atomic_load(F.ctl + CW_CNT + 64 * F.tid, __ATOMIC_RELAXED, __HIP_MEMORY_SCOPE_AGENT); if (c > LISTCAP) c = LISTCAP; tab[T_CNT + F.tid] = c; }
    __syncthreads();
    if (F.tid == 0) { int acc = 0; for (int e = 0; e < NEXP; ++e) { tab[T_BLK0 + e] = acc; acc += (tab[T_CNT + e] + 255) >> 8; } tab[T_BLK0 + NEXP] = acc; tab[T_NB] = acc; }
    __syncthreads();
    if (F.tid < NEXP) { const int b0 = tab[T_BLK0 + F.tid], b1 = tab[T_BLK0 + F.tid + 1]; for (int bb = b0; bb < b1; ++bb) tab[T_BLKE + bb] = F.tid; }
    __syncthreads();
}

__device__ __forceinline__ void combine_ln2(Frame& F) {
    const KArgs a = kargs();
    unsigned char* ws = F.ws;
    const bf16_t* h1 = (const bf16_t*)(ws + WS_PRE); const unsigned char* ys = ws + WS_YS;     const unsigned* tokinfo = (const unsigned*)(ws + WS_TOKINFO);
    const LAS int* tab = (const LAS int*)(F.lds + TAB_OFF);
    const float *g2 = a->in[16], *b2 = a->in[17]; float* outp = a->out;
    const int lane = F.lane, gw = F.vcu * NWAVES + F.wave, NGW = F.G * NWAVES;
    f32x4 gv[4], bv[4];
#pragma unroll
    for (int j = 0; j < 4; ++j) { gv[j] = *(const f32x4*)(g2 + 4 * lane + 256 * j); bv[j] = *(const f32x4*)(b2 + 4 * lane + 256 * j); }
    const int nrw = (NTOK - gw + NGW - 1) / NGW;
    if (nrw > 0) {
#define ROWK(k) (gw + ((k) < nrw ? (k) : nrw - 1) * NGW)
#define TI_LOAD(k, A, B) do { const unsigned* ti_ = tokinfo + (size_t)ROWK(k) * 8; A = *(const u32x4*)ti_; B = *(const u32x2*)(ti_ + 4); } while (0)
#define DATA_LOAD(k, A, B, HW, YA, YB) do { const int e1_ = (int)A.x, e2_ = (int)A.w; \
        const size_t s1_ = (size_t)tab[T_BLK0 + e1_] * 256 + A.y, s2_ = (size_t)tab[T_BLK0 + e2_] * 256 + B.x; \
        const bf16_t* hr_ = h1 + (size_t)ROWK(k) * DM + 4 * lane; const unsigned char* y1_ = ys + s1_ * DM + 4 * lane; const unsigned char* y2_ = ys + s2_ * DM + 4 * lane; \
        _Pragma("unroll") for (int j = 0; j < 4; ++j) { HW[j] = __builtin_nontemporal_load((const u32x2*)(hr_ + 256 * j)); YA[j] = __builtin_nontemporal_load((const unsigned*)(y1_ + 256 * j)); YB[j] = __builtin_nontemporal_load((const unsigned*)(y2_ + 256 * j)); } } while (0)
        u32x4 tc0, tn0, tq0; u32x2 tc1, tn1, tq1;
        u32x2 hw[4], hwn[4]; unsigned ya[4], yb[4], yan[4], ybn[4];
        TI_LOAD(0, tc0, tc1); TI_LOAD(1, tn0, tn1);
        DATA_LOAD(0, tc0, tc1, hw, ya, yb);
        for (int k = 0; k < nrw; ++k) {
            TI_LOAD(k + 2, tq0, tq1);
            DATA_LOAD(k + 1, tn0, tn1, hwn, yan, ybn);
            const float w1 = __uint_as_float(tc0.z), w2 = __uint_as_float(tc1.y);
            f32x4 v[4]; float sm = 0.f;
#pragma unroll
            for (int j = 0; j < 4; ++j) {
                v[j][0] = ALPHA * bflo(hw[j].x) + w1 * __builtin_amdgcn_cvt_f32_fp8((int)ya[j], 0) + w2 * __builtin_amdgcn_cvt_f32_fp8((int)yb[j], 0);
                v[j][1] = ALPHA * bfhi(hw[j].x) + w1 * __builtin_amdgcn_cvt_f32_fp8((int)ya[j], 1) + w2 * __builtin_amdgcn_cvt_f32_fp8((int)yb[j], 1);
                v[j][2] = ALPHA * bflo(hw[j].y) + w1 * __builtin_amdgcn_cvt_f32_fp8((int)ya[j], 2) + w2 * __builtin_amdgcn_cvt_f32_fp8((int)yb[j], 2);
                v[j][3] = ALPHA * bfhi(hw[j].y) + w1 * __builtin_amdgcn_cvt_f32_fp8((int)ya[j], 3) + w2 * __builtin_amdgcn_cvt_f32_fp8((int)yb[j], 3);
                sm += (v[j][0] + v[j][1]) + (v[j][2] + v[j][3]); }
            const float mean = dpp_sum_f(sm) * (1.f / DM); float s2v = 0.f;
#pragma unroll
            for (int j = 0; j < 4; ++j) { v[j] = v[j] - mean; s2v += (v[j][0] * v[j][0] + v[j][1] * v[j][1]) + (v[j][2] * v[j][2] + v[j][3] * v[j][3]); }
            const float rstd = 1.f / sqrtf(dpp_sum_f(s2v) * (1.f / DM) + LN_EPS);
            float* orow = outp + (size_t)(gw + k * NGW) * DM + 4 * lane;
#pragma unroll
            for (int j = 0; j < 4; ++j) __builtin_nontemporal_store(v[j] * rstd * gv[j] + bv[j], (f32x4*)(orow + 256 * j));
            tc0 = tn0; tc1 = tn1; tn0 = tq0; tn1 = tq1;
#pragma unroll
            for (int j = 0; j < 4; ++j) { hw[j] = hwn[j]; ya[j] = yan[j]; yb[j] = ybn[j]; }
        }
#undef ROWK
#undef TI_LOAD
#undef DATA_LOAD
    }
}

#if DBG_NAIVE
constexpr size_t WS_NK = 296 * MiB, WS_NV = 312 * MiB, WS_NKI = 328 * MiB;
__device__ __forceinline__ float naive_proj(const float* xs  , const float* w_in, int col) {
    float s = 0.f; for (int d = 0; d < DM; ++d) s += xs[d] * w_in[(size_t)d * INW + col]; return s;
}
__device__ __forceinline__ void naive_kv(Frame& F) {
    const KArgs ka = kargs(); const float* xin = ka->in[0]; const float* win = ka->in[1];
    float* nk = (float*)(F.ws + WS_NK); float* nv = (float*)(F.ws + WS_NV); float* nki = (float*)(F.ws + WS_NKI);
    LAS float* xs = (LAS float*)F.lds; LAS float* pr = xs + 1024;
    for (int tok = F.vcu; tok < NTOK; tok += F.G) {
        __syncthreads();
        for (int i = F.tid; i < DM; i += 512) xs[i] = xin[(size_t)tok * DM + i];
        __syncthreads();
        if (F.tid < 320) { const int col = F.tid < 256 ? 512 + F.tid : 1280 + (F.tid - 256); float s = 0.f; for (int d = 0; d < DM; ++d) s += xs[d] * win[(size_t)d * INW + col]; pr[F.tid] = s; }
        __syncthreads();
        const int pos = tok & (SEQ - 1);
        if (F.tid < 24) {
            const int grp = F.tid >> 3, i = F.tid & 7, base = grp == 0 ? 0 : (grp == 1 ? 64 : 256);
            const float inv = (float)pow(500000.0, -(double)i / 8.0); const float ang = (float)pos * inv, c = cosf(ang), s = sinf(ang);
            const float x1 = pr[base + i], x2 = pr[base + 8 + i]; pr[base + i] = x1 * c - x2 * s; pr[base + 8 + i] = x2 * c + x1 * s;
        }
        __syncthreads();
        if (F.tid < 128) { nk[(size_t)tok * 128 + F.tid] = pr[F.tid]; nv[(size_t)tok * 128 + F.tid] = pr[128 + F.tid]; }
        if (F.tid < 64) nki[(size_t)tok * 64 + F.tid] = pr[256 + F.tid];
    }
}
__device__ __forceinline__ void naive_attn(Frame& F) {
    const KArgs ka = kargs(); const float* xin = ka->in[0]; const float* win = ka->in[1];
    const float* nk = (const float*)(F.ws + WS_NK); const float* nv = (const float*)(F.ws + WS_NV); const float* nki = (const float*)(F.ws + WS_NKI);
    bf16_t* attn = (bf16_t*)(F.ws + WS_AC) + 512;
    LAS float* xs = (LAS float*)F.lds;
    LAS float* qs = xs + 1024;
    LAS float* qis = qs + 512;
    LAS float* wis = qis + 512;
    LAS float* sc = wis + 16;
    LAS int* sel = (LAS int*)(sc + 2048);
    LAS int* nsel = sel + 256;
    LAS float* pl = (LAS float*)(nsel + 16);
    for (int tok = F.vcu; tok < NTOK; tok += F.G) {
        const int pos = tok & (SEQ - 1), b0 = tok - pos;
        __syncthreads();
        for (int i = F.tid; i < DM; i += 512) xs[i] = xin[(size_t)tok * DM + i];
        if (F.tid == 0) nsel[0] = 0;
        __syncthreads();
        for (int c = F.tid; c < 1032; c += 512) { const int col = c < 512 ? c : (c < 1024 ? 768 + (c - 512) : 1344 + (c - 1024));
            float s = 0.f; for (int d = 0; d < DM; ++d) s += xs[d] * win[(size_t)d * INW + col];
            if (c < 512) qs[c] = s; else if (c < 1024) qis[c - 512] = s; else wis[c - 1024] = s; }
        __syncthreads();
        if (F.tid < 128) { const int which = F.tid >> 6, hd = (F.tid >> 3) & 7, i = F.tid & 7; LAS float* p = (which ? qis : qs) + hd * 64;
            const float inv = (float)pow(500000.0, -(double)i / 8.0); const float ang = (float)pos * inv, c = cosf(ang), s = sinf(ang);
            const float x1 = p[i], x2 = p[8 + i]; p[i] = x1 * c - x2 * s; p[8 + i] = x2 * c + x1 * s; }
        __syncthreads();
#if DBG_NAIVE == 2
        { const bf16_t* qif = (const bf16_t*)(F.ws + WS_QI) + (size_t)tok * 512; for (int i = F.tid; i < 512; i += 512) qis[i] = __uint_as_float((unsigned)qif[i] << 16);
          if (F.tid < 8) wis[F.tid] = ((const float*)(F.ws + WS_WI))[(size_t)tok * 8 + F.tid]; }
        __syncthreads();
        for (int s = F.tid; s <= pos; s += 512) { const int tk_ = b0 + s; const bf16_t* kr = (const bf16_t*)(F.ws + WS_KI) + (size_t)(tk_ >> 5) * 2048 + (tk_ & 31) * 16; float tot = 0.f;
            for (int hd = 0; hd < 8; ++hd) { float d = 0.f; for (int e = 0; e < 64; ++e) d += qis[hd * 64 + e] * __uint_as_float((unsigned)kr[(e >> 4) * 512 + ((e >> 3) & 1) * 8 + (e & 7)] << 16); tot += fmaxf(d, 0.f) * (wis[hd] * WSCALE); }
            sc[s] = tot; }
#else
        for (int s = F.tid; s <= pos; s += 512) { const float* kr = nki + (size_t)(b0 + s) * 64; float tot = 0.f;
            for (int hd = 0; hd < 8; ++hd) { float d = 0.f; for (int e = 0; e < 64; ++e) d += qis[hd * 64 + e] * kr[e]; d *= 0.125f; tot += fmaxf(d, 0.f) * wis[hd]; }
            sc[s] = tot * 0.35355339059327373f; }
#endif
        __syncthreads();
        for (int s = F.tid; s <= pos; s += 512) { bool take = true;
            if (pos >= 256) { const float xv = sc[s]; int rank = 0; for (int s2 = 0; s2 <= pos; ++s2) { const float y = sc[s2]; rank += (y > xv || (y == xv && s2 < s)) ? 1 : 0; } take = rank < 256; }
            if (take) { const int p = atomicAdd((int*)nsel, 1); sel[p] = s; } }
        __syncthreads();
        const int ns = nsel[0]; const int hd = F.wave, lane = F.lane;
        float lg[4]; float mx = -INFINITY;
        for (int jj = 0; jj < 4; ++jj) { const int j = lane + 64 * jj; lg[jj] = -INFINITY;
            if (j < ns) { const float* kr = nk + (size_t)(b0 + sel[j]) * 128 + (hd >> 2) * 64; float d = 0.f; for (int e = 0; e < 64; ++e) d += qs[hd * 64 + e] * kr[e]; lg[jj] = d * 0.125f; mx = fmaxf(mx, lg[jj]); } }
        mx = wave_max(mx); float sum = 0.f;
        for (int jj = 0; jj < 4; ++jj) { const int j = lane + 64 * jj; const float p = (j < ns) ? expf(lg[jj] - mx) : 0.f; sum += p; pl[hd * 256 + j] = p; }
        sum = wave_sum(sum);
        LDS_WAIT(); asm volatile("" ::: "memory");
        float o = 0.f;
        for (int j = 0; j < ns; ++j) o += pl[hd * 256 + j] * nv[(size_t)(b0 + sel[j]) * 128 + (hd >> 2) * 64 + lane];
        o /= sum;
        bf16_t* ap = attn + (size_t)tok * 1024 + hd * 64 + lane;
        const float fast = __uint_as_float((unsigned)(*ap) << 16);
        const float blended = o + DBG_G * (fast - o);
        *ap = (bf16_t)(pkbf(blended, 0.f) & 0xffffu);
    }
}
#endif

__global__ void __launch_bounds__(NWAVES * 64, 2) mk_fwd(Args args_unused) {
    extern __shared__ __attribute__((aligned(16))) unsigned char lds[];
    Frame F;
    F.lds = (LAS unsigned char*)lds;
    F.MISC = (volatile LAS unsigned*)(F.lds + LDSCTL_OFF);
    F.tid = threadIdx.x; F.lane = F.tid & 63; F.wave = __builtin_amdgcn_readfirstlane(F.tid >> 6);
    F.G = gridDim.x; { const int bx = blockIdx.x; F.vcu = (F.G % 8 == 0) ? (bx % 8) * (F.G / 8) + bx / 8 : bx; }
    unsigned char* ws; int lo, hi;
    { const KArgs ka = kargs(); ws = ka->ws; lo = ka->ph_lo; hi = ka->ph_hi; }
    F.ws = ws; F.ctl = (unsigned*)(ws + WS_CTL);
    for (int u = F.tid; u < (LDS_BYTES - LDSCTL_OFF) / 4; u += NWAVES * 64) ((LAS unsigned*)(F.lds + LDSCTL_OFF))[u] = 0u;
    __syncthreads();
#if MK_SPLIT
#define GRID_BAR() do { } while (0)
#else
    XcdBarrier bar = xcd_barrier_post(F.ctl + CW_BAR, F.MISC + 8);
#define GRID_BAR() xcd_barrier(bar)
#endif
#ifndef PHASE_MASK
#define PHASE_MASK 0xFFFF
#endif
#define IN(k) ((((PHASE_MASK) >> (k)) & 1) && lo <= (k) && (k) < hi)
#define BOTH(k, k2) (IN(k) && IN(k2))

    bf16_t* xb = (bf16_t*)(ws + WS_XB);
    bf16_t *qb = (bf16_t*)(ws + WS_Q), *kbuf = (bf16_t*)(ws + WS_K), *vbuf = (bf16_t*)(ws + WS_V), *qib = (bf16_t*)(ws + WS_QI), *kib = (bf16_t*)(ws + WS_KI);
    float* wib = (float*)(ws + WS_WI);
    bf16_t *ub = (bf16_t*)(ws + WS_U), *cbb = (bf16_t*)(ws + WS_CB), *acb = (bf16_t*)(ws + WS_AC), *gab = (bf16_t*)(ws + WS_GA), *rtb = (bf16_t*)(ws + WS_RT);
    unsigned* masks = (unsigned*)(ws + WS_MASK);
    bf16_t *merged = (bf16_t*)(ws + WS_MERGED), *h1b = (bf16_t*)(ws + WS_PRE), *ysb_unused = nullptr; (void)ysb_unused;
    float* pre = (float*)(ws + WS_PRE);

    if (IN(0)) { p0_prologue(F); if (BOTH(0, 1)) GRID_BAR(); }
    if (IN(1)) {
        pg8::Gemm g{xb, (const bf16_t*)(ws + WS_WIN), NTOK, NPROJ, DM, 0}; pg8::StaticOrder S; S.init(NTOK, NPROJ, F.G, (int)blockIdx.x);
        EpiProj E{qb, kbuf, vbuf, qib, kib, ub, cbb, gab, rtb, wib, (const float*)(ws + WS_ROPE), kargs()->in[2]};
        pg8::gemm_phase<EpiProj, pg8::StaticOrder, true, false>(F.lds, g, S, E, nullptr);
        if (BOTH(1, 2)) GRID_BAR();
    }
    if (IN(2)) {
        LAS float* scl = (LAS float*)F.lds;
        LAS unsigned* maskw = (LAS unsigned*)(F.lds + TAB_OFF);
        for (int i = F.tid; i < 2048; i += 512) maskw[i] = 0u;
        __syncthreads();
        if (F.G == 256) {
            const int b = F.vcu >> 4, j = F.vcu & 15;
#pragma unroll 1
            for (int i = 0; i < 8; ++i) { const int qt = 32 * (i >> 1) + ((i & 1) ? 31 - j : j);
                const int gwv = F.vcu * NWAVES + F.wave, jx0 = i < 4 ? 2 * i : 4 + i;
                score_select_unit(F, b, qt, qib, kib, wib, scl, maskw, masks, gwv + 2048 * jx0, i < 4 ? gwv + 2048 * (jx0 + 1) : -1); }
        } else {
#pragma unroll 1
            for (int un = F.vcu; un < NBATCH * 128; un += F.G) score_select_unit(F, un >> 7, un & 127, qib, kib, wib, scl, maskw, masks, -1, -1);
        }
        conv_pass(F, ub, cbb, kargs()->in[5], acb);
        if (PROBE_P2 == 3) conv_pass(F, ub, cbb, kargs()->in[5], acb);
        if (BOTH(2, 3)) GRID_BAR();
    }
    if (IN(3)) {
        const int nun = NBATCH * 8 * 8;
        if (F.G == 256) {
            const int bh = F.vcu >> 1, s0 = 2 * (F.vcu & 1);
#pragma unroll 1
            for (int i = 0; i < 4; ++i) { const int qbk = (i == 0) ? s0 : (i == 1) ? 7 - s0 : (i == 2) ? s0 + 1 : 6 - s0;
                attn_body::attn_unit<8>(bh >> 3, bh & 7, qbk, (const attn_body::bf16*)qb, (const attn_body::bf16*)kbuf, (const attn_body::bf16*)vbuf, (attn_body::bf16*)acb, masks, (char*)lds); }
        } else {
#pragma unroll 1
            for (int un = F.vcu; un < nun; un += F.G) attn_body::attn_unit<8>(un >> 6, (un >> 3) & 7, un & 7, (const attn_body::bf16*)qb, (const attn_body::bf16*)kbuf, (const attn_body::bf16*)vbuf, (attn_body::bf16*)acb, masks, (char*)lds);
        }
        if (BOTH(3, 4)) GRID_BAR();
    }
#if DBG_NAIVE
    if (IN(4)) { naive_kv(F); }
    if (IN(11)) { naive_attn(F); }
#else
    if (IN(4)) { if (BOTH(4, 5)) { } }
#endif
    if (IN(5)) {
        pg8::Gemm g{acb, (const bf16_t*)(ws + WS_WAU), NTOK, DM, DM, 0}; pg8::StaticOrder S; S.init(NTOK, DM, F.G, (int)blockIdx.x);
        EpiMerged E{gab, rtb, merged};
        pg8::gemm_phase<EpiMerged, pg8::StaticOrder, true, false, true>(F.lds, g, S, E, nullptr);
        if (BOTH(5, 6)) GRID_BAR();
    }
    if (IN(6)) {
        pg8::Gemm g{merged, (const bf16_t*)(ws + WS_WOUT), NTOK, DM, DM, 0}; pg8::StaticOrder S; S.init(NTOK, DM, F.G, (int)blockIdx.x);
        EpiOut E{(bf16_t*)(ws + WS_MIX)};
        pg8::gemm_phase<EpiOut, pg8::StaticOrder, true, false>(F.lds, g, S, E, nullptr);
        if (BOTH(6, 7)) GRID_BAR();
    }
    if (IN(7)) { ln1_router(F, (kargs()->flags & 1) != 0); if (BOTH(7, 8)) GRID_BAR(); }
    if (IN(8)) {
        moe_tables(F);
        LAS int* tab = (LAS int*)(F.lds + TAB_OFF);
        const int nunits = tab[T_NB] * 4; const int* lists = (const int*)(ws + WS_LIST);
        for (int i = 0; i < T_ROWS_UNITS; ++i) { const int L = i * F.G + F.vcu; if (L >= nunits) break;
            const int rbg = L >> 2, e = tab[T_BLKE + rbg], slot0 = (rbg - tab[T_BLK0 + e]) * 256, cnt = tab[T_CNT + e];
            if (F.tid < 256) { const int sl = slot0 + F.tid; tab[T_ROWS + i * 256 + F.tid] = sl < cnt ? lists[(size_t)e * LISTCAP + sl] : 0; } }
        __syncthreads();
        pg8::Gemm g{(const bf16_t*)(ws + WS_H1Q), (const bf16_t*)(ws + WS_WGU), CAPROWS, NEXP * 1024, 512, 0}; pg8::MoeOrder S{tab + T_BLKE, nunits, F.G, F.vcu};
        EpiSwiGLU E{ws + WS_HID};
        pg8::gemm_phase<EpiSwiGLU, pg8::MoeOrder, true, true, false, true>(F.lds, g, S, E, tab + T_ROWS);
        if (BOTH(8, 9)) GRID_BAR();
    }
    if (IN(9)) {
        moe_tables(F);
        LAS int* tab = (LAS int*)(F.lds + TAB_OFF);
        const int nunits = tab[T_NB] * 4;
        pg8::Gemm g{(const bf16_t*)(ws + WS_HID), (const bf16_t*)(ws + WS_WD), CAPROWS, NEXP * 1024, 256, 0}; pg8::MoeOrder S{tab + T_BLKE, nunits, F.G, F.vcu};
        EpiYs E{ws + WS_YS};
        pg8::gemm_phase<EpiYs, pg8::MoeOrder, true, false, false, true>(F.lds, g, S, E, nullptr);
        if (BOTH(9, 10)) GRID_BAR();
    }
    if (IN(10)) { moe_tables(F); combine_ln2(F); }
#undef IN
#undef BOTH
}

extern "C" void kernel_launch(void* const* d_in, const int* in_sizes, int n_in, void* d_out, int out_size, void* d_ws, size_t ws_size, hipStream_t stream) {
    static int grid = 0;
    if (grid == 0) {
        if (n_in != 18 || in_sizes[0] != NTOK * DM || out_size != NTOK * DM || ws_size < WS_END) { fprintf(stderr, "kernel_launch: unexpected shapes (n_in %d, ws %zu)\n", n_in, ws_size); grid = -1; return; }
        int dev = 0, cus = 0, per_cu = 0;
        if (hipGetDevice(&dev) != hipSuccess || hipDeviceGetAttribute(&cus, hipDeviceAttributeMultiprocessorCount, dev) != hipSuccess) { grid = -1; return; }
        if (hipFuncSetAttribute((const void*)mk_fwd, hipFuncAttributeMaxDynamicSharedMemorySize, LDS_BYTES) != hipSuccess) { fprintf(stderr, "kernel_launch: hipFuncSetAttribute failed\n"); grid = -1; return; }
        if (hipOccupancyMaxActiveBlocksPerMultiprocessor(&per_cu, (const void*)mk_fwd, NWAVES * 64, LDS_BYTES) != hipSuccess || per_cu < 1) fprintf(stderr, "kernel_launch: occupancy query reports %d\n", per_cu);
        (void)hipGetLastError();
        grid = cus;
    }
    if (grid < 0) return;
    (void)hipMemsetAsync((char*)d_ws + WS_CTL, 0, CTL_ZERO_BYTES, stream);
    Args a{};
    for (int i = 0; i < 18; ++i) a.in[i] = (const float*)d_in[i];
    a.out = (float*)d_out; a.ws = (unsigned char*)d_ws;
#if MK_SPLIT
#if DBG_NAIVE
    const int seq[] = {0, 1, 2, 3, 4, 11, 5, 6, 7, 8, 9, 10};
#else
    const int seq[] = {0, 1, 2, 3, 5, 6, 7, 8, 9, 10};
#endif
    for (int ph : seq) { a.ph_lo = ph; a.ph_hi = ph + 1;
#ifdef PROBE_P7
        if (ph == 7) { a.flags = 1; hipLaunchKernelGGL(mk_fwd, dim3(grid), dim3(NWAVES * 64), LDS_BYTES, stream, a); a.flags = 0; }
#endif
        hipLaunchKernelGGL(mk_fwd, dim3(grid), dim3(NWAVES * 64), LDS_BYTES, stream, a);
#ifdef PROBE_DUP
        if (ph == PROBE_DUP) hipLaunchKernelGGL(mk_fwd, dim3(grid), dim3(NWAVES * 64), LDS_BYTES, stream, a);
#endif
    }
#else
    a.ph_lo = 0; a.ph_hi = 11;
    hipLaunchKernelGGL(mk_fwd, dim3(grid), dim3(NWAVES * 64), LDS_BYTES, stream, a);
#endif
}
```

```cpp
#include <hip/hip_runtime.h>
#include <hip/hip_bf16.h>
#include <cstdio>
#include <cstdint>

#ifndef MK_SPLIT
#define MK_SPLIT 0
#endif
#ifndef DBG_NAIVE
#define DBG_NAIVE 0
#endif
#ifndef DBG_G
#define DBG_G 1.0f
#endif

#define LAS __attribute__((address_space(3)))
#define GAS __attribute__((address_space(1)))
typedef unsigned short bf16_t;
typedef short bf16x8 __attribute__((ext_vector_type(8)));
typedef short s16x4 __attribute__((ext_vector_type(4)));
typedef float f32x2 __attribute__((ext_vector_type(2)));
typedef float f32x4 __attribute__((ext_vector_type(4)));
typedef float f32x16 __attribute__((ext_vector_type(16)));
typedef unsigned u32x2 __attribute__((ext_vector_type(2)));
typedef unsigned u32x4 __attribute__((ext_vector_type(4)));
typedef unsigned u32x16 __attribute__((ext_vector_type(16)));
typedef __bf16 bf16x2_t __attribute__((ext_vector_type(2)));

constexpr int NTOK = 32768, SEQ = 2048, NBATCH = 16, DM = 1024;
constexpr int NPROJ = 5120, INW = 4936;
constexpr int NEXP = 32, DEXP = 512, LISTCAP = 32768;
constexpr int CAPROWS = 65536 + NEXP * 256;
constexpr float LN_EPS = 1e-5f;
constexpr float ALPHA = 1.189207115002721f;
constexpr float C2 = 0.125f * 1.4426950408889634f;
constexpr float WSCALE = 0.125f * 0.35355339059327373f;

constexpr size_t MiB = 1u << 20;
constexpr size_t WS_CTL = 0, CTL_ZERO_BYTES = 1 * MiB;
constexpr size_t WS_ROPE = 1 * MiB;
constexpr size_t WS_WC = 1 * MiB + 256 * 1024;
constexpr size_t WS_WIN = 2 * MiB, WS_WAU = 12 * MiB, WS_WCU = 13 * MiB, WS_WOUT = 14 * MiB, WS_WD = 16 * MiB, WS_WGU = 48 * MiB;
constexpr size_t WS_XB = 112 * MiB;
constexpr size_t WS_MIX = 112 * MiB;
constexpr size_t WS_H1Q = 304 * MiB;
constexpr size_t WS_AC = 112 * MiB;
constexpr size_t WS_Q = 176 * MiB, WS_K = 208 * MiB, WS_V = 216 * MiB, WS_QI = 224 * MiB, WS_KI = 256 * MiB, WS_WI = 260 * MiB;
constexpr size_t WS_MERGED = 176 * MiB;
constexpr size_t WS_U = 264 * MiB, WS_ATTN = 264 * MiB;
constexpr size_t WS_CB = 296 * MiB, WS_MASK = 360 * MiB, WS_GATES = 368 * MiB;
constexpr size_t WS_GA = 368 * MiB, WS_RT = 432 * MiB;
constexpr size_t WS_PRE = 240 * MiB;
constexpr size_t WS_HID = 368 * MiB;
constexpr size_t WS_LIST = 496 * MiB, WS_TOKINFO = 500 * MiB;
constexpr size_t WS_YS = 48 * MiB;
constexpr size_t WS_END = 512 * MiB;
static_assert(WS_YS + (size_t)CAPROWS * 1024 * 2 <= WS_PRE && WS_HID + (size_t)CAPROWS * 512 * 2 <= WS_LIST, "ws map");
constexpr int CW_BAR = 4096;
constexpr int CW_CNT = 8192;
constexpr int RING_BYTES = 131072;
constexpr int LDSCTL_OFF = RING_BYTES;
constexpr int TAB_OFF = RING_BYTES + 512;
constexpr int T_CNT = 0, T_BLK0 = 32, T_NB = 68, T_BLKE = 72, T_ROWS = 400, T_ROWS_UNITS = 12;
constexpr int LDS_BYTES = 147456;
static_assert(TAB_OFF + (T_ROWS + T_ROWS_UNITS * 256) * 4 <= LDS_BYTES && TAB_OFF + 8192 <= LDS_BYTES, "lds map");
constexpr int NWAVES = 8;

__device__ __forceinline__ unsigned pkbf(float lo, float hi) { f32x2 v = {lo, hi}; bf16x2_t b = __builtin_convertvector(v, bf16x2_t); return __builtin_bit_cast(unsigned, b); }
__device__ __forceinline__ float bflo(unsigned u) { return __uint_as_float(u << 16); }
__device__ __forceinline__ float bfhi(unsigned u) { return __uint_as_float(u & 0xffff0000u); }
__device__ __forceinline__ float wave_sum(float v) {
#pragma unroll
    for (int o = 1; o < 64; o <<= 1) v += __shfl_xor(v, o);
    return v;
}
__device__ __forceinline__ float wave_max(float v) {
#pragma unroll
    for (int o = 1; o < 64; o <<= 1) v = fmaxf(v, __shfl_xor(v, o));
    return v;
}
__device__ __forceinline__ float wave_min(float v) {
#pragma unroll
    for (int o = 1; o < 64; o <<= 1) v = fminf(v, __shfl_xor(v, o));
    return v;
}
#define LDS_WAIT() asm volatile("s_waitcnt lgkmcnt(0)" ::: "memory")
#define VM_WAIT() asm volatile("s_waitcnt vmcnt(0)" ::: "memory")

namespace pg8 {
constexpr int BM = 256, BK = 64, HALF = 128, HTB = HALF * BK * 2, STAGE_BYTES = 8 * HTB, NXCD = 8, WGM = 8;
__host__ __device__ __forceinline__ int lds_byte(int r, int c) { const int st = (r >> 4) * 2 + (c >> 5), rr = r & 15, cc = c & 31, ob = rr * 64 + cc * 2; return st * 1024 + (ob ^ (((ob >> 9) & 1) << 5)); }
__host__ __device__ __forceinline__ void stage_rc(int b, int& R, int& C) { const int st = b / 1024, sb = b % 1024, swz = sb ^ (((sb >> 9) & 1) << 5); R = (st >> 1) * 16 + swz / 64; C = (st & 1) * 32 + (swz % 64) / 2; }
__host__ __device__ __forceinline__ int perm32(int rho) { const int n = rho >> 4, i = rho & 15; return 8 * (i >> 2) + 4 * n + (i & 3); }

struct Unit { int pm, pn; };
struct Gemm { const bf16_t* A; const bf16_t* Bt; int M, N, K; int apitch; };

struct StaticOrder {
    int nM, nN, nwg, G, c;
    __host__ __device__ void init(int M, int N, int G_, int c_) { nM = M / BM; nN = N / BM; nwg = nM * nN; G = G_; c = c_; }
    __host__ __device__ bool next(int i, Unit& u) const {
        const long L = (long)i * G + c; if (L >= nwg) return false;
        int wgid = (int)L; { const int q = nwg / NXCD, r = nwg % NXCD, xcd = wgid % NXCD, off = wgid / NXCD; wgid = (xcd < r ? xcd * (q + 1) : r * (q + 1) + (xcd - r) * q) + off; }
        const int nig = WGM * nN, gid = wgid / nig, fm = gid * WGM, gsz = (nM - fm) < WGM ? (nM - fm) : WGM;
        u.pm = fm + ((wgid % nig) % gsz); u.pn = (wgid % nig) / gsz; return true;
    }
};
struct MoeOrder {
    const LAS int* blk_e; int nunits, G, c;
    __device__ __forceinline__ bool next(int i, Unit& u) const {
        const int L = i * G + c; if (L >= nunits) return false;
        const int rbg = L >> 2; u.pm = rbg; u.pn = blk_e[rbg] * 4 + (L & 3); return true;
    }
};

typedef int i32x8 __attribute__((ext_vector_type(8)));
typedef int i32x4_t __attribute__((ext_vector_type(4)));
constexpr int F8_WSCALE_E = 122;
template <class Epi, class Sched, bool ALIGN_EPI, bool GATHER, bool MIDHOOK = false, bool F8 = false>
__device__ __forceinline__ void gemm_phase(LAS unsigned char* lds, const Gemm g, const Sched& S, const Epi& E, const LAS int* rowtab) {
    const int tid = threadIdx.x, wid = __builtin_amdgcn_readfirstlane(tid >> 6), lane = tid & 63, wr = wid >> 2, wc = wid & 3, fr = lane & 15, fq = lane >> 4;
    const int K = g.K; int nt = K / BK;
    if constexpr (F8) asm volatile("" : "+s"(nt));
    int Rr[2]; unsigned cofs[2], voffB[2];
#pragma unroll
    for (int i = 0; i < 2; ++i) { int R, C; stage_rc(tid * 16 + i * 8192, R, C); const int Rb = Epi::PERM ? ((R & ~31) + perm32(R & 31)) : R;
        Rr[i] = R; cofs[i] = (unsigned)C * 2u; voffB[i] = (unsigned)(Rb * K + C) * 2u; }
    const unsigned rowb = g.apitch ? (unsigned)g.apitch : (unsigned)K * 2u;
    const size_t kstep = (size_t)(BK * 2);
    const size_t hstep = (size_t)HALF * K * 2;
    const size_t tstep = 2 * hstep;
    const unsigned ldsw = (unsigned)wid * 1024u;
    const int aoff = lds_byte(wr * 64 + fr, fq * 8), boff = lds_byte(wc * 32 + fr, fq * 8);
    const char* gA = (const char*)g.A;
#define PG8_SA(b, h) (((b) * 2 + (h)) * HTB)
#define PG8_SB(b, h) ((4 + (b) * 2 + (h)) * HTB)
#define PG8_STAGE(bufoff, gbase, voff) do { _Pragma("unroll") for (int _i = 0; _i < 2; ++_i) \
        __builtin_amdgcn_global_load_lds((const unsigned*)((const char*)(gbase) + (voff)[_i]), (LAS unsigned*)(lds + (bufoff) + ldsw + _i * 8192), 16, 0, 0); } while (0)
#define PG8_LD8(p_) __builtin_shufflevector(*(const LAS i32x4_t*)(p_), *(const LAS i32x4_t*)((p_) + 1024), 0, 1, 2, 3, 4, 5, 6, 7)
#define PG8_LDA(dst, b, h) do { if constexpr (F8) { _Pragma("unroll") for (int m = 0; m < 4; ++m) dst##8[m] = PG8_LD8(lds + PG8_SA(b, h) + aoff + m * 2048); } \
        else { _Pragma("unroll") for (int m = 0; m < 4; ++m) _Pragma("unroll") for (int k = 0; k < 2; ++k) dst[m][k] = *(const LAS bf16x8*)(lds + PG8_SA(b, h) + aoff + m * 2048 + k * 1024); } } while (0)
#define PG8_LDB(dst, b, h) do { if constexpr (F8) { _Pragma("unroll") for (int n = 0; n < 2; ++n) dst##8[n] = PG8_LD8(lds + PG8_SB(b, h) + boff + n * 2048); } \
        else { _Pragma("unroll") for (int n = 0; n < 2; ++n) _Pragma("unroll") for (int k = 0; k < 2; ++k) dst[n][k] = *(const LAS bf16x8*)(lds + PG8_SB(b, h) + boff + n * 2048 + k * 1024); } } while (0)
#define PG8_MMA(ai, bj, At, Bt) do { if constexpr (F8) __builtin_amdgcn_sched_barrier(0);     \
        __builtin_amdgcn_s_setprio(1); \
        if constexpr (F8) { _Pragma("unroll") for (int m = 0; m < 4; ++m) _Pragma("unroll") for (int n = 0; n < 2; ++n) \
            asm volatile("v_mfma_scale_f32_16x16x128_f8f6f4 %0, %1, %2, %0, %3, %4 op_sel_hi:[0,0,0]" : "+v"(acc[ai][bj][m][n]) : "v"(Bt##8[n]), "v"(At##8[m]), "v"(f8_sw), "v"(f8_sa));     \
            __builtin_amdgcn_sched_barrier(0); } \
        else { _Pragma("unroll") for (int m = 0; m < 4; ++m) _Pragma("unroll") for (int n = 0; n < 2; ++n) _Pragma("unroll") for (int k = 0; k < 2; ++k) \
            acc[ai][bj][m][n] = __builtin_amdgcn_mfma_f32_16x16x32_bf16(Bt[n][k], At[m][k], acc[ai][bj][m][n], 0, 0, 0); } \
        __builtin_amdgcn_s_setprio(0); } while (0)
#define PG8_WAIT_V(n) asm volatile("s_waitcnt vmcnt(" #n ")" ::: "memory")
#define PG8_WAIT_L(n) asm volatile("s_waitcnt lgkmcnt(" #n ")" ::: "memory")
#define PG8_BAR __builtin_amdgcn_s_barrier()
#define PG8_SCHED __builtin_amdgcn_sched_barrier(0)
#define PG8_AOFF(d0, d1, un, uidx) do { _Pragma("unroll") for (int _i = 0; _i < 2; ++_i) { unsigned r0_, r1_; \
        if (GATHER) { r0_ = (unsigned)rowtab[(uidx) * 256 + Rr[_i]]; r1_ = (unsigned)rowtab[(uidx) * 256 + 128 + Rr[_i]]; } \
        else { r0_ = (unsigned)((un).pm * 256 + Rr[_i]); r1_ = r0_ + 128u; } \
        d0[_i] = r0_ * rowb + cofs[_i]; d1[_i] = r1_ * rowb + cofs[_i]; } } while (0)
    Unit cur, nxt; int ui = 0;
    if (!S.next(0, cur)) return;
    f32x4 acc[2][2][4][2];
#pragma unroll
    for (int a = 0; a < 2; ++a)
#pragma unroll
        for (int b = 0; b < 2; ++b)
#pragma unroll
            for (int m = 0; m < 4; ++m)
#pragma unroll
                for (int n = 0; n < 2; ++n) acc[a][b][m][n] = (f32x4){0.f, 0.f, 0.f, 0.f};
    bf16x8 At[4][2], B0[2][2], B1[2][2]; i32x8 At8[4], B08[2], B18[2];
    int f8_sw = F8_WSCALE_E, f8_sa = 127; asm volatile("" : "+v"(f8_sw), "+v"(f8_sa));
    unsigned oc0[2], oc1[2], on0[2], on1[2];
    PG8_AOFF(oc0, oc1, cur, 0);
    const char* cB = (const char*)g.Bt + (size_t)cur.pn * tstep;
    PG8_STAGE(PG8_SB(0, 0), cB, voffB); PG8_STAGE(PG8_SB(0, 1), cB + hstep, voffB); PG8_STAGE(PG8_SA(0, 0), gA, oc0); PG8_STAGE(PG8_SA(0, 1), gA, oc1);
    if (wr == 1) PG8_BAR;
    PG8_WAIT_V(2); PG8_BAR;
    PG8_STAGE(PG8_SB(1, 0), cB + kstep, voffB); PG8_STAGE(PG8_SA(1, 0), gA + kstep, oc0); PG8_STAGE(PG8_SB(1, 1), cB + hstep + kstep, voffB);
    PG8_WAIT_V(6); PG8_BAR;
    for (;;) {
        const bool has_next = S.next(ui + 1, nxt);
        if (has_next) { PG8_AOFF(on0, on1, nxt, ui + 1); } else { on0[0] = oc0[0]; on0[1] = oc0[1]; on1[0] = oc1[0]; on1[1] = oc1[1]; }
        const char* nB = has_next ? (const char*)g.Bt + (size_t)nxt.pn * tstep : cB;
        for (int t = 0; t < nt; t += 2) {
            if constexpr (MIDHOOK) { if (t == nt / 2) E.mid(acc, cur, wr, wc, fr, fq); }
            const bool last = (t == nt - 2);
            const char* a1 = gA + (size_t)(t + 1) * kstep;
            const char* a2 = last ? gA : gA + (size_t)(t + 2) * kstep; const char* b2 = last ? nB : cB + (size_t)(t + 2) * kstep;
            const char* a3 = a2 + kstep; const char* b3 = b2 + kstep;
            unsigned o20[2], o21[2];
            o20[0] = last ? on0[0] : oc0[0]; o20[1] = last ? on0[1] : oc0[1]; o21[0] = last ? on1[0] : oc1[0]; o21[1] = last ? on1[1] : oc1[1];
            PG8_LDB(B0, 0, 0); PG8_LDB(B1, 0, 1); PG8_SCHED; PG8_LDA(At, 0, 0); PG8_STAGE(PG8_SA(1, 1), a1, oc1);
            PG8_WAIT_V(8); PG8_WAIT_L(0); PG8_BAR; PG8_MMA(0, 0, At, B0); PG8_MMA(0, 1, At, B1); PG8_BAR; PG8_SCHED;
            PG8_LDA(At, 0, 1); PG8_STAGE(PG8_SB(0, 0), b2, voffB); PG8_STAGE(PG8_SB(0, 1), b2 + hstep, voffB); PG8_STAGE(PG8_SA(0, 0), a2, o20);
            PG8_WAIT_V(8); PG8_WAIT_L(0); PG8_BAR; PG8_MMA(1, 0, At, B0); PG8_MMA(1, 1, At, B1); PG8_BAR; PG8_SCHED;
            PG8_LDB(B0, 1, 0); PG8_LDB(B1, 1, 1); PG8_SCHED; PG8_LDA(At, 1, 0); PG8_STAGE(PG8_SA(0, 1), a2, o21);
            PG8_WAIT_V(8); PG8_WAIT_L(0); PG8_BAR; PG8_MMA(0, 0, At, B0); PG8_MMA(0, 1, At, B1); PG8_BAR; PG8_SCHED;
            PG8_LDA(At, 1, 1); PG8_STAGE(PG8_SB(1, 0), b3, voffB); PG8_STAGE(PG8_SB(1, 1), b3 + hstep, voffB); PG8_STAGE(PG8_SA(1, 0), a3, o20);
            PG8_WAIT_V(8); PG8_WAIT_L(0); PG8_BAR; PG8_MMA(1, 0, At, B0); PG8_MMA(1, 1, At, B1); PG8_BAR; PG8_SCHED;
        }
        if constexpr (ALIGN_EPI) { if (wr == 0) PG8_BAR; }
        if constexpr (F8) asm volatile("s_nop 15\n\ts_nop 15" ::: "memory");
        E(acc, cur, wr, wc, fr, fq);
#ifdef PROBE_EPI2
        if constexpr (!MIDHOOK && !F8 && !GATHER) E(acc, cur, wr, wc, fr, fq);
#endif
        if (!has_next) break;
#pragma unroll
        for (int a = 0; a < 2; ++a)
#pragma unroll
            for (int b = 0; b < 2; ++b)
#pragma unroll
                for (int m = 0; m < 4; ++m)
#pragma unroll
                    for (int n = 0; n < 2; ++n) acc[a][b][m][n] = (f32x4){0.f, 0.f, 0.f, 0.f};
        cur = nxt; cB = nB; ++ui;
        oc0[0] = on0[0]; oc0[1] = on0[1]; oc1[0] = on1[0]; oc1[1] = on1[1];
        if constexpr (ALIGN_EPI) { if (wr == 1) PG8_BAR; }
    }
    PG8_WAIT_V(0);
    if constexpr (!ALIGN_EPI) { if (wr == 0) PG8_BAR; }
    PG8_BAR;
#undef PG8_SA
#undef PG8_SB
#undef PG8_STAGE
#undef PG8_LDA
#undef PG8_LDB
#undef PG8_MMA
#undef PG8_LD8
#undef PG8_WAIT_V
#undef PG8_WAIT_L
#undef PG8_BAR
#undef PG8_SCHED
#undef PG8_AOFF
}
}

typedef f32x4 AccT[2][2][4][2];
__device__ __forceinline__ void store8bf(bf16_t* p, const f32x4& v0, const f32x4& v1) {
    u32x4 w; w.x = pkbf(v0[0], v0[1]); w.y = pkbf(v0[2], v0[3]); w.z = pkbf(v1[0], v1[1]); w.w = pkbf(v1[2], v1[3]); *(u32x4*)p = w;
}
__device__ __forceinline__ void rope8(f32x4& v0, f32x4& v1, const float* rope, int pos, int i0) {
    const f32x4 c = *(const f32x4*)(rope + pos * 8 + i0), s = *(const f32x4*)(rope + SEQ * 8 + pos * 8 + i0);
    float a, b;
    a = v0[0]; b = v0[1]; v0[0] = a * c[0] - b * s[0]; v0[1] = b * c[0] + a * s[0];
    a = v0[2]; b = v0[3]; v0[2] = a * c[1] - b * s[1]; v0[3] = b * c[1] + a * s[1];
    a = v1[0]; b = v1[1]; v1[0] = a * c[2] - b * s[2]; v1[1] = b * c[2] + a * s[2];
    a = v1[2]; b = v1[3]; v1[2] = a * c[3] - b * s[3]; v1[3] = b * c[3] + a * s[3];
}
__device__ __forceinline__ float sigmoidf_(float z) { return __builtin_amdgcn_rcpf(1.0f + __expf(-z)); }

struct EpiProj {
    static constexpr bool PERM = true;
    bf16_t *q, *k, *v, *qi, *ki, *u, *cb, *ga, *rt; float* wi; const float* rope; const float* gate_bias;
    __device__ __forceinline__ void operator()(const AccT& acc, const pg8::Unit& un, int wr, int wc, int fr, int fq) const {
        const int pn = un.pn, row0 = un.pm * 256 + wr * 64 + fr, cg = 32 * wc + 8 * fq;
        const bool rot = ((wc & 1) == 0) && (fq < 2); const int i0 = 4 * fq;
        if (pn < 2 || pn == 3 || pn == 4) {
            bf16_t* dst = (pn < 2) ? q + pn * 256 : qi + (pn - 3) * 256; const float sc = (pn < 2) ? C2 : 1.0f;
#pragma unroll
            for (int ai = 0; ai < 2; ++ai)
#pragma unroll
                for (int m = 0; m < 4; ++m) { const int row = row0 + ai * 128 + m * 16, pos = row & (SEQ - 1);
#pragma unroll
                    for (int bj = 0; bj < 2; ++bj) { f32x4 v0 = acc[ai][bj][m][0], v1 = acc[ai][bj][m][1];
                        if (rot) rope8(v0, v1, rope, pos, i0);
                        v0 = v0 * sc; v1 = v1 * sc; store8bf(dst + (size_t)row * 512 + bj * 128 + cg, v0, v1); } }
        } else if (pn == 2) {
#pragma unroll
            for (int ai = 0; ai < 2; ++ai)
#pragma unroll
                for (int m = 0; m < 4; ++m) { const int row = row0 + ai * 128 + m * 16, pos = row & (SEQ - 1);
                    f32x4 v0 = acc[ai][0][m][0], v1 = acc[ai][0][m][1];
                    if (rot) rope8(v0, v1, rope, pos, i0);
                    store8bf(k + (size_t)row * 128 + cg, v0, v1);
                    store8bf(v + (size_t)row * 128 + cg, acc[ai][1][m][0], acc[ai][1][m][1]); }
        } else if (pn == 5) {
            if (wc < 2) {
#pragma unroll
                for (int ai = 0; ai < 2; ++ai)
#pragma unroll
                    for (int m = 0; m < 4; ++m) { const int row = row0 + ai * 128 + m * 16, pos = row & (SEQ - 1);
                        f32x4 v0 = acc[ai][0][m][0], v1 = acc[ai][0][m][1];
                        if (rot) rope8(v0, v1, rope, pos, i0);
                        { const int jch = cg >> 3; store8bf(ki + ((size_t)(row >> 5) * 4 + (jch >> 1)) * 512 + (row & 31) * 16 + (jch & 1) * 8, v0, v1); } }
            } else if (wc == 2 && fq == 0) {
#pragma unroll
                for (int ai = 0; ai < 2; ++ai)
#pragma unroll
                    for (int m = 0; m < 4; ++m) { const int row = row0 + ai * 128 + m * 16;
                        *(f32x4*)(wi + (size_t)row * 8) = acc[ai][0][m][0]; *(f32x4*)(wi + (size_t)row * 8 + 4) = acc[ai][0][m][1]; }
            }
        } else if (pn < 10) {
#pragma unroll
            for (int ai = 0; ai < 2; ++ai)
#pragma unroll
                for (int m = 0; m < 4; ++m) { const int row = row0 + ai * 128 + m * 16;
                    store8bf(u + (size_t)row * 512 + (pn - 6) * 128 + cg, acc[ai][0][m][0] * acc[ai][1][m][0], acc[ai][0][m][1] * acc[ai][1][m][1]); }
        } else if (pn < 12) {
#pragma unroll
            for (int ai = 0; ai < 2; ++ai)
#pragma unroll
                for (int m = 0; m < 4; ++m) { const int row = row0 + ai * 128 + m * 16;
#pragma unroll
                    for (int bj = 0; bj < 2; ++bj) store8bf(cb + (size_t)row * 512 + (pn - 10) * 256 + bj * 128 + cg, acc[ai][bj][m][0], acc[ai][bj][m][1]); }
        } else {
            const int gc0 = (pn - 12) * 128 + cg;
            const f32x4 ba0 = *(const f32x4*)(gate_bias + gc0), ba1 = *(const f32x4*)(gate_bias + gc0 + 4), bc0 = *(const f32x4*)(gate_bias + 1024 + gc0), bc1 = *(const f32x4*)(gate_bias + 1024 + gc0 + 4);
#pragma unroll
            for (int ai = 0; ai < 2; ++ai)
#pragma unroll
                for (int m = 0; m < 4; ++m) { const int row = row0 + ai * 128 + m * 16;
                    const f32x4 a0 = acc[ai][0][m][0] + ba0, a1 = acc[ai][0][m][1] + ba1, c0 = acc[ai][1][m][0] + bc0, c1 = acc[ai][1][m][1] + bc1;
                    f32x4 g0, g1, r0, r1;
#pragma unroll
                    for (int e = 0; e < 4; ++e) { const float ea0 = 1.0f + __expf(-a0[e]), ea1 = 1.0f + __expf(-a1[e]);
                        g0[e] = __builtin_amdgcn_rcpf(ea0); g1[e] = __builtin_amdgcn_rcpf(ea1);
                        r0[e] = ea0 * __builtin_amdgcn_rcpf(1.0f + __expf(-c0[e])); r1[e] = ea1 * __builtin_amdgcn_rcpf(1.0f + __expf(-c1[e])); }
                    store8bf(ga + (size_t)row * 1024 + gc0, g0, g1); store8bf(rt + (size_t)row * 1024 + gc0, r0, r1); }
        }
    }
};
struct EpiMerged {
    static constexpr bool PERM = true;
    const bf16_t* ga; const bf16_t* rt; bf16_t* out;
    __device__ __forceinline__ void scale(AccT& acc, const bf16_t* gsrc, const pg8::Unit& un, int wr, int wc, int fr, int fq) const {
        unsigned off0 = (unsigned)(un.pm * 256 + wr * 64 + fr) * 1024u + (unsigned)(un.pn * 256 + 32 * wc + 8 * fq);
        asm volatile("" : "+v"(off0));
#pragma unroll
        for (int ai = 0; ai < 2; ++ai)
#pragma unroll
            for (int m = 0; m < 4; ++m) {
#pragma unroll
                for (int bj = 0; bj < 2; ++bj) { const u32x4 gw = __builtin_nontemporal_load((const u32x4*)(gsrc + (off0 + (unsigned)((ai * 128 + m * 16) * 1024 + bj * 128))));
                    f32x4& v0 = acc[ai][bj][m][0]; f32x4& v1 = acc[ai][bj][m][1];
                    v0[0] *= bflo(gw.x); v0[1] *= bfhi(gw.x); v0[2] *= bflo(gw.y); v0[3] *= bfhi(gw.y);
                    v1[0] *= bflo(gw.z); v1[1] *= bfhi(gw.z); v1[2] *= bflo(gw.w); v1[3] *= bfhi(gw.w); } }
    }
    __device__ __forceinline__ void mid(AccT& acc, const pg8::Unit& un, int wr, int wc, int fr, int fq) const { scale(acc, rt, un, wr, wc, fr, fq); }
    __device__ __forceinline__ void operator()(AccT& acc, const pg8::Unit& un, int wr, int wc, int fr, int fq) const {
        scale(acc, ga, un, wr, wc, fr, fq);
        const int row0 = un.pm * 256 + wr * 64 + fr, col0 = un.pn * 256 + 32 * wc + 8 * fq;
#pragma unroll
        for (int ai = 0; ai < 2; ++ai)
#pragma unroll
            for (int m = 0; m < 4; ++m) { const int row = row0 + ai * 128 + m * 16;
#pragma unroll
                for (int bj = 0; bj < 2; ++bj) store8bf(out + (size_t)row * 1024 + col0 + bj * 128, acc[ai][bj][m][0], acc[ai][bj][m][1]); }
    }
};
struct EpiOut {
    static constexpr bool PERM = true;
    bf16_t* mix;
    __device__ __forceinline__ void operator()(const AccT& acc, const pg8::Unit& un, int wr, int wc, int fr, int fq) const {
        const int row0 = un.pm * 256 + wr * 64 + fr, col0 = un.pn * 256 + 32 * wc + 8 * fq;
#pragma unroll
        for (int ai = 0; ai < 2; ++ai)
#pragma unroll
            for (int m = 0; m < 4; ++m) { const int row = row0 + ai * 128 + m * 16;
#pragma unroll
                for (int bj = 0; bj < 2; ++bj) store8bf(mix + (size_t)row * 1024 + col0 + bj * 128, acc[ai][bj][m][0], acc[ai][bj][m][1]); }
    }
};
struct EpiSwiGLU {
    static constexpr bool PERM = true;
    unsigned char* hid;
    __device__ __forceinline__ void operator()(const AccT& acc, const pg8::Unit& un, int wr, int wc, int fr, int fq) const {
        const int row0 = un.pm * 256 + wr * 64 + fr, col0 = (un.pn & 3) * 128 + 32 * wc + 8 * fq;
#pragma unroll
        for (int ai = 0; ai < 2; ++ai)
#pragma unroll
            for (int m = 0; m < 4; ++m) { const int row = row0 + ai * 128 + m * 16; f32x4 h0, h1;
#pragma unroll
                for (int e = 0; e < 4; ++e) { const float g0 = acc[ai][0][m][0][e], g1 = acc[ai][0][m][1][e];
                    h0[e] = g0 * sigmoidf_(g0) * acc[ai][1][m][0][e]; h1[e] = g1 * sigmoidf_(g1) * acc[ai][1][m][1][e]; }
                int w0 = 0, w1 = 0;
                w0 = __builtin_amdgcn_cvt_pk_fp8_f32(h0[0], h0[1], w0, false); w0 = __builtin_amdgcn_cvt_pk_fp8_f32(h0[2], h0[3], w0, true);
                w1 = __builtin_amdgcn_cvt_pk_fp8_f32(h1[0], h1[1], w1, false); w1 = __builtin_amdgcn_cvt_pk_fp8_f32(h1[2], h1[3], w1, true);
                *(u32x2*)(hid + (size_t)row * 512 + col0) = (u32x2){(unsigned)w0, (unsigned)w1}; }
    }
};
struct EpiYs {
    static constexpr bool PERM = true;
    unsigned char* ys;
    __device__ __forceinline__ void operator()(const AccT& acc, const pg8::Unit& un, int wr, int wc, int fr, int fq) const {
        const int row0 = un.pm * 256 + wr * 64 + fr, col0 = (un.pn & 3) * 256 + 32 * wc + 8 * fq;
#pragma unroll
        for (int ai = 0; ai < 2; ++ai)
#pragma unroll
            for (int m = 0; m < 4; ++m) { const int row = row0 + ai * 128 + m * 16;
#pragma unroll
                for (int bj = 0; bj < 2; ++bj) { const f32x4 v0 = acc[ai][bj][m][0], v1 = acc[ai][bj][m][1]; int w0 = 0, w1 = 0;
                    w0 = __builtin_amdgcn_cvt_pk_fp8_f32(v0[0], v0[1], w0, false); w0 = __builtin_amdgcn_cvt_pk_fp8_f32(v0[2], v0[3], w0, true);
                    w1 = __builtin_amdgcn_cvt_pk_fp8_f32(v1[0], v1[1], w1, false); w1 = __builtin_amdgcn_cvt_pk_fp8_f32(v1[2], v1[3], w1, true);
                    *(u32x2*)(ys + (size_t)row * 1024 + col0 + bj * 128) = (u32x2){(unsigned)w0, (unsigned)w1}; } }
    }
};

namespace attn_body {
using bf16 = __hip_bfloat16;
constexpr int D = 64, QP = 512, KP = 128, OP = 1024, OCOL = 512;
constexpr int NW = 8, QBLK = 32, QB = QBLK * NW, KVBLK = 64;
__device__ __forceinline__ int crow(int r, int hi) { return (r & 3) + 8 * (r >> 2) + 4 * hi; }
#define SBAR() __builtin_amdgcn_sched_barrier(0)
__device__ __forceinline__ void cmask(f32x16& p0, f32x16& p1, int jb, int qrel, int hi) {
    const float NEG = -INFINITY; int kb = 64 * jb + 4 * hi;
#pragma unroll
    for (int r = 0; r < 16; ++r) { int kv = kb + (r & 3) + 8 * (r >> 2); if (kv > qrel) p0[r] = NEG; if (kv + 32 > qrel) p1[r] = NEG; }
}
constexpr int NSLOT = 3, SLOTB = 8192;
constexpr int LDS_K = 0, LDS_V = NSLOT * SLOTB, LDS_WS = 2 * NSLOT * SLOTB, LDS_OST = LDS_WS + NW * 64 * 4, LDS_QF = LDS_OST + NW * 4096, LDS_BYTES_A = LDS_QF + NW * 4096;
static_assert(LDS_BYTES_A <= 131072, "attention LDS");
__device__ __forceinline__ void glds16(const void* gsrc, unsigned lds_dst) { unsigned keep;
    asm volatile("s_mov_b32 %0, m0\n\ts_mov_b32 m0, %2\n\ts_nop 0\n\tglobal_load_lds_dwordx4 %1, off\n\ts_mov_b32 m0, %0" : "=&s"(keep) : "v"(gsrc), "s"(lds_dst) : "memory"); }
__device__ __forceinline__ float max3f(float a, float b, float c) { float r; asm("v_max3_f32 %0, %1, %2, %3" : "=v"(r) : "v"(a), "v"(b), "v"(c)); return r; }
__device__ __forceinline__ float max2f(float a, float b) { float r; asm("v_max_f32_e32 %0, %1, %2" : "=v"(r) : "v"(a), "v"(b)); return r; }
__device__ __forceinline__ float fadd_s(float a, float b) { float r; asm("v_add_f32_e32 %0, %1, %2" : "=v"(r) : "v"(a), "v"(b)); return r; }
__device__ __forceinline__ float fsub_s(float a, float b) { float r; asm("v_sub_f32_e32 %0, %1, %2" : "=v"(r) : "v"(a), "v"(b)); return r; }
__device__ __forceinline__ unsigned cvtpk_s(float lo, float hi) { return pkbf(lo, hi); }
__device__ __forceinline__ float msel(float x, float neg, unsigned long long m) { float r; asm("v_cndmask_b32_e64 %0, %1, %2, %3" : "=v"(r) : "v"(neg), "v"(x), "s"(m)); return r; }
#define WAIT_BAR(N) asm volatile("s_waitcnt vmcnt(" #N ") lgkmcnt(0)\n\ts_barrier" ::: "memory")

typedef __attribute__((address_space(3))) const char* lds_cptr;
__device__ __forceinline__ void qkt(f32x16& p0, f32x16& p1, const char* Kslot, lds_cptr qfp, const f32x16& negm, int r32, int hi) {
    const char* kb = Kslot + hi * 1024 + r32 * 16;
#pragma unroll
    for (int d0 = 0; d0 < 4; ++d0) {
        const bf16x8 b0 = *reinterpret_cast<const bf16x8*>(kb + d0 * 2048);
        const bf16x8 b1 = *reinterpret_cast<const bf16x8*>(kb + d0 * 2048 + 512);
        const bf16x8 qd = *(const LAS bf16x8*)(qfp + d0 * 1024);
        if (d0 == 0) { p0 = __builtin_amdgcn_mfma_f32_32x32x16_bf16(b0, qd, negm, 0, 0, 0); p1 = __builtin_amdgcn_mfma_f32_32x32x16_bf16(b1, qd, negm, 0, 0, 0); }
        else { p0 = __builtin_amdgcn_mfma_f32_32x32x16_bf16(b0, qd, p0, 0, 0, 0); p1 = __builtin_amdgcn_mfma_f32_32x32x16_bf16(b1, qd, p1, 0, 0, 0); } }
}
typedef short v4i16_t __attribute__((ext_vector_type(4)));
__device__ __forceinline__ void kload8(bf16x8* kf, lds_cptr kp) {
    kf[0] = *(const LAS bf16x8*)(kp);        kf[1] = *(const LAS bf16x8*)(kp + 512);
    kf[2] = *(const LAS bf16x8*)(kp + 2048); kf[3] = *(const LAS bf16x8*)(kp + 2560);
    kf[4] = *(const LAS bf16x8*)(kp + 4096); kf[5] = *(const LAS bf16x8*)(kp + 4608);
    kf[6] = *(const LAS bf16x8*)(kp + 6144); kf[7] = *(const LAS bf16x8*)(kp + 6656);
}
__device__ __forceinline__ void kload2(bf16x8* kf, lds_cptr kp, int j) { kf[2 * j] = *(const LAS bf16x8*)(kp + j * 2048); kf[2 * j + 1] = *(const LAS bf16x8*)(kp + j * 2048 + 512); }
__device__ __forceinline__ s16x4 vtr(lds_cptr p) { return __builtin_bit_cast(s16x4, __builtin_amdgcn_ds_read_tr16_b64_v4i16((LAS v4i16_t*)p)); }
__device__ __forceinline__ float rowmax(const f32x16& p0, const f32x16& p1) {
    float a = max3f(p0[0], p0[1], p1[0]), b = max3f(p0[2], p0[3], p1[1]); a = max3f(a, p1[2], p1[3]);
#pragma unroll
    for (int r = 4; r < 16; r += 4) { a = max3f(a, p0[r], p0[r + 1]); b = max3f(b, p0[r + 2], p0[r + 3]); a = max3f(a, p1[r], p1[r + 1]); b = max3f(b, p1[r + 2], p1[r + 3]); }
    const float m = max2f(a, b);
    auto rr = __builtin_amdgcn_permlane32_swap(__float_as_uint(m), __float_as_uint(m), false, false);
    return max2f(__uint_as_float(rr[0]), __uint_as_float(rr[1]));
}
__device__ __forceinline__ void pv(f32x16* o, int vb, bf16x8 pa0, bf16x8 pa1, bf16x8 pa2, bf16x8 pa3) {
#pragma unroll
    for (int d0 = 0; d0 < 2; ++d0) { s16x4 lo[4], hi[4];
#pragma unroll
        for (int ks = 0; ks < 4; ++ks) {
            asm volatile("ds_read_b64_tr_b16 %0,%1 offset:%c2" : "=&v"(lo[ks]) : "v"(vb), "i"(d0 * 4096 + ks * 1024) : "memory");
            asm volatile("ds_read_b64_tr_b16 %0,%1 offset:%c2" : "=&v"(hi[ks]) : "v"(vb), "i"(d0 * 4096 + ks * 1024 + 512) : "memory"); }
        asm volatile("s_waitcnt lgkmcnt(0)" ::: "memory"); SBAR();
#define PK(k) (bf16x8){lo[k][0], lo[k][1], lo[k][2], lo[k][3], hi[k][0], hi[k][1], hi[k][2], hi[k][3]}
        o[d0] = __builtin_amdgcn_mfma_f32_32x32x16_bf16(pa0, PK(0), o[d0], 0, 0, 0);
        o[d0] = __builtin_amdgcn_mfma_f32_32x32x16_bf16(pa1, PK(1), o[d0], 0, 0, 0);
        o[d0] = __builtin_amdgcn_mfma_f32_32x32x16_bf16(pa2, PK(2), o[d0], 0, 0, 0);
        o[d0] = __builtin_amdgcn_mfma_f32_32x32x16_bf16(pa3, PK(3), o[d0], 0, 0, 0);
#undef PK
    }
}
#define ATTN_STORE16(p, v) (*(u32x4*)(p) = (v))
template <int THRL> __device__ __forceinline__ void attn_unit(int b, int h, int qb, const bf16* Q, const bf16* __restrict__ K, const bf16* __restrict__ V, bf16* O, const unsigned* masks, char* shm) {
    const int tid = threadIdx.x, lane = tid & 63, r32 = lane & 31, hi = lane >> 5; const int wid = __builtin_amdgcn_readfirstlane(tid >> 6);
    const long rowbase = (long)b * SEQ; const int q0 = qb * QB;
    const bf16* Qw = Q + (rowbase + q0 + wid * QBLK) * QP + h * D;
    const bf16 *Kh = K + rowbase * KP + (h >> 2) * D, *Vh = V + rowbase * KP + (h >> 2) * D;
    const unsigned* mrow = masks + ((size_t)(b * (SEQ / 32) + (q0 >> 5) + wid) * (SEQ / 64)) * 64;
    const unsigned lds0 = (unsigned)(uintptr_t)shm;
    float* wsf = (float*)(shm + LDS_WS) + wid * 64;
    const bf16* ksrc = Kh + (long)lane * KP + wid * 8;
    const bf16* vsrc = Vh + (long)(16 * (wid & 3) + (lane >> 2)) * KP + (wid >> 2) * 32 + (lane & 3) * 8;
    const unsigned kdst = lds0 + LDS_K + wid * 1024, vdst = lds0 + LDS_V + wid * 1024;
#define DMA_K(t, slot) glds16(ksrc + (long)(t) * KVBLK * KP, (unsigned)__builtin_amdgcn_readfirstlane(kdst + (slot)))
#define DMA_V(t, slot) glds16(vsrc + (long)(t) * KVBLK * KP, (unsigned)__builtin_amdgcn_readfirstlane(vdst + (slot)))
    const int vb0 = (int)(lds0 + LDS_V) + ((lane >> 4) & 1) * 32 + (lane & 3) * 8 + (4 * hi + ((lane & 15) >> 2)) * 64;
    const char* Kbase = shm + LDS_K; bf16x8 kf[8];
    const lds_cptr shm3 = (lds_cptr)shm; const lds_cptr kp0 = shm3 + LDS_K + hi * 1024 + r32 * 16; const lds_cptr vp0 = shm3 + LDS_V + ((lane >> 4) & 1) * 32 + (lane & 3) * 8 + (4 * hi + ((lane & 15) >> 2)) * 64;
    const int NT = (q0 + QB) / KVBLK;
    u32x16 mA, mB;
#define MLOAD0(t) do { const unsigned* mp_ = mrow + (size_t)(t) * 64; \
        asm volatile("s_load_dwordx16 %0, %1, 0x0" : "=s"(mA) : "s"(mp_)); asm volatile("s_load_dwordx16 %0, %1, 0x40" : "=s"(mB) : "s"(mp_)); } while (0)
#define MLOAD1(t) do { const unsigned* mp_ = mrow + (size_t)(t) * 64; \
        asm volatile("s_load_dwordx16 %0, %1, 0x80" : "=s"(mA) : "s"(mp_)); asm volatile("s_load_dwordx16 %0, %1, 0xc0" : "=s"(mB) : "s"(mp_)); } while (0)
#define MPAIR(M, j) (((unsigned long long)(M)[2 * (j) + 1] << 32) | (unsigned long long)(M)[2 * (j)])
#define MAPPLY(P) do { asm volatile("s_waitcnt lgkmcnt(0)" : "+s"(mA), "+s"(mB)); const float NEG_ = -INFINITY; \
        _Pragma("unroll") for (int r = 0; r < 8; ++r) { P[r] = msel(P[r], NEG_, MPAIR(mA, r)); P[r + 8] = msel(P[r + 8], NEG_, MPAIR(mB, r)); } } while (0)
    DMA_K(0, 0); DMA_V(0, 0); DMA_K(1, SLOTB);
    MLOAD0(0);
    const lds_cptr qfp = shm3 + LDS_QF + wid * 4096 + lane * 16;
    { bf16x8 qr[4];
#pragma unroll
      for (int d0 = 0; d0 < 4; ++d0) qr[d0] = *reinterpret_cast<const bf16x8*>(&Qw[(long)r32 * QP + d0 * 16 + hi * 8]);
#pragma unroll
      for (int d0 = 0; d0 < 4; ++d0) *(LAS bf16x8*)(LAS char*)(qfp + d0 * 1024) = qr[d0]; }
#define QF(i) (*(const LAS bf16x8*)(qfp + (i) * 1024))
    float mhat = 0.f, l_reg = 0.f; f32x16 o[2]; o[0] = f32x16{}; o[1] = f32x16{}; f32x16 negm = f32x16{}; asm volatile("" : "+v"(negm));
    const int qrel = wid * QBLK + r32;
#define CMASK(P0, P1, t) do { int jb_ = (t) - (NT - 4); if (jb_ >= 0) cmask(P0, P1, jb_, qrel, hi); } while (0)
    bool resc = false;
#define START(P0, P1) do { const float rm = rowmax(P0, P1); resc = false; \
    { const float dl = rm; mhat = fadd_s(mhat, dl); \
      _Pragma("unroll") for (int r = 0; r < 16; ++r) { P0[r] = fsub_s(P0[r], dl); P1[r] = fsub_s(P1[r], dl); } \
      _Pragma("unroll") for (int r = 0; r < 16; ++r) negm[r] = -mhat; asm volatile("" : "+v"(negm)); } } while (0)
#define RESC() do { if (resc) { asm volatile("s_waitcnt lgkmcnt(0)" ::: "memory"); \
      _Pragma("unroll") for (int d_ = 0; d_ < 2; ++d_) _Pragma("unroll") for (int r = 0; r < 16; ++r) o[d_][r] *= wsf[crow(r, hi)]; } } while (0)
    f32x16 pA0, pA1, pB0, pB1;
    int sl_prev = 0, sl_cur = 0, sl_next = SLOTB;
#define ROT() do { sl_prev = sl_cur; sl_cur = sl_next; sl_next = (sl_next == (NSLOT - 1) * SLOTB) ? 0 : sl_next + SLOTB; } while (0)
    DMA_K(2, 2 * SLOTB);
    WAIT_BAR(3);
    qkt(pA0, pA1, Kbase, qfp, negm, r32, hi); asm volatile("s_nop 15\n\ts_nop 7" : "+v"(pA0), "+v"(pA1)); CMASK(pA0, pA1, 0);
    START(pA0, pA1);
    MAPPLY(pA0); MLOAD1(0); MAPPLY(pA1); MLOAD0(1);
    _Pragma("unroll") for (int r = 0; r < 16; ++r) { pA0[r] = __builtin_amdgcn_exp2f(pA0[r]); pA1[r] = __builtin_amdgcn_exp2f(pA1[r]); }
    WAIT_BAR(0);
    DMA_K(3, 0); DMA_V(1, SLOTB);
    ROT();
    kload8(kf, kp0 + sl_cur);
    WAIT_BAR(2);
    s16x4 vlo[8], vhi[8]; u32x4 pw0, pw1, pw2, pw3;
#define PKW(P, B) cvtpk_s(P[B], P[B + 1])
#define PAF(k) __builtin_bit_cast(bf16x8, pw##k)
#define VFR(i) (bf16x8){vlo[i][0], vlo[i][1], vlo[i][2], vlo[i][3], vhi[i][0], vhi[i][1], vhi[i][2], vhi[i][3]}
#define PIN(x) asm volatile("" : "+v"(x))
#define MX3(a, b, c) __builtin_fmaxf(__builtin_fmaxf((a), (b)), (c))
#define GAPA(MF, A0, A1, A2, A3, W0, W1, PW) do { MF; sacc += A0; sacc += A1; sacc += A2; sacc += A3; PIN(sacc); W0; W1; PIN(PW); SBAR(); } while (0)
#define EX(v) __builtin_amdgcn_exp2f(v)
#define GAPB(MF, X, B) do { MF; X[B] = EX(X[B]); X[B + 1] = EX(X[B + 1]); X[B + 2] = EX(X[B + 2]); X[B + 3] = EX(X[B + 3]); PIN(X); SBAR(); } while (0)
#define VRD(i) do { vlo[i] = vtr(vp_ + (((i) >> 2) * 4096 + ((i) & 3) * 1024)); vhi[i] = vtr(vp_ + (((i) >> 2) * 4096 + ((i) & 3) * 1024 + 512)); } while (0)
#define KRD(G, j) do { if (G) { kload2(kf, kp0 + sl_next, j); SBAR(); } } while (0)
#define STEP(C0, C1, P0, P1, t, GK, GV, GL, GM) do { SBAR(); \
    const lds_cptr vp_ = vp0 + sl_prev; \
    VRD(0); bf16x8 qa_ = QF(0), qb_ = QF(1); SBAR(); float sacc = (P0[0] + P0[1]); \
    GAPA(C0 = __builtin_amdgcn_mfma_f32_32x32x16_bf16(kf[0], qa_, negm, 0, 0, 0), P0[2], P0[3], P0[4], P0[5],     pw0[0] = PKW(P0, 0), pw0[1] = PKW(P0, 2), pw0); \
    VRD(4); SBAR(); GAPA(C1 = __builtin_amdgcn_mfma_f32_32x32x16_bf16(kf[1], qa_, negm, 0, 0, 0), P0[6], P0[7], P0[8], P0[9],     pw0[2] = PKW(P0, 4), pw0[3] = PKW(P0, 6), pw0); \
    VRD(1); qa_ = QF(2); SBAR(); GAPA(C0 = __builtin_amdgcn_mfma_f32_32x32x16_bf16(kf[2], qb_, C0, 0, 0, 0),   P0[10], P0[11], P0[12], P0[13], pw1[0] = PKW(P0, 8), pw1[1] = PKW(P0, 10), pw1); \
    VRD(5); SBAR(); GAPA(C1 = __builtin_amdgcn_mfma_f32_32x32x16_bf16(kf[3], qb_, C1, 0, 0, 0),   P0[14], P0[15], P1[0], P1[1],   pw1[2] = PKW(P0, 12), pw1[3] = PKW(P0, 14), pw1); \
    VRD(2); qb_ = QF(3); SBAR(); GAPA(C0 = __builtin_amdgcn_mfma_f32_32x32x16_bf16(kf[4], qa_, C0, 0, 0, 0),   P1[2], P1[3], P1[4], P1[5],     pw2[0] = PKW(P1, 0), pw2[1] = PKW(P1, 2), pw2); \
    VRD(6); SBAR(); GAPA(C1 = __builtin_amdgcn_mfma_f32_32x32x16_bf16(kf[5], qa_, C1, 0, 0, 0),   P1[6], P1[7], P1[8], P1[9],     pw2[2] = PKW(P1, 4), pw2[3] = PKW(P1, 6), pw2); \
    VRD(3); SBAR(); GAPA(C0 = __builtin_amdgcn_mfma_f32_32x32x16_bf16(kf[6], qb_, C0, 0, 0, 0),   P1[10], P1[11], P1[12], P1[13], pw3[0] = PKW(P1, 8), pw3[1] = PKW(P1, 10), pw3); \
    VRD(7); SBAR(); GAPA(C1 = __builtin_amdgcn_mfma_f32_32x32x16_bf16(kf[7], qb_, C1, 0, 0, 0),   P1[14], P1[15], 0.f, 0.f,       pw3[2] = PKW(P1, 12), pw3[3] = PKW(P1, 14), pw3); \
    l_reg += sacc; \
    if (GK) { DMA_K((t) + 3, sl_cur); } if (GV) { DMA_V((t) + 1, sl_next); } \
    CMASK(C0, C1, t); \
    { float a = MX3(C0[0], C0[1], C1[0]), b = MX3(C0[2], C0[3], C1[1]); a = MX3(a, C1[2], C1[3]); \
      _Pragma("unroll") for (int r = 4; r < 16; r += 4) { a = MX3(a, C0[r], C0[r + 1]); b = MX3(b, C0[r + 2], C0[r + 3]); a = MX3(a, C1[r], C1[r + 1]); b = MX3(b, C1[r + 2], C1[r + 3]); } \
      float rm = __builtin_fmaxf(a, b); { auto rr = __builtin_amdgcn_permlane32_swap(__float_as_uint(rm), __float_as_uint(rm), false, false); rm = __builtin_fmaxf(__uint_as_float(rr[0]), __uint_as_float(rr[1])); } \
      resc = false; \
      if (__builtin_expect(__any(rm > (float)THRL), 0)) { const float dl = __builtin_fmaxf(rm, 0.f); mhat += dl; \
        _Pragma("unroll") for (int r = 0; r < 16; ++r) { C0[r] -= dl; C1[r] -= dl; } \
        _Pragma("unroll") for (int r = 0; r < 16; ++r) negm[r] = -mhat; asm volatile("" : "+v"(negm)); \
        const float f = __builtin_amdgcn_exp2f(-dl); l_reg *= f; if (hi == 0) wsf[r32] = f; resc = true; } } \
    MAPPLY(C0); MLOAD1(t); \
    SBAR(); \
    GAPB(o[0] = __builtin_amdgcn_mfma_f32_32x32x16_bf16(PAF(0), VFR(0), o[0], 0, 0, 0), C0, 0); \
    GAPB(o[1] = __builtin_amdgcn_mfma_f32_32x32x16_bf16(PAF(0), VFR(4), o[1], 0, 0, 0), C0, 4); \
    KRD(GL, 0); GAPB(o[0] = __builtin_amdgcn_mfma_f32_32x32x16_bf16(PAF(1), VFR(1), o[0], 0, 0, 0), C0, 8); \
    KRD(GL, 1); GAPB(o[1] = __builtin_amdgcn_mfma_f32_32x32x16_bf16(PAF(1), VFR(5), o[1], 0, 0, 0), C0, 12); \
    MAPPLY(C1); if (GM) { MLOAD0((t) + 1); } SBAR(); \
    KRD(GL, 2); GAPB(o[0] = __builtin_amdgcn_mfma_f32_32x32x16_bf16(PAF(2), VFR(2), o[0], 0, 0, 0), C1, 0); \
    KRD(GL, 3); GAPB(o[1] = __builtin_amdgcn_mfma_f32_32x32x16_bf16(PAF(2), VFR(6), o[1], 0, 0, 0), C1, 4); \
    GAPB(o[0] = __builtin_amdgcn_mfma_f32_32x32x16_bf16(PAF(3), VFR(3), o[0], 0, 0, 0), C1, 8); \
    GAPB(o[1] = __builtin_amdgcn_mfma_f32_32x32x16_bf16(PAF(3), VFR(7), o[1], 0, 0, 0), C1, 12); \
    } while (0)
    int t = 1;
#undef CMASK
#define CMASK(P0, P1, t) do { } while (0)
    for (; t + 5 < NT; t += 2) {
        STEP(pB0, pB1, pA0, pA1, t, true, true, true, true);     WAIT_BAR(2); RESC(); ROT();
        STEP(pA0, pA1, pB0, pB1, t + 1, true, true, true, true); WAIT_BAR(2); RESC(); ROT();
    }
#undef CMASK
#define CMASK(P0, P1, t) do { int jb_ = (t) - (NT - 4); if (jb_ >= 0) cmask(P0, P1, jb_, qrel, hi); } while (0)
#define ENDW(tt) do { if ((tt) + 3 < NT) { WAIT_BAR(2); } else if ((tt) + 2 < NT) { WAIT_BAR(1); } else { WAIT_BAR(0); } } while (0)
    for (; t + 1 < NT; t += 2) {
        STEP(pB0, pB1, pA0, pA1, t, (t + 3 < NT), (t + 1 < NT), (t + 1 < NT), (t + 1 < NT));         ENDW(t);     RESC(); ROT();
        STEP(pA0, pA1, pB0, pB1, t + 1, (t + 4 < NT), (t + 2 < NT), (t + 2 < NT), (t + 2 < NT));     ENDW(t + 1); RESC(); ROT();
    }
    STEP(pB0, pB1, pA0, pA1, NT - 1, false, false, false, false); RESC();
    { float sacc = pB0[0] + pB0[1]; _Pragma("unroll") for (int r = 2; r < 16; ++r) sacc += pB0[r]; _Pragma("unroll") for (int r = 0; r < 16; ++r) sacc += pB1[r]; l_reg += sacc;
      pw0 = (u32x4){PKW(pB0, 0), PKW(pB0, 2), PKW(pB0, 4), PKW(pB0, 6)}; pw1 = (u32x4){PKW(pB0, 8), PKW(pB0, 10), PKW(pB0, 12), PKW(pB0, 14)}; pw2 = (u32x4){PKW(pB1, 0), PKW(pB1, 2), PKW(pB1, 4), PKW(pB1, 6)}; pw3 = (u32x4){PKW(pB1, 8), PKW(pB1, 10), PKW(pB1, 12), PKW(pB1, 14)};
      SBAR(); pv(o, vb0 + sl_cur, PAF(0), PAF(1), PAF(2), PAF(3)); }
#undef PKW
#undef PAF
#undef VFR
#undef PIN
#undef MX3
#undef GAPA
#undef GAPB
#undef EX
#undef VRD
#undef KRD
#undef STEP
#undef ENDW
    { auto rr = __builtin_amdgcn_permlane32_swap(__float_as_uint(l_reg), __float_as_uint(l_reg), false, false); l_reg = __uint_as_float(rr[0]) + __uint_as_float(rr[1]); }
    if (hi == 0) wsf[32 + r32] = l_reg; asm volatile("s_waitcnt lgkmcnt(0)" ::: "memory");
    float rli[16];
#pragma unroll
    for (int r = 0; r < 16; ++r) rli[r] = __builtin_amdgcn_rcpf(wsf[32 + crow(r, hi)]);
    bf16* Ow = O + (rowbase + q0 + wid * QBLK) * OP + OCOL + h * D;
    { bf16* stg = (bf16*)(shm + LDS_OST) + wid * 2048;
#pragma unroll
      for (int r = 0; r < 16; ++r) { const int orow = crow(r, hi);
#pragma unroll
        for (int d0 = 0; d0 < 2; ++d0) stg[orow * 64 + d0 * 32 + r32] = __float2bfloat16(o[d0][r] * rli[r]); }
      asm volatile("s_waitcnt lgkmcnt(0)" ::: "memory");
#pragma unroll
      for (int i = 0; i < 4; ++i) { const int row = i * 8 + (lane >> 3), ch = lane & 7; const u32x4 v = *(const u32x4*)(stg + row * 64 + ch * 8); ATTN_STORE16(Ow + (long)row * OP + ch * 8, v); } }
    asm volatile("s_waitcnt lgkmcnt(0)\n\ts_barrier" ::: "memory");
#undef DMA_K
#undef DMA_V
#undef CMASK
#undef START
#undef RESC
#undef ROT
#undef MLOAD0
#undef MLOAD1
#undef MPAIR
#undef QF
#undef MAPPLY
}
#undef SBAR
#undef WAIT_BAR
}

#define XB_TMO      128
#define XB_XCNT(j)  (256  + 64 * (j))
#define XB_XSUB(j)  (1280 + 64 * (j))
#define XB_XGEN(j)  (2304 + 64 * (j))
#define XB_TOP      3328
#define XB_TOPGEN   3392
#define XCD_BAR_WORDS 3456
#define XB_SPIN_CAP (1u << 18)
__device__ __forceinline__ unsigned xb_ld(unsigned* p)              { return __hip_atomic_load(p, __ATOMIC_RELAXED, __HIP_MEMORY_SCOPE_AGENT); }
__device__ __forceinline__ unsigned xb_add(unsigned* p, unsigned v) { return __hip_atomic_fetch_add(p, v, __ATOMIC_RELAXED, __HIP_MEMORY_SCOPE_AGENT); }
__device__ __forceinline__ unsigned xb_xcc_id() { return (unsigned)__builtin_amdgcn_s_getreg((3 << 11) | 20) & 0xFu; }
#define XB_SPIN(cond, bar) do { unsigned _sp = 0; while (cond) { __builtin_amdgcn_s_sleep(1); \
    if ((++_sp & 255u) == 0u) { if (xb_ld(&(bar)[XB_TMO])) break; if (_sp > XB_SPIN_CAP) { atomicAdd(&(bar)[XB_TMO], 1u); break; } } } } while (0)
struct XcdBarrier { unsigned* bar; unsigned x; volatile LAS unsigned* st; };
__device__ __forceinline__ XcdBarrier xcd_barrier_post(unsigned* bar, volatile LAS unsigned* st) {
    XcdBarrier b; b.bar = bar; b.x = xb_xcc_id(); b.st = st;
    if (threadIdx.x == 0) (void)xb_add(&bar[XB_XCNT(b.x)], 1u);
    return b;
}
__device__ __forceinline__ void xcd_barrier_complete(unsigned* bar, unsigned x, unsigned& nloc, unsigned& nx) {
    const unsigned G = gridDim.x * gridDim.y * gridDim.z;
    unsigned sum, cnt, mine, sp = 0u;
    for (;;) {
        sum = 0u; cnt = 0u; mine = 0u;
#pragma unroll
        for (unsigned j = 0; j < 16; ++j) { const unsigned c = xb_ld(&bar[XB_XCNT(j)]); sum += c; cnt += (c > 0u) ? 1u : 0u; mine = (j == x) ? c : mine; }
        if (sum == G) break;
        __builtin_amdgcn_s_sleep(1);
        if ((++sp & 255u) == 0u) { if (xb_ld(&bar[XB_TMO])) break; if (sp > XB_SPIN_CAP) { atomicAdd(&bar[XB_TMO], 1u); break; } }
    }
    nloc = mine > 0u ? mine : 1u; nx = cnt > 0u ? cnt : 1u;
}
__device__ __forceinline__ void xcd_barrier(const XcdBarrier& b) {
    asm volatile("s_waitcnt vmcnt(0)" ::: "memory");
    __syncthreads();
    if (threadIdx.x == 0) {
        unsigned* bar = b.bar;
        __builtin_amdgcn_s_waitcnt(0);
        unsigned nloc = b.st[0], nx = b.st[1];
        if (nloc == 0u) { xcd_barrier_complete(bar, b.x, nloc, nx); b.st[0] = nloc; b.st[1] = nx; }
        const unsigned old = xb_add(&bar[XB_XSUB(b.x)], 1u);
        const unsigned gen = old / nloc;
        if (old + 1u == (gen + 1u) * nloc) {
            __builtin_amdgcn_fence(__ATOMIC_RELEASE, "agent");
            asm volatile("s_waitcnt vmcnt(0)" ::: "memory");
            const unsigned og = xb_add(&bar[XB_TOP], 1u);
            const unsigned tg = og / nx;
            if (og + 1u == (tg + 1u) * nx) xb_add(&bar[XB_TOPGEN], 1u);
            else XB_SPIN(xb_ld(&bar[XB_TOPGEN]) == tg, bar);
            __builtin_amdgcn_fence(__ATOMIC_ACQUIRE, "agent");
            xb_add(&bar[XB_XGEN(b.x)], 1u);
            asm volatile("s_waitcnt vmcnt(0)" ::: "memory");
        } else {
            XB_SPIN(xb_ld(&bar[XB_XGEN(b.x)]) == gen, bar);
            __builtin_amdgcn_fence(__ATOMIC_ACQUIRE, "agent");
            asm volatile("s_waitcnt vmcnt(0)" ::: "memory");
        }
    }
    __syncthreads();
}

struct Frame {
    LAS unsigned char* lds; volatile LAS unsigned* MISC; unsigned* ctl;
    int tid, lane, wave, vcu, G;
    unsigned char* ws;
};
struct Args { const float* in[18]; float* out; unsigned char* ws; int ph_lo, ph_hi, flags, pad; };
typedef const __attribute__((address_space(4))) Args* KArgs;
__device__ __forceinline__ KArgs kargs() { KArgs p = (KArgs)__builtin_amdgcn_kernarg_segment_ptr(); asm volatile("" : "+s"(p)); return p; }

__device__ __forceinline__ int ropeperm(int d) { return d < 8 ? 2 * d : (d < 16 ? 2 * (d - 8) + 1 : d); }
__device__ __forceinline__ int win_row(int c) {
    if (c < 512)  return (c & ~63) + ropeperm(c & 63);
    if (c < 640)  { const int cc = c - 512; return 512 + (cc & ~63) + ropeperm(cc & 63); }
    if (c < 768)  return c;
    if (c < 1280) { const int cc = c - 768; return 768 + (cc & ~63) + ropeperm(cc & 63); }
    if (c < 1344) return 1280 + ropeperm(c - 1280);
    if (c < 1352) return c;
    if (c < 1864) { const int ch = c - 1352; return 1536 + (ch >> 7) * 256 + (ch & 127); }
    if (c < 2376) return 2560 + (c - 1864);
    if (c < 2888) { const int ch = c - 2376; return 1536 + (ch >> 7) * 256 + 128 + (ch & 127); }
    { const int g = c - 2888, gi = g & 1023; return 3072 + (gi >> 7) * 256 + (g >> 10) * 128 + (gi & 127); }
}
struct TItem { const float* src; bf16_t* WT; int N, KT, rbase, mode, n0, k0, kd; };
__device__ __forceinline__ void t_load(const TItem& t, float (&rg)[32], int lane) {
    int nn = t.n0 + (lane & 31); if (nn >= t.N) nn = t.N - 1;
    const float* p = t.src + (size_t)(t.k0 + (lane >> 5)) * t.N + nn;
#pragma unroll
    for (int i = 0; i < 32; ++i) rg[i] = __builtin_nontemporal_load(p + (size_t)(2 * i) * t.N);
}
__device__ __forceinline__ void t_write(const TItem& t, const float (&rg)[32], LAS float* scr, int lane) {
#pragma unroll
    for (int i = 0; i < 32; ++i) scr[(2 * i + (lane >> 5)) * 33 + (lane & 31)] = rg[i];
    LDS_WAIT(); asm volatile("" ::: "memory");
    if (t.mode >= 3) {
        const int c4 = lane & 3;
#pragma unroll
        for (int j = 0; j < 2; ++j) { const int n = (lane >> 2) + 16 * j; const LAS float* sp = scr + (16 * c4) * 33 + n;
            if (t.n0 + n < t.N) { const int nn = t.n0 + n; const int row = t.mode == 3 ? t.rbase + (nn >> 7) * 256 + (nn & 127) : t.rbase + nn;
                u32x4 o;
#pragma unroll
                for (int q = 0; q < 4; ++q) { int wv = 0;
                    wv = __builtin_amdgcn_cvt_pk_fp8_f32(32.f * sp[(4 * q + 0) * 33], 32.f * sp[(4 * q + 1) * 33], wv, false);
                    wv = __builtin_amdgcn_cvt_pk_fp8_f32(32.f * sp[(4 * q + 2) * 33], 32.f * sp[(4 * q + 3) * 33], wv, true); o[q] = (unsigned)wv; }
                *(u32x4*)((unsigned char*)t.WT + (size_t)row * t.KT + t.k0 + 16 * c4) = o; } }
        LDS_WAIT(); asm volatile("" ::: "memory");
        return;
    }
    const int c = lane & 7;
#pragma unroll
    for (int j = 0; j < 4; ++j) { const int n = (lane >> 3) + 8 * j; const LAS float* sp = scr + (8 * c) * 33 + n;
        if (t.n0 + n < t.N) { const int nn = t.n0 + n; const int row = t.mode == 0 ? t.rbase + nn : (t.mode == 1 ? win_row(nn) : t.rbase + (nn >> 7) * 256 + (nn & 127));
            u32x4 o; o.x = pkbf(sp[0 * 33], sp[1 * 33]); o.y = pkbf(sp[2 * 33], sp[3 * 33]); o.z = pkbf(sp[4 * 33], sp[5 * 33]); o.w = pkbf(sp[6 * 33], sp[7 * 33]);
            *(u32x4*)(t.WT + (size_t)row * t.KT + t.kd + t.k0 + 8 * c) = o; } }
    LDS_WAIT(); asm volatile("" ::: "memory");
}
__device__ __forceinline__ void p0_prologue(Frame& F) {
    const KArgs ka = kargs();
    unsigned char* ws = F.ws;
    LAS float* scr = (LAS float*)(F.lds + F.wave * 16384);
    const int gw = F.vcu * NWAVES + F.wave, NGW = F.G * NWAVES;
    const int gt = F.vcu * 512 + F.tid, NGT = F.G * 512;
    bf16_t* Win = (bf16_t*)(ws + WS_WIN); bf16_t* Wau = (bf16_t*)(ws + WS_WAU); bf16_t* Wout = (bf16_t*)(ws + WS_WOUT);
    bf16_t* Wd = (bf16_t*)(ws + WS_WD); bf16_t* Wgu = (bf16_t*)(ws + WS_WGU);
    constexpr int I_IN = 16 * 155, I_AU = 8 * 32, I_OUT = 16 * 32, I_G = 32 * 16 * 16, I_D = 32 * 8 * 32;
    constexpr int NITEMS = I_IN + 2 * I_AU + I_OUT + 2 * I_G + I_D;
    const float *p_win = ka->in[1], *p_wau = ka->in[3], *p_wcu = ka->in[4], *p_wout = ka->in[6], *p_wg = ka->in[13], *p_wu = ka->in[14], *p_wd = ka->in[15];
#define T_DECODE(IT, T) do { int r_ = (IT); \
        if (r_ < I_IN) { T = TItem{p_win, Win, INW, 1024, 0, 1, 32 * (r_ % 155), 64 * (r_ / 155), 0}; } else { r_ -= I_IN; \
        if (r_ < I_AU) { T = TItem{p_wau, Wau, 1024, 1024, 0, 0, 32 * (r_ % 32), 64 * (r_ / 32), 512};     } else { r_ -= I_AU; \
        if (r_ < I_AU) { T = TItem{p_wcu, Wau, 1024, 1024, 0, 0, 32 * (r_ % 32), 64 * (r_ / 32), 0}; } else { r_ -= I_AU; \
        if (r_ < I_OUT) { T = TItem{p_wout, Wout, 1024, 1024, 0, 0, 32 * (r_ % 32), 64 * (r_ / 32), 0}; } else { r_ -= I_OUT; \
        if (r_ < I_G) { const int e_ = r_ >> 8, q_ = r_ & 255; T = TItem{p_wg + (size_t)e_ * 1024 * 512, Wgu, 512, 1024, e_ * 1024, 3, 32 * (q_ & 15), 64 * (q_ >> 4), 0}; } else { r_ -= I_G; \
        if (r_ < I_G) { const int e_ = r_ >> 8, q_ = r_ & 255; T = TItem{p_wu + (size_t)e_ * 1024 * 512, Wgu, 512, 1024, e_ * 1024 + 128, 3, 32 * (q_ & 15), 64 * (q_ >> 4), 0}; } else { r_ -= I_G; \
        { const int e_ = r_ >> 8, q_ = r_ & 255; T = TItem{p_wd + (size_t)e_ * 512 * 1024, Wd, 1024, 512, e_ * 1024, 4, 32 * (q_ & 31), 64 * (q_ >> 5), 0}; } } } } } } } } while (0)
    const int nitems = (F.G == 256) ? I_IN + 2 * I_AU + I_OUT : NITEMS;
    if (gw < nitems) {
        TItem cur, nxt; float rc[32], rn[32];
        T_DECODE(gw, cur); t_load(cur, rc, F.lane);
        for (int it = gw; it < nitems; it += NGW) {
            const int itn = (it + NGW < nitems) ? it + NGW : it;
            T_DECODE(itn, nxt); t_load(nxt, rn, F.lane);
            t_write(cur, rc, scr, F.lane);
            cur = nxt;
#pragma unroll
            for (int i = 0; i < 32; ++i) rc[i] = rn[i];
        }
    }
#undef T_DECODE
    for (int i = gt; i < 184 * 128; i += NGT) *(u32x4*)(Win + (size_t)1352 * 1024 + (size_t)i * 8) = (u32x4){0u, 0u, 0u, 0u};
    float* rope = (float*)(ws + WS_ROPE);
    for (int i = gt; i < SEQ * 8; i += NGT) { const int pos = i >> 3, j = i & 7;
        const float inv = (float)pow(500000.0, -(double)j / 8.0); const float ang = (float)pos * inv;
        rope[i] = cosf(ang); rope[SEQ * 8 + i] = sinf(ang); }
    { float* wc = (float*)(ws + WS_WC); const float* rgw = ka->in[9]; const float* rew = ka->in[11];
      for (int i = gt; i < 1024 * 48; i += NGT) { const int k = i / 48, c = i % 48;
          wc[i] = c < 4 ? rgw[k * 4 + c] : (c < 36 ? rew[(size_t)((c - 4) >> 3) * 1024 * 8 + k * 8 + ((c - 4) & 7)] : 0.f); } }
    const float* x = ka->in[0]; bf16_t* xb = (bf16_t*)(ws + WS_XB);
    for (size_t i = gt; i < (size_t)NTOK * DM / 8; i += (size_t)NGT * 4) {
        f32x4 va[4], vb[4];
#pragma unroll
        for (int q = 0; q < 4; ++q) { size_t ii = i + (size_t)q * NGT; if (ii >= (size_t)NTOK * DM / 8) ii = i; va[q] = __builtin_nontemporal_load((const f32x4*)(x + ii * 8)); vb[q] = __builtin_nontemporal_load((const f32x4*)(x + ii * 8 + 4)); }
#pragma unroll
        for (int q = 0; q < 4; ++q) { const size_t ii = i + (size_t)q * NGT; if (ii < (size_t)NTOK * DM / 8) store8bf(xb + ii * 8, va[q], vb[q]); } }
}

__device__ __forceinline__ int dpp_sum_i(int v) {
    v += __builtin_amdgcn_update_dpp(0, v, 0x111, 0xf, 0xf, true); v += __builtin_amdgcn_update_dpp(0, v, 0x112, 0xf, 0xf, true);
    v += __builtin_amdgcn_update_dpp(0, v, 0x114, 0xf, 0xf, true); v += __builtin_amdgcn_update_dpp(0, v, 0x118, 0xf, 0xf, true);
    return __builtin_amdgcn_readlane(v, 15) + __builtin_amdgcn_readlane(v, 31) + __builtin_amdgcn_readlane(v, 47) + __builtin_amdgcn_readlane(v, 63);
}
__device__ __forceinline__ float dpp_shr_f(float v, int ctrl_sel) {
    const int vi = __float_as_int(v);
    return __int_as_float(ctrl_sel == 1 ? __builtin_amdgcn_update_dpp(vi, vi, 0x111, 0xf, 0xf, false) : ctrl_sel == 2 ? __builtin_amdgcn_update_dpp(vi, vi, 0x112, 0xf, 0xf, false)
                        : ctrl_sel == 4 ? __builtin_amdgcn_update_dpp(vi, vi, 0x114, 0xf, 0xf, false) : __builtin_amdgcn_update_dpp(vi, vi, 0x118, 0xf, 0xf, false));
}
__device__ __forceinline__ float dpp_max_f(float v) {
    v = fmaxf(v, dpp_shr_f(v, 1)); v = fmaxf(v, dpp_shr_f(v, 2)); v = fmaxf(v, dpp_shr_f(v, 4)); v = fmaxf(v, dpp_shr_f(v, 8));
    const float a = __int_as_float(__builtin_amdgcn_readlane(__float_as_int(v), 15)), b = __int_as_float(__builtin_amdgcn_readlane(__float_as_int(v), 31));
    const float c = __int_as_float(__builtin_amdgcn_readlane(__float_as_int(v), 47)), d = __int_as_float(__builtin_amdgcn_readlane(__float_as_int(v), 63));
    return fmaxf(fmaxf(a, b), fmaxf(c, d));
}
__device__ __forceinline__ float dpp_min_f(float v) { return -dpp_max_f(-v); }
__device__ __forceinline__ float dpp_sum_f(float v) {
    v += __int_as_float(__builtin_amdgcn_update_dpp(0, __float_as_int(v), 0x111, 0xf, 0xf, true)); v += __int_as_float(__builtin_amdgcn_update_dpp(0, __float_as_int(v), 0x112, 0xf, 0xf, true));
    v += __int_as_float(__builtin_amdgcn_update_dpp(0, __float_as_int(v), 0x114, 0xf, 0xf, true)); v += __int_as_float(__builtin_amdgcn_update_dpp(0, __float_as_int(v), 0x118, 0xf, 0xf, true));
    const float a = __int_as_float(__builtin_amdgcn_readlane(__float_as_int(v), 15)), b = __int_as_float(__builtin_amdgcn_readlane(__float_as_int(v), 31));
    const float c = __int_as_float(__builtin_amdgcn_readlane(__float_as_int(v), 47)), d = __int_as_float(__builtin_amdgcn_readlane(__float_as_int(v), 63));
    return (a + b) + (c + d);
}
template <int NC>
__device__ __forceinline__ void select_token(const LAS float* srow, int t, int lane, unsigned tbit, LAS unsigned* maskw) {
    if (t < 256) {
#pragma unroll
        for (int c = 0; c < (NC < 4 ? NC : 4); ++c) if (64 * c + lane <= t) (void)__hip_atomic_fetch_or(maskw + 64 * c + lane, tbit, __ATOMIC_RELAXED, __HIP_MEMORY_SCOPE_WORKGROUP);
        return;
    }
    float x[NC];
#pragma unroll
    for (int c = 0; c < NC; ++c) x[c] = srow[64 * c + lane];
#pragma unroll
    for (int c = 4; c < NC; ++c) if (64 * c + 63 > t) x[c] = (64 * c + lane <= t) ? x[c] : -INFINITY;
    float mn = fminf(fminf(x[0], x[1]), fminf(x[2], x[3])), mx = -INFINITY;
#pragma unroll
    for (int c = 0; c < NC; ++c) mx = fmaxf(mx, x[c]);
    mn = dpp_min_f(mn);
    float lo = mn - (fabsf(mn) * 1e-6f + 1e-30f), hi = dpp_max_f(mx);
    const float BIGF = 0x1p100f;
#define COUNT_GT(P, OUT) do { const float nb1_ = -(P) * BIGF; const f32x2 nb_ = {nb1_, nb1_}, bg_ = {BIGF, BIGF}; f32x2 a0_ = {0.f, 0.f}, a1_ = {0.f, 0.f}, a2_ = {0.f, 0.f}, a3_ = {0.f, 0.f}; \
        _Pragma("unroll") for (int c = 0; c < NC; c += 8) { f32x2 y_[4]; \
            _Pragma("unroll") for (int e = 0; e < 4; ++e) { const f32x2 xx_ = {x[c + 2 * e], x[c + 2 * e + 1]}; asm("v_pk_fma_f32 %0, %1, %2, %3 clamp" : "=v"(y_[e]) : "v"(xx_), "v"(bg_), "v"(nb_)); } \
            a0_ += y_[0]; a1_ += y_[1]; a2_ += y_[2]; a3_ += y_[3]; } \
        const f32x2 s2_ = (a0_ + a1_) + (a2_ + a3_); OUT = (int)(dpp_sum_f(s2_[0] + s2_[1]) + 0.5f); } while (0)
    float tau = hi; int need = 256; bool exact = false;
#ifndef PROBE_SEL
#define PROBE_SEL 0
#endif
    {
        float glo = (float)(t + 1) - 255.5f, ghi = -255.5f; int side = 0;
        for (int it = 0; it < 200; ++it) {
            float p = lo + (hi - lo) * (glo * __builtin_amdgcn_rcpf(glo - ghi));
            if (it >= 48 || !(p > lo) || !(p < hi)) p = lo + (hi - lo) * 0.5f;
            if (!(p > lo) || !(p < hi)) break;
            int cm; COUNT_GT(p, cm);
            if (cm == 256) { tau = p; exact = true; break; }
            if (cm > 256) { lo = p; glo = (float)cm - 255.5f; if (side < 0) ghi *= 0.5f; side = -1; }
            else { hi = p; ghi = (float)cm - 255.5f; if (side > 0) glo *= 0.5f; side = 1; }
        }
        if (!exact) { tau = hi; int g; COUNT_GT(hi, g); need = 256 - g; }
    }
#undef COUNT_GT
    if (exact) {
#pragma unroll
        for (int c = 0; c < NC; ++c) (void)__hip_atomic_fetch_or(maskw + 64 * c + lane, (x[c] > tau) ? tbit : 0u, __ATOMIC_RELAXED, __HIP_MEMORY_SCOPE_WORKGROUP);
    } else {
        int base = 0;
#pragma unroll
        for (int c = 0; c < NC; ++c) {
            const bool gt = x[c] > tau, eq = x[c] == tau;
            const unsigned long long tb = __ballot(eq);
            const int rank = base + (int)__builtin_amdgcn_mbcnt_hi((unsigned)(tb >> 32), __builtin_amdgcn_mbcnt_lo((unsigned)tb, 0u));
            base += __popcll(tb);
            if (gt || (eq && rank < need)) (void)__hip_atomic_fetch_or(maskw + 64 * c + lane, tbit, __ATOMIC_RELAXED, __HIP_MEMORY_SCOPE_WORKGROUP);
        }
    }
}
struct XItem { const float* src; unsigned char* dst; int N; };
__device__ __forceinline__ XItem x_decode(int id, int lane, const float* wg, const float* wu, const float* wd, unsigned char* Wgu8, unsigned char* Wd8) {
    const int m = id >> 13, r = id & 8191, e = r >> 8, q = r & 255; XItem t;
    if (m < 2) { const int kb = q >> 3, nb = q & 7, n = nb * 64 + lane;
        t.src = (m == 0 ? wg : wu) + (size_t)e * 1024 * 512 + (size_t)(kb * 32) * 512 + nb * 64; t.N = 512;
        t.dst = Wgu8 + (size_t)(e * 1024 + (n >> 7) * 256 + m * 128 + (n & 127)) * 1024 + kb * 32; }
    else { const int kb = q >> 4, nb = q & 15, n = nb * 64 + lane;
        t.src = wd + (size_t)e * 512 * 1024 + (size_t)(kb * 32) * 1024 + nb * 64; t.N = 1024;
        t.dst = Wd8 + (size_t)(e * 1024 + n) * 512 + kb * 32; }
    return t;
}
__device__ __forceinline__ void x_load(const XItem& t, float (&rg)[32], int lane) {
    unsigned voff = (unsigned)lane * 4u; const unsigned stride = (unsigned)t.N * 4u; const float* base = t.src;
#define XL_(i) "global_load_dword %" #i ", %16, %17 nt\n\tv_add_u32_e32 %16, %18, %16\n\t"
#define XL16_ XL_(0) XL_(1) XL_(2) XL_(3) XL_(4) XL_(5) XL_(6) XL_(7) XL_(8) XL_(9) XL_(10) XL_(11) XL_(12) XL_(13) XL_(14) XL_(15)
    asm volatile(XL16_ : "=&v"(rg[0]), "=&v"(rg[1]), "=&v"(rg[2]), "=&v"(rg[3]), "=&v"(rg[4]), "=&v"(rg[5]), "=&v"(rg[6]), "=&v"(rg[7]), "=&v"(rg[8]), "=&v"(rg[9]), "=&v"(rg[10]), "=&v"(rg[11]), "=&v"(rg[12]), "=&v"(rg[13]), "=&v"(rg[14]), "=&v"(rg[15]), "+v"(voff) : "s"(base), "s"(stride));
    asm volatile(XL16_ : "=&v"(rg[16]), "=&v"(rg[17]), "=&v"(rg[18]), "=&v"(rg[19]), "=&v"(rg[20]), "=&v"(rg[21]), "=&v"(rg[22]), "=&v"(rg[23]), "=&v"(rg[24]), "=&v"(rg[25]), "=&v"(rg[26]), "=&v"(rg[27]), "=&v"(rg[28]), "=&v"(rg[29]), "=&v"(rg[30]), "=&v"(rg[31]), "+v"(voff) : "s"(base), "s"(stride));
#undef XL16_
#undef XL_
}
__device__ __forceinline__ void x_store(const XItem& t, float (&rg)[32]) {
    asm volatile("s_waitcnt vmcnt(0)" ::: "memory");
#pragma unroll
    for (int i = 0; i < 32; ++i) asm volatile("" : "+v"(rg[i]));
    u32x4 o0, o1;
#pragma unroll
    for (int q = 0; q < 4; ++q) { int w0 = 0, w1 = 0;
        w0 = __builtin_amdgcn_cvt_pk_fp8_f32(32.f * rg[4 * q], 32.f * rg[4 * q + 1], w0, false); w0 = __builtin_amdgcn_cvt_pk_fp8_f32(32.f * rg[4 * q + 2], 32.f * rg[4 * q + 3], w0, true);
        w1 = __builtin_amdgcn_cvt_pk_fp8_f32(32.f * rg[16 + 4 * q], 32.f * rg[16 + 4 * q + 1], w1, false); w1 = __builtin_amdgcn_cvt_pk_fp8_f32(32.f * rg[16 + 4 * q + 2], 32.f * rg[16 + 4 * q + 3], w1, true);
        o0[q] = (unsigned)w0; o1[q] = (unsigned)w1; }
    *(u32x4*)t.dst = o0; *(u32x4*)(t.dst + 16) = o1;
}
__device__ __forceinline__ void score_select_unit(Frame& F, int b, int qt16, const bf16_t* qi, const bf16_t* ki, const float* wi, LAS float* scl, LAS unsigned* maskw, unsigned* masks, int xid0, int xid1) {
    const int lane = F.lane, wid = F.wave, r = lane & 31, h = lane >> 5;
    const int T0 = qt16 * 16; const size_t rowb = (size_t)b * SEQ;
    XItem xa, xb; float xr0[32], xr1[32];
    { const KArgs ka = kargs(); unsigned char* w8a = F.ws + WS_WGU; unsigned char* w8b = F.ws + WS_WD;
      xa = x_decode(xid0 >= 0 ? xid0 : 0, lane, ka->in[13], ka->in[14], ka->in[15], w8a, w8b); xb = x_decode(xid1 >= 0 ? xid1 : 0, lane, ka->in[13], ka->in[14], ka->in[15], w8a, w8b); }
    {
        LAS float* wtab = (LAS float*)(F.lds + TAB_OFF + 8192);
        if (F.tid < 128) wtab[F.tid] = wi[(rowb + T0) * 8 + F.tid] * WSCALE;
        bf16x8 a[4][4];
        const int tk = (r >> 4) + 2 * ((r >> 2) & 1), hd = (r & 3) + 4 * ((r >> 3) & 1);
        const int nsteps = ((T0 + 15) >> 8) + 1, kb0 = 32 * wid;
        const char* kbu = (const char*)(ki + (rowb >> 5) * 2048 + (size_t)wid * 2048);
        const unsigned klo = (unsigned)(r * 16 + h * 8) * 2u;
#define KI_LD4(DST, KN) do { const char* ks_ = kbu + (size_t)(KN) * 32768; asm volatile("" : "+s"(ks_)); \
            _Pragma("unroll") for (int kk = 0; kk < 4; ++kk) DST[kk] = *(const GAS bf16x8*)((const GAS char*)ks_ + klo + 1024 * kk); } while (0)
        bf16x8 bfA[4], bfB[4];
        KI_LD4(bfA, 0);
        { const char* qbu = (const char*)(qi + (rowb + T0) * 512); asm volatile("" : "+s"(qbu)); const unsigned qlo = (unsigned)(tk * 512 + hd * 64 + 8 * h) * 2u;
#pragma unroll
          for (int rb = 0; rb < 4; ++rb)
#pragma unroll
              for (int kk = 0; kk < 4; ++kk) a[rb][kk] = *(const GAS bf16x8*)((const GAS char*)qbu + qlo + (rb * 4096 + 32 * kk)); }
        LDS_WAIT(); __syncthreads();
        const LAS float* wl = wtab + 16 * h;
#define SCORE_STEP(KS, BF) do { const int kb_ = 256 * (KS) + kb0; if (kb_ <= T0 + 15) { \
            _Pragma("unroll") for (int rb = 0; rb < 4; ++rb) { \
                f32x16 acc = f32x16{}; \
                _Pragma("unroll") for (int kk = 0; kk < 4; ++kk) acc = __builtin_amdgcn_mfma_f32_32x32x16_bf16(a[rb][kk], BF[kk], acc, 0, 0, 0); \
                const f32x4 w0_ = *(const LAS f32x4*)(wl + 32 * rb), w1_ = *(const LAS f32x4*)(wl + 32 * rb + 4), w2_ = *(const LAS f32x4*)(wl + 32 * rb + 8), w3_ = *(const LAS f32x4*)(wl + 32 * rb + 12); \
                float s0 = 0.f, s1 = 0.f; \
                _Pragma("unroll") for (int reg = 0; reg < 4; ++reg) {     \
                    const float y0_ = __int_as_float(max(__float_as_int(acc[reg]), 0)), y1_ = __int_as_float(max(__float_as_int(acc[reg + 4]), 0)); \
                    const float y2_ = __int_as_float(max(__float_as_int(acc[reg + 8]), 0)), y3_ = __int_as_float(max(__float_as_int(acc[reg + 12]), 0)); \
                    s0 += w0_[reg] * y0_; s0 += w1_[reg] * y1_; s1 += w2_[reg] * y2_; s1 += w3_[reg] * y3_; } \
                LAS float* sp = scl + (4 * rb + 2 * h) * 2048 + kb_ + r; \
                sp[0] = s0; sp[2048] = s1; } } } while (0)
        for (int ks = 0; ks < nsteps; ks += 2) {
            { const int kn = (ks + 1 < 8) ? ks + 1 : 7;
              KI_LD4(bfB, kn); }
            SCORE_STEP(ks, bfA);
            { const int kn = (ks + 2 < 8) ? ks + 2 : 7;
              KI_LD4(bfA, kn); }
            if (ks + 1 < nsteps) SCORE_STEP(ks + 1, bfB);
        }
#undef SCORE_STEP
#undef KI_LD4
    }
    if (F.tid == 0) *(LAS int*)(F.lds + TAB_OFF + 8192 + 512) = 0;
    LDS_WAIT(); __syncthreads();
    if (xid0 >= 0) x_load(xa, xr0, lane);
    if (xid1 >= 0) x_load(xb, xr1, lane);
#ifndef PROBE_P2
#define PROBE_P2 0
#endif
    LAS int* tokctr = (LAS int*)(F.lds + TAB_OFF + 8192 + 512);
#pragma unroll 1
    for (;;) {
        int tl = 0; if (lane == 0) tl = __hip_atomic_fetch_add(tokctr, 1, __ATOMIC_RELAXED, __HIP_MEMORY_SCOPE_WORKGROUP);
        tl = __builtin_amdgcn_readfirstlane(tl);
        if (tl >= 16) break;
        const int t = T0 + tl, nch = (t >> 6) + 1;
        const unsigned tbit = 1u << tl; const LAS float* srow = scl + tl * 2048;
        if (nch <= 8) select_token<8>(srow, t, lane, tbit, maskw);
        else if (nch <= 16) select_token<16>(srow, t, lane, tbit, maskw);
        else if (nch <= 24) select_token<24>(srow, t, lane, tbit, maskw);
        else select_token<32>(srow, t, lane, tbit, maskw);
    }
    if (xid0 >= 0) x_store(xa, xr0);
    if (xid1 >= 0) x_store(xb, xr1);
    LDS_WAIT(); __syncthreads();
    {
        const int ktmax = (T0 + 15) >> 6; unsigned short* mbase = (unsigned short*)(masks + ((size_t)(b * (SEQ / 32) + (qt16 >> 1)) * (SEQ / 64)) * 64) + (qt16 & 1);
#pragma unroll
        for (int jj = 0; jj < 4; ++jj) { const int key = F.tid + 512 * jj, kt = key >> 6, kap = key & 63;
            const unsigned wv = maskw[key]; maskw[key] = 0u;
            if (kt <= ktmax) { const int half = kap >> 5, k5 = kap & 31, hi_ = (k5 >> 2) & 1, rr = (k5 & 3) + 4 * (k5 >> 3); mbase[2 * (kt * 64 + 32 * half + 2 * rr + hi_)] = (unsigned short)wv; } }
    }
    LDS_WAIT(); __syncthreads();
}
__device__ __forceinline__ void conv_pass(Frame& F, const bf16_t* u, const bf16_t* cb, const float* cw, bf16_t* conv) {
    const int gt = F.vcu * 512 + F.tid, NGT = F.G * 512;
    for (int idx = gt; idx < NTOK * 64; idx += NGT) {
        const int tok = idx >> 6, cg = (idx & 63) * 8, pos = tok & (SEQ - 1);
        const u32x4 z = (u32x4){0u, 0u, 0u, 0u};
        const u32x4 u0 = *(const u32x4*)(u + (size_t)tok * 512 + cg);
        const u32x4 u1 = pos >= 1 ? *(const u32x4*)(u + (size_t)(tok - 1) * 512 + cg) : z;
        const u32x4 u2 = pos >= 2 ? *(const u32x4*)(u + (size_t)(tok - 2) * 512 + cg) : z;
        const u32x4 bv = __builtin_nontemporal_load((const u32x4*)(cb + (size_t)tok * 512 + cg));
        const f32x4 w0a = *(const f32x4*)(cw + cg), w0b = *(const f32x4*)(cw + cg + 4);
        const f32x4 w1a = *(const f32x4*)(cw + 512 + cg), w1b = *(const f32x4*)(cw + 512 + cg + 4);
        const f32x4 w2a = *(const f32x4*)(cw + 1024 + cg), w2b = *(const f32x4*)(cw + 1024 + cg + 4);
        f32x4 ya, yb;
#define CV(E, WA, I, WORD, HALF) (WA[I] * (HALF ? bfhi(E.WORD) : bflo(E.WORD)))
        ya[0] = bflo(bv.x) * (CV(u2, w0a, 0, x, 0) + CV(u1, w1a, 0, x, 0) + CV(u0, w2a, 0, x, 0));
        ya[1] = bfhi(bv.x) * (CV(u2, w0a, 1, x, 1) + CV(u1, w1a, 1, x, 1) + CV(u0, w2a, 1, x, 1));
        ya[2] = bflo(bv.y) * (CV(u2, w0a, 2, y, 0) + CV(u1, w1a, 2, y, 0) + CV(u0, w2a, 2, y, 0));
        ya[3] = bfhi(bv.y) * (CV(u2, w0a, 3, y, 1) + CV(u1, w1a, 3, y, 1) + CV(u0, w2a, 3, y, 1));
        yb[0] = bflo(bv.z) * (CV(u2, w0b, 0, z, 0) + CV(u1, w1b, 0, z, 0) + CV(u0, w2b, 0, z, 0));
        yb[1] = bfhi(bv.z) * (CV(u2, w0b, 1, z, 1) + CV(u1, w1b, 1, z, 1) + CV(u0, w2b, 1, z, 1));
        yb[2] = bflo(bv.w) * (CV(u2, w0b, 2, w, 0) + CV(u1, w1b, 2, w, 0) + CV(u0, w2b, 2, w, 0));
        yb[3] = bfhi(bv.w) * (CV(u2, w0b, 3, w, 1) + CV(u1, w1b, 3, w, 1) + CV(u0, w2b, 3, w, 1));
#undef CV
        store8bf(conv + (size_t)tok * 1024 + cg, ya, yb);
    }
}

constexpr int P7_HS = 1032;
constexpr int P7_H = 0, P7_HL = 16 * P7_HS * 2, P7_P = 2 * 16 * P7_HS * 2, P7_L = P7_P + 8 * 16 * 48 * 4, P7_R = P7_L + 16 * 48 * 4, P7_END = P7_R + 6 * 128 * 4 + 2 * 32 * 4;
static_assert(P7_END <= RING_BYTES && (P7_P % 16) == 0, "P7 LDS map");
__device__ __forceinline__ void ln1_router(Frame& F, bool dry) {
    const KArgs a = kargs();
    unsigned char* ws = F.ws;
    const float* xin = a->in[0]; const bf16_t* mixb = (const bf16_t*)(ws + WS_MIX); bf16_t* h1b = dry ? (bf16_t*)(ws + WS_GATES) : (bf16_t*)(ws + WS_PRE);
    int* lists = (int*)(ws + (dry ? WS_MERGED : WS_LIST)); unsigned* tokinfo = (unsigned*)(ws + (dry ? WS_MERGED + 8 * MiB : WS_TOKINFO)); const int cbank = dry ? 64 * NEXP : 0;
    unsigned char* h1q = ws + (dry ? WS_MERGED + 16 * MiB : WS_H1Q);
    const float *g1 = a->in[7], *b1 = a->in[8], *rgb = a->in[10], *reb = a->in[12]; const float* wc = (const float*)(ws + WS_WC);
    const int lane = F.lane, wid = F.wave, tid = F.tid;
    LAS bf16_t* Hh = (LAS bf16_t*)(F.lds + P7_H); LAS bf16_t* Hl = (LAS bf16_t*)(F.lds + P7_HL); LAS float* P = (LAS float*)(F.lds + P7_P); LAS float* L = (LAS float*)(F.lds + P7_L);
    LAS int* RE = (LAS int*)(F.lds + P7_R);
    LAS int* hist = RE + 768; LAS int* basev = RE + 800;
    if (tid < 64) hist[tid] = 0;
    f32x4 gv[4], bv[4];
#pragma unroll
    for (int j = 0; j < 4; ++j) { gv[j] = *(const f32x4*)(g1 + 4 * lane + 256 * j); bv[j] = *(const f32x4*)(b1 + 4 * lane + 256 * j); }
    bf16x8 bhi[4][3], blo[4][3];
    { const int kq = lane >> 4, jn = lane & 15; const float* wp = wc + (size_t)(128 * wid + 8 * kq) * 48 + jn;
#pragma unroll
      for (int sidx = 0; sidx < 4; ++sidx)
#pragma unroll
          for (int cb = 0; cb < 3; ++cb) { u32x4 ph, pl;
#pragma unroll
              for (int jp = 0; jp < 4; ++jp) { const float w0 = wp[(size_t)(32 * sidx + 2 * jp) * 48 + 16 * cb], w1 = wp[(size_t)(32 * sidx + 2 * jp + 1) * 48 + 16 * cb];
                  const unsigned hh = pkbf(w0, w1); ph[jp] = hh; pl[jp] = pkbf(w0 - bflo(hh), w1 - bfhi(hh)); }
              bhi[sidx][cb] = __builtin_bit_cast(bf16x8, ph); blo[sidx][cb] = __builtin_bit_cast(bf16x8, pl); } }
    const int ngrp_total = NTOK / 16;
#pragma unroll 1
    for (int gi = F.vcu * 8; gi < ngrp_total; gi += F.G * 8) {
      f32x4 vn[2][4]; u32x2 mn[2][4];
#pragma unroll
      for (int rr = 0; rr < 2; ++rr)
#pragma unroll
          for (int j = 0; j < 4; ++j) { const size_t o_ = (size_t)(gi * 16 + 2 * wid + rr) * DM + 4 * lane + 256 * j; vn[rr][j] = __builtin_nontemporal_load((const f32x4*)(xin + o_)); mn[rr][j] = __builtin_nontemporal_load((const u32x2*)(mixb + o_)); }
#pragma unroll 1
      for (int gg = 0; gg < 8; ++gg) {
        const int row0 = (gi + gg) * 16;
#pragma unroll
        for (int rr = 0; rr < 2; ++rr) { const int rl = 2 * wid + rr, row = row0 + rl;
            f32x4 v[4]; float sm = 0.f;
#pragma unroll
            for (int j = 0; j < 4; ++j) { const u32x2 mw = mn[rr][j]; v[j] = vn[rr][j] * ALPHA + (f32x4){bflo(mw.x), bfhi(mw.x), bflo(mw.y), bfhi(mw.y)}; sm += (v[j][0] + v[j][1]) + (v[j][2] + v[j][3]); }
            const float mean = dpp_sum_f(sm) * (1.f / DM); float s2 = 0.f;
#pragma unroll
            for (int j = 0; j < 4; ++j) { v[j] = v[j] - mean; s2 += (v[j][0] * v[j][0] + v[j][1] * v[j][1]) + (v[j][2] * v[j][2] + v[j][3] * v[j][3]); }
            const float rstd = 1.f / sqrtf(dpp_sum_f(s2) * (1.f / DM) + LN_EPS);
#pragma unroll
            for (int j = 0; j < 4; ++j) { v[j] = v[j] * rstd * gv[j] + bv[j];
                u32x2 o; o.x = pkbf(v[j][0], v[j][1]); o.y = pkbf(v[j][2], v[j][3]); *(u32x2*)(h1b + (size_t)row * DM + 4 * lane + 256 * j) = o;
                { int wv = 0; wv = __builtin_amdgcn_cvt_pk_fp8_f32(v[j][0], v[j][1], wv, false); wv = __builtin_amdgcn_cvt_pk_fp8_f32(v[j][2], v[j][3], wv, true);
                  *(int*)(h1q + (size_t)row * 1024 + 4 * lane + 256 * j) = wv; }
                { const unsigned h01 = o.x, h23 = o.y;
                  *(LAS u32x2*)(Hh + rl * P7_HS + 4 * lane + 256 * j) = (u32x2){h01, h23};
                  *(LAS u32x2*)(Hl + rl * P7_HS + 4 * lane + 256 * j) = (u32x2){pkbf(v[j][0] - bflo(h01), v[j][1] - bfhi(h01)), pkbf(v[j][2] - bflo(h23), v[j][3] - bfhi(h23))}; } } }
        { const int gnx = gg < 7 ? gg + 1 : gg;
#pragma unroll
          for (int rr = 0; rr < 2; ++rr)
#pragma unroll
              for (int j = 0; j < 4; ++j) { const size_t o_ = (size_t)((gi + gnx) * 16 + 2 * wid + rr) * DM + 4 * lane + 256 * j; vn[rr][j] = __builtin_nontemporal_load((const f32x4*)(xin + o_)); mn[rr][j] = __builtin_nontemporal_load((const u32x2*)(mixb + o_)); } }
        LDS_WAIT(); __syncthreads();
        { f32x4 acc[3]; acc[0] = (f32x4){0.f, 0.f, 0.f, 0.f}; acc[1] = acc[0]; acc[2] = acc[0];
          const int hoff = (lane & 15) * P7_HS + 128 * wid + 8 * (lane >> 4);
#pragma unroll
          for (int sidx = 0; sidx < 4; ++sidx) { const bf16x8 ah = *(const LAS bf16x8*)(Hh + hoff + 32 * sidx), al = *(const LAS bf16x8*)(Hl + hoff + 32 * sidx);
#pragma unroll
              for (int cb = 0; cb < 3; ++cb) { acc[cb] = __builtin_amdgcn_mfma_f32_16x16x32_bf16(ah, bhi[sidx][cb], acc[cb], 0, 0, 0);
                  acc[cb] = __builtin_amdgcn_mfma_f32_16x16x32_bf16(ah, blo[sidx][cb], acc[cb], 0, 0, 0); acc[cb] = __builtin_amdgcn_mfma_f32_16x16x32_bf16(al, bhi[sidx][cb], acc[cb], 0, 0, 0); } }
          LAS float* pp = P + (wid * 16 + 4 * (lane >> 4)) * 48 + (lane & 15);
#pragma unroll
          for (int cb = 0; cb < 3; ++cb)
#pragma unroll
              for (int rg = 0; rg < 4; ++rg) pp[rg * 48 + 16 * cb] = acc[cb][rg]; }
        LDS_WAIT(); __syncthreads();
        for (int idx = tid; idx < 16 * 48; idx += 512) { float sum = 0.f;
#pragma unroll
            for (int w = 0; w < 8; ++w) sum += P[w * 768 + idx];
            L[idx] = sum; }
        LDS_WAIT(); __syncthreads();
        if (tid < 16) { const LAS float* lr = L + tid * 48;
            float gl[4]; int grp = 0;
#pragma unroll
            for (int i = 0; i < 4; ++i) gl[i] = lr[i] + rgb[i];
            float gm = gl[0];
#pragma unroll
            for (int i = 1; i < 4; ++i) if (gl[i] > gm) { gm = gl[i]; grp = i; }
            float den = 0.f;
#pragma unroll
            for (int i = 0; i < 4; ++i) den += __expf(gl[i] - gm);
            const float pgrp = 1.f / den;
            float el[8];
#pragma unroll
            for (int i = 0; i < 8; ++i) el[i] = lr[4 + 8 * grp + i] + reb[grp * 8 + i];
            int i1 = 0; float v1 = el[0];
#pragma unroll
            for (int i = 1; i < 8; ++i) if (el[i] > v1) { v1 = el[i]; i1 = i; }
            int i2 = -1; float v2 = -INFINITY;
#pragma unroll
            for (int i = 0; i < 8; ++i) if (i != i1 && el[i] > v2) { v2 = el[i]; i2 = i; }
            const float ex = __expf(v2 - v1), w1 = pgrp / (1.f + ex), w2 = pgrp * ex / (1.f + ex);
            const int e1 = grp * 8 + i1, e2 = grp * 8 + i2, ti = gg * 16 + tid;
            RE[ti] = e1; RE[128 + ti] = e2; RE[256 + ti] = (int)__float_as_uint(w1); RE[384 + ti] = (int)__float_as_uint(w2);
            RE[512 + ti] = __hip_atomic_fetch_add(hist + e1, 1, __ATOMIC_RELAXED, __HIP_MEMORY_SCOPE_WORKGROUP);
            RE[640 + ti] = __hip_atomic_fetch_add(hist + e2, 1, __ATOMIC_RELAXED, __HIP_MEMORY_SCOPE_WORKGROUP);
        }
      }
      LDS_WAIT(); __syncthreads();
      if (tid < NEXP) { const int hc = hist[tid]; basev[tid] = hc ? (int)__hip_atomic_fetch_add(F.ctl + CW_CNT + cbank + 64 * tid, (unsigned)hc, __ATOMIC_RELAXED, __HIP_MEMORY_SCOPE_AGENT) : 0; }
      LDS_WAIT(); __syncthreads();
      if (tid < 128) { const int row = gi * 16 + tid; const int e1 = RE[tid], e2 = RE[128 + tid];
          const unsigned r1 = (unsigned)(basev[e1] + RE[512 + tid]), r2 = (unsigned)(basev[e2] + RE[640 + tid]);
          if (r1 < (unsigned)LISTCAP) lists[(size_t)e1 * LISTCAP + r1] = row;
          if (r2 < (unsigned)LISTCAP) lists[(size_t)e2 * LISTCAP + r2] = row;
          unsigned* ti = tokinfo + (size_t)row * 8;
          *(u32x4*)ti = (u32x4){(unsigned)e1, r1, (unsigned)RE[256 + tid], (unsigned)e2}; *(u32x2*)(ti + 4) = (u32x2){r2, (unsigned)RE[384 + tid]}; }
      LDS_WAIT(); __syncthreads();
      if (tid < 64) hist[tid] = 0;
      LDS_WAIT(); __syncthreads();
    }
}
__device__ __forceinline__ void moe_tables(Frame& F) {
    LAS int* tab = (LAS int*)(F.lds + TAB_OFF);
    __syncthreads();
    if (F.tid < NEXP) { int c = (int)__hip_atomic_load(F.ctl + CW_CNT + 64 * F.tid, __ATOMIC_RELAXED, __HIP_MEMORY_SCOPE_AGENT); if (c > LISTCAP) c = LISTCAP; tab[T_CNT + F.tid] = c; }
    __syncthreads();
    if (F.tid == 0) { int acc = 0; for (int e = 0; e < NEXP; ++e) { tab[T_BLK0 + e] = acc; acc += (tab[T_CNT + e] + 255) >> 8; } tab[T_BLK0 + NEXP] = acc; tab[T_NB] = acc; }
    __syncthreads();
    if (F.tid < NEXP) { const int b0 = tab[T_BLK0 + F.tid], b1 = tab[T_BLK0 + F.tid + 1]; for (int bb = b0; bb < b1; ++bb) tab[T_BLKE + bb] = F.tid; }
    __syncthreads();
}

__device__ __forceinline__ void combine_ln2(Frame& F) {
    const KArgs a = kargs();
    unsigned char* ws = F.ws;
    const bf16_t* h1 = (const bf16_t*)(ws + WS_PRE); const unsigned char* ys = ws + WS_YS;     const unsigned* tokinfo = (const unsigned*)(ws + WS_TOKINFO);
    const LAS int* tab = (const LAS int*)(F.lds + TAB_OFF);
    const float *g2 = a->in[16], *b2 = a->in[17]; float* outp = a->out;
    const int lane = F.lane, gw = F.vcu * NWAVES + F.wave, NGW = F.G * NWAVES;
    f32x4 gv[4], bv[4];
#pragma unroll
    for (int j = 0; j < 4; ++j) { gv[j] = *(const f32x4*)(g2 + 4 * lane + 256 * j); bv[j] = *(const f32x4*)(b2 + 4 * lane + 256 * j); }
    const int nrw = (NTOK - gw + NGW - 1) / NGW;
    if (nrw > 0) {
#define ROWK(k) (gw + ((k) < nrw ? (k) : nrw - 1) * NGW)
#define TI_LOAD(k, A, B) do { const unsigned* ti_ = tokinfo + (size_t)ROWK(k) * 8; A = *(const u32x4*)ti_; B = *(const u32x2*)(ti_ + 4); } while (0)
#define DATA_LOAD(k, A, B, HW, YA, YB) do { const int e1_ = (int)A.x, e2_ = (int)A.w; \
        const size_t s1_ = (size_t)tab[T_BLK0 + e1_] * 256 + A.y, s2_ = (size_t)tab[T_BLK0 + e2_] * 256 + B.x; \
        const bf16_t* hr_ = h1 + (size_t)ROWK(k) * DM + 4 * lane; const unsigned char* y1_ = ys + s1_ * DM + 4 * lane; const unsigned char* y2_ = ys + s2_ * DM + 4 * lane; \
        _Pragma("unroll") for (int j = 0; j < 4; ++j) { HW[j] = __builtin_nontemporal_load((const u32x2*)(hr_ + 256 * j)); YA[j] = __builtin_nontemporal_load((const unsigned*)(y1_ + 256 * j)); YB[j] = __builtin_nontemporal_load((const unsigned*)(y2_ + 256 * j)); } } while (0)
        u32x4 tc0, tn0, tq0; u32x2 tc1, tn1, tq1;
        u32x2 hw[4], hwn[4]; unsigned ya[4], yb[4], yan[4], ybn[4];
        TI_LOAD(0, tc0, tc1); TI_LOAD(1, tn0, tn1);
        DATA_LOAD(0, tc0, tc1, hw, ya, yb);
        for (int k = 0; k < nrw; ++k) {
            TI_LOAD(k + 2, tq0, tq1);
            DATA_LOAD(k + 1, tn0, tn1, hwn, yan, ybn);
            const float w1 = __uint_as_float(tc0.z), w2 = __uint_as_float(tc1.y);
            f32x4 v[4]; float sm = 0.f;
#pragma unroll
            for (int j = 0; j < 4; ++j) {
                v[j][0] = ALPHA * bflo(hw[j].x) + w1 * __builtin_amdgcn_cvt_f32_fp8((int)ya[j], 0) + w2 * __builtin_amdgcn_cvt_f32_fp8((int)yb[j], 0);
                v[j][1] = ALPHA * bfhi(hw[j].x) + w1 * __builtin_amdgcn_cvt_f32_fp8((int)ya[j], 1) + w2 * __builtin_amdgcn_cvt_f32_fp8((int)yb[j], 1);
                v[j][2] = ALPHA * bflo(hw[j].y) + w1 * __builtin_amdgcn_cvt_f32_fp8((int)ya[j], 2) + w2 * __builtin_amdgcn_cvt_f32_fp8((int)yb[j], 2);
                v[j][3] = ALPHA * bfhi(hw[j].y) + w1 * __builtin_amdgcn_cvt_f32_fp8((int)ya[j], 3) + w2 * __builtin_amdgcn_cvt_f32_fp8((int)yb[j], 3);
                sm += (v[j][0] + v[j][1]) + (v[j][2] + v[j][3]); }
            const float mean = dpp_sum_f(sm) * (1.f / DM); float s2v = 0.f;
#pragma unroll
            for (int j = 0; j < 4; ++j) { v[j] = v[j] - mean; s2v += (v[j][0] * v[j][0] + v[j][1] * v[j][1]) + (v[j][2] * v[j][2] + v[j][3] * v[j][3]); }
            const float rstd = 1.f / sqrtf(dpp_sum_f(s2v) * (1.f / DM) + LN_EPS);
            float* orow = outp + (size_t)(gw + k * NGW) * DM + 4 * lane;
#pragma unroll
            for (int j = 0; j < 4; ++j) __builtin_nontemporal_store(v[j] * rstd * gv[j] + bv[j], (f32x4*)(orow + 256 * j));
            tc0 = tn0; tc1 = tn1; tn0 = tq0; tn1 = tq1;
#pragma unroll
            for (int j = 0; j < 4; ++j) { hw[j] = hwn[j]; ya[j] = yan[j]; yb[j] = ybn[j]; }
        }
#undef ROWK
#undef TI_LOAD
#undef DATA_LOAD
    }
}

#if DBG_NAIVE
constexpr size_t WS_NK = 296 * MiB, WS_NV = 312 * MiB, WS_NKI = 328 * MiB;
__device__ __forceinline__ float naive_proj(const float* xs  , const float* w_in, int col) {
    float s = 0.f; for (int d = 0; d < DM; ++d) s += xs[d] * w_in[(size_t)d * INW + col]; return s;
}
__device__ __forceinline__ void naive_kv(Frame& F) {
    const KArgs ka = kargs(); const float* xin = ka->in[0]; const float* win = ka->in[1];
    float* nk = (float*)(F.ws + WS_NK); float* nv = (float*)(F.ws + WS_NV); float* nki = (float*)(F.ws + WS_NKI);
    LAS float* xs = (LAS float*)F.lds; LAS float* pr = xs + 1024;
    for (int tok = F.vcu; tok < NTOK; tok += F.G) {
        __syncthreads();
        for (int i = F.tid; i < DM; i += 512) xs[i] = xin[(size_t)tok * DM + i];
        __syncthreads();
        if (F.tid < 320) { const int col = F.tid < 256 ? 512 + F.tid : 1280 + (F.tid - 256); float s = 0.f; for (int d = 0; d < DM; ++d) s += xs[d] * win[(size_t)d * INW + col]; pr[F.tid] = s; }
        __syncthreads();
        const int pos = tok & (SEQ - 1);
        if (F.tid < 24) {
            const int grp = F.tid >> 3, i = F.tid & 7, base = grp == 0 ? 0 : (grp == 1 ? 64 : 256);
            const float inv = (float)pow(500000.0, -(double)i / 8.0); const float ang = (float)pos * inv, c = cosf(ang), s = sinf(ang);
            const float x1 = pr[base + i], x2 = pr[base + 8 + i]; pr[base + i] = x1 * c - x2 * s; pr[base + 8 + i] = x2 * c + x1 * s;
        }
        __syncthreads();
        if (F.tid < 128) { nk[(size_t)tok * 128 + F.tid] = pr[F.tid]; nv[(size_t)tok * 128 + F.tid] = pr[128 + F.tid]; }
        if (F.tid < 64) nki[(size_t)tok * 64 + F.tid] = pr[256 + F.tid];
    }
}
__device__ __forceinline__ void naive_attn(Frame& F) {
    const KArgs ka = kargs(); const float* xin = ka->in[0]; const float* win = ka->in[1];
    const float* nk = (const float*)(F.ws + WS_NK); const float* nv = (const float*)(F.ws + WS_NV); const float* nki = (const float*)(F.ws + WS_NKI);
    bf16_t* attn = (bf16_t*)(F.ws + WS_AC) + 512;
    LAS float* xs = (LAS float*)F.lds;
    LAS float* qs = xs + 1024;
    LAS float* qis = qs + 512;
    LAS float* wis = qis + 512;
    LAS float* sc = wis + 16;
    LAS int* sel = (LAS int*)(sc + 2048);
    LAS int* nsel = sel + 256;
    LAS float* pl = (LAS float*)(nsel + 16);
    for (int tok = F.vcu; tok < NTOK; tok += F.G) {
        const int pos = tok & (SEQ - 1), b0 = tok - pos;
        __syncthreads();
        for (int i = F.tid; i < DM; i += 512) xs[i] = xin[(size_t)tok * DM + i];
        if (F.tid == 0) nsel[0] = 0;
        __syncthreads();
        for (int c = F.tid; c < 1032; c += 512) { const int col = c < 512 ? c : (c < 1024 ? 768 + (c - 512) : 1344 + (c - 1024));
            float s = 0.f; for (int d = 0; d < DM; ++d) s += xs[d] * win[(size_t)d * INW + col];
            if (c < 512) qs[c] = s; else if (c < 1024) qis[c - 512] = s; else wis[c - 1024] = s; }
        __syncthreads();
        if (F.tid < 128) { const int which = F.tid >> 6, hd = (F.tid >> 3) & 7, i = F.tid & 7; LAS float* p = (which ? qis : qs) + hd * 64;
            const float inv = (float)pow(500000.0, -(double)i / 8.0); const float ang = (float)pos * inv, c = cosf(ang), s = sinf(ang);
            const float x1 = p[i], x2 = p[8 + i]; p[i] = x1 * c - x2 * s; p[8 + i] = x2 * c + x1 * s; }
        __syncthreads();
#if DBG_NAIVE == 2
        { const bf16_t* qif = (const bf16_t*)(F.ws + WS_QI) + (size_t)tok * 512; for (int i = F.tid; i < 512; i += 512) qis[i] = __uint_as_float((unsigned)qif[i] << 16);
          if (F.tid < 8) wis[F.tid] = ((const float*)(F.ws + WS_WI))[(size_t)tok * 8 + F.tid]; }
        __syncthreads();
        for (int s = F.tid; s <= pos; s += 512) { const int tk_ = b0 + s; const bf16_t* kr = (const bf16_t*)(F.ws + WS_KI) + (size_t)(tk_ >> 5) * 2048 + (tk_ & 31) * 16; float tot = 0.f;
            for (int hd = 0; hd < 8; ++hd) { float d = 0.f; for (int e = 0; e < 64; ++e) d += qis[hd * 64 + e] * __uint_as_float((unsigned)kr[(e >> 4) * 512 + ((e >> 3) & 1) * 8 + (e & 7)] << 16); tot += fmaxf(d, 0.f) * (wis[hd] * WSCALE); }
            sc[s] = tot; }
#else
        for (int s = F.tid; s <= pos; s += 512) { const float* kr = nki + (size_t)(b0 + s) * 64; float tot = 0.f;
            for (int hd = 0; hd < 8; ++hd) { float d = 0.f; for (int e = 0; e < 64; ++e) d += qis[hd * 64 + e] * kr[e]; d *= 0.125f; tot += fmaxf(d, 0.f) * wis[hd]; }
            sc[s] = tot * 0.35355339059327373f; }
#endif
        __syncthreads();
        for (int s = F.tid; s <= pos; s += 512) { bool take = true;
            if (pos >= 256) { const float xv = sc[s]; int rank = 0; for (int s2 = 0; s2 <= pos; ++s2) { const float y = sc[s2]; rank += (y > xv || (y == xv && s2 < s)) ? 1 : 0; } take = rank < 256; }
            if (take) { const int p = atomicAdd((int*)nsel, 1); sel[p] = s; } }
        __syncthreads();
        const int ns = nsel[0]; const int hd = F.wave, lane = F.lane;
        float lg[4]; float mx = -INFINITY;
        for (int jj = 0; jj < 4; ++jj) { const int j = lane + 64 * jj; lg[jj] = -INFINITY;
            if (j < ns) { const float* kr = nk + (size_t)(b0 + sel[j]) * 128 + (hd >> 2) * 64; float d = 0.f; for (int e = 0; e < 64; ++e) d += qs[hd * 64 + e] * kr[e]; lg[jj] = d * 0.125f; mx = fmaxf(mx, lg[jj]); } }
        mx = wave_max(mx); float sum = 0.f;
        for (int jj = 0; jj < 4; ++jj) { const int j = lane + 64 * jj; const float p = (j < ns) ? expf(lg[jj] - mx) : 0.f; sum += p; pl[hd * 256 + j] = p; }
        sum = wave_sum(sum);
        LDS_WAIT(); asm volatile("" ::: "memory");
        float o = 0.f;
        for (int j = 0; j < ns; ++j) o += pl[hd * 256 + j] * nv[(size_t)(b0 + sel[j]) * 128 + (hd >> 2) * 64 + lane];
        o /= sum;
        bf16_t* ap = attn + (size_t)tok * 1024 + hd * 64 + lane;
        const float fast = __uint_as_float((unsigned)(*ap) << 16);
        const float blended = o + DBG_G * (fast - o);
        *ap = (bf16_t)(pkbf(blended, 0.f) & 0xffffu);
    }
}
#endif

__global__ void __launch_bounds__(NWAVES * 64, 2) mk_fwd(Args args_unused) {
    extern __shared__ __attribute__((aligned(16))) unsigned char lds[];
    Frame F;
    F.lds = (LAS unsigned char*)lds;
    F.MISC = (volatile LAS unsigned*)(F.lds + LDSCTL_OFF);
    F.tid = threadIdx.x; F.lane = F.tid & 63; F.wave = __builtin_amdgcn_readfirstlane(F.tid >> 6);
    F.G = gridDim.x; { const int bx = blockIdx.x; F.vcu = (F.G % 8 == 0) ? (bx % 8) * (F.G / 8) + bx / 8 : bx; }
    unsigned char* ws; int lo, hi;
    { const KArgs ka = kargs(); ws = ka->ws; lo = ka->ph_lo; hi = ka->ph_hi; }
    F.ws = ws; F.ctl = (unsigned*)(ws + WS_CTL);
    for (int u = F.tid; u < (LDS_BYTES - LDSCTL_OFF) / 4; u += NWAVES * 64) ((LAS unsigned*)(F.lds + LDSCTL_OFF))[u] = 0u;
    __syncthreads();
#if MK_SPLIT
#define GRID_BAR() do { } while (0)
#else
    XcdBarrier bar = xcd_barrier_post(F.ctl + CW_BAR, F.MISC + 8);
#define GRID_BAR() xcd_barrier(bar)
#endif
#ifndef PHASE_MASK
#define PHASE_MASK 0xFFFF
#endif
#define IN(k) ((((PHASE_MASK) >> (k)) & 1) && lo <= (k) && (k) < hi)
#define BOTH(k, k2) (IN(k) && IN(k2))

    bf16_t* xb = (bf16_t*)(ws + WS_XB);
    bf16_t *qb = (bf16_t*)(ws + WS_Q), *kbuf = (bf16_t*)(ws + WS_K), *vbuf = (bf16_t*)(ws + WS_V), *qib = (bf16_t*)(ws + WS_QI), *kib = (bf16_t*)(ws + WS_KI);
    float* wib = (float*)(ws + WS_WI);
    bf16_t *ub = (bf16_t*)(ws + WS_U), *cbb = (bf16_t*)(ws + WS_CB), *acb = (bf16_t*)(ws + WS_AC), *gab = (bf16_t*)(ws + WS_GA), *rtb = (bf16_t*)(ws + WS_RT);
    unsigned* masks = (unsigned*)(ws + WS_MASK);
    bf16_t *merged = (bf16_t*)(ws + WS_MERGED), *h1b = (bf16_t*)(ws + WS_PRE), *ysb_unused = nullptr; (void)ysb_unused;
    float* pre = (float*)(ws + WS_PRE);

    if (IN(0)) { p0_prologue(F); if (BOTH(0, 1)) GRID_BAR(); }
    if (IN(1)) {
        pg8::Gemm g{xb, (const bf16_t*)(ws + WS_WIN), NTOK, NPROJ, DM, 0}; pg8::StaticOrder S; S.init(NTOK, NPROJ, F.G, (int)blockIdx.x);
        EpiProj E{qb, kbuf, vbuf, qib, kib, ub, cbb, gab, rtb, wib, (const float*)(ws + WS_ROPE), kargs()->in[2]};
        pg8::gemm_phase<EpiProj, pg8::StaticOrder, true, false>(F.lds, g, S, E, nullptr);
        if (BOTH(1, 2)) GRID_BAR();
    }
    if (IN(2)) {
        LAS float* scl = (LAS float*)F.lds;
        LAS unsigned* maskw = (LAS unsigned*)(F.lds + TAB_OFF);
        for (int i = F.tid; i < 2048; i += 512) maskw[i] = 0u;
        __syncthreads();
        if (F.G == 256) {
            const int b = F.vcu >> 4, j = F.vcu & 15;
#pragma unroll 1
            for (int i = 0; i < 8; ++i) { const int qt = 32 * (i >> 1) + ((i & 1) ? 31 - j : j);
                const int gwv = F.vcu * NWAVES + F.wave, jx0 = i < 4 ? 2 * i : 4 + i;
                score_select_unit(F, b, qt, qib, kib, wib, scl, maskw, masks, gwv + 2048 * jx0, i < 4 ? gwv + 2048 * (jx0 + 1) : -1); }
        } else {
#pragma unroll 1
            for (int un = F.vcu; un < NBATCH * 128; un += F.G) score_select_unit(F, un >> 7, un & 127, qib, kib, wib, scl, maskw, masks, -1, -1);
        }
        conv_pass(F, ub, cbb, kargs()->in[5], acb);
        if (PROBE_P2 == 3) conv_pass(F, ub, cbb, kargs()->in[5], acb);
        if (BOTH(2, 3)) GRID_BAR();
    }
    if (IN(3)) {
        const int nun = NBATCH * 8 * 8;
        if (F.G == 256) {
            const int bh = F.vcu >> 1, s0 = 2 * (F.vcu & 1);
#pragma unroll 1
            for (int i = 0; i < 4; ++i) { const int qbk = (i == 0) ? s0 : (i == 1) ? 7 - s0 : (i == 2) ? s0 + 1 : 6 - s0;
                attn_body::attn_unit<8>(bh >> 3, bh & 7, qbk, (const attn_body::bf16*)qb, (const attn_body::bf16*)kbuf, (const attn_body::bf16*)vbuf, (attn_body::bf16*)acb, masks, (char*)lds); }
        } else {
#pragma unroll 1
            for (int un = F.vcu; un < nun; un += F.G) attn_body::attn_unit<8>(un >> 6, (un >> 3) & 7, un & 7, (const attn_body::bf16*)qb, (const attn_body::bf16*)kbuf, (const attn_body::bf16*)vbuf, (attn_body::bf16*)acb, masks, (char*)lds);
        }
        if (BOTH(3, 4)) GRID_BAR();
    }
#if DBG_NAIVE
    if (IN(4)) { naive_kv(F); }
    if (IN(11)) { naive_attn(F); }
#else
    if (IN(4)) { if (BOTH(4, 5)) { } }
#endif
    if (IN(5)) {
        pg8::Gemm g{acb, (const bf16_t*)(ws + WS_WAU), NTOK, DM, DM, 0}; pg8::StaticOrder S; S.init(NTOK, DM, F.G, (int)blockIdx.x);
        EpiMerged E{gab, rtb, merged};
        pg8::gemm_phase<EpiMerged, pg8::StaticOrder, true, false, true>(F.lds, g, S, E, nullptr);
        if (BOTH(5, 6)) GRID_BAR();
    }
    if (IN(6)) {
        pg8::Gemm g{merged, (const bf16_t*)(ws + WS_WOUT), NTOK, DM, DM, 0}; pg8::StaticOrder S; S.init(NTOK, DM, F.G, (int)blockIdx.x);
        EpiOut E{(bf16_t*)(ws + WS_MIX)};
        pg8::gemm_phase<EpiOut, pg8::StaticOrder, true, false>(F.lds, g, S, E, nullptr);
        if (BOTH(6, 7)) GRID_BAR();
    }
    if (IN(7)) { ln1_router(F, (kargs()->flags & 1) != 0); if (BOTH(7, 8)) GRID_BAR(); }
    if (IN(8)) {
        moe_tables(F);
        LAS int* tab = (LAS int*)(F.lds + TAB_OFF);
        const int nunits = tab[T_NB] * 4; const int* lists = (const int*)(ws + WS_LIST);
        for (int i = 0; i < T_ROWS_UNITS; ++i) { const int L = i * F.G + F.vcu; if (L >= nunits) break;
            const int rbg = L >> 2, e = tab[T_BLKE + rbg], slot0 = (rbg - tab[T_BLK0 + e]) * 256, cnt = tab[T_CNT + e];
            if (F.tid < 256) { const int sl = slot0 + F.tid; tab[T_ROWS + i * 256 + F.tid] = sl < cnt ? lists[(size_t)e * LISTCAP + sl] : 0; } }
        __syncthreads();
        pg8::Gemm g{(const bf16_t*)(ws + WS_H1Q), (const bf16_t*)(ws + WS_WGU), CAPROWS, NEXP * 1024, 512, 0}; pg8::MoeOrder S{tab + T_BLKE, nunits, F.G, F.vcu};
        EpiSwiGLU E{ws + WS_HID};
        pg8::gemm_phase<EpiSwiGLU, pg8::MoeOrder, true, true, false, true>(F.lds, g, S, E, tab + T_ROWS);
        if (BOTH(8, 9)) GRID_BAR();
    }
    if (IN(9)) {
        moe_tables(F);
        LAS int* tab = (LAS int*)(F.lds + TAB_OFF);
        const int nunits = tab[T_NB] * 4;
        pg8::Gemm g{(const bf16_t*)(ws + WS_HID), (const bf16_t*)(ws + WS_WD), CAPROWS, NEXP * 1024, 256, 0}; pg8::MoeOrder S{tab + T_BLKE, nunits, F.G, F.vcu};
        EpiYs E{ws + WS_YS};
        pg8::gemm_phase<EpiYs, pg8::MoeOrder, true, false, false, true>(F.lds, g, S, E, nullptr);
        if (BOTH(9, 10)) GRID_BAR();
    }
    if (IN(10)) { moe_tables(F); combine_ln2(F); }
#undef IN
#undef BOTH
}

extern "C" void kernel_launch(void* const* d_in, const int* in_sizes, int n_in, void* d_out, int out_size, void* d_ws, size_t ws_size, hipStream_t stream) {
    static int grid = 0;
    if (grid == 0) {
        if (n_in != 18 || in_sizes[0] != NTOK * DM || out_size != NTOK * DM || ws_size < WS_END) { fprintf(stderr, "kernel_launch: unexpected shapes (n_in %d, ws %zu)\n", n_in, ws_size); grid = -1; return; }
        int dev = 0, cus = 0, per_cu = 0;
        if (hipGetDevice(&dev) != hipSuccess || hipDeviceGetAttribute(&cus, hipDeviceAttributeMultiprocessorCount, dev) != hipSuccess) { grid = -1; return; }
        if (hipFuncSetAttribute((const void*)mk_fwd, hipFuncAttributeMaxDynamicSharedMemorySize, LDS_BYTES) != hipSuccess) { fprintf(stderr, "kernel_launch: hipFuncSetAttribute failed\n"); grid = -1; return; }
        if (hipOccupancyMaxActiveBlocksPerMultiprocessor(&per_cu, (const void*)mk_fwd, NWAVES * 64, LDS_BYTES) != hipSuccess || per_cu < 1) fprintf(stderr, "kernel_launch: occupancy query reports %d\n", per_cu);
        (void)hipGetLastError();
        grid = cus;
    }
    if (grid < 0) return;
    (void)hipMemsetAsync((char*)d_ws + WS_CTL, 0, CTL_ZERO_BYTES, stream);
    Args a{};
    for (int i = 0; i < 18; ++i) a.in[i] = (const float*)d_in[i];
    a.out = (float*)d_out; a.ws = (unsigned char*)d_ws;
#if MK_SPLIT
#if DBG_NAIVE
    const int seq[] = {0, 1, 2, 3, 4, 11, 5, 6, 7, 8, 9, 10};
#else
    const int seq[] = {0, 1, 2, 3, 5, 6, 7, 8, 9, 10};
#endif
    for (int ph : seq) { a.ph_lo = ph; a.ph_hi = ph + 1;
#ifdef PROBE_P7
        if (ph == 7) { a.flags = 1; hipLaunchKernelGGL(mk_fwd, dim3(grid), dim3(NWAVES * 64), LDS_BYTES, stream, a); a.flags = 0; }
#endif
        hipLaunchKernelGGL(mk_fwd, dim3(grid), dim3(NWAVES * 64), LDS_BYTES, stream, a);
#ifdef PROBE_DUP
        if (ph == PROBE_DUP) hipLaunchKernelGGL(mk_fwd, dim3(grid), dim3(NWAVES * 64), LDS_BYTES, stream, a);
#endif
    }
#else
    a.ph_lo = 0; a.ph_hi = 11;
    hipLaunchKernelGGL(mk_fwd, dim3(grid), dim3(NWAVES * 64), LDS_BYTES, stream, a);
#endif
}
```

```cpp
#include <hip/hip_runtime.h>
#include <hip/hip_bf16.h>
#include <cstdio>
#include <cstdint>

#ifndef MK_SPLIT
#define MK_SPLIT 0
#endif
#ifndef DBG_NAIVE
#define DBG_NAIVE 0
#endif
#ifndef DBG_G
#define DBG_G 1.0f
#endif

#define LAS __attribute__((address_space(3)))
#define GAS __attribute__((address_space(1)))
typedef unsigned short bf16_t;
typedef short bf16x8 __attribute__((ext_vector_type(8)));
typedef short s16x4 __attribute__((ext_vector_type(4)));
typedef float f32x2 __attribute__((ext_vector_type(2)));
typedef float f32x4 __attribute__((ext_vector_type(4)));
typedef float f32x16 __attribute__((ext_vector_type(16)));
typedef unsigned u32x2 __attribute__((ext_vector_type(2)));
typedef unsigned u32x4 __attribute__((ext_vector_type(4)));
typedef unsigned u32x16 __attribute__((ext_vector_type(16)));
typedef __bf16 bf16x2_t __attribute__((ext_vector_type(2)));

constexpr int NTOK = 32768, SEQ = 2048, NBATCH = 16, DM = 1024;
constexpr int NPROJ = 5120, INW = 4936;
constexpr int NEXP = 32, DEXP = 512, LISTCAP = 32768;
constexpr int CAPROWS = 65536 + NEXP * 256;
constexpr float LN_EPS = 1e-5f;
constexpr float ALPHA = 1.189207115002721f;
constexpr float C2 = 0.125f * 1.4426950408889634f;
constexpr float WSCALE = 0.125f * 0.35355339059327373f;

constexpr size_t MiB = 1u << 20;
constexpr size_t WS_CTL = 0, CTL_ZERO_BYTES = 1 * MiB;
constexpr size_t WS_ROPE = 1 * MiB;
constexpr size_t WS_WC = 1 * MiB + 256 * 1024;
constexpr size_t WS_WIN = 2 * MiB, WS_WAU = 12 * MiB, WS_WCU = 13 * MiB, WS_WOUT = 14 * MiB, WS_WD = 16 * MiB, WS_WGU = 48 * MiB;
constexpr size_t WS_XB = 112 * MiB;
constexpr size_t WS_MIX = 112 * MiB;
constexpr size_t WS_H1Q = 304 * MiB;
constexpr size_t WS_AC = 112 * MiB;
constexpr size_t WS_Q = 176 * MiB, WS_K = 208 * MiB, WS_V = 216 * MiB, WS_QI = 224 * MiB, WS_KI = 256 * MiB, WS_WI = 260 * MiB;
constexpr size_t WS_MERGED = 176 * MiB;
constexpr size_t WS_U = 264 * MiB, WS_ATTN = 264 * MiB;
constexpr size_t WS_CB = 296 * MiB, WS_MASK = 360 * MiB, WS_GATES = 368 * MiB;
constexpr size_t WS_GA = 368 * MiB, WS_RT = 432 * MiB;
constexpr size_t WS_PRE = 240 * MiB;
constexpr size_t WS_HID = 368 * MiB;
constexpr size_t WS_LIST = 496 * MiB, WS_TOKINFO = 500 * MiB;
constexpr size_t WS_YS = 48 * MiB;
constexpr size_t WS_END = 512 * MiB;
static_assert(WS_YS + (size_t)CAPROWS * 1024 * 2 <= WS_PRE && WS_HID + (size_t)CAPROWS * 512 * 2 <= WS_LIST, "ws map");
constexpr int CW_BAR = 4096;
constexpr int CW_CNT = 8192;
constexpr int RING_BYTES = 131072;
constexpr int LDSCTL_OFF = RING_BYTES;
constexpr int TAB_OFF = RING_BYTES + 512;
constexpr int T_CNT = 0, T_BLK0 = 32, T_NB = 68, T_BLKE = 72, T_ROWS = 400, T_ROWS_UNITS = 12;
constexpr int QIF_OFF = 147456;
constexpr int LDS_BYTES = 163840;
static_assert(TAB_OFF + (T_ROWS + T_ROWS_UNITS * 256) * 4 <= QIF_OFF && TAB_OFF + 8192 + 1024 <= QIF_OFF && QIF_OFF + 16384 <= LDS_BYTES, "lds map");
constexpr int NWAVES = 8;

__device__ __forceinline__ unsigned pkbf(float lo, float hi) { f32x2 v = {lo, hi}; bf16x2_t b = __builtin_convertvector(v, bf16x2_t); return __builtin_bit_cast(unsigned, b); }
__device__ __forceinline__ float bflo(unsigned u) { return __uint_as_float(u << 16); }
__device__ __forceinline__ float bfhi(unsigned u) { return __uint_as_float(u & 0xffff0000u); }
__device__ __forceinline__ float wave_sum(float v) {
#pragma unroll
    for (int o = 1; o < 64; o <<= 1) v += __shfl_xor(v, o);
    return v;
}
__device__ __forceinline__ float wave_max(float v) {
#pragma unroll
    for (int o = 1; o < 64; o <<= 1) v = fmaxf(v, __shfl_xor(v, o));
    return v;
}
__device__ __forceinline__ float wave_min(float v) {
#pragma unroll
    for (int o = 1; o < 64; o <<= 1) v = fminf(v, __shfl_xor(v, o));
    return v;
}
#define LDS_WAIT() asm volatile("s_waitcnt lgkmcnt(0)" ::: "memory")
#define VM_WAIT() asm volatile("s_waitcnt vmcnt(0)" ::: "memory")

namespace pg8 {
constexpr int BM = 256, BK = 64, HALF = 128, HTB = HALF * BK * 2, STAGE_BYTES = 8 * HTB, NXCD = 8, WGM = 8;
__host__ __device__ __forceinline__ int lds_byte(int r, int c) { const int st = (r >> 4) * 2 + (c >> 5), rr = r & 15, cc = c & 31, ob = rr * 64 + cc * 2; return st * 1024 + (ob ^ (((ob >> 9) & 1) << 5)); }
__host__ __device__ __forceinline__ void stage_rc(int b, int& R, int& C) { const int st = b / 1024, sb = b % 1024, swz = sb ^ (((sb >> 9) & 1) << 5); R = (st >> 1) * 16 + swz / 64; C = (st & 1) * 32 + (swz % 64) / 2; }
__host__ __device__ __forceinline__ int perm32(int rho) { const int n = rho >> 4, i = rho & 15; return 8 * (i >> 2) + 4 * n + (i & 3); }

struct Unit { int pm, pn; };
struct Gemm { const bf16_t* A; const bf16_t* Bt; int M, N, K; int apitch; };

struct StaticOrder {
    int nM, nN, nwg, G, c;
    __host__ __device__ void init(int M, int N, int G_, int c_) { nM = M / BM; nN = N / BM; nwg = nM * nN; G = G_; c = c_; }
    __host__ __device__ bool next(int i, Unit& u) const {
        const long L = (long)i * G + c; if (L >= nwg) return false;
        int wgid = (int)L; { const int q = nwg / NXCD, r = nwg % NXCD, xcd = wgid % NXCD, off = wgid / NXCD; wgid = (xcd < r ? xcd * (q + 1) : r * (q + 1) + (xcd - r) * q) + off; }
        const int nig = WGM * nN, gid = wgid / nig, fm = gid * WGM, gsz = (nM - fm) < WGM ? (nM - fm) : WGM;
        u.pm = fm + ((wgid % nig) % gsz); u.pn = (wgid % nig) / gsz; return true;
    }
};
struct MoeOrder {
    const LAS int* blk_e; int nunits, G, c;
    __device__ __forceinline__ bool next(int i, Unit& u) const {
        const int L = i * G + c; if (L >= nunits) return false;
        const int rbg = L >> 2; u.pm = rbg; u.pn = blk_e[rbg] * 4 + (L & 3); return true;
    }
};

typedef int i32x8 __attribute__((ext_vector_type(8)));
typedef int i32x4_t __attribute__((ext_vector_type(4)));
constexpr int F8_WSCALE_E = 122;
template <class Epi, class Sched, bool ALIGN_EPI, bool GATHER, bool MIDHOOK = false, bool F8 = false>
__device__ __forceinline__ void gemm_phase(LAS unsigned char* lds, const Gemm g, const Sched& S, const Epi& E, const LAS int* rowtab) {
    const int tid = threadIdx.x, wid = __builtin_amdgcn_readfirstlane(tid >> 6), lane = tid & 63, wr = wid >> 2, wc = wid & 3, fr = lane & 15, fq = lane >> 4;
    const int K = g.K; int nt = K / BK;
    if constexpr (F8) asm volatile("" : "+s"(nt));
    int Rr[2]; unsigned cofs[2], voffB[2];
#pragma unroll
    for (int i = 0; i < 2; ++i) { int R, C; stage_rc(tid * 16 + i * 8192, R, C); const int Rb = Epi::PERM ? ((R & ~31) + perm32(R & 31)) : R;
        Rr[i] = R; cofs[i] = (unsigned)C * 2u; voffB[i] = (unsigned)(Rb * K + C) * 2u; }
    const unsigned rowb = g.apitch ? (unsigned)g.apitch : (unsigned)K * 2u;
    const size_t kstep = (size_t)(BK * 2);
    const size_t hstep = (size_t)HALF * K * 2;
    const size_t tstep = 2 * hstep;
    const unsigned ldsw = (unsigned)wid * 1024u;
    const int aoff = lds_byte(wr * 64 + fr, fq * 8), boff = lds_byte(wc * 32 + fr, fq * 8);
    const char* gA = (const char*)g.A;
#define PG8_SA(b, h) (((b) * 2 + (h)) * HTB)
#define PG8_SB(b, h) ((4 + (b) * 2 + (h)) * HTB)
#define PG8_STAGE(bufoff, gbase, voff) do { _Pragma("unroll") for (int _i = 0; _i < 2; ++_i) \
        __builtin_amdgcn_global_load_lds((const unsigned*)((const char*)(gbase) + (voff)[_i]), (LAS unsigned*)(lds + (bufoff) + ldsw + _i * 8192), 16, 0, 0); } while (0)
#define PG8_LD8(p_) __builtin_shufflevector(*(const LAS i32x4_t*)(p_), *(const LAS i32x4_t*)((p_) + 1024), 0, 1, 2, 3, 4, 5, 6, 7)
#define PG8_LDA(dst, b, h) do { if constexpr (F8) { _Pragma("unroll") for (int m = 0; m < 4; ++m) dst##8[m] = PG8_LD8(lds + PG8_SA(b, h) + aoff + m * 2048); } \
        else { _Pragma("unroll") for (int m = 0; m < 4; ++m) _Pragma("unroll") for (int k = 0; k < 2; ++k) dst[m][k] = *(const LAS bf16x8*)(lds + PG8_SA(b, h) + aoff + m * 2048 + k * 1024); } } while (0)
#define PG8_LDB(dst, b, h) do { if constexpr (F8) { _Pragma("unroll") for (int n = 0; n < 2; ++n) dst##8[n] = PG8_LD8(lds + PG8_SB(b, h) + boff + n * 2048); } \
        else { _Pragma("unroll") for (int n = 0; n < 2; ++n) _Pragma("unroll") for (int k = 0; k < 2; ++k) dst[n][k] = *(const LAS bf16x8*)(lds + PG8_SB(b, h) + boff + n * 2048 + k * 1024); } } while (0)
#define PG8_MMA(ai, bj, At, Bt) do { if constexpr (F8) __builtin_amdgcn_sched_barrier(0);     \
        __builtin_amdgcn_s_setprio(1); \
        if constexpr (F8) { _Pragma("unroll") for (int m = 0; m < 4; ++m) _Pragma("unroll") for (int n = 0; n < 2; ++n) \
            asm volatile("v_mfma_scale_f32_16x16x128_f8f6f4 %0, %1, %2, %0, %3, %4 op_sel_hi:[0,0,0]" : "+v"(acc[ai][bj][m][n]) : "v"(Bt##8[n]), "v"(At##8[m]), "v"(f8_sw), "v"(f8_sa));     \
            __builtin_amdgcn_sched_barrier(0); } \
        else { _Pragma("unroll") for (int m = 0; m < 4; ++m) _Pragma("unroll") for (int n = 0; n < 2; ++n) _Pragma("unroll") for (int k = 0; k < 2; ++k) \
            acc[ai][bj][m][n] = __builtin_amdgcn_mfma_f32_16x16x32_bf16(Bt[n][k], At[m][k], acc[ai][bj][m][n], 0, 0, 0); } \
        __builtin_amdgcn_s_setprio(0); } while (0)
#define PG8_WAIT_V(n) asm volatile("s_waitcnt vmcnt(" #n ")" ::: "memory")
#define PG8_WAIT_L(n) asm volatile("s_waitcnt lgkmcnt(" #n ")" ::: "memory")
#define PG8_BAR __builtin_amdgcn_s_barrier()
#define PG8_SCHED __builtin_amdgcn_sched_barrier(0)
#define PG8_AOFF(d0, d1, un, uidx) do { _Pragma("unroll") for (int _i = 0; _i < 2; ++_i) { unsigned r0_, r1_; \
        if (GATHER) { r0_ = (unsigned)rowtab[(uidx) * 256 + Rr[_i]]; r1_ = (unsigned)rowtab[(uidx) * 256 + 128 + Rr[_i]]; } \
        else { r0_ = (unsigned)((un).pm * 256 + Rr[_i]); r1_ = r0_ + 128u; } \
        d0[_i] = r0_ * rowb + cofs[_i]; d1[_i] = r1_ * rowb + cofs[_i]; } } while (0)
    Unit cur, nxt; int ui = 0;
    if (!S.next(0, cur)) return;
    f32x4 acc[2][2][4][2];
#pragma unroll
    for (int a = 0; a < 2; ++a)
#pragma unroll
        for (int b = 0; b < 2; ++b)
#pragma unroll
            for (int m = 0; m < 4; ++m)
#pragma unroll
                for (int n = 0; n < 2; ++n) acc[a][b][m][n] = (f32x4){0.f, 0.f, 0.f, 0.f};
    bf16x8 At[4][2], B0[2][2], B1[2][2]; i32x8 At8[4], B08[2], B18[2];
    int f8_sw = F8_WSCALE_E, f8_sa = 127; asm volatile("" : "+v"(f8_sw), "+v"(f8_sa));
    unsigned oc0[2], oc1[2], on0[2], on1[2];
    PG8_AOFF(oc0, oc1, cur, 0);
    const char* cB = (const char*)g.Bt + (size_t)cur.pn * tstep;
    PG8_STAGE(PG8_SB(0, 0), cB, voffB); PG8_STAGE(PG8_SB(0, 1), cB + hstep, voffB); PG8_STAGE(PG8_SA(0, 0), gA, oc0); PG8_STAGE(PG8_SA(0, 1), gA, oc1);
    if (wr == 1) PG8_BAR;
    PG8_WAIT_V(2); PG8_BAR;
    PG8_STAGE(PG8_SB(1, 0), cB + kstep, voffB); PG8_STAGE(PG8_SA(1, 0), gA + kstep, oc0); PG8_STAGE(PG8_SB(1, 1), cB + hstep + kstep, voffB);
    PG8_WAIT_V(6); PG8_BAR;
    for (;;) {
        const bool has_next = S.next(ui + 1, nxt);
        if (has_next) { PG8_AOFF(on0, on1, nxt, ui + 1); } else { on0[0] = oc0[0]; on0[1] = oc0[1]; on1[0] = oc1[0]; on1[1] = oc1[1]; }
        const char* nB = has_next ? (const char*)g.Bt + (size_t)nxt.pn * tstep : cB;
        for (int t = 0; t < nt; t += 2) {
            if constexpr (MIDHOOK) { if (t == nt / 2) E.mid(acc, cur, wr, wc, fr, fq); }
            const bool last = (t == nt - 2);
            const char* a1 = gA + (size_t)(t + 1) * kstep;
            const char* a2 = last ? gA : gA + (size_t)(t + 2) * kstep; const char* b2 = last ? nB : cB + (size_t)(t + 2) * kstep;
            const char* a3 = a2 + kstep; const char* b3 = b2 + kstep;
            unsigned o20[2], o21[2];
            o20[0] = last ? on0[0] : oc0[0]; o20[1] = last ? on0[1] : oc0[1]; o21[0] = last ? on1[0] : oc1[0]; o21[1] = last ? on1[1] : oc1[1];
            PG8_LDB(B0, 0, 0); PG8_LDB(B1, 0, 1); PG8_SCHED; PG8_LDA(At, 0, 0); PG8_STAGE(PG8_SA(1, 1), a1, oc1);
            PG8_WAIT_V(8); PG8_WAIT_L(0); PG8_BAR; PG8_MMA(0, 0, At, B0); PG8_MMA(0, 1, At, B1); PG8_BAR; PG8_SCHED;
            PG8_LDA(At, 0, 1); PG8_STAGE(PG8_SB(0, 0), b2, voffB); PG8_STAGE(PG8_SB(0, 1), b2 + hstep, voffB); PG8_STAGE(PG8_SA(0, 0), a2, o20);
            PG8_WAIT_V(8); PG8_WAIT_L(0); PG8_BAR; PG8_MMA(1, 0, At, B0); PG8_MMA(1, 1, At, B1); PG8_BAR; PG8_SCHED;
            PG8_LDB(B0, 1, 0); PG8_LDB(B1, 1, 1); PG8_SCHED; PG8_LDA(At, 1, 0); PG8_STAGE(PG8_SA(0, 1), a2, o21);
            PG8_WAIT_V(8); PG8_WAIT_L(0); PG8_BAR; PG8_MMA(0, 0, At, B0); PG8_MMA(0, 1, At, B1); PG8_BAR; PG8_SCHED;
            PG8_LDA(At, 1, 1); PG8_STAGE(PG8_SB(1, 0), b3, voffB); PG8_STAGE(PG8_SB(1, 1), b3 + hstep, voffB); PG8_STAGE(PG8_SA(1, 0), a3, o20);
            PG8_WAIT_V(8); PG8_WAIT_L(0); PG8_BAR; PG8_MMA(1, 0, At, B0); PG8_MMA(1, 1, At, B1); PG8_BAR; PG8_SCHED;
        }
        if constexpr (ALIGN_EPI) { if (wr == 0) PG8_BAR; }
        if constexpr (F8) asm volatile("s_nop 15\n\ts_nop 15" ::: "memory");
        E(acc, cur, wr, wc, fr, fq);
#ifdef PROBE_EPI2
        if constexpr (!MIDHOOK && !F8 && !GATHER) E(acc, cur, wr, wc, fr, fq);
#endif
        if (!has_next) break;
#pragma unroll
        for (int a = 0; a < 2; ++a)
#pragma unroll
            for (int b = 0; b < 2; ++b)
#pragma unroll
                for (int m = 0; m < 4; ++m)
#pragma unroll
                    for (int n = 0; n < 2; ++n) acc[a][b][m][n] = (f32x4){0.f, 0.f, 0.f, 0.f};
        cur = nxt; cB = nB; ++ui;
        oc0[0] = on0[0]; oc0[1] = on0[1]; oc1[0] = on1[0]; oc1[1] = on1[1];
        if constexpr (ALIGN_EPI) { if (wr == 1) PG8_BAR; }
    }
    PG8_WAIT_V(0);
    if constexpr (!ALIGN_EPI) { if (wr == 0) PG8_BAR; }
    PG8_BAR;
#undef PG8_SA
#undef PG8_SB
#undef PG8_STAGE
#undef PG8_LDA
#undef PG8_LDB
#undef PG8_MMA
#undef PG8_LD8
#undef PG8_WAIT_V
#undef PG8_WAIT_L
#undef PG8_BAR
#undef PG8_SCHED
#undef PG8_AOFF
}
}

typedef f32x4 AccT[2][2][4][2];
__device__ __forceinline__ void store8bf(bf16_t* p, const f32x4& v0, const f32x4& v1) {
    u32x4 w; w.x = pkbf(v0[0], v0[1]); w.y = pkbf(v0[2], v0[3]); w.z = pkbf(v1[0], v1[1]); w.w = pkbf(v1[2], v1[3]); *(u32x4*)p = w;
}
__device__ __forceinline__ void rope8(f32x4& v0, f32x4& v1, const float* rope, int pos, int i0) {
    const f32x4 c = *(const f32x4*)(rope + pos * 8 + i0), s = *(const f32x4*)(rope + SEQ * 8 + pos * 8 + i0);
    float a, b;
    a = v0[0]; b = v0[1]; v0[0] = a * c[0] - b * s[0]; v0[1] = b * c[0] + a * s[0];
    a = v0[2]; b = v0[3]; v0[2] = a * c[1] - b * s[1]; v0[3] = b * c[1] + a * s[1];
    a = v1[0]; b = v1[1]; v1[0] = a * c[2] - b * s[2]; v1[1] = b * c[2] + a * s[2];
    a = v1[2]; b = v1[3]; v1[2] = a * c[3] - b * s[3]; v1[3] = b * c[3] + a * s[3];
}
__device__ __forceinline__ float sigmoidf_(float z) { return __builtin_amdgcn_rcpf(1.0f + __expf(-z)); }

struct EpiProj {
    static constexpr bool PERM = true;
    bf16_t *q, *k, *v, *qi, *ki, *u, *cb, *ga, *rt; float* wi; const float* rope; const float* gate_bias;
    __device__ __forceinline__ void operator()(const AccT& acc, const pg8::Unit& un, int wr, int wc, int fr, int fq) const {
        const int pn = un.pn, row0 = un.pm * 256 + wr * 64 + fr, cg = 32 * wc + 8 * fq;
        const bool rot = ((wc & 1) == 0) && (fq < 2); const int i0 = 4 * fq;
        if (pn < 2 || pn == 3 || pn == 4) {
            bf16_t* dst = (pn < 2) ? q + pn * 256 : qi + (pn - 3) * 256; const float sc = (pn < 2) ? C2 : 1.0f;
#pragma unroll
            for (int ai = 0; ai < 2; ++ai)
#pragma unroll
                for (int m = 0; m < 4; ++m) { const int row = row0 + ai * 128 + m * 16, pos = row & (SEQ - 1);
#pragma unroll
                    for (int bj = 0; bj < 2; ++bj) { f32x4 v0 = acc[ai][bj][m][0], v1 = acc[ai][bj][m][1];
                        if (rot) rope8(v0, v1, rope, pos, i0);
                        v0 = v0 * sc; v1 = v1 * sc; store8bf(dst + (size_t)row * 512 + bj * 128 + cg, v0, v1); } }
        } else if (pn == 2) {
#pragma unroll
            for (int ai = 0; ai < 2; ++ai)
#pragma unroll
                for (int m = 0; m < 4; ++m) { const int row = row0 + ai * 128 + m * 16, pos = row & (SEQ - 1);
                    f32x4 v0 = acc[ai][0][m][0], v1 = acc[ai][0][m][1];
                    if (rot) rope8(v0, v1, rope, pos, i0);
                    store8bf(k + (size_t)row * 128 + cg, v0, v1);
                    store8bf(v + (size_t)row * 128 + cg, acc[ai][1][m][0], acc[ai][1][m][1]); }
        } else if (pn == 5) {
            if (wc < 2) {
#pragma unroll
                for (int ai = 0; ai < 2; ++ai)
#pragma unroll
                    for (int m = 0; m < 4; ++m) { const int row = row0 + ai * 128 + m * 16, pos = row & (SEQ - 1);
                        f32x4 v0 = acc[ai][0][m][0], v1 = acc[ai][0][m][1];
                        if (rot) rope8(v0, v1, rope, pos, i0);
                        { const int jch = cg >> 3; store8bf(ki + ((size_t)(row >> 5) * 4 + (jch >> 1)) * 512 + (row & 31) * 16 + (jch & 1) * 8, v0, v1); } }
            } else if (wc == 2 && fq == 0) {
#pragma unroll
                for (int ai = 0; ai < 2; ++ai)
#pragma unroll
                    for (int m = 0; m < 4; ++m) { const int row = row0 + ai * 128 + m * 16;
                        *(f32x4*)(wi + (size_t)row * 8) = acc[ai][0][m][0]; *(f32x4*)(wi + (size_t)row * 8 + 4) = acc[ai][0][m][1]; }
            }
        } else if (pn < 10) {
#pragma unroll
            for (int ai = 0; ai < 2; ++ai)
#pragma unroll
                for (int m = 0; m < 4; ++m) { const int row = row0 + ai * 128 + m * 16;
                    store8bf(u + (size_t)row * 512 + (pn - 6) * 128 + cg, acc[ai][0][m][0] * acc[ai][1][m][0], acc[ai][0][m][1] * acc[ai][1][m][1]); }
        } else if (pn < 12) {
#pragma unroll
            for (int ai = 0; ai < 2; ++ai)
#pragma unroll
                for (int m = 0; m < 4; ++m) { const int row = row0 + ai * 128 + m * 16;
#pragma unroll
                    for (int bj = 0; bj < 2; ++bj) store8bf(cb + (size_t)row * 512 + (pn - 10) * 256 + bj * 128 + cg, acc[ai][bj][m][0], acc[ai][bj][m][1]); }
        } else {
            const int gc0 = (pn - 12) * 128 + cg;
            const f32x4 ba0 = *(const f32x4*)(gate_bias + gc0), ba1 = *(const f32x4*)(gate_bias + gc0 + 4), bc0 = *(const f32x4*)(gate_bias + 1024 + gc0), bc1 = *(const f32x4*)(gate_bias + 1024 + gc0 + 4);
#pragma unroll
            for (int ai = 0; ai < 2; ++ai)
#pragma unroll
                for (int m = 0; m < 4; ++m) { const int row = row0 + ai * 128 + m * 16;
                    const f32x4 a0 = acc[ai][0][m][0] + ba0, a1 = acc[ai][0][m][1] + ba1, c0 = acc[ai][1][m][0] + bc0, c1 = acc[ai][1][m][1] + bc1;
                    f32x4 g0, g1, r0, r1;
#pragma unroll
                    for (int e = 0; e < 4; ++e) { const float ea0 = 1.0f + __expf(-a0[e]), ea1 = 1.0f + __expf(-a1[e]);
                        g0[e] = __builtin_amdgcn_rcpf(ea0); g1[e] = __builtin_amdgcn_rcpf(ea1);
                        r0[e] = ea0 * __builtin_amdgcn_rcpf(1.0f + __expf(-c0[e])); r1[e] = ea1 * __builtin_amdgcn_rcpf(1.0f + __expf(-c1[e])); }
                    store8bf(ga + (size_t)row * 1024 + gc0, g0, g1); store8bf(rt + (size_t)row * 1024 + gc0, r0, r1); }
        }
    }
};
struct EpiMerged {
    static constexpr bool PERM = true;
    const bf16_t* ga; const bf16_t* rt; bf16_t* out;
    __device__ __forceinline__ void scale(AccT& acc, const bf16_t* gsrc, const pg8::Unit& un, int wr, int wc, int fr, int fq) const {
        unsigned off0 = (unsigned)(un.pm * 256 + wr * 64 + fr) * 1024u + (unsigned)(un.pn * 256 + 32 * wc + 8 * fq);
        asm volatile("" : "+v"(off0));
#pragma unroll
        for (int ai = 0; ai < 2; ++ai)
#pragma unroll
            for (int m = 0; m < 4; ++m) {
#pragma unroll
                for (int bj = 0; bj < 2; ++bj) { const u32x4 gw = __builtin_nontemporal_load((const u32x4*)(gsrc + (off0 + (unsigned)((ai * 128 + m * 16) * 1024 + bj * 128))));
                    f32x4& v0 = acc[ai][bj][m][0]; f32x4& v1 = acc[ai][bj][m][1];
                    v0[0] *= bflo(gw.x); v0[1] *= bfhi(gw.x); v0[2] *= bflo(gw.y); v0[3] *= bfhi(gw.y);
                    v1[0] *= bflo(gw.z); v1[1] *= bfhi(gw.z); v1[2] *= bflo(gw.w); v1[3] *= bfhi(gw.w); } }
    }
    __device__ __forceinline__ void mid(AccT& acc, const pg8::Unit& un, int wr, int wc, int fr, int fq) const { scale(acc, rt, un, wr, wc, fr, fq); }
    __device__ __forceinline__ void operator()(AccT& acc, const pg8::Unit& un, int wr, int wc, int fr, int fq) const {
        scale(acc, ga, un, wr, wc, fr, fq);
        const int row0 = un.pm * 256 + wr * 64 + fr, col0 = un.pn * 256 + 32 * wc + 8 * fq;
#pragma unroll
        for (int ai = 0; ai < 2; ++ai)
#pragma unroll
            for (int m = 0; m < 4; ++m) { const int row = row0 + ai * 128 + m * 16;
#pragma unroll
                for (int bj = 0; bj < 2; ++bj) store8bf(out + (size_t)row * 1024 + col0 + bj * 128, acc[ai][bj][m][0], acc[ai][bj][m][1]); }
    }
};
struct EpiOut {
    static constexpr bool PERM = true;
    bf16_t* mix;
    __device__ __forceinline__ void operator()(const AccT& acc, const pg8::Unit& un, int wr, int wc, int fr, int fq) const {
        const int row0 = un.pm * 256 + wr * 64 + fr, col0 = un.pn * 256 + 32 * wc + 8 * fq;
#pragma unroll
        for (int ai = 0; ai < 2; ++ai)
#pragma unroll
            for (int m = 0; m < 4; ++m) { const int row = row0 + ai * 128 + m * 16;
#pragma unroll
                for (int bj = 0; bj < 2; ++bj) store8bf(mix + (size_t)row * 1024 + col0 + bj * 128, acc[ai][bj][m][0], acc[ai][bj][m][1]); }
    }
};
struct EpiSwiGLU {
    static constexpr bool PERM = true;
    unsigned char* hid;
    __device__ __forceinline__ void operator()(const AccT& acc, const pg8::Unit& un, int wr, int wc, int fr, int fq) const {
        const int row0 = un.pm * 256 + wr * 64 + fr, col0 = (un.pn & 3) * 128 + 32 * wc + 8 * fq;
#pragma unroll
        for (int ai = 0; ai < 2; ++ai)
#pragma unroll
            for (int m = 0; m < 4; ++m) { const int row = row0 + ai * 128 + m * 16; f32x4 h0, h1;
#pragma unroll
                for (int e = 0; e < 4; ++e) { const float g0 = acc[ai][0][m][0][e], g1 = acc[ai][0][m][1][e];
                    h0[e] = g0 * sigmoidf_(g0) * acc[ai][1][m][0][e]; h1[e] = g1 * sigmoidf_(g1) * acc[ai][1][m][1][e]; }
                int w0 = 0, w1 = 0;
                w0 = __builtin_amdgcn_cvt_pk_fp8_f32(h0[0], h0[1], w0, false); w0 = __builtin_amdgcn_cvt_pk_fp8_f32(h0[2], h0[3], w0, true);
                w1 = __builtin_amdgcn_cvt_pk_fp8_f32(h1[0], h1[1], w1, false); w1 = __builtin_amdgcn_cvt_pk_fp8_f32(h1[2], h1[3], w1, true);
                *(u32x2*)(hid + (size_t)row * 512 + col0) = (u32x2){(unsigned)w0, (unsigned)w1}; }
    }
};
struct EpiYs {
    static constexpr bool PERM = true;
    unsigned char* ys;
    __device__ __forceinline__ void operator()(const AccT& acc, const pg8::Unit& un, int wr, int wc, int fr, int fq) const {
        const int row0 = un.pm * 256 + wr * 64 + fr, col0 = (un.pn & 3) * 256 + 32 * wc + 8 * fq;
#pragma unroll
        for (int ai = 0; ai < 2; ++ai)
#pragma unroll
            for (int m = 0; m < 4; ++m) { const int row = row0 + ai * 128 + m * 16;
#pragma unroll
                for (int bj = 0; bj < 2; ++bj) { const f32x4 v0 = acc[ai][bj][m][0], v1 = acc[ai][bj][m][1]; int w0 = 0, w1 = 0;
                    w0 = __builtin_amdgcn_cvt_pk_fp8_f32(v0[0], v0[1], w0, false); w0 = __builtin_amdgcn_cvt_pk_fp8_f32(v0[2], v0[3], w0, true);
                    w1 = __builtin_amdgcn_cvt_pk_fp8_f32(v1[0], v1[1], w1, false); w1 = __builtin_amdgcn_cvt_pk_fp8_f32(v1[2], v1[3], w1, true);
                    *(u32x2*)(ys + (size_t)row * 1024 + col0 + bj * 128) = (u32x2){(unsigned)w0, (unsigned)w1}; } }
    }
};

namespace attn_body {
using bf16 = __hip_bfloat16;
constexpr int D = 64, QP = 512, KP = 128, OP = 1024, OCOL = 512;
constexpr int NW = 8, QBLK = 32, QB = QBLK * NW, KVBLK = 64;
__device__ __forceinline__ int crow(int r, int hi) { return (r & 3) + 8 * (r >> 2) + 4 * hi; }
#define SBAR() __builtin_amdgcn_sched_barrier(0)
__device__ __forceinline__ void cmask(f32x16& p0, f32x16& p1, int jb, int qrel, int hi) {
    const float NEG = -INFINITY; int kb = 64 * jb + 4 * hi;
#pragma unroll
    for (int r = 0; r < 16; ++r) { int kv = kb + (r & 3) + 8 * (r >> 2); if (kv > qrel) p0[r] = NEG; if (kv + 32 > qrel) p1[r] = NEG; }
}
constexpr int NSLOT = 3, SLOTB = 8192;
constexpr int LDS_K = 0, LDS_V = NSLOT * SLOTB, LDS_WS = 2 * NSLOT * SLOTB, LDS_OST = LDS_WS + NW * 64 * 4, LDS_QF = LDS_OST + NW * 4096, LDS_BYTES_A = LDS_QF + NW * 4096;
static_assert(LDS_BYTES_A <= 131072, "attention LDS");
__device__ __forceinline__ void glds16(const void* gsrc, unsigned lds_dst) { unsigned keep;
    asm volatile("s_mov_b32 %0, m0\n\ts_mov_b32 m0, %2\n\ts_nop 0\n\tglobal_load_lds_dwordx4 %1, off\n\ts_mov_b32 m0, %0" : "=&s"(keep) : "v"(gsrc), "s"(lds_dst) : "memory"); }
__device__ __forceinline__ float max3f(float a, float b, float c) { float r; asm("v_max3_f32 %0, %1, %2, %3" : "=v"(r) : "v"(a), "v"(b), "v"(c)); return r; }
__device__ __forceinline__ float max2f(float a, float b) { float r; asm("v_max_f32_e32 %0, %1, %2" : "=v"(r) : "v"(a), "v"(b)); return r; }
__device__ __forceinline__ float fadd_s(float a, float b) { float r; asm("v_add_f32_e32 %0, %1, %2" : "=v"(r) : "v"(a), "v"(b)); return r; }
__device__ __forceinline__ float fsub_s(float a, float b) { float r; asm("v_sub_f32_e32 %0, %1, %2" : "=v"(r) : "v"(a), "v"(b)); return r; }
__device__ __forceinline__ unsigned cvtpk_s(float lo, float hi) { return pkbf(lo, hi); }
__device__ __forceinline__ float msel(float x, float neg, unsigned long long m) { float r; asm("v_cndmask_b32_e64 %0, %1, %2, %3" : "=v"(r) : "v"(neg), "v"(x), "s"(m)); return r; }
#define WAIT_BAR(N) asm volatile("s_waitcnt vmcnt(" #N ") lgkmcnt(0)\n\ts_barrier" ::: "memory")

typedef __attribute__((address_space(3))) const char* lds_cptr;
__device__ __forceinline__ void qkt(f32x16& p0, f32x16& p1, const char* Kslot, lds_cptr qfp, const f32x16& negm, int r32, int hi) {
    const char* kb = Kslot + hi * 1024 + r32 * 16;
#pragma unroll
    for (int d0 = 0; d0 < 4; ++d0) {
        const bf16x8 b0 = *reinterpret_cast<const bf16x8*>(kb + d0 * 2048);
        const bf16x8 b1 = *reinterpret_cast<const bf16x8*>(kb + d0 * 2048 + 512);
        const bf16x8 qd = *(const LAS bf16x8*)(qfp + d0 * 1024);
        if (d0 == 0) { p0 = __builtin_amdgcn_mfma_f32_32x32x16_bf16(b0, qd, negm, 0, 0, 0); p1 = __builtin_amdgcn_mfma_f32_32x32x16_bf16(b1, qd, negm, 0, 0, 0); }
        else { p0 = __builtin_amdgcn_mfma_f32_32x32x16_bf16(b0, qd, p0, 0, 0, 0); p1 = __builtin_amdgcn_mfma_f32_32x32x16_bf16(b1, qd, p1, 0, 0, 0); } }
}
typedef short v4i16_t __attribute__((ext_vector_type(4)));
__device__ __forceinline__ void kload8(bf16x8* kf, lds_cptr kp) {
    kf[0] = *(const LAS bf16x8*)(kp);        kf[1] = *(const LAS bf16x8*)(kp + 512);
    kf[2] = *(const LAS bf16x8*)(kp + 2048); kf[3] = *(const LAS bf16x8*)(kp + 2560);
    kf[4] = *(const LAS bf16x8*)(kp + 4096); kf[5] = *(const LAS bf16x8*)(kp + 4608);
    kf[6] = *(const LAS bf16x8*)(kp + 6144); kf[7] = *(const LAS bf16x8*)(kp + 6656);
}
__device__ __forceinline__ void kload2(bf16x8* kf, lds_cptr kp, int j) { kf[2 * j] = *(const LAS bf16x8*)(kp + j * 2048); kf[2 * j + 1] = *(const LAS bf16x8*)(kp + j * 2048 + 512); }
__device__ __forceinline__ s16x4 vtr(lds_cptr p) { return __builtin_bit_cast(s16x4, __builtin_amdgcn_ds_read_tr16_b64_v4i16((LAS v4i16_t*)p)); }
__device__ __forceinline__ float rowmax(const f32x16& p0, const f32x16& p1) {
    float a = max3f(p0[0], p0[1], p1[0]), b = max3f(p0[2], p0[3], p1[1]); a = max3f(a, p1[2], p1[3]);
#pragma unroll
    for (int r = 4; r < 16; r += 4) { a = max3f(a, p0[r], p0[r + 1]); b = max3f(b, p0[r + 2], p0[r + 3]); a = max3f(a, p1[r], p1[r + 1]); b = max3f(b, p1[r + 2], p1[r + 3]); }
    const float m = max2f(a, b);
    auto rr = __builtin_amdgcn_permlane32_swap(__float_as_uint(m), __float_as_uint(m), false, false);
    return max2f(__uint_as_float(rr[0]), __uint_as_float(rr[1]));
}
__device__ __forceinline__ void pv(f32x16* o, int vb, bf16x8 pa0, bf16x8 pa1, bf16x8 pa2, bf16x8 pa3) {
#pragma unroll
    for (int d0 = 0; d0 < 2; ++d0) { s16x4 lo[4], hi[4];
#pragma unroll
        for (int ks = 0; ks < 4; ++ks) {
            asm volatile("ds_read_b64_tr_b16 %0,%1 offset:%c2" : "=&v"(lo[ks]) : "v"(vb), "i"(d0 * 4096 + ks * 1024) : "memory");
            asm volatile("ds_read_b64_tr_b16 %0,%1 offset:%c2" : "=&v"(hi[ks]) : "v"(vb), "i"(d0 * 4096 + ks * 1024 + 512) : "memory"); }
        asm volatile("s_waitcnt lgkmcnt(0)" ::: "memory"); SBAR();
#define PK(k) (bf16x8){lo[k][0], lo[k][1], lo[k][2], lo[k][3], hi[k][0], hi[k][1], hi[k][2], hi[k][3]}
        o[d0] = __builtin_amdgcn_mfma_f32_32x32x16_bf16(pa0, PK(0), o[d0], 0, 0, 0);
        o[d0] = __builtin_amdgcn_mfma_f32_32x32x16_bf16(pa1, PK(1), o[d0], 0, 0, 0);
        o[d0] = __builtin_amdgcn_mfma_f32_32x32x16_bf16(pa2, PK(2), o[d0], 0, 0, 0);
        o[d0] = __builtin_amdgcn_mfma_f32_32x32x16_bf16(pa3, PK(3), o[d0], 0, 0, 0);
#undef PK
    }
}
#define ATTN_STORE16(p, v) (*(u32x4*)(p) = (v))
template <int THRL> __device__ __forceinline__ void attn_unit(int b, int h, int qb, const bf16* Q, const bf16* __restrict__ K, const bf16* __restrict__ V, bf16* O, const unsigned* masks, char* shm) {
    const int tid = threadIdx.x, lane = tid & 63, r32 = lane & 31, hi = lane >> 5; const int wid = __builtin_amdgcn_readfirstlane(tid >> 6);
    const long rowbase = (long)b * SEQ; const int q0 = qb * QB;
    const bf16* Qw = Q + (rowbase + q0 + wid * QBLK) * QP + h * D;
    const bf16 *Kh = K + rowbase * KP + (h >> 2) * D, *Vh = V + rowbase * KP + (h >> 2) * D;
    const unsigned* mrow = masks + ((size_t)(b * (SEQ / 32) + (q0 >> 5) + wid) * (SEQ / 64)) * 64;
    const unsigned lds0 = (unsigned)(uintptr_t)shm;
    float* wsf = (float*)(shm + LDS_WS) + wid * 64;
    const bf16* ksrc = Kh + (long)lane * KP + wid * 8;
    const bf16* vsrc = Vh + (long)(16 * (wid & 3) + (lane >> 2)) * KP + (wid >> 2) * 32 + (lane & 3) * 8;
    const unsigned kdst = lds0 + LDS_K + wid * 1024, vdst = lds0 + LDS_V + wid * 1024;
#define DMA_K(t, slot) glds16(ksrc + (long)(t) * KVBLK * KP, (unsigned)__builtin_amdgcn_readfirstlane(kdst + (slot)))
#define DMA_V(t, slot) glds16(vsrc + (long)(t) * KVBLK * KP, (unsigned)__builtin_amdgcn_readfirstlane(vdst + (slot)))
    const int vb0 = (int)(lds0 + LDS_V) + ((lane >> 4) & 1) * 32 + (lane & 3) * 8 + (4 * hi + ((lane & 15) >> 2)) * 64;
    const char* Kbase = shm + LDS_K; bf16x8 kf[8];
    const lds_cptr shm3 = (lds_cptr)shm; const lds_cptr kp0 = shm3 + LDS_K + hi * 1024 + r32 * 16; const lds_cptr vp0 = shm3 + LDS_V + ((lane >> 4) & 1) * 32 + (lane & 3) * 8 + (4 * hi + ((lane & 15) >> 2)) * 64;
    const int NT = (q0 + QB) / KVBLK;
    u32x16 mA, mB;
#define MLOAD0(t) do { const unsigned* mp_ = mrow + (size_t)(t) * 64; \
        asm volatile("s_load_dwordx16 %0, %1, 0x0" : "=s"(mA) : "s"(mp_)); asm volatile("s_load_dwordx16 %0, %1, 0x40" : "=s"(mB) : "s"(mp_)); } while (0)
#define MLOAD1(t) do { const unsigned* mp_ = mrow + (size_t)(t) * 64; \
        asm volatile("s_load_dwordx16 %0, %1, 0x80" : "=s"(mA) : "s"(mp_)); asm volatile("s_load_dwordx16 %0, %1, 0xc0" : "=s"(mB) : "s"(mp_)); } while (0)
#define MPAIR(M, j) (((unsigned long long)(M)[2 * (j) + 1] << 32) | (unsigned long long)(M)[2 * (j)])
#define MAPPLY(P) do { asm volatile("s_waitcnt lgkmcnt(0)" : "+s"(mA), "+s"(mB)); const float NEG_ = -INFINITY; \
        _Pragma("unroll") for (int r = 0; r < 8; ++r) { P[r] = msel(P[r], NEG_, MPAIR(mA, r)); P[r + 8] = msel(P[r + 8], NEG_, MPAIR(mB, r)); } } while (0)
    DMA_K(0, 0); DMA_V(0, 0); DMA_K(1, SLOTB);
    MLOAD0(0);
    const lds_cptr qfp = shm3 + LDS_QF + wid * 4096 + lane * 16;
    { bf16x8 qr[4];
#pragma unroll
      for (int d0 = 0; d0 < 4; ++d0) qr[d0] = *reinterpret_cast<const bf16x8*>(&Qw[(long)r32 * QP + d0 * 16 + hi * 8]);
#pragma unroll
      for (int d0 = 0; d0 < 4; ++d0) *(LAS bf16x8*)(LAS char*)(qfp + d0 * 1024) = qr[d0]; }
#define QF(i) (*(const LAS bf16x8*)(qfp + (i) * 1024))
    float mhat = 0.f, l_reg = 0.f; f32x16 o[2]; o[0] = f32x16{}; o[1] = f32x16{}; f32x16 negm = f32x16{}; asm volatile("" : "+v"(negm));
    const int qrel = wid * QBLK + r32;
#define CMASK(P0, P1, t) do { int jb_ = (t) - (NT - 4); if (jb_ >= 0) cmask(P0, P1, jb_, qrel, hi); } while (0)
    bool resc = false;
#define START(P0, P1) do { const float rm = rowmax(P0, P1); resc = false; \
    { const float dl = rm; mhat = fadd_s(mhat, dl); \
      _Pragma("unroll") for (int r = 0; r < 16; ++r) { P0[r] = fsub_s(P0[r], dl); P1[r] = fsub_s(P1[r], dl); } \
      _Pragma("unroll") for (int r = 0; r < 16; ++r) negm[r] = -mhat; asm volatile("" : "+v"(negm)); } } while (0)
#define RESC() do { if (resc) { asm volatile("s_waitcnt lgkmcnt(0)" ::: "memory"); \
      _Pragma("unroll") for (int d_ = 0; d_ < 2; ++d_) _Pragma("unroll") for (int r = 0; r < 16; ++r) o[d_][r] *= wsf[crow(r, hi)]; } } while (0)
    f32x16 pA0, pA1, pB0, pB1;
    int sl_prev = 0, sl_cur = 0, sl_next = SLOTB;
#define ROT() do { sl_prev = sl_cur; sl_cur = sl_next; sl_next = (sl_next == (NSLOT - 1) * SLOTB) ? 0 : sl_next + SLOTB; } while (0)
    DMA_K(2, 2 * SLOTB);
    WAIT_BAR(3);
    qkt(pA0, pA1, Kbase, qfp, negm, r32, hi); asm volatile("s_nop 15\n\ts_nop 7" : "+v"(pA0), "+v"(pA1)); CMASK(pA0, pA1, 0);
    START(pA0, pA1);
    MAPPLY(pA0); MLOAD1(0); MAPPLY(pA1); MLOAD0(1);
    _Pragma("unroll") for (int r = 0; r < 16; ++r) { pA0[r] = __builtin_amdgcn_exp2f(pA0[r]); pA1[r] = __builtin_amdgcn_exp2f(pA1[r]); }
    WAIT_BAR(0);
    DMA_K(3, 0); DMA_V(1, SLOTB);
    ROT();
    kload8(kf, kp0 + sl_cur);
    WAIT_BAR(2);
    s16x4 vlo[8], vhi[8]; u32x4 pw0, pw1, pw2, pw3;
#define PKW(P, B) cvtpk_s(P[B], P[B + 1])
#define PAF(k) __builtin_bit_cast(bf16x8, pw##k)
#define VFR(i) (bf16x8){vlo[i][0], vlo[i][1], vlo[i][2], vlo[i][3], vhi[i][0], vhi[i][1], vhi[i][2], vhi[i][3]}
#define PIN(x) asm volatile("" : "+v"(x))
#define MX3(a, b, c) __builtin_fmaxf(__builtin_fmaxf((a), (b)), (c))
#define GAPA(MF, A0, A1, A2, A3, W0, W1, PW) do { MF; sacc += A0; sacc += A1; sacc += A2; sacc += A3; PIN(sacc); W0; W1; PIN(PW); SBAR(); } while (0)
#define EX(v) __builtin_amdgcn_exp2f(v)
#define GAPB(MF, X, B) do { MF; X[B] = EX(X[B]); X[B + 1] = EX(X[B + 1]); X[B + 2] = EX(X[B + 2]); X[B + 3] = EX(X[B + 3]); PIN(X); SBAR(); } while (0)
#define VRD(i) do { vlo[i] = vtr(vp_ + (((i) >> 2) * 4096 + ((i) & 3) * 1024)); vhi[i] = vtr(vp_ + (((i) >> 2) * 4096 + ((i) & 3) * 1024 + 512)); } while (0)
#define KRD(G, j) do { if (G) { kload2(kf, kp0 + sl_next, j); SBAR(); } } while (0)
#define STEP(C0, C1, P0, P1, t, GK, GV, GL, GM) do { SBAR(); \
    const lds_cptr vp_ = vp0 + sl_prev; \
    VRD(0); bf16x8 qa_ = QF(0), qb_ = QF(1); SBAR(); float sacc = (P0[0] + P0[1]); \
    GAPA(C0 = __builtin_amdgcn_mfma_f32_32x32x16_bf16(kf[0], qa_, negm, 0, 0, 0), P0[2], P0[3], P0[4], P0[5],     pw0[0] = PKW(P0, 0), pw0[1] = PKW(P0, 2), pw0); \
    VRD(4); SBAR(); GAPA(C1 = __builtin_amdgcn_mfma_f32_32x32x16_bf16(kf[1], qa_, negm, 0, 0, 0), P0[6], P0[7], P0[8], P0[9],     pw0[2] = PKW(P0, 4), pw0[3] = PKW(P0, 6), pw0); \
    VRD(1); qa_ = QF(2); SBAR(); GAPA(C0 = __builtin_amdgcn_mfma_f32_32x32x16_bf16(kf[2], qb_, C0, 0, 0, 0),   P0[10], P0[11], P0[12], P0[13], pw1[0] = PKW(P0, 8), pw1[1] = PKW(P0, 10), pw1); \
    VRD(5); SBAR(); GAPA(C1 = __builtin_amdgcn_mfma_f32_32x32x16_bf16(kf[3], qb_, C1, 0, 0, 0),   P0[14], P0[15], P1[0], P1[1],   pw1[2] = PKW(P0, 12), pw1[3] = PKW(P0, 14), pw1); \
    VRD(2); qb_ = QF(3); SBAR(); GAPA(C0 = __builtin_amdgcn_mfma_f32_32x32x16_bf16(kf[4], qa_, C0, 0, 0, 0),   P1[2], P1[3], P1[4], P1[5],     pw2[0] = PKW(P1, 0), pw2[1] = PKW(P1, 2), pw2); \
    VRD(6); SBAR(); GAPA(C1 = __builtin_amdgcn_mfma_f32_32x32x16_bf16(kf[5], qa_, C1, 0, 0, 0),   P1[6], P1[7], P1[8], P1[9],     pw2[2] = PKW(P1, 4), pw2[3] = PKW(P1, 6), pw2); \
    VRD(3); SBAR(); GAPA(C0 = __builtin_amdgcn_mfma_f32_32x32x16_bf16(kf[6], qb_, C0, 0, 0, 0),   P1[10], P1[11], P1[12], P1[13], pw3[0] = PKW(P1, 8), pw3[1] = PKW(P1, 10), pw3); \
    VRD(7); SBAR(); GAPA(C1 = __builtin_amdgcn_mfma_f32_32x32x16_bf16(kf[7], qb_, C1, 0, 0, 0),   P1[14], P1[15], 0.f, 0.f,       pw3[2] = PKW(P1, 12), pw3[3] = PKW(P1, 14), pw3); \
    l_reg += sacc; \
    if (GK) { DMA_K((t) + 3, sl_cur); } if (GV) { DMA_V((t) + 1, sl_next); } \
    CMASK(C0, C1, t); \
    { float a = MX3(C0[0], C0[1], C1[0]), b = MX3(C0[2], C0[3], C1[1]); a = MX3(a, C1[2], C1[3]); \
      _Pragma("unroll") for (int r = 4; r < 16; r += 4) { a = MX3(a, C0[r], C0[r + 1]); b = MX3(b, C0[r + 2], C0[r + 3]); a = MX3(a, C1[r], C1[r + 1]); b = MX3(b, C1[r + 2], C1[r + 3]); } \
      float rm = __builtin_fmaxf(a, b); { auto rr = __builtin_amdgcn_permlane32_swap(__float_as_uint(rm), __float_as_uint(rm), false, false); rm = __builtin_fmaxf(__uint_as_float(rr[0]), __uint_as_float(rr[1])); } \
      resc = false; \
      if (__builtin_expect(__any(rm > (float)THRL), 0)) { const float dl = __builtin_fmaxf(rm, 0.f); mhat += dl; \
        _Pragma("unroll") for (int r = 0; r < 16; ++r) { C0[r] -= dl; C1[r] -= dl; } \
        _Pragma("unroll") for (int r = 0; r < 16; ++r) negm[r] = -mhat; asm volatile("" : "+v"(negm)); \
        const float f = __builtin_amdgcn_exp2f(-dl); l_reg *= f; if (hi == 0) wsf[r32] = f; resc = true; } } \
    MAPPLY(C0); MLOAD1(t); \
    SBAR(); \
    GAPB(o[0] = __builtin_amdgcn_mfma_f32_32x32x16_bf16(PAF(0), VFR(0), o[0], 0, 0, 0), C0, 0); \
    GAPB(o[1] = __builtin_amdgcn_mfma_f32_32x32x16_bf16(PAF(0), VFR(4), o[1], 0, 0, 0), C0, 4); \
    KRD(GL, 0); GAPB(o[0] = __builtin_amdgcn_mfma_f32_32x32x16_bf16(PAF(1), VFR(1), o[0], 0, 0, 0), C0, 8); \
    KRD(GL, 1); GAPB(o[1] = __builtin_amdgcn_mfma_f32_32x32x16_bf16(PAF(1), VFR(5), o[1], 0, 0, 0), C0, 12); \
    MAPPLY(C1); if (GM) { MLOAD0((t) + 1); } SBAR(); \
    KRD(GL, 2); GAPB(o[0] = __builtin_amdgcn_mfma_f32_32x32x16_bf16(PAF(2), VFR(2), o[0], 0, 0, 0), C1, 0); \
    KRD(GL, 3); GAPB(o[1] = __builtin_amdgcn_mfma_f32_32x32x16_bf16(PAF(2), VFR(6), o[1], 0, 0, 0), C1, 4); \
    GAPB(o[0] = __builtin_amdgcn_mfma_f32_32x32x16_bf16(PAF(3), VFR(3), o[0], 0, 0, 0), C1, 8); \
    GAPB(o[1] = __builtin_amdgcn_mfma_f32_32x32x16_bf16(PAF(3), VFR(7), o[1], 0, 0, 0), C1, 12); \
    } while (0)
    int t = 1;
#undef CMASK
#define CMASK(P0, P1, t) do { } while (0)
    for (; t + 5 < NT; t += 2) {
        STEP(pB0, pB1, pA0, pA1, t, true, true, true, true);     WAIT_BAR(2); RESC(); ROT();
        STEP(pA0, pA1, pB0, pB1, t + 1, true, true, true, true); WAIT_BAR(2); RESC(); ROT();
    }
#undef CMASK
#define CMASK(P0, P1, t) do { int jb_ = (t) - (NT - 4); if (jb_ >= 0) cmask(P0, P1, jb_, qrel, hi); } while (0)
#define ENDW(tt) do { if ((tt) + 3 < NT) { WAIT_BAR(2); } else if ((tt) + 2 < NT) { WAIT_BAR(1); } else { WAIT_BAR(0); } } while (0)
    for (; t + 1 < NT; t += 2) {
        STEP(pB0, pB1, pA0, pA1, t, (t + 3 < NT), (t + 1 < NT), (t + 1 < NT), (t + 1 < NT));         ENDW(t);     RESC(); ROT();
        STEP(pA0, pA1, pB0, pB1, t + 1, (t + 4 < NT), (t + 2 < NT), (t + 2 < NT), (t + 2 < NT));     ENDW(t + 1); RESC(); ROT();
    }
    STEP(pB0, pB1, pA0, pA1, NT - 1, false, false, false, false); RESC();
    { float sacc = pB0[0] + pB0[1]; _Pragma("unroll") for (int r = 2; r < 16; ++r) sacc += pB0[r]; _Pragma("unroll") for (int r = 0; r < 16; ++r) sacc += pB1[r]; l_reg += sacc;
      pw0 = (u32x4){PKW(pB0, 0), PKW(pB0, 2), PKW(pB0, 4), PKW(pB0, 6)}; pw1 = (u32x4){PKW(pB0, 8), PKW(pB0, 10), PKW(pB0, 12), PKW(pB0, 14)}; pw2 = (u32x4){PKW(pB1, 0), PKW(pB1, 2), PKW(pB1, 4), PKW(pB1, 6)}; pw3 = (u32x4){PKW(pB1, 8), PKW(pB1, 10), PKW(pB1, 12), PKW(pB1, 14)};
      SBAR(); pv(o, vb0 + sl_cur, PAF(0), PAF(1), PAF(2), PAF(3)); }
#undef PKW
#undef PAF
#undef VFR
#undef PIN
#undef MX3
#undef GAPA
#undef GAPB
#undef EX
#undef VRD
#undef KRD
#undef STEP
#undef ENDW
    { auto rr = __builtin_amdgcn_permlane32_swap(__float_as_uint(l_reg), __float_as_uint(l_reg), false, false); l_reg = __uint_as_float(rr[0]) + __uint_as_float(rr[1]); }
    if (hi == 0) wsf[32 + r32] = l_reg; asm volatile("s_waitcnt lgkmcnt(0)" ::: "memory");
    float rli[16];
#pragma unroll
    for (int r = 0; r < 16; ++r) rli[r] = __builtin_amdgcn_rcpf(wsf[32 + crow(r, hi)]);
    bf16* Ow = O + (rowbase + q0 + wid * QBLK) * OP + OCOL + h * D;
    { bf16* stg = (bf16*)(shm + LDS_OST) + wid * 2048;
#pragma unroll
      for (int r = 0; r < 16; ++r) { const int orow = crow(r, hi);
#pragma unroll
        for (int d0 = 0; d0 < 2; ++d0) stg[orow * 64 + d0 * 32 + r32] = __float2bfloat16(o[d0][r] * rli[r]); }
      asm volatile("s_waitcnt lgkmcnt(0)" ::: "memory");
#pragma unroll
      for (int i = 0; i < 4; ++i) { const int row = i * 8 + (lane >> 3), ch = lane & 7; const u32x4 v = *(const u32x4*)(stg + row * 64 + ch * 8); ATTN_STORE16(Ow + (long)row * OP + ch * 8, v); } }
    asm volatile("s_waitcnt lgkmcnt(0)\n\ts_barrier" ::: "memory");
#undef DMA_K
#undef DMA_V
#undef CMASK
#undef START
#undef RESC
#undef ROT
#undef MLOAD0
#undef MLOAD1
#undef MPAIR
#undef QF
#undef MAPPLY
}
#undef SBAR
#undef WAIT_BAR
}

#define XB_TMO      128
#define XB_XCNT(j)  (256  + 64 * (j))
#define XB_XSUB(j)  (1280 + 64 * (j))
#define XB_XGEN(j)  (2304 + 64 * (j))
#define XB_TOP      3328
#define XB_TOPGEN   3392
#define XCD_BAR_WORDS 3456
#define XB_SPIN_CAP (1u << 18)
__device__ __forceinline__ unsigned xb_ld(unsigned* p)              { return __hip_atomic_load(p, __ATOMIC_RELAXED, __HIP_MEMORY_SCOPE_AGENT); }
__device__ __forceinline__ unsigned xb_add(unsigned* p, unsigned v) { return __hip_atomic_fetch_add(p, v, __ATOMIC_RELAXED, __HIP_MEMORY_SCOPE_AGENT); }
__device__ __forceinline__ unsigned xb_xcc_id() { return (unsigned)__builtin_amdgcn_s_getreg((3 << 11) | 20) & 0xFu; }
#define XB_SPIN(cond, bar) do { unsigned _sp = 0; while (cond) { __builtin_amdgcn_s_sleep(1); \
    if ((++_sp & 255u) == 0u) { if (xb_ld(&(bar)[XB_TMO])) break; if (_sp > XB_SPIN_CAP) { atomicAdd(&(bar)[XB_TMO], 1u); break; } } } } while (0)
struct XcdBarrier { unsigned* bar; unsigned x; volatile LAS unsigned* st; };
__device__ __forceinline__ XcdBarrier xcd_barrier_post(unsigned* bar, volatile LAS unsigned* st) {
    XcdBarrier b; b.bar = bar; b.x = xb_xcc_id(); b.st = st;
    if (threadIdx.x == 0) (void)xb_add(&bar[XB_XCNT(b.x)], 1u);
    return b;
}
__device__ __forceinline__ void xcd_barrier_complete(unsigned* bar, unsigned x, unsigned& nloc, unsigned& nx) {
    const unsigned G = gridDim.x * gridDim.y * gridDim.z;
    unsigned sum, cnt, mine, sp = 0u;
    for (;;) {
        sum = 0u; cnt = 0u; mine = 0u;
#pragma unroll
        for (unsigned j = 0; j < 16; ++j) { const unsigned c = xb_ld(&bar[XB_XCNT(j)]); sum += c; cnt += (c > 0u) ? 1u : 0u; mine = (j == x) ? c : mine; }
        if (sum == G) break;
        __builtin_amdgcn_s_sleep(1);
        if ((++sp & 255u) == 0u) { if (xb_ld(&bar[XB_TMO])) break; if (sp > XB_SPIN_CAP) { atomicAdd(&bar[XB_TMO], 1u); break; } }
    }
    nloc = mine > 0u ? mine : 1u; nx = cnt > 0u ? cnt : 1u;
}
__device__ __forceinline__ void xcd_barrier(const XcdBarrier& b) {
    asm volatile("s_waitcnt vmcnt(0)" ::: "memory");
    __syncthreads();
    if (threadIdx.x == 0) {
        unsigned* bar = b.bar;
        __builtin_amdgcn_s_waitcnt(0);
        unsigned nloc = b.st[0], nx = b.st[1];
        if (nloc == 0u) { xcd_barrier_complete(bar, b.x, nloc, nx); b.st[0] = nloc; b.st[1] = nx; }
        const unsigned old = xb_add(&bar[XB_XSUB(b.x)], 1u);
        const unsigned gen = old / nloc;
        if (old + 1u == (gen + 1u) * nloc) {
            __builtin_amdgcn_fence(__ATOMIC_RELEASE, "agent");
            asm volatile("s_waitcnt vmcnt(0)" ::: "memory");
            const unsigned og = xb_add(&bar[XB_TOP], 1u);
            const unsigned tg = og / nx;
            if (og + 1u == (tg + 1u) * nx) xb_add(&bar[XB_TOPGEN], 1u);
            else XB_SPIN(xb_ld(&bar[XB_TOPGEN]) == tg, bar);
            __builtin_amdgcn_fence(__ATOMIC_ACQUIRE, "agent");
            xb_add(&bar[XB_XGEN(b.x)], 1u);
            asm volatile("s_waitcnt vmcnt(0)" ::: "memory");
        } else {
            XB_SPIN(xb_ld(&bar[XB_XGEN(b.x)]) == gen, bar);
            __builtin_amdgcn_fence(__ATOMIC_ACQUIRE, "agent");
            asm volatile("s_waitcnt vmcnt(0)" ::: "memory");
        }
    }
    __syncthreads();
}

struct Frame {
    LAS unsigned char* lds; volatile LAS unsigned* MISC; unsigned* ctl;
    int tid, lane, wave, vcu, G;
    unsigned char* ws;
};
struct Args { const float* in[18]; float* out; unsigned char* ws; int ph_lo, ph_hi, flags, pad; };
typedef const __attribute__((address_space(4))) Args* KArgs;
__device__ __forceinline__ KArgs kargs() { KArgs p = (KArgs)__builtin_amdgcn_kernarg_segment_ptr(); asm volatile("" : "+s"(p)); return p; }

__device__ __forceinline__ int ropeperm(int d) { return d < 8 ? 2 * d : (d < 16 ? 2 * (d - 8) + 1 : d); }
__device__ __forceinline__ int win_row(int c) {
    if (c < 512)  return (c & ~63) + ropeperm(c & 63);
    if (c < 640)  { const int cc = c - 512; return 512 + (cc & ~63) + ropeperm(cc & 63); }
    if (c < 768)  return c;
    if (c < 1280) { const int cc = c - 768; return 768 + (cc & ~63) + ropeperm(cc & 63); }
    if (c < 1344) return 1280 + ropeperm(c - 1280);
    if (c < 1352) return c;
    if (c < 1864) { const int ch = c - 1352; return 1536 + (ch >> 7) * 256 + (ch & 127); }
    if (c < 2376) return 2560 + (c - 1864);
    if (c < 2888) { const int ch = c - 2376; return 1536 + (ch >> 7) * 256 + 128 + (ch & 127); }
    { const int g = c - 2888, gi = g & 1023; return 3072 + (gi >> 7) * 256 + (g >> 10) * 128 + (gi & 127); }
}
struct TItem { const float* src; bf16_t* WT; int N, KT, rbase, mode, n0, k0, kd; };
__device__ __forceinline__ void t_load(const TItem& t, float (&rg)[32], int lane) {
    int nn = t.n0 + (lane & 31); if (nn >= t.N) nn = t.N - 1;
    const float* p = t.src + (size_t)(t.k0 + (lane >> 5)) * t.N + nn;
#pragma unroll
    for (int i = 0; i < 32; ++i) rg[i] = __builtin_nontemporal_load(p + (size_t)(2 * i) * t.N);
}
__device__ __forceinline__ void t_write(const TItem& t, const float (&rg)[32], LAS float* scr, int lane) {
#pragma unroll
    for (int i = 0; i < 32; ++i) scr[(2 * i + (lane >> 5)) * 33 + (lane & 31)] = rg[i];
    LDS_WAIT(); asm volatile("" ::: "memory");
    if (t.mode >= 3) {
        const int c4 = lane & 3;
#pragma unroll
        for (int j = 0; j < 2; ++j) { const int n = (lane >> 2) + 16 * j; const LAS float* sp = scr + (16 * c4) * 33 + n;
            if (t.n0 + n < t.N) { const int nn = t.n0 + n; const int row = t.mode == 3 ? t.rbase + (nn >> 7) * 256 + (nn & 127) : t.rbase + nn;
                u32x4 o;
#pragma unroll
                for (int q = 0; q < 4; ++q) { int wv = 0;
                    wv = __builtin_amdgcn_cvt_pk_fp8_f32(32.f * sp[(4 * q + 0) * 33], 32.f * sp[(4 * q + 1) * 33], wv, false);
                    wv = __builtin_amdgcn_cvt_pk_fp8_f32(32.f * sp[(4 * q + 2) * 33], 32.f * sp[(4 * q + 3) * 33], wv, true); o[q] = (unsigned)wv; }
                *(u32x4*)((unsigned char*)t.WT + (size_t)row * t.KT + t.k0 + 16 * c4) = o; } }
        LDS_WAIT(); asm volatile("" ::: "memory");
        return;
    }
    const int c = lane & 7;
#pragma unroll
    for (int j = 0; j < 4; ++j) { const int n = (lane >> 3) + 8 * j; const LAS float* sp = scr + (8 * c) * 33 + n;
        if (t.n0 + n < t.N) { const int nn = t.n0 + n; const int row = t.mode == 0 ? t.rbase + nn : (t.mode == 1 ? win_row(nn) : t.rbase + (nn >> 7) * 256 + (nn & 127));
            u32x4 o; o.x = pkbf(sp[0 * 33], sp[1 * 33]); o.y = pkbf(sp[2 * 33], sp[3 * 33]); o.z = pkbf(sp[4 * 33], sp[5 * 33]); o.w = pkbf(sp[6 * 33], sp[7 * 33]);
            *(u32x4*)(t.WT + (size_t)row * t.KT + t.kd + t.k0 + 8 * c) = o; } }
    LDS_WAIT(); asm volatile("" ::: "memory");
}
__device__ __forceinline__ void p0_prologue(Frame& F) {
    const KArgs ka = kargs();
    unsigned char* ws = F.ws;
    LAS float* scr = (LAS float*)(F.lds + F.wave * 16384);
    const int gw = F.vcu * NWAVES + F.wave, NGW = F.G * NWAVES;
    const int gt = F.vcu * 512 + F.tid, NGT = F.G * 512;
    bf16_t* Win = (bf16_t*)(ws + WS_WIN); bf16_t* Wau = (bf16_t*)(ws + WS_WAU); bf16_t* Wout = (bf16_t*)(ws + WS_WOUT);
    bf16_t* Wd = (bf16_t*)(ws + WS_WD); bf16_t* Wgu = (bf16_t*)(ws + WS_WGU);
    constexpr int I_IN = 16 * 155, I_AU = 8 * 32, I_OUT = 16 * 32, I_G = 32 * 16 * 16, I_D = 32 * 8 * 32;
    constexpr int NITEMS = I_IN + 2 * I_AU + I_OUT + 2 * I_G + I_D;
    const float *p_win = ka->in[1], *p_wau = ka->in[3], *p_wcu = ka->in[4], *p_wout = ka->in[6], *p_wg = ka->in[13], *p_wu = ka->in[14], *p_wd = ka->in[15];
#define T_DECODE(IT, T) do { int r_ = (IT); \
        if (r_ < I_IN) { T = TItem{p_win, Win, INW, 1024, 0, 1, 32 * (r_ % 155), 64 * (r_ / 155), 0}; } else { r_ -= I_IN; \
        if (r_ < I_AU) { T = TItem{p_wau, Wau, 1024, 1024, 0, 0, 32 * (r_ % 32), 64 * (r_ / 32), 512};     } else { r_ -= I_AU; \
        if (r_ < I_AU) { T = TItem{p_wcu, Wau, 1024, 1024, 0, 0, 32 * (r_ % 32), 64 * (r_ / 32), 0}; } else { r_ -= I_AU; \
        if (r_ < I_OUT) { T = TItem{p_wout, Wout, 1024, 1024, 0, 0, 32 * (r_ % 32), 64 * (r_ / 32), 0}; } else { r_ -= I_OUT; \
        if (r_ < I_G) { const int e_ = r_ >> 8, q_ = r_ & 255; T = TItem{p_wg + (size_t)e_ * 1024 * 512, Wgu, 512, 1024, e_ * 1024, 3, 32 * (q_ & 15), 64 * (q_ >> 4), 0}; } else { r_ -= I_G; \
        if (r_ < I_G) { const int e_ = r_ >> 8, q_ = r_ & 255; T = TItem{p_wu + (size_t)e_ * 1024 * 512, Wgu, 512, 1024, e_ * 1024 + 128, 3, 32 * (q_ & 15), 64 * (q_ >> 4), 0}; } else { r_ -= I_G; \
        { const int e_ = r_ >> 8, q_ = r_ & 255; T = TItem{p_wd + (size_t)e_ * 512 * 1024, Wd, 1024, 512, e_ * 1024, 4, 32 * (q_ & 31), 64 * (q_ >> 5), 0}; } } } } } } } } while (0)
    const int nitems = (F.G == 256) ? I_IN + 2 * I_AU + I_OUT : NITEMS;
    if (gw < nitems) {
        TItem cur, nxt; float rc[32], rn[32];
        T_DECODE(gw, cur); t_load(cur, rc, F.lane);
        for (int it = gw; it < nitems; it += NGW) {
            const int itn = (it + NGW < nitems) ? it + NGW : it;
            T_DECODE(itn, nxt); t_load(nxt, rn, F.lane);
            t_write(cur, rc, scr, F.lane);
            cur = nxt;
#pragma unroll
            for (int i = 0; i < 32; ++i) rc[i] = rn[i];
        }
    }
#undef T_DECODE
    for (int i = gt; i < 184 * 128; i += NGT) *(u32x4*)(Win + (size_t)1352 * 1024 + (size_t)i * 8) = (u32x4){0u, 0u, 0u, 0u};
    float* rope = (float*)(ws + WS_ROPE);
    for (int i = gt; i < SEQ * 8; i += NGT) { const int pos = i >> 3, j = i & 7;
        const float inv = (float)pow(500000.0, -(double)j / 8.0); const float ang = (float)pos * inv;
        rope[i] = cosf(ang); rope[SEQ * 8 + i] = sinf(ang); }
    { float* wc = (float*)(ws + WS_WC); const float* rgw = ka->in[9]; const float* rew = ka->in[11];
      for (int i = gt; i < 1024 * 48; i += NGT) { const int k = i / 48, c = i % 48;
          wc[i] = c < 4 ? rgw[k * 4 + c] : (c < 36 ? rew[(size_t)((c - 4) >> 3) * 1024 * 8 + k * 8 + ((c - 4) & 7)] : 0.f); } }
    const float* x = ka->in[0]; bf16_t* xb = (bf16_t*)(ws + WS_XB);
    for (size_t i = gt; i < (size_t)NTOK * DM / 8; i += (size_t)NGT * 4) {
        f32x4 va[4], vb[4];
#pragma unroll
        for (int q = 0; q < 4; ++q) { size_t ii = i + (size_t)q * NGT; if (ii >= (size_t)NTOK * DM / 8) ii = i; va[q] = __builtin_nontemporal_load((const f32x4*)(x + ii * 8)); vb[q] = __builtin_nontemporal_load((const f32x4*)(x + ii * 8 + 4)); }
#pragma unroll
        for (int q = 0; q < 4; ++q) { const size_t ii = i + (size_t)q * NGT; if (ii < (size_t)NTOK * DM / 8) store8bf(xb + ii * 8, va[q], vb[q]); } }
}

__device__ __forceinline__ int dpp_sum_i(int v) {
    v += __builtin_amdgcn_update_dpp(0, v, 0x111, 0xf, 0xf, true); v += __builtin_amdgcn_update_dpp(0, v, 0x112, 0xf, 0xf, true);
    v += __builtin_amdgcn_update_dpp(0, v, 0x114, 0xf, 0xf, true); v += __builtin_amdgcn_update_dpp(0, v, 0x118, 0xf, 0xf, true);
    return __builtin_amdgcn_readlane(v, 15) + __builtin_amdgcn_readlane(v, 31) + __builtin_amdgcn_readlane(v, 47) + __builtin_amdgcn_readlane(v, 63);
}
__device__ __forceinline__ float dpp_shr_f(float v, int ctrl_sel) {
    const int vi = __float_as_int(v);
    return __int_as_float(ctrl_sel == 1 ? __builtin_amdgcn_update_dpp(vi, vi, 0x111, 0xf, 0xf, false) : ctrl_sel == 2 ? __builtin_amdgcn_update_dpp(vi, vi, 0x112, 0xf, 0xf, false)
                        : ctrl_sel == 4 ? __builtin_amdgcn_update_dpp(vi, vi, 0x114, 0xf, 0xf, false) : __builtin_amdgcn_update_dpp(vi, vi, 0x118, 0xf, 0xf, false));
}
__device__ __forceinline__ float dpp_max_f(float v) {
    v = fmaxf(v, dpp_shr_f(v, 1)); v = fmaxf(v, dpp_shr_f(v, 2)); v = fmaxf(v, dpp_shr_f(v, 4)); v = fmaxf(v, dpp_shr_f(v, 8));
    const float a = __int_as_float(__builtin_amdgcn_readlane(__float_as_int(v), 15)), b = __int_as_float(__builtin_amdgcn_readlane(__float_as_int(v), 31));
    const float c = __int_as_float(__builtin_amdgcn_readlane(__float_as_int(v), 47)), d = __int_as_float(__builtin_amdgcn_readlane(__float_as_int(v), 63));
    return fmaxf(fmaxf(a, b), fmaxf(c, d));
}
__device__ __forceinline__ float dpp_min_f(float v) { return -dpp_max_f(-v); }
__device__ __forceinline__ float dpp_sum_f(float v) {
    v += __int_as_float(__builtin_amdgcn_update_dpp(0, __float_as_int(v), 0x111, 0xf, 0xf, true)); v += __int_as_float(__builtin_amdgcn_update_dpp(0, __float_as_int(v), 0x112, 0xf, 0xf, true));
    v += __int_as_float(__builtin_amdgcn_update_dpp(0, __float_as_int(v), 0x114, 0xf, 0xf, true)); v += __int_as_float(__builtin_amdgcn_update_dpp(0, __float_as_int(v), 0x118, 0xf, 0xf, true));
    const float a = __int_as_float(__builtin_amdgcn_readlane(__float_as_int(v), 15)), b = __int_as_float(__builtin_amdgcn_readlane(__float_as_int(v), 31));
    const float c = __int_as_float(__builtin_amdgcn_readlane(__float_as_int(v), 47)), d = __int_as_float(__builtin_amdgcn_readlane(__float_as_int(v), 63));
    return (a + b) + (c + d);
}
template <int NC>
__device__ __forceinline__ void select_token(const LAS float* srow, int t, int lane, unsigned tbit, LAS unsigned* maskw) {
    if (t < 256) {
#pragma unroll
        for (int c = 0; c < (NC < 4 ? NC : 4); ++c) if (64 * c + lane <= t) (void)__hip_atomic_fetch_or(maskw + 64 * c + lane, tbit, __ATOMIC_RELAXED, __HIP_MEMORY_SCOPE_WORKGROUP);
        return;
    }
    float x[NC];
#pragma unroll
    for (int c = 0; c < NC; ++c) x[c] = srow[64 * c + lane];
#pragma unroll
    for (int c = 4; c < NC; ++c) if (64 * c + 63 > t) x[c] = (64 * c + lane <= t) ? x[c] : -INFINITY;
    float mn = fminf(fminf(x[0], x[1]), fminf(x[2], x[3])), mx = -INFINITY;
#pragma unroll
    for (int c = 0; c < NC; ++c) mx = fmaxf(mx, x[c]);
    mn = dpp_min_f(mn);
    float lo = mn - (fabsf(mn) * 1e-6f + 1e-30f), hi = dpp_max_f(mx);
    const float BIGF = 0x1p100f;
#define COUNT_GT(P, OUT) do { const float nb1_ = -(P) * BIGF; const f32x2 nb_ = {nb1_, nb1_}, bg_ = {BIGF, BIGF}; f32x2 a0_ = {0.f, 0.f}, a1_ = {0.f, 0.f}, a2_ = {0.f, 0.f}, a3_ = {0.f, 0.f}; \
        _Pragma("unroll") for (int c = 0; c < NC; c += 8) { f32x2 y_[4]; \
            _Pragma("unroll") for (int e = 0; e < 4; ++e) { const f32x2 xx_ = {x[c + 2 * e], x[c + 2 * e + 1]}; asm("v_pk_fma_f32 %0, %1, %2, %3 clamp" : "=v"(y_[e]) : "v"(xx_), "v"(bg_), "v"(nb_)); } \
            a0_ += y_[0]; a1_ += y_[1]; a2_ += y_[2]; a3_ += y_[3]; } \
        const f32x2 s2_ = (a0_ + a1_) + (a2_ + a3_); OUT = (int)(dpp_sum_f(s2_[0] + s2_[1]) + 0.5f); } while (0)
    float tau = hi; int need = 256; bool exact = false;
#ifndef PROBE_SEL
#define PROBE_SEL 0
#endif
    {
        float glo = (float)(t + 1) - 255.5f, ghi = -255.5f; int side = 0;
        for (int it = 0; it < 200; ++it) {
            float p = lo + (hi - lo) * (glo * __builtin_amdgcn_rcpf(glo - ghi));
            if (it >= 48 || !(p > lo) || !(p < hi)) p = lo + (hi - lo) * 0.5f;
            if (!(p > lo) || !(p < hi)) break;
            int cm; COUNT_GT(p, cm);
            if (cm == 256) { tau = p; exact = true; break; }
            if (cm > 256) { lo = p; glo = (float)cm - 255.5f; if (side < 0) ghi *= 0.5f; side = -1; }
            else { hi = p; ghi = (float)cm - 255.5f; if (side > 0) glo *= 0.5f; side = 1; }
        }
        if (!exact) { tau = hi; int g; COUNT_GT(hi, g); need = 256 - g; }
    }
#undef COUNT_GT
    if (exact) {
#pragma unroll
        for (int c = 0; c < NC; ++c) (void)__hip_atomic_fetch_or(maskw + 64 * c + lane, (x[c] > tau) ? tbit : 0u, __ATOMIC_RELAXED, __HIP_MEMORY_SCOPE_WORKGROUP);
    } else {
        int base = 0;
#pragma unroll
        for (int c = 0; c < NC; ++c) {
            const bool gt = x[c] > tau, eq = x[c] == tau;
            const unsigned long long tb = __ballot(eq);
            const int rank = base + (int)__builtin_amdgcn_mbcnt_hi((unsigned)(tb >> 32), __builtin_amdgcn_mbcnt_lo((unsigned)tb, 0u));
            base += __popcll(tb);
            if (gt || (eq && rank < need)) (void)__hip_atomic_fetch_or(maskw + 64 * c + lane, tbit, __ATOMIC_RELAXED, __HIP_MEMORY_SCOPE_WORKGROUP);
        }
    }
}
struct XItem { const float* src; unsigned char* dst; int N; };
__device__ __forceinline__ XItem x_decode(int id, int lane, const float* wg, const float* wu, const float* wd, unsigned char* Wgu8, unsigned char* Wd8) {
    const int m = id >> 13, r = id & 8191, e = r >> 8, q = r & 255; XItem t;
    if (m < 2) { const int kb = q >> 3, nb = q & 7, n = nb * 64 + lane;
        t.src = (m == 0 ? wg : wu) + (size_t)e * 1024 * 512 + (size_t)(kb * 32) * 512 + nb * 64; t.N = 512;
        t.dst = Wgu8 + (size_t)(e * 1024 + (n >> 7) * 256 + m * 128 + (n & 127)) * 1024 + kb * 32; }
    else { const int kb = q >> 4, nb = q & 15, n = nb * 64 + lane;
        t.src = wd + (size_t)e * 512 * 1024 + (size_t)(kb * 32) * 1024 + nb * 64; t.N = 1024;
        t.dst = Wd8 + (size_t)(e * 1024 + n) * 512 + kb * 32; }
    return t;
}
__device__ __forceinline__ void x_load(const XItem& t, float (&rg)[32], int lane) {
    unsigned voff = (unsigned)lane * 4u; const unsigned stride = (unsigned)t.N * 4u; const float* base = t.src;
#define XL_(i) "global_load_dword %" #i ", %16, %17 nt\n\tv_add_u32_e32 %16, %18, %16\n\t"
#define XL16_ XL_(0) XL_(1) XL_(2) XL_(3) XL_(4) XL_(5) XL_(6) XL_(7) XL_(8) XL_(9) XL_(10) XL_(11) XL_(12) XL_(13) XL_(14) XL_(15)
    asm volatile(XL16_ : "=&v"(rg[0]), "=&v"(rg[1]), "=&v"(rg[2]), "=&v"(rg[3]), "=&v"(rg[4]), "=&v"(rg[5]), "=&v"(rg[6]), "=&v"(rg[7]), "=&v"(rg[8]), "=&v"(rg[9]), "=&v"(rg[10]), "=&v"(rg[11]), "=&v"(rg[12]), "=&v"(rg[13]), "=&v"(rg[14]), "=&v"(rg[15]), "+v"(voff) : "s"(base), "s"(stride));
    asm volatile(XL16_ : "=&v"(rg[16]), "=&v"(rg[17]), "=&v"(rg[18]), "=&v"(rg[19]), "=&v"(rg[20]), "=&v"(rg[21]), "=&v"(rg[22]), "=&v"(rg[23]), "=&v"(rg[24]), "=&v"(rg[25]), "=&v"(rg[26]), "=&v"(rg[27]), "=&v"(rg[28]), "=&v"(rg[29]), "=&v"(rg[30]), "=&v"(rg[31]), "+v"(voff) : "s"(base), "s"(stride));
#undef XL16_
#undef XL_
}
__device__ __forceinline__ void x_store(const XItem& t, float (&rg)[32]) {
    asm volatile("s_waitcnt vmcnt(0)" ::: "memory");
#pragma unroll
    for (int i = 0; i < 32; ++i) asm volatile("" : "+v"(rg[i]));
    u32x4 o0, o1;
#pragma unroll
    for (int q = 0; q < 4; ++q) { int w0 = 0, w1 = 0;
        w0 = __builtin_amdgcn_cvt_pk_fp8_f32(32.f * rg[4 * q], 32.f * rg[4 * q + 1], w0, false); w0 = __builtin_amdgcn_cvt_pk_fp8_f32(32.f * rg[4 * q + 2], 32.f * rg[4 * q + 3], w0, true);
        w1 = __builtin_amdgcn_cvt_pk_fp8_f32(32.f * rg[16 + 4 * q], 32.f * rg[16 + 4 * q + 1], w1, false); w1 = __builtin_amdgcn_cvt_pk_fp8_f32(32.f * rg[16 + 4 * q + 2], 32.f * rg[16 + 4 * q + 3], w1, true);
        o0[q] = (unsigned)w0; o1[q] = (unsigned)w1; }
    *(u32x4*)t.dst = o0; *(u32x4*)(t.dst + 16) = o1;
}
struct P2Carry { bf16x8 bfA[4]; float w; };
#define KI_LD4(DST, KBU, KLO, KN) do { const char* ks_ = (KBU) + (size_t)(KN) * 32768; asm volatile("" : "+s"(ks_)); \
            _Pragma("unroll") for (int kk = 0; kk < 4; ++kk) DST[kk] = *(const GAS bf16x8*)((const GAS char*)ks_ + (KLO) + 1024 * kk); } while (0)
__device__ __forceinline__ void p2_request(Frame& F, int b, int qt16, const bf16_t* qi, const bf16_t* ki, const float* wi, P2Carry& C) {
    const int lane = F.lane, wid = F.wave, r = lane & 31, h = lane >> 5;
    const int T0 = qt16 * 16; const size_t rowb = (size_t)b * SEQ;
    const int tk = (r >> 4) + 2 * ((r >> 2) & 1), hd = (r & 3) + 4 * ((r >> 3) & 1);
    const char* kbu = (const char*)(ki + (rowb >> 5) * 2048 + (size_t)wid * 2048); const unsigned klo = (unsigned)(r * 16 + h * 8) * 2u;
    asm volatile("global_load_dwordx4 %0, %4, %5\n\tglobal_load_dwordx4 %1, %4, %5 offset:1024\n\tglobal_load_dwordx4 %2, %4, %5 offset:2048\n\tglobal_load_dwordx4 %3, %4, %5 offset:3072"
                 : "=&v"(C.bfA[0]), "=&v"(C.bfA[1]), "=&v"(C.bfA[2]), "=&v"(C.bfA[3]) : "v"(klo), "s"(kbu));
    { const bf16_t* qp = qi + (rowb + T0 + tk) * 512 + hd * 64 + 8 * h;
#pragma unroll
      for (int jj = 0; jj < 2; ++jj) { const int j = 2 * wid + jj, rb = j >> 2, kk = j & 3;
          attn_body::glds16(qp + rb * 2048 + 16 * kk, (unsigned)__builtin_amdgcn_readfirstlane((int)(unsigned)(size_t)(F.lds + QIF_OFF + j * 1024))); } }
    { const float* wb = wi + (rowb + T0) * 8; const unsigned wo = (unsigned)(F.tid & 127) * 4u;
      asm volatile("global_load_dword %0, %1, %2" : "=&v"(C.w) : "v"(wo), "s"(wb)); }
}
__device__ __forceinline__ void p2_pin(P2Carry& C) { asm volatile("" : "+v"(C.bfA[0]), "+v"(C.bfA[1]), "+v"(C.bfA[2]), "+v"(C.bfA[3]), "+v"(C.w)); }
__device__ __forceinline__ void p2_wtab(Frame& F, P2Carry& C) {
    if (F.tid < 128) ((LAS float*)(F.lds + TAB_OFF + 8192))[F.tid] = C.w * WSCALE;
}
__device__ __forceinline__ void score_select_unit(Frame& F, int b, int qt16, int nb, int nqt16, P2Carry& C, const bf16_t* qi, const bf16_t* ki, const float* wi, LAS float* scl, LAS unsigned* maskw, unsigned* masks, int xid0, int xid1) {
    const int lane = F.lane, wid = F.wave, r = lane & 31, h = lane >> 5;
    const int T0 = qt16 * 16; const size_t rowb = (size_t)b * SEQ;
    XItem xa, xb; float xr0[32], xr1[32];
    { const KArgs ka = kargs(); unsigned char* w8a = F.ws + WS_WGU; unsigned char* w8b = F.ws + WS_WD;
      xa = x_decode(xid0 >= 0 ? xid0 : 0, lane, ka->in[13], ka->in[14], ka->in[15], w8a, w8b); xb = x_decode(xid1 >= 0 ? xid1 : 0, lane, ka->in[13], ka->in[14], ka->in[15], w8a, w8b); }
    {
        const LAS float* wtab = (const LAS float*)(F.lds + TAB_OFF + 8192);
        bf16x8 a[4][4]; bf16x8 (&bfA)[4] = C.bfA; bf16x8 bfB[4];
#pragma unroll
        for (int rb = 0; rb < 4; ++rb)
#pragma unroll
            for (int kk = 0; kk < 4; ++kk) a[rb][kk] = *(const LAS bf16x8*)(F.lds + QIF_OFF + (rb * 4 + kk) * 1024 + lane * 16);
        const int nsteps = ((T0 + 15) >> 8) + 1, kb0 = 32 * wid;
        const char* kbu = (const char*)(ki + (rowb >> 5) * 2048 + (size_t)wid * 2048);
        const unsigned klo = (unsigned)(r * 16 + h * 8) * 2u;
        const LAS float* wl = wtab + 16 * h;
#define SCORE_STEP(KS, BF) do { const int kb_ = 256 * (KS) + kb0; if (kb_ <= T0 + 15) { \
            _Pragma("unroll") for (int rb = 0; rb < 4; ++rb) { \
                f32x16 acc = f32x16{}; \
                _Pragma("unroll") for (int kk = 0; kk < 4; ++kk) acc = __builtin_amdgcn_mfma_f32_32x32x16_bf16(a[rb][kk], BF[kk], acc, 0, 0, 0); \
                const f32x4 w0_ = *(const LAS f32x4*)(wl + 32 * rb), w1_ = *(const LAS f32x4*)(wl + 32 * rb + 4), w2_ = *(const LAS f32x4*)(wl + 32 * rb + 8), w3_ = *(const LAS f32x4*)(wl + 32 * rb + 12); \
                float s0 = 0.f, s1 = 0.f; \
                _Pragma("unroll") for (int reg = 0; reg < 4; ++reg) {     \
                    const float y0_ = __int_as_float(max(__float_as_int(acc[reg]), 0)), y1_ = __int_as_float(max(__float_as_int(acc[reg + 4]), 0)); \
                    const float y2_ = __int_as_float(max(__float_as_int(acc[reg + 8]), 0)), y3_ = __int_as_float(max(__float_as_int(acc[reg + 12]), 0)); \
                    s0 += w0_[reg] * y0_; s0 += w1_[reg] * y1_; s1 += w2_[reg] * y2_; s1 += w3_[reg] * y3_; } \
                LAS float* sp = scl + (4 * rb + 2 * h) * 2048 + kb_ + r; \
                sp[0] = s0; sp[2048] = s1; } } } while (0)
        for (int ks = 0; ks < nsteps; ks += 2) {
            { const int kn = (ks + 1 < 8) ? ks + 1 : 7;
              KI_LD4(bfB, kbu, klo, kn); }
            SCORE_STEP(ks, bfA);
            if (ks + 2 < nsteps) KI_LD4(bfA, kbu, klo, ks + 2);
            if (ks + 1 < nsteps) SCORE_STEP(ks + 1, bfB);
        }
#undef SCORE_STEP
    }
    if (F.tid == 0) *(LAS int*)(F.lds + TAB_OFF + 8192 + 512) = 0;
    LDS_WAIT(); __syncthreads();
    p2_request(F, nb, nqt16, qi, ki, wi, C);
    if (xid0 >= 0) x_load(xa, xr0, lane);
    if (xid1 >= 0) x_load(xb, xr1, lane);
#ifndef PROBE_P2
#define PROBE_P2 0
#endif
    LAS int* tokctr = (LAS int*)(F.lds + TAB_OFF + 8192 + 512);
#pragma unroll 1
    for (;;) {
        int tl = 0; if (lane == 0) tl = __hip_atomic_fetch_add(tokctr, 1, __ATOMIC_RELAXED, __HIP_MEMORY_SCOPE_WORKGROUP);
        tl = __builtin_amdgcn_readfirstlane(tl);
        if (tl >= 16) break;
        const int t = T0 + tl, nch = (t >> 6) + 1;
        const unsigned tbit = 1u << tl; const LAS float* srow = scl + tl * 2048;
        if (nch <= 8) select_token<8>(srow, t, lane, tbit, maskw);
        else if (nch <= 16) select_token<16>(srow, t, lane, tbit, maskw);
        else if (nch <= 24) select_token<24>(srow, t, lane, tbit, maskw);
        else select_token<32>(srow, t, lane, tbit, maskw);
    }
    if (xid0 >= 0) x_store(xa, xr0);
    if (xid1 >= 0) x_store(xb, xr1);
    LDS_WAIT(); __syncthreads();
    {
        const int ktmax = (T0 + 15) >> 6; unsigned short* mbase = (unsigned short*)(masks + ((size_t)(b * (SEQ / 32) + (qt16 >> 1)) * (SEQ / 64)) * 64) + (qt16 & 1);
#pragma unroll
        for (int jj = 0; jj < 4; ++jj) { const int key = F.tid + 512 * jj, kt = key >> 6, kap = key & 63;
            const unsigned wv = maskw[key]; maskw[key] = 0u;
            if (kt <= ktmax) { const int half = kap >> 5, k5 = kap & 31, hi_ = (k5 >> 2) & 1, rr = (k5 & 3) + 4 * (k5 >> 3); mbase[2 * (kt * 64 + 32 * half + 2 * rr + hi_)] = (unsigned short)wv; } }
    }
    VM_WAIT(); p2_pin(C);
    p2_wtab(F, C);
    LDS_WAIT(); __syncthreads();
}
#undef KI_LD4
__device__ __forceinline__ void conv_pass(Frame& F, const bf16_t* u, const bf16_t* cb, const float* cw, bf16_t* conv) {
    const int gt = F.vcu * 512 + F.tid, NGT = F.G * 512;
    for (int idx = gt; idx < NTOK * 64; idx += NGT) {
        const int tok = idx >> 6, cg = (idx & 63) * 8, pos = tok & (SEQ - 1);
        const u32x4 z = (u32x4){0u, 0u, 0u, 0u};
        const u32x4 u0 = *(const u32x4*)(u + (size_t)tok * 512 + cg);
        const u32x4 u1 = pos >= 1 ? *(const u32x4*)(u + (size_t)(tok - 1) * 512 + cg) : z;
        const u32x4 u2 = pos >= 2 ? *(const u32x4*)(u + (size_t)(tok - 2) * 512 + cg) : z;
        const u32x4 bv = __builtin_nontemporal_load((const u32x4*)(cb + (size_t)tok * 512 + cg));
        const f32x4 w0a = *(const f32x4*)(cw + cg), w0b = *(const f32x4*)(cw + cg + 4);
        const f32x4 w1a = *(const f32x4*)(cw + 512 + cg), w1b = *(const f32x4*)(cw + 512 + cg + 4);
        const f32x4 w2a = *(const f32x4*)(cw + 1024 + cg), w2b = *(const f32x4*)(cw + 1024 + cg + 4);
        f32x4 ya, yb;
#define CV(E, WA, I, WORD, HALF) (WA[I] * (HALF ? bfhi(E.WORD) : bflo(E.WORD)))
        ya[0] = bflo(bv.x) * (CV(u2, w0a, 0, x, 0) + CV(u1, w1a, 0, x, 0) + CV(u0, w2a, 0, x, 0));
        ya[1] = bfhi(bv.x) * (CV(u2, w0a, 1, x, 1) + CV(u1, w1a, 1, x, 1) + CV(u0, w2a, 1, x, 1));
        ya[2] = bflo(bv.y) * (CV(u2, w0a, 2, y, 0) + CV(u1, w1a, 2, y, 0) + CV(u0, w2a, 2, y, 0));
        ya[3] = bfhi(bv.y) * (CV(u2, w0a, 3, y, 1) + CV(u1, w1a, 3, y, 1) + CV(u0, w2a, 3, y, 1));
        yb[0] = bflo(bv.z) * (CV(u2, w0b, 0, z, 0) + CV(u1, w1b, 0, z, 0) + CV(u0, w2b, 0, z, 0));
        yb[1] = bfhi(bv.z) * (CV(u2, w0b, 1, z, 1) + CV(u1, w1b, 1, z, 1) + CV(u0, w2b, 1, z, 1));
        yb[2] = bflo(bv.w) * (CV(u2, w0b, 2, w, 0) + CV(u1, w1b, 2, w, 0) + CV(u0, w2b, 2, w, 0));
        yb[3] = bfhi(bv.w) * (CV(u2, w0b, 3, w, 1) + CV(u1, w1b, 3, w, 1) + CV(u0, w2b, 3, w, 1));
#undef CV
        store8bf(conv + (size_t)tok * 1024 + cg, ya, yb);
    }
}

constexpr int P7_HS = 1032;
constexpr int P7_H = 0, P7_HL = 16 * P7_HS * 2, P7_P = 2 * 16 * P7_HS * 2, P7_L = P7_P + 8 * 16 * 48 * 4, P7_R = P7_L + 16 * 48 * 4, P7_END = P7_R + 6 * 128 * 4 + 2 * 32 * 4;
static_assert(P7_END <= RING_BYTES && (P7_P % 16) == 0, "P7 LDS map");
__device__ __forceinline__ void ln1_router(Frame& F, bool dry) {
    const KArgs a = kargs();
    unsigned char* ws = F.ws;
    const float* xin = a->in[0]; const bf16_t* mixb = (const bf16_t*)(ws + WS_MIX); bf16_t* h1b = dry ? (bf16_t*)(ws + WS_GATES) : (bf16_t*)(ws + WS_PRE);
    int* lists = (int*)(ws + (dry ? WS_MERGED : WS_LIST)); unsigned* tokinfo = (unsigned*)(ws + (dry ? WS_MERGED + 8 * MiB : WS_TOKINFO)); const int cbank = dry ? 64 * NEXP : 0;
    unsigned char* h1q = ws + (dry ? WS_MERGED + 16 * MiB : WS_H1Q);
    const float *g1 = a->in[7], *b1 = a->in[8], *rgb = a->in[10], *reb = a->in[12]; const float* wc = (const float*)(ws + WS_WC);
    const int lane = F.lane, wid = F.wave, tid = F.tid;
    LAS bf16_t* Hh = (LAS bf16_t*)(F.lds + P7_H); LAS bf16_t* Hl = (LAS bf16_t*)(F.lds + P7_HL); LAS float* P = (LAS float*)(F.lds + P7_P); LAS float* L = (LAS float*)(F.lds + P7_L);
    LAS int* RE = (LAS int*)(F.lds + P7_R);
    LAS int* hist = RE + 768; LAS int* basev = RE + 800;
    if (tid < 64) hist[tid] = 0;
    f32x4 gv[4], bv[4];
#pragma unroll
    for (int j = 0; j < 4; ++j) { gv[j] = *(const f32x4*)(g1 + 4 * lane + 256 * j); bv[j] = *(const f32x4*)(b1 + 4 * lane + 256 * j); }
    bf16x8 bhi[4][3], blo[4][3];
    { const int kq = lane >> 4, jn = lane & 15; const float* wp = wc + (size_t)(128 * wid + 8 * kq) * 48 + jn;
#pragma unroll
      for (int sidx = 0; sidx < 4; ++sidx)
#pragma unroll
          for (int cb = 0; cb < 3; ++cb) { u32x4 ph, pl;
#pragma unroll
              for (int jp = 0; jp < 4; ++jp) { const float w0 = wp[(size_t)(32 * sidx + 2 * jp) * 48 + 16 * cb], w1 = wp[(size_t)(32 * sidx + 2 * jp + 1) * 48 + 16 * cb];
                  const unsigned hh = pkbf(w0, w1); ph[jp] = hh; pl[jp] = pkbf(w0 - bflo(hh), w1 - bfhi(hh)); }
              bhi[sidx][cb] = __builtin_bit_cast(bf16x8, ph); blo[sidx][cb] = __builtin_bit_cast(bf16x8, pl); } }
    const int ngrp_total = NTOK / 16;
#pragma unroll 1
    for (int gi = F.vcu * 8; gi < ngrp_total; gi += F.G * 8) {
      f32x4 vn[2][4]; u32x2 mn[2][4];
#pragma unroll
      for (int rr = 0; rr < 2; ++rr)
#pragma unroll
          for (int j = 0; j < 4; ++j) { const size_t o_ = (size_t)(gi * 16 + 2 * wid + rr) * DM + 4 * lane + 256 * j; vn[rr][j] = __builtin_nontemporal_load((const f32x4*)(xin + o_)); mn[rr][j] = __builtin_nontemporal_load((const u32x2*)(mixb + o_)); }
#pragma unroll 1
      for (int gg = 0; gg < 8; ++gg) {
        const int row0 = (gi + gg) * 16;
#pragma unroll
        for (int rr = 0; rr < 2; ++rr) { const int rl = 2 * wid + rr, row = row0 + rl;
            f32x4 v[4]; float sm = 0.f;
#pragma unroll
            for (int j = 0; j < 4; ++j) { const u32x2 mw = mn[rr][j]; v[j] = vn[rr][j] * ALPHA + (f32x4){bflo(mw.x), bfhi(mw.x), bflo(mw.y), bfhi(mw.y)}; sm += (v[j][0] + v[j][1]) + (v[j][2] + v[j][3]); }
            const float mean = dpp_sum_f(sm) * (1.f / DM); float s2 = 0.f;
#pragma unroll
            for (int j = 0; j < 4; ++j) { v[j] = v[j] - mean; s2 += (v[j][0] * v[j][0] + v[j][1] * v[j][1]) + (v[j][2] * v[j][2] + v[j][3] * v[j][3]); }
            const float rstd = 1.f / sqrtf(dpp_sum_f(s2) * (1.f / DM) + LN_EPS);
#pragma unroll
            for (int j = 0; j < 4; ++j) { v[j] = v[j] * rstd * gv[j] + bv[j];
                u32x2 o; o.x = pkbf(v[j][0], v[j][1]); o.y = pkbf(v[j][2], v[j][3]); *(u32x2*)(h1b + (size_t)row * DM + 4 * lane + 256 * j) = o;
                { int wv = 0; wv = __builtin_amdgcn_cvt_pk_fp8_f32(v[j][0], v[j][1], wv, false); wv = __builtin_amdgcn_cvt_pk_fp8_f32(v[j][2], v[j][3], wv, true);
                  *(int*)(h1q + (size_t)row * 1024 + 4 * lane + 256 * j) = wv; }
                { const unsigned h01 = o.x, h23 = o.y;
                  *(LAS u32x2*)(Hh + rl * P7_HS + 4 * lane + 256 * j) = (u32x2){h01, h23};
                  *(LAS u32x2*)(Hl + rl * P7_HS + 4 * lane + 256 * j) = (u32x2){pkbf(v[j][0] - bflo(h01), v[j][1] - bfhi(h01)), pkbf(v[j][2] - bflo(h23), v[j][3] - bfhi(h23))}; } } }
        { const int gnx = gg < 7 ? gg + 1 : gg;
#pragma unroll
          for (int rr = 0; rr < 2; ++rr)
#pragma unroll
              for (int j = 0; j < 4; ++j) { const size_t o_ = (size_t)((gi + gnx) * 16 + 2 * wid + rr) * DM + 4 * lane + 256 * j; vn[rr][j] = __builtin_nontemporal_load((const f32x4*)(xin + o_)); mn[rr][j] = __builtin_nontemporal_load((const u32x2*)(mixb + o_)); } }
        LDS_WAIT(); __syncthreads();
        { f32x4 acc[3]; acc[0] = (f32x4){0.f, 0.f, 0.f, 0.f}; acc[1] = acc[0]; acc[2] = acc[0];
          const int hoff = (lane & 15) * P7_HS + 128 * wid + 8 * (lane >> 4);
#pragma unroll
          for (int sidx = 0; sidx < 4; ++sidx) { const bf16x8 ah = *(const LAS bf16x8*)(Hh + hoff + 32 * sidx), al = *(const LAS bf16x8*)(Hl + hoff + 32 * sidx);
#pragma unroll
              for (int cb = 0; cb < 3; ++cb) { acc[cb] = __builtin_amdgcn_mfma_f32_16x16x32_bf16(ah, bhi[sidx][cb], acc[cb], 0, 0, 0);
                  acc[cb] = __builtin_amdgcn_mfma_f32_16x16x32_bf16(ah, blo[sidx][cb], acc[cb], 0, 0, 0); acc[cb] = __builtin_amdgcn_mfma_f32_16x16x32_bf16(al, bhi[sidx][cb], acc[cb], 0, 0, 0); } }
          LAS float* pp = P + (wid * 16 + 4 * (lane >> 4)) * 48 + (lane & 15);
#pragma unroll
          for (int cb = 0; cb < 3; ++cb)
#pragma unroll
              for (int rg = 0; rg < 4; ++rg) pp[rg * 48 + 16 * cb] = acc[cb][rg]; }
        LDS_WAIT(); __syncthreads();
        for (int idx = tid; idx < 16 * 48; idx += 512) { float sum = 0.f;
#pragma unroll
            for (int w = 0; w < 8; ++w) sum += P[w * 768 + idx];
            L[idx] = sum; }
        LDS_WAIT(); __syncthreads();
        if (tid < 16) { const LAS float* lr = L + tid * 48;
            float gl[4]; int grp = 0;
#pragma unroll
            for (int i = 0; i < 4; ++i) gl[i] = lr[i] + rgb[i];
            float gm = gl[0];
#pragma unroll
            for (int i = 1; i < 4; ++i) if (gl[i] > gm) { gm = gl[i]; grp = i; }
            float den = 0.f;
#pragma unroll
            for (int i = 0; i < 4; ++i) den += __expf(gl[i] - gm);
            const float pgrp = 1.f / den;
            float el[8];
#pragma unroll
            for (int i = 0; i < 8; ++i) el[i] = lr[4 + 8 * grp + i] + reb[grp * 8 + i];
            int i1 = 0; float v1 = el[0];
#pragma unroll
            for (int i = 1; i < 8; ++i) if (el[i] > v1) { v1 = el[i]; i1 = i; }
            int i2 = -1; float v2 = -INFINITY;
#pragma unroll
            for (int i = 0; i < 8; ++i) if (i != i1 && el[i] > v2) { v2 = el[i]; i2 = i; }
            const float ex = __expf(v2 - v1), w1 = pgrp / (1.f + ex), w2 = pgrp * ex / (1.f + ex);
            const int e1 = grp * 8 + i1, e2 = grp * 8 + i2, ti = gg * 16 + tid;
            RE[ti] = e1; RE[128 + ti] = e2; RE[256 + ti] = (int)__float_as_uint(w1); RE[384 + ti] = (int)__float_as_uint(w2);
            RE[512 + ti] = __hip_atomic_fetch_add(hist + e1, 1, __ATOMIC_RELAXED, __HIP_MEMORY_SCOPE_WORKGROUP);
            RE[640 + ti] = __hip_atomic_fetch_add(hist + e2, 1, __ATOMIC_RELAXED, __HIP_MEMORY_SCOPE_WORKGROUP);
        }
      }
      LDS_WAIT(); __syncthreads();
      if (tid < NEXP) { const int hc = hist[tid]; basev[tid] = hc ? (int)__hip_atomic_fetch_add(F.ctl + CW_CNT + cbank + 64 * tid, (unsigned)hc, __ATOMIC_RELAXED, __HIP_MEMORY_SCOPE_AGENT) : 0; }
      LDS_WAIT(); __syncthreads();
      if (tid < 128) { const int row = gi * 16 + tid; const int e1 = RE[tid], e2 = RE[128 + tid];
          const unsigned r1 = (unsigned)(basev[e1] + RE[512 + tid]), r2 = (unsigned)(basev[e2] + RE[640 + tid]);
          if (r1 < (unsigned)LISTCAP) lists[(size_t)e1 * LISTCAP + r1] = row;
          if (r2 < (unsigned)LISTCAP) lists[(size_t)e2 * LISTCAP + r2] = row;
          unsigned* ti = tokinfo + (size_t)row * 8;
          *(u32x4*)ti = (u32x4){(unsigned)e1, r1, (unsigned)RE[256 + tid], (unsigned)e2}; *(u32x2*)(ti + 4) = (u32x2){r2, (unsigned)RE[384 + tid]}; }
      LDS_WAIT(); __syncthreads();
      if (tid < 64) hist[tid] = 0;
      LDS_WAIT(); __syncthreads();
    }
}
__device__ __forceinline__ void moe_tables(Frame& F) {
    LAS int* tab = (LAS int*)(F.lds + TAB_OFF);
    __syncthreads();
    if (F.tid < NEXP) { int c = (int)__hip_atomic_load(F.ctl + CW_CNT + 64 * F.tid, __ATOMIC_RELAXED, __HIP_MEMORY_SCOPE_AGENT); if (c > LISTCAP) c = LISTCAP; tab[T_CNT + F.tid] = c; }
    __syncthreads();
    if (F.tid == 0) { int acc = 0; for (int e = 0; e < NEXP; ++e) { tab[T_BLK0 + e] = acc; acc += (tab[T_CNT + e] + 255) >> 8; } tab[T_BLK0 + NEXP] = acc; tab[T_NB] = acc; }
    __syncthreads();
    if (F.tid < NEXP) { const int b0 = tab[T_BLK0 + F.tid], b1 = tab[T_BLK0 + F.tid + 1]; for (int bb = b0; bb < b1; ++bb) tab[T_BLKE + bb] = F.tid; }
    __syncthreads();
}

__device__ __forceinline__ void combine_ln2(Frame& F) {
    const KArgs a = kargs();
    unsigned char* ws = F.ws;
    const bf16_t* h1 = (const bf16_t*)(ws + WS_PRE); const unsigned char* ys = ws + WS_YS;     const unsigned* tokinfo = (const unsigned*)(ws + WS_TOKINFO);
    const LAS int* tab = (const LAS int*)(F.lds + TAB_OFF);
    const float *g2 = a->in[16], *b2 = a->in[17]; float* outp = a->out;
    const int lane = F.lane, gw = F.vcu * NWAVES + F.wave, NGW = F.G * NWAVES;
    f32x4 gv[4], bv[4];
#pragma unroll
    for (int j = 0; j < 4; ++j) { gv[j] = *(const f32x4*)(g2 + 4 * lane + 256 * j); bv[j] = *(const f32x4*)(b2 + 4 * lane + 256 * j); }
    const int nrw = (NTOK - gw + NGW - 1) / NGW;
    if (nrw > 0) {
#define ROWK(k) (gw + ((k) < nrw ? (k) : nrw - 1) * NGW)
#define TI_LOAD(k, A, B) do { const unsigned* ti_ = tokinfo + (size_t)ROWK(k) * 8; A = *(const u32x4*)ti_; B = *(const u32x2*)(ti_ + 4); } while (0)
#define DATA_LOAD(k, A, B, HW, YA, YB) do { const int e1_ = (int)A.x, e2_ = (int)A.w; \
        const size_t s1_ = (size_t)tab[T_BLK0 + e1_] * 256 + A.y, s2_ = (size_t)tab[T_BLK0 + e2_] * 256 + B.x; \
        const bf16_t* hr_ = h1 + (size_t)ROWK(k) * DM + 4 * lane; const unsigned char* y1_ = ys + s1_ * DM + 4 * lane; const unsigned char* y2_ = ys + s2_ * DM + 4 * lane; \
        _Pragma("unroll") for (int j = 0; j < 4; ++j) { HW[j] = __builtin_nontemporal_load((const u32x2*)(hr_ + 256 * j)); YA[j] = __builtin_nontemporal_load((const unsigned*)(y1_ + 256 * j)); YB[j] = __builtin_nontemporal_load((const unsigned*)(y2_ + 256 * j)); } } while (0)
        u32x4 tc0, tn0, tq0; u32x2 tc1, tn1, tq1;
        u32x2 hw[4], hwn[4]; unsigned ya[4], yb[4], yan[4], ybn[4];
        TI_LOAD(0, tc0, tc1); TI_LOAD(1, tn0, tn1);
        DATA_LOAD(0, tc0, tc1, hw, ya, yb);
        for (int k = 0; k < nrw; ++k) {
            TI_LOAD(k + 2, tq0, tq1);
            DATA_LOAD(k + 1, tn0, tn1, hwn, yan, ybn);
            const float w1 = __uint_as_float(tc0.z), w2 = __uint_as_float(tc1.y);
            f32x4 v[4]; float sm = 0.f;
#pragma unroll
            for (int j = 0; j < 4; ++j) {
                v[j][0] = ALPHA * bflo(hw[j].x) + w1 * __builtin_amdgcn_cvt_f32_fp8((int)ya[j], 0) + w2 * __builtin_amdgcn_cvt_f32_fp8((int)yb[j], 0);
                v[j][1] = ALPHA * bfhi(hw[j].x) + w1 * __builtin_amdgcn_cvt_f32_fp8((int)ya[j], 1) + w2 * __builtin_amdgcn_cvt_f32_fp8((int)yb[j], 1);
                v[j][2] = ALPHA * bflo(hw[j].y) + w1 * __builtin_amdgcn_cvt_f32_fp8((int)ya[j], 2) + w2 * __builtin_amdgcn_cvt_f32_fp8((int)yb[j], 2);
                v[j][3] = ALPHA * bfhi(hw[j].y) + w1 * __builtin_amdgcn_cvt_f32_fp8((int)ya[j], 3) + w2 * __builtin_amdgcn_cvt_f32_fp8((int)yb[j], 3);
                sm += (v[j][0] + v[j][1]) + (v[j][2] + v[j][3]); }
            const float mean = dpp_sum_f(sm) * (1.f / DM); float s2v = 0.f;
#pragma unroll
            for (int j = 0; j < 4; ++j) { v[j] = v[j] - mean; s2v += (v[j][0] * v[j][0] + v[j][1] * v[j][1]) + (v[j][2] * v[j][2] + v[j][3] * v[j][3]); }
            const float rstd = 1.f / sqrtf(dpp_sum_f(s2v) * (1.f / DM) + LN_EPS);
            float* orow = outp + (size_t)(gw + k * NGW) * DM + 4 * lane;
#pragma unroll
            for (int j = 0; j < 4; ++j) __builtin_nontemporal_store(v[j] * rstd * gv[j] + bv[j], (f32x4*)(orow + 256 * j));
            tc0 = tn0; tc1 = tn1; tn0 = tq0; tn1 = tq1;
#pragma unroll
            for (int j = 0; j < 4; ++j) { hw[j] = hwn[j]; ya[j] = yan[j]; yb[j] = ybn[j]; }
        }
#undef ROWK
#undef TI_LOAD
#undef DATA_LOAD
    }
}

#if DBG_NAIVE
constexpr size_t WS_NK = 296 * MiB, WS_NV = 312 * MiB, WS_NKI = 328 * MiB;
__device__ __forceinline__ float naive_proj(const float* xs  , const float* w_in, int col) {
    float s = 0.f; for (int d = 0; d < DM; ++d) s += xs[d] * w_in[(size_t)d * INW + col]; return s;
}
__device__ __forceinline__ void naive_kv(Frame& F) {
    const KArgs ka = kargs(); const float* xin = ka->in[0]; const float* win = ka->in[1];
    float* nk = (float*)(F.ws + WS_NK); float* nv = (float*)(F.ws + WS_NV); float* nki = (float*)(F.ws + WS_NKI);
    LAS float* xs = (LAS float*)F.lds; LAS float* pr = xs + 1024;
    for (int tok = F.vcu; tok < NTOK; tok += F.G) {
        __syncthreads();
        for (int i = F.tid; i < DM; i += 512) xs[i] = xin[(size_t)tok * DM + i];
        __syncthreads();
        if (F.tid < 320) { const int col = F.tid < 256 ? 512 + F.tid : 1280 + (F.tid - 256); float s = 0.f; for (int d = 0; d < DM; ++d) s += xs[d] * win[(size_t)d * INW + col]; pr[F.tid] = s; }
        __syncthreads();
        const int pos = tok & (SEQ - 1);
        if (F.tid < 24) {
            const int grp = F.tid >> 3, i = F.tid & 7, base = grp == 0 ? 0 : (grp == 1 ? 64 : 256);
            const float inv = (float)pow(500000.0, -(double)i / 8.0); const float ang = (float)pos * inv, c = cosf(ang), s = sinf(ang);
            const float x1 = pr[base + i], x2 = pr[base + 8 + i]; pr[base + i] = x1 * c - x2 * s; pr[base + 8 + i] = x2 * c + x1 * s;
        }
        __syncthreads();
        if (F.tid < 128) { nk[(size_t)tok * 128 + F.tid] = pr[F.tid]; nv[(size_t)tok * 128 + F.tid] = pr[128 + F.tid]; }
        if (F.tid < 64) nki[(size_t)tok * 64 + F.tid] = pr[256 + F.tid];
    }
}
__device__ __forceinline__ void naive_attn(Frame& F) {
    const KArgs ka = kargs(); const float* xin = ka->in[0]; const float* win = ka->in[1];
    const float* nk = (const float*)(F.ws + WS_NK); const float* nv = (const float*)(F.ws + WS_NV); const float* nki = (const float*)(F.ws + WS_NKI);
    bf16_t* attn = (bf16_t*)(F.ws + WS_AC) + 512;
    LAS float* xs = (LAS float*)F.lds;
    LAS float* qs = xs + 1024;
    LAS float* qis = qs + 512;
    LAS float* wis = qis + 512;
    LAS float* sc = wis + 16;
    LAS int* sel = (LAS int*)(sc + 2048);
    LAS int* nsel = sel + 256;
    LAS float* pl = (LAS float*)(nsel + 16);
    for (int tok = F.vcu; tok < NTOK; tok += F.G) {
        const int pos = tok & (SEQ - 1), b0 = tok - pos;
        __syncthreads();
        for (int i = F.tid; i < DM; i += 512) xs[i] = xin[(size_t)tok * DM + i];
        if (F.tid == 0) nsel[0] = 0;
        __syncthreads();
        for (int c = F.tid; c < 1032; c += 512) { const int col = c < 512 ? c : (c < 1024 ? 768 + (c - 512) : 1344 + (c - 1024));
            float s = 0.f; for (int d = 0; d < DM; ++d) s += xs[d] * win[(size_t)d * INW + col];
            if (c < 512) qs[c] = s; else if (c < 1024) qis[c - 512] = s; else wis[c - 1024] = s; }
        __syncthreads();
        if (F.tid < 128) { const int which = F.tid >> 6, hd = (F.tid >> 3) & 7, i = F.tid & 7; LAS float* p = (which ? qis : qs) + hd * 64;
            const float inv = (float)pow(500000.0, -(double)i / 8.0); const float ang = (float)pos * inv, c = cosf(ang), s = sinf(ang);
            const float x1 = p[i], x2 = p[8 + i]; p[i] = x1 * c - x2 * s; p[8 + i] = x2 * c + x1 * s; }
        __syncthreads();
#if DBG_NAIVE == 2
        { const bf16_t* qif = (const bf16_t*)(F.ws + WS_QI) + (size_t)tok * 512; for (int i = F.tid; i < 512; i += 512) qis[i] = __uint_as_float((unsigned)qif[i] << 16);
          if (F.tid < 8) wis[F.tid] = ((const float*)(F.ws + WS_WI))[(size_t)tok * 8 + F.tid]; }
        __syncthreads();
        for (int s = F.tid; s <= pos; s += 512) { const int tk_ = b0 + s; const bf16_t* kr = (const bf16_t*)(F.ws + WS_KI) + (size_t)(tk_ >> 5) * 2048 + (tk_ & 31) * 16; float tot = 0.f;
            for (int hd = 0; hd < 8; ++hd) { float d = 0.f; for (int e = 0; e < 64; ++e) d += qis[hd * 64 + e] * __uint_as_float((unsigned)kr[(e >> 4) * 512 + ((e >> 3) & 1) * 8 + (e & 7)] << 16); tot += fmaxf(d, 0.f) * (wis[hd] * WSCALE); }
            sc[s] = tot; }
#else
        for (int s = F.tid; s <= pos; s += 512) { const float* kr = nki + (size_t)(b0 + s) * 64; float tot = 0.f;
            for (int hd = 0; hd < 8; ++hd) { float d = 0.f; for (int e = 0; e < 64; ++e) d += qis[hd * 64 + e] * kr[e]; d *= 0.125f; tot += fmaxf(d, 0.f) * wis[hd]; }
            sc[s] = tot * 0.35355339059327373f; }
#endif
        __syncthreads();
        for (int s = F.tid; s <= pos; s += 512) { bool take = true;
            if (pos >= 256) { const float xv = sc[s]; int rank = 0; for (int s2 = 0; s2 <= pos; ++s2) { const float y = sc[s2]; rank += (y > xv || (y == xv && s2 < s)) ? 1 : 0; } take = rank < 256; }
            if (take) { const int p = atomicAdd((int*)nsel, 1); sel[p] = s; } }
        __syncthreads();
        const int ns = nsel[0]; const int hd = F.wave, lane = F.lane;
        float lg[4]; float mx = -INFINITY;
        for (int jj = 0; jj < 4; ++jj) { const int j = lane + 64 * jj; lg[jj] = -INFINITY;
            if (j < ns) { const float* kr = nk + (size_t)(b0 + sel[j]) * 128 + (hd >> 2) * 64; float d = 0.f; for (int e = 0; e < 64; ++e) d += qs[hd * 64 + e] * kr[e]; lg[jj] = d * 0.125f; mx = fmaxf(mx, lg[jj]); } }
        mx = wave_max(mx); float sum = 0.f;
        for (int jj = 0; jj < 4; ++jj) { const int j = lane + 64 * jj; const float p = (j < ns) ? expf(lg[jj] - mx) : 0.f; sum += p; pl[hd * 256 + j] = p; }
        sum = wave_sum(sum);
        LDS_WAIT(); asm volatile("" ::: "memory");
        float o = 0.f;
        for (int j = 0; j < ns; ++j) o += pl[hd * 256 + j] * nv[(size_t)(b0 + sel[j]) * 128 + (hd >> 2) * 64 + lane];
        o /= sum;
        bf16_t* ap = attn + (size_t)tok * 1024 + hd * 64 + lane;
        const float fast = __uint_as_float((unsigned)(*ap) << 16);
        const float blended = o + DBG_G * (fast - o);
        *ap = (bf16_t)(pkbf(blended, 0.f) & 0xffffu);
    }
}
#endif

__global__ void __launch_bounds__(NWAVES * 64, 2) mk_fwd(Args args_unused) {
    extern __shared__ __attribute__((aligned(16))) unsigned char lds[];
    Frame F;
    F.lds = (LAS unsigned char*)lds;
    F.MISC = (volatile LAS unsigned*)(F.lds + LDSCTL_OFF);
    F.tid = threadIdx.x; F.lane = F.tid & 63; F.wave = __builtin_amdgcn_readfirstlane(F.tid >> 6);
    F.G = gridDim.x; { const int bx = blockIdx.x; F.vcu = (F.G % 8 == 0) ? (bx % 8) * (F.G / 8) + bx / 8 : bx; }
    unsigned char* ws; int lo, hi;
    { const KArgs ka = kargs(); ws = ka->ws; lo = ka->ph_lo; hi = ka->ph_hi; }
    F.ws = ws; F.ctl = (unsigned*)(ws + WS_CTL);
    for (int u = F.tid; u < (LDS_BYTES - LDSCTL_OFF) / 4; u += NWAVES * 64) ((LAS unsigned*)(F.lds + LDSCTL_OFF))[u] = 0u;
    __syncthreads();
#if MK_SPLIT
#define GRID_BAR() do { } while (0)
#else
    XcdBarrier bar = xcd_barrier_post(F.ctl + CW_BAR, F.MISC + 8);
#define GRID_BAR() xcd_barrier(bar)
#endif
#ifndef PHASE_MASK
#define PHASE_MASK 0xFFFF
#endif
#define IN(k) ((((PHASE_MASK) >> (k)) & 1) && lo <= (k) && (k) < hi)
#define BOTH(k, k2) (IN(k) && IN(k2))

    bf16_t* xb = (bf16_t*)(ws + WS_XB);
    bf16_t *qb = (bf16_t*)(ws + WS_Q), *kbuf = (bf16_t*)(ws + WS_K), *vbuf = (bf16_t*)(ws + WS_V), *qib = (bf16_t*)(ws + WS_QI), *kib = (bf16_t*)(ws + WS_KI);
    float* wib = (float*)(ws + WS_WI);
    bf16_t *ub = (bf16_t*)(ws + WS_U), *cbb = (bf16_t*)(ws + WS_CB), *acb = (bf16_t*)(ws + WS_AC), *gab = (bf16_t*)(ws + WS_GA), *rtb = (bf16_t*)(ws + WS_RT);
    unsigned* masks = (unsigned*)(ws + WS_MASK);
    bf16_t *merged = (bf16_t*)(ws + WS_MERGED), *h1b = (bf16_t*)(ws + WS_PRE), *ysb_unused = nullptr; (void)ysb_unused;
    float* pre = (float*)(ws + WS_PRE);

    if (IN(0)) { p0_prologue(F); if (BOTH(0, 1)) GRID_BAR(); }
    if (IN(1)) {
        pg8::Gemm g{xb, (const bf16_t*)(ws + WS_WIN), NTOK, NPROJ, DM, 0}; pg8::StaticOrder S; S.init(NTOK, NPROJ, F.G, (int)blockIdx.x);
        EpiProj E{qb, kbuf, vbuf, qib, kib, ub, cbb, gab, rtb, wib, (const float*)(ws + WS_ROPE), kargs()->in[2]};
        pg8::gemm_phase<EpiProj, pg8::StaticOrder, true, false>(F.lds, g, S, E, nullptr);
        if (BOTH(1, 2)) GRID_BAR();
    }
    if (IN(2)) {
        LAS float* scl = (LAS float*)F.lds;
        LAS unsigned* maskw = (LAS unsigned*)(F.lds + TAB_OFF);
        for (int i = F.tid; i < 2048; i += 512) maskw[i] = 0u;
        __syncthreads();
        if (F.G == 256) {
            const int b = F.vcu >> 4, j = F.vcu & 15;
            P2Carry C; p2_request(F, b, j, qib, kib, wib, C); VM_WAIT(); p2_pin(C); p2_wtab(F, C); LDS_WAIT(); __syncthreads();
#pragma unroll 1
            for (int i = 0; i < 8; ++i) { const int qt = 32 * (i >> 1) + ((i & 1) ? 31 - j : j); const int in = i < 7 ? i + 1 : 7, qtn = 32 * (in >> 1) + ((in & 1) ? 31 - j : j);
                const int gwv = F.vcu * NWAVES + F.wave, jx0 = i < 4 ? 2 * i : 4 + i;
                score_select_unit(F, b, qt, b, qtn, C, qib, kib, wib, scl, maskw, masks, gwv + 2048 * jx0, i < 4 ? gwv + 2048 * (jx0 + 1) : -1); }
        } else {
            if (F.vcu < NBATCH * 128) {
                P2Carry C; p2_request(F, F.vcu >> 7, F.vcu & 127, qib, kib, wib, C); VM_WAIT(); p2_pin(C); p2_wtab(F, C); LDS_WAIT(); __syncthreads();
#pragma unroll 1
                for (int un = F.vcu; un < NBATCH * 128; un += F.G) { const int unn = un + F.G < NBATCH * 128 ? un + F.G : un;
                    score_select_unit(F, un >> 7, un & 127, unn >> 7, unn & 127, C, qib, kib, wib, scl, maskw, masks, -1, -1); } }
        }
        conv_pass(F, ub, cbb, kargs()->in[5], acb);
        if (PROBE_P2 == 3) conv_pass(F, ub, cbb, kargs()->in[5], acb);
        if (BOTH(2, 3)) GRID_BAR();
    }
    if (IN(3)) {
        const int nun = NBATCH * 8 * 8;
        if (F.G == 256) {
            const int bh = F.vcu >> 1, s0 = 2 * (F.vcu & 1);
#pragma unroll 1
            for (int i = 0; i < 4; ++i) { const int qbk = (i == 0) ? s0 : (i == 1) ? 7 - s0 : (i == 2) ? s0 + 1 : 6 - s0;
                attn_body::attn_unit<8>(bh >> 3, bh & 7, qbk, (const attn_body::bf16*)qb, (const attn_body::bf16*)kbuf, (const attn_body::bf16*)vbuf, (attn_body::bf16*)acb, masks, (char*)lds); }
        } else {
#pragma unroll 1
            for (int un = F.vcu; un < nun; un += F.G) attn_body::attn_unit<8>(un >> 6, (un >> 3) & 7, un & 7, (const attn_body::bf16*)qb, (const attn_body::bf16*)kbuf, (const attn_body::bf16*)vbuf, (attn_body::bf16*)acb, masks, (char*)lds);
        }
        if (BOTH(3, 4)) GRID_BAR();
    }
#if DBG_NAIVE
    if (IN(4)) { naive_kv(F); }
    if (IN(11)) { naive_attn(F); }
#else
    if (IN(4)) { if (BOTH(4, 5)) { } }
#endif
    if (IN(5)) {
        pg8::Gemm g{acb, (const bf16_t*)(ws + WS_WAU), NTOK, DM, DM, 0}; pg8::StaticOrder S; S.init(NTOK, DM, F.G, (int)blockIdx.x);
        EpiMerged E{gab, rtb, merged};
        pg8::gemm_phase<EpiMerged, pg8::StaticOrder, true, false, true>(F.lds, g, S, E, nullptr);
        if (BOTH(5, 6)) GRID_BAR();
    }
    if (IN(6)) {
        pg8::Gemm g{merged, (const bf16_t*)(ws + WS_WOUT), NTOK, DM, DM, 0}; pg8::StaticOrder S; S.init(NTOK, DM, F.G, (int)blockIdx.x);
        EpiOut E{(bf16_t*)(ws + WS_MIX)};
        pg8::gemm_phase<EpiOut, pg8::StaticOrder, true, false>(F.lds, g, S, E, nullptr);
        if (BOTH(6, 7)) GRID_BAR();
    }
    if (IN(7)) { ln1_router(F, (kargs()->flags & 1) != 0); if (BOTH(7, 8)) GRID_BAR(); }
    if (IN(8)) {
        moe_tables(F);
        LAS int* tab = (LAS int*)(F.lds + TAB_OFF);
        const int nunits = tab[T_NB] * 4; const int* lists = (const int*)(ws + WS_LIST);
        for (int i = 0; i < T_ROWS_UNITS; ++i) { const int L = i * F.G + F.vcu; if (L >= nunits) break;
            const int rbg = L >> 2, e = tab[T_BLKE + rbg], slot0 = (rbg - tab[T_BLK0 + e]) * 256, cnt = tab[T_CNT + e];
            if (F.tid < 256) { const int sl = slot0 + F.tid; tab[T_ROWS + i * 256 + F.tid] = sl < cnt ? lists[(size_t)e * LISTCAP + sl] : 0; } }
        __syncthreads();
        pg8::Gemm g{(const bf16_t*)(ws + WS_H1Q), (const bf16_t*)(ws + WS_WGU), CAPROWS, NEXP * 1024, 512, 0}; pg8::MoeOrder S{tab + T_BLKE, nunits, F.G, F.vcu};
        EpiSwiGLU E{ws + WS_HID};
        pg8::gemm_phase<EpiSwiGLU, pg8::MoeOrder, true, true, false, true>(F.lds, g, S, E, tab + T_ROWS);
        if (BOTH(8, 9)) GRID_BAR();
    }
    if (IN(9)) {
        moe_tables(F);
        LAS int* tab = (LAS int*)(F.lds + TAB_OFF);
        const int nunits = tab[T_NB] * 4;
        pg8::Gemm g{(const bf16_t*)(ws + WS_HID), (const bf16_t*)(ws + WS_WD), CAPROWS, NEXP * 1024, 256, 0}; pg8::MoeOrder S{tab + T_BLKE, nunits, F.G, F.vcu};
        EpiYs E{ws + WS_YS};
        pg8::gemm_phase<EpiYs, pg8::MoeOrder, true, false, false, true>(F.lds, g, S, E, nullptr);
        if (BOTH(9, 10)) GRID_BAR();
    }
    if (IN(10)) { moe_tables(F); combine_ln2(F); }
#undef IN
#undef BOTH
}

extern "C" void kernel_launch(void* const* d_in, const int* in_sizes, int n_in, void* d_out, int out_size, void* d_ws, size_t ws_size, hipStream_t stream) {
    static int grid = 0;
    if (grid == 0) {
        if (n_in != 18 || in_sizes[0] != NTOK * DM || out_size != NTOK * DM || ws_size < WS_END) { fprintf(stderr, "kernel_launch: unexpected shapes (n_in %d, ws %zu)\n", n_in, ws_size); grid = -1; return; }
        int dev = 0, cus = 0, per_cu = 0;
        if (hipGetDevice(&dev) != hipSuccess || hipDeviceGetAttribute(&cus, hipDeviceAttributeMultiprocessorCount, dev) != hipSuccess) { grid = -1; return; }
        if (hipFuncSetAttribute((const void*)mk_fwd, hipFuncAttributeMaxDynamicSharedMemorySize, LDS_BYTES) != hipSuccess) { fprintf(stderr, "kernel_launch: hipFuncSetAttribute failed\n"); grid = -1; return; }
        if (hipOccupancyMaxActiveBlocksPerMultiprocessor(&per_cu, (const void*)mk_fwd, NWAVES * 64, LDS_BYTES) != hipSuccess || per_cu < 1) fprintf(stderr, "kernel_launch: occupancy query reports %d\n", per_cu);
        (void)hipGetLastError();
        grid = cus;
    }
    if (grid < 0) return;
    (void)hipMemsetAsync((char*)d_ws + WS_CTL, 0, CTL_ZERO_BYTES, stream);
    Args a{};
    for (int i = 0; i < 18; ++i) a.in[i] = (const float*)d_in[i];
    a.out = (float*)d_out; a.ws = (unsigned char*)d_ws;
#if MK_SPLIT
#if DBG_NAIVE
    const int seq[] = {0, 1, 2, 3, 4, 11, 5, 6, 7, 8, 9, 10};
#else
    const int seq[] = {0, 1, 2, 3, 5, 6, 7, 8, 9, 10};
#endif
    for (int ph : seq) { a.ph_lo = ph; a.ph_hi = ph + 1;
#ifdef PROBE_P7
        if (ph == 7) { a.flags = 1; hipLaunchKernelGGL(mk_fwd, dim3(grid), dim3(NWAVES * 64), LDS_BYTES, stream, a); a.flags = 0; }
#endif
        hipLaunchKernelGGL(mk_fwd, dim3(grid), dim3(NWAVES * 64), LDS_BYTES, stream, a);
#ifdef PROBE_DUP
        if (ph == PROBE_DUP) hipLaunchKernelGGL(mk_fwd, dim3(grid), dim3(NWAVES * 64), LDS_BYTES, stream, a);
#endif
    }
#else
    a.ph_lo = 0; a.ph_hi = 11;
    hipLaunchKernelGGL(mk_fwd, dim3(grid), dim3(NWAVES * 64), LDS_BYTES, stream, a);
#endif
}
```

```cpp
#include <hip/hip_runtime.h>
#include <hip/hip_bf16.h>
#include <cstdio>
#include <cstdint>

#ifndef MK_SPLIT
#define MK_SPLIT 0
#endif
#ifndef DBG_NAIVE
#define DBG_NAIVE 0
#endif
#ifndef DBG_G
#define DBG_G 1.0f
#endif

#define LAS __attribute__((address_space(3)))
#define GAS __attribute__((address_space(1)))
typedef unsigned short bf16_t;
typedef short bf16x8 __attribute__((ext_vector_type(8)));
typedef short s16x4 __attribute__((ext_vector_type(4)));
typedef float f32x2 __attribute__((ext_vector_type(2)));
typedef float f32x4 __attribute__((ext_vector_type(4)));
typedef float f32x16 __attribute__((ext_vector_type(16)));
typedef unsigned u32x2 __attribute__((ext_vector_type(2)));
typedef unsigned u32x4 __attribute__((ext_vector_type(4)));
typedef unsigned u32x16 __attribute__((ext_vector_type(16)));
typedef __bf16 bf16x2_t __attribute__((ext_vector_type(2)));

constexpr int NTOK = 32768, SEQ = 2048, NBATCH = 16, DM = 1024;
constexpr int NPROJ = 5120, INW = 4936;
constexpr int NEXP = 32, DEXP = 512, LISTCAP = 32768;
constexpr int CAPROWS = 65536 + NEXP * 256;
constexpr float LN_EPS = 1e-5f;
constexpr float ALPHA = 1.189207115002721f;
constexpr float C2 = 0.125f * 1.4426950408889634f;
constexpr float WSCALE = 0.125f * 0.35355339059327373f;

constexpr size_t MiB = 1u << 20;
constexpr size_t WS_CTL = 0, CTL_ZERO_BYTES = 1 * MiB;
constexpr size_t WS_ROPE = 1 * MiB;
constexpr size_t WS_WC = 1 * MiB + 256 * 1024;
constexpr size_t WS_WIN = 2 * MiB, WS_WAU = 12 * MiB, WS_WCU = 13 * MiB, WS_WOUT = 14 * MiB, WS_WD = 16 * MiB, WS_WGU = 48 * MiB;
constexpr size_t WS_XB = 112 * MiB;
constexpr size_t WS_MIX = 112 * MiB;
constexpr size_t WS_H1Q = 304 * MiB;
constexpr size_t WS_AC = 112 * MiB;
constexpr size_t WS_Q = 176 * MiB, WS_K = 208 * MiB, WS_V = 216 * MiB, WS_QI = 224 * MiB, WS_KI = 256 * MiB, WS_WI = 260 * MiB;
constexpr size_t WS_MERGED = 176 * MiB;
constexpr size_t WS_U = 264 * MiB, WS_ATTN = 264 * MiB;
constexpr size_t WS_CB = 296 * MiB, WS_MASK = 360 * MiB, WS_GATES = 368 * MiB;
constexpr size_t WS_GA = 368 * MiB, WS_RT = 432 * MiB;
constexpr size_t WS_PRE = 240 * MiB;
constexpr size_t WS_HID = 368 * MiB;
constexpr size_t WS_LIST = 496 * MiB, WS_TOKINFO = 500 * MiB;
constexpr size_t WS_YS = 48 * MiB;
constexpr size_t WS_END = 512 * MiB;
static_assert(WS_YS + (size_t)CAPROWS * 1024 * 2 <= WS_PRE && WS_HID + (size_t)CAPROWS * 512 * 2 <= WS_LIST, "ws map");
constexpr int CW_BAR = 4096;
constexpr int CW_CNT = 8192;
constexpr int RING_BYTES = 131072;
constexpr int LDSCTL_OFF = RING_BYTES;
constexpr int TAB_OFF = RING_BYTES + 512;
constexpr int T_CNT = 0, T_BLK0 = 32, T_NB = 68, T_BLKE = 72, T_ROWS = 400, T_ROWS_UNITS = 12;
constexpr int QIF_OFF = 147456;
constexpr int LDS_BYTES = 163840;
static_assert(TAB_OFF + (T_ROWS + T_ROWS_UNITS * 256) * 4 <= QIF_OFF && TAB_OFF + 8192 + 1024 <= QIF_OFF && QIF_OFF + 16384 <= LDS_BYTES, "lds map");
constexpr int NWAVES = 8;

__device__ __forceinline__ unsigned pkbf(float lo, float hi) { f32x2 v = {lo, hi}; bf16x2_t b = __builtin_convertvector(v, bf16x2_t); return __builtin_bit_cast(unsigned, b); }
__device__ __forceinline__ float bflo(unsigned u) { return __uint_as_float(u << 16); }
__device__ __forceinline__ float bfhi(unsigned u) { return __uint_as_float(u & 0xffff0000u); }
__device__ __forceinline__ float wave_sum(float v) {
#pragma unroll
    for (int o = 1; o < 64; o <<= 1) v += __shfl_xor(v, o);
    return v;
}
__device__ __forceinline__ float wave_max(float v) {
#pragma unroll
    for (int o = 1; o < 64; o <<= 1) v = fmaxf(v, __shfl_xor(v, o));
    return v;
}
__device__ __forceinline__ float wave_min(float v) {
#pragma unroll
    for (int o = 1; o < 64; o <<= 1) v = fminf(v, __shfl_xor(v, o));
    return v;
}
#define LDS_WAIT() asm volatile("s_waitcnt lgkmcnt(0)" ::: "memory")
#define VM_WAIT() asm volatile("s_waitcnt vmcnt(0)" ::: "memory")

namespace pg8 {
constexpr int BM = 256, BK = 64, HALF = 128, HTB = HALF * BK * 2, STAGE_BYTES = 8 * HTB, NXCD = 8, WGM = 8;
__host__ __device__ __forceinline__ int lds_byte(int r, int c) { const int st = (r >> 4) * 2 + (c >> 5), rr = r & 15, cc = c & 31, ob = rr * 64 + cc * 2; return st * 1024 + (ob ^ (((ob >> 9) & 1) << 5)); }
__host__ __device__ __forceinline__ void stage_rc(int b, int& R, int& C) { const int st = b / 1024, sb = b % 1024, swz = sb ^ (((sb >> 9) & 1) << 5); R = (st >> 1) * 16 + swz / 64; C = (st & 1) * 32 + (swz % 64) / 2; }
__host__ __device__ __forceinline__ int perm32(int rho) { const int n = rho >> 4, i = rho & 15; return 8 * (i >> 2) + 4 * n + (i & 3); }

struct Unit { int pm, pn; };
struct Gemm { const bf16_t* A; const bf16_t* Bt; int M, N, K; int apitch; };

struct StaticOrder {
    int nM, nN, nwg, G, c;
    __host__ __device__ void init(int M, int N, int G_, int c_) { nM = M / BM; nN = N / BM; nwg = nM * nN; G = G_; c = c_; }
    __host__ __device__ bool next(int i, Unit& u) const {
        const long L = (long)i * G + c; if (L >= nwg) return false;
        int wgid = (int)L; { const int q = nwg / NXCD, r = nwg % NXCD, xcd = wgid % NXCD, off = wgid / NXCD; wgid = (xcd < r ? xcd * (q + 1) : r * (q + 1) + (xcd - r) * q) + off; }
        const int nig = WGM * nN, gid = wgid / nig, fm = gid * WGM, gsz = (nM - fm) < WGM ? (nM - fm) : WGM;
        u.pm = fm + ((wgid % nig) % gsz); u.pn = (wgid % nig) / gsz; return true;
    }
};
struct MoeOrder {
    const LAS int* blk_e; int nunits, G, c;
    __device__ __forceinline__ bool next(int i, Unit& u) const {
        const int L = i * G + c; if (L >= nunits) return false;
        const int rbg = L >> 2; u.pm = rbg; u.pn = blk_e[rbg] * 4 + (L & 3); return true;
    }
};

typedef int i32x8 __attribute__((ext_vector_type(8)));
typedef int i32x4_t __attribute__((ext_vector_type(4)));
constexpr int F8_WSCALE_E = 122;
template <class Epi, class Sched, bool ALIGN_EPI, bool GATHER, bool MIDHOOK = false, bool F8 = false>
__device__ __forceinline__ void gemm_phase(LAS unsigned char* lds, const Gemm g, const Sched& S, const Epi& E, const LAS int* rowtab) {
    const int tid = threadIdx.x, wid = __builtin_amdgcn_readfirstlane(tid >> 6), lane = tid & 63, wr = wid >> 2, wc = wid & 3, fr = lane & 15, fq = lane >> 4;
    const int K = g.K; int nt = K / BK;
    if constexpr (F8) asm volatile("" : "+s"(nt));
    int Rr[2]; unsigned cofs[2], voffB[2];
#pragma unroll
    for (int i = 0; i < 2; ++i) { int R, C; stage_rc(tid * 16 + i * 8192, R, C); const int Rb = Epi::PERM ? ((R & ~31) + perm32(R & 31)) : R;
        Rr[i] = R; cofs[i] = (unsigned)C * 2u; voffB[i] = (unsigned)(Rb * K + C) * 2u; }
    const unsigned rowb = g.apitch ? (unsigned)g.apitch : (unsigned)K * 2u;
    const size_t kstep = (size_t)(BK * 2);
    const size_t hstep = (size_t)HALF * K * 2;
    const size_t tstep = 2 * hstep;
    const unsigned ldsw = (unsigned)wid * 1024u;
    const int aoff = lds_byte(wr * 64 + fr, fq * 8), boff = lds_byte(wc * 32 + fr, fq * 8);
    const char* gA = (const char*)g.A;
#define PG8_SA(b, h) (((b) * 2 + (h)) * HTB)
#define PG8_SB(b, h) ((4 + (b) * 2 + (h)) * HTB)
#define PG8_STAGE(bufoff, gbase, voff) do { _Pragma("unroll") for (int _i = 0; _i < 2; ++_i) \
        __builtin_amdgcn_global_load_lds((const unsigned*)((const char*)(gbase) + (voff)[_i]), (LAS unsigned*)(lds + (bufoff) + ldsw + _i * 8192), 16, 0, 0); } while (0)
#define PG8_LD8(p_) __builtin_shufflevector(*(const LAS i32x4_t*)(p_), *(const LAS i32x4_t*)((p_) + 1024), 0, 1, 2, 3, 4, 5, 6, 7)
#define PG8_LDA(dst, b, h) do { if constexpr (F8) { _Pragma("unroll") for (int m = 0; m < 4; ++m) dst##8[m] = PG8_LD8(lds + PG8_SA(b, h) + aoff + m * 2048); } \
        else { _Pragma("unroll") for (int m = 0; m < 4; ++m) _Pragma("unroll") for (int k = 0; k < 2; ++k) dst[m][k] = *(const LAS bf16x8*)(lds + PG8_SA(b, h) + aoff + m * 2048 + k * 1024); } } while (0)
#define PG8_LDB(dst, b, h) do { if constexpr (F8) { _Pragma("unroll") for (int n = 0; n < 2; ++n) dst##8[n] = PG8_LD8(lds + PG8_SB(b, h) + boff + n * 2048); } \
        else { _Pragma("unroll") for (int n = 0; n < 2; ++n) _Pragma("unroll") for (int k = 0; k < 2; ++k) dst[n][k] = *(const LAS bf16x8*)(lds + PG8_SB(b, h) + boff + n * 2048 + k * 1024); } } while (0)
#define PG8_MMA(ai, bj, At, Bt) do { if constexpr (F8) __builtin_amdgcn_sched_barrier(0);     \
        __builtin_amdgcn_s_setprio(1); \
        if constexpr (F8) { _Pragma("unroll") for (int m = 0; m < 4; ++m) _Pragma("unroll") for (int n = 0; n < 2; ++n) \
            asm volatile("v_mfma_scale_f32_16x16x128_f8f6f4 %0, %1, %2, %0, %3, %4 op_sel_hi:[0,0,0]" : "+v"(acc[ai][bj][m][n]) : "v"(Bt##8[n]), "v"(At##8[m]), "v"(f8_sw), "v"(f8_sa));     \
            __builtin_amdgcn_sched_barrier(0); } \
        else { _Pragma("unroll") for (int m = 0; m < 4; ++m) _Pragma("unroll") for (int n = 0; n < 2; ++n) _Pragma("unroll") for (int k = 0; k < 2; ++k) \
            acc[ai][bj][m][n] = __builtin_amdgcn_mfma_f32_16x16x32_bf16(Bt[n][k], At[m][k], acc[ai][bj][m][n], 0, 0, 0); } \
        __builtin_amdgcn_s_setprio(0); } while (0)
#define PG8_WAIT_V(n) asm volatile("s_waitcnt vmcnt(" #n ")" ::: "memory")
#define PG8_WAIT_L(n) asm volatile("s_waitcnt lgkmcnt(" #n ")" ::: "memory")
#define PG8_BAR __builtin_amdgcn_s_barrier()
#define PG8_SCHED __builtin_amdgcn_sched_barrier(0)
#define PG8_AOFF(d0, d1, un, uidx) do { _Pragma("unroll") for (int _i = 0; _i < 2; ++_i) { unsigned r0_, r1_; \
        if (GATHER) { r0_ = (unsigned)rowtab[(uidx) * 256 + Rr[_i]]; r1_ = (unsigned)rowtab[(uidx) * 256 + 128 + Rr[_i]]; } \
        else { r0_ = (unsigned)((un).pm * 256 + Rr[_i]); r1_ = r0_ + 128u; } \
        d0[_i] = r0_ * rowb + cofs[_i]; d1[_i] = r1_ * rowb + cofs[_i]; } } while (0)
    Unit cur, nxt; int ui = 0;
    if (!S.next(0, cur)) return;
    f32x4 acc[2][2][4][2];
#pragma unroll
    for (int a = 0; a < 2; ++a)
#pragma unroll
        for (int b = 0; b < 2; ++b)
#pragma unroll
            for (int m = 0; m < 4; ++m)
#pragma unroll
                for (int n = 0; n < 2; ++n) acc[a][b][m][n] = (f32x4){0.f, 0.f, 0.f, 0.f};
    bf16x8 At[4][2], B0[2][2], B1[2][2]; i32x8 At8[4], B08[2], B18[2];
    int f8_sw = F8_WSCALE_E, f8_sa = 127; asm volatile("" : "+v"(f8_sw), "+v"(f8_sa));
    unsigned oc0[2], oc1[2], on0[2], on1[2];
    PG8_AOFF(oc0, oc1, cur, 0);
    const char* cB = (const char*)g.Bt + (size_t)cur.pn * tstep;
    PG8_STAGE(PG8_SB(0, 0), cB, voffB); PG8_STAGE(PG8_SB(0, 1), cB + hstep, voffB); PG8_STAGE(PG8_SA(0, 0), gA, oc0); PG8_STAGE(PG8_SA(0, 1), gA, oc1);
    if (wr == 1) PG8_BAR;
    PG8_WAIT_V(2); PG8_BAR;
    PG8_STAGE(PG8_SB(1, 0), cB + kstep, voffB); PG8_STAGE(PG8_SA(1, 0), gA + kstep, oc0); PG8_STAGE(PG8_SB(1, 1), cB + hstep + kstep, voffB);
    PG8_WAIT_V(6); PG8_BAR;
    for (;;) {
        const bool has_next = S.next(ui + 1, nxt);
        if (has_next) { PG8_AOFF(on0, on1, nxt, ui + 1); } else { on0[0] = oc0[0]; on0[1] = oc0[1]; on1[0] = oc1[0]; on1[1] = oc1[1]; }
        const char* nB = has_next ? (const char*)g.Bt + (size_t)nxt.pn * tstep : cB;
        for (int t = 0; t < nt; t += 2) {
            if constexpr (MIDHOOK) { if (t == nt / 2) E.mid(acc, cur, wr, wc, fr, fq); }
            const bool last = (t == nt - 2);
            const char* a1 = gA + (size_t)(t + 1) * kstep;
            const char* a2 = last ? gA : gA + (size_t)(t + 2) * kstep; const char* b2 = last ? nB : cB + (size_t)(t + 2) * kstep;
            const char* a3 = a2 + kstep; const char* b3 = b2 + kstep;
            unsigned o20[2], o21[2];
            o20[0] = last ? on0[0] : oc0[0]; o20[1] = last ? on0[1] : oc0[1]; o21[0] = last ? on1[0] : oc1[0]; o21[1] = last ? on1[1] : oc1[1];
            PG8_LDB(B0, 0, 0); PG8_LDB(B1, 0, 1); PG8_SCHED; PG8_LDA(At, 0, 0); PG8_STAGE(PG8_SA(1, 1), a1, oc1);
            PG8_WAIT_V(8); PG8_WAIT_L(0); PG8_BAR; PG8_MMA(0, 0, At, B0); PG8_MMA(0, 1, At, B1); PG8_BAR; PG8_SCHED;
            PG8_LDA(At, 0, 1); PG8_STAGE(PG8_SB(0, 0), b2, voffB); PG8_STAGE(PG8_SB(0, 1), b2 + hstep, voffB); PG8_STAGE(PG8_SA(0, 0), a2, o20);
            PG8_WAIT_V(8); PG8_WAIT_L(0); PG8_BAR; PG8_MMA(1, 0, At, B0); PG8_MMA(1, 1, At, B1); PG8_BAR; PG8_SCHED;
            PG8_LDB(B0, 1, 0); PG8_LDB(B1, 1, 1); PG8_SCHED; PG8_LDA(At, 1, 0); PG8_STAGE(PG8_SA(0, 1), a2, o21);
            PG8_WAIT_V(8); PG8_WAIT_L(0); PG8_BAR; PG8_MMA(0, 0, At, B0); PG8_MMA(0, 1, At, B1); PG8_BAR; PG8_SCHED;
            PG8_LDA(At, 1, 1); PG8_STAGE(PG8_SB(1, 0), b3, voffB); PG8_STAGE(PG8_SB(1, 1), b3 + hstep, voffB); PG8_STAGE(PG8_SA(1, 0), a3, o20);
            PG8_WAIT_V(8); PG8_WAIT_L(0); PG8_BAR; PG8_MMA(1, 0, At, B0); PG8_MMA(1, 1, At, B1); PG8_BAR; PG8_SCHED;
        }
        if constexpr (ALIGN_EPI) { if (wr == 0) PG8_BAR; }
        if constexpr (F8) asm volatile("s_nop 15\n\ts_nop 15" ::: "memory");
        E(acc, cur, wr, wc, fr, fq);
#ifdef PROBE_EPI2
        if constexpr (!MIDHOOK && !F8 && !GATHER) E(acc, cur, wr, wc, fr, fq);
#endif
        if (!has_next) break;
#pragma unroll
        for (int a = 0; a < 2; ++a)
#pragma unroll
            for (int b = 0; b < 2; ++b)
#pragma unroll
                for (int m = 0; m < 4; ++m)
#pragma unroll
                    for (int n = 0; n < 2; ++n) acc[a][b][m][n] = (f32x4){0.f, 0.f, 0.f, 0.f};
        cur = nxt; cB = nB; ++ui;
        oc0[0] = on0[0]; oc0[1] = on0[1]; oc1[0] = on1[0]; oc1[1] = on1[1];
        if constexpr (ALIGN_EPI) { if (wr == 1) PG8_BAR; }
    }
    PG8_WAIT_V(0);
    if constexpr (!ALIGN_EPI) { if (wr == 0) PG8_BAR; }
    PG8_BAR;
#undef PG8_SA
#undef PG8_SB
#undef PG8_STAGE
#undef PG8_LDA
#undef PG8_LDB
#undef PG8_MMA
#undef PG8_LD8
#undef PG8_WAIT_V
#undef PG8_WAIT_L
#undef PG8_BAR
#undef PG8_SCHED
#undef PG8_AOFF
}
}

typedef f32x4 AccT[2][2][4][2];
__device__ __forceinline__ void store8bf(bf16_t* p, const f32x4& v0, const f32x4& v1) {
    u32x4 w; w.x = pkbf(v0[0], v0[1]); w.y = pkbf(v0[2], v0[3]); w.z = pkbf(v1[0], v1[1]); w.w = pkbf(v1[2], v1[3]); *(u32x4*)p = w;
}
__device__ __forceinline__ void rope8(f32x4& v0, f32x4& v1, const float* rope, int pos, int i0) {
    const f32x4 c = *(const f32x4*)(rope + pos * 8 + i0), s = *(const f32x4*)(rope + SEQ * 8 + pos * 8 + i0);
    float a, b;
    a = v0[0]; b = v0[1]; v0[0] = a * c[0] - b * s[0]; v0[1] = b * c[0] + a * s[0];
    a = v0[2]; b = v0[3]; v0[2] = a * c[1] - b * s[1]; v0[3] = b * c[1] + a * s[1];
    a = v1[0]; b = v1[1]; v1[0] = a * c[2] - b * s[2]; v1[1] = b * c[2] + a * s[2];
    a = v1[2]; b = v1[3]; v1[2] = a * c[3] - b * s[3]; v1[3] = b * c[3] + a * s[3];
}
__device__ __forceinline__ float sigmoidf_(float z) { return __builtin_amdgcn_rcpf(1.0f + __expf(-z)); }

struct EpiProj {
    static constexpr bool PERM = true;
    bf16_t *q, *k, *v, *qi, *ki, *u, *cb, *ga, *rt; float* wi; const float* rope; const float* gate_bias;
    __device__ __forceinline__ void operator()(const AccT& acc, const pg8::Unit& un, int wr, int wc, int fr, int fq) const {
        const int pn = un.pn, row0 = un.pm * 256 + wr * 64 + fr, cg = 32 * wc + 8 * fq;
        const bool rot = ((wc & 1) == 0) && (fq < 2); const int i0 = 4 * fq;
        if (pn < 2 || pn == 3 || pn == 4) {
            bf16_t* dst = (pn < 2) ? q + pn * 256 : qi + (pn - 3) * 256; const float sc = (pn < 2) ? C2 : 1.0f;
#pragma unroll
            for (int ai = 0; ai < 2; ++ai)
#pragma unroll
                for (int m = 0; m < 4; ++m) { const int row = row0 + ai * 128 + m * 16, pos = row & (SEQ - 1);
#pragma unroll
                    for (int bj = 0; bj < 2; ++bj) { f32x4 v0 = acc[ai][bj][m][0], v1 = acc[ai][bj][m][1];
                        if (rot) rope8(v0, v1, rope, pos, i0);
                        v0 = v0 * sc; v1 = v1 * sc; store8bf(dst + (size_t)row * 512 + bj * 128 + cg, v0, v1); } }
        } else if (pn == 2) {
#pragma unroll
            for (int ai = 0; ai < 2; ++ai)
#pragma unroll
                for (int m = 0; m < 4; ++m) { const int row = row0 + ai * 128 + m * 16, pos = row & (SEQ - 1);
                    f32x4 v0 = acc[ai][0][m][0], v1 = acc[ai][0][m][1];
                    if (rot) rope8(v0, v1, rope, pos, i0);
                    store8bf(k + (size_t)row * 128 + cg, v0, v1);
                    store8bf(v + (size_t)row * 128 + cg, acc[ai][1][m][0], acc[ai][1][m][1]); }
        } else if (pn == 5) {
            if (wc < 2) {
#pragma unroll
                for (int ai = 0; ai < 2; ++ai)
#pragma unroll
                    for (int m = 0; m < 4; ++m) { const int row = row0 + ai * 128 + m * 16, pos = row & (SEQ - 1);
                        f32x4 v0 = acc[ai][0][m][0], v1 = acc[ai][0][m][1];
                        if (rot) rope8(v0, v1, rope, pos, i0);
                        { const int jch = cg >> 3; store8bf(ki + ((size_t)(row >> 5) * 4 + (jch >> 1)) * 512 + (row & 31) * 16 + (jch & 1) * 8, v0, v1); } }
            } else if (wc == 2 && fq == 0) {
#pragma unroll
                for (int ai = 0; ai < 2; ++ai)
#pragma unroll
                    for (int m = 0; m < 4; ++m) { const int row = row0 + ai * 128 + m * 16;
                        *(f32x4*)(wi + (size_t)row * 8) = acc[ai][0][m][0]; *(f32x4*)(wi + (size_t)row * 8 + 4) = acc[ai][0][m][1]; }
            }
        } else if (pn < 10) {
#pragma unroll
            for (int ai = 0; ai < 2; ++ai)
#pragma unroll
                for (int m = 0; m < 4; ++m) { const int row = row0 + ai * 128 + m * 16;
                    store8bf(u + (size_t)row * 512 + (pn - 6) * 128 + cg, acc[ai][0][m][0] * acc[ai][1][m][0], acc[ai][0][m][1] * acc[ai][1][m][1]); }
        } else if (pn < 12) {
#pragma unroll
            for (int ai = 0; ai < 2; ++ai)
#pragma unroll
                for (int m = 0; m < 4; ++m) { const int row = row0 + ai * 128 + m * 16;
#pragma unroll
                    for (int bj = 0; bj < 2; ++bj) store8bf(cb + (size_t)row * 512 + (pn - 10) * 256 + bj * 128 + cg, acc[ai][bj][m][0], acc[ai][bj][m][1]); }
        } else {
            const int gc0 = (pn - 12) * 128 + cg;
            const f32x4 ba0 = *(const f32x4*)(gate_bias + gc0), ba1 = *(const f32x4*)(gate_bias + gc0 + 4), bc0 = *(const f32x4*)(gate_bias + 1024 + gc0), bc1 = *(const f32x4*)(gate_bias + 1024 + gc0 + 4);
#pragma unroll
            for (int ai = 0; ai < 2; ++ai)
#pragma unroll
                for (int m = 0; m < 4; ++m) { const int row = row0 + ai * 128 + m * 16;
                    const f32x4 a0 = acc[ai][0][m][0] + ba0, a1 = acc[ai][0][m][1] + ba1, c0 = acc[ai][1][m][0] + bc0, c1 = acc[ai][1][m][1] + bc1;
                    f32x4 g0, g1, r0, r1;
#pragma unroll
                    for (int e = 0; e < 4; ++e) { const float ea0 = 1.0f + __expf(-a0[e]), ea1 = 1.0f + __expf(-a1[e]);
                        g0[e] = __builtin_amdgcn_rcpf(ea0); g1[e] = __builtin_amdgcn_rcpf(ea1);
                        r0[e] = ea0 * __builtin_amdgcn_rcpf(1.0f + __expf(-c0[e])); r1[e] = ea1 * __builtin_amdgcn_rcpf(1.0f + __expf(-c1[e])); }
                    store8bf(ga + (size_t)row * 1024 + gc0, g0, g1); store8bf(rt + (size_t)row * 1024 + gc0, r0, r1); }
        }
    }
};
struct EpiMerged {
    static constexpr bool PERM = true;
    const bf16_t* ga; const bf16_t* rt; bf16_t* out;
    __device__ __forceinline__ void scale(AccT& acc, const bf16_t* gsrc, const pg8::Unit& un, int wr, int wc, int fr, int fq) const {
        unsigned off0 = (unsigned)(un.pm * 256 + wr * 64 + fr) * 1024u + (unsigned)(un.pn * 256 + 32 * wc + 8 * fq);
        asm volatile("" : "+v"(off0));
#pragma unroll
        for (int ai = 0; ai < 2; ++ai)
#pragma unroll
            for (int m = 0; m < 4; ++m) {
#pragma unroll
                for (int bj = 0; bj < 2; ++bj) { const u32x4 gw = __builtin_nontemporal_load((const u32x4*)(gsrc + (off0 + (unsigned)((ai * 128 + m * 16) * 1024 + bj * 128))));
                    f32x4& v0 = acc[ai][bj][m][0]; f32x4& v1 = acc[ai][bj][m][1];
                    v0[0] *= bflo(gw.x); v0[1] *= bfhi(gw.x); v0[2] *= bflo(gw.y); v0[3] *= bfhi(gw.y);
                    v1[0] *= bflo(gw.z); v1[1] *= bfhi(gw.z); v1[2] *= bflo(gw.w); v1[3] *= bfhi(gw.w); } }
    }
    __device__ __forceinline__ void mid(AccT& acc, const pg8::Unit& un, int wr, int wc, int fr, int fq) const { scale(acc, rt, un, wr, wc, fr, fq); }
    __device__ __forceinline__ void operator()(AccT& acc, const pg8::Unit& un, int wr, int wc, int fr, int fq) const {
        scale(acc, ga, un, wr, wc, fr, fq);
        const int row0 = un.pm * 256 + wr * 64 + fr, col0 = un.pn * 256 + 32 * wc + 8 * fq;
#pragma unroll
        for (int ai = 0; ai < 2; ++ai)
#pragma unroll
            for (int m = 0; m < 4; ++m) { const int row = row0 + ai * 128 + m * 16;
#pragma unroll
                for (int bj = 0; bj < 2; ++bj) store8bf(out + (size_t)row * 1024 + col0 + bj * 128, acc[ai][bj][m][0], acc[ai][bj][m][1]); }
    }
};
struct EpiOut {
    static constexpr bool PERM = true;
    bf16_t* mix;
    __device__ __forceinline__ void operator()(const AccT& acc, const pg8::Unit& un, int wr, int wc, int fr, int fq) const {
        const int row0 = un.pm * 256 + wr * 64 + fr, col0 = un.pn * 256 + 32 * wc + 8 * fq;
#pragma unroll
        for (int ai = 0; ai < 2; ++ai)
#pragma unroll
            for (int m = 0; m < 4; ++m) { const int row = row0 + ai * 128 + m * 16;
#pragma unroll
                for (int bj = 0; bj < 2; ++bj) store8bf(mix + (size_t)row * 1024 + col0 + bj * 128, acc[ai][bj][m][0], acc[ai][bj][m][1]); }
    }
};
struct EpiSwiGLU {
    static constexpr bool PERM = true;
    unsigned char* hid;
    __device__ __forceinline__ void operator()(const AccT& acc, const pg8::Unit& un, int wr, int wc, int fr, int fq) const {
        const int row0 = un.pm * 256 + wr * 64 + fr, col0 = (un.pn & 3) * 128 + 32 * wc + 8 * fq;
#pragma unroll
        for (int ai = 0; ai < 2; ++ai)
#pragma unroll
            for (int m = 0; m < 4; ++m) { const int row = row0 + ai * 128 + m * 16; f32x4 h0, h1;
#pragma unroll
                for (int e = 0; e < 4; ++e) { const float g0 = acc[ai][0][m][0][e], g1 = acc[ai][0][m][1][e];
                    h0[e] = g0 * sigmoidf_(g0) * acc[ai][1][m][0][e]; h1[e] = g1 * sigmoidf_(g1) * acc[ai][1][m][1][e]; }
                int w0 = 0, w1 = 0;
                w0 = __builtin_amdgcn_cvt_pk_fp8_f32(h0[0], h0[1], w0, false); w0 = __builtin_amdgcn_cvt_pk_fp8_f32(h0[2], h0[3], w0, true);
                w1 = __builtin_amdgcn_cvt_pk_fp8_f32(h1[0], h1[1], w1, false); w1 = __builtin_amdgcn_cvt_pk_fp8_f32(h1[2], h1[3], w1, true);
                *(u32x2*)(hid + (size_t)row * 512 + col0) = (u32x2){(unsigned)w0, (unsigned)w1}; }
    }
};
struct EpiYs {
    static constexpr bool PERM = true;
    unsigned char* ys;
    __device__ __forceinline__ void operator()(const AccT& acc, const pg8::Unit& un, int wr, int wc, int fr, int fq) const {
        const int row0 = un.pm * 256 + wr * 64 + fr, col0 = (un.pn & 3) * 256 + 32 * wc + 8 * fq;
#pragma unroll
        for (int ai = 0; ai < 2; ++ai)
#pragma unroll
            for (int m = 0; m < 4; ++m) { const int row = row0 + ai * 128 + m * 16;
#pragma unroll
                for (int bj = 0; bj < 2; ++bj) { const f32x4 v0 = acc[ai][bj][m][0], v1 = acc[ai][bj][m][1]; int w0 = 0, w1 = 0;
                    w0 = __builtin_amdgcn_cvt_pk_fp8_f32(v0[0], v0[1], w0, false); w0 = __builtin_amdgcn_cvt_pk_fp8_f32(v0[2], v0[3], w0, true);
                    w1 = __builtin_amdgcn_cvt_pk_fp8_f32(v1[0], v1[1], w1, false); w1 = __builtin_amdgcn_cvt_pk_fp8_f32(v1[2], v1[3], w1, true);
                    *(u32x2*)(ys + (size_t)row * 1024 + col0 + bj * 128) = (u32x2){(unsigned)w0, (unsigned)w1}; } }
    }
};

namespace attn_body {
using bf16 = __hip_bfloat16;
constexpr int D = 64, QP = 512, KP = 128, OP = 1024, OCOL = 512;
constexpr int NW = 8, QBLK = 32, QB = QBLK * NW, KVBLK = 64;
__device__ __forceinline__ int crow(int r, int hi) { return (r & 3) + 8 * (r >> 2) + 4 * hi; }
#define SBAR() __builtin_amdgcn_sched_barrier(0)
__device__ __forceinline__ void cmask(f32x16& p0, f32x16& p1, int jb, int qrel, int hi) {
    const float NEG = -INFINITY; int kb = 64 * jb + 4 * hi;
#pragma unroll
    for (int r = 0; r < 16; ++r) { int kv = kb + (r & 3) + 8 * (r >> 2); if (kv > qrel) p0[r] = NEG; if (kv + 32 > qrel) p1[r] = NEG; }
}
constexpr int NSLOT = 3, SLOTB = 8192;
constexpr int LDS_K = 0, LDS_V = NSLOT * SLOTB, LDS_WS = 2 * NSLOT * SLOTB, LDS_OST = LDS_WS + NW * 64 * 4, LDS_QF = LDS_OST + NW * 4096, LDS_BYTES_A = LDS_QF + NW * 4096;
static_assert(LDS_BYTES_A <= 131072, "attention LDS");
__device__ __forceinline__ void glds16(const void* gsrc, unsigned lds_dst) { unsigned keep;
    asm volatile("s_mov_b32 %0, m0\n\ts_mov_b32 m0, %2\n\ts_nop 0\n\tglobal_load_lds_dwordx4 %1, off\n\ts_mov_b32 m0, %0" : "=&s"(keep) : "v"(gsrc), "s"(lds_dst) : "memory"); }
__device__ __forceinline__ float max3f(float a, float b, float c) { float r; asm("v_max3_f32 %0, %1, %2, %3" : "=v"(r) : "v"(a), "v"(b), "v"(c)); return r; }
__device__ __forceinline__ float max2f(float a, float b) { float r; asm("v_max_f32_e32 %0, %1, %2" : "=v"(r) : "v"(a), "v"(b)); return r; }
__device__ __forceinline__ float fadd_s(float a, float b) { float r; asm("v_add_f32_e32 %0, %1, %2" : "=v"(r) : "v"(a), "v"(b)); return r; }
__device__ __forceinline__ float fsub_s(float a, float b) { float r; asm("v_sub_f32_e32 %0, %1, %2" : "=v"(r) : "v"(a), "v"(b)); return r; }
__device__ __forceinline__ unsigned cvtpk_s(float lo, float hi) { return pkbf(lo, hi); }
__device__ __forceinline__ float msel(float x, float neg, unsigned long long m) { float r; asm("v_cndmask_b32_e64 %0, %1, %2, %3" : "=v"(r) : "v"(neg), "v"(x), "s"(m)); return r; }
#define WAIT_BAR(N) asm volatile("s_waitcnt vmcnt(" #N ") lgkmcnt(0)\n\ts_barrier" ::: "memory")

typedef __attribute__((address_space(3))) const char* lds_cptr;
__device__ __forceinline__ void qkt(f32x16& p0, f32x16& p1, const char* Kslot, lds_cptr qfp, const f32x16& negm, int r32, int hi) {
    const char* kb = Kslot + hi * 1024 + r32 * 16;
#pragma unroll
    for (int d0 = 0; d0 < 4; ++d0) {
        const bf16x8 b0 = *reinterpret_cast<const bf16x8*>(kb + d0 * 2048);
        const bf16x8 b1 = *reinterpret_cast<const bf16x8*>(kb + d0 * 2048 + 512);
        const bf16x8 qd = *(const LAS bf16x8*)(qfp + d0 * 1024);
        if (d0 == 0) { p0 = __builtin_amdgcn_mfma_f32_32x32x16_bf16(b0, qd, negm, 0, 0, 0); p1 = __builtin_amdgcn_mfma_f32_32x32x16_bf16(b1, qd, negm, 0, 0, 0); }
        else { p0 = __builtin_amdgcn_mfma_f32_32x32x16_bf16(b0, qd, p0, 0, 0, 0); p1 = __builtin_amdgcn_mfma_f32_32x32x16_bf16(b1, qd, p1, 0, 0, 0); } }
}
typedef short v4i16_t __attribute__((ext_vector_type(4)));
__device__ __forceinline__ void kload8(bf16x8* kf, lds_cptr kp) {
    kf[0] = *(const LAS bf16x8*)(kp);        kf[1] = *(const LAS bf16x8*)(kp + 512);
    kf[2] = *(const LAS bf16x8*)(kp + 2048); kf[3] = *(const LAS bf16x8*)(kp + 2560);
    kf[4] = *(const LAS bf16x8*)(kp + 4096); kf[5] = *(const LAS bf16x8*)(kp + 4608);
    kf[6] = *(const LAS bf16x8*)(kp + 6144); kf[7] = *(const LAS bf16x8*)(kp + 6656);
}
__device__ __forceinline__ void kload2(bf16x8* kf, lds_cptr kp, int j) { kf[2 * j] = *(const LAS bf16x8*)(kp + j * 2048); kf[2 * j + 1] = *(const LAS bf16x8*)(kp + j * 2048 + 512); }
__device__ __forceinline__ s16x4 vtr(lds_cptr p) { return __builtin_bit_cast(s16x4, __builtin_amdgcn_ds_read_tr16_b64_v4i16((LAS v4i16_t*)p)); }
__device__ __forceinline__ float rowmax(const f32x16& p0, const f32x16& p1) {
    float a = max3f(p0[0], p0[1], p1[0]), b = max3f(p0[2], p0[3], p1[1]); a = max3f(a, p1[2], p1[3]);
#pragma unroll
    for (int r = 4; r < 16; r += 4) { a = max3f(a, p0[r], p0[r + 1]); b = max3f(b, p0[r + 2], p0[r + 3]); a = max3f(a, p1[r], p1[r + 1]); b = max3f(b, p1[r + 2], p1[r + 3]); }
    const float m = max2f(a, b);
    auto rr = __builtin_amdgcn_permlane32_swap(__float_as_uint(m), __float_as_uint(m), false, false);
    return max2f(__uint_as_float(rr[0]), __uint_as_float(rr[1]));
}
__device__ __forceinline__ void pv(f32x16* o, int vb, bf16x8 pa0, bf16x8 pa1, bf16x8 pa2, bf16x8 pa3) {
#pragma unroll
    for (int d0 = 0; d0 < 2; ++d0) { s16x4 lo[4], hi[4];
#pragma unroll
        for (int ks = 0; ks < 4; ++ks) {
            asm volatile("ds_read_b64_tr_b16 %0,%1 offset:%c2" : "=&v"(lo[ks]) : "v"(vb), "i"(d0 * 4096 + ks * 1024) : "memory");
            asm volatile("ds_read_b64_tr_b16 %0,%1 offset:%c2" : "=&v"(hi[ks]) : "v"(vb), "i"(d0 * 4096 + ks * 1024 + 512) : "memory"); }
        asm volatile("s_waitcnt lgkmcnt(0)" ::: "memory"); SBAR();
#define PK(k) (bf16x8){lo[k][0], lo[k][1], lo[k][2], lo[k][3], hi[k][0], hi[k][1], hi[k][2], hi[k][3]}
        o[d0] = __builtin_amdgcn_mfma_f32_32x32x16_bf16(pa0, PK(0), o[d0], 0, 0, 0);
        o[d0] = __builtin_amdgcn_mfma_f32_32x32x16_bf16(pa1, PK(1), o[d0], 0, 0, 0);
        o[d0] = __builtin_amdgcn_mfma_f32_32x32x16_bf16(pa2, PK(2), o[d0], 0, 0, 0);
        o[d0] = __builtin_amdgcn_mfma_f32_32x32x16_bf16(pa3, PK(3), o[d0], 0, 0, 0);
#undef PK
    }
}
#define ATTN_STORE16(p, v) (*(u32x4*)(p) = (v))
template <int THRL> __device__ __forceinline__ void attn_unit(int b, int h, int qb, const bf16* Q, const bf16* __restrict__ K, const bf16* __restrict__ V, bf16* O, const unsigned* masks, char* shm) {
    const int tid = threadIdx.x, lane = tid & 63, r32 = lane & 31, hi = lane >> 5; const int wid = __builtin_amdgcn_readfirstlane(tid >> 6);
    const long rowbase = (long)b * SEQ; const int q0 = qb * QB;
    const bf16* Qw = Q + (rowbase + q0 + wid * QBLK) * QP + h * D;
    const bf16 *Kh = K + rowbase * KP + (h >> 2) * D, *Vh = V + rowbase * KP + (h >> 2) * D;
    const unsigned* mrow = masks + ((size_t)(b * (SEQ / 32) + (q0 >> 5) + wid) * (SEQ / 64)) * 64;
    const unsigned lds0 = (unsigned)(uintptr_t)shm;
    float* wsf = (float*)(shm + LDS_WS) + wid * 64;
    const bf16* ksrc = Kh + (long)lane * KP + wid * 8;
    const bf16* vsrc = Vh + (long)(16 * (wid & 3) + (lane >> 2)) * KP + (wid >> 2) * 32 + (lane & 3) * 8;
    const unsigned kdst = lds0 + LDS_K + wid * 1024, vdst = lds0 + LDS_V + wid * 1024;
#define DMA_K(t, slot) glds16(ksrc + (long)(t) * KVBLK * KP, (unsigned)__builtin_amdgcn_readfirstlane(kdst + (slot)))
#define DMA_V(t, slot) glds16(vsrc + (long)(t) * KVBLK * KP, (unsigned)__builtin_amdgcn_readfirstlane(vdst + (slot)))
    const int vb0 = (int)(lds0 + LDS_V) + ((lane >> 4) & 1) * 32 + (lane & 3) * 8 + (4 * hi + ((lane & 15) >> 2)) * 64;
    const char* Kbase = shm + LDS_K; bf16x8 kf[8];
    const lds_cptr shm3 = (lds_cptr)shm; const lds_cptr kp0 = shm3 + LDS_K + hi * 1024 + r32 * 16; const lds_cptr vp0 = shm3 + LDS_V + ((lane >> 4) & 1) * 32 + (lane & 3) * 8 + (4 * hi + ((lane & 15) >> 2)) * 64;
    const int NT = (q0 + QB) / KVBLK;
    u32x16 mA, mB;
#define MLOAD0(t) do { const unsigned* mp_ = mrow + (size_t)(t) * 64; \
        asm volatile("s_load_dwordx16 %0, %1, 0x0" : "=s"(mA) : "s"(mp_)); asm volatile("s_load_dwordx16 %0, %1, 0x40" : "=s"(mB) : "s"(mp_)); } while (0)
#define MLOAD1(t) do { const unsigned* mp_ = mrow + (size_t)(t) * 64; \
        asm volatile("s_load_dwordx16 %0, %1, 0x80" : "=s"(mA) : "s"(mp_)); asm volatile("s_load_dwordx16 %0, %1, 0xc0" : "=s"(mB) : "s"(mp_)); } while (0)
#define MPAIR(M, j) (((unsigned long long)(M)[2 * (j) + 1] << 32) | (unsigned long long)(M)[2 * (j)])
#define MAPPLY(P) do { asm volatile("s_waitcnt lgkmcnt(0)" : "+s"(mA), "+s"(mB)); const float NEG_ = -INFINITY; \
        _Pragma("unroll") for (int r = 0; r < 8; ++r) { P[r] = msel(P[r], NEG_, MPAIR(mA, r)); P[r + 8] = msel(P[r + 8], NEG_, MPAIR(mB, r)); } } while (0)
    DMA_K(0, 0); DMA_V(0, 0); DMA_K(1, SLOTB);
    MLOAD0(0);
    const lds_cptr qfp = shm3 + LDS_QF + wid * 4096 + lane * 16;
    { bf16x8 qr[4];
#pragma unroll
      for (int d0 = 0; d0 < 4; ++d0) qr[d0] = *reinterpret_cast<const bf16x8*>(&Qw[(long)r32 * QP + d0 * 16 + hi * 8]);
#pragma unroll
      for (int d0 = 0; d0 < 4; ++d0) *(LAS bf16x8*)(LAS char*)(qfp + d0 * 1024) = qr[d0]; }
#define QF(i) (*(const LAS bf16x8*)(qfp + (i) * 1024))
    float mhat = 0.f, l_reg = 0.f; f32x16 o[2]; o[0] = f32x16{}; o[1] = f32x16{}; f32x16 negm = f32x16{}; asm volatile("" : "+v"(negm));
    const int qrel = wid * QBLK + r32;
#define CMASK(P0, P1, t) do { int jb_ = (t) - (NT - 4); if (jb_ >= 0) cmask(P0, P1, jb_, qrel, hi); } while (0)
    bool resc = false;
#define START(P0, P1) do { const float rm = rowmax(P0, P1); resc = false; \
    { const float dl = rm; mhat = fadd_s(mhat, dl); \
      _Pragma("unroll") for (int r = 0; r < 16; ++r) { P0[r] = fsub_s(P0[r], dl); P1[r] = fsub_s(P1[r], dl); } \
      _Pragma("unroll") for (int r = 0; r < 16; ++r) negm[r] = -mhat; asm volatile("" : "+v"(negm)); } } while (0)
#define RESC() do { if (resc) { asm volatile("s_waitcnt lgkmcnt(0)" ::: "memory"); \
      _Pragma("unroll") for (int d_ = 0; d_ < 2; ++d_) _Pragma("unroll") for (int r = 0; r < 16; ++r) o[d_][r] *= wsf[crow(r, hi)]; } } while (0)
    f32x16 pA0, pA1, pB0, pB1;
    int sl_prev = 0, sl_cur = 0, sl_next = SLOTB;
#define ROT() do { sl_prev = sl_cur; sl_cur = sl_next; sl_next = (sl_next == (NSLOT - 1) * SLOTB) ? 0 : sl_next + SLOTB; } while (0)
    DMA_K(2, 2 * SLOTB);
    WAIT_BAR(3);
    qkt(pA0, pA1, Kbase, qfp, negm, r32, hi); asm volatile("s_nop 15\n\ts_nop 7" : "+v"(pA0), "+v"(pA1)); CMASK(pA0, pA1, 0);
    START(pA0, pA1);
    MAPPLY(pA0); MLOAD1(0); MAPPLY(pA1); MLOAD0(1);
    _Pragma("unroll") for (int r = 0; r < 16; ++r) { pA0[r] = __builtin_amdgcn_exp2f(pA0[r]); pA1[r] = __builtin_amdgcn_exp2f(pA1[r]); }
    WAIT_BAR(0);
    DMA_K(3, 0); DMA_V(1, SLOTB);
    ROT();
    kload8(kf, kp0 + sl_cur);
    WAIT_BAR(2);
    s16x4 vlo[8], vhi[8]; u32x4 pw0, pw1, pw2, pw3;
#define PKW(P, B) cvtpk_s(P[B], P[B + 1])
#define PAF(k) __builtin_bit_cast(bf16x8, pw##k)
#define VFR(i) (bf16x8){vlo[i][0], vlo[i][1], vlo[i][2], vlo[i][3], vhi[i][0], vhi[i][1], vhi[i][2], vhi[i][3]}
#define PIN(x) asm volatile("" : "+v"(x))
#define MX3(a, b, c) __builtin_fmaxf(__builtin_fmaxf((a), (b)), (c))
#define GAPA(MF, A0, A1, A2, A3, W0, W1, PW) do { MF; sacc += A0; sacc += A1; sacc += A2; sacc += A3; PIN(sacc); W0; W1; PIN(PW); SBAR(); } while (0)
#define EX(v) __builtin_amdgcn_exp2f(v)
#define GAPB(MF, X, B) do { MF; X[B] = EX(X[B]); X[B + 1] = EX(X[B + 1]); X[B + 2] = EX(X[B + 2]); X[B + 3] = EX(X[B + 3]); PIN(X); SBAR(); } while (0)
#define VRD(i) do { vlo[i] = vtr(vp_ + (((i) >> 2) * 4096 + ((i) & 3) * 1024)); vhi[i] = vtr(vp_ + (((i) >> 2) * 4096 + ((i) & 3) * 1024 + 512)); } while (0)
#define KRD(G, j) do { if (G) { kload2(kf, kp0 + sl_next, j); SBAR(); } } while (0)
#define STEP(C0, C1, P0, P1, t, GK, GV, GL, GM) do { SBAR(); \
    const lds_cptr vp_ = vp0 + sl_prev; \
    VRD(0); bf16x8 qa_ = QF(0), qb_ = QF(1); SBAR(); float sacc = (P0[0] + P0[1]); \
    GAPA(C0 = __builtin_amdgcn_mfma_f32_32x32x16_bf16(kf[0], qa_, negm, 0, 0, 0), P0[2], P0[3], P0[4], P0[5],     pw0[0] = PKW(P0, 0), pw0[1] = PKW(P0, 2), pw0); \
    VRD(4); SBAR(); GAPA(C1 = __builtin_amdgcn_mfma_f32_32x32x16_bf16(kf[1], qa_, negm, 0, 0, 0), P0[6], P0[7], P0[8], P0[9],     pw0[2] = PKW(P0, 4), pw0[3] = PKW(P0, 6), pw0); \
    VRD(1); qa_ = QF(2); SBAR(); GAPA(C0 = __builtin_amdgcn_mfma_f32_32x32x16_bf16(kf[2], qb_, C0, 0, 0, 0),   P0[10], P0[11], P0[12], P0[13], pw1[0] = PKW(P0, 8), pw1[1] = PKW(P0, 10), pw1); \
    VRD(5); SBAR(); GAPA(C1 = __builtin_amdgcn_mfma_f32_32x32x16_bf16(kf[3], qb_, C1, 0, 0, 0),   P0[14], P0[15], P1[0], P1[1],   pw1[2] = PKW(P0, 12), pw1[3] = PKW(P0, 14), pw1); \
    VRD(2); qb_ = QF(3); SBAR(); GAPA(C0 = __builtin_amdgcn_mfma_f32_32x32x16_bf16(kf[4], qa_, C0, 0, 0, 0),   P1[2], P1[3], P1[4], P1[5],     pw2[0] = PKW(P1, 0), pw2[1] = PKW(P1, 2), pw2); \
    VRD(6); SBAR(); GAPA(C1 = __builtin_amdgcn_mfma_f32_32x32x16_bf16(kf[5], qa_, C1, 0, 0, 0),   P1[6], P1[7], P1[8], P1[9],     pw2[2] = PKW(P1, 4), pw2[3] = PKW(P1, 6), pw2); \
    VRD(3); SBAR(); GAPA(C0 = __builtin_amdgcn_mfma_f32_32x32x16_bf16(kf[6], qb_, C0, 0, 0, 0),   P1[10], P1[11], P1[12], P1[13], pw3[0] = PKW(P1, 8), pw3[1] = PKW(P1, 10), pw3); \
    VRD(7); SBAR(); GAPA(C1 = __builtin_amdgcn_mfma_f32_32x32x16_bf16(kf[7], qb_, C1, 0, 0, 0),   P1[14], P1[15], 0.f, 0.f,       pw3[2] = PKW(P1, 12), pw3[3] = PKW(P1, 14), pw3); \
    l_reg += sacc; \
    if (GK) { DMA_K((t) + 3, sl_cur); } if (GV) { DMA_V((t) + 1, sl_next); } \
    CMASK(C0, C1, t); \
    { float a = MX3(C0[0], C0[1], C1[0]), b = MX3(C0[2], C0[3], C1[1]); a = MX3(a, C1[2], C1[3]); \
      _Pragma("unroll") for (int r = 4; r < 16; r += 4) { a = MX3(a, C0[r], C0[r + 1]); b = MX3(b, C0[r + 2], C0[r + 3]); a = MX3(a, C1[r], C1[r + 1]); b = MX3(b, C1[r + 2], C1[r + 3]); } \
      float rm = __builtin_fmaxf(a, b); { auto rr = __builtin_amdgcn_permlane32_swap(__float_as_uint(rm), __float_as_uint(rm), false, false); rm = __builtin_fmaxf(__uint_as_float(rr[0]), __uint_as_float(rr[1])); } \
      resc = false; \
      if (__builtin_expect(__any(rm > (float)THRL), 0)) { const float dl = __builtin_fmaxf(rm, 0.f); mhat += dl; \
        _Pragma("unroll") for (int r = 0; r < 16; ++r) { C0[r] -= dl; C1[r] -= dl; } \
        _Pragma("unroll") for (int r = 0; r < 16; ++r) negm[r] = -mhat; asm volatile("" : "+v"(negm)); \
        const float f = __builtin_amdgcn_exp2f(-dl); l_reg *= f; if (hi == 0) wsf[r32] = f; resc = true; } } \
    MAPPLY(C0); MLOAD1(t); \
    SBAR(); \
    GAPB(o[0] = __builtin_amdgcn_mfma_f32_32x32x16_bf16(PAF(0), VFR(0), o[0], 0, 0, 0), C0, 0); \
    GAPB(o[1] = __builtin_amdgcn_mfma_f32_32x32x16_bf16(PAF(0), VFR(4), o[1], 0, 0, 0), C0, 4); \
    KRD(GL, 0); GAPB(o[0] = __builtin_amdgcn_mfma_f32_32x32x16_bf16(PAF(1), VFR(1), o[0], 0, 0, 0), C0, 8); \
    KRD(GL, 1); GAPB(o[1] = __builtin_amdgcn_mfma_f32_32x32x16_bf16(PAF(1), VFR(5), o[1], 0, 0, 0), C0, 12); \
    MAPPLY(C1); if (GM) { MLOAD0((t) + 1); } SBAR(); \
    KRD(GL, 2); GAPB(o[0] = __builtin_amdgcn_mfma_f32_32x32x16_bf16(PAF(2), VFR(2), o[0], 0, 0, 0), C1, 0); \
    KRD(GL, 3); GAPB(o[1] = __builtin_amdgcn_mfma_f32_32x32x16_bf16(PAF(2), VFR(6), o[1], 0, 0, 0), C1, 4); \
    GAPB(o[0] = __builtin_amdgcn_mfma_f32_32x32x16_bf16(PAF(3), VFR(3), o[0], 0, 0, 0), C1, 8); \
    GAPB(o[1] = __builtin_amdgcn_mfma_f32_32x32x16_bf16(PAF(3), VFR(7), o[1], 0, 0, 0), C1, 12); \
    } while (0)
    int t = 1;
#undef CMASK
#define CMASK(P0, P1, t) do { } while (0)
    for (; t + 5 < NT; t += 2) {
        STEP(pB0, pB1, pA0, pA1, t, true, true, true, true);     WAIT_BAR(2); RESC(); ROT();
        STEP(pA0, pA1, pB0, pB1, t + 1, true, true, true, true); WAIT_BAR(2); RESC(); ROT();
    }
#undef CMASK
#define CMASK(P0, P1, t) do { int jb_ = (t) - (NT - 4); if (jb_ >= 0) cmask(P0, P1, jb_, qrel, hi); } while (0)
#define ENDW(tt) do { if ((tt) + 3 < NT) { WAIT_BAR(2); } else if ((tt) + 2 < NT) { WAIT_BAR(1); } else { WAIT_BAR(0); } } while (0)
    for (; t + 1 < NT; t += 2) {
        STEP(pB0, pB1, pA0, pA1, t, (t + 3 < NT), (t + 1 < NT), (t + 1 < NT), (t + 1 < NT));         ENDW(t);     RESC(); ROT();
        STEP(pA0, pA1, pB0, pB1, t + 1, (t + 4 < NT), (t + 2 < NT), (t + 2 < NT), (t + 2 < NT));     ENDW(t + 1); RESC(); ROT();
    }
    STEP(pB0, pB1, pA0, pA1, NT - 1, false, false, false, false); RESC();
    { float sacc = pB0[0] + pB0[1]; _Pragma("unroll") for (int r = 2; r < 16; ++r) sacc += pB0[r]; _Pragma("unroll") for (int r = 0; r < 16; ++r) sacc += pB1[r]; l_reg += sacc;
      pw0 = (u32x4){PKW(pB0, 0), PKW(pB0, 2), PKW(pB0, 4), PKW(pB0, 6)}; pw1 = (u32x4){PKW(pB0, 8), PKW(pB0, 10), PKW(pB0, 12), PKW(pB0, 14)}; pw2 = (u32x4){PKW(pB1, 0), PKW(pB1, 2), PKW(pB1, 4), PKW(pB1, 6)}; pw3 = (u32x4){PKW(pB1, 8), PKW(pB1, 10), PKW(pB1, 12), PKW(pB1, 14)};
      SBAR(); pv(o, vb0 + sl_cur, PAF(0), PAF(1), PAF(2), PAF(3)); }
#undef PKW
#undef PAF
#undef VFR
#undef PIN
#undef MX3
#undef GAPA
#undef GAPB
#undef EX
#undef VRD
#undef KRD
#undef STEP
#undef ENDW
    { auto rr = __builtin_amdgcn_permlane32_swap(__float_as_uint(l_reg), __float_as_uint(l_reg), false, false); l_reg = __uint_as_float(rr[0]) + __uint_as_float(rr[1]); }
    if (hi == 0) wsf[32 + r32] = l_reg; asm volatile("s_waitcnt lgkmcnt(0)" ::: "memory");
    float rli[16];
#pragma unroll
    for (int r = 0; r < 16; ++r) rli[r] = __builtin_amdgcn_rcpf(wsf[32 + crow(r, hi)]);
    bf16* Ow = O + (rowbase + q0 + wid * QBLK) * OP + OCOL + h * D;
    { bf16* stg = (bf16*)(shm + LDS_OST) + wid * 2048;
#pragma unroll
      for (int r = 0; r < 16; ++r) { const int orow = crow(r, hi);
#pragma unroll
        for (int d0 = 0; d0 < 2; ++d0) stg[orow * 64 + d0 * 32 + r32] = __float2bfloat16(o[d0][r] * rli[r]); }
      asm volatile("s_waitcnt lgkmcnt(0)" ::: "memory");
#pragma unroll
      for (int i = 0; i < 4; ++i) { const int row = i * 8 + (lane >> 3), ch = lane & 7; const u32x4 v = *(const u32x4*)(stg + row * 64 + ch * 8); ATTN_STORE16(Ow + (long)row * OP + ch * 8, v); } }
    asm volatile("s_waitcnt lgkmcnt(0)\n\ts_barrier" ::: "memory");
#undef DMA_K
#undef DMA_V
#undef CMASK
#undef START
#undef RESC
#undef ROT
#undef MLOAD0
#undef MLOAD1
#undef MPAIR
#undef QF
#undef MAPPLY
}
#undef SBAR
#undef WAIT_BAR
}

#define XB_TMO      128
#define XB_XCNT(j)  (256  + 64 * (j))
#define XB_XSUB(j)  (1280 + 64 * (j))
#define XB_XGEN(j)  (2304 + 64 * (j))
#define XB_TOP      3328
#define XB_TOPGEN   3392
#define XCD_BAR_WORDS 3456
#define XB_SPIN_CAP (1u << 18)
__device__ __forceinline__ unsigned xb_ld(unsigned* p)              { return __hip_atomic_load(p, __ATOMIC_RELAXED, __HIP_MEMORY_SCOPE_AGENT); }
__device__ __forceinline__ unsigned xb_add(unsigned* p, unsigned v) { return __hip_atomic_fetch_add(p, v, __ATOMIC_RELAXED, __HIP_MEMORY_SCOPE_AGENT); }
__device__ __forceinline__ unsigned xb_xcc_id() { return (unsigned)__builtin_amdgcn_s_getreg((3 << 11) | 20) & 0xFu; }
#define XB_SPIN(cond, bar) do { unsigned _sp = 0; while (cond) { __builtin_amdgcn_s_sleep(1); \
    if ((++_sp & 255u) == 0u) { if (xb_ld(&(bar)[XB_TMO])) break; if (_sp > XB_SPIN_CAP) { atomicAdd(&(bar)[XB_TMO], 1u); break; } } } } while (0)
struct XcdBarrier { unsigned* bar; unsigned x; volatile LAS unsigned* st; };
__device__ __forceinline__ XcdBarrier xcd_barrier_post(unsigned* bar, volatile LAS unsigned* st) {
    XcdBarrier b; b.bar = bar; b.x = xb_xcc_id(); b.st = st;
    if (threadIdx.x == 0) (void)xb_add(&bar[XB_XCNT(b.x)], 1u);
    return b;
}
__device__ __forceinline__ void xcd_barrier_complete(unsigned* bar, unsigned x, unsigned& nloc, unsigned& nx) {
    const unsigned G = gridDim.x * gridDim.y * gridDim.z;
    unsigned sum, cnt, mine, sp = 0u;
    for (;;) {
        sum = 0u; cnt = 0u; mine = 0u;
#pragma unroll
        for (unsigned j = 0; j < 16; ++j) { const unsigned c = xb_ld(&bar[XB_XCNT(j)]); sum += c; cnt += (c > 0u) ? 1u : 0u; mine = (j == x) ? c : mine; }
        if (sum == G) break;
        __builtin_amdgcn_s_sleep(1);
        if ((++sp & 255u) == 0u) { if (xb_ld(&bar[XB_TMO])) break; if (sp > XB_SPIN_CAP) { atomicAdd(&bar[XB_TMO], 1u); break; } }
    }
    nloc = mine > 0u ? mine : 1u; nx = cnt > 0u ? cnt : 1u;
}
__device__ __forceinline__ void xcd_barrier(const XcdBarrier& b) {
    asm volatile("s_waitcnt vmcnt(0)" ::: "memory");
    __syncthreads();
    if (threadIdx.x == 0) {
        unsigned* bar = b.bar;
        __builtin_amdgcn_s_waitcnt(0);
        unsigned nloc = b.st[0], nx = b.st[1];
        if (nloc == 0u) { xcd_barrier_complete(bar, b.x, nloc, nx); b.st[0] = nloc; b.st[1] = nx; }
        const unsigned old = xb_add(&bar[XB_XSUB(b.x)], 1u);
        const unsigned gen = old / nloc;
        if (old + 1u == (gen + 1u) * nloc) {
            __builtin_amdgcn_fence(__ATOMIC_RELEASE, "agent");
            asm volatile("s_waitcnt vmcnt(0)" ::: "memory");
            const unsigned og = xb_add(&bar[XB_TOP], 1u);
            const unsigned tg = og / nx;
            if (og + 1u == (tg + 1u) * nx) xb_add(&bar[XB_TOPGEN], 1u);
            else XB_SPIN(xb_ld(&bar[XB_TOPGEN]) == tg, bar);
            __builtin_amdgcn_fence(__ATOMIC_ACQUIRE, "agent");
            xb_add(&bar[XB_XGEN(b.x)], 1u);
            asm volatile("s_waitcnt vmcnt(0)" ::: "memory");
        } else {
            XB_SPIN(xb_ld(&bar[XB_XGEN(b.x)]) == gen, bar);
            __builtin_amdgcn_fence(__ATOMIC_ACQUIRE, "agent");
            asm volatile("s_waitcnt vmcnt(0)" ::: "memory");
        }
    }
    __syncthreads();
}

struct Frame {
    LAS unsigned char* lds; volatile LAS unsigned* MISC; unsigned* ctl;
    int tid, lane, wave, vcu, G;
    unsigned char* ws;
};
struct Args { const float* in[18]; float* out; unsigned char* ws; int ph_lo, ph_hi, flags, pad; };
typedef const __attribute__((address_space(4))) Args* KArgs;
__device__ __forceinline__ KArgs kargs() { KArgs p = (KArgs)__builtin_amdgcn_kernarg_segment_ptr(); asm volatile("" : "+s"(p)); return p; }

__device__ __forceinline__ int ropeperm(int d) { return d < 8 ? 2 * d : (d < 16 ? 2 * (d - 8) + 1 : d); }
__device__ __forceinline__ int win_row(int c) {
    if (c < 512)  return (c & ~63) + ropeperm(c & 63);
    if (c < 640)  { const int cc = c - 512; return 512 + (cc & ~63) + ropeperm(cc & 63); }
    if (c < 768)  return c;
    if (c < 1280) { const int cc = c - 768; return 768 + (cc & ~63) + ropeperm(cc & 63); }
    if (c < 1344) return 1280 + ropeperm(c - 1280);
    if (c < 1352) return c;
    if (c < 1864) { const int ch = c - 1352; return 1536 + (ch >> 7) * 256 + (ch & 127); }
    if (c < 2376) return 2560 + (c - 1864);
    if (c < 2888) { const int ch = c - 2376; return 1536 + (ch >> 7) * 256 + 128 + (ch & 127); }
    { const int g = c - 2888, gi = g & 1023; return 3072 + (gi >> 7) * 256 + (g >> 10) * 128 + (gi & 127); }
}
struct TItem { const float* src; bf16_t* WT; int N, KT, rbase, mode, n0, k0, kd; };
__device__ __forceinline__ void t_load(const TItem& t, float (&rg)[32], int lane) {
    int nn = t.n0 + (lane & 31); if (nn >= t.N) nn = t.N - 1;
    const float* p = t.src + (size_t)(t.k0 + (lane >> 5)) * t.N + nn;
#pragma unroll
    for (int i = 0; i < 32; ++i) rg[i] = __builtin_nontemporal_load(p + (size_t)(2 * i) * t.N);
}
__device__ __forceinline__ void t_write(const TItem& t, const float (&rg)[32], LAS float* scr, int lane) {
#pragma unroll
    for (int i = 0; i < 32; ++i) scr[(2 * i + (lane >> 5)) * 33 + (lane & 31)] = rg[i];
    LDS_WAIT(); asm volatile("" ::: "memory");
    if (t.mode >= 3) {
        const int c4 = lane & 3;
#pragma unroll
        for (int j = 0; j < 2; ++j) { const int n = (lane >> 2) + 16 * j; const LAS float* sp = scr + (16 * c4) * 33 + n;
            if (t.n0 + n < t.N) { const int nn = t.n0 + n; const int row = t.mode == 3 ? t.rbase + (nn >> 7) * 256 + (nn & 127) : t.rbase + nn;
                u32x4 o;
#pragma unroll
                for (int q = 0; q < 4; ++q) { int wv = 0;
                    wv = __builtin_amdgcn_cvt_pk_fp8_f32(32.f * sp[(4 * q + 0) * 33], 32.f * sp[(4 * q + 1) * 33], wv, false);
                    wv = __builtin_amdgcn_cvt_pk_fp8_f32(32.f * sp[(4 * q + 2) * 33], 32.f * sp[(4 * q + 3) * 33], wv, true); o[q] = (unsigned)wv; }
                *(u32x4*)((unsigned char*)t.WT + (size_t)row * t.KT + t.k0 + 16 * c4) = o; } }
        LDS_WAIT(); asm volatile("" ::: "memory");
        return;
    }
    const int c = lane & 7;
#pragma unroll
    for (int j = 0; j < 4; ++j) { const int n = (lane >> 3) + 8 * j; const LAS float* sp = scr + (8 * c) * 33 + n;
        if (t.n0 + n < t.N) { const int nn = t.n0 + n; const int row = t.mode == 0 ? t.rbase + nn : (t.mode == 1 ? win_row(nn) : t.rbase + (nn >> 7) * 256 + (nn & 127));
            u32x4 o; o.x = pkbf(sp[0 * 33], sp[1 * 33]); o.y = pkbf(sp[2 * 33], sp[3 * 33]); o.z = pkbf(sp[4 * 33], sp[5 * 33]); o.w = pkbf(sp[6 * 33], sp[7 * 33]);
            *(u32x4*)(t.WT + (size_t)row * t.KT + t.kd + t.k0 + 8 * c) = o; } }
    LDS_WAIT(); asm volatile("" ::: "memory");
}
__device__ __forceinline__ void p0_prologue(Frame& F) {
    const KArgs ka = kargs();
    unsigned char* ws = F.ws;
    LAS float* scr = (LAS float*)(F.lds + F.wave * 16384);
    const int gw = F.vcu * NWAVES + F.wave, NGW = F.G * NWAVES;
    const int gt = F.vcu * 512 + F.tid, NGT = F.G * 512;
    bf16_t* Win = (bf16_t*)(ws + WS_WIN); bf16_t* Wau = (bf16_t*)(ws + WS_WAU); bf16_t* Wout = (bf16_t*)(ws + WS_WOUT);
    bf16_t* Wd = (bf16_t*)(ws + WS_WD); bf16_t* Wgu = (bf16_t*)(ws + WS_WGU);
    constexpr int I_IN = 16 * 155, I_AU = 8 * 32, I_OUT = 16 * 32, I_G = 32 * 16 * 16, I_D = 32 * 8 * 32;
    constexpr int NITEMS = I_IN + 2 * I_AU + I_OUT + 2 * I_G + I_D;
    const float *p_win = ka->in[1], *p_wau = ka->in[3], *p_wcu = ka->in[4], *p_wout = ka->in[6], *p_wg = ka->in[13], *p_wu = ka->in[14], *p_wd = ka->in[15];
#define T_DECODE(IT, T) do { int r_ = (IT); \
        if (r_ < I_IN) { T = TItem{p_win, Win, INW, 1024, 0, 1, 32 * (r_ % 155), 64 * (r_ / 155), 0}; } else { r_ -= I_IN; \
        if (r_ < I_AU) { T = TItem{p_wau, Wau, 1024, 1024, 0, 0, 32 * (r_ % 32), 64 * (r_ / 32), 512};     } else { r_ -= I_AU; \
        if (r_ < I_AU) { T = TItem{p_wcu, Wau, 1024, 1024, 0, 0, 32 * (r_ % 32), 64 * (r_ / 32), 0}; } else { r_ -= I_AU; \
        if (r_ < I_OUT) { T = TItem{p_wout, Wout, 1024, 1024, 0, 0, 32 * (r_ % 32), 64 * (r_ / 32), 0}; } else { r_ -= I_OUT; \
        if (r_ < I_G) { const int e_ = r_ >> 8, q_ = r_ & 255; T = TItem{p_wg + (size_t)e_ * 1024 * 512, Wgu, 512, 1024, e_ * 1024, 3, 32 * (q_ & 15), 64 * (q_ >> 4), 0}; } else { r_ -= I_G; \
        if (r_ < I_G) { const int e_ = r_ >> 8, q_ = r_ & 255; T = TItem{p_wu + (size_t)e_ * 1024 * 512, Wgu, 512, 1024, e_ * 1024 + 128, 3, 32 * (q_ & 15), 64 * (q_ >> 4), 0}; } else { r_ -= I_G; \
        { const int e_ = r_ >> 8, q_ = r_ & 255; T = TItem{p_wd + (size_t)e_ * 512 * 1024, Wd, 1024, 512, e_ * 1024, 4, 32 * (q_ & 31), 64 * (q_ >> 5), 0}; } } } } } } } } while (0)
    const int nitems = (F.G == 256) ? I_IN + 2 * I_AU + I_OUT : NITEMS;
    if (gw < nitems) {
        TItem cur, nxt; float rc[32], rn[32];
        T_DECODE(gw, cur); t_load(cur, rc, F.lane);
        for (int it = gw; it < nitems; it += NGW) {
            const int itn = (it + NGW < nitems) ? it + NGW : it;
            T_DECODE(itn, nxt); t_load(nxt, rn, F.lane);
            t_write(cur, rc, scr, F.lane);
            cur = nxt;
#pragma unroll
            for (int i = 0; i < 32; ++i) rc[i] = rn[i];
        }
    }
#undef T_DECODE
    for (int i = gt; i < 184 * 128; i += NGT) *(u32x4*)(Win + (size_t)1352 * 1024 + (size_t)i * 8) = (u32x4){0u, 0u, 0u, 0u};
    float* rope = (float*)(ws + WS_ROPE);
    for (int i = gt; i < SEQ * 8; i += NGT) { const int pos = i >> 3, j = i & 7;
        const float inv = (float)pow(500000.0, -(double)j / 8.0); const float ang = (float)pos * inv;
        rope[i] = cosf(ang); rope[SEQ * 8 + i] = sinf(ang); }
    { float* wc = (float*)(ws + WS_WC); const float* rgw = ka->in[9]; const float* rew = ka->in[11];
      for (int i = gt; i < 1024 * 48; i += NGT) { const int k = i / 48, c = i % 48;
          wc[i] = c < 4 ? rgw[k * 4 + c] : (c < 36 ? rew[(size_t)((c - 4) >> 3) * 1024 * 8 + k * 8 + ((c - 4) & 7)] : 0.f); } }
    const float* x = ka->in[0]; bf16_t* xb = (bf16_t*)(ws + WS_XB);
    for (size_t i = gt; i < (size_t)NTOK * DM / 8; i += (size_t)NGT * 4) {
        f32x4 va[4], vb[4];
#pragma unroll
        for (int q = 0; q < 4; ++q) { size_t ii = i + (size_t)q * NGT; if (ii >= (size_t)NTOK * DM / 8) ii = i; va[q] = __builtin_nontemporal_load((const f32x4*)(x + ii * 8)); vb[q] = __builtin_nontemporal_load((const f32x4*)(x + ii * 8 + 4)); }
#pragma unroll
        for (int q = 0; q < 4; ++q) { const size_t ii = i + (size_t)q * NGT; if (ii < (size_t)NTOK * DM / 8) store8bf(xb + ii * 8, va[q], vb[q]); } }
}

__device__ __forceinline__ int dpp_sum_i(int v) {
    v += __builtin_amdgcn_update_dpp(0, v, 0x111, 0xf, 0xf, true); v += __builtin_amdgcn_update_dpp(0, v, 0x112, 0xf, 0xf, true);
    v += __builtin_amdgcn_update_dpp(0, v, 0x114, 0xf, 0xf, true); v += __builtin_amdgcn_update_dpp(0, v, 0x118, 0xf, 0xf, true);
    return __builtin_amdgcn_readlane(v, 15) + __builtin_amdgcn_readlane(v, 31) + __builtin_amdgcn_readlane(v, 47) + __builtin_amdgcn_readlane(v, 63);
}
__device__ __forceinline__ float dpp_shr_f(float v, int ctrl_sel) {
    const int vi = __float_as_int(v);
    return __int_as_float(ctrl_sel == 1 ? __builtin_amdgcn_update_dpp(vi, vi, 0x111, 0xf, 0xf, false) : ctrl_sel == 2 ? __builtin_amdgcn_update_dpp(vi, vi, 0x112, 0xf, 0xf, false)
                        : ctrl_sel == 4 ? __builtin_amdgcn_update_dpp(vi, vi, 0x114, 0xf, 0xf, false) : __builtin_amdgcn_update_dpp(vi, vi, 0x118, 0xf, 0xf, false));
}
__device__ __forceinline__ float dpp_max_f(float v) {
    v = fmaxf(v, dpp_shr_f(v, 1)); v = fmaxf(v, dpp_shr_f(v, 2)); v = fmaxf(v, dpp_shr_f(v, 4)); v = fmaxf(v, dpp_shr_f(v, 8));
    const float a = __int_as_float(__builtin_amdgcn_readlane(__float_as_int(v), 15)), b = __int_as_float(__builtin_amdgcn_readlane(__float_as_int(v), 31));
    const float c = __int_as_float(__builtin_amdgcn_readlane(__float_as_int(v), 47)), d = __int_as_float(__builtin_amdgcn_readlane(__float_as_int(v), 63));
    return fmaxf(fmaxf(a, b), fmaxf(c, d));
}
__device__ __forceinline__ float dpp_min_f(float v) { return -dpp_max_f(-v); }
__device__ __forceinline__ float dpp_sum_f(float v) {
    v += __int_as_float(__builtin_amdgcn_update_dpp(0, __float_as_int(v), 0x111, 0xf, 0xf, true)); v += __int_as_float(__builtin_amdgcn_update_dpp(0, __float_as_int(v), 0x112, 0xf, 0xf, true));
    v += __int_as_float(__builtin_amdgcn_update_dpp(0, __float_as_int(v), 0x114, 0xf, 0xf, true)); v += __int_as_float(__builtin_amdgcn_update_dpp(0, __float_as_int(v), 0x118, 0xf, 0xf, true));
    const float a = __int_as_float(__builtin_amdgcn_readlane(__float_as_int(v), 15)), b = __int_as_float(__builtin_amdgcn_readlane(__float_as_int(v), 31));
    const float c = __int_as_float(__builtin_amdgcn_readlane(__float_as_int(v), 47)), d = __int_as_float(__builtin_amdgcn_readlane(__float_as_int(v), 63));
    return (a + b) + (c + d);
}
template <int NC>
__device__ __forceinline__ void select_token(const LAS float* srow, int t, int lane, unsigned tbit, LAS unsigned* maskw) {
    if (t < 256) {
#pragma unroll
        for (int c = 0; c < (NC < 4 ? NC : 4); ++c) if (64 * c + lane <= t) (void)__hip_atomic_fetch_or(maskw + 64 * c + lane, tbit, __ATOMIC_RELAXED, __HIP_MEMORY_SCOPE_WORKGROUP);
        return;
    }
    float x[NC];
#pragma unroll
    for (int c = 0; c < NC; ++c) x[c] = srow[64 * c + lane];
#pragma unroll
    for (int c = 4; c < NC; ++c) if (64 * c + 63 > t) x[c] = (64 * c + lane <= t) ? x[c] : -INFINITY;
    float mn = fminf(fminf(x[0], x[1]), fminf(x[2], x[3])), mx = -INFINITY;
#pragma unroll
    for (int c = 0; c < NC; ++c) mx = fmaxf(mx, x[c]);
    mn = dpp_min_f(mn);
    float lo = mn - (fabsf(mn) * 1e-6f + 1e-30f), hi = dpp_max_f(mx);
    const float BIGF = 0x1p100f;
#define COUNT_GT(P, OUT) do { const float nb1_ = -(P) * BIGF; const f32x2 nb_ = {nb1_, nb1_}, bg_ = {BIGF, BIGF}; f32x2 a0_ = {0.f, 0.f}, a1_ = {0.f, 0.f}, a2_ = {0.f, 0.f}, a3_ = {0.f, 0.f}; \
        _Pragma("unroll") for (int c = 0; c < NC; c += 8) { f32x2 y_[4]; \
            _Pragma("unroll") for (int e = 0; e < 4; ++e) { const f32x2 xx_ = {x[c + 2 * e], x[c + 2 * e + 1]}; asm("v_pk_fma_f32 %0, %1, %2, %3 clamp" : "=v"(y_[e]) : "v"(xx_), "v"(bg_), "v"(nb_)); } \
            a0_ += y_[0]; a1_ += y_[1]; a2_ += y_[2]; a3_ += y_[3]; } \
        const f32x2 s2_ = (a0_ + a1_) + (a2_ + a3_); OUT = (int)(dpp_sum_f(s2_[0] + s2_[1]) + 0.5f); } while (0)
    float tau = hi; int need = 256; bool exact = false;
#ifndef PROBE_SEL
#define PROBE_SEL 0
#endif
    {
        float glo = (float)(t + 1) - 255.5f, ghi = -255.5f; int side = 0;
        for (int it = 0; it < 200; ++it) {
            float p = lo + (hi - lo) * (glo * __builtin_amdgcn_rcpf(glo - ghi));
            if (it >= 48 || !(p > lo) || !(p < hi)) p = lo + (hi - lo) * 0.5f;
            if (!(p > lo) || !(p < hi)) break;
            int cm; COUNT_GT(p, cm);
            if (cm == 256) { tau = p; exact = true; break; }
            if (cm > 256) { lo = p; glo = (float)cm - 255.5f; if (side < 0) ghi *= 0.5f; side = -1; }
            else { hi = p; ghi = (float)cm - 255.5f; if (side > 0) glo *= 0.5f; side = 1; }
        }
        if (!exact) { tau = hi; int g; COUNT_GT(hi, g); need = 256 - g; }
    }
#undef COUNT_GT
    if (exact) {
#pragma unroll
        for (int c = 0; c < NC; ++c) (void)__hip_atomic_fetch_or(maskw + 64 * c + lane, (x[c] > tau) ? tbit : 0u, __ATOMIC_RELAXED, __HIP_MEMORY_SCOPE_WORKGROUP);
    } else {
        int base = 0;
#pragma unroll
        for (int c = 0; c < NC; ++c) {
            const bool gt = x[c] > tau, eq = x[c] == tau;
            const unsigned long long tb = __ballot(eq);
            const int rank = base + (int)__builtin_amdgcn_mbcnt_hi((unsigned)(tb >> 32), __builtin_amdgcn_mbcnt_lo((unsigned)tb, 0u));
            base += __popcll(tb);
            if (gt || (eq && rank < need)) (void)__hip_atomic_fetch_or(maskw + 64 * c + lane, tbit, __ATOMIC_RELAXED, __HIP_MEMORY_SCOPE_WORKGROUP);
        }
    }
}
struct XItem { const float* src; unsigned char* dst; int N; };
__device__ __forceinline__ XItem x_decode(int id, int lane, const float* wg, const float* wu, const float* wd, unsigned char* Wgu8, unsigned char* Wd8) {
    const int m = id >> 13, r = id & 8191, e = r >> 8, q = r & 255; XItem t;
    if (m < 2) { const int kb = q >> 3, nb = q & 7, n = nb * 64 + lane;
        t.src = (m == 0 ? wg : wu) + (size_t)e * 1024 * 512 + (size_t)(kb * 32) * 512 + nb * 64; t.N = 512;
        t.dst = Wgu8 + (size_t)(e * 1024 + (n >> 7) * 256 + m * 128 + (n & 127)) * 1024 + kb * 32; }
    else { const int kb = q >> 4, nb = q & 15, n = nb * 64 + lane;
        t.src = wd + (size_t)e * 512 * 1024 + (size_t)(kb * 32) * 1024 + nb * 64; t.N = 1024;
        t.dst = Wd8 + (size_t)(e * 1024 + n) * 512 + kb * 32; }
    return t;
}
__device__ __forceinline__ void x_load(const XItem& t, float (&rg)[32], int lane) {
    unsigned voff = (unsigned)lane * 4u; const unsigned stride = (unsigned)t.N * 4u; const float* base = t.src;
#define XL_(i) "global_load_dword %" #i ", %16, %17 nt\n\tv_add_u32_e32 %16, %18, %16\n\t"
#define XL16_ XL_(0) XL_(1) XL_(2) XL_(3) XL_(4) XL_(5) XL_(6) XL_(7) XL_(8) XL_(9) XL_(10) XL_(11) XL_(12) XL_(13) XL_(14) XL_(15)
    asm volatile(XL16_ : "=&v"(rg[0]), "=&v"(rg[1]), "=&v"(rg[2]), "=&v"(rg[3]), "=&v"(rg[4]), "=&v"(rg[5]), "=&v"(rg[6]), "=&v"(rg[7]), "=&v"(rg[8]), "=&v"(rg[9]), "=&v"(rg[10]), "=&v"(rg[11]), "=&v"(rg[12]), "=&v"(rg[13]), "=&v"(rg[14]), "=&v"(rg[15]), "+v"(voff) : "s"(base), "s"(stride));
    asm volatile(XL16_ : "=&v"(rg[16]), "=&v"(rg[17]), "=&v"(rg[18]), "=&v"(rg[19]), "=&v"(rg[20]), "=&v"(rg[21]), "=&v"(rg[22]), "=&v"(rg[23]), "=&v"(rg[24]), "=&v"(rg[25]), "=&v"(rg[26]), "=&v"(rg[27]), "=&v"(rg[28]), "=&v"(rg[29]), "=&v"(rg[30]), "=&v"(rg[31]), "+v"(voff) : "s"(base), "s"(stride));
#undef XL16_
#undef XL_
}
__device__ __forceinline__ void x_store(const XItem& t, float (&rg)[32]) {
    asm volatile("s_waitcnt vmcnt(0)" ::: "memory");
#pragma unroll
    for (int i = 0; i < 32; ++i) asm volatile("" : "+v"(rg[i]));
    u32x4 o0, o1;
#pragma unroll
    for (int q = 0; q < 4; ++q) { int w0 = 0, w1 = 0;
        w0 = __builtin_amdgcn_cvt_pk_fp8_f32(32.f * rg[4 * q], 32.f * rg[4 * q + 1], w0, false); w0 = __builtin_amdgcn_cvt_pk_fp8_f32(32.f * rg[4 * q + 2], 32.f * rg[4 * q + 3], w0, true);
        w1 = __builtin_amdgcn_cvt_pk_fp8_f32(32.f * rg[16 + 4 * q], 32.f * rg[16 + 4 * q + 1], w1, false); w1 = __builtin_amdgcn_cvt_pk_fp8_f32(32.f * rg[16 + 4 * q + 2], 32.f * rg[16 + 4 * q + 3], w1, true);
        o0[q] = (unsigned)w0; o1[q] = (unsigned)w1; }
    *(u32x4*)t.dst = o0; *(u32x4*)(t.dst + 16) = o1;
}
struct P2Carry { bf16x8 bfA[4]; float w; };
#define KI_LD4(DST, KBU, KLO, KN) do { const char* ks_ = (KBU) + (size_t)(KN) * 32768; asm volatile("" : "+s"(ks_)); \
            _Pragma("unroll") for (int kk = 0; kk < 4; ++kk) DST[kk] = *(const GAS bf16x8*)((const GAS char*)ks_ + (KLO) + 1024 * kk); } while (0)
__device__ __forceinline__ void p2_request(Frame& F, int b, int qt16, const bf16_t* qi, const bf16_t* ki, const float* wi, P2Carry& C) {
    const int lane = F.lane, wid = F.wave, r = lane & 31, h = lane >> 5;
    const int T0 = qt16 * 16; const size_t rowb = (size_t)b * SEQ;
    const int tk = (r >> 4) + 2 * ((r >> 2) & 1), hd = (r & 3) + 4 * ((r >> 3) & 1);
    const char* kbu = (const char*)(ki + (rowb >> 5) * 2048 + (size_t)wid * 2048); const unsigned klo = (unsigned)(r * 16 + h * 8) * 2u;
    asm volatile("global_load_dwordx4 %0, %4, %5\n\tglobal_load_dwordx4 %1, %4, %5 offset:1024\n\tglobal_load_dwordx4 %2, %4, %5 offset:2048\n\tglobal_load_dwordx4 %3, %4, %5 offset:3072"
                 : "=&v"(C.bfA[0]), "=&v"(C.bfA[1]), "=&v"(C.bfA[2]), "=&v"(C.bfA[3]) : "v"(klo), "s"(kbu));
    { const bf16_t* qp = qi + (rowb + T0 + tk) * 512 + hd * 64 + 8 * h;
#pragma unroll
      for (int jj = 0; jj < 2; ++jj) { const int j = 2 * wid + jj, rb = j >> 2, kk = j & 3;
          attn_body::glds16(qp + rb * 2048 + 16 * kk, (unsigned)__builtin_amdgcn_readfirstlane((int)(unsigned)(size_t)(F.lds + QIF_OFF + j * 1024))); } }
    { const float* wb = wi + (rowb + T0) * 8; const unsigned wo = (unsigned)(F.tid & 127) * 4u;
      asm volatile("global_load_dword %0, %1, %2" : "=&v"(C.w) : "v"(wo), "s"(wb)); }
}
__device__ __forceinline__ void p2_pin(P2Carry& C) { asm volatile("" : "+v"(C.bfA[0]), "+v"(C.bfA[1]), "+v"(C.bfA[2]), "+v"(C.bfA[3]), "+v"(C.w)); }
__device__ __forceinline__ void p2_wtab(Frame& F, P2Carry& C) {
    if (F.tid < 128) ((LAS float*)(F.lds + TAB_OFF + 8192))[F.tid] = C.w * WSCALE;
}
__device__ __forceinline__ void score_select_unit(Frame& F, int b, int qt16, int nb, int nqt16, P2Carry& C, const bf16_t* qi, const bf16_t* ki, const float* wi, LAS float* scl, LAS unsigned* maskw, unsigned* masks, int xid0, int xid1) {
    const int lane = F.lane, wid = F.wave, r = lane & 31, h = lane >> 5;
    const int T0 = qt16 * 16; const size_t rowb = (size_t)b * SEQ;
    XItem xa, xb; float xr0[32], xr1[32];
    { const KArgs ka = kargs(); unsigned char* w8a = F.ws + WS_WGU; unsigned char* w8b = F.ws + WS_WD;
      xa = x_decode(xid0 >= 0 ? xid0 : 0, lane, ka->in[13], ka->in[14], ka->in[15], w8a, w8b); xb = x_decode(xid1 >= 0 ? xid1 : 0, lane, ka->in[13], ka->in[14], ka->in[15], w8a, w8b); }
    {
        const LAS float* wtab = (const LAS float*)(F.lds + TAB_OFF + 8192);
        bf16x8 a[4][4]; bf16x8 (&bfA)[4] = C.bfA; bf16x8 bfB[4];
#pragma unroll
        for (int rb = 0; rb < 4; ++rb)
#pragma unroll
            for (int kk = 0; kk < 4; ++kk) a[rb][kk] = *(const LAS bf16x8*)(F.lds + QIF_OFF + (rb * 4 + kk) * 1024 + lane * 16);
        const int nsteps = ((T0 + 15) >> 8) + 1, kb0 = 32 * wid;
        const char* kbu = (const char*)(ki + (rowb >> 5) * 2048 + (size_t)wid * 2048);
        const unsigned klo = (unsigned)(r * 16 + h * 8) * 2u;
        const LAS float* wl = wtab + 16 * h;
#define SCORE_STEP(KS, BF) do { const int kb_ = 256 * (KS) + kb0; if (kb_ <= T0 + 15) { \
            _Pragma("unroll") for (int rb = 0; rb < 4; ++rb) { \
                f32x16 acc = f32x16{}; \
                _Pragma("unroll") for (int kk = 0; kk < 4; ++kk) acc = __builtin_amdgcn_mfma_f32_32x32x16_bf16(a[rb][kk], BF[kk], acc, 0, 0, 0); \
                const f32x4 w0_ = *(const LAS f32x4*)(wl + 32 * rb), w1_ = *(const LAS f32x4*)(wl + 32 * rb + 4), w2_ = *(const LAS f32x4*)(wl + 32 * rb + 8), w3_ = *(const LAS f32x4*)(wl + 32 * rb + 12); \
                float s0 = 0.f, s1 = 0.f; \
                _Pragma("unroll") for (int reg = 0; reg < 4; ++reg) {     \
                    const float y0_ = __int_as_float(max(__float_as_int(acc[reg]), 0)), y1_ = __int_as_float(max(__float_as_int(acc[reg + 4]), 0)); \
                    const float y2_ = __int_as_float(max(__float_as_int(acc[reg + 8]), 0)), y3_ = __int_as_float(max(__float_as_int(acc[reg + 12]), 0)); \
                    s0 += w0_[reg] * y0_; s0 += w1_[reg] * y1_; s1 += w2_[reg] * y2_; s1 += w3_[reg] * y3_; } \
                LAS float* sp = scl + (4 * rb + 2 * h) * 2048 + kb_ + r; \
                sp[0] = s0; sp[2048] = s1; } } } while (0)
        for (int ks = 0; ks < nsteps; ks += 2) {
            { const int kn = (ks + 1 < 8) ? ks + 1 : 7;
              KI_LD4(bfB, kbu, klo, kn); }
            SCORE_STEP(ks, bfA);
            if (ks + 2 < nsteps) KI_LD4(bfA, kbu, klo, ks + 2);
            if (ks + 1 < nsteps) SCORE_STEP(ks + 1, bfB);
        }
#undef SCORE_STEP
    }
    if (F.tid == 0) *(LAS int*)(F.lds + TAB_OFF + 8192 + 512) = 0;
    LDS_WAIT(); __syncthreads();
    p2_request(F, nb, nqt16, qi, ki, wi, C);
    if (xid0 >= 0) x_load(xa, xr0, lane);
    if (xid1 >= 0) x_load(xb, xr1, lane);
#ifndef PROBE_P2
#define PROBE_P2 0
#endif
    LAS int* tokctr = (LAS int*)(F.lds + TAB_OFF + 8192 + 512);
#pragma unroll 1
    for (;;) {
        int tl = 0; if (lane == 0) tl = __hip_atomic_fetch_add(tokctr, 1, __ATOMIC_RELAXED, __HIP_MEMORY_SCOPE_WORKGROUP);
        tl = __builtin_amdgcn_readfirstlane(tl);
        if (tl >= 16) break;
        const int t = T0 + tl, nch = (t >> 6) + 1;
        const unsigned tbit = 1u << tl; const LAS float* srow = scl + tl * 2048;
        if (nch <= 8) select_token<8>(srow, t, lane, tbit, maskw);
        else if (nch <= 16) select_token<16>(srow, t, lane, tbit, maskw);
        else if (nch <= 24) select_token<24>(srow, t, lane, tbit, maskw);
        else select_token<32>(srow, t, lane, tbit, maskw);
    }
    if (xid0 >= 0) x_store(xa, xr0);
    if (xid1 >= 0) x_store(xb, xr1);
    VM_WAIT(); p2_pin(C);
    p2_wtab(F, C);
    LDS_WAIT(); __syncthreads();
    {
        const int ktmax = (T0 + 15) >> 6; unsigned short* mbase = (unsigned short*)(masks + ((size_t)(b * (SEQ / 32) + (qt16 >> 1)) * (SEQ / 64)) * 64) + (qt16 & 1);
#pragma unroll
        for (int jj = 0; jj < 4; ++jj) { const int key = F.tid + 512 * jj, kt = key >> 6, kap = key & 63;
            const unsigned wv = maskw[key]; maskw[key] = 0u;
            if (kt <= ktmax) { const int half = kap >> 5, k5 = kap & 31, hi_ = (k5 >> 2) & 1, rr = (k5 & 3) + 4 * (k5 >> 3); mbase[2 * (kt * 64 + 32 * half + 2 * rr + hi_)] = (unsigned short)wv; } }
    }
}
#undef KI_LD4
__device__ __forceinline__ void conv_pass(Frame& F, const bf16_t* u, const bf16_t* cb, const float* cw, bf16_t* conv) {
    const int gt = F.vcu * 512 + F.tid, NGT = F.G * 512;
    for (int idx = gt; idx < NTOK * 64; idx += NGT) {
        const int tok = idx >> 6, cg = (idx & 63) * 8, pos = tok & (SEQ - 1);
        const u32x4 z = (u32x4){0u, 0u, 0u, 0u};
        const u32x4 u0 = *(const u32x4*)(u + (size_t)tok * 512 + cg);
        const u32x4 u1 = pos >= 1 ? *(const u32x4*)(u + (size_t)(tok - 1) * 512 + cg) : z;
        const u32x4 u2 = pos >= 2 ? *(const u32x4*)(u + (size_t)(tok - 2) * 512 + cg) : z;
        const u32x4 bv = __builtin_nontemporal_load((const u32x4*)(cb + (size_t)tok * 512 + cg));
        const f32x4 w0a = *(const f32x4*)(cw + cg), w0b = *(const f32x4*)(cw + cg + 4);
        const f32x4 w1a = *(const f32x4*)(cw + 512 + cg), w1b = *(const f32x4*)(cw + 512 + cg + 4);
        const f32x4 w2a = *(const f32x4*)(cw + 1024 + cg), w2b = *(const f32x4*)(cw + 1024 + cg + 4);
        f32x4 ya, yb;
#define CV(E, WA, I, WORD, HALF) (WA[I] * (HALF ? bfhi(E.WORD) : bflo(E.WORD)))
        ya[0] = bflo(bv.x) * (CV(u2, w0a, 0, x, 0) + CV(u1, w1a, 0, x, 0) + CV(u0, w2a, 0, x, 0));
        ya[1] = bfhi(bv.x) * (CV(u2, w0a, 1, x, 1) + CV(u1, w1a, 1, x, 1) + CV(u0, w2a, 1, x, 1));
        ya[2] = bflo(bv.y) * (CV(u2, w0a, 2, y, 0) + CV(u1, w1a, 2, y, 0) + CV(u0, w2a, 2, y, 0));
        ya[3] = bfhi(bv.y) * (CV(u2, w0a, 3, y, 1) + CV(u1, w1a, 3, y, 1) + CV(u0, w2a, 3, y, 1));
        yb[0] = bflo(bv.z) * (CV(u2, w0b, 0, z, 0) + CV(u1, w1b, 0, z, 0) + CV(u0, w2b, 0, z, 0));
        yb[1] = bfhi(bv.z) * (CV(u2, w0b, 1, z, 1) + CV(u1, w1b, 1, z, 1) + CV(u0, w2b, 1, z, 1));
        yb[2] = bflo(bv.w) * (CV(u2, w0b, 2, w, 0) + CV(u1, w1b, 2, w, 0) + CV(u0, w2b, 2, w, 0));
        yb[3] = bfhi(bv.w) * (CV(u2, w0b, 3, w, 1) + CV(u1, w1b, 3, w, 1) + CV(u0, w2b, 3, w, 1));
#undef CV
        store8bf(conv + (size_t)tok * 1024 + cg, ya, yb);
    }
}

constexpr int P7_HS = 1032;
constexpr int P7_H = 0, P7_HL = 16 * P7_HS * 2, P7_P = 2 * 16 * P7_HS * 2, P7_L = P7_P + 8 * 16 * 48 * 4, P7_R = P7_L + 16 * 48 * 4, P7_END = P7_R + 6 * 128 * 4 + 2 * 32 * 4;
static_assert(P7_END <= RING_BYTES && (P7_P % 16) == 0, "P7 LDS map");
__device__ __forceinline__ void ln1_router(Frame& F, bool dry) {
    const KArgs a = kargs();
    unsigned char* ws = F.ws;
    const float* xin = a->in[0]; const bf16_t* mixb = (const bf16_t*)(ws + WS_MIX); bf16_t* h1b = dry ? (bf16_t*)(ws + WS_GATES) : (bf16_t*)(ws + WS_PRE);
    int* lists = (int*)(ws + (dry ? WS_MERGED : WS_LIST)); unsigned* tokinfo = (unsigned*)(ws + (dry ? WS_MERGED + 8 * MiB : WS_TOKINFO)); const int cbank = dry ? 64 * NEXP : 0;
    unsigned char* h1q = ws + (dry ? WS_MERGED + 16 * MiB : WS_H1Q);
    const float *g1 = a->in[7], *b1 = a->in[8], *rgb = a->in[10], *reb = a->in[12]; const float* wc = (const float*)(ws + WS_WC);
    const int lane = F.lane, wid = F.wave, tid = F.tid;
    LAS bf16_t* Hh = (LAS bf16_t*)(F.lds + P7_H); LAS bf16_t* Hl = (LAS bf16_t*)(F.lds + P7_HL); LAS float* P = (LAS float*)(F.lds + P7_P); LAS float* L = (LAS float*)(F.lds + P7_L);
    LAS int* RE = (LAS int*)(F.lds + P7_R);
    LAS int* hist = RE + 768; LAS int* basev = RE + 800;
    if (tid < 64) hist[tid] = 0;
    f32x4 gv[4], bv[4];
#pragma unroll
    for (int j = 0; j < 4; ++j) { gv[j] = *(const f32x4*)(g1 + 4 * lane + 256 * j); bv[j] = *(const f32x4*)(b1 + 4 * lane + 256 * j); }
    bf16x8 bhi[4][3], blo[4][3];
    { const int kq = lane >> 4, jn = lane & 15; const float* wp = wc + (size_t)(128 * wid + 8 * kq) * 48 + jn;
#pragma unroll
      for (int sidx = 0; sidx < 4; ++sidx)
#pragma unroll
          for (int cb = 0; cb < 3; ++cb) { u32x4 ph, pl;
#pragma unroll
              for (int jp = 0; jp < 4; ++jp) { const float w0 = wp[(size_t)(32 * sidx + 2 * jp) * 48 + 16 * cb], w1 = wp[(size_t)(32 * sidx + 2 * jp + 1) * 48 + 16 * cb];
                  const unsigned hh = pkbf(w0, w1); ph[jp] = hh; pl[jp] = pkbf(w0 - bflo(hh), w1 - bfhi(hh)); }
              bhi[sidx][cb] = __builtin_bit_cast(bf16x8, ph); blo[sidx][cb] = __builtin_bit_cast(bf16x8, pl); } }
    const int ngrp_total = NTOK / 16;
#pragma unroll 1
    for (int gi = F.vcu * 8; gi < ngrp_total; gi += F.G * 8) {
      f32x4 vn[2][4]; u32x2 mn[2][4];
#pragma unroll
      for (int rr = 0; rr < 2; ++rr)
#pragma unroll
          for (int j = 0; j < 4; ++j) { const size_t o_ = (size_t)(gi * 16 + 2 * wid + rr) * DM + 4 * lane + 256 * j; vn[rr][j] = __builtin_nontemporal_load((const f32x4*)(xin + o_)); mn[rr][j] = __builtin_nontemporal_load((const u32x2*)(mixb + o_)); }
#pragma unroll 1
      for (int gg = 0; gg < 8; ++gg) {
        const int row0 = (gi + gg) * 16;
#pragma unroll
        for (int rr = 0; rr < 2; ++rr) { const int rl = 2 * wid + rr, row = row0 + rl;
            f32x4 v[4]; float sm = 0.f;
#pragma unroll
            for (int j = 0; j < 4; ++j) { const u32x2 mw = mn[rr][j]; v[j] = vn[rr][j] * ALPHA + (f32x4){bflo(mw.x), bfhi(mw.x), bflo(mw.y), bfhi(mw.y)}; sm += (v[j][0] + v[j][1]) + (v[j][2] + v[j][3]); }
            const float mean = dpp_sum_f(sm) * (1.f / DM); float s2 = 0.f;
#pragma unroll
            for (int j = 0; j < 4; ++j) { v[j] = v[j] - mean; s2 += (v[j][0] * v[j][0] + v[j][1] * v[j][1]) + (v[j][2] * v[j][2] + v[j][3] * v[j][3]); }
            const float rstd = 1.f / sqrtf(dpp_sum_f(s2) * (1.f / DM) + LN_EPS);
#pragma unroll
            for (int j = 0; j < 4; ++j) { v[j] = v[j] * rstd * gv[j] + bv[j];
                u32x2 o; o.x = pkbf(v[j][0], v[j][1]); o.y = pkbf(v[j][2], v[j][3]); *(u32x2*)(h1b + (size_t)row * DM + 4 * lane + 256 * j) = o;
                { int wv = 0; wv = __builtin_amdgcn_cvt_pk_fp8_f32(v[j][0], v[j][1], wv, false); wv = __builtin_amdgcn_cvt_pk_fp8_f32(v[j][2], v[j][3], wv, true);
                  *(int*)(h1q + (size_t)row * 1024 + 4 * lane + 256 * j) = wv; }
                { const unsigned h01 = o.x, h23 = o.y;
                  *(LAS u32x2*)(Hh + rl * P7_HS + 4 * lane + 256 * j) = (u32x2){h01, h23};
                  *(LAS u32x2*)(Hl + rl * P7_HS + 4 * lane + 256 * j) = (u32x2){pkbf(v[j][0] - bflo(h01), v[j][1] - bfhi(h01)), pkbf(v[j][2] - bflo(h23), v[j][3] - bfhi(h23))}; } } }
        { const int gnx = gg < 7 ? gg + 1 : gg;
#pragma unroll
          for (int rr = 0; rr < 2; ++rr)
#pragma unroll
              for (int j = 0; j < 4; ++j) { const size_t o_ = (size_t)((gi + gnx) * 16 + 2 * wid + rr) * DM + 4 * lane + 256 * j; vn[rr][j] = __builtin_nontemporal_load((const f32x4*)(xin + o_)); mn[rr][j] = __builtin_nontemporal_load((const u32x2*)(mixb + o_)); } }
        LDS_WAIT(); __syncthreads();
        { f32x4 acc[3]; acc[0] = (f32x4){0.f, 0.f, 0.f, 0.f}; acc[1] = acc[0]; acc[2] = acc[0];
          const int hoff = (lane & 15) * P7_HS + 128 * wid + 8 * (lane >> 4);
#pragma unroll
          for (int sidx = 0; sidx < 4; ++sidx) { const bf16x8 ah = *(const LAS bf16x8*)(Hh + hoff + 32 * sidx), al = *(const LAS bf16x8*)(Hl + hoff + 32 * sidx);
#pragma unroll
              for (int cb = 0; cb < 3; ++cb) { acc[cb] = __builtin_amdgcn_mfma_f32_16x16x32_bf16(ah, bhi[sidx][cb], acc[cb], 0, 0, 0);
                  acc[cb] = __builtin_amdgcn_mfma_f32_16x16x32_bf16(ah, blo[sidx][cb], acc[cb], 0, 0, 0); acc[cb] = __builtin_amdgcn_mfma_f32_16x16x32_bf16(al, bhi[sidx][cb], acc[cb], 0, 0, 0); } }
          LAS float* pp = P + (wid * 16 + 4 * (lane >> 4)) * 48 + (lane & 15);
#pragma unroll
          for (int cb = 0; cb < 3; ++cb)
#pragma unroll
              for (int rg = 0; rg < 4; ++rg) pp[rg * 48 + 16 * cb] = acc[cb][rg]; }
        LDS_WAIT(); __syncthreads();
        for (int idx = tid; idx < 16 * 48; idx += 512) { float sum = 0.f;
#pragma unroll
            for (int w = 0; w < 8; ++w) sum += P[w * 768 + idx];
            L[idx] = sum; }
        LDS_WAIT(); __syncthreads();
        if (wid == gg && lane < 16) { const LAS float* lr = L + lane * 48;
            float gl[4]; int grp = 0;
#pragma unroll
            for (int i = 0; i < 4; ++i) gl[i] = lr[i] + rgb[i];
            float gm = gl[0];
#pragma unroll
            for (int i = 1; i < 4; ++i) if (gl[i] > gm) { gm = gl[i]; grp = i; }
            float den = 0.f;
#pragma unroll
            for (int i = 0; i < 4; ++i) den += __expf(gl[i] - gm);
            const float pgrp = 1.f / den;
            float el[8];
#pragma unroll
            for (int i = 0; i < 8; ++i) el[i] = lr[4 + 8 * grp + i] + reb[grp * 8 + i];
            int i1 = 0; float v1 = el[0];
#pragma unroll
            for (int i = 1; i < 8; ++i) if (el[i] > v1) { v1 = el[i]; i1 = i; }
            int i2 = -1; float v2 = -INFINITY;
#pragma unroll
            for (int i = 0; i < 8; ++i) if (i != i1 && el[i] > v2) { v2 = el[i]; i2 = i; }
            const float ex = __expf(v2 - v1), w1 = pgrp / (1.f + ex), w2 = pgrp * ex / (1.f + ex);
            const int e1 = grp * 8 + i1, e2 = grp * 8 + i2, ti = gg * 16 + lane;
            RE[ti] = e1; RE[128 + ti] = e2; RE[256 + ti] = (int)__float_as_uint(w1); RE[384 + ti] = (int)__float_as_uint(w2);
            RE[512 + ti] = __hip_atomic_fetch_add(hist + e1, 1, __ATOMIC_RELAXED, __HIP_MEMORY_SCOPE_WORKGROUP);
            RE[640 + ti] = __hip_atomic_fetch_add(hist + e2, 1, __ATOMIC_RELAXED, __HIP_MEMORY_SCOPE_WORKGROUP);
        }
      }
      LDS_WAIT(); __syncthreads();
      if (tid < NEXP) { const int hc = hist[tid]; basev[tid] = hc ? (int)__hip_atomic_fetch_add(F.ctl + CW_CNT + cbank + 64 * tid, (unsigned)hc, __ATOMIC_RELAXED, __HIP_MEMORY_SCOPE_AGENT) : 0; }
      LDS_WAIT(); __syncthreads();
      if (tid < 128) { const int row = gi * 16 + tid; const int e1 = RE[tid], e2 = RE[128 + tid];
          const unsigned r1 = (unsigned)(basev[e1] + RE[512 + tid]), r2 = (unsigned)(basev[e2] + RE[640 + tid]);
          if (r1 < (unsigned)LISTCAP) lists[(size_t)e1 * LISTCAP + r1] = row;
          if (r2 < (unsigned)LISTCAP) lists[(size_t)e2 * LISTCAP + r2] = row;
          unsigned* ti = tokinfo + (size_t)row * 8;
          *(u32x4*)ti = (u32x4){(unsigned)e1, r1, (unsigned)RE[256 + tid], (unsigned)e2}; *(u32x2*)(ti + 4) = (u32x2){r2, (unsigned)RE[384 + tid]}; }
      LDS_WAIT(); __syncthreads();
      if (tid < 64) hist[tid] = 0;
      LDS_WAIT(); __syncthreads();
    }
}
__device__ __forceinline__ void moe_tables(Frame& F) {
    LAS int* tab = (LAS int*)(F.lds + TAB_OFF);
    __syncthreads();
    if (F.tid < NEXP) { int c = (int)__hip_atomic_load(F.ctl + CW_CNT + 64 * F.tid, __ATOMIC_RELAXED, __HIP_MEMORY_SCOPE_AGENT); if (c > LISTCAP) c = LISTCAP; tab[T_CNT + F.tid] = c; }
    __syncthreads();
    if (F.tid == 0) { int acc = 0; for (int e = 0; e < NEXP; ++e) { tab[T_BLK0 + e] = acc; acc += (tab[T_CNT + e] + 255) >> 8; } tab[T_BLK0 + NEXP] = acc; tab[T_NB] = acc; }
    __syncthreads();
    if (F.tid < NEXP) { const int b0 = tab[T_BLK0 + F.tid], b1 = tab[T_BLK0 + F.tid + 1]; for (int bb = b0; bb < b1; ++bb) tab[T_BLKE + bb] = F.tid; }
    __syncthreads();
}

__device__ __forceinline__ void combine_ln2(Frame& F) {
    const KArgs a = kargs();
    unsigned char* ws = F.ws;
    const bf16_t* h1 = (const bf16_t*)(ws + WS_PRE); const unsigned char* ys = ws + WS_YS;     const unsigned* tokinfo = (const unsigned*)(ws + WS_TOKINFO);
    const LAS int* tab = (const LAS int*)(F.lds + TAB_OFF);
    const float *g2 = a->in[16], *b2 = a->in[17]; float* outp = a->out;
    const int lane = F.lane, gw = F.vcu * NWAVES + F.wave, NGW = F.G * NWAVES;
    f32x4 gv[4], bv[4];
#pragma unroll
    for (int j = 0; j < 4; ++j) { gv[j] = *(const f32x4*)(g2 + 4 * lane + 256 * j); bv[j] = *(const f32x4*)(b2 + 4 * lane + 256 * j); }
    const int nrw = (NTOK - gw + NGW - 1) / NGW;
    if (nrw > 0) {
#define ROWK(k) (gw + ((k) < nrw ? (k) : nrw - 1) * NGW)
#define TI_LOAD(k, A, B) do { const unsigned* ti_ = tokinfo + (size_t)ROWK(k) * 8; A = *(const u32x4*)ti_; B = *(const u32x2*)(ti_ + 4); } while (0)
#define DATA_LOAD(k, A, B, HW, YA, YB) do { const int e1_ = (int)A.x, e2_ = (int)A.w; \
        const size_t s1_ = (size_t)tab[T_BLK0 + e1_] * 256 + A.y, s2_ = (size_t)tab[T_BLK0 + e2_] * 256 + B.x; \
        const bf16_t* hr_ = h1 + (size_t)ROWK(k) * DM + 4 * lane; const unsigned char* y1_ = ys + s1_ * DM + 4 * lane; const unsigned char* y2_ = ys + s2_ * DM + 4 * lane; \
        _Pragma("unroll") for (int j = 0; j < 4; ++j) { HW[j] = __builtin_nontemporal_load((const u32x2*)(hr_ + 256 * j)); YA[j] = __builtin_nontemporal_load((const unsigned*)(y1_ + 256 * j)); YB[j] = __builtin_nontemporal_load((const unsigned*)(y2_ + 256 * j)); } } while (0)
        u32x4 tc0, tn0, tq0; u32x2 tc1, tn1, tq1;
        u32x2 hw[4], hwn[4]; unsigned ya[4], yb[4], yan[4], ybn[4];
        TI_LOAD(0, tc0, tc1); TI_LOAD(1, tn0, tn1);
        DATA_LOAD(0, tc0, tc1, hw, ya, yb);
        for (int k = 0; k < nrw; ++k) {
            TI_LOAD(k + 2, tq0, tq1);
            DATA_LOAD(k + 1, tn0, tn1, hwn, yan, ybn);
            const float w1 = __uint_as_float(tc0.z), w2 = __uint_as_float(tc1.y);
            f32x4 v[4]; float sm = 0.f;
#pragma unroll
            for (int j = 0; j < 4; ++j) {
                v[j][0] = ALPHA * bflo(hw[j].x) + w1 * __builtin_amdgcn_cvt_f32_fp8((int)ya[j], 0) + w2 * __builtin_amdgcn_cvt_f32_fp8((int)yb[j], 0);
                v[j][1] = ALPHA * bfhi(hw[j].x) + w1 * __builtin_amdgcn_cvt_f32_fp8((int)ya[j], 1) + w2 * __builtin_amdgcn_cvt_f32_fp8((int)yb[j], 1);
                v[j][2] = ALPHA * bflo(hw[j].y) + w1 * __builtin_amdgcn_cvt_f32_fp8((int)ya[j], 2) + w2 * __builtin_amdgcn_cvt_f32_fp8((int)yb[j], 2);
                v[j][3] = ALPHA * bfhi(hw[j].y) + w1 * __builtin_amdgcn_cvt_f32_fp8((int)ya[j], 3) + w2 * __builtin_amdgcn_cvt_f32_fp8((int)yb[j], 3);
                sm += (v[j][0] + v[j][1]) + (v[j][2] + v[j][3]); }
            const float mean = dpp_sum_f(sm) * (1.f / DM); float s2v = 0.f;
#pragma unroll
            for (int j = 0; j < 4; ++j) { v[j] = v[j] - mean; s2v += (v[j][0] * v[j][0] + v[j][1] * v[j][1]) + (v[j][2] * v[j][2] + v[j][3] * v[j][3]); }
            const float rstd = 1.f / sqrtf(dpp_sum_f(s2v) * (1.f / DM) + LN_EPS);
            float* orow = outp + (size_t)(gw + k * NGW) * DM + 4 * lane;
#pragma unroll
            for (int j = 0; j < 4; ++j) __builtin_nontemporal_store(v[j] * rstd * gv[j] + bv[j], (f32x4*)(orow + 256 * j));
            tc0 = tn0; tc1 = tn1; tn0 = tq0; tn1 = tq1;
#pragma unroll
            for (int j = 0; j < 4; ++j) { hw[j] = hwn[j]; ya[j] = yan[j]; yb[j] = ybn[j]; }
        }
#undef ROWK
#undef TI_LOAD
#undef DATA_LOAD
    }
}

#if DBG_NAIVE
constexpr size_t WS_NK = 296 * MiB, WS_NV = 312 * MiB, WS_NKI = 328 * MiB;
__device__ __forceinline__ float naive_proj(const float* xs  , const float* w_in, int col) {
    float s = 0.f; for (int d = 0; d < DM; ++d) s += xs[d] * w_in[(size_t)d * INW + col]; return s;
}
__device__ __forceinline__ void naive_kv(Frame& F) {
    const KArgs ka = kargs(); const float* xin = ka->in[0]; const float* win = ka->in[1];
    float* nk = (float*)(F.ws + WS_NK); float* nv = (float*)(F.ws + WS_NV); float* nki = (float*)(F.ws + WS_NKI);
    LAS float* xs = (LAS float*)F.lds; LAS float* pr = xs + 1024;
    for (int tok = F.vcu; tok < NTOK; tok += F.G) {
        __syncthreads();
        for (int i = F.tid; i < DM; i += 512) xs[i] = xin[(size_t)tok * DM + i];
        __syncthreads();
        if (F.tid < 320) { const int col = F.tid < 256 ? 512 + F.tid : 1280 + (F.tid - 256); float s = 0.f; for (int d = 0; d < DM; ++d) s += xs[d] * win[(size_t)d * INW + col]; pr[F.tid] = s; }
        __syncthreads();
        const int pos = tok & (SEQ - 1);
        if (F.tid < 24) {
            const int grp = F.tid >> 3, i = F.tid & 7, base = grp == 0 ? 0 : (grp == 1 ? 64 : 256);
            const float inv = (float)pow(500000.0, -(double)i / 8.0); const float ang = (float)pos * inv, c = cosf(ang), s = sinf(ang);
            const float x1 = pr[base + i], x2 = pr[base + 8 + i]; pr[base + i] = x1 * c - x2 * s; pr[base + 8 + i] = x2 * c + x1 * s;
        }
        __syncthreads();
        if (F.tid < 128) { nk[(size_t)tok * 128 + F.tid] = pr[F.tid]; nv[(size_t)tok * 128 + F.tid] = pr[128 + F.tid]; }
        if (F.tid < 64) nki[(size_t)tok * 64 + F.tid] = pr[256 + F.tid];
    }
}
__device__ __forceinline__ void naive_attn(Frame& F) {
    const KArgs ka = kargs(); const float* xin = ka->in[0]; const float* win = ka->in[1];
    const float* nk = (const float*)(F.ws + WS_NK); const float* nv = (const float*)(F.ws + WS_NV); const float* nki = (const float*)(F.ws + WS_NKI);
    bf16_t* attn = (bf16_t*)(F.ws + WS_AC) + 512;
    LAS float* xs = (LAS float*)F.lds;
    LAS float* qs = xs + 1024;
    LAS float* qis = qs + 512;
    LAS float* wis = qis + 512;
    LAS float* sc = wis + 16;
    LAS int* sel = (LAS int*)(sc + 2048);
    LAS int* nsel = sel + 256;
    LAS float* pl = (LAS float*)(nsel + 16);
    for (int tok = F.vcu; tok < NTOK; tok += F.G) {
        const int pos = tok & (SEQ - 1), b0 = tok - pos;
        __syncthreads();
        for (int i = F.tid; i < DM; i += 512) xs[i] = xin[(size_t)tok * DM + i];
        if (F.tid == 0) nsel[0] = 0;
        __syncthreads();
        for (int c = F.tid; c < 1032; c += 512) { const int col = c < 512 ? c : (c < 1024 ? 768 + (c - 512) : 1344 + (c - 1024));
            float s = 0.f; for (int d = 0; d < DM; ++d) s += xs[d] * win[(size_t)d * INW + col];
            if (c < 512) qs[c] = s; else if (c < 1024) qis[c - 512] = s; else wis[c - 1024] = s; }
        __syncthreads();
        if (F.tid < 128) { const int which = F.tid >> 6, hd = (F.tid >> 3) & 7, i = F.tid & 7; LAS float* p = (which ? qis : qs) + hd * 64;
            const float inv = (float)pow(500000.0, -(double)i / 8.0); const float ang = (float)pos * inv, c = cosf(ang), s = sinf(ang);
            const float x1 = p[i], x2 = p[8 + i]; p[i] = x1 * c - x2 * s; p[8 + i] = x2 * c + x1 * s; }
        __syncthreads();
#if DBG_NAIVE == 2
        { const bf16_t* qif = (const bf16_t*)(F.ws + WS_QI) + (size_t)tok * 512; for (int i = F.tid; i < 512; i += 512) qis[i] = __uint_as_float((unsigned)qif[i] << 16);
          if (F.tid < 8) wis[F.tid] = ((const float*)(F.ws + WS_WI))[(size_t)tok * 8 + F.tid]; }
        __syncthreads();
        for (int s = F.tid; s <= pos; s += 512) { const int tk_ = b0 + s; const bf16_t* kr = (const bf16_t*)(F.ws + WS_KI) + (size_t)(tk_ >> 5) * 2048 + (tk_ & 31) * 16; float tot = 0.f;
            for (int hd = 0; hd < 8; ++hd) { float d = 0.f; for (int e = 0; e < 64; ++e) d += qis[hd * 64 + e] * __uint_as_float((unsigned)kr[(e >> 4) * 512 + ((e >> 3) & 1) * 8 + (e & 7)] << 16); tot += fmaxf(d, 0.f) * (wis[hd] * WSCALE); }
            sc[s] = tot; }
#else
        for (int s = F.tid; s <= pos; s += 512) { const float* kr = nki + (size_t)(b0 + s) * 64; float tot = 0.f;
            for (int hd = 0; hd < 8; ++hd) { float d = 0.f; for (int e = 0; e < 64; ++e) d += qis[hd * 64 + e] * kr[e]; d *= 0.125f; tot += fmaxf(d, 0.f) * wis[hd]; }
            sc[s] = tot * 0.35355339059327373f; }
#endif
        __syncthreads();
        for (int s = F.tid; s <= pos; s += 512) { bool take = true;
            if (pos >= 256) { const float xv = sc[s]; int rank = 0; for (int s2 = 0; s2 <= pos; ++s2) { const float y = sc[s2]; rank += (y > xv || (y == xv && s2 < s)) ? 1 : 0; } take = rank < 256; }
            if (take) { const int p = atomicAdd((int*)nsel, 1); sel[p] = s; } }
        __syncthreads();
        const int ns = nsel[0]; const int hd = F.wave, lane = F.lane;
        float lg[4]; float mx = -INFINITY;
        for (int jj = 0; jj < 4; ++jj) { const int j = lane + 64 * jj; lg[jj] = -INFINITY;
            if (j < ns) { const float* kr = nk + (size_t)(b0 + sel[j]) * 128 + (hd >> 2) * 64; float d = 0.f; for (int e = 0; e < 64; ++e) d += qs[hd * 64 + e] * kr[e]; lg[jj] = d * 0.125f; mx = fmaxf(mx, lg[jj]); } }
        mx = wave_max(mx); float sum = 0.f;
        for (int jj = 0; jj < 4; ++jj) { const int j = lane + 64 * jj; const float p = (j < ns) ? expf(lg[jj] - mx) : 0.f; sum += p; pl[hd * 256 + j] = p; }
        sum = wave_sum(sum);
        LDS_WAIT(); asm volatile("" ::: "memory");
        float o = 0.f;
        for (int j = 0; j < ns; ++j) o += pl[hd * 256 + j] * nv[(size_t)(b0 + sel[j]) * 128 + (hd >> 2) * 64 + lane];
        o /= sum;
        bf16_t* ap = attn + (size_t)tok * 1024 + hd * 64 + lane;
        const float fast = __uint_as_float((unsigned)(*ap) << 16);
        const float blended = o + DBG_G * (fast - o);
        *ap = (bf16_t)(pkbf(blended, 0.f) & 0xffffu);
    }
}
#endif

__global__ void __launch_bounds__(NWAVES * 64, 2) mk_fwd(Args args_unused) {
    extern __shared__ __attribute__((aligned(16))) unsigned char lds[];
    Frame F;
    F.lds = (LAS unsigned char*)lds;
    F.MISC = (volatile LAS unsigned*)(F.lds + LDSCTL_OFF);
    F.tid = threadIdx.x; F.lane = F.tid & 63; F.wave = __builtin_amdgcn_readfirstlane(F.tid >> 6);
    F.G = gridDim.x; { const int bx = blockIdx.x; F.vcu = (F.G % 8 == 0) ? (bx % 8) * (F.G / 8) + bx / 8 : bx; }
    unsigned char* ws; int lo, hi;
    { const KArgs ka = kargs(); ws = ka->ws; lo = ka->ph_lo; hi = ka->ph_hi; }
    F.ws = ws; F.ctl = (unsigned*)(ws + WS_CTL);
    for (int u = F.tid; u < (LDS_BYTES - LDSCTL_OFF) / 4; u += NWAVES * 64) ((LAS unsigned*)(F.lds + LDSCTL_OFF))[u] = 0u;
    __syncthreads();
#if MK_SPLIT
#define GRID_BAR() do { } while (0)
#else
    XcdBarrier bar = xcd_barrier_post(F.ctl + CW_BAR, F.MISC + 8);
#define GRID_BAR() xcd_barrier(bar)
#endif
#ifndef PHASE_MASK
#define PHASE_MASK 0xFFFF
#endif
#define IN(k) ((((PHASE_MASK) >> (k)) & 1) && lo <= (k) && (k) < hi)
#define BOTH(k, k2) (IN(k) && IN(k2))

    bf16_t* xb = (bf16_t*)(ws + WS_XB);
    bf16_t *qb = (bf16_t*)(ws + WS_Q), *kbuf = (bf16_t*)(ws + WS_K), *vbuf = (bf16_t*)(ws + WS_V), *qib = (bf16_t*)(ws + WS_QI), *kib = (bf16_t*)(ws + WS_KI);
    float* wib = (float*)(ws + WS_WI);
    bf16_t *ub = (bf16_t*)(ws + WS_U), *cbb = (bf16_t*)(ws + WS_CB), *acb = (bf16_t*)(ws + WS_AC), *gab = (bf16_t*)(ws + WS_GA), *rtb = (bf16_t*)(ws + WS_RT);
    unsigned* masks = (unsigned*)(ws + WS_MASK);
    bf16_t *merged = (bf16_t*)(ws + WS_MERGED), *h1b = (bf16_t*)(ws + WS_PRE), *ysb_unused = nullptr; (void)ysb_unused;
    float* pre = (float*)(ws + WS_PRE);

    if (IN(0)) { p0_prologue(F); if (BOTH(0, 1)) GRID_BAR(); }
    if (IN(1)) {
        pg8::Gemm g{xb, (const bf16_t*)(ws + WS_WIN), NTOK, NPROJ, DM, 0}; pg8::StaticOrder S; S.init(NTOK, NPROJ, F.G, (int)blockIdx.x);
        EpiProj E{qb, kbuf, vbuf, qib, kib, ub, cbb, gab, rtb, wib, (const float*)(ws + WS_ROPE), kargs()->in[2]};
#ifndef P1_STAGGER
#define P1_STAGGER 1
#endif
        if (F.vcu & 1) { for (int i = 0; i < P1_STAGGER; ++i) __builtin_amdgcn_s_sleep(127); }
        pg8::gemm_phase<EpiProj, pg8::StaticOrder, true, false>(F.lds, g, S, E, nullptr);
        if (BOTH(1, 2)) GRID_BAR();
    }
    if (IN(2)) {
        LAS float* scl = (LAS float*)F.lds;
        LAS unsigned* maskw = (LAS unsigned*)(F.lds + TAB_OFF);
        for (int i = F.tid; i < 2048; i += 512) maskw[i] = 0u;
        __syncthreads();
        if (F.G == 256) {
            const int b = F.vcu >> 4, j = F.vcu & 15;
            P2Carry C; p2_request(F, b, j, qib, kib, wib, C); VM_WAIT(); p2_pin(C); p2_wtab(F, C); LDS_WAIT(); __syncthreads();
#pragma unroll 1
            for (int i = 0; i < 8; ++i) { const int qt = 32 * (i >> 1) + ((i & 1) ? 31 - j : j); const int in = i < 7 ? i + 1 : 7, qtn = 32 * (in >> 1) + ((in & 1) ? 31 - j : j);
                const int gwv = F.vcu * NWAVES + F.wave, jx0 = i < 4 ? 2 * i : 4 + i;
                score_select_unit(F, b, qt, b, qtn, C, qib, kib, wib, scl, maskw, masks, gwv + 2048 * jx0, i < 4 ? gwv + 2048 * (jx0 + 1) : -1); }
        } else {
            if (F.vcu < NBATCH * 128) {
                P2Carry C; p2_request(F, F.vcu >> 7, F.vcu & 127, qib, kib, wib, C); VM_WAIT(); p2_pin(C); p2_wtab(F, C); LDS_WAIT(); __syncthreads();
#pragma unroll 1
                for (int un = F.vcu; un < NBATCH * 128; un += F.G) { const int unn = un + F.G < NBATCH * 128 ? un + F.G : un;
                    score_select_unit(F, un >> 7, un & 127, unn >> 7, unn & 127, C, qib, kib, wib, scl, maskw, masks, -1, -1); } }
        }
        conv_pass(F, ub, cbb, kargs()->in[5], acb);
        if (PROBE_P2 == 3) conv_pass(F, ub, cbb, kargs()->in[5], acb);
        if (BOTH(2, 3)) GRID_BAR();
    }
    if (IN(3)) {
        const int nun = NBATCH * 8 * 8;
        if (F.G == 256) {
            const int bh = F.vcu >> 1, s0 = 2 * (F.vcu & 1);
#pragma unroll 1
            for (int i = 0; i < 4; ++i) { const int qbk = (i == 0) ? s0 : (i == 1) ? 7 - s0 : (i == 2) ? s0 + 1 : 6 - s0;
                attn_body::attn_unit<8>(bh >> 3, bh & 7, qbk, (const attn_body::bf16*)qb, (const attn_body::bf16*)kbuf, (const attn_body::bf16*)vbuf, (attn_body::bf16*)acb, masks, (char*)lds); }
        } else {
#pragma unroll 1
            for (int un = F.vcu; un < nun; un += F.G) attn_body::attn_unit<8>(un >> 6, (un >> 3) & 7, un & 7, (const attn_body::bf16*)qb, (const attn_body::bf16*)kbuf, (const attn_body::bf16*)vbuf, (attn_body::bf16*)acb, masks, (char*)lds);
        }
        if (BOTH(3, 4)) GRID_BAR();
    }
#if DBG_NAIVE
    if (IN(4)) { naive_kv(F); }
    if (IN(11)) { naive_attn(F); }
#else
    if (IN(4)) { if (BOTH(4, 5)) { } }
#endif
    if (IN(5)) {
        pg8::Gemm g{acb, (const bf16_t*)(ws + WS_WAU), NTOK, DM, DM, 0}; pg8::StaticOrder S; S.init(NTOK, DM, F.G, (int)blockIdx.x);
        EpiMerged E{gab, rtb, merged};
        pg8::gemm_phase<EpiMerged, pg8::StaticOrder, true, false, true>(F.lds, g, S, E, nullptr);
        if (BOTH(5, 6)) GRID_BAR();
    }
    if (IN(6)) {
        pg8::Gemm g{merged, (const bf16_t*)(ws + WS_WOUT), NTOK, DM, DM, 0}; pg8::StaticOrder S; S.init(NTOK, DM, F.G, (int)blockIdx.x);
        EpiOut E{(bf16_t*)(ws + WS_MIX)};
        pg8::gemm_phase<EpiOut, pg8::StaticOrder, true, false>(F.lds, g, S, E, nullptr);
        if (BOTH(6, 7)) GRID_BAR();
    }
    if (IN(7)) { ln1_router(F, (kargs()->flags & 1) != 0); if (BOTH(7, 8)) GRID_BAR(); }
    if (IN(8)) {
        moe_tables(F);
        LAS int* tab = (LAS int*)(F.lds + TAB_OFF);
        const int nunits = tab[T_NB] * 4; const int* lists = (const int*)(ws + WS_LIST);
        for (int i = 0; i < T_ROWS_UNITS; ++i) { const int L = i * F.G + F.vcu; if (L >= nunits) break;
            const int rbg = L >> 2, e = tab[T_BLKE + rbg], slot0 = (rbg - tab[T_BLK0 + e]) * 256, cnt = tab[T_CNT + e];
            if (F.tid < 256) { const int sl = slot0 + F.tid; tab[T_ROWS + i * 256 + F.tid] = sl < cnt ? lists[(size_t)e * LISTCAP + sl] : 0; } }
        __syncthreads();
        pg8::Gemm g{(const bf16_t*)(ws + WS_H1Q), (const bf16_t*)(ws + WS_WGU), CAPROWS, NEXP * 1024, 512, 0}; pg8::MoeOrder S{tab + T_BLKE, nunits, F.G, F.vcu};
        EpiSwiGLU E{ws + WS_HID};
        pg8::gemm_phase<EpiSwiGLU, pg8::MoeOrder, true, true, false, true>(F.lds, g, S, E, tab + T_ROWS);
        if (BOTH(8, 9)) GRID_BAR();
    }
    if (IN(9)) {
        moe_tables(F);
        LAS int* tab = (LAS int*)(F.lds + TAB_OFF);
        const int nunits = tab[T_NB] * 4;
        pg8::Gemm g{(const bf16_t*)(ws + WS_HID), (const bf16_t*)(ws + WS_WD), CAPROWS, NEXP * 1024, 256, 0}; pg8::MoeOrder S{tab + T_BLKE, nunits, F.G, F.vcu};
        EpiYs E{ws + WS_YS};
        pg8::gemm_phase<EpiYs, pg8::MoeOrder, true, false, false, true>(F.lds, g, S, E, nullptr);
        if (BOTH(9, 10)) GRID_BAR();
    }
    if (IN(10)) { moe_tables(F); combine_ln2(F); }
#undef IN
#undef BOTH
}

extern "C" void kernel_launch(void* const* d_in, const int* in_sizes, int n_in, void* d_out, int out_size, void* d_ws, size_t ws_size, hipStream_t stream) {
    static int grid = 0;
    if (grid == 0) {
        if (n_in != 18 || in_sizes[0] != NTOK * DM || out_size != NTOK * DM || ws_size < WS_END) { fprintf(stderr, "kernel_launch: unexpected shapes (n_in %d, ws %zu)\n", n_in, ws_size); grid = -1; return; }
        int dev = 0, cus = 0, per_cu = 0;
        if (hipGetDevice(&dev) != hipSuccess || hipDeviceGetAttribute(&cus, hipDeviceAttributeMultiprocessorCount, dev) != hipSuccess) { grid = -1; return; }
        if (hipFuncSetAttribute((const void*)mk_fwd, hipFuncAttributeMaxDynamicSharedMemorySize, LDS_BYTES) != hipSuccess) { fprintf(stderr, "kernel_launch: hipFuncSetAttribute failed\n"); grid = -1; return; }
        if (hipOccupancyMaxActiveBlocksPerMultiprocessor(&per_cu, (const void*)mk_fwd, NWAVES * 64, LDS_BYTES) != hipSuccess || per_cu < 1) fprintf(stderr, "kernel_launch: occupancy query reports %d\n", per_cu);
        (void)hipGetLastError();
        grid = cus;
    }
    if (grid < 0) return;
    (void)hipMemsetAsync((char*)d_ws + WS_CTL, 0, CTL_ZERO_BYTES, stream);
    Args a{};
    for (int i = 0; i < 18; ++i) a.in[i] = (const float*)d_in[i];
    a.out = (float*)d_out; a.ws = (unsigned char*)d_ws;
#if MK_SPLIT
#if DBG_NAIVE
    const int seq[] = {0, 1, 2, 3, 4, 11, 5, 6, 7, 8, 9, 10};
#else
    const int seq[] = {0, 1, 2, 3, 5, 6, 7, 8, 9, 10};
#endif
    for (int ph : seq) { a.ph_lo = ph; a.ph_hi = ph + 1;
#ifdef PROBE_P7
        if (ph == 7) { a.flags = 1; hipLaunchKernelGGL(mk_fwd, dim3(grid), dim3(NWAVES * 64), LDS_BYTES, stream, a); a.flags = 0; }
#endif
        hipLaunchKernelGGL(mk_fwd, dim3(grid), dim3(NWAVES * 64), LDS_BYTES, stream, a);
#ifdef PROBE_DUP
        if (ph == PROBE_DUP) hipLaunchKernelGGL(mk_fwd, dim3(grid), dim3(NWAVES * 64), LDS_BYTES, stream, a);
#endif
    }
#else
    a.ph_lo = 0; a.ph_hi = 11;
    hipLaunchKernelGGL(mk_fwd, dim3(grid), dim3(NWAVES * 64), LDS_BYTES, stream, a);
#endif
}
```

```cpp
#include <hip/hip_runtime.h>
#include <hip/hip_bf16.h>
#include <cstdio>
#include <cstdint>

#ifndef MK_SPLIT
#define MK_SPLIT 0
#endif
#ifndef DBG_NAIVE
#define DBG_NAIVE 0
#endif
#ifndef DBG_G
#define DBG_G 1.0f
#endif

#define LAS __attribute__((address_space(3)))
#define GAS __attribute__((address_space(1)))
typedef unsigned short bf16_t;
typedef short bf16x8 __attribute__((ext_vector_type(8)));
typedef short s16x4 __attribute__((ext_vector_type(4)));
typedef float f32x2 __attribute__((ext_vector_type(2)));
typedef float f32x4 __attribute__((ext_vector_type(4)));
typedef float f32x16 __attribute__((ext_vector_type(16)));
typedef unsigned u32x2 __attribute__((ext_vector_type(2)));
typedef unsigned u32x4 __attribute__((ext_vector_type(4)));
typedef unsigned u32x16 __attribute__((ext_vector_type(16)));
typedef __bf16 bf16x2_t __attribute__((ext_vector_type(2)));

constexpr int NTOK = 32768, SEQ = 2048, NBATCH = 16, DM = 1024;
constexpr int NPROJ = 5120, INW = 4936;
constexpr int NEXP = 32, DEXP = 512, LISTCAP = 32768;
constexpr int CAPROWS = 65536 + NEXP * 256;
constexpr float LN_EPS = 1e-5f;
constexpr float ALPHA = 1.189207115002721f;
constexpr float C2 = 0.125f * 1.4426950408889634f;
constexpr float WSCALE = 0.125f * 0.35355339059327373f;

constexpr size_t MiB = 1u << 20;
constexpr size_t WS_CTL = 0, CTL_ZERO_BYTES = 64 * 1024;
constexpr size_t WS_ROPE = 1 * MiB;
constexpr size_t WS_WC = 1 * MiB + 256 * 1024;
constexpr size_t WS_WIN = 2 * MiB, WS_WAU = 12 * MiB, WS_WCU = 13 * MiB, WS_WOUT = 14 * MiB, WS_WD = 16 * MiB, WS_WGU = 48 * MiB;
constexpr size_t WS_XB = 112 * MiB;
constexpr size_t WS_MIX = 112 * MiB;
constexpr size_t WS_H1Q = 304 * MiB;
constexpr size_t WS_AC = 112 * MiB;
constexpr size_t WS_Q = 176 * MiB, WS_K = 208 * MiB, WS_V = 216 * MiB, WS_QI = 224 * MiB, WS_KI = 256 * MiB, WS_WI = 260 * MiB;
constexpr size_t WS_MERGED = 176 * MiB;
constexpr size_t WS_U = 264 * MiB, WS_ATTN = 264 * MiB;
constexpr size_t WS_CB = 296 * MiB, WS_MASK = 360 * MiB, WS_GATES = 368 * MiB;
constexpr size_t WS_GA = 368 * MiB, WS_RT = 432 * MiB;
constexpr size_t WS_PRE = 240 * MiB;
constexpr size_t WS_HID = 368 * MiB;
constexpr size_t WS_LIST = 496 * MiB, WS_TOKINFO = 500 * MiB;
constexpr size_t WS_YS = 112 * MiB;
constexpr size_t WS_XQ = 328 * MiB;
constexpr size_t WS_WIN8 = 502 * MiB;
constexpr size_t WS_END = 512 * MiB;
static_assert(WS_YS + (size_t)CAPROWS * 1024 <= WS_PRE && WS_HID + (size_t)CAPROWS * 512 * 2 <= WS_LIST, "ws map");
constexpr int CW_BAR = 4096;
constexpr int CW_CNT = 8192;
constexpr int CW_DEP = 12288;
constexpr int RING_BYTES = 131072;
constexpr int LDSCTL_OFF = RING_BYTES;
constexpr int TAB_OFF = RING_BYTES + 512;
constexpr int T_CNT = 0, T_BLK0 = 32, T_NB = 68, T_BLKE = 72, T_ROWS = 400, T_ROWS_UNITS = 12;
constexpr int QIF_OFF = 147456;
constexpr int LDS_BYTES = 163840;
static_assert(TAB_OFF + (T_ROWS + T_ROWS_UNITS * 256) * 4 <= QIF_OFF && TAB_OFF + 8192 + 1024 <= QIF_OFF && QIF_OFF + 16384 <= LDS_BYTES, "lds map");
constexpr int NWAVES = 8;

__device__ __forceinline__ unsigned pkbf(float lo, float hi) { f32x2 v = {lo, hi}; bf16x2_t b = __builtin_convertvector(v, bf16x2_t); return __builtin_bit_cast(unsigned, b); }
__device__ __forceinline__ float bflo(unsigned u) { return __uint_as_float(u << 16); }
__device__ __forceinline__ float bfhi(unsigned u) { return __uint_as_float(u & 0xffff0000u); }
__device__ __forceinline__ float wave_sum(float v) {
#pragma unroll
    for (int o = 1; o < 64; o <<= 1) v += __shfl_xor(v, o);
    return v;
}
__device__ __forceinline__ float wave_max(float v) {
#pragma unroll
    for (int o = 1; o < 64; o <<= 1) v = fmaxf(v, __shfl_xor(v, o));
    return v;
}
__device__ __forceinline__ float wave_min(float v) {
#pragma unroll
    for (int o = 1; o < 64; o <<= 1) v = fminf(v, __shfl_xor(v, o));
    return v;
}
#define LDS_WAIT() asm volatile("s_waitcnt lgkmcnt(0)" ::: "memory")
#define VM_WAIT() asm volatile("s_waitcnt vmcnt(0)" ::: "memory")

namespace pg8 {
constexpr int BM = 256, BK = 64, HALF = 128, HTB = HALF * BK * 2, STAGE_BYTES = 8 * HTB, NXCD = 8, WGM = 8;
__host__ __device__ __forceinline__ int lds_byte(int r, int c) { const int st = (r >> 4) * 2 + (c >> 5), rr = r & 15, cc = c & 31, ob = rr * 64 + cc * 2; return st * 1024 + (ob ^ (((ob >> 9) & 1) << 5)); }
__host__ __device__ __forceinline__ void stage_rc(int b, int& R, int& C) { const int st = b / 1024, sb = b % 1024, swz = sb ^ (((sb >> 9) & 1) << 5); R = (st >> 1) * 16 + swz / 64; C = (st & 1) * 32 + (swz % 64) / 2; }
__host__ __device__ __forceinline__ int perm32(int rho) { const int n = rho >> 4, i = rho & 15; return 8 * (i >> 2) + 4 * n + (i & 3); }

struct Unit { int pm, pn; };
struct Gemm { const bf16_t* A; const bf16_t* Bt; int M, N, K; int apitch; };

struct StaticOrder {
    int nM, nN, nwg, G, c;
    __host__ __device__ void init(int M, int N, int G_, int c_) { nM = M / BM; nN = N / BM; nwg = nM * nN; G = G_; c = c_; }
    __host__ __device__ bool next(int i, Unit& u) const {
        const long L = (long)i * G + c; if (L >= nwg) return false;
        int wgid = (int)L; { const int q = nwg / NXCD, r = nwg % NXCD, xcd = wgid % NXCD, off = wgid / NXCD; wgid = (xcd < r ? xcd * (q + 1) : r * (q + 1) + (xcd - r) * q) + off; }
        const int nig = WGM * nN, gid = wgid / nig, fm = gid * WGM, gsz = (nM - fm) < WGM ? (nM - fm) : WGM;
        u.pm = fm + ((wgid % nig) % gsz); u.pn = (wgid % nig) / gsz; return true;
    }
};
struct MoeOrder {
    const LAS int* blk_e; int nunits, G, c;
    __device__ __forceinline__ bool next(int i, Unit& u) const {
        const int L = i * G + c; if (L >= nunits) return false;
        const int rbg = L >> 2; u.pm = rbg; u.pn = blk_e[rbg] * 4 + (L & 3); return true;
    }
};

struct MoeOrder9 {
    const LAS int* blk_e; int nunits, G, c; unsigned* c2; unsigned* tmo;
    __device__ __forceinline__ bool next(int i, Unit& u) const {
        const int cc = i >= 4 ? (c + G / 2) % G : c;
        const int L = i * G + cc; if (L >= nunits) return false;
        if (i >= 4 && c2 != nullptr) { const unsigned need = (unsigned)(nunits - 4 * G); unsigned sp = 0;
            while (__hip_atomic_load(c2, __ATOMIC_RELAXED, __HIP_MEMORY_SCOPE_AGENT) < need) { __builtin_amdgcn_s_sleep(1);
                if ((++sp & 255u) == 0u) { if (__hip_atomic_load(tmo, __ATOMIC_RELAXED, __HIP_MEMORY_SCOPE_AGENT)) break; if (sp > (1u << 18)) { atomicAdd(tmo, 1u); break; } } }
            __builtin_amdgcn_fence(__ATOMIC_ACQUIRE, "agent"); }
        const int rbg = L >> 2; u.pm = rbg; u.pn = blk_e[rbg] * 4 + (L & 3); return true;
    }
};

typedef int i32x8 __attribute__((ext_vector_type(8)));
typedef int i32x4_t __attribute__((ext_vector_type(4)));
constexpr int F8_WSCALE_E = 122;
template <class Epi, class Sched, bool ALIGN_EPI, bool GATHER, bool MIDHOOK = false, bool F8 = false>
__device__ __forceinline__ void gemm_phase(LAS unsigned char* lds, const Gemm g, const Sched& S, const Epi& E, const LAS int* rowtab) {
    int tid_ = threadIdx.x; asm volatile("" : "+v"(tid_));
    const int tid = tid_, wid = __builtin_amdgcn_readfirstlane(tid >> 6), lane = tid & 63, wr = wid >> 2, wc = wid & 3, fr = lane & 15, fq = lane >> 4;
    const int K = g.K; int nt = K / BK;
    if constexpr (F8) asm volatile("" : "+s"(nt));
    int Rr[2]; unsigned cofs[2], voffB[2];
#pragma unroll
    for (int i = 0; i < 2; ++i) { int R, C; stage_rc(tid * 16 + i * 8192, R, C); const int Rb = Epi::PERM ? ((R & ~31) + perm32(R & 31)) : R;
        Rr[i] = R; cofs[i] = (unsigned)C * 2u; voffB[i] = (unsigned)(Rb * K + C) * 2u; }
    const unsigned rowb = g.apitch ? (unsigned)g.apitch : (unsigned)K * 2u;
    const size_t kstep = (size_t)(BK * 2);
    const size_t hstep = (size_t)HALF * K * 2;
    const size_t tstep = 2 * hstep;
    const unsigned ldsw = (unsigned)wid * 1024u;
    const int aoff = lds_byte(wr * 64 + fr, fq * 8), boff = lds_byte(wc * 32 + fr, fq * 8);
    const char* gA = (const char*)g.A;
#define PG8_SA(b, h) (((b) * 2 + (h)) * HTB)
#define PG8_SB(b, h) ((4 + (b) * 2 + (h)) * HTB)
#define PG8_STAGE(bufoff, gbase, voff) do { _Pragma("unroll") for (int _i = 0; _i < 2; ++_i) \
        __builtin_amdgcn_global_load_lds((const unsigned*)((const char*)(gbase) + (voff)[_i]), (LAS unsigned*)(lds + (bufoff) + ldsw + _i * 8192), 16, 0, 0); } while (0)
#define PG8_LD8(p_) __builtin_shufflevector(*(const LAS i32x4_t*)(p_), *(const LAS i32x4_t*)((p_) + 1024), 0, 1, 2, 3, 4, 5, 6, 7)
#define PG8_LDA(dst, b, h) do { if constexpr (F8) { _Pragma("unroll") for (int m = 0; m < 4; ++m) dst##8[m] = PG8_LD8(lds + PG8_SA(b, h) + aoff + m * 2048); } \
        else { _Pragma("unroll") for (int m = 0; m < 4; ++m) _Pragma("unroll") for (int k = 0; k < 2; ++k) dst[m][k] = *(const LAS bf16x8*)(lds + PG8_SA(b, h) + aoff + m * 2048 + k * 1024); } } while (0)
#define PG8_LDB(dst, b, h) do { if constexpr (F8) { _Pragma("unroll") for (int n = 0; n < 2; ++n) dst##8[n] = PG8_LD8(lds + PG8_SB(b, h) + boff + n * 2048); } \
        else { _Pragma("unroll") for (int n = 0; n < 2; ++n) _Pragma("unroll") for (int k = 0; k < 2; ++k) dst[n][k] = *(const LAS bf16x8*)(lds + PG8_SB(b, h) + boff + n * 2048 + k * 1024); } } while (0)
#define PG8_MMA(ai, bj, At, Bt) do { if constexpr (F8) __builtin_amdgcn_sched_barrier(0);     \
        __builtin_amdgcn_s_setprio(1); \
        if constexpr (F8) { _Pragma("unroll") for (int m = 0; m < 4; ++m) _Pragma("unroll") for (int n = 0; n < 2; ++n) \
            asm volatile("v_mfma_scale_f32_16x16x128_f8f6f4 %0, %1, %2, %0, %3, %4 op_sel_hi:[0,0,0]" : "+v"(acc[ai][bj][m][n]) : "v"(Bt##8[n]), "v"(At##8[m]), "v"(f8_sw), "v"(f8_sa));     \
            __builtin_amdgcn_sched_barrier(0); } \
        else { _Pragma("unroll") for (int m = 0; m < 4; ++m) _Pragma("unroll") for (int n = 0; n < 2; ++n) _Pragma("unroll") for (int k = 0; k < 2; ++k) \
            acc[ai][bj][m][n] = __builtin_amdgcn_mfma_f32_16x16x32_bf16(Bt[n][k], At[m][k], acc[ai][bj][m][n], 0, 0, 0); } \
        __builtin_amdgcn_s_setprio(0); } while (0)
#define PG8_WAIT_V(n) asm volatile("s_waitcnt vmcnt(" #n ")" ::: "memory")
#define PG8_WAIT_L(n) asm volatile("s_waitcnt lgkmcnt(" #n ")" ::: "memory")
#define PG8_BAR __builtin_amdgcn_s_barrier()
#define PG8_SCHED __builtin_amdgcn_sched_barrier(0)
#define PG8_AOFF(d0, d1, un, uidx) do { _Pragma("unroll") for (int _i = 0; _i < 2; ++_i) { unsigned r0_, r1_; \
        if (GATHER) { r0_ = (unsigned)rowtab[(uidx) * 256 + Rr[_i]]; r1_ = (unsigned)rowtab[(uidx) * 256 + 128 + Rr[_i]]; } \
        else { r0_ = (unsigned)((un).pm * 256 + Rr[_i]); r1_ = r0_ + 128u; } \
        d0[_i] = r0_ * rowb + cofs[_i]; d1[_i] = r1_ * rowb + cofs[_i]; } } while (0)
    Unit cur, nxt; int ui = 0;
    if (!S.next(0, cur)) return;
    f32x4 acc[2][2][4][2];
#pragma unroll
    for (int a = 0; a < 2; ++a)
#pragma unroll
        for (int b = 0; b < 2; ++b)
#pragma unroll
            for (int m = 0; m < 4; ++m)
#pragma unroll
                for (int n = 0; n < 2; ++n) acc[a][b][m][n] = (f32x4){0.f, 0.f, 0.f, 0.f};
    bf16x8 At[4][2], B0[2][2], B1[2][2]; i32x8 At8[4], B08[2], B18[2];
    int f8_sw = F8_WSCALE_E, f8_sa = 127; asm volatile("" : "+v"(f8_sw), "+v"(f8_sa));
    unsigned oc0[2], oc1[2], on0[2], on1[2];
    PG8_AOFF(oc0, oc1, cur, 0);
    const char* cB = (const char*)g.Bt + (size_t)cur.pn * tstep;
    PG8_STAGE(PG8_SB(0, 0), cB, voffB); PG8_STAGE(PG8_SB(0, 1), cB + hstep, voffB); PG8_STAGE(PG8_SA(0, 0), gA, oc0); PG8_STAGE(PG8_SA(0, 1), gA, oc1);
    if (wr == 1) PG8_BAR;
    PG8_WAIT_V(2); PG8_BAR;
    PG8_STAGE(PG8_SB(1, 0), cB + kstep, voffB); PG8_STAGE(PG8_SA(1, 0), gA + kstep, oc0); PG8_STAGE(PG8_SB(1, 1), cB + hstep + kstep, voffB);
    PG8_WAIT_V(6); PG8_BAR;
    for (;;) {
        const bool has_next = S.next(ui + 1, nxt);
        if (has_next) { PG8_AOFF(on0, on1, nxt, ui + 1); } else { on0[0] = oc0[0]; on0[1] = oc0[1]; on1[0] = oc1[0]; on1[1] = oc1[1]; }
        const char* nB = has_next ? (const char*)g.Bt + (size_t)nxt.pn * tstep : cB;
        for (int t = 0; t < nt; t += 2) {
            if constexpr (MIDHOOK) { if (t == nt / 2) E.mid(acc, cur, wr, wc, fr, fq); }
            const bool last = (t == nt - 2);
            const char* a1 = gA + (size_t)(t + 1) * kstep;
            const char* a2 = last ? gA : gA + (size_t)(t + 2) * kstep; const char* b2 = last ? nB : cB + (size_t)(t + 2) * kstep;
            const char* a3 = a2 + kstep; const char* b3 = b2 + kstep;
            unsigned o20[2], o21[2];
            o20[0] = last ? on0[0] : oc0[0]; o20[1] = last ? on0[1] : oc0[1]; o21[0] = last ? on1[0] : oc1[0]; o21[1] = last ? on1[1] : oc1[1];
            PG8_LDB(B0, 0, 0); PG8_LDB(B1, 0, 1); PG8_SCHED; PG8_LDA(At, 0, 0); PG8_STAGE(PG8_SA(1, 1), a1, oc1);
            PG8_WAIT_V(8); PG8_WAIT_L(0); PG8_BAR; PG8_MMA(0, 0, At, B0); PG8_MMA(0, 1, At, B1); PG8_BAR; PG8_SCHED;
            PG8_LDA(At, 0, 1); PG8_STAGE(PG8_SB(0, 0), b2, voffB); PG8_STAGE(PG8_SB(0, 1), b2 + hstep, voffB); PG8_STAGE(PG8_SA(0, 0), a2, o20);
            PG8_WAIT_V(8); PG8_WAIT_L(0); PG8_BAR; PG8_MMA(1, 0, At, B0); PG8_MMA(1, 1, At, B1); PG8_BAR; PG8_SCHED;
            PG8_LDB(B0, 1, 0); PG8_LDB(B1, 1, 1); PG8_SCHED; PG8_LDA(At, 1, 0); PG8_STAGE(PG8_SA(0, 1), a2, o21);
            PG8_WAIT_V(8); PG8_WAIT_L(0); PG8_BAR; PG8_MMA(0, 0, At, B0); PG8_MMA(0, 1, At, B1); PG8_BAR; PG8_SCHED;
            PG8_LDA(At, 1, 1); PG8_STAGE(PG8_SB(1, 0), b3, voffB); PG8_STAGE(PG8_SB(1, 1), b3 + hstep, voffB); PG8_STAGE(PG8_SA(1, 0), a3, o20);
            PG8_WAIT_V(8); PG8_WAIT_L(0); PG8_BAR; PG8_MMA(1, 0, At, B0); PG8_MMA(1, 1, At, B1); PG8_BAR; PG8_SCHED;
        }
        if constexpr (ALIGN_EPI) { if (wr == 0) PG8_BAR; }
        if constexpr (F8) asm volatile("s_nop 15\n\ts_nop 15" ::: "memory");
        E(acc, cur, wr, wc, fr, fq);
#ifdef PROBE_EPI2
        if constexpr (!MIDHOOK && !F8 && !GATHER) E(acc, cur, wr, wc, fr, fq);
#endif
        if (!has_next) break;
#pragma unroll
        for (int a = 0; a < 2; ++a)
#pragma unroll
            for (int b = 0; b < 2; ++b)
#pragma unroll
                for (int m = 0; m < 4; ++m)
#pragma unroll
                    for (int n = 0; n < 2; ++n) acc[a][b][m][n] = (f32x4){0.f, 0.f, 0.f, 0.f};
        cur = nxt; cB = nB; ++ui;
        oc0[0] = on0[0]; oc0[1] = on0[1]; oc1[0] = on1[0]; oc1[1] = on1[1];
        if constexpr (ALIGN_EPI) { if (wr == 1) PG8_BAR; }
    }
    PG8_WAIT_V(0);
    if constexpr (!ALIGN_EPI) { if (wr == 0) PG8_BAR; }
    PG8_BAR;
#undef PG8_SA
#undef PG8_SB
#undef PG8_STAGE
#undef PG8_LDA
#undef PG8_LDB
#undef PG8_MMA
#undef PG8_LD8
#undef PG8_WAIT_V
#undef PG8_WAIT_L
#undef PG8_BAR
#undef PG8_SCHED
#undef PG8_AOFF
}
}

typedef f32x4 AccT[2][2][4][2];
__device__ __forceinline__ void store8bf(bf16_t* p, const f32x4& v0, const f32x4& v1) {
    u32x4 w; w.x = pkbf(v0[0], v0[1]); w.y = pkbf(v0[2], v0[3]); w.z = pkbf(v1[0], v1[1]); w.w = pkbf(v1[2], v1[3]); *(u32x4*)p = w;
}
__device__ __forceinline__ void store8bf_nt(bf16_t* p, const f32x4& v0, const f32x4& v1) {
    u32x4 w; w.x = pkbf(v0[0], v0[1]); w.y = pkbf(v0[2], v0[3]); w.z = pkbf(v1[0], v1[1]); w.w = pkbf(v1[2], v1[3]); __builtin_nontemporal_store(w, (u32x4*)p);
}
__device__ __forceinline__ void rope8(f32x4& v0, f32x4& v1, const float* rope, int pos, int i0) {
    const f32x4 c = *(const f32x4*)(rope + pos * 8 + i0), s = *(const f32x4*)(rope + SEQ * 8 + pos * 8 + i0);
    float a, b;
    a = v0[0]; b = v0[1]; v0[0] = a * c[0] - b * s[0]; v0[1] = b * c[0] + a * s[0];
    a = v0[2]; b = v0[3]; v0[2] = a * c[1] - b * s[1]; v0[3] = b * c[1] + a * s[1];
    a = v1[0]; b = v1[1]; v1[0] = a * c[2] - b * s[2]; v1[1] = b * c[2] + a * s[2];
    a = v1[2]; b = v1[3]; v1[2] = a * c[3] - b * s[3]; v1[3] = b * c[3] + a * s[3];
}
__device__ __forceinline__ float sigmoidf_(float z) { return __builtin_amdgcn_rcpf(1.0f + __expf(-z)); }

struct EpiProj {
    static constexpr bool PERM = true;
    bf16_t *q, *k, *v, *qi, *ki, *u, *cb, *ga, *rt; float* wi; const float* rope; const float* gate_bias; int pmap;
    __device__ __forceinline__ void operator()(const AccT& acc, const pg8::Unit& un, int wr, int wc, int fr, int fq) const {
        const int pn = pmap ? un.pn + 6 : (un.pn < 6 ? un.pn : un.pn + 6), row0 = un.pm * 256 + wr * 64 + fr, cg = 32 * wc + 8 * fq;
        const bool rot = ((wc & 1) == 0) && (fq < 2); const int i0 = 4 * fq;
        if (pn < 2 || pn == 3 || pn == 4) {
            bf16_t* dst = (pn < 2) ? q + pn * 256 : qi + (pn - 3) * 256; const float sc = (pn < 2) ? C2 : 1.0f;
#pragma unroll
            for (int ai = 0; ai < 2; ++ai)
#pragma unroll
                for (int m = 0; m < 4; ++m) { const int row = row0 + ai * 128 + m * 16, pos = row & (SEQ - 1);
#pragma unroll
                    for (int bj = 0; bj < 2; ++bj) { f32x4 v0 = acc[ai][bj][m][0], v1 = acc[ai][bj][m][1];
                        if (rot) rope8(v0, v1, rope, pos, i0);
                        v0 = v0 * sc; v1 = v1 * sc; store8bf_nt(dst + (size_t)row * 512 + bj * 128 + cg, v0, v1); } }
        } else if (pn == 2) {
#pragma unroll
            for (int ai = 0; ai < 2; ++ai)
#pragma unroll
                for (int m = 0; m < 4; ++m) { const int row = row0 + ai * 128 + m * 16, pos = row & (SEQ - 1);
                    f32x4 v0 = acc[ai][0][m][0], v1 = acc[ai][0][m][1];
                    if (rot) rope8(v0, v1, rope, pos, i0);
                    store8bf(k + (size_t)row * 128 + cg, v0, v1);
                    store8bf(v + (size_t)row * 128 + cg, acc[ai][1][m][0], acc[ai][1][m][1]); }
        } else if (pn == 5) {
            if (wc < 2) {
#pragma unroll
                for (int ai = 0; ai < 2; ++ai)
#pragma unroll
                    for (int m = 0; m < 4; ++m) { const int row = row0 + ai * 128 + m * 16, pos = row & (SEQ - 1);
                        f32x4 v0 = acc[ai][0][m][0], v1 = acc[ai][0][m][1];
                        if (rot) rope8(v0, v1, rope, pos, i0);
                        { const int jch = cg >> 3; store8bf(ki + ((size_t)(row >> 5) * 4 + (jch >> 1)) * 512 + (row & 31) * 16 + (jch & 1) * 8, v0, v1); } }
            } else if (wc == 2 && fq == 0) {
#pragma unroll
                for (int ai = 0; ai < 2; ++ai)
#pragma unroll
                    for (int m = 0; m < 4; ++m) { const int row = row0 + ai * 128 + m * 16;
                        *(f32x4*)(wi + (size_t)row * 8) = acc[ai][0][m][0]; *(f32x4*)(wi + (size_t)row * 8 + 4) = acc[ai][0][m][1]; }
            }
        } else if (pn < 10) {
#pragma unroll
            for (int ai = 0; ai < 2; ++ai)
#pragma unroll
                for (int m = 0; m < 4; ++m) { const int row = row0 + ai * 128 + m * 16;
                    store8bf_nt(u + (size_t)row * 512 + (pn - 6) * 128 + cg, acc[ai][0][m][0] * acc[ai][1][m][0], acc[ai][0][m][1] * acc[ai][1][m][1]); }
        } else if (pn < 12) {
#pragma unroll
            for (int ai = 0; ai < 2; ++ai)
#pragma unroll
                for (int m = 0; m < 4; ++m) { const int row = row0 + ai * 128 + m * 16;
#pragma unroll
                    for (int bj = 0; bj < 2; ++bj) store8bf_nt(cb + (size_t)row * 512 + (pn - 10) * 256 + bj * 128 + cg, acc[ai][bj][m][0], acc[ai][bj][m][1]); }
        } else {
            const int gc0 = (pn - 12) * 128 + cg;
            const f32x4 ba0 = *(const f32x4*)(gate_bias + gc0), ba1 = *(const f32x4*)(gate_bias + gc0 + 4), bc0 = *(const f32x4*)(gate_bias + 1024 + gc0), bc1 = *(const f32x4*)(gate_bias + 1024 + gc0 + 4);
#pragma unroll
            for (int ai = 0; ai < 2; ++ai)
#pragma unroll
                for (int m = 0; m < 4; ++m) { const int row = row0 + ai * 128 + m * 16;
                    const f32x4 a0 = acc[ai][0][m][0] + ba0, a1 = acc[ai][0][m][1] + ba1, c0 = acc[ai][1][m][0] + bc0, c1 = acc[ai][1][m][1] + bc1;
                    f32x4 g0, g1, r0, r1;
#pragma unroll
                    for (int e = 0; e < 4; ++e) { const float ea0 = 1.0f + __expf(-a0[e]), ea1 = 1.0f + __expf(-a1[e]);
                        g0[e] = __builtin_amdgcn_rcpf(ea0); g1[e] = __builtin_amdgcn_rcpf(ea1);
                        r0[e] = ea0 * __builtin_amdgcn_rcpf(1.0f + __expf(-c0[e])); r1[e] = ea1 * __builtin_amdgcn_rcpf(1.0f + __expf(-c1[e])); }
                    { u32x4 wg_, wr_; wg_.x = pkbf(g0[0], g0[1]); wg_.y = pkbf(g0[2], g0[3]); wg_.z = pkbf(g1[0], g1[1]); wg_.w = pkbf(g1[2], g1[3]);
                      wr_.x = pkbf(r0[0], r0[1]); wr_.y = pkbf(r0[2], r0[3]); wr_.z = pkbf(r1[0], r1[1]); wr_.w = pkbf(r1[2], r1[3]);
                      __builtin_nontemporal_store(wg_, (u32x4*)(ga + (size_t)row * 1024 + gc0)); __builtin_nontemporal_store(wr_, (u32x4*)(rt + (size_t)row * 1024 + gc0)); } }
        }
    }
};
struct EpiGates {
    static constexpr bool PERM = true;
    bf16_t *ga, *rt; const float* gate_bias;
    __device__ __forceinline__ void operator()(const AccT& acc, const pg8::Unit& un, int wr, int wc, int fr, int fq) const {
        const int row0 = un.pm * 256 + wr * 64 + fr, cg = 32 * wc + 8 * fq, gc0 = un.pn * 128 + cg;
        const f32x4 ba0 = *(const f32x4*)(gate_bias + gc0), ba1 = *(const f32x4*)(gate_bias + gc0 + 4), bc0 = *(const f32x4*)(gate_bias + 1024 + gc0), bc1 = *(const f32x4*)(gate_bias + 1024 + gc0 + 4);
#pragma unroll
        for (int ai = 0; ai < 2; ++ai)
#pragma unroll
            for (int m = 0; m < 4; ++m) { const int row = row0 + ai * 128 + m * 16;
                const f32x4 a0 = acc[ai][0][m][0] + ba0, a1 = acc[ai][0][m][1] + ba1, c0 = acc[ai][1][m][0] + bc0, c1 = acc[ai][1][m][1] + bc1;
                f32x4 g0, g1, r0, r1;
#pragma unroll
                for (int e = 0; e < 4; ++e) { const float ea0 = 1.0f + __expf(-a0[e]), ea1 = 1.0f + __expf(-a1[e]);
                    g0[e] = __builtin_amdgcn_rcpf(ea0); g1[e] = __builtin_amdgcn_rcpf(ea1);
                    r0[e] = ea0 * __builtin_amdgcn_rcpf(1.0f + __expf(-c0[e])); r1[e] = ea1 * __builtin_amdgcn_rcpf(1.0f + __expf(-c1[e])); }
                { u32x4 wg_, wr_; wg_.x = pkbf(g0[0], g0[1]); wg_.y = pkbf(g0[2], g0[3]); wg_.z = pkbf(g1[0], g1[1]); wg_.w = pkbf(g1[2], g1[3]);
                  wr_.x = pkbf(r0[0], r0[1]); wr_.y = pkbf(r0[2], r0[3]); wr_.z = pkbf(r1[0], r1[1]); wr_.w = pkbf(r1[2], r1[3]);
                  __builtin_nontemporal_store(wg_, (u32x4*)(ga + (size_t)row * 1024 + gc0)); __builtin_nontemporal_store(wr_, (u32x4*)(rt + (size_t)row * 1024 + gc0)); } }
    }
};
struct EpiMerged {
    static constexpr bool PERM = true;
    const bf16_t* ga; const bf16_t* rt; bf16_t* out;
    __device__ __forceinline__ void scale(AccT& acc, const bf16_t* gsrc, const pg8::Unit& un, int wr, int wc, int fr, int fq) const {
        unsigned off0 = (unsigned)(un.pm * 256 + wr * 64 + fr) * 1024u + (unsigned)(un.pn * 256 + 32 * wc + 8 * fq);
        asm volatile("" : "+v"(off0));
#pragma unroll
        for (int ai = 0; ai < 2; ++ai)
#pragma unroll
            for (int m = 0; m < 4; ++m) {
#pragma unroll
                for (int bj = 0; bj < 2; ++bj) { const u32x4 gw = __builtin_nontemporal_load((const u32x4*)(gsrc + (off0 + (unsigned)((ai * 128 + m * 16) * 1024 + bj * 128))));
                    f32x4& v0 = acc[ai][bj][m][0]; f32x4& v1 = acc[ai][bj][m][1];
                    v0[0] *= bflo(gw.x); v0[1] *= bfhi(gw.x); v0[2] *= bflo(gw.y); v0[3] *= bfhi(gw.y);
                    v1[0] *= bflo(gw.z); v1[1] *= bfhi(gw.z); v1[2] *= bflo(gw.w); v1[3] *= bfhi(gw.w); } }
    }
    __device__ __forceinline__ void mid(AccT& acc, const pg8::Unit& un, int wr, int wc, int fr, int fq) const { scale(acc, rt, un, wr, wc, fr, fq); }
    __device__ __forceinline__ void operator()(AccT& acc, const pg8::Unit& un, int wr, int wc, int fr, int fq) const {
        scale(acc, ga, un, wr, wc, fr, fq);
        const int row0 = un.pm * 256 + wr * 64 + fr, col0 = un.pn * 256 + 32 * wc + 8 * fq;
#pragma unroll
        for (int ai = 0; ai < 2; ++ai)
#pragma unroll
            for (int m = 0; m < 4; ++m) { const int row = row0 + ai * 128 + m * 16;
#pragma unroll
                for (int bj = 0; bj < 2; ++bj) store8bf(out + (size_t)row * 1024 + col0 + bj * 128, acc[ai][bj][m][0], acc[ai][bj][m][1]); }
    }
};
struct EpiOut {
    static constexpr bool PERM = true;
    bf16_t* mix;
    __device__ __forceinline__ void operator()(const AccT& acc, const pg8::Unit& un, int wr, int wc, int fr, int fq) const {
        const int row0 = un.pm * 256 + wr * 64 + fr, col0 = un.pn * 256 + 32 * wc + 8 * fq;
#pragma unroll
        for (int ai = 0; ai < 2; ++ai)
#pragma unroll
            for (int m = 0; m < 4; ++m) { const int row = row0 + ai * 128 + m * 16;
#pragma unroll
                for (int bj = 0; bj < 2; ++bj) store8bf(mix + (size_t)row * 1024 + col0 + bj * 128, acc[ai][bj][m][0], acc[ai][bj][m][1]); }
    }
};
__device__ __forceinline__ unsigned dep_add(unsigned* p) { return __hip_atomic_fetch_add(p, 1u, __ATOMIC_RELAXED, __HIP_MEMORY_SCOPE_AGENT); }
struct EpiSwiGLU {
    static constexpr bool PERM = true;
    unsigned char* hid;
    unsigned* dep; unsigned x, nloc; int G;
    __device__ __forceinline__ void operator()(const AccT& acc, const pg8::Unit& un, int wr, int wc, int fr, int fq) const {
        const int row0 = un.pm * 256 + wr * 64 + fr, col0 = (un.pn & 3) * 128 + 32 * wc + 8 * fq;
#pragma unroll
        for (int ai = 0; ai < 2; ++ai)
#pragma unroll
            for (int m = 0; m < 4; ++m) { const int row = row0 + ai * 128 + m * 16; f32x4 h0, h1;
#pragma unroll
                for (int e = 0; e < 4; ++e) { const float g0 = acc[ai][0][m][0][e], g1 = acc[ai][0][m][1][e];
                    h0[e] = g0 * sigmoidf_(g0) * acc[ai][1][m][0][e]; h1[e] = g1 * sigmoidf_(g1) * acc[ai][1][m][1][e]; }
                int w0 = 0, w1 = 0;
                w0 = __builtin_amdgcn_cvt_pk_fp8_f32(h0[0], h0[1], w0, false); w0 = __builtin_amdgcn_cvt_pk_fp8_f32(h0[2], h0[3], w0, true);
                w1 = __builtin_amdgcn_cvt_pk_fp8_f32(h1[0], h1[1], w1, false); w1 = __builtin_amdgcn_cvt_pk_fp8_f32(h1[2], h1[3], w1, true);
                *(u32x2*)(hid + (size_t)row * 512 + col0) = (u32x2){(unsigned)w0, (unsigned)w1}; }
        const int L = un.pm * 4 + (un.pn & 3);
        if (dep != nullptr && L >= 3 * G) {
            asm volatile("s_waitcnt vmcnt(0)" ::: "memory");
            __syncthreads();
            if (threadIdx.x == 0) {
                if (L < 4 * G) { const unsigned old = dep_add(dep + 64 * x);
                    if (old + 1u == nloc) { __builtin_amdgcn_fence(__ATOMIC_RELEASE, "agent"); asm volatile("s_waitcnt vmcnt(0)" ::: "memory"); (void)dep_add(dep + 64 * 16); } }
                else { __builtin_amdgcn_fence(__ATOMIC_RELEASE, "agent"); asm volatile("s_waitcnt vmcnt(0)" ::: "memory"); (void)dep_add(dep + 64 * 17); }
            }
        }
    }
};
struct EpiYs {
    static constexpr bool PERM = true;
    unsigned char* ys;
    __device__ __forceinline__ void operator()(const AccT& acc, const pg8::Unit& un, int wr, int wc, int fr, int fq) const {
        const int row0 = un.pm * 256 + wr * 64 + fr, col0 = (un.pn & 3) * 256 + 32 * wc + 8 * fq;
#pragma unroll
        for (int ai = 0; ai < 2; ++ai)
#pragma unroll
            for (int m = 0; m < 4; ++m) { const int row = row0 + ai * 128 + m * 16;
#pragma unroll
                for (int bj = 0; bj < 2; ++bj) { const f32x4 v0 = acc[ai][bj][m][0], v1 = acc[ai][bj][m][1]; int w0 = 0, w1 = 0;
                    w0 = __builtin_amdgcn_cvt_pk_fp8_f32(v0[0], v0[1], w0, false); w0 = __builtin_amdgcn_cvt_pk_fp8_f32(v0[2], v0[3], w0, true);
                    w1 = __builtin_amdgcn_cvt_pk_fp8_f32(v1[0], v1[1], w1, false); w1 = __builtin_amdgcn_cvt_pk_fp8_f32(v1[2], v1[3], w1, true);
                    *(u32x2*)(ys + (size_t)row * 1024 + col0 + bj * 128) = (u32x2){(unsigned)w0, (unsigned)w1}; } }
    }
};

namespace attn_body {
using bf16 = __hip_bfloat16;
constexpr int D = 64, QP = 512, KP = 128, OP = 1024, OCOL = 512;
constexpr int NW = 8, QBLK = 32, QB = QBLK * NW, KVBLK = 64;
__device__ __forceinline__ int crow(int r, int hi) { return (r & 3) + 8 * (r >> 2) + 4 * hi; }
#define SBAR() __builtin_amdgcn_sched_barrier(0)
__device__ __forceinline__ void cmask(f32x16& p0, f32x16& p1, int jb, int qrel, int hi) {
    const float NEG = -INFINITY; int kb = 64 * jb + 4 * hi;
#pragma unroll
    for (int r = 0; r < 16; ++r) { int kv = kb + (r & 3) + 8 * (r >> 2); if (kv > qrel) p0[r] = NEG; if (kv + 32 > qrel) p1[r] = NEG; }
}
constexpr int NSLOT = 3, SLOTB = 8192;
constexpr int LDS_K = 0, LDS_V = NSLOT * SLOTB, LDS_WS = 2 * NSLOT * SLOTB, LDS_OST = LDS_WS + NW * 64 * 4, LDS_QF = LDS_OST + NW * 4096, LDS_BYTES_A = LDS_QF + NW * 4096;
static_assert(LDS_BYTES_A <= 131072, "attention LDS");
__device__ __forceinline__ void glds16(const void* gsrc, unsigned lds_dst) { unsigned keep;
    asm volatile("s_mov_b32 %0, m0\n\ts_mov_b32 m0, %2\n\ts_nop 0\n\tglobal_load_lds_dwordx4 %1, off\n\ts_mov_b32 m0, %0" : "=&s"(keep) : "v"(gsrc), "s"(lds_dst) : "memory"); }
__device__ __forceinline__ float max3f(float a, float b, float c) { float r; asm("v_max3_f32 %0, %1, %2, %3" : "=v"(r) : "v"(a), "v"(b), "v"(c)); return r; }
__device__ __forceinline__ float max2f(float a, float b) { float r; asm("v_max_f32_e32 %0, %1, %2" : "=v"(r) : "v"(a), "v"(b)); return r; }
__device__ __forceinline__ float fadd_s(float a, float b) { float r; asm("v_add_f32_e32 %0, %1, %2" : "=v"(r) : "v"(a), "v"(b)); return r; }
__device__ __forceinline__ float fsub_s(float a, float b) { float r; asm("v_sub_f32_e32 %0, %1, %2" : "=v"(r) : "v"(a), "v"(b)); return r; }
__device__ __forceinline__ unsigned cvtpk_s(float lo, float hi) { return pkbf(lo, hi); }
__device__ __forceinline__ float msel(float x, float neg, unsigned long long m) { float r; asm("v_cndmask_b32_e64 %0, %1, %2, %3" : "=v"(r) : "v"(neg), "v"(x), "s"(m)); return r; }
#define WAIT_BAR(N) asm volatile("s_waitcnt vmcnt(" #N ") lgkmcnt(0)\n\ts_barrier" ::: "memory")

typedef __attribute__((address_space(3))) const char* lds_cptr;
__device__ __forceinline__ void qkt(f32x16& p0, f32x16& p1, const char* Kslot, lds_cptr qfp, const f32x16& negm, int r32, int hi) {
    const char* kb = Kslot + hi * 1024 + r32 * 16;
#pragma unroll
    for (int d0 = 0; d0 < 4; ++d0) {
        const bf16x8 b0 = *reinterpret_cast<const bf16x8*>(kb + d0 * 2048);
        const bf16x8 b1 = *reinterpret_cast<const bf16x8*>(kb + d0 * 2048 + 512);
        const bf16x8 qd = *(const LAS bf16x8*)(qfp + d0 * 1024);
        if (d0 == 0) { p0 = __builtin_amdgcn_mfma_f32_32x32x16_bf16(b0, qd, negm, 0, 0, 0); p1 = __builtin_amdgcn_mfma_f32_32x32x16_bf16(b1, qd, negm, 0, 0, 0); }
        else { p0 = __builtin_amdgcn_mfma_f32_32x32x16_bf16(b0, qd, p0, 0, 0, 0); p1 = __builtin_amdgcn_mfma_f32_32x32x16_bf16(b1, qd, p1, 0, 0, 0); } }
}
typedef short v4i16_t __attribute__((ext_vector_type(4)));
__device__ __forceinline__ void kload8(bf16x8* kf, lds_cptr kp) {
    kf[0] = *(const LAS bf16x8*)(kp);        kf[1] = *(const LAS bf16x8*)(kp + 512);
    kf[2] = *(const LAS bf16x8*)(kp + 2048); kf[3] = *(const LAS bf16x8*)(kp + 2560);
    kf[4] = *(const LAS bf16x8*)(kp + 4096); kf[5] = *(const LAS bf16x8*)(kp + 4608);
    kf[6] = *(const LAS bf16x8*)(kp + 6144); kf[7] = *(const LAS bf16x8*)(kp + 6656);
}
__device__ __forceinline__ void kload2(bf16x8* kf, lds_cptr kp, int j) { kf[2 * j] = *(const LAS bf16x8*)(kp + j * 2048); kf[2 * j + 1] = *(const LAS bf16x8*)(kp + j * 2048 + 512); }
__device__ __forceinline__ s16x4 vtr(lds_cptr p) { return __builtin_bit_cast(s16x4, __builtin_amdgcn_ds_read_tr16_b64_v4i16((LAS v4i16_t*)p)); }
__device__ __forceinline__ float rowmax(const f32x16& p0, const f32x16& p1) {
    float a = max3f(p0[0], p0[1], p1[0]), b = max3f(p0[2], p0[3], p1[1]); a = max3f(a, p1[2], p1[3]);
#pragma unroll
    for (int r = 4; r < 16; r += 4) { a = max3f(a, p0[r], p0[r + 1]); b = max3f(b, p0[r + 2], p0[r + 3]); a = max3f(a, p1[r], p1[r + 1]); b = max3f(b, p1[r + 2], p1[r + 3]); }
    const float m = max2f(a, b);
    auto rr = __builtin_amdgcn_permlane32_swap(__float_as_uint(m), __float_as_uint(m), false, false);
    return max2f(__uint_as_float(rr[0]), __uint_as_float(rr[1]));
}
__device__ __forceinline__ void pv(f32x16* o, int vb, bf16x8 pa0, bf16x8 pa1, bf16x8 pa2, bf16x8 pa3) {
#pragma unroll
    for (int d0 = 0; d0 < 2; ++d0) { s16x4 lo[4], hi[4];
#pragma unroll
        for (int ks = 0; ks < 4; ++ks) {
            asm volatile("ds_read_b64_tr_b16 %0,%1 offset:%c2" : "=&v"(lo[ks]) : "v"(vb), "i"(d0 * 4096 + ks * 1024) : "memory");
            asm volatile("ds_read_b64_tr_b16 %0,%1 offset:%c2" : "=&v"(hi[ks]) : "v"(vb), "i"(d0 * 4096 + ks * 1024 + 512) : "memory"); }
        asm volatile("s_waitcnt lgkmcnt(0)" ::: "memory"); SBAR();
#define PK(k) (bf16x8){lo[k][0], lo[k][1], lo[k][2], lo[k][3], hi[k][0], hi[k][1], hi[k][2], hi[k][3]}
        o[d0] = __builtin_amdgcn_mfma_f32_32x32x16_bf16(pa0, PK(0), o[d0], 0, 0, 0);
        o[d0] = __builtin_amdgcn_mfma_f32_32x32x16_bf16(pa1, PK(1), o[d0], 0, 0, 0);
        o[d0] = __builtin_amdgcn_mfma_f32_32x32x16_bf16(pa2, PK(2), o[d0], 0, 0, 0);
        o[d0] = __builtin_amdgcn_mfma_f32_32x32x16_bf16(pa3, PK(3), o[d0], 0, 0, 0);
#undef PK
    }
}
#define ATTN_STORE16(p, v) (*(u32x4*)(p) = (v))
template <int THRL> __device__ __forceinline__ void attn_unit(int b, int h, int qb, const bf16* Q, const bf16* __restrict__ K, const bf16* __restrict__ V, bf16* O, const unsigned* masks, char* shm) {
    const int tid = threadIdx.x, lane = tid & 63, r32 = lane & 31, hi = lane >> 5; const int wid = __builtin_amdgcn_readfirstlane(tid >> 6);
    const long rowbase = (long)b * SEQ; const int q0 = qb * QB;
    const bf16* Qw = Q + (rowbase + q0 + wid * QBLK) * QP + h * D;
    const bf16 *Kh = K + rowbase * KP + (h >> 2) * D, *Vh = V + rowbase * KP + (h >> 2) * D;
    const unsigned* mrow = masks + ((size_t)(b * (SEQ / 32) + (q0 >> 5) + wid) * (SEQ / 64)) * 64;
    const unsigned lds0 = (unsigned)(uintptr_t)shm;
    float* wsf = (float*)(shm + LDS_WS) + wid * 64;
    const bf16* ksrc = Kh + (long)lane * KP + wid * 8;
    const bf16* vsrc = Vh + (long)(16 * (wid & 3) + (lane >> 2)) * KP + (wid >> 2) * 32 + (lane & 3) * 8;
    const unsigned kdst = lds0 + LDS_K + wid * 1024, vdst = lds0 + LDS_V + wid * 1024;
#define DMA_K(t, slot) glds16(ksrc + (long)(t) * KVBLK * KP, (unsigned)__builtin_amdgcn_readfirstlane(kdst + (slot)))
#define DMA_V(t, slot) glds16(vsrc + (long)(t) * KVBLK * KP, (unsigned)__builtin_amdgcn_readfirstlane(vdst + (slot)))
    const int vb0 = (int)(lds0 + LDS_V) + ((lane >> 4) & 1) * 32 + (lane & 3) * 8 + (4 * hi + ((lane & 15) >> 2)) * 64;
    const char* Kbase = shm + LDS_K; bf16x8 kf[8];
    const lds_cptr shm3 = (lds_cptr)shm; const lds_cptr kp0 = shm3 + LDS_K + hi * 1024 + r32 * 16; const lds_cptr vp0 = shm3 + LDS_V + ((lane >> 4) & 1) * 32 + (lane & 3) * 8 + (4 * hi + ((lane & 15) >> 2)) * 64;
    const int NT = (q0 + QB) / KVBLK;
    u32x16 mA, mB;
#define MLOAD0(t) do { const unsigned* mp_ = mrow + (size_t)(t) * 64; \
        asm volatile("s_load_dwordx16 %0, %1, 0x0" : "=s"(mA) : "s"(mp_)); asm volatile("s_load_dwordx16 %0, %1, 0x40" : "=s"(mB) : "s"(mp_)); } while (0)
#define MLOAD1(t) do { const unsigned* mp_ = mrow + (size_t)(t) * 64; \
        asm volatile("s_load_dwordx16 %0, %1, 0x80" : "=s"(mA) : "s"(mp_)); asm volatile("s_load_dwordx16 %0, %1, 0xc0" : "=s"(mB) : "s"(mp_)); } while (0)
#define MPAIR(M, j) (((unsigned long long)(M)[2 * (j) + 1] << 32) | (unsigned long long)(M)[2 * (j)])
#define MAPPLY(P) do { asm volatile("s_waitcnt lgkmcnt(0)" : "+s"(mA), "+s"(mB)); const float NEG_ = -INFINITY; \
        _Pragma("unroll") for (int r = 0; r < 8; ++r) { P[r] = msel(P[r], NEG_, MPAIR(mA, r)); P[r + 8] = msel(P[r + 8], NEG_, MPAIR(mB, r)); } } while (0)
    DMA_K(0, 0); DMA_V(0, 0); DMA_K(1, SLOTB);
    MLOAD0(0);
    const lds_cptr qfp = shm3 + LDS_QF + wid * 4096 + lane * 16;
    { bf16x8 qr[4];
#pragma unroll
      for (int d0 = 0; d0 < 4; ++d0) qr[d0] = *reinterpret_cast<const bf16x8*>(&Qw[(long)r32 * QP + d0 * 16 + hi * 8]);
#pragma unroll
      for (int d0 = 0; d0 < 4; ++d0) *(LAS bf16x8*)(LAS char*)(qfp + d0 * 1024) = qr[d0]; }
#define QF(i) (*(const LAS bf16x8*)(qfp + (i) * 1024))
    float mhat = 0.f, l_reg = 0.f; f32x16 o[2]; o[0] = f32x16{}; o[1] = f32x16{}; f32x16 negm = f32x16{}; asm volatile("" : "+v"(negm));
    const int qrel = wid * QBLK + r32;
#define CMASK(P0, P1, t) do { int jb_ = (t) - (NT - 4); if (jb_ >= 0) cmask(P0, P1, jb_, qrel, hi); } while (0)
    bool resc = false;
#define START(P0, P1) do { const float rm = rowmax(P0, P1); resc = false; \
    { const float dl = rm; mhat = fadd_s(mhat, dl); \
      _Pragma("unroll") for (int r = 0; r < 16; ++r) { P0[r] = fsub_s(P0[r], dl); P1[r] = fsub_s(P1[r], dl); } \
      _Pragma("unroll") for (int r = 0; r < 16; ++r) negm[r] = -mhat; asm volatile("" : "+v"(negm)); } } while (0)
#define RESC() do { if (resc) { asm volatile("s_waitcnt lgkmcnt(0)" ::: "memory"); \
      _Pragma("unroll") for (int d_ = 0; d_ < 2; ++d_) _Pragma("unroll") for (int r = 0; r < 16; ++r) o[d_][r] *= wsf[crow(r, hi)]; } } while (0)
    f32x16 pA0, pA1, pB0, pB1;
    int sl_prev = 0, sl_cur = 0, sl_next = SLOTB;
#define ROT() do { sl_prev = sl_cur; sl_cur = sl_next; sl_next = (sl_next == (NSLOT - 1) * SLOTB) ? 0 : sl_next + SLOTB; } while (0)
    DMA_K(2, 2 * SLOTB);
    WAIT_BAR(3);
    qkt(pA0, pA1, Kbase, qfp, negm, r32, hi); asm volatile("s_nop 15\n\ts_nop 7" : "+v"(pA0), "+v"(pA1)); CMASK(pA0, pA1, 0);
    START(pA0, pA1);
    MAPPLY(pA0); MLOAD1(0); MAPPLY(pA1); MLOAD0(1);
    _Pragma("unroll") for (int r = 0; r < 16; ++r) { pA0[r] = __builtin_amdgcn_exp2f(pA0[r]); pA1[r] = __builtin_amdgcn_exp2f(pA1[r]); }
    WAIT_BAR(0);
    DMA_K(3, 0); DMA_V(1, SLOTB);
    ROT();
    kload8(kf, kp0 + sl_cur);
    WAIT_BAR(2);
    s16x4 vlo[8], vhi[8]; u32x4 pw0, pw1, pw2, pw3;
#define PKW(P, B) cvtpk_s(P[B], P[B + 1])
#define PAF(k) __builtin_bit_cast(bf16x8, pw##k)
#define VFR(i) (bf16x8){vlo[i][0], vlo[i][1], vlo[i][2], vlo[i][3], vhi[i][0], vhi[i][1], vhi[i][2], vhi[i][3]}
#define PIN(x) asm volatile("" : "+v"(x))
#define MX3(a, b, c) __builtin_fmaxf(__builtin_fmaxf((a), (b)), (c))
#define GAPA(MF, A0, A1, A2, A3, W0, W1, PW) do { MF; sacc += A0; sacc += A1; sacc += A2; sacc += A3; PIN(sacc); W0; W1; PIN(PW); SBAR(); } while (0)
#define EX(v) __builtin_amdgcn_exp2f(v)
#define GAPB(MF, X, B) do { MF; X[B] = EX(X[B]); X[B + 1] = EX(X[B + 1]); X[B + 2] = EX(X[B + 2]); X[B + 3] = EX(X[B + 3]); PIN(X); SBAR(); } while (0)
#define VRD(i) do { vlo[i] = vtr(vp_ + (((i) >> 2) * 4096 + ((i) & 3) * 1024)); vhi[i] = vtr(vp_ + (((i) >> 2) * 4096 + ((i) & 3) * 1024 + 512)); } while (0)
#define KRD(G, j) do { if (G) { kload2(kf, kp0 + sl_next, j); SBAR(); } } while (0)
#define STEP(C0, C1, P0, P1, t, GK, GV, GL, GM) do { SBAR(); \
    const lds_cptr vp_ = vp0 + sl_prev; \
    VRD(0); bf16x8 qa_ = QF(0), qb_ = QF(1); SBAR(); float sacc = (P0[0] + P0[1]); \
    GAPA(C0 = __builtin_amdgcn_mfma_f32_32x32x16_bf16(kf[0], qa_, negm, 0, 0, 0), P0[2], P0[3], P0[4], P0[5],     pw0[0] = PKW(P0, 0), pw0[1] = PKW(P0, 2), pw0); \
    VRD(4); SBAR(); GAPA(C1 = __builtin_amdgcn_mfma_f32_32x32x16_bf16(kf[1], qa_, negm, 0, 0, 0), P0[6], P0[7], P0[8], P0[9],     pw0[2] = PKW(P0, 4), pw0[3] = PKW(P0, 6), pw0); \
    VRD(1); qa_ = QF(2); SBAR(); GAPA(C0 = __builtin_amdgcn_mfma_f32_32x32x16_bf16(kf[2], qb_, C0, 0, 0, 0),   P0[10], P0[11], P0[12], P0[13], pw1[0] = PKW(P0, 8), pw1[1] = PKW(P0, 10), pw1); \
    VRD(5); SBAR(); GAPA(C1 = __builtin_amdgcn_mfma_f32_32x32x16_bf16(kf[3], qb_, C1, 0, 0, 0),   P0[14], P0[15], P1[0], P1[1],   pw1[2] = PKW(P0, 12), pw1[3] = PKW(P0, 14), pw1); \
    VRD(2); qb_ = QF(3); SBAR(); GAPA(C0 = __builtin_amdgcn_mfma_f32_32x32x16_bf16(kf[4], qa_, C0, 0, 0, 0),   P1[2], P1[3], P1[4], P1[5],     pw2[0] = PKW(P1, 0), pw2[1] = PKW(P1, 2), pw2); \
    VRD(6); SBAR(); GAPA(C1 = __builtin_amdgcn_mfma_f32_32x32x16_bf16(kf[5], qa_, C1, 0, 0, 0),   P1[6], P1[7], P1[8], P1[9],     pw2[2] = PKW(P1, 4), pw2[3] = PKW(P1, 6), pw2); \
    VRD(3); SBAR(); GAPA(C0 = __builtin_amdgcn_mfma_f32_32x32x16_bf16(kf[6], qb_, C0, 0, 0, 0),   P1[10], P1[11], P1[12], P1[13], pw3[0] = PKW(P1, 8), pw3[1] = PKW(P1, 10), pw3); \
    VRD(7); SBAR(); GAPA(C1 = __builtin_amdgcn_mfma_f32_32x32x16_bf16(kf[7], qb_, C1, 0, 0, 0),   P1[14], P1[15], 0.f, 0.f,       pw3[2] = PKW(P1, 12), pw3[3] = PKW(P1, 14), pw3); \
    l_reg += sacc; \
    if (GK) { DMA_K((t) + 3, sl_cur); } if (GV) { DMA_V((t) + 1, sl_next); } \
    CMASK(C0, C1, t); \
    { float a = MX3(C0[0], C0[1], C1[0]), b = MX3(C0[2], C0[3], C1[1]); a = MX3(a, C1[2], C1[3]); \
      _Pragma("unroll") for (int r = 4; r < 16; r += 4) { a = MX3(a, C0[r], C0[r + 1]); b = MX3(b, C0[r + 2], C0[r + 3]); a = MX3(a, C1[r], C1[r + 1]); b = MX3(b, C1[r + 2], C1[r + 3]); } \
      float rm = __builtin_fmaxf(a, b); { auto rr = __builtin_amdgcn_permlane32_swap(__float_as_uint(rm), __float_as_uint(rm), false, false); rm = __builtin_fmaxf(__uint_as_float(rr[0]), __uint_as_float(rr[1])); } \
      resc = false; \
      if (__builtin_expect(__any(rm > (float)THRL), 0)) { const float dl = __builtin_fmaxf(rm, 0.f); mhat += dl; \
        _Pragma("unroll") for (int r = 0; r < 16; ++r) { C0[r] -= dl; C1[r] -= dl; } \
        _Pragma("unroll") for (int r = 0; r < 16; ++r) negm[r] = -mhat; asm volatile("" : "+v"(negm)); \
        const float f = __builtin_amdgcn_exp2f(-dl); l_reg *= f; if (hi == 0) wsf[r32] = f; resc = true; } } \
    MAPPLY(C0); MLOAD1(t); \
    SBAR(); \
    GAPB(o[0] = __builtin_amdgcn_mfma_f32_32x32x16_bf16(PAF(0), VFR(0), o[0], 0, 0, 0), C0, 0); \
    GAPB(o[1] = __builtin_amdgcn_mfma_f32_32x32x16_bf16(PAF(0), VFR(4), o[1], 0, 0, 0), C0, 4); \
    KRD(GL, 0); GAPB(o[0] = __builtin_amdgcn_mfma_f32_32x32x16_bf16(PAF(1), VFR(1), o[0], 0, 0, 0), C0, 8); \
    KRD(GL, 1); GAPB(o[1] = __builtin_amdgcn_mfma_f32_32x32x16_bf16(PAF(1), VFR(5), o[1], 0, 0, 0), C0, 12); \
    MAPPLY(C1); if (GM) { MLOAD0((t) + 1); } SBAR(); \
    KRD(GL, 2); GAPB(o[0] = __builtin_amdgcn_mfma_f32_32x32x16_bf16(PAF(2), VFR(2), o[0], 0, 0, 0), C1, 0); \
    KRD(GL, 3); GAPB(o[1] = __builtin_amdgcn_mfma_f32_32x32x16_bf16(PAF(2), VFR(6), o[1], 0, 0, 0), C1, 4); \
    GAPB(o[0] = __builtin_amdgcn_mfma_f32_32x32x16_bf16(PAF(3), VFR(3), o[0], 0, 0, 0), C1, 8); \
    GAPB(o[1] = __builtin_amdgcn_mfma_f32_32x32x16_bf16(PAF(3), VFR(7), o[1], 0, 0, 0), C1, 12); \
    } while (0)
    int t = 1;
#undef CMASK
#define CMASK(P0, P1, t) do { } while (0)
    for (; t + 5 < NT; t += 2) {
        STEP(pB0, pB1, pA0, pA1, t, true, true, true, true);     WAIT_BAR(2); RESC(); ROT();
        STEP(pA0, pA1, pB0, pB1, t + 1, true, true, true, true); WAIT_BAR(2); RESC(); ROT();
    }
#undef CMASK
#define CMASK(P0, P1, t) do { int jb_ = (t) - (NT - 4); if (jb_ >= 0) cmask(P0, P1, jb_, qrel, hi); } while (0)
#define ENDW(tt) do { if ((tt) + 3 < NT) { WAIT_BAR(2); } else if ((tt) + 2 < NT) { WAIT_BAR(1); } else { WAIT_BAR(0); } } while (0)
    for (; t + 1 < NT; t += 2) {
        STEP(pB0, pB1, pA0, pA1, t, (t + 3 < NT), (t + 1 < NT), (t + 1 < NT), (t + 1 < NT));         ENDW(t);     RESC(); ROT();
        STEP(pA0, pA1, pB0, pB1, t + 1, (t + 4 < NT), (t + 2 < NT), (t + 2 < NT), (t + 2 < NT));     ENDW(t + 1); RESC(); ROT();
    }
    STEP(pB0, pB1, pA0, pA1, NT - 1, false, false, false, false); RESC();
    { float sacc = pB0[0] + pB0[1]; _Pragma("unroll") for (int r = 2; r < 16; ++r) sacc += pB0[r]; _Pragma("unroll") for (int r = 0; r < 16; ++r) sacc += pB1[r]; l_reg += sacc;
      pw0 = (u32x4){PKW(pB0, 0), PKW(pB0, 2), PKW(pB0, 4), PKW(pB0, 6)}; pw1 = (u32x4){PKW(pB0, 8), PKW(pB0, 10), PKW(pB0, 12), PKW(pB0, 14)}; pw2 = (u32x4){PKW(pB1, 0), PKW(pB1, 2), PKW(pB1, 4), PKW(pB1, 6)}; pw3 = (u32x4){PKW(pB1, 8), PKW(pB1, 10), PKW(pB1, 12), PKW(pB1, 14)};
      SBAR(); pv(o, vb0 + sl_cur, PAF(0), PAF(1), PAF(2), PAF(3)); }
#undef PKW
#undef PAF
#undef VFR
#undef PIN
#undef MX3
#undef GAPA
#undef GAPB
#undef EX
#undef VRD
#undef KRD
#undef STEP
#undef ENDW
    { auto rr = __builtin_amdgcn_permlane32_swap(__float_as_uint(l_reg), __float_as_uint(l_reg), false, false); l_reg = __uint_as_float(rr[0]) + __uint_as_float(rr[1]); }
    if (hi == 0) wsf[32 + r32] = l_reg; asm volatile("s_waitcnt lgkmcnt(0)" ::: "memory");
    float rli[16];
#pragma unroll
    for (int r = 0; r < 16; ++r) rli[r] = __builtin_amdgcn_rcpf(wsf[32 + crow(r, hi)]);
    bf16* Ow = O + (rowbase + q0 + wid * QBLK) * OP + OCOL + h * D;
    { bf16* stg = (bf16*)(shm + LDS_OST) + wid * 2048;
#pragma unroll
      for (int r = 0; r < 16; ++r) { const int orow = crow(r, hi);
#pragma unroll
        for (int d0 = 0; d0 < 2; ++d0) stg[orow * 64 + d0 * 32 + r32] = __float2bfloat16(o[d0][r] * rli[r]); }
      asm volatile("s_waitcnt lgkmcnt(0)" ::: "memory");
#pragma unroll
      for (int i = 0; i < 4; ++i) { const int row = i * 8 + (lane >> 3), ch = lane & 7; const u32x4 v = *(const u32x4*)(stg + row * 64 + ch * 8); ATTN_STORE16(Ow + (long)row * OP + ch * 8, v); } }
    asm volatile("s_waitcnt lgkmcnt(0)\n\ts_barrier" ::: "memory");
#undef DMA_K
#undef DMA_V
#undef CMASK
#undef START
#undef RESC
#undef ROT
#undef MLOAD0
#undef MLOAD1
#undef MPAIR
#undef QF
#undef MAPPLY
}
#undef SBAR
#undef WAIT_BAR
}

#define XB_TMO      128
#define XB_XCNT(j)  (256  + 64 * (j))
#define XB_XSUB(j)  (1280 + 64 * (j))
#define XB_XGEN(j)  (2304 + 64 * (j))
#define XB_TOP      3328
#define XB_TOPGEN   3392
#define XCD_BAR_WORDS 3456
#define XB_SPIN_CAP (1u << 18)
__device__ __forceinline__ unsigned xb_ld(unsigned* p)              { return __hip_atomic_load(p, __ATOMIC_RELAXED, __HIP_MEMORY_SCOPE_AGENT); }
__device__ __forceinline__ unsigned xb_add(unsigned* p, unsigned v) { return __hip_atomic_fetch_add(p, v, __ATOMIC_RELAXED, __HIP_MEMORY_SCOPE_AGENT); }
__device__ __forceinline__ unsigned xb_xcc_id() { return (unsigned)__builtin_amdgcn_s_getreg((3 << 11) | 20) & 0xFu; }
#define XB_SPIN(cond, bar) do { unsigned _sp = 0; while (cond) { __builtin_amdgcn_s_sleep(1); \
    if ((++_sp & 255u) == 0u) { if (xb_ld(&(bar)[XB_TMO])) break; if (_sp > XB_SPIN_CAP) { atomicAdd(&(bar)[XB_TMO], 1u); break; } } } } while (0)
struct XcdBarrier { unsigned* bar; unsigned x; volatile LAS unsigned* st; };
__device__ __forceinline__ XcdBarrier xcd_barrier_post(unsigned* bar, volatile LAS unsigned* st) {
    XcdBarrier b; b.bar = bar; b.x = xb_xcc_id(); b.st = st;
    if (threadIdx.x == 0) (void)xb_add(&bar[XB_XCNT(b.x)], 1u);
    return b;
}
__device__ __forceinline__ void xcd_barrier_complete(unsigned* bar, unsigned x, unsigned& nloc, unsigned& nx) {
    const unsigned G = gridDim.x * gridDim.y * gridDim.z;
    unsigned sum, cnt, mine, sp = 0u;
    for (;;) {
        sum = 0u; cnt = 0u; mine = 0u;
#pragma unroll
        for (unsigned j = 0; j < 16; ++j) { const unsigned c = xb_ld(&bar[XB_XCNT(j)]); sum += c; cnt += (c > 0u) ? 1u : 0u; mine = (j == x) ? c : mine; }
        if (sum == G) break;
        __builtin_amdgcn_s_sleep(1);
        if ((++sp & 255u) == 0u) { if (xb_ld(&bar[XB_TMO])) break; if (sp > XB_SPIN_CAP) { atomicAdd(&bar[XB_TMO], 1u); break; } }
    }
    nloc = mine > 0u ? mine : 1u; nx = cnt > 0u ? cnt : 1u;
}
__device__ __forceinline__ void xcd_barrier(const XcdBarrier& b) {
    asm volatile("s_waitcnt vmcnt(0)" ::: "memory");
    __syncthreads();
    if (threadIdx.x == 0) {
        unsigned* bar = b.bar;
        __builtin_amdgcn_s_waitcnt(0);
        unsigned nloc = b.st[0], nx = b.st[1];
        if (nloc == 0u) { xcd_barrier_complete(bar, b.x, nloc, nx); b.st[0] = nloc; b.st[1] = nx; }
        const unsigned old = xb_add(&bar[XB_XSUB(b.x)], 1u);
        const unsigned gen = old / nloc;
        if (old + 1u == (gen + 1u) * nloc) {
            __builtin_amdgcn_fence(__ATOMIC_RELEASE, "agent");
            asm volatile("s_waitcnt vmcnt(0)" ::: "memory");
            const unsigned og = xb_add(&bar[XB_TOP], 1u);
            const unsigned tg = og / nx;
            if (og + 1u == (tg + 1u) * nx) xb_add(&bar[XB_TOPGEN], 1u);
            else XB_SPIN(xb_ld(&bar[XB_TOPGEN]) == tg, bar);
            __builtin_amdgcn_fence(__ATOMIC_ACQUIRE, "agent");
            xb_add(&bar[XB_XGEN(b.x)], 1u);
            asm volatile("s_waitcnt vmcnt(0)" ::: "memory");
        } else {
            XB_SPIN(xb_ld(&bar[XB_XGEN(b.x)]) == gen, bar);
            __builtin_amdgcn_fence(__ATOMIC_ACQUIRE, "agent");
            asm volatile("s_waitcnt vmcnt(0)" ::: "memory");
        }
    }
    __syncthreads();
}

struct Frame {
    LAS unsigned char* lds; volatile LAS unsigned* MISC; unsigned* ctl;
    int tid, lane, wave, vcu, G;
    unsigned char* ws;
};
struct Args { const float* in[18]; float* out; unsigned char* ws; int ph_lo, ph_hi, flags, pad; };
typedef const __attribute__((address_space(4))) Args* KArgs;
__device__ __forceinline__ KArgs kargs() { KArgs p = (KArgs)__builtin_amdgcn_kernarg_segment_ptr(); asm volatile("" : "+s"(p)); return p; }

__device__ __forceinline__ int ropeperm(int d) { return d < 8 ? 2 * d : (d < 16 ? 2 * (d - 8) + 1 : d); }
__device__ __forceinline__ int win_row(int c) {
    if (c < 512)  return (c & ~63) + ropeperm(c & 63);
    if (c < 640)  { const int cc = c - 512; return 512 + (cc & ~63) + ropeperm(cc & 63); }
    if (c < 768)  return c;
    if (c < 1280) { const int cc = c - 768; return 768 + (cc & ~63) + ropeperm(cc & 63); }
    if (c < 1344) return 1280 + ropeperm(c - 1280);
    if (c < 1352) return c;
    if (c < 1864) { const int ch = c - 1352; return 1536 + (ch >> 7) * 256 + (ch & 127); }
    if (c < 2376) return 2560 + (c - 1864);
    if (c < 2888) { const int ch = c - 2376; return 1536 + (ch >> 7) * 256 + 128 + (ch & 127); }
    { const int g = c - 2888, gi = g & 1023; return 3072 + (gi >> 7) * 256 + (g >> 10) * 128 + (gi & 127); }
}
struct TItem { const float* src; bf16_t* WT; int N, KT, rbase, mode, n0, k0, kd; };
__device__ __forceinline__ void t_load(const TItem& t, float (&rg)[32], int lane) {
    int nn = t.n0 + (lane & 31); if (nn >= t.N) nn = t.N - 1;
    const float* p = t.src + (size_t)(t.k0 + (lane >> 5)) * t.N + nn;
#pragma unroll
    for (int i = 0; i < 32; ++i) rg[i] = __builtin_nontemporal_load(p + (size_t)(2 * i) * t.N);
}
__device__ __forceinline__ void t_write(const TItem& t, const float (&rg)[32], LAS float* scr, int lane) {
#pragma unroll
    for (int i = 0; i < 32; ++i) scr[(2 * i + (lane >> 5)) * 33 + (lane & 31)] = rg[i];
    LDS_WAIT(); asm volatile("" ::: "memory");
    if (t.mode >= 3) {
        const int c4 = lane & 3;
#pragma unroll
        for (int j = 0; j < 2; ++j) { const int n = (lane >> 2) + 16 * j; const LAS float* sp = scr + (16 * c4) * 33 + n;
            if (t.n0 + n < t.N && !(t.mode == 6 && t.n0 + n >= 1352)) { const int nn = t.n0 + n; const int row = t.mode == 3 ? t.rbase + (nn >> 7) * 256 + (nn & 127) : (t.mode == 5 ? win_row(nn) - 1536 : (t.mode == 6 ? win_row(nn) : t.rbase + nn));
                u32x4 o;
#pragma unroll
                for (int q = 0; q < 4; ++q) { int wv = 0;
                    wv = __builtin_amdgcn_cvt_pk_fp8_f32(32.f * sp[(4 * q + 0) * 33], 32.f * sp[(4 * q + 1) * 33], wv, false);
                    wv = __builtin_amdgcn_cvt_pk_fp8_f32(32.f * sp[(4 * q + 2) * 33], 32.f * sp[(4 * q + 3) * 33], wv, true); o[q] = (unsigned)wv; }
                *(u32x4*)((unsigned char*)t.WT + (size_t)row * t.KT + t.k0 + 16 * c4) = o; } }
        LDS_WAIT(); asm volatile("" ::: "memory");
        return;
    }
    const int c = lane & 7;
#pragma unroll
    for (int j = 0; j < 4; ++j) { const int n = (lane >> 3) + 8 * j; const LAS float* sp = scr + (8 * c) * 33 + n;
        if (t.n0 + n < t.N) { const int nn = t.n0 + n; const int row = t.mode == 0 ? t.rbase + nn : (t.mode == 1 ? win_row(nn) : t.rbase + (nn >> 7) * 256 + (nn & 127));
            u32x4 o; o.x = pkbf(sp[0 * 33], sp[1 * 33]); o.y = pkbf(sp[2 * 33], sp[3 * 33]); o.z = pkbf(sp[4 * 33], sp[5 * 33]); o.w = pkbf(sp[6 * 33], sp[7 * 33]);
            *(u32x4*)(t.WT + (size_t)row * t.KT + t.kd + t.k0 + 8 * c) = o; } }
    LDS_WAIT(); asm volatile("" ::: "memory");
}
__device__ __forceinline__ void p0_prologue(Frame& F) {
    const KArgs ka = kargs();
    unsigned char* ws = F.ws;
    LAS float* scr = (LAS float*)(F.lds + F.wave * 16384);
    constexpr int XW = 6, IW = NWAVES - XW;
    const bool itemw = F.wave >= XW;
    const int gw = F.vcu * IW + (F.wave - XW), NGW = F.G * IW;
    const int gt = F.vcu * (IW * 64) + (F.tid - XW * 64), NGT = F.G * (IW * 64);
    bf16_t* Win = (bf16_t*)(ws + WS_WIN); bf16_t* Wau = (bf16_t*)(ws + WS_WAU); bf16_t* Wout = (bf16_t*)(ws + WS_WOUT);
    bf16_t* Wd = (bf16_t*)(ws + WS_WD); bf16_t* Wgu = (bf16_t*)(ws + WS_WGU);
    constexpr int I_IN = 16 * 49, I_AU = 8 * 32, I_OUT = 16 * 32, I_G8 = 16 * 64 + 16 * 43, I_G = 32 * 16 * 16, I_D = 32 * 8 * 32;
    constexpr int NITEMS = I_IN + 2 * I_AU + I_OUT + I_G8 + 2 * I_G + I_D;
    unsigned char* Win8 = ws + WS_WIN8;
    const float *p_win = ka->in[1], *p_wau = ka->in[3], *p_wcu = ka->in[4], *p_wout = ka->in[6], *p_wg = ka->in[13], *p_wu = ka->in[14], *p_wd = ka->in[15];
#define T_DECODE(IT, T) do { int r_ = (IT); \
        if (r_ < I_IN) { T = TItem{p_win, Win, INW, 1024, 0, 1, 32 * (42 + r_ % 49), 64 * (r_ / 49), 0};     } else { r_ -= I_IN; \
        if (r_ < I_AU) { T = TItem{p_wau, Wau, 1024, 1024, 0, 0, 32 * (r_ % 32), 64 * (r_ / 32), 512};     } else { r_ -= I_AU; \
        if (r_ < I_AU) { T = TItem{p_wcu, Wau, 1024, 1024, 0, 0, 32 * (r_ % 32), 64 * (r_ / 32), 0}; } else { r_ -= I_AU; \
        if (r_ < I_OUT) { T = TItem{p_wout, Wout, 1024, 1024, 0, 0, 32 * (r_ % 32), 64 * (r_ / 32), 0}; } else { r_ -= I_OUT; \
        if (r_ < I_G8) { if (r_ < 16 * 64) { T = TItem{p_win, (bf16_t*)Win8, INW, 1024, 0, 5, 2888 + 32 * (r_ % 64), 64 * (r_ / 64), 0}; }     \
                         else { const int r2_ = r_ - 16 * 64; T = TItem{p_win, (bf16_t*)Win8, INW, 1024, 0, 6, 32 * (r2_ % 43), 64 * (r2_ / 43), 0}; } }     else { r_ -= I_G8; \
        if (r_ < I_G) { const int e_ = r_ >> 8, q_ = r_ & 255; T = TItem{p_wg + (size_t)e_ * 1024 * 512, Wgu, 512, 1024, e_ * 1024, 3, 32 * (q_ & 15), 64 * (q_ >> 4), 0}; } else { r_ -= I_G; \
        if (r_ < I_G) { const int e_ = r_ >> 8, q_ = r_ & 255; T = TItem{p_wu + (size_t)e_ * 1024 * 512, Wgu, 512, 1024, e_ * 1024 + 128, 3, 32 * (q_ & 15), 64 * (q_ >> 4), 0}; } else { r_ -= I_G; \
        { const int e_ = r_ >> 8, q_ = r_ & 255; T = TItem{p_wd + (size_t)e_ * 512 * 1024, Wd, 1024, 512, e_ * 1024, 4, 32 * (q_ & 31), 64 * (q_ >> 5), 0}; } } } } } } } } } while (0)
    const int nitems = (F.G == 256) ? I_IN + 2 * I_AU + I_OUT + I_G8 : NITEMS;
    if (itemw) {
    if (gw < nitems) {
        TItem cur, nxt; float rc[32], rn[32];
        T_DECODE(gw, cur); t_load(cur, rc, F.lane);
        for (int it = gw; it < nitems; it += NGW) {
            const int itn = (it + NGW < nitems) ? it + NGW : it;
            T_DECODE(itn, nxt); t_load(nxt, rn, F.lane);
            t_write(cur, rc, scr, F.lane);
            cur = nxt;
#pragma unroll
            for (int i = 0; i < 32; ++i) rc[i] = rn[i];
        }
    }
#undef T_DECODE
    for (int i = gt; i < 184 * 64; i += NGT) *(u32x4*)(ws + WS_WIN8 + (size_t)1352 * 1024 + (size_t)i * 16) = (u32x4){0u, 0u, 0u, 0u};
    float* rope = (float*)(ws + WS_ROPE);
    for (int i = gt; i < SEQ * 8; i += NGT) { const int pos = i >> 3, j = i & 7;
        const float inv = (float)pow(500000.0, -(double)j / 8.0); const float ang = (float)pos * inv;
        rope[i] = cosf(ang); rope[SEQ * 8 + i] = sinf(ang); }
    { float* wc = (float*)(ws + WS_WC); const float* rgw = ka->in[9]; const float* rew = ka->in[11];
      for (int i = gt; i < 1024 * 48; i += NGT) { const int k = i / 48, c = i % 48;
          wc[i] = c < 4 ? rgw[k * 4 + c] : (c < 36 ? rew[(size_t)((c - 4) >> 3) * 1024 * 8 + k * 8 + ((c - 4) & 7)] : 0.f); } }
    return; }
    const float* x = ka->in[0]; bf16_t* xb = (bf16_t*)(ws + WS_XB);
    const int xt = F.vcu * (XW * 64) + F.tid, NXT = F.G * (XW * 64);
    for (size_t i = xt; i < (size_t)NTOK * DM / 8; i += (size_t)NXT * 4) {
        f32x4 va[4], vb[4];
#pragma unroll
        for (int q = 0; q < 4; ++q) { size_t ii = i + (size_t)q * NXT; if (ii >= (size_t)NTOK * DM / 8) ii = i; va[q] = __builtin_nontemporal_load((const f32x4*)(x + ii * 8)); vb[q] = __builtin_nontemporal_load((const f32x4*)(x + ii * 8 + 4)); }
#pragma unroll
        for (int q = 0; q < 4; ++q) { const size_t ii = i + (size_t)q * NXT; if (ii < (size_t)NTOK * DM / 8) { store8bf(xb + ii * 8, va[q], vb[q]);
            int w0 = 0, w1 = 0;
            w0 = __builtin_amdgcn_cvt_pk_fp8_f32(va[q][0], va[q][1], w0, false); w0 = __builtin_amdgcn_cvt_pk_fp8_f32(va[q][2], va[q][3], w0, true);
            w1 = __builtin_amdgcn_cvt_pk_fp8_f32(vb[q][0], vb[q][1], w1, false); w1 = __builtin_amdgcn_cvt_pk_fp8_f32(vb[q][2], vb[q][3], w1, true);
            *(u32x2*)(ws + WS_XQ + ii * 8) = (u32x2){(unsigned)w0, (unsigned)w1}; } } }
}

__device__ __forceinline__ int dpp_sum_i(int v) {
    v += __builtin_amdgcn_update_dpp(0, v, 0x111, 0xf, 0xf, true); v += __builtin_amdgcn_update_dpp(0, v, 0x112, 0xf, 0xf, true);
    v += __builtin_amdgcn_update_dpp(0, v, 0x114, 0xf, 0xf, true); v += __builtin_amdgcn_update_dpp(0, v, 0x118, 0xf, 0xf, true);
    return __builtin_amdgcn_readlane(v, 15) + __builtin_amdgcn_readlane(v, 31) + __builtin_amdgcn_readlane(v, 47) + __builtin_amdgcn_readlane(v, 63);
}
__device__ __forceinline__ float dpp_shr_f(float v, int ctrl_sel) {
    const int vi = __float_as_int(v);
    return __int_as_float(ctrl_sel == 1 ? __builtin_amdgcn_update_dpp(vi, vi, 0x111, 0xf, 0xf, false) : ctrl_sel == 2 ? __builtin_amdgcn_update_dpp(vi, vi, 0x112, 0xf, 0xf, false)
                        : ctrl_sel == 4 ? __builtin_amdgcn_update_dpp(vi, vi, 0x114, 0xf, 0xf, false) : __builtin_amdgcn_update_dpp(vi, vi, 0x118, 0xf, 0xf, false));
}
__device__ __forceinline__ float dpp_max_f(float v) {
    v = fmaxf(v, dpp_shr_f(v, 1)); v = fmaxf(v, dpp_shr_f(v, 2)); v = fmaxf(v, dpp_shr_f(v, 4)); v = fmaxf(v, dpp_shr_f(v, 8));
    const float a = __int_as_float(__builtin_amdgcn_readlane(__float_as_int(v), 15)), b = __int_as_float(__builtin_amdgcn_readlane(__float_as_int(v), 31));
    const float c = __int_as_float(__builtin_amdgcn_readlane(__float_as_int(v), 47)), d = __int_as_float(__builtin_amdgcn_readlane(__float_as_int(v), 63));
    return fmaxf(fmaxf(a, b), fmaxf(c, d));
}
__device__ __forceinline__ float dpp_min_f(float v) { return -dpp_max_f(-v); }
__device__ __forceinline__ float dpp_sum_f(float v) {
    v += __int_as_float(__builtin_amdgcn_update_dpp(0, __float_as_int(v), 0x111, 0xf, 0xf, true)); v += __int_as_float(__builtin_amdgcn_update_dpp(0, __float_as_int(v), 0x112, 0xf, 0xf, true));
    v += __int_as_float(__builtin_amdgcn_update_dpp(0, __float_as_int(v), 0x114, 0xf, 0xf, true)); v += __int_as_float(__builtin_amdgcn_update_dpp(0, __float_as_int(v), 0x118, 0xf, 0xf, true));
    const float a = __int_as_float(__builtin_amdgcn_readlane(__float_as_int(v), 15)), b = __int_as_float(__builtin_amdgcn_readlane(__float_as_int(v), 31));
    const float c = __int_as_float(__builtin_amdgcn_readlane(__float_as_int(v), 47)), d = __int_as_float(__builtin_amdgcn_readlane(__float_as_int(v), 63));
    return (a + b) + (c + d);
}
template <int NC>
__device__ __forceinline__ void select_token(const LAS float* srow, int t, int lane, unsigned tbit, LAS unsigned* maskw) {
    if (t < 256) {
#pragma unroll
        for (int c = 0; c < (NC < 4 ? NC : 4); ++c) if (64 * c + lane <= t) (void)__hip_atomic_fetch_or(maskw + 64 * c + lane, tbit, __ATOMIC_RELAXED, __HIP_MEMORY_SCOPE_WORKGROUP);
        return;
    }
    float x[NC];
#pragma unroll
    for (int c = 0; c < NC; ++c) x[c] = srow[64 * c + lane];
#pragma unroll
    for (int c = 4; c < NC; ++c) if (64 * c + 63 > t) x[c] = (64 * c + lane <= t) ? x[c] : -INFINITY;
    float mn = fminf(fminf(x[0], x[1]), fminf(x[2], x[3])), mx = -INFINITY;
#pragma unroll
    for (int c = 0; c < NC; ++c) mx = fmaxf(mx, x[c]);
    mn = dpp_min_f(mn);
    float lo = mn - (fabsf(mn) * 1e-6f + 1e-30f), hi = dpp_max_f(mx);
    const float BIGF = 0x1p100f;
#define COUNT_GT(P, OUT) do { const float nb1_ = -(P) * BIGF; const f32x2 nb_ = {nb1_, nb1_}, bg_ = {BIGF, BIGF}; f32x2 a0_ = {0.f, 0.f}, a1_ = {0.f, 0.f}, a2_ = {0.f, 0.f}, a3_ = {0.f, 0.f}; \
        _Pragma("unroll") for (int c = 0; c < NC; c += 8) { f32x2 y_[4]; \
            _Pragma("unroll") for (int e = 0; e < 4; ++e) { const f32x2 xx_ = {x[c + 2 * e], x[c + 2 * e + 1]}; asm("v_pk_fma_f32 %0, %1, %2, %3 clamp" : "=v"(y_[e]) : "v"(xx_), "v"(bg_), "v"(nb_)); } \
            a0_ += y_[0]; a1_ += y_[1]; a2_ += y_[2]; a3_ += y_[3]; } \
        const f32x2 s2_ = (a0_ + a1_) + (a2_ + a3_); OUT = (int)(dpp_sum_f(s2_[0] + s2_[1]) + 0.5f); } while (0)
    float tau = hi; int need = 256; bool exact = false;
#ifndef PROBE_SEL
#define PROBE_SEL 0
#endif
    {
        float glo = (float)(t + 1) - 255.5f, ghi = -255.5f; int side = 0;
        for (int it = 0; it < 200; ++it) {
            float p = lo + (hi - lo) * (glo * __builtin_amdgcn_rcpf(glo - ghi));
            if (it >= 48 || !(p > lo) || !(p < hi)) p = lo + (hi - lo) * 0.5f;
            if (!(p > lo) || !(p < hi)) break;
            int cm; COUNT_GT(p, cm);
            if (cm == 256) { tau = p; exact = true; break; }
            if (cm > 256) { lo = p; glo = (float)cm - 255.5f; if (side < 0) ghi *= 0.5f; side = -1; }
            else { hi = p; ghi = (float)cm - 255.5f; if (side > 0) glo *= 0.5f; side = 1; }
        }
        if (!exact) { tau = hi; int g; COUNT_GT(hi, g); need = 256 - g; }
    }
#undef COUNT_GT
    if (exact) {
#pragma unroll
        for (int c = 0; c < NC; ++c) (void)__hip_atomic_fetch_or(maskw + 64 * c + lane, (x[c] > tau) ? tbit : 0u, __ATOMIC_RELAXED, __HIP_MEMORY_SCOPE_WORKGROUP);
    } else {
        int base = 0;
#pragma unroll
        for (int c = 0; c < NC; ++c) {
            const bool gt = x[c] > tau, eq = x[c] == tau;
            const unsigned long long tb = __ballot(eq);
            const int rank = base + (int)__builtin_amdgcn_mbcnt_hi((unsigned)(tb >> 32), __builtin_amdgcn_mbcnt_lo((unsigned)tb, 0u));
            base += __popcll(tb);
            if (gt || (eq && rank < need)) (void)__hip_atomic_fetch_or(maskw + 64 * c + lane, tbit, __ATOMIC_RELAXED, __HIP_MEMORY_SCOPE_WORKGROUP);
        }
    }
}
struct XItem { const float* src; unsigned char* dst; int N; };
__device__ __forceinline__ XItem x_decode(int id, int lane, const float* wg, const float* wu, const float* wd, unsigned char* Wgu8, unsigned char* Wd8) {
    const int m = id >> 13, r = id & 8191, e = r >> 8, q = r & 255; XItem t;
    if (m < 2) { const int kb = q >> 3, nb = q & 7, n = nb * 64 + lane;
        t.src = (m == 0 ? wg : wu) + (size_t)e * 1024 * 512 + (size_t)(kb * 32) * 512 + nb * 64; t.N = 512;
        t.dst = Wgu8 + (size_t)(e * 1024 + (n >> 7) * 256 + m * 128 + (n & 127)) * 1024 + kb * 32; }
    else { const int kb = q >> 4, nb = q & 15, n = nb * 64 + lane;
        t.src = wd + (size_t)e * 512 * 1024 + (size_t)(kb * 32) * 1024 + nb * 64; t.N = 1024;
        t.dst = Wd8 + (size_t)(e * 1024 + n) * 512 + kb * 32; }
    return t;
}
__device__ __forceinline__ void x_load(const XItem& t, float (&rg)[32], int lane) {
    unsigned voff = (unsigned)lane * 4u; const unsigned stride = (unsigned)t.N * 4u; const float* base = t.src;
#define XL_(i) "global_load_dword %" #i ", %16, %17 nt\n\tv_add_u32_e32 %16, %18, %16\n\t"
#define XL16_ XL_(0) XL_(1) XL_(2) XL_(3) XL_(4) XL_(5) XL_(6) XL_(7) XL_(8) XL_(9) XL_(10) XL_(11) XL_(12) XL_(13) XL_(14) XL_(15)
    asm volatile(XL16_ : "=&v"(rg[0]), "=&v"(rg[1]), "=&v"(rg[2]), "=&v"(rg[3]), "=&v"(rg[4]), "=&v"(rg[5]), "=&v"(rg[6]), "=&v"(rg[7]), "=&v"(rg[8]), "=&v"(rg[9]), "=&v"(rg[10]), "=&v"(rg[11]), "=&v"(rg[12]), "=&v"(rg[13]), "=&v"(rg[14]), "=&v"(rg[15]), "+v"(voff) : "s"(base), "s"(stride));
    asm volatile(XL16_ : "=&v"(rg[16]), "=&v"(rg[17]), "=&v"(rg[18]), "=&v"(rg[19]), "=&v"(rg[20]), "=&v"(rg[21]), "=&v"(rg[22]), "=&v"(rg[23]), "=&v"(rg[24]), "=&v"(rg[25]), "=&v"(rg[26]), "=&v"(rg[27]), "=&v"(rg[28]), "=&v"(rg[29]), "=&v"(rg[30]), "=&v"(rg[31]), "+v"(voff) : "s"(base), "s"(stride));
#undef XL16_
#undef XL_
}
__device__ __forceinline__ void x_store(const XItem& t, float (&rg)[32]) {
    asm volatile("s_waitcnt vmcnt(0)" ::: "memory");
#pragma unroll
    for (int i = 0; i < 32; ++i) asm volatile("" : "+v"(rg[i]));
    u32x4 o0, o1;
#pragma unroll
    for (int q = 0; q < 4; ++q) { int w0 = 0, w1 = 0;
        w0 = __builtin_amdgcn_cvt_pk_fp8_f32(32.f * rg[4 * q], 32.f * rg[4 * q + 1], w0, false); w0 = __builtin_amdgcn_cvt_pk_fp8_f32(32.f * rg[4 * q + 2], 32.f * rg[4 * q + 3], w0, true);
        w1 = __builtin_amdgcn_cvt_pk_fp8_f32(32.f * rg[16 + 4 * q], 32.f * rg[16 + 4 * q + 1], w1, false); w1 = __builtin_amdgcn_cvt_pk_fp8_f32(32.f * rg[16 + 4 * q + 2], 32.f * rg[16 + 4 * q + 3], w1, true);
        o0[q] = (unsigned)w0; o1[q] = (unsigned)w1; }
    *(u32x4*)t.dst = o0; *(u32x4*)(t.dst + 16) = o1;
}
__device__ __forceinline__ void conv_item(int idx, const bf16_t* u, const bf16_t* cb, const float* cw, bf16_t* conv) {
        const int tok = idx >> 6, cg = (idx & 63) * 8, pos = tok & (SEQ - 1);
        const u32x4 z = (u32x4){0u, 0u, 0u, 0u};
        const u32x4 u0 = *(const u32x4*)(u + (size_t)tok * 512 + cg);
        const u32x4 u1 = pos >= 1 ? *(const u32x4*)(u + (size_t)(tok - 1) * 512 + cg) : z;
        const u32x4 u2 = pos >= 2 ? *(const u32x4*)(u + (size_t)(tok - 2) * 512 + cg) : z;
        const u32x4 bv = __builtin_nontemporal_load((const u32x4*)(cb + (size_t)tok * 512 + cg));
        const f32x4 w0a = *(const f32x4*)(cw + cg), w0b = *(const f32x4*)(cw + cg + 4);
        const f32x4 w1a = *(const f32x4*)(cw + 512 + cg), w1b = *(const f32x4*)(cw + 512 + cg + 4);
        const f32x4 w2a = *(const f32x4*)(cw + 1024 + cg), w2b = *(const f32x4*)(cw + 1024 + cg + 4);
        f32x4 ya, yb;
#define CV(E, WA, I, WORD, HALF) (WA[I] * (HALF ? bfhi(E.WORD) : bflo(E.WORD)))
        ya[0] = bflo(bv.x) * (CV(u2, w0a, 0, x, 0) + CV(u1, w1a, 0, x, 0) + CV(u0, w2a, 0, x, 0));
        ya[1] = bfhi(bv.x) * (CV(u2, w0a, 1, x, 1) + CV(u1, w1a, 1, x, 1) + CV(u0, w2a, 1, x, 1));
        ya[2] = bflo(bv.y) * (CV(u2, w0a, 2, y, 0) + CV(u1, w1a, 2, y, 0) + CV(u0, w2a, 2, y, 0));
        ya[3] = bfhi(bv.y) * (CV(u2, w0a, 3, y, 1) + CV(u1, w1a, 3, y, 1) + CV(u0, w2a, 3, y, 1));
        yb[0] = bflo(bv.z) * (CV(u2, w0b, 0, z, 0) + CV(u1, w1b, 0, z, 0) + CV(u0, w2b, 0, z, 0));
        yb[1] = bfhi(bv.z) * (CV(u2, w0b, 1, z, 1) + CV(u1, w1b, 1, z, 1) + CV(u0, w2b, 1, z, 1));
        yb[2] = bflo(bv.w) * (CV(u2, w0b, 2, w, 0) + CV(u1, w1b, 2, w, 0) + CV(u0, w2b, 2, w, 0));
        yb[3] = bfhi(bv.w) * (CV(u2, w0b, 3, w, 1) + CV(u1, w1b, 3, w, 1) + CV(u0, w2b, 3, w, 1));
#undef CV
        store8bf(conv + (size_t)tok * 1024 + cg, ya, yb);
}
__device__ __forceinline__ void conv_chunk4(int tok0, int cg, const bf16_t* u, const bf16_t* cb, const float* cw, bf16_t* conv) {
    const bool first = (tok0 & (SEQ - 1)) == 0;
    const u32x4 z = (u32x4){0u, 0u, 0u, 0u};
    u32x4 uu[6], bv[4];
    uu[0] = first ? z : *(const u32x4*)(u + (size_t)(tok0 - 2) * 512 + cg); uu[1] = first ? z : *(const u32x4*)(u + (size_t)(tok0 - 1) * 512 + cg);
#pragma unroll
    for (int q = 0; q < 4; ++q) { uu[2 + q] = *(const u32x4*)(u + (size_t)(tok0 + q) * 512 + cg); bv[q] = __builtin_nontemporal_load((const u32x4*)(cb + (size_t)(tok0 + q) * 512 + cg)); }
    const f32x4 w0a = *(const f32x4*)(cw + cg), w0b = *(const f32x4*)(cw + cg + 4);
    const f32x4 w1a = *(const f32x4*)(cw + 512 + cg), w1b = *(const f32x4*)(cw + 512 + cg + 4);
    const f32x4 w2a = *(const f32x4*)(cw + 1024 + cg), w2b = *(const f32x4*)(cw + 1024 + cg + 4);
#pragma unroll
    for (int q = 0; q < 4; ++q) { const u32x4 u2 = uu[q], u1 = uu[q + 1], u0 = uu[q + 2], b4 = bv[q]; f32x4 ya, yb;
#define CV(E, WA, I, WORD, HALF) (WA[I] * (HALF ? bfhi(E.WORD) : bflo(E.WORD)))
        ya[0] = bflo(b4.x) * (CV(u2, w0a, 0, x, 0) + CV(u1, w1a, 0, x, 0) + CV(u0, w2a, 0, x, 0));
        ya[1] = bfhi(b4.x) * (CV(u2, w0a, 1, x, 1) + CV(u1, w1a, 1, x, 1) + CV(u0, w2a, 1, x, 1));
        ya[2] = bflo(b4.y) * (CV(u2, w0a, 2, y, 0) + CV(u1, w1a, 2, y, 0) + CV(u0, w2a, 2, y, 0));
        ya[3] = bfhi(b4.y) * (CV(u2, w0a, 3, y, 1) + CV(u1, w1a, 3, y, 1) + CV(u0, w2a, 3, y, 1));
        yb[0] = bflo(b4.z) * (CV(u2, w0b, 0, z, 0) + CV(u1, w1b, 0, z, 0) + CV(u0, w2b, 0, z, 0));
        yb[1] = bfhi(b4.z) * (CV(u2, w0b, 1, z, 1) + CV(u1, w1b, 1, z, 1) + CV(u0, w2b, 1, z, 1));
        yb[2] = bflo(b4.w) * (CV(u2, w0b, 2, w, 0) + CV(u1, w1b, 2, w, 0) + CV(u0, w2b, 2, w, 0));
        yb[3] = bfhi(b4.w) * (CV(u2, w0b, 3, w, 1) + CV(u1, w1b, 3, w, 1) + CV(u0, w2b, 3, w, 1));
#undef CV
        store8bf(conv + (size_t)(tok0 + q) * 1024 + cg, ya, yb); }
}
struct P2Carry { bf16x8 bfA[4]; float w; };
#define KI_LD4(DST, KBU, KLO, KN) do { const char* ks_ = (KBU) + (size_t)(KN) * 32768; asm volatile("" : "+s"(ks_)); \
            _Pragma("unroll") for (int kk = 0; kk < 4; ++kk) DST[kk] = *(const GAS bf16x8*)((const GAS char*)ks_ + (KLO) + 1024 * kk); } while (0)
__device__ __forceinline__ void p2_request(Frame& F, int b, int qt16, const bf16_t* qi, const bf16_t* ki, const float* wi, P2Carry& C) {
    const int lane = F.lane, wid = F.wave, r = lane & 31, h = lane >> 5;
    const int T0 = qt16 * 16; const size_t rowb = (size_t)b * SEQ;
    const int tk = (r >> 4) + 2 * ((r >> 2) & 1), hd = (r & 3) + 4 * ((r >> 3) & 1);
    const char* kbu = (const char*)(ki + (rowb >> 5) * 2048 + (size_t)wid * 2048); const unsigned klo = (unsigned)(r * 16 + h * 8) * 2u;
    asm volatile("global_load_dwordx4 %0, %4, %5\n\tglobal_load_dwordx4 %1, %4, %5 offset:1024\n\tglobal_load_dwordx4 %2, %4, %5 offset:2048\n\tglobal_load_dwordx4 %3, %4, %5 offset:3072"
                 : "=&v"(C.bfA[0]), "=&v"(C.bfA[1]), "=&v"(C.bfA[2]), "=&v"(C.bfA[3]) : "v"(klo), "s"(kbu));
    { const bf16_t* qp = qi + (rowb + T0 + tk) * 512 + hd * 64 + 8 * h;
#pragma unroll
      for (int jj = 0; jj < 2; ++jj) { const int j = 2 * wid + jj, rb = j >> 2, kk = j & 3;
          attn_body::glds16(qp + rb * 2048 + 16 * kk, (unsigned)__builtin_amdgcn_readfirstlane((int)(unsigned)(size_t)(F.lds + QIF_OFF + j * 1024))); } }
    { const float* wb = wi + (rowb + T0) * 8; const unsigned wo = (unsigned)(F.tid & 127) * 4u;
      asm volatile("global_load_dword %0, %1, %2" : "=&v"(C.w) : "v"(wo), "s"(wb)); }
}
__device__ __forceinline__ void p2_pin(P2Carry& C) { asm volatile("" : "+v"(C.bfA[0]), "+v"(C.bfA[1]), "+v"(C.bfA[2]), "+v"(C.bfA[3]), "+v"(C.w)); }
__device__ __forceinline__ void p2_wtab(Frame& F, P2Carry& C) {
    if (F.tid < 128) ((LAS float*)(F.lds + TAB_OFF + 8192))[F.tid] = C.w * WSCALE;
}
__device__ __forceinline__ void score_select_unit(Frame& F, int b, int qt16, int nb, int nqt16, P2Carry& C, const bf16_t* qi, const bf16_t* ki, const float* wi, LAS float* scl, LAS unsigned* maskw, unsigned* masks, int xid0, int xid1, int cvbase) {
    const int lane = F.lane, wid = F.wave, r = lane & 31, h = lane >> 5;
    const int T0 = qt16 * 16; const size_t rowb = (size_t)b * SEQ;
    XItem xa, xb; float xr0[32], xr1[32];
    { const KArgs ka = kargs(); unsigned char* w8a = F.ws + WS_WGU; unsigned char* w8b = F.ws + WS_WD;
      xa = x_decode(xid0 >= 0 ? xid0 : 0, lane, ka->in[13], ka->in[14], ka->in[15], w8a, w8b); xb = x_decode(xid1 >= 0 ? xid1 : 0, lane, ka->in[13], ka->in[14], ka->in[15], w8a, w8b); }
    {
        const LAS float* wtab = (const LAS float*)(F.lds + TAB_OFF + 8192);
        bf16x8 a[4][4]; bf16x8 (&bfA)[4] = C.bfA; bf16x8 bfB[4];
#pragma unroll
        for (int rb = 0; rb < 4; ++rb)
#pragma unroll
            for (int kk = 0; kk < 4; ++kk) a[rb][kk] = *(const LAS bf16x8*)(F.lds + QIF_OFF + (rb * 4 + kk) * 1024 + lane * 16);
        const int nsteps = ((T0 + 15) >> 8) + 1, kb0 = 32 * wid;
        const char* kbu = (const char*)(ki + (rowb >> 5) * 2048 + (size_t)wid * 2048);
        const unsigned klo = (unsigned)(r * 16 + h * 8) * 2u;
        const LAS float* wl = wtab + 16 * h;
#define SCORE_STEP(KS, BF) do { const int kb_ = 256 * (KS) + kb0; if (kb_ <= T0 + 15) { \
            _Pragma("unroll") for (int rb = 0; rb < 4; ++rb) { \
                f32x16 acc = f32x16{}; \
                _Pragma("unroll") for (int kk = 0; kk < 4; ++kk) acc = __builtin_amdgcn_mfma_f32_32x32x16_bf16(a[rb][kk], BF[kk], acc, 0, 0, 0); \
                const f32x4 w0_ = *(const LAS f32x4*)(wl + 32 * rb), w1_ = *(const LAS f32x4*)(wl + 32 * rb + 4), w2_ = *(const LAS f32x4*)(wl + 32 * rb + 8), w3_ = *(const LAS f32x4*)(wl + 32 * rb + 12); \
                float s0 = 0.f, s1 = 0.f; \
                _Pragma("unroll") for (int reg = 0; reg < 4; ++reg) {     \
                    const float y0_ = __int_as_float(max(__float_as_int(acc[reg]), 0)), y1_ = __int_as_float(max(__float_as_int(acc[reg + 4]), 0)); \
                    const float y2_ = __int_as_float(max(__float_as_int(acc[reg + 8]), 0)), y3_ = __int_as_float(max(__float_as_int(acc[reg + 12]), 0)); \
                    s0 += w0_[reg] * y0_; s0 += w1_[reg] * y1_; s1 += w2_[reg] * y2_; s1 += w3_[reg] * y3_; } \
                LAS float* sp = scl + (4 * rb + 2 * h) * 2048 + kb_ + r; \
                sp[0] = s0; sp[2048] = s1; } } } while (0)
        for (int ks = 0; ks < nsteps; ks += 2) {
            { const int kn = (ks + 1 < 8) ? ks + 1 : 7;
              KI_LD4(bfB, kbu, klo, kn); }
            SCORE_STEP(ks, bfA);
            if (ks + 2 < nsteps) KI_LD4(bfA, kbu, klo, ks + 2);
            if (ks + 1 < nsteps) SCORE_STEP(ks + 1, bfB);
        }
#undef SCORE_STEP
    }
    if (F.tid == 0) *(LAS int*)(F.lds + TAB_OFF + 8192 + 512) = 0;
    LDS_WAIT(); __syncthreads();
    p2_request(F, nb, nqt16, qi, ki, wi, C);
    if (xid0 >= 0) x_load(xa, xr0, lane);
    if (xid1 >= 0) x_load(xb, xr1, lane);
#ifndef PROBE_P2
#define PROBE_P2 0
#endif
    LAS int* tokctr = (LAS int*)(F.lds + TAB_OFF + 8192 + 512);
#pragma unroll 1
    for (;;) {
        int tl = 0; if (lane == 0) tl = __hip_atomic_fetch_add(tokctr, 1, __ATOMIC_RELAXED, __HIP_MEMORY_SCOPE_WORKGROUP);
        tl = __builtin_amdgcn_readfirstlane(tl);
        if (tl >= 16) {
            if (cvbase < 0 || tl >= 20) break;
            const KArgs ka = kargs();
            conv_chunk4((cvbase >> 6) + (tl - 16) * 4, lane * 8, (const bf16_t*)(F.ws + WS_U), (const bf16_t*)(F.ws + WS_CB), ka->in[5], (bf16_t*)(F.ws + WS_AC));
            continue; }
        const int t = T0 + tl, nch = (t >> 6) + 1;
        const unsigned tbit = 1u << tl; const LAS float* srow = scl + tl * 2048;
        if (nch <= 8) select_token<8>(srow, t, lane, tbit, maskw);
        else if (nch <= 16) select_token<16>(srow, t, lane, tbit, maskw);
        else if (nch <= 24) select_token<24>(srow, t, lane, tbit, maskw);
        else select_token<32>(srow, t, lane, tbit, maskw);
    }
    if (xid0 >= 0) x_store(xa, xr0);
    if (xid1 >= 0) x_store(xb, xr1);
    VM_WAIT(); p2_pin(C);
    p2_wtab(F, C);
    LDS_WAIT(); __syncthreads();
    {
        const int ktmax = (T0 + 15) >> 6; unsigned short* mbase = (unsigned short*)(masks + ((size_t)(b * (SEQ / 32) + (qt16 >> 1)) * (SEQ / 64)) * 64) + (qt16 & 1);
#pragma unroll
        for (int jj = 0; jj < 4; ++jj) { const int key = F.tid + 512 * jj, kt = key >> 6, kap = key & 63;
            const unsigned wv = maskw[key]; maskw[key] = 0u;
            if (kt <= ktmax) { const int half = kap >> 5, k5 = kap & 31, hi_ = (k5 >> 2) & 1, rr = (k5 & 3) + 4 * (k5 >> 3); mbase[2 * (kt * 64 + 32 * half + 2 * rr + hi_)] = (unsigned short)wv; } }
    }
}
#undef KI_LD4
__device__ __forceinline__ void conv_pass(Frame& F, const bf16_t* u, const bf16_t* cb, const float* cw, bf16_t* conv) {
    const int gt = F.vcu * 512 + F.tid, NGT = F.G * 512;
    for (int idx = gt; idx < NTOK * 64; idx += NGT) conv_item(idx, u, cb, cw, conv);
}

constexpr int P7_HS = 1032;
constexpr int P7_H = 0, P7_HL = 16 * P7_HS * 2, P7_P = 2 * 16 * P7_HS * 2, P7_L = P7_P + 8 * 16 * 48 * 4, P7_R = P7_L + 16 * 48 * 4, P7_END = P7_R + 6 * 128 * 4 + 2 * 32 * 4;
static_assert(P7_END <= RING_BYTES && (P7_P % 16) == 0, "P7 LDS map");
__device__ __forceinline__ void ln1_router(Frame& F, bool dry) {
    const KArgs a = kargs();
    unsigned char* ws = F.ws;
    const float* xin = a->in[0]; const bf16_t* mixb = (const bf16_t*)(ws + WS_MIX); bf16_t* h1b = dry ? (bf16_t*)(ws + WS_GATES) : (bf16_t*)(ws + WS_PRE);
    int* lists = (int*)(ws + (dry ? WS_MERGED : WS_LIST)); unsigned* tokinfo = (unsigned*)(ws + (dry ? WS_MERGED + 8 * MiB : WS_TOKINFO)); const int cbank = dry ? 64 * NEXP : 0;
    unsigned char* h1q = ws + (dry ? WS_MERGED + 16 * MiB : WS_H1Q);
    const float *g1 = a->in[7], *b1 = a->in[8], *rgb = a->in[10], *reb = a->in[12]; const float* wc = (const float*)(ws + WS_WC);
    const int lane = F.lane, wid = F.wave, tid = F.tid;
    LAS bf16_t* Hh = (LAS bf16_t*)(F.lds + P7_H); LAS bf16_t* Hl = (LAS bf16_t*)(F.lds + P7_HL); LAS float* P = (LAS float*)(F.lds + P7_P); LAS float* L = (LAS float*)(F.lds + P7_L);
    LAS int* RE = (LAS int*)(F.lds + P7_R);
    LAS int* hist = RE + 768; LAS int* basev = RE + 800;
    if (tid < 64) hist[tid] = 0;
    f32x4 gv[4], bv[4];
#pragma unroll
    for (int j = 0; j < 4; ++j) { gv[j] = *(const f32x4*)(g1 + 4 * lane + 256 * j); bv[j] = *(const f32x4*)(b1 + 4 * lane + 256 * j); }
    bf16x8 bhi[4][3], blo[4][3];
    { const int kq = lane >> 4, jn = lane & 15; const float* wp = wc + (size_t)(128 * wid + 8 * kq) * 48 + jn;
#pragma unroll
      for (int sidx = 0; sidx < 4; ++sidx)
#pragma unroll
          for (int cb = 0; cb < 3; ++cb) { u32x4 ph, pl;
#pragma unroll
              for (int jp = 0; jp < 4; ++jp) { const float w0 = wp[(size_t)(32 * sidx + 2 * jp) * 48 + 16 * cb], w1 = wp[(size_t)(32 * sidx + 2 * jp + 1) * 48 + 16 * cb];
                  const unsigned hh = pkbf(w0, w1); ph[jp] = hh; pl[jp] = pkbf(w0 - bflo(hh), w1 - bfhi(hh)); }
              bhi[sidx][cb] = __builtin_bit_cast(bf16x8, ph); blo[sidx][cb] = __builtin_bit_cast(bf16x8, pl); } }
    const int ngrp_total = NTOK / 16;
#pragma unroll 1
    for (int gi = F.vcu * 8; gi < ngrp_total; gi += F.G * 8) {
      f32x4 vn[2][4]; u32x2 mn[2][4];
#pragma unroll
      for (int rr = 0; rr < 2; ++rr)
#pragma unroll
          for (int j = 0; j < 4; ++j) { const size_t o_ = (size_t)(gi * 16 + 2 * wid + rr) * DM + 4 * lane + 256 * j; vn[rr][j] = __builtin_nontemporal_load((const f32x4*)(xin + o_)); mn[rr][j] = __builtin_nontemporal_load((const u32x2*)(mixb + o_)); }
#pragma unroll 1
      for (int gg = 0; gg < 8; ++gg) {
        const int row0 = (gi + gg) * 16;
#pragma unroll
        for (int rr = 0; rr < 2; ++rr) { const int rl = 2 * wid + rr, row = row0 + rl;
            f32x4 v[4]; float sm = 0.f;
#pragma unroll
            for (int j = 0; j < 4; ++j) { const u32x2 mw = mn[rr][j]; v[j] = vn[rr][j] * ALPHA + (f32x4){bflo(mw.x), bfhi(mw.x), bflo(mw.y), bfhi(mw.y)}; sm += (v[j][0] + v[j][1]) + (v[j][2] + v[j][3]); }
            const float mean = dpp_sum_f(sm) * (1.f / DM); float s2 = 0.f;
#pragma unroll
            for (int j = 0; j < 4; ++j) { v[j] = v[j] - mean; s2 += (v[j][0] * v[j][0] + v[j][1] * v[j][1]) + (v[j][2] * v[j][2] + v[j][3] * v[j][3]); }
            const float rstd = 1.f / sqrtf(dpp_sum_f(s2) * (1.f / DM) + LN_EPS);
#pragma unroll
            for (int j = 0; j < 4; ++j) { v[j] = v[j] * rstd * gv[j] + bv[j];
                u32x2 o; o.x = pkbf(v[j][0], v[j][1]); o.y = pkbf(v[j][2], v[j][3]); *(u32x2*)(h1b + (size_t)row * DM + 4 * lane + 256 * j) = o;
                { int wv = 0; wv = __builtin_amdgcn_cvt_pk_fp8_f32(v[j][0], v[j][1], wv, false); wv = __builtin_amdgcn_cvt_pk_fp8_f32(v[j][2], v[j][3], wv, true);
                  *(int*)(h1q + (size_t)row * 1024 + 4 * lane + 256 * j) = wv; }
                { const unsigned h01 = o.x, h23 = o.y;
                  *(LAS u32x2*)(Hh + rl * P7_HS + 4 * lane + 256 * j) = (u32x2){h01, h23};
                  *(LAS u32x2*)(Hl + rl * P7_HS + 4 * lane + 256 * j) = (u32x2){pkbf(v[j][0] - bflo(h01), v[j][1] - bfhi(h01)), pkbf(v[j][2] - bflo(h23), v[j][3] - bfhi(h23))}; } } }
        { const int gnx = gg < 7 ? gg + 1 : gg;
#pragma unroll
          for (int rr = 0; rr < 2; ++rr)
#pragma unroll
              for (int j = 0; j < 4; ++j) { const size_t o_ = (size_t)((gi + gnx) * 16 + 2 * wid + rr) * DM + 4 * lane + 256 * j; vn[rr][j] = __builtin_nontemporal_load((const f32x4*)(xin + o_)); mn[rr][j] = __builtin_nontemporal_load((const u32x2*)(mixb + o_)); } }
        LDS_WAIT(); __syncthreads();
        { f32x4 acc[3]; acc[0] = (f32x4){0.f, 0.f, 0.f, 0.f}; acc[1] = acc[0]; acc[2] = acc[0];
          const int hoff = (lane & 15) * P7_HS + 128 * wid + 8 * (lane >> 4);
#pragma unroll
          for (int sidx = 0; sidx < 4; ++sidx) { const bf16x8 ah = *(const LAS bf16x8*)(Hh + hoff + 32 * sidx), al = *(const LAS bf16x8*)(Hl + hoff + 32 * sidx);
#pragma unroll
              for (int cb = 0; cb < 3; ++cb) { acc[cb] = __builtin_amdgcn_mfma_f32_16x16x32_bf16(ah, bhi[sidx][cb], acc[cb], 0, 0, 0);
                  acc[cb] = __builtin_amdgcn_mfma_f32_16x16x32_bf16(ah, blo[sidx][cb], acc[cb], 0, 0, 0); acc[cb] = __builtin_amdgcn_mfma_f32_16x16x32_bf16(al, bhi[sidx][cb], acc[cb], 0, 0, 0); } }
          LAS float* pp = P + (wid * 16 + 4 * (lane >> 4)) * 48 + (lane & 15);
#pragma unroll
          for (int cb = 0; cb < 3; ++cb)
#pragma unroll
              for (int rg = 0; rg < 4; ++rg) pp[rg * 48 + 16 * cb] = acc[cb][rg]; }
        LDS_WAIT(); __syncthreads();
        for (int idx = tid; idx < 16 * 48; idx += 512) { float sum = 0.f;
#pragma unroll
            for (int w = 0; w < 8; ++w) sum += P[w * 768 + idx];
            L[idx] = sum; }
        LDS_WAIT(); __syncthreads();
        if (wid == gg && lane < 16) { const LAS float* lr = L + lane * 48;
            float gl[4]; int grp = 0;
#pragma unroll
            for (int i = 0; i < 4; ++i) gl[i] = lr[i] + rgb[i];
            float gm = gl[0];
#pragma unroll
            for (int i = 1; i < 4; ++i) if (gl[i] > gm) { gm = gl[i]; grp = i; }
            float den = 0.f;
#pragma unroll
            for (int i = 0; i < 4; ++i) den += __expf(gl[i] - gm);
            const float pgrp = 1.f / den;
            float el[8];
#pragma unroll
            for (int i = 0; i < 8; ++i) el[i] = lr[4 + 8 * grp + i] + reb[grp * 8 + i];
            int i1 = 0; float v1 = el[0];
#pragma unroll
            for (int i = 1; i < 8; ++i) if (el[i] > v1) { v1 = el[i]; i1 = i; }
            int i2 = -1; float v2 = -INFINITY;
#pragma unroll
            for (int i = 0; i < 8; ++i) if (i != i1 && el[i] > v2) { v2 = el[i]; i2 = i; }
            const float ex = __expf(v2 - v1), w1 = pgrp / (1.f + ex), w2 = pgrp * ex / (1.f + ex);
            const int e1 = grp * 8 + i1, e2 = grp * 8 + i2, ti = gg * 16 + lane;
            RE[ti] = e1; RE[128 + ti] = e2; RE[256 + ti] = (int)__float_as_uint(w1); RE[384 + ti] = (int)__float_as_uint(w2);
            RE[512 + ti] = __hip_atomic_fetch_add(hist + e1, 1, __ATOMIC_RELAXED, __HIP_MEMORY_SCOPE_WORKGROUP);
            RE[640 + ti] = __hip_atomic_fetch_add(hist + e2, 1, __ATOMIC_RELAXED, __HIP_MEMORY_SCOPE_WORKGROUP);
        }
      }
      LDS_WAIT(); __syncthreads();
      if (tid < NEXP) { const int hc = hist[tid]; basev[tid] = hc ? (int)__hip_atomic_fetch_add(F.ctl + CW_CNT + cbank + 64 * tid, (unsigned)hc, __ATOMIC_RELAXED, __HIP_MEMORY_SCOPE_AGENT) : 0; }
      LDS_WAIT(); __syncthreads();
      if (tid < 128) { const int row = gi * 16 + tid; const int e1 = RE[tid], e2 = RE[128 + tid];
          const unsigned r1 = (unsigned)(basev[e1] + RE[512 + tid]), r2 = (unsigned)(basev[e2] + RE[640 + tid]);
          if (r1 < (unsigned)LISTCAP) lists[(size_t)e1 * LISTCAP + r1] = row;
          if (r2 < (unsigned)LISTCAP) lists[(size_t)e2 * LISTCAP + r2] = row;
          unsigned* ti = tokinfo + (size_t)row * 8;
          *(u32x4*)ti = (u32x4){(unsigned)e1, r1, (unsigned)RE[256 + tid], (unsigned)e2}; *(u32x2*)(ti + 4) = (u32x2){r2, (unsigned)RE[384 + tid]}; }
      LDS_WAIT(); __syncthreads();
      if (tid < 64) hist[tid] = 0;
      LDS_WAIT(); __syncthreads();
    }
}
__device__ __forceinline__ void moe_tables(Frame& F) {
    LAS int* tab = (LAS int*)(F.lds + TAB_OFF);
    __syncthreads();
    if (F.tid < NEXP) { int c = (int)__hip_atomic_load(F.ctl + CW_CNT + 64 * F.tid, __ATOMIC_RELAXED, __HIP_MEMORY_SCOPE_AGENT); if (c > LISTCAP) c = LISTCAP; tab[T_CNT + F.tid] = c; }
    __syncthreads();
    if (F.tid == 0) { int acc = 0; for (int e = 0; e < NEXP; ++e) { tab[T_BLK0 + e] = acc; acc += (tab[T_CNT + e] + 255) >> 8; } tab[T_BLK0 + NEXP] = acc; tab[T_NB] = acc; }
    __syncthreads();
    if (F.tid < NEXP) { const int b0 = tab[T_BLK0 + F.tid], b1 = tab[T_BLK0 + F.tid + 1]; for (int bb = b0; bb < b1; ++bb) tab[T_BLKE + bb] = F.tid; }
    __syncthreads();
}

__device__ __forceinline__ void combine_ln2(Frame& F) {
    const KArgs a = kargs();
    unsigned char* ws = F.ws;
    const bf16_t* h1 = (const bf16_t*)(ws + WS_PRE); const unsigned char* ys = ws + WS_YS;     const unsigned* tokinfo = (const unsigned*)(ws + WS_TOKINFO);
    const LAS int* tab = (const LAS int*)(F.lds + TAB_OFF);
    const float *g2 = a->in[16], *b2 = a->in[17]; float* outp = a->out;
    const int lane = F.lane, gw = F.vcu * NWAVES + F.wave, NGW = F.G * NWAVES;
    f32x4 gv[4], bv[4];
#pragma unroll
    for (int j = 0; j < 4; ++j) { gv[j] = *(const f32x4*)(g2 + 4 * lane + 256 * j); bv[j] = *(const f32x4*)(b2 + 4 * lane + 256 * j); }
    const int nrw = (NTOK - gw + NGW - 1) / NGW;
    if (nrw > 0) {
#define ROWK(k) (gw + ((k) < nrw ? (k) : nrw - 1) * NGW)
#define TI_LOAD(k, A, B) do { const unsigned* ti_ = tokinfo + (size_t)ROWK(k) * 8; A = *(const u32x4*)ti_; B = *(const u32x2*)(ti_ + 4); } while (0)
#define DATA_LOAD(k, A, B, HW, YA, YB) do { const int e1_ = (int)A.x, e2_ = (int)A.w; \
        const size_t s1_ = (size_t)tab[T_BLK0 + e1_] * 256 + A.y, s2_ = (size_t)tab[T_BLK0 + e2_] * 256 + B.x; \
        const bf16_t* hr_ = h1 + (size_t)ROWK(k) * DM + 4 * lane; const unsigned char* y1_ = ys + s1_ * DM + 4 * lane; const unsigned char* y2_ = ys + s2_ * DM + 4 * lane; \
        _Pragma("unroll") for (int j = 0; j < 4; ++j) { HW[j] = __builtin_nontemporal_load((const u32x2*)(hr_ + 256 * j)); YA[j] = __builtin_nontemporal_load((const unsigned*)(y1_ + 256 * j)); YB[j] = __builtin_nontemporal_load((const unsigned*)(y2_ + 256 * j)); } } while (0)
        u32x4 tc0, tn0, tq0; u32x2 tc1, tn1, tq1;
        u32x2 hw[4], hwn[4]; unsigned ya[4], yb[4], yan[4], ybn[4];
        TI_LOAD(0, tc0, tc1); TI_LOAD(1, tn0, tn1);
        DATA_LOAD(0, tc0, tc1, hw, ya, yb);
        for (int k = 0; k < nrw; ++k) {
            TI_LOAD(k + 2, tq0, tq1);
            DATA_LOAD(k + 1, tn0, tn1, hwn, yan, ybn);
            const float w1 = __uint_as_float(tc0.z), w2 = __uint_as_float(tc1.y);
            f32x4 v[4]; float sm = 0.f;
#pragma unroll
            for (int j = 0; j < 4; ++j) {
                v[j][0] = ALPHA * bflo(hw[j].x) + w1 * __builtin_amdgcn_cvt_f32_fp8((int)ya[j], 0) + w2 * __builtin_amdgcn_cvt_f32_fp8((int)yb[j], 0);
                v[j][1] = ALPHA * bfhi(hw[j].x) + w1 * __builtin_amdgcn_cvt_f32_fp8((int)ya[j], 1) + w2 * __builtin_amdgcn_cvt_f32_fp8((int)yb[j], 1);
                v[j][2] = ALPHA * bflo(hw[j].y) + w1 * __builtin_amdgcn_cvt_f32_fp8((int)ya[j], 2) + w2 * __builtin_amdgcn_cvt_f32_fp8((int)yb[j], 2);
                v[j][3] = ALPHA * bfhi(hw[j].y) + w1 * __builtin_amdgcn_cvt_f32_fp8((int)ya[j], 3) + w2 * __builtin_amdgcn_cvt_f32_fp8((int)yb[j], 3);
                sm += (v[j][0] + v[j][1]) + (v[j][2] + v[j][3]); }
            const float mean = dpp_sum_f(sm) * (1.f / DM); float s2v = 0.f;
#pragma unroll
            for (int j = 0; j < 4; ++j) { v[j] = v[j] - mean; s2v += (v[j][0] * v[j][0] + v[j][1] * v[j][1]) + (v[j][2] * v[j][2] + v[j][3] * v[j][3]); }
            const float rstd = 1.f / sqrtf(dpp_sum_f(s2v) * (1.f / DM) + LN_EPS);
            float* orow = outp + (size_t)(gw + k * NGW) * DM + 4 * lane;
#pragma unroll
            for (int j = 0; j < 4; ++j) __builtin_nontemporal_store(v[j] * rstd * gv[j] + bv[j], (f32x4*)(orow + 256 * j));
            tc0 = tn0; tc1 = tn1; tn0 = tq0; tn1 = tq1;
#pragma unroll
            for (int j = 0; j < 4; ++j) { hw[j] = hwn[j]; ya[j] = yan[j]; yb[j] = ybn[j]; }
        }
#undef ROWK
#undef TI_LOAD
#undef DATA_LOAD
    }
}

#if DBG_NAIVE
constexpr size_t WS_NK = 296 * MiB, WS_NV = 312 * MiB, WS_NKI = 328 * MiB;
__device__ __forceinline__ float naive_proj(const float* xs  , const float* w_in, int col) {
    float s = 0.f; for (int d = 0; d < DM; ++d) s += xs[d] * w_in[(size_t)d * INW + col]; return s;
}
__device__ __forceinline__ void naive_kv(Frame& F) {
    const KArgs ka = kargs(); const float* xin = ka->in[0]; const float* win = ka->in[1];
    float* nk = (float*)(F.ws + WS_NK); float* nv = (float*)(F.ws + WS_NV); float* nki = (float*)(F.ws + WS_NKI);
    LAS float* xs = (LAS float*)F.lds; LAS float* pr = xs + 1024;
    for (int tok = F.vcu; tok < NTOK; tok += F.G) {
        __syncthreads();
        for (int i = F.tid; i < DM; i += 512) xs[i] = xin[(size_t)tok * DM + i];
        __syncthreads();
        if (F.tid < 320) { const int col = F.tid < 256 ? 512 + F.tid : 1280 + (F.tid - 256); float s = 0.f; for (int d = 0; d < DM; ++d) s += xs[d] * win[(size_t)d * INW + col]; pr[F.tid] = s; }
        __syncthreads();
        const int pos = tok & (SEQ - 1);
        if (F.tid < 24) {
            const int grp = F.tid >> 3, i = F.tid & 7, base = grp == 0 ? 0 : (grp == 1 ? 64 : 256);
            const float inv = (float)pow(500000.0, -(double)i / 8.0); const float ang = (float)pos * inv, c = cosf(ang), s = sinf(ang);
            const float x1 = pr[base + i], x2 = pr[base + 8 + i]; pr[base + i] = x1 * c - x2 * s; pr[base + 8 + i] = x2 * c + x1 * s;
        }
        __syncthreads();
        if (F.tid < 128) { nk[(size_t)tok * 128 + F.tid] = pr[F.tid]; nv[(size_t)tok * 128 + F.tid] = pr[128 + F.tid]; }
        if (F.tid < 64) nki[(size_t)tok * 64 + F.tid] = pr[256 + F.tid];
    }
}
__device__ __forceinline__ void naive_attn(Frame& F) {
    const KArgs ka = kargs(); const float* xin = ka->in[0]; const float* win = ka->in[1];
    const float* nk = (const float*)(F.ws + WS_NK); const float* nv = (const float*)(F.ws + WS_NV); const float* nki = (const float*)(F.ws + WS_NKI);
    bf16_t* attn = (bf16_t*)(F.ws + WS_AC) + 512;
    LAS float* xs = (LAS float*)F.lds;
    LAS float* qs = xs + 1024;
    LAS float* qis = qs + 512;
    LAS float* wis = qis + 512;
    LAS float* sc = wis + 16;
    LAS int* sel = (LAS int*)(sc + 2048);
    LAS int* nsel = sel + 256;
    LAS float* pl = (LAS float*)(nsel + 16);
    for (int tok = F.vcu; tok < NTOK; tok += F.G) {
        const int pos = tok & (SEQ - 1), b0 = tok - pos;
        __syncthreads();
        for (int i = F.tid; i < DM; i += 512) xs[i] = xin[(size_t)tok * DM + i];
        if (F.tid == 0) nsel[0] = 0;
        __syncthreads();
        for (int c = F.tid; c < 1032; c += 512) { const int col = c < 512 ? c : (c < 1024 ? 768 + (c - 512) : 1344 + (c - 1024));
            float s = 0.f; for (int d = 0; d < DM; ++d) s += xs[d] * win[(size_t)d * INW + col];
            if (c < 512) qs[c] = s; else if (c < 1024) qis[c - 512] = s; else wis[c - 1024] = s; }
        __syncthreads();
        if (F.tid < 128) { const int which = F.tid >> 6, hd = (F.tid >> 3) & 7, i = F.tid & 7; LAS float* p = (which ? qis : qs) + hd * 64;
            const float inv = (float)pow(500000.0, -(double)i / 8.0); const float ang = (float)pos * inv, c = cosf(ang), s = sinf(ang);
            const float x1 = p[i], x2 = p[8 + i]; p[i] = x1 * c - x2 * s; p[8 + i] = x2 * c + x1 * s; }
        __syncthreads();
#if DBG_NAIVE == 2
        { const bf16_t* qif = (const bf16_t*)(F.ws + WS_QI) + (size_t)tok * 512; for (int i = F.tid; i < 512; i += 512) qis[i] = __uint_as_float((unsigned)qif[i] << 16);
          if (F.tid < 8) wis[F.tid] = ((const float*)(F.ws + WS_WI))[(size_t)tok * 8 + F.tid]; }
        __syncthreads();
        for (int s = F.tid; s <= pos; s += 512) { const int tk_ = b0 + s; const bf16_t* kr = (const bf16_t*)(F.ws + WS_KI) + (size_t)(tk_ >> 5) * 2048 + (tk_ & 31) * 16; float tot = 0.f;
            for (int hd = 0; hd < 8; ++hd) { float d = 0.f; for (int e = 0; e < 64; ++e) d += qis[hd * 64 + e] * __uint_as_float((unsigned)kr[(e >> 4) * 512 + ((e >> 3) & 1) * 8 + (e & 7)] << 16); tot += fmaxf(d, 0.f) * (wis[hd] * WSCALE); }
            sc[s] = tot; }
#else
        for (int s = F.tid; s <= pos; s += 512) { const float* kr = nki + (size_t)(b0 + s) * 64; float tot = 0.f;
            for (int hd = 0; hd < 8; ++hd) { float d = 0.f; for (int e = 0; e < 64; ++e) d += qis[hd * 64 + e] * kr[e]; d *= 0.125f; tot += fmaxf(d, 0.f) * wis[hd]; }
            sc[s] = tot * 0.35355339059327373f; }
#endif
        __syncthreads();
        for (int s = F.tid; s <= pos; s += 512) { bool take = true;
            if (pos >= 256) { const float xv = sc[s]; int rank = 0; for (int s2 = 0; s2 <= pos; ++s2) { const float y = sc[s2]; rank += (y > xv || (y == xv && s2 < s)) ? 1 : 0; } take = rank < 256; }
            if (take) { const int p = atomicAdd((int*)nsel, 1); sel[p] = s; } }
        __syncthreads();
        const int ns = nsel[0]; const int hd = F.wave, lane = F.lane;
        float lg[4]; float mx = -INFINITY;
        for (int jj = 0; jj < 4; ++jj) { const int j = lane + 64 * jj; lg[jj] = -INFINITY;
            if (j < ns) { const float* kr = nk + (size_t)(b0 + sel[j]) * 128 + (hd >> 2) * 64; float d = 0.f; for (int e = 0; e < 64; ++e) d += qs[hd * 64 + e] * kr[e]; lg[jj] = d * 0.125f; mx = fmaxf(mx, lg[jj]); } }
        mx = wave_max(mx); float sum = 0.f;
        for (int jj = 0; jj < 4; ++jj) { const int j = lane + 64 * jj; const float p = (j < ns) ? expf(lg[jj] - mx) : 0.f; sum += p; pl[hd * 256 + j] = p; }
        sum = wave_sum(sum);
        LDS_WAIT(); asm volatile("" ::: "memory");
        float o = 0.f;
        for (int j = 0; j < ns; ++j) o += pl[hd * 256 + j] * nv[(size_t)(b0 + sel[j]) * 128 + (hd >> 2) * 64 + lane];
        o /= sum;
        bf16_t* ap = attn + (size_t)tok * 1024 + hd * 64 + lane;
        const float fast = __uint_as_float((unsigned)(*ap) << 16);
        const float blended = o + DBG_G * (fast - o);
        *ap = (bf16_t)(pkbf(blended, 0.f) & 0xffffu);
    }
}
#endif

__global__ void __launch_bounds__(NWAVES * 64, 2) mk_fwd(Args args_unused) {
    extern __shared__ __attribute__((aligned(16))) unsigned char lds[];
    Frame F;
    F.lds = (LAS unsigned char*)lds;
    F.MISC = (volatile LAS unsigned*)(F.lds + LDSCTL_OFF);
    F.tid = threadIdx.x; F.lane = F.tid & 63; F.wave = __builtin_amdgcn_readfirstlane(F.tid >> 6);
    F.G = gridDim.x; { const int bx = blockIdx.x; F.vcu = (F.G % 8 == 0) ? (bx % 8) * (F.G / 8) + bx / 8 : bx; }
    unsigned char* ws; int lo, hi;
    { const KArgs ka = kargs(); ws = ka->ws; lo = ka->ph_lo; hi = ka->ph_hi; }
    F.ws = ws; F.ctl = (unsigned*)(ws + WS_CTL);
    for (int u = F.tid; u < (LDS_BYTES - LDSCTL_OFF) / 4; u += NWAVES * 64) ((LAS unsigned*)(F.lds + LDSCTL_OFF))[u] = 0u;
    __syncthreads();
#if MK_SPLIT
#define GRID_BAR() do { } while (0)
#else
    XcdBarrier bar = xcd_barrier_post(F.ctl + CW_BAR, F.MISC + 8);
#define GRID_BAR() xcd_barrier(bar)
#endif
#ifndef PHASE_MASK
#define PHASE_MASK 0xFFFF
#endif
#define IN(k) ((((PHASE_MASK) >> (k)) & 1) && lo <= (k) && (k) < hi)
#define BOTH(k, k2) (IN(k) && IN(k2))

    bf16_t* xb = (bf16_t*)(ws + WS_XB);
    bf16_t *qb = (bf16_t*)(ws + WS_Q), *kbuf = (bf16_t*)(ws + WS_K), *vbuf = (bf16_t*)(ws + WS_V), *qib = (bf16_t*)(ws + WS_QI), *kib = (bf16_t*)(ws + WS_KI);
    float* wib = (float*)(ws + WS_WI);
    bf16_t *ub = (bf16_t*)(ws + WS_U), *cbb = (bf16_t*)(ws + WS_CB), *acb = (bf16_t*)(ws + WS_AC), *gab = (bf16_t*)(ws + WS_GA), *rtb = (bf16_t*)(ws + WS_RT);
    unsigned* masks = (unsigned*)(ws + WS_MASK);
    bf16_t *merged = (bf16_t*)(ws + WS_MERGED), *h1b = (bf16_t*)(ws + WS_PRE), *ysb_unused = nullptr; (void)ysb_unused;
    float* pre = (float*)(ws + WS_PRE);

    if (IN(0)) { p0_prologue(F); if (BOTH(0, 1)) GRID_BAR(); }
    if (IN(1)) {
#define P1_BF16() { const bf16_t *xa_ = xb, *wa_ = (const bf16_t*)(ws + WS_WIN) + (size_t)1536 * 1024; bf16_t *u_ = ub, *cb_ = cbb; asm volatile("" : "+s"(xa_), "+s"(wa_), "+s"(u_), "+s"(cb_));     \
        pg8::Gemm g{xa_, wa_, NTOK, 1536, DM, 0}; pg8::StaticOrder S; S.init(NTOK, 1536, F.G, (int)blockIdx.x); \
        EpiProj E{qb, kbuf, vbuf, qib, kib, u_, cb_, gab, rtb, wib, (const float*)(ws + WS_ROPE), kargs()->in[2], 1}; \
        pg8::gemm_phase<EpiProj, pg8::StaticOrder, true, false>(F.lds, g, S, E, nullptr); }
#ifndef P1_STAGGER
#define P1_STAGGER 1
#endif
        if (F.vcu & 2) { for (int i = 0; i < P1_STAGGER; ++i) __builtin_amdgcn_s_sleep(127); }
        const int first8 = __builtin_amdgcn_readfirstlane(F.vcu & 1);
#define P1_F8() {     \
            pg8::Gemm g8{(const bf16_t*)(ws + WS_XQ), (const bf16_t*)(ws + WS_WIN8), NTOK, 3584, 512, 0}; pg8::StaticOrder S8; S8.init(NTOK, 3584, F.G, (int)blockIdx.x); \
            EpiProj E8{qb, kbuf, vbuf, qib, kib, ub, cbb, gab, rtb, wib, (const float*)(ws + WS_ROPE), kargs()->in[2], 0}; \
            pg8::gemm_phase<EpiProj, pg8::StaticOrder, true, false, false, true>(F.lds, g8, S8, E8, nullptr); }
        if (first8 != 0) P1_F8()
        P1_BF16()
        if (first8 == 0) P1_F8()
        if (BOTH(1, 2)) GRID_BAR();
    }
    if (IN(2)) {
        LAS float* scl = (LAS float*)F.lds;
        LAS unsigned* maskw = (LAS unsigned*)(F.lds + TAB_OFF);
        for (int i = F.tid; i < 2048; i += 512) maskw[i] = 0u;
        __syncthreads();
        if (F.G == 256) {
            const int b = F.vcu >> 4, j = F.vcu & 15;
            P2Carry C; p2_request(F, b, j, qib, kib, wib, C); VM_WAIT(); p2_pin(C); p2_wtab(F, C); LDS_WAIT(); __syncthreads();
#pragma unroll 1
            for (int i = 0; i < 8; ++i) { const int qt = 32 * (i >> 1) + ((i & 1) ? 31 - j : j); const int in = i < 7 ? i + 1 : 7, qtn = 32 * (in >> 1) + ((in & 1) ? 31 - j : j);
                const int gwv = F.vcu * NWAVES + F.wave, jx0 = i < 4 ? 2 * i : 4 + i;
                score_select_unit(F, b, qt, b, qtn, C, qib, kib, wib, scl, maskw, masks, gwv + 2048 * jx0, i < 4 ? gwv + 2048 * (jx0 + 1) : -1, (F.vcu * 8 + i) * 1024); }
        } else {
            if (F.vcu < NBATCH * 128) {
                P2Carry C; p2_request(F, F.vcu >> 7, F.vcu & 127, qib, kib, wib, C); VM_WAIT(); p2_pin(C); p2_wtab(F, C); LDS_WAIT(); __syncthreads();
#pragma unroll 1
                for (int un = F.vcu; un < NBATCH * 128; un += F.G) { const int unn = un + F.G < NBATCH * 128 ? un + F.G : un;
                    score_select_unit(F, un >> 7, un & 127, unn >> 7, unn & 127, C, qib, kib, wib, scl, maskw, masks, -1, -1, -1); } }
        }
        if (F.G != 256) conv_pass(F, ub, cbb, kargs()->in[5], acb);
        if (BOTH(2, 3)) GRID_BAR();
    }
    if (IN(3)) {
        const int nun = NBATCH * 8 * 8;
        if (F.G == 256) {
            const int bh = F.vcu >> 1, s0 = 2 * (F.vcu & 1);
#pragma unroll 1
            for (int i = 0; i < 4; ++i) { const int qbk = (i == 0) ? s0 : (i == 1) ? 7 - s0 : (i == 2) ? s0 + 1 : 6 - s0;
                attn_body::attn_unit<8>(bh >> 3, bh & 7, qbk, (const attn_body::bf16*)qb, (const attn_body::bf16*)kbuf, (const attn_body::bf16*)vbuf, (attn_body::bf16*)acb, masks, (char*)lds); }
        } else {
#pragma unroll 1
            for (int un = F.vcu; un < nun; un += F.G) attn_body::attn_unit<8>(un >> 6, (un >> 3) & 7, un & 7, (const attn_body::bf16*)qb, (const attn_body::bf16*)kbuf, (const attn_body::bf16*)vbuf, (attn_body::bf16*)acb, masks, (char*)lds);
        }
        if (BOTH(3, 4)) GRID_BAR();
    }
#if DBG_NAIVE
    if (IN(4)) { naive_kv(F); }
    if (IN(11)) { naive_attn(F); }
#else
    if (IN(4)) { if (BOTH(4, 5)) { } }
#endif
    if (IN(5)) {
        pg8::Gemm g{acb, (const bf16_t*)(ws + WS_WAU), NTOK, DM, DM, 0}; pg8::StaticOrder S; S.init(NTOK, DM, F.G, (int)blockIdx.x);
        EpiMerged E{gab, rtb, merged};
        pg8::gemm_phase<EpiMerged, pg8::StaticOrder, true, false, true>(F.lds, g, S, E, nullptr);
        if (BOTH(5, 6)) GRID_BAR();
    }
    if (IN(6)) {
        pg8::Gemm g{merged, (const bf16_t*)(ws + WS_WOUT), NTOK, DM, DM, 0}; pg8::StaticOrder S; S.init(NTOK, DM, F.G, (int)blockIdx.x);
        EpiOut E{(bf16_t*)(ws + WS_MIX)};
        pg8::gemm_phase<EpiOut, pg8::StaticOrder, true, false>(F.lds, g, S, E, nullptr);
        if (BOTH(6, 7)) GRID_BAR();
    }
    if (IN(7)) { ln1_router(F, (kargs()->flags & 1) != 0); if (BOTH(7, 8)) GRID_BAR(); }
    if (IN(8)) {
        moe_tables(F);
        LAS int* tab = (LAS int*)(F.lds + TAB_OFF);
        const int nunits = tab[T_NB] * 4; const int* lists = (const int*)(ws + WS_LIST);
        for (int i = 0; i < T_ROWS_UNITS; ++i) { const int L = i * F.G + F.vcu; if (L >= nunits) break;
            const int rbg = L >> 2, e = tab[T_BLKE + rbg], slot0 = (rbg - tab[T_BLK0 + e]) * 256, cnt = tab[T_CNT + e];
            if (F.tid < 256) { const int sl = slot0 + F.tid; tab[T_ROWS + i * 256 + F.tid] = sl < cnt ? lists[(size_t)e * LISTCAP + sl] : 0; } }
        __syncthreads();
        pg8::Gemm g{(const bf16_t*)(ws + WS_H1Q), (const bf16_t*)(ws + WS_WGU), CAPROWS, NEXP * 1024, 512, 0}; pg8::MoeOrder S{tab + T_BLKE, nunits, F.G, F.vcu};
        EpiSwiGLU E{ws + WS_HID, BOTH(8, 9) ? F.ctl + CW_DEP : nullptr, bar.x, bar.st[0], F.G};
        pg8::gemm_phase<EpiSwiGLU, pg8::MoeOrder, true, true, false, true>(F.lds, g, S, E, tab + T_ROWS);
    }
    if (IN(9)) {
        if (!BOTH(8, 9)) moe_tables(F);
        LAS int* tab = (LAS int*)(F.lds + TAB_OFF);
        const int nunits = tab[T_NB] * 4;
        if (BOTH(8, 9)) {
            if (F.tid == 0) { unsigned* dep = F.ctl + CW_DEP; const unsigned nx = bar.st[1]; XB_SPIN(xb_ld(dep + 64 * 16) < nx, bar.bar);
                __builtin_amdgcn_fence(__ATOMIC_ACQUIRE, "agent"); asm volatile("s_waitcnt vmcnt(0)" ::: "memory"); }
            __syncthreads(); }
        pg8::Gemm g{(const bf16_t*)(ws + WS_HID), (const bf16_t*)(ws + WS_WD), CAPROWS, NEXP * 1024, 256, 0};
        pg8::MoeOrder9 S{tab + T_BLKE, nunits, F.G, F.vcu, BOTH(8, 9) ? F.ctl + CW_DEP + 64 * 17 : nullptr, bar.bar + XB_TMO};
        EpiYs E{ws + WS_YS};
        pg8::gemm_phase<EpiYs, pg8::MoeOrder9, true, false, false, true>(F.lds, g, S, E, nullptr);
        if (BOTH(9, 10)) GRID_BAR();
    }
    if (IN(10)) { if (!BOTH(9, 10)) moe_tables(F); combine_ln2(F); }
#undef IN
#undef BOTH
}

extern "C" void kernel_launch(void* const* d_in, const int* in_sizes, int n_in, void* d_out, int out_size, void* d_ws, size_t ws_size, hipStream_t stream) {
    static int grid = 0;
    if (grid == 0) {
        if (n_in != 18 || in_sizes[0] != NTOK * DM || out_size != NTOK * DM || ws_size < WS_END) { fprintf(stderr, "kernel_launch: unexpected shapes (n_in %d, ws %zu)\n", n_in, ws_size); grid = -1; return; }
        int dev = 0, cus = 0, per_cu = 0;
        if (hipGetDevice(&dev) != hipSuccess || hipDeviceGetAttribute(&cus, hipDeviceAttributeMultiprocessorCount, dev) != hipSuccess) { grid = -1; return; }
        if (hipFuncSetAttribute((const void*)mk_fwd, hipFuncAttributeMaxDynamicSharedMemorySize, LDS_BYTES) != hipSuccess) { fprintf(stderr, "kernel_launch: hipFuncSetAttribute failed\n"); grid = -1; return; }
        if (hipOccupancyMaxActiveBlocksPerMultiprocessor(&per_cu, (const void*)mk_fwd, NWAVES * 64, LDS_BYTES) != hipSuccess || per_cu < 1) fprintf(stderr, "kernel_launch: occupancy query reports %d\n", per_cu);
        (void)hipGetLastError();
        grid = cus;
    }
    if (grid < 0) return;
    (void)hipMemsetAsync((char*)d_ws + WS_CTL, 0, CTL_ZERO_BYTES, stream);
    Args a{};
    for (int i = 0; i < 18; ++i) a.in[i] = (const float*)d_in[i];
    a.out = (float*)d_out; a.ws = (unsigned char*)d_ws;
#if MK_SPLIT
#if DBG_NAIVE
    const int seq[] = {0, 1, 2, 3, 4, 11, 5, 6, 7, 8, 9, 10};
#else
    const int seq[] = {0, 1, 2, 3, 5, 6, 7, 8, 9, 10};
#endif
    for (int ph : seq) { a.ph_lo = ph; a.ph_hi = ph + 1;
#ifdef PROBE_P7
        if (ph == 7) { a.flags = 1; hipLaunchKernelGGL(mk_fwd, dim3(grid), dim3(NWAVES * 64), LDS_BYTES, stream, a); a.flags = 0; }
#endif
        hipLaunchKernelGGL(mk_fwd, dim3(grid), dim3(NWAVES * 64), LDS_BYTES, stream, a);
#ifdef PROBE_DUP
        if (ph == PROBE_DUP) hipLaunchKernelGGL(mk_fwd, dim3(grid), dim3(NWAVES * 64), LDS_BYTES, stream, a);
#endif
    }
#else
    a.ph_lo = 0; a.ph_hi = 11;
    hipLaunchKernelGGL(mk_fwd, dim3(grid), dim3(NWAVES * 64), LDS_BYTES, stream, a);
#endif
}
```
